# Optimizing an MI355X kernel written in HIP

```python
import jax, jax.numpy as jnp
from jax import lax
import numpy as np

D_MODEL = 1024
BATCH = 16
SEQ = 2048
DEPTH = 1

HEAD_DIM = 64
ATTN_HEADS = 8
RWKV_HEADS = 8
ATTN_WIDTH = ATTN_HEADS * HEAD_DIM
RWKV_WIDTH = RWKV_HEADS * HEAD_DIM
MIX_WIDTH = ATTN_WIDTH + RWKV_WIDTH
DECAY_LORA = 64
ICLR_LORA = 64
GATE_LORA = 128
RWKV_COLS = 3 * RWKV_WIDTH + DECAY_LORA + ICLR_LORA + GATE_LORA
IN_COLS = 3 * ATTN_WIDTH + RWKV_COLS
DILATED_PATTERNS = ((128, 1), (512, 4), (2048, 16))
ATTN_BLOCK = 128
D_FF = -(-8 * D_MODEL // (3 * 256)) * 256
NORM_EPS = 1e-6
LNX_EPS = 64e-5

kernel_name = 'hymba_dilated_attn_rwkv7_swiglu'


def rms_norm(x, g):
    xf = x.astype(jnp.float32)
    return xf * lax.rsqrt(jnp.mean(xf * xf, axis=-1, keepdims=True) + NORM_EPS) * g.astype(jnp.float32)


def alibi_slopes(n_heads):
    return jnp.exp2(-8.0 * jnp.arange(1, n_heads + 1, dtype=jnp.float32) / n_heads)


def dilated_band(q, k, v, slopes, window, dilation):
    B, S, H, Dh = q.shape
    steps = window // dilation
    bq = ATTN_BLOCK
    assert steps <= bq
    unit = dilation * bq
    s_pad = -(-S // unit) * unit
    n_sub = s_pad // dilation
    n_blk = n_sub // bq

    def to_blocks(t):
        t = jnp.pad(t, ((0, 0), (0, s_pad - S), (0, 0), (0, 0)))
        t = t.reshape(B, n_sub, dilation, H, Dh).transpose(0, 2, 3, 1, 4)
        return t.reshape(B, dilation, H, n_blk, bq, Dh)

    def with_prev(t):
        prev = jnp.pad(t, ((0, 0), (0, 0), (0, 0), (1, 0), (0, 0), (0, 0)))[:, :, :, :-1]
        return jnp.concatenate([prev, t], axis=4)

    qb = to_blocks(q)
    kw = with_prev(to_blocks(k))
    vw = with_prev(to_blocks(v))
    scores = jnp.einsum('bdhnqe,bdhnke->bdhnqk', qb, kw)
    q_idx = jnp.arange(bq)[:, None] + bq
    k_idx = jnp.arange(2 * bq)[None, :]
    diff = q_idx - k_idx
    key_abs = jnp.arange(n_blk)[:, None, None] * bq + k_idx[None] - bq
    valid = (diff >= 0) & (diff <= steps) & (key_abs >= 0)
    bias = -slopes[:, None, None, None] * (diff.astype(jnp.float32) * dilation)
    scores = jnp.where(valid, scores + bias, -jnp.inf)
    m = jnp.max(scores, axis=-1)
    p = jnp.exp(scores - m[..., None])
    den = jnp.sum(p, axis=-1)
    num = jnp.einsum('bdhnqk,bdhnke->bdhnqe', p, vw)

    def from_blocks(t):
        tail = t.shape[5:]
        t = t.reshape((B, dilation, H, n_sub) + tail)
        t = jnp.moveaxis(t, 3, 1)
        return t.reshape((B, s_pad, H) + tail)[:, :S]

    return from_blocks(num), from_blocks(m), from_blocks(den)


def dilated_attention(q, k, v, q_norm_g, k_norm_g):
    B, S, _ = q.shape
    shp = (B, S, ATTN_HEADS, HEAD_DIM)
    q = rms_norm(q.reshape(shp), q_norm_g) * HEAD_DIM ** -0.5
    k = rms_norm(k.reshape(shp), k_norm_g)
    v = v.reshape(shp).astype(jnp.float32)
    slopes = alibi_slopes(ATTN_HEADS)
    nums, maxs, dens = [], [], []
    for window, dilation in DILATED_PATTERNS:
        num, m, den = dilated_band(q, k, v, slopes, window, dilation)
        nums.append(num); maxs.append(m); dens.append(den)
    maxs = jnp.stack(maxs)
    scale = jnp.exp(maxs - jnp.max(maxs, axis=0))
    total_num = jnp.sum(scale[..., None] * jnp.stack(nums), axis=0)
    total_den = jnp.sum(scale * jnp.stack(dens), axis=0)
    return total_num / total_den[..., None]


def wkv7_scan(r, w, k, v, a, b):
    B, S, H, Dh = r.shape

    def step(state, inp):
        r_t, w_t, k_t, v_t, a_t, b_t = inp
        sa = jnp.einsum('bhij,bhj->bhi', state, a_t)
        state = (state * w_t[:, :, None, :] + sa[..., None] * b_t[:, :, None, :]
                 + v_t[..., None] * k_t[:, :, None, :])
        return state, jnp.einsum('bhij,bhj->bhi', state, r_t)

    xs = tuple(jnp.moveaxis(t, 1, 0) for t in (r, w, k, v, a, b))
    state0 = jnp.zeros((B, H, Dh, Dh), jnp.float32)
    _, y = lax.scan(step, state0, xs)
    return jnp.moveaxis(y, 0, 1)


def rwkv7_time_mix(p_rw, mu, w0, w2, a0, a2, g2, k_k, k_a, r_k, lnx_g, lnx_b):
    B, S, _ = p_rw.shape
    p = p_rw.astype(jnp.float32)
    prev = jnp.pad(p, ((0, 0), (1, 0), (0, 0)))[:, :-1]
    xs = p + (prev - p) * mu
    cuts = [RWKV_WIDTH, 2 * RWKV_WIDTH, 3 * RWKV_WIDTH,
            3 * RWKV_WIDTH + DECAY_LORA, 3 * RWKV_WIDTH + DECAY_LORA + ICLR_LORA]
    r, k, v, wl, al, gl = jnp.split(xs, cuts, axis=-1)
    w = -jax.nn.softplus(-(w0 + jnp.tanh(wl) @ w2)) - 0.5
    decay = jnp.exp(-jnp.exp(w))
    a = jax.nn.sigmoid(a0 + al @ a2)
    g = jax.nn.sigmoid(gl) @ g2

    def heads(t):
        return t.reshape(B, S, RWKV_HEADS, HEAD_DIM)

    kk = heads(k * k_k)
    kk = kk / jnp.maximum(jnp.sqrt(jnp.sum(kk * kk, axis=-1, keepdims=True)), 1e-12)
    k = k * (1.0 + (a - 1.0) * k_a)
    r_h, k_h, v_h, w_h, a_h = heads(r), heads(k), heads(v), heads(decay), heads(a)
    y = wkv7_scan(r_h, w_h, k_h, v_h, -kk, kk * a_h)
    mean = jnp.mean(y, axis=-1, keepdims=True)
    var = jnp.mean(jnp.square(y - mean), axis=-1, keepdims=True)
    y = ((y - mean) * lax.rsqrt(var + LNX_EPS)).reshape(B, S, RWKV_WIDTH) * lnx_g + lnx_b
    bonus = jnp.sum(r_h * k_h * r_k, axis=-1, keepdims=True) * v_h
    return (y + bonus.reshape(B, S, RWKV_WIDTH)) * g


def hybrid_layer(x, norm1_g, w_in, q_norm_g, k_norm_g, attn_out_g, rwkv_mu, w0, w2, a0, a2, g2,
                 k_k, k_a, r_k, lnx_g, lnx_b, w_out, norm2_g, w_gate, w_up, w_down):
    B, S, _ = x.shape
    xn = rms_norm(x, norm1_g).astype(x.dtype)
    proj = xn @ w_in
    q, k, v, p_rw = jnp.split(proj, [ATTN_WIDTH, 2 * ATTN_WIDTH, 3 * ATTN_WIDTH], axis=-1)
    attn = dilated_attention(q, k, v, q_norm_g, k_norm_g)
    attn = rms_norm(attn, attn_out_g.reshape(ATTN_HEADS, HEAD_DIM)).reshape(B, S, ATTN_WIDTH)
    rwkv = rwkv7_time_mix(p_rw, rwkv_mu, w0, w2, a0, a2, g2, k_k, k_a, r_k, lnx_g, lnx_b)
    mixed = jnp.concatenate([attn, rwkv], axis=-1).astype(x.dtype)
    x = x + mixed @ w_out
    xn2 = rms_norm(x, norm2_g).astype(x.dtype)
    ffn = (jax.nn.silu(xn2 @ w_gate) * (xn2 @ w_up)) @ w_down
    return x + ffn


def setup_inputs(seed: int = 0) -> dict:
    key = jax.random.key(seed)
    ks = jax.random.split(key, 24)
    L = DEPTH
    f32 = jnp.float32

    def nrm(k, shape, scale):
        return jax.random.normal(k, shape, f32) * scale

    return {
        'x': nrm(ks[0], (BATCH, SEQ, D_MODEL), 1.0),
        'norm1_g': 1.0 + nrm(ks[1], (L, D_MODEL), 0.02),
        'w_in': nrm(ks[2], (L, D_MODEL, IN_COLS), D_MODEL ** -0.5),
        'q_norm_g': 1.0 + nrm(ks[3], (L, HEAD_DIM), 0.02),
        'k_norm_g': 1.0 + nrm(ks[4], (L, HEAD_DIM), 0.02),
        'attn_out_g': 1.0 + nrm(ks[5], (L, ATTN_WIDTH), 0.02),
        'rwkv_mu': jax.random.uniform(ks[6], (L, RWKV_COLS), f32),
        'w0': jax.random.uniform(ks[7], (L, RWKV_WIDTH), f32, minval=-6.0, maxval=1.0),
        'w2': nrm(ks[8], (L, DECAY_LORA, RWKV_WIDTH), 0.5 * DECAY_LORA ** -0.5),
        'a0': nrm(ks[9], (L, RWKV_WIDTH), 0.1),
        'a2': nrm(ks[10], (L, ICLR_LORA, RWKV_WIDTH), ICLR_LORA ** -0.5),
        'g2': nrm(ks[11], (L, GATE_LORA, RWKV_WIDTH), GATE_LORA ** -0.5),
        'k_k': 0.85 + nrm(ks[12], (L, RWKV_WIDTH), 0.02),
        'k_a': 1.0 + nrm(ks[13], (L, RWKV_WIDTH), 0.02),
        'r_k': nrm(ks[14], (L, RWKV_HEADS, HEAD_DIM), 0.1),
        'lnx_g': 1.0 + nrm(ks[15], (L, RWKV_WIDTH), 0.02),
        'lnx_b': nrm(ks[16], (L, RWKV_WIDTH), 0.01),
        'w_out': nrm(ks[17], (L, MIX_WIDTH, D_MODEL), MIX_WIDTH ** -0.5),
        'norm2_g': 1.0 + nrm(ks[18], (L, D_MODEL), 0.02),
        'w_gate': nrm(ks[19], (L, D_MODEL, D_FF), D_MODEL ** -0.5),
        'w_up': nrm(ks[20], (L, D_MODEL, D_FF), D_MODEL ** -0.5),
        'w_down': nrm(ks[21], (L, D_FF, D_MODEL), D_FF ** -0.5),
    }


def reference(x, norm1_g, w_in, q_norm_g, k_norm_g, attn_out_g, rwkv_mu, w0, w2, a0, a2, g2,
              k_k, k_a, r_k, lnx_g, lnx_b, w_out, norm2_g, w_gate, w_up, w_down):
    h = x
    for layer in range(DEPTH):
        h = hybrid_layer(h, norm1_g[layer], w_in[layer], q_norm_g[layer], k_norm_g[layer],
                         attn_out_g[layer], rwkv_mu[layer], w0[layer], w2[layer], a0[layer],
                         a2[layer], g2[layer], k_k[layer], k_a[layer], r_k[layer], lnx_g[layer],
                         lnx_b[layer], w_out[layer], norm2_g[layer], w_gate[layer], w_up[layer],
                         w_down[layer])
    return h
```

```cpp
#include <hip/hip_runtime.h>
#include <cstdio>
#include <cstdint>

#ifndef MK_N_LAUNCHES
#define MK_N_LAUNCHES 1
#endif

namespace pg8 {
#define PG8_LAS __attribute__((address_space(3)))
typedef unsigned short bf16_t;
typedef short bf16x8 __attribute__((ext_vector_type(8)));
typedef float f32x4 __attribute__((ext_vector_type(4)));
typedef float f32x2 __attribute__((ext_vector_type(2)));
typedef unsigned u32x4 __attribute__((ext_vector_type(4)));
constexpr int BM = 256, BK = 64, HALF = 128, HTB = HALF * BK * 2, STAGE_BYTES = 8 * HTB, NXCD = 8, WGM = 8;

__host__ __device__ __forceinline__ int lds_byte(int r, int c) { const int st = (r >> 4) * 2 + (c >> 5), rr = r & 15, cc = c & 31, ob = rr * 64 + cc * 2; return st * 1024 + (ob ^ (((ob >> 9) & 1) << 5)); }
__host__ __device__ __forceinline__ void stage_rc(int b, int& R, int& C) { const int st = b / 1024, sb = b % 1024, swz = sb ^ (((sb >> 9) & 1) << 5); R = (st >> 1) * 16 + swz / 64; C = (st & 1) * 32 + (swz % 64) / 2; }
__host__ __device__ __forceinline__ int perm32(int rho) { const int n = rho >> 4, i = rho & 15; return 8 * (i >> 2) + 4 * n + (i & 3); }

struct Unit { int pm, pn; };
struct Gemm { const bf16_t* A; const bf16_t* Bt; int M, N, K; };

struct StaticOrder {
    int nM, nN, nwg, G, c;
    __host__ __device__ void init(int M, int N, int G_, int c_) { nM = M / BM; nN = N / BM; nwg = nM * nN; G = G_; c = c_; }
    __host__ __device__ bool next(int i, Unit& u) const {
        const long L = (long)i * G + c; if (L >= nwg) return false;
        int wgid = (int)L; { const int q = nwg / NXCD, r = nwg % NXCD, xcd = wgid % NXCD, off = wgid / NXCD; wgid = (xcd < r ? xcd * (q + 1) : r * (q + 1) + (xcd - r) * q) + off; }
        const int nig = WGM * nN, gid = wgid / nig, fm = gid * WGM, gsz = (nM - fm) < WGM ? (nM - fm) : WGM;
        u.pm = fm + ((wgid % nig) % gsz); u.pn = (wgid % nig) / gsz; return true;
    }
    __device__ __forceinline__ void a_ready(const Unit&) const {}
    __device__ __forceinline__ void done(const Unit&) const {}
};

__device__ __forceinline__ unsigned cvt_pk_bf16(float lo, float hi) { unsigned r; asm volatile("v_cvt_pk_bf16_f32 %0, %1, %2" : "=v"(r) : "v"(lo), "v"(hi)); return r; }
__device__ __forceinline__ float fsigmoid(float x) { return __builtin_amdgcn_rcpf(1.0f + __builtin_amdgcn_exp2f(-1.4426950408889634f * x)); }

struct EpiBf16 {
    static constexpr bool PERM = true, AFTER_DRAIN = false;
    bf16_t* O; int ldc;
    __device__ __forceinline__ void operator()(const f32x4 (&acc)[2][2][4][2], const Unit& u, int wr, int wc, int fr, int fq) const {
        const int row0 = u.pm * BM + wr * 64 + fr; const int col0 = u.pn * BM + wc * 32 + 8 * fq;
#pragma unroll
        for (int ai = 0; ai < 2; ++ai)
#pragma unroll
            for (int m = 0; m < 4; ++m) { bf16_t* rowp = O + (size_t)(row0 + ai * HALF + m * 16) * ldc + col0;
#pragma unroll
                for (int bj = 0; bj < 2; ++bj) { const f32x4 v0 = acc[ai][bj][m][0], v1 = acc[ai][bj][m][1];
                    u32x4 w; w.x = cvt_pk_bf16(v0[0], v0[1]); w.y = cvt_pk_bf16(v0[2], v0[3]); w.z = cvt_pk_bf16(v1[0], v1[1]); w.w = cvt_pk_bf16(v1[2], v1[3]);
                    *(u32x4*)(rowp + bj * HALF) = w; } }
    }
};
struct EpiProj {
    static constexpr bool PERM = true, AFTER_DRAIN = false;
    bf16_t* O; int ldc; const float* qg; const float* kg;
    __device__ __forceinline__ void operator()(const f32x4 (&acc)[2][2][4][2], const Unit& u, int wr, int wc, int fr, int fq) const {
        const int row0 = u.pm * BM + wr * 64 + fr;
        if (u.pn >= 4) {
            const int col0 = u.pn * BM + wc * 32 + 8 * fq;
#pragma unroll
            for (int ai = 0; ai < 2; ++ai)
#pragma unroll
                for (int m = 0; m < 4; ++m) { bf16_t* rowp = O + (size_t)(row0 + ai * HALF + m * 16) * ldc + col0;
#pragma unroll
                    for (int bj = 0; bj < 2; ++bj) { const f32x4 v0 = acc[ai][bj][m][0], v1 = acc[ai][bj][m][1];
                        u32x4 w; w.x = cvt_pk_bf16(v0[0], v0[1]); w.y = cvt_pk_bf16(v0[2], v0[3]); w.z = cvt_pk_bf16(v1[0], v1[1]); w.w = cvt_pk_bf16(v1[2], v1[3]);
                        *(u32x4*)(rowp + bj * HALF) = w; } }
        } else {
            const float* gsrc = (u.pn < 2 ? qg : kg) + 8 * fq; const float sc = u.pn < 2 ? 0.125f * 1.4426950408889634f : 1.0f;
            f32x4 g4[2][2];
#pragma unroll
            for (int bj = 0; bj < 2; ++bj)
#pragma unroll
                for (int n = 0; n < 2; ++n) g4[bj][n] = *(const f32x4*)(gsrc + 32 * bj + 4 * n) * sc;
            const int col0 = u.pn * BM + wc * 64 + 8 * fq;
#pragma unroll
            for (int ai = 0; ai < 2; ++ai)
#pragma unroll
                for (int m = 0; m < 4; ++m) {
                    float ss = 0.f;
#pragma unroll
                    for (int bj = 0; bj < 2; ++bj)
#pragma unroll
                        for (int n = 0; n < 2; ++n) { const f32x4 v = acc[ai][bj][m][n]; ss += (v[0] * v[0] + v[1] * v[1]) + (v[2] * v[2] + v[3] * v[3]); }
                    ss += __shfl_xor(ss, 16); ss += __shfl_xor(ss, 32);
                    const float rstd = 1.0f / sqrtf(ss * (1.0f / 64.0f) + 1e-6f);
                    bf16_t* rowp = O + (size_t)(row0 + ai * HALF + m * 16) * ldc + col0;
#pragma unroll
                    for (int bj = 0; bj < 2; ++bj) { const f32x4 v0 = acc[ai][bj][m][0] * g4[bj][0] * rstd, v1 = acc[ai][bj][m][1] * g4[bj][1] * rstd;
                        u32x4 w; w.x = cvt_pk_bf16(v0[0], v0[1]); w.y = cvt_pk_bf16(v0[2], v0[3]); w.z = cvt_pk_bf16(v1[0], v1[1]); w.w = cvt_pk_bf16(v1[2], v1[3]);
                        *(u32x4*)(rowp + 32 * bj) = w; }
                    __builtin_amdgcn_sched_barrier(0); }
        }
    }
};
struct EpiLora {
    static constexpr bool PERM = true, AFTER_DRAIN = false;
    bf16_t* O; int ldc; const float* w0; const float* a0;
    __device__ __forceinline__ void operator()(const f32x4 (&acc)[2][2][4][2], const Unit& u, int wr, int wc, int fr, int fq) const {
        const int row0 = u.pm * BM + wr * 64 + fr; const int col0 = u.pn * BM + wc * 32 + 8 * fq;
        const int kind = u.pn >> 1;
        const float sc = kind == 0 ? -0.6065306597126334f : (kind == 1 ? 1.0f : 0.0f), lin = kind == 2 ? 1.0f : 0.0f;
        const float* bp = kind == 0 ? w0 : a0;
        const float bs = kind == 2 ? 0.0f : 1.0f;
#pragma unroll
        for (int bj = 0; bj < 2; ++bj) {
            const int c = (col0 + bj * HALF) & 511;
            const f32x4 b0 = *(const f32x4*)(bp + c) * bs, b1 = *(const f32x4*)(bp + c + 4) * bs;
#pragma unroll
            for (int ai = 0; ai < 2; ++ai)
#pragma unroll
                for (int m = 0; m < 4; ++m) { bf16_t* rowp = O + (size_t)(row0 + ai * HALF + m * 16) * ldc + col0;
                    f32x4 v0 = acc[ai][bj][m][0] + b0, v1 = acc[ai][bj][m][1] + b1;
#pragma unroll
                    for (int e = 0; e < 4; ++e) { v0[e] = sc * fsigmoid(v0[e]) + lin * v0[e]; v1[e] = sc * fsigmoid(v1[e]) + lin * v1[e]; }
                    u32x4 w; w.x = cvt_pk_bf16(v0[0], v0[1]); w.y = cvt_pk_bf16(v0[2], v0[3]); w.z = cvt_pk_bf16(v1[0], v1[1]); w.w = cvt_pk_bf16(v1[2], v1[3]);
                    *(u32x4*)(rowp + bj * HALF) = w;
                    __builtin_amdgcn_sched_barrier(0); }
        }
    }
};
struct EpiSwiglu {
    static constexpr bool PERM = true, AFTER_DRAIN = false;
    bf16_t* H; int ldh; const float* SS;
    __device__ __forceinline__ void operator()(const f32x4 (&acc)[2][2][4][2], const Unit& u, int wr, int wc, int fr, int fq) const {
        const int row0 = u.pm * BM + wr * 64 + fr; const int col0 = u.pn * HALF + wc * 32 + 8 * fq;
#pragma unroll
        for (int ai = 0; ai < 2; ++ai)
#pragma unroll
            for (int m = 0; m < 4; ++m) { const int row = row0 + ai * HALF + m * 16; bf16_t* rowp = H + (size_t)row * ldh + col0;
                const f32x4 s4 = *(const f32x4*)(SS + (size_t)row * 4);
                const float rstd = 1.0f / sqrtf(((s4[0] + s4[1]) + (s4[2] + s4[3])) * (1.0f / 1024.0f) + 1e-6f);
                float h[8];
#pragma unroll
                for (int n = 0; n < 2; ++n)
#pragma unroll
                    for (int e = 0; e < 4; ++e) { const float g = acc[ai][0][m][n][e] * rstd, up = acc[ai][1][m][n][e] * rstd; h[4 * n + e] = g * fsigmoid(g) * up; }
                u32x4 w; w.x = cvt_pk_bf16(h[0], h[1]); w.y = cvt_pk_bf16(h[2], h[3]); w.z = cvt_pk_bf16(h[4], h[5]); w.w = cvt_pk_bf16(h[6], h[7]);
                *(u32x4*)rowp = w;
                __builtin_amdgcn_sched_barrier(0); }
    }
};
struct EpiOut {
    static constexpr bool PERM = true, AFTER_DRAIN = false;
    const float* base; float* out; bf16_t* xb; float* SS; int ldc; PG8_LAS float* scr;
    __device__ __forceinline__ void operator()(const f32x4 (&acc)[2][2][4][2], const Unit& u, int wr, int wc, int fr, int fq) const {
        const int row0 = u.pm * BM + wr * 64 + fr, col0 = u.pn * BM + wc * 32 + 8 * fq;
#pragma unroll
        for (int ai = 0; ai < 2; ++ai)
#pragma unroll
            for (int m = 0; m < 4; ++m) { const size_t off = (size_t)(row0 + ai * HALF + m * 16) * ldc + col0;
                float ss = 0.f;
#pragma unroll
                for (int bj = 0; bj < 2; ++bj) {
                    const f32x4 o0 = *(const f32x4*)(base + off + bj * HALF) + acc[ai][bj][m][0], o1 = *(const f32x4*)(base + off + bj * HALF + 4) + acc[ai][bj][m][1];
                    *(f32x4*)(out + off + bj * HALF) = o0; *(f32x4*)(out + off + bj * HALF + 4) = o1;
                    u32x4 w; w.x = cvt_pk_bf16(o0[0], o0[1]); w.y = cvt_pk_bf16(o0[2], o0[3]); w.z = cvt_pk_bf16(o1[0], o1[1]); w.w = cvt_pk_bf16(o1[2], o1[3]);
                    *(u32x4*)(xb + off + bj * HALF) = w;
                    ss += ((o0[0] * o0[0] + o0[1] * o0[1]) + (o0[2] * o0[2] + o0[3] * o0[3])) + ((o1[0] * o1[0] + o1[1] * o1[1]) + (o1[2] * o1[2] + o1[3] * o1[3])); }
                ss += __shfl_xor(ss, 16); ss += __shfl_xor(ss, 32);
                if (fq == 0) scr[((((wr * 2 + ai) * 4 + m) * 16) + fr) * 4 + wc] = ss;
                asm volatile("" ::: "memory"); }
        asm volatile("s_waitcnt lgkmcnt(0)" ::: "memory"); __builtin_amdgcn_s_barrier(); asm volatile("" ::: "memory");
        const int tid = threadIdx.x;
        if (tid < 256) { const f32x4 s4 = *(const PG8_LAS f32x4*)(scr + tid * 4);
            const int row = u.pm * BM + ((tid >> 6) & 1) * HALF + (tid >> 7) * 64 + ((tid >> 4) & 3) * 16 + (tid & 15);
            SS[(size_t)row * 4 + u.pn] = (s4[0] + s4[1]) + (s4[2] + s4[3]); }
    }
};
struct EpiResF32 {
    static constexpr bool PERM = false, AFTER_DRAIN = false;
    const float* base; float* out; int ldc;
    __device__ __forceinline__ void operator()(const f32x4 (&acc)[2][2][4][2], const Unit& u, int wr, int wc, int fr, int fq) const {
        const int row0 = u.pm * BM + wr * 64 + fr, col0 = u.pn * BM + wc * 32 + 4 * fq;
#pragma unroll
        for (int ai = 0; ai < 2; ++ai)
#pragma unroll
            for (int m = 0; m < 4; ++m) { const size_t off = (size_t)(row0 + ai * HALF + m * 16) * ldc + col0;
#pragma unroll
                for (int bj = 0; bj < 2; ++bj)
#pragma unroll
                    for (int n = 0; n < 2; ++n) { const f32x4 b = *(const f32x4*)(base + off + bj * HALF + n * 16); *(f32x4*)(out + off + bj * HALF + n * 16) = b + acc[ai][bj][m][n]; }
                if (m & 1) asm volatile("" ::: "memory"); }
    }
};

template <class Epi, class Sched, bool ALIGN_EPI = false, bool SP2 = false>
__device__ __forceinline__ void gemm_phase(PG8_LAS unsigned char* lds, const Gemm g, const Sched& S, const Epi& E) {
    const int tid = threadIdx.x, wid = __builtin_amdgcn_readfirstlane(tid >> 6), lane = tid & 63, wr = wid >> 2, wc = wid & 3, fr = lane & 15, fq = lane >> 4;
    const int K = g.K, nt = K / BK;
    unsigned voffA[2], voffB[2];
#pragma unroll
    for (int i = 0; i < 2; ++i) { int R, C; stage_rc(tid * 16 + i * 8192, R, C); const int Rb = Epi::PERM ? ((R & ~31) + perm32(R & 31)) : R;
        voffA[i] = (unsigned)(R * K + C) * 2u; voffB[i] = (unsigned)(Rb * K + C) * 2u; }
    const size_t kstep = (size_t)(BK * 2);
    const size_t hstep = (size_t)HALF * K * 2;
    const size_t tstep = 2 * hstep;
    const unsigned ldsw = (unsigned)wid * 1024u;
    const int aoff = lds_byte(wr * 64 + fr, fq * 8), boff = lds_byte(wc * 32 + fr, fq * 8);
#define PG8_SA(b, h) (((b) * 2 + (h)) * HTB)
#define PG8_SB(b, h) ((4 + (b) * 2 + (h)) * HTB)
#define PG8_STAGE(bufoff, gbase, voff) do { _Pragma("unroll") for (int _i = 0; _i < 2; ++_i) \
        __builtin_amdgcn_global_load_lds((const unsigned*)((const char*)(gbase) + (voff)[_i]), (PG8_LAS unsigned*)(lds + (bufoff) + ldsw + _i * 8192), 16, 0, 0); } while (0)
#define PG8_LDA(dst, b, h) do { _Pragma("unroll") for (int m = 0; m < 4; ++m) _Pragma("unroll") for (int k = 0; k < 2; ++k) dst[m][k] = *(const PG8_LAS bf16x8*)(lds + PG8_SA(b, h) + aoff + m * 2048 + k * 1024); } while (0)
#define PG8_LDB(dst, b, h) do { _Pragma("unroll") for (int n = 0; n < 2; ++n) _Pragma("unroll") for (int k = 0; k < 2; ++k) dst[n][k] = *(const PG8_LAS bf16x8*)(lds + PG8_SB(b, h) + boff + n * 2048 + k * 1024); } while (0)
#define PG8_MMA(ai, bj, At, Bt) do { __builtin_amdgcn_s_setprio(1); _Pragma("unroll") for (int m = 0; m < 4; ++m) _Pragma("unroll") for (int n = 0; n < 2; ++n) _Pragma("unroll") for (int k = 0; k < 2; ++k) \
        acc[ai][bj][m][n] = __builtin_amdgcn_mfma_f32_16x16x32_bf16(Bt[n][k], At[m][k], acc[ai][bj][m][n], 0, 0, 0); __builtin_amdgcn_s_setprio(0); } while (0)
#define PG8_WAIT_V(n) asm volatile("s_waitcnt vmcnt(" #n ")" ::: "memory")
#define PG8_WAIT_L(n) asm volatile("s_waitcnt lgkmcnt(" #n ")" ::: "memory")
#define PG8_BAR __builtin_amdgcn_s_barrier()
#define PG8_SCHED __builtin_amdgcn_sched_barrier(0)
    Unit cur, nxt; int ui = 0;
    if (!S.next(0, cur)) return;
    f32x4 acc[2][2][4][2];
#pragma unroll
    for (int a = 0; a < 2; ++a)
#pragma unroll
        for (int b = 0; b < 2; ++b)
#pragma unroll
            for (int m = 0; m < 4; ++m)
#pragma unroll
                for (int n = 0; n < 2; ++n) acc[a][b][m][n] = (f32x4){0.f, 0.f, 0.f, 0.f};
    bf16x8 At[4][2], B0[2][2], B1[2][2];
    const char* cA = (const char*)g.A + (size_t)cur.pm * tstep; const char* cB = (const char*)g.Bt + (size_t)cur.pn * tstep;
    S.a_ready(cur);
    if constexpr (SP2) {
        PG8_STAGE(PG8_SB(0, 0), cB, voffB); PG8_STAGE(PG8_SB(0, 1), cB + hstep, voffB); PG8_STAGE(PG8_SA(0, 0), cA, voffA); PG8_STAGE(PG8_SA(0, 1), cA + hstep, voffA);
        if (wr == 1) PG8_BAR;
        PG8_WAIT_V(2); PG8_BAR;
        PG8_STAGE(PG8_SB(1, 0), cB + kstep, voffB); PG8_STAGE(PG8_SA(1, 0), cA + kstep, voffA); PG8_STAGE(PG8_SB(1, 1), cB + hstep + kstep, voffB);
        PG8_WAIT_V(6); PG8_BAR;
    } else {
        PG8_STAGE(PG8_SB(0, 0), cB, voffB); PG8_STAGE(PG8_SA(0, 0), cA, voffA); PG8_STAGE(PG8_SB(0, 1), cB + hstep, voffB); PG8_STAGE(PG8_SA(0, 1), cA + hstep, voffA);
        if (wr == 1) PG8_BAR;
        PG8_WAIT_V(4); PG8_BAR;
        PG8_STAGE(PG8_SB(1, 0), cB + kstep, voffB); PG8_STAGE(PG8_SA(1, 0), cA + kstep, voffA); PG8_STAGE(PG8_SB(1, 1), cB + hstep + kstep, voffB);
        PG8_WAIT_V(6); PG8_BAR;
    }
    for (;;) {
        const bool has_next = S.next(ui + 1, nxt);
        const char* nA = has_next ? (const char*)g.A + (size_t)nxt.pm * tstep : cA; const char* nB = has_next ? (const char*)g.Bt + (size_t)nxt.pn * tstep : cB;
#pragma nounroll
        for (int t = 0; t < nt; t += 2) {
            const bool last = (t == nt - 2);
            const char* a1 = cA + (size_t)(t + 1) * kstep;
            const char* a2 = last ? nA : cA + (size_t)(t + 2) * kstep; const char* b2 = last ? nB : cB + (size_t)(t + 2) * kstep;
            const char* a3 = a2 + kstep; const char* b3 = b2 + kstep;
            if (last && has_next) S.a_ready(nxt);
            if constexpr (SP2) {
            PG8_LDB(B0, 0, 0); PG8_LDB(B1, 0, 1); PG8_SCHED; PG8_LDA(At, 0, 0); PG8_STAGE(PG8_SA(1, 1), a1 + hstep, voffA);
            PG8_WAIT_V(8); PG8_WAIT_L(0); PG8_BAR; PG8_MMA(0, 0, At, B0); PG8_MMA(0, 1, At, B1); PG8_BAR; PG8_SCHED;
            PG8_LDA(At, 0, 1); PG8_STAGE(PG8_SB(0, 0), b2, voffB); PG8_STAGE(PG8_SB(0, 1), b2 + hstep, voffB); PG8_STAGE(PG8_SA(0, 0), a2, voffA);
            PG8_WAIT_V(8); PG8_WAIT_L(0); PG8_BAR; PG8_MMA(1, 0, At, B0); PG8_MMA(1, 1, At, B1); PG8_BAR; PG8_SCHED;
            PG8_LDB(B0, 1, 0); PG8_LDB(B1, 1, 1); PG8_SCHED; PG8_LDA(At, 1, 0); PG8_STAGE(PG8_SA(0, 1), a2 + hstep, voffA);
            PG8_WAIT_V(8); PG8_WAIT_L(0); PG8_BAR; PG8_MMA(0, 0, At, B0); PG8_MMA(0, 1, At, B1); PG8_BAR; PG8_SCHED;
            PG8_LDA(At, 1, 1); PG8_STAGE(PG8_SB(1, 0), b3, voffB); PG8_STAGE(PG8_SB(1, 1), b3 + hstep, voffB); PG8_STAGE(PG8_SA(1, 0), a3, voffA);
            PG8_WAIT_V(8); PG8_WAIT_L(0); PG8_BAR; PG8_MMA(1, 0, At, B0); PG8_MMA(1, 1, At, B1); PG8_BAR; PG8_SCHED;
            } else {
            PG8_LDB(B0, 0, 0); PG8_SCHED; PG8_LDA(At, 0, 0); PG8_STAGE(PG8_SA(1, 1), a1 + hstep, voffA);
            PG8_WAIT_L(8); PG8_BAR; PG8_WAIT_L(0); PG8_MMA(0, 0, At, B0); PG8_BAR; PG8_SCHED;
            PG8_LDB(B1, 0, 1); PG8_STAGE(PG8_SB(0, 0), b2, voffB);
            PG8_BAR; PG8_WAIT_L(0); PG8_MMA(0, 1, At, B1); PG8_BAR;
            PG8_LDA(At, 0, 1); PG8_STAGE(PG8_SA(0, 0), a2, voffA);
            PG8_BAR; PG8_WAIT_L(0); PG8_MMA(1, 0, At, B0); PG8_BAR; PG8_SCHED;
            PG8_STAGE(PG8_SB(0, 1), b2 + hstep, voffB);
            PG8_WAIT_V(6); PG8_BAR; PG8_MMA(1, 1, At, B1); PG8_BAR;
            PG8_LDB(B0, 1, 0); PG8_SCHED; PG8_LDA(At, 1, 0); PG8_STAGE(PG8_SA(0, 1), a2 + hstep, voffA);
            PG8_WAIT_L(8); PG8_BAR; PG8_WAIT_L(0); PG8_MMA(0, 0, At, B0); PG8_BAR; PG8_SCHED;
            PG8_LDB(B1, 1, 1); PG8_STAGE(PG8_SB(1, 0), b3, voffB);
            PG8_BAR; PG8_WAIT_L(0); PG8_MMA(0, 1, At, B1); PG8_BAR;
            PG8_LDA(At, 1, 1); PG8_STAGE(PG8_SA(1, 0), a3, voffA);
            PG8_BAR; PG8_WAIT_L(0); PG8_MMA(1, 0, At, B0); PG8_BAR; PG8_SCHED;
            PG8_STAGE(PG8_SB(1, 1), b3 + hstep, voffB);
            PG8_WAIT_V(6); PG8_BAR; PG8_MMA(1, 1, At, B1); PG8_BAR;
            }
        }
        if constexpr (ALIGN_EPI) { if (wr == 0) PG8_BAR; }
        if constexpr (!Epi::AFTER_DRAIN) { E(acc, cur, wr, wc, fr, fq); S.done(cur); }
        if (!has_next) break;
#pragma unroll
        for (int a = 0; a < 2; ++a)
#pragma unroll
            for (int b = 0; b < 2; ++b)
#pragma unroll
                for (int m = 0; m < 4; ++m)
#pragma unroll
                    for (int n = 0; n < 2; ++n) acc[a][b][m][n] = (f32x4){0.f, 0.f, 0.f, 0.f};
        cur = nxt; cA = nA; cB = nB; ++ui;
        if constexpr (ALIGN_EPI) { if (wr == 1) PG8_BAR; }
    }
    PG8_WAIT_V(0);
    if constexpr (!ALIGN_EPI) { if (wr == 0) PG8_BAR; }
    PG8_BAR;
#undef PG8_SA
#undef PG8_SB
#undef PG8_STAGE
#undef PG8_LDA
#undef PG8_LDB
#undef PG8_MMA
#undef PG8_WAIT_V
#undef PG8_WAIT_L
#undef PG8_BAR
#undef PG8_SCHED
}
}

constexpr int NWAVES = 8;
constexpr int N_LAUNCHES = MK_N_LAUNCHES;
constexpr int PER_PHASE = 10;
constexpr int BATCH = 16, SEQ = 2048, D = 1024, M = BATCH * SEQ;
constexpr int NH = 8, HD = 64, AW = 512, RW = 512;
constexpr int RWKV_COLS = 1792, IN_COLS = 3328, FF = 2816, NGU = 2 * FF, NLORA = 1536, KLORA = 256;
constexpr int PC_Q = 0, PC_K = 512, PC_V = 1024, PC_RW = 1536;
constexpr int RC_R = 0, RC_K = 512, RC_V = 1024, RC_L = 1536;
constexpr float NORM_EPS = 1e-6f, LNX_EPS = 64e-5f;
constexpr float LOG2E = 1.4426950408889634f;

constexpr size_t MiB = 1u << 20;
constexpr size_t WS_CTL = 0, CTL_ZERO_BYTES = 1 * MiB;
constexpr size_t WS_WIN = 2 * MiB;
constexpr size_t WS_WOUT = 9 * MiB;
constexpr size_t WS_WGU = 11 * MiB;
constexpr size_t WS_WDN = 22 * MiB;
constexpr size_t WS_WL = 28 * MiB;
constexpr size_t WS_BON = 29 * MiB;
constexpr size_t WS_SS = 30 * MiB;
constexpr size_t WS_XN = 32 * MiB;
constexpr size_t WS_PROJ = 96 * MiB;
constexpr size_t WS_A2 = 304 * MiB;
constexpr size_t WS_DAG = 320 * MiB;
constexpr size_t WS_ML = 416 * MiB;
constexpr size_t WS_END = 424 * MiB;
constexpr size_t DO_PO = 0, DO_Y = 96 * MiB;
constexpr int CW_TMO = 0, CW_CODE = 1;
constexpr int CW_BAR = 4096;
constexpr int CW_ATTQ = 8192;

constexpr int LDS_BYTES = 147456;
constexpr int RING_OFF = 0, RING_BYTES = LDS_BYTES - 1024;
constexpr int LDSCTL_OFF = RING_BYTES, MISC_OFF = LDSCTL_OFF + 320;

#define GAS __attribute__((address_space(1)))
#define LAS __attribute__((address_space(3)))
typedef unsigned short bf16;
typedef unsigned v4u __attribute__((ext_vector_type(4)));
typedef unsigned v2u __attribute__((ext_vector_type(2)));
typedef float f32x4 __attribute__((ext_vector_type(4)));
typedef float f32x2 __attribute__((ext_vector_type(2)));
typedef float f32x16 __attribute__((ext_vector_type(16)));
typedef short bf16x8 __attribute__((ext_vector_type(8)));
typedef short s16x4 __attribute__((ext_vector_type(4)));
typedef GAS unsigned gu32;
#define RLX_AGENT __ATOMIC_RELAXED, __HIP_MEMORY_SCOPE_AGENT
#define LDS_WAIT() asm volatile("s_waitcnt lgkmcnt(0)" ::: "memory")
#define VM_WAIT() asm volatile("s_waitcnt vmcnt(0)" ::: "memory")
__device__ __forceinline__ unsigned f2bf(float f) { unsigned u = __builtin_bit_cast(unsigned, f); return (u + 0x7fffu + ((u >> 16) & 1u)) >> 16; }
__device__ __forceinline__ unsigned pk2(float lo, float hi) { return f2bf(lo) | (f2bf(hi) << 16); }
__device__ __forceinline__ float bflo(unsigned w) { return __builtin_bit_cast(float, w << 16); }
__device__ __forceinline__ float bfhi(unsigned w) { return __builtin_bit_cast(float, w & 0xffff0000u); }
__device__ __forceinline__ float fsig(float x) { return __builtin_amdgcn_rcpf(1.0f + __builtin_amdgcn_exp2f(-LOG2E * x)); }

#define XB_TMO      128
#define XB_XCNT(j)  (256  + 64 * (j))
#define XB_XSUB(j)  (1280 + 64 * (j))
#define XB_XGEN(j)  (2304 + 64 * (j))
#define XB_TOP      3328
#define XB_TOPGEN   3392
#define XCD_BAR_WORDS 3456
#define XB_SPIN_CAP (1u << 18)
__device__ __forceinline__ unsigned xb_ld(unsigned* p)              { return __hip_atomic_load(p, __ATOMIC_RELAXED, __HIP_MEMORY_SCOPE_AGENT); }
__device__ __forceinline__ unsigned xb_add(unsigned* p, unsigned v) { return __hip_atomic_fetch_add(p, v, __ATOMIC_RELAXED, __HIP_MEMORY_SCOPE_AGENT); }
__device__ __forceinline__ unsigned xb_xcc_id() { return (unsigned)__builtin_amdgcn_s_getreg((3 << 11) | 20) & 0xFu; }
#define XB_SPIN(cond, bar) do { unsigned _sp = 0; while (cond) { __builtin_amdgcn_s_sleep(1); \
    if ((++_sp & 255u) == 0u) { if (xb_ld(&(bar)[XB_TMO])) break; if (_sp > XB_SPIN_CAP) { atomicAdd(&(bar)[XB_TMO], 1u); break; } } } } while (0)
struct XcdBarrier { unsigned* bar; unsigned x; volatile LAS unsigned* st; };
__device__ __forceinline__ XcdBarrier xcd_barrier_post(unsigned* bar, volatile LAS unsigned* st) {
    XcdBarrier b; b.bar = bar; b.x = xb_xcc_id(); b.st = st;
    if (threadIdx.x == 0) (void)xb_add(&bar[XB_XCNT(b.x)], 1u);
    return b;
}
__device__ __forceinline__ void xcd_barrier_complete(unsigned* bar, unsigned x, unsigned& nloc, unsigned& nx) {
    const unsigned G = gridDim.x * gridDim.y * gridDim.z;
    unsigned sum, cnt, mine, sp = 0u;
    for (;;) {
        sum = 0u; cnt = 0u; mine = 0u;
#pragma unroll
        for (unsigned j = 0; j < 16; ++j) { const unsigned c = xb_ld(&bar[XB_XCNT(j)]); sum += c; cnt += (c > 0u) ? 1u : 0u; mine = (j == x) ? c : mine; }
        if (sum == G) break;
        __builtin_amdgcn_s_sleep(1);
        if ((++sp & 255u) == 0u) { if (xb_ld(&bar[XB_TMO])) break; if (sp > XB_SPIN_CAP) { atomicAdd(&bar[XB_TMO], 1u); break; } }
    }
    nloc = mine > 0u ? mine : 1u; nx = cnt > 0u ? cnt : 1u;
}
__device__ __forceinline__ void xcd_barrier(const XcdBarrier& b) {
    asm volatile("s_waitcnt vmcnt(0)" ::: "memory");
    __syncthreads();
    if (threadIdx.x == 0) {
        unsigned* bar = b.bar;
        __builtin_amdgcn_s_waitcnt(0);
        unsigned nloc = b.st[0], nx = b.st[1];
        if (nloc == 0u) { xcd_barrier_complete(bar, b.x, nloc, nx); b.st[0] = nloc; b.st[1] = nx; }
        const unsigned old = xb_add(&bar[XB_XSUB(b.x)], 1u);
        const unsigned gen = old / nloc;
        if (old + 1u == (gen + 1u) * nloc) {
            __builtin_amdgcn_fence(__ATOMIC_RELEASE, "agent");
            asm volatile("s_waitcnt vmcnt(0)" ::: "memory");
            const unsigned og = xb_add(&bar[XB_TOP], 1u);
            const unsigned tg = og / nx;
            if (og + 1u == (tg + 1u) * nx) xb_add(&bar[XB_TOPGEN], 1u);
            else XB_SPIN(xb_ld(&bar[XB_TOPGEN]) == tg, bar);
            __builtin_amdgcn_fence(__ATOMIC_ACQUIRE, "agent");
            xb_add(&bar[XB_XGEN(b.x)], 1u);
            asm volatile("s_waitcnt vmcnt(0)" ::: "memory");
        } else {
            XB_SPIN(xb_ld(&bar[XB_XGEN(b.x)]) == gen, bar);
            __builtin_amdgcn_fence(__ATOMIC_ACQUIRE, "agent");
            asm volatile("s_waitcnt vmcnt(0)" ::: "memory");
        }
    }
    __syncthreads();
}

struct Frame {
    LAS unsigned char* lds;
    volatile LAS unsigned* MISC;
    gu32* ctl;
    int tid, lane, wave;
    int vcu, G;
    float* out; unsigned char* ws;
};
struct Args { const float* in[22]; float* out; unsigned char* ws; int ph_lo, ph_hi, li, pad; };
enum { I_X = 0, I_N1G, I_WIN, I_QNG, I_KNG, I_AOG, I_MU, I_W0, I_W2, I_A0, I_A2, I_G2, I_KK, I_KA, I_RK, I_LNG, I_LNB, I_WOUT, I_N2G, I_WG, I_WU, I_WD };

__device__ __forceinline__ float wave_sum(float v) {
#pragma unroll
    for (int o = 1; o < 64; o <<= 1) v += __shfl_xor(v, o);
    return v;
}
__device__ __forceinline__ float red16(float x) {
    x += __builtin_bit_cast(float, __builtin_amdgcn_update_dpp(0, __builtin_bit_cast(int, x), 0x128, 0xf, 0xf, false));
    x += __builtin_bit_cast(float, __builtin_amdgcn_update_dpp(0, __builtin_bit_cast(int, x), 0x124, 0xf, 0xf, false));
    x += __builtin_bit_cast(float, __builtin_amdgcn_update_dpp(0, __builtin_bit_cast(int, x), 0x122, 0xf, 0xf, false));
    x += __builtin_bit_cast(float, __builtin_amdgcn_update_dpp(0, __builtin_bit_cast(int, x), 0x121, 0xf, 0xf, false));
    return x;
}

__device__ __forceinline__ void p0_transpose_item(const float* W, int K, int N, bf16* WT, int rmode, LAS float* scr, int item, int lane, const float* ksc = nullptr) {
    const int nblk = N / 32, kb = item / nblk, nb = item % nblk, k0 = 64 * kb, n0 = 32 * nb;
    const int rbase = rmode == 0 ? n0 : rmode == 3 ? (n0 < 1024 ? ((n0 >> 8) * 256 + ((n0 >> 5) & 1) * 128 + ((n0 >> 6) & 3) * 32) : n0) : ((n0 >> 7) * 256 + (n0 & 127) + (rmode == 2 ? 128 : 0));
#pragma unroll 8
    for (int i = 0; i < 32; ++i) { const int kk = 2 * i + (lane >> 5); scr[kk * 33 + (lane & 31)] = W[(size_t)(k0 + kk) * N + n0 + (lane & 31)] * (ksc ? ksc[k0 + kk] : 1.0f); }
    LDS_WAIT(); asm volatile("" ::: "memory");
    const int c = lane & 7;
#pragma unroll
    for (int j = 0; j < 4; ++j) { const int n = (lane >> 3) + 8 * j; const LAS float* s = scr + (8 * c) * 33 + n;
        v4u o; o.x = pk2(s[0 * 33], s[1 * 33]); o.y = pk2(s[2 * 33], s[3 * 33]); o.z = pk2(s[4 * 33], s[5 * 33]); o.w = pk2(s[6 * 33], s[7 * 33]);
        *(GAS v4u*)(WT + (size_t)(rbase + n) * K + k0 + 8 * c) = o; }
    LDS_WAIT(); asm volatile("" ::: "memory");
}
__device__ __forceinline__ void rms_row_to_bf16(int lane, const float* xrow, const float* g, bf16* orow) {
    const GAS f32x4* xr = (const GAS f32x4*)xrow + lane;
    const GAS f32x4* gr = (const GAS f32x4*)g + lane;
    f32x4 v[4]; float s = 0.f;
#pragma unroll
    for (int j = 0; j < 4; ++j) { v[j] = xr[64 * j]; s += (v[j].x * v[j].x + v[j].y * v[j].y) + (v[j].z * v[j].z + v[j].w * v[j].w); }
    const float rstd = 1.f / sqrtf(wave_sum(s) * (1.f / D) + NORM_EPS);
    GAS unsigned long long* o8 = (GAS unsigned long long*)orow + lane;
#pragma unroll
    for (int j = 0; j < 4; ++j) { const f32x4 gg = gr[64 * j];
        o8[64 * j] = (unsigned long long)pk2(v[j].x * rstd * gg.x, v[j].y * rstd * gg.y) | ((unsigned long long)pk2(v[j].z * rstd * gg.z, v[j].w * rstd * gg.w) << 32); }
}

__device__ __forceinline__ void p0_prologue(Frame& F, const Args& AR) {
    LAS float* scr = (LAS float*)(F.lds + RING_OFF + F.wave * 16384);
    const int gw = F.vcu * NWAVES + F.wave, NGW = F.G * NWAVES;
    bf16* Win_t = (bf16*)(F.ws + WS_WIN); bf16* Wout_t = (bf16*)(F.ws + WS_WOUT); bf16* Wgu_t = (bf16*)(F.ws + WS_WGU); bf16* Wdn_t = (bf16*)(F.ws + WS_WDN); bf16* Wl_t = (bf16*)(F.ws + WS_WL);
    constexpr int I_IN = (D / 64) * (IN_COLS / 32), I_OUT = (D / 64) * (D / 32), I_G = (D / 64) * (FF / 32), I_DN = (FF / 64) * (D / 32);
    constexpr int NITEMS = I_IN + I_OUT + 2 * I_G + I_DN;
    for (int it = gw; it < NITEMS; it += NGW) {
        int r = it;
        if (r < I_IN) { p0_transpose_item(AR.in[I_WIN], D, IN_COLS, Win_t, 3, scr, r, F.lane); continue; } r -= I_IN;
        if (r < I_OUT) { p0_transpose_item(AR.in[I_WOUT], D, D, Wout_t, 0, scr, r, F.lane); continue; } r -= I_OUT;
        if (r < I_G) { p0_transpose_item(AR.in[I_WG], D, FF, Wgu_t, 1, scr, r, F.lane, AR.in[I_N2G]); continue; } r -= I_G;
        if (r < I_G) { p0_transpose_item(AR.in[I_WU], D, FF, Wgu_t, 2, scr, r, F.lane, AR.in[I_N2G]); continue; } r -= I_G;
        p0_transpose_item(AR.in[I_WD], FF, D, Wdn_t, 0, scr, r, F.lane);
    }
    for (int e = (F.vcu * NWAVES * 64 + F.tid); e < NLORA * KLORA; e += F.G * NWAVES * 64) {
        const int row = e / KLORA, k = e % KLORA, kind = row >> 9, c = row & 511; float v = 0.f;
        if (kind == 0) { if (k < 64) v = AR.in[I_W2][k * 512 + c]; }
        else if (kind == 1) { if (k >= 64 && k < 128) v = AR.in[I_A2][(k - 64) * 512 + c]; }
        else { if (k >= 128) v = AR.in[I_G2][(k - 128) * 512 + c]; }
        Wl_t[e] = (bf16)f2bf(v);
    }
    bf16* XN = (bf16*)(F.ws + WS_XN);
    for (int m = gw; m < M; m += NGW) rms_row_to_bf16(F.lane, AR.in[I_X] + (size_t)m * D, AR.in[I_N1G], XN + (size_t)m * D);
}

__device__ __forceinline__ void p2_prep(Frame& F, const Args& AR) {
    const int gw = F.vcu * NWAVES + F.wave, NGW = F.G * NWAVES, lane = F.lane;
    const bf16* PROJ = (const bf16*)(F.ws + WS_PROJ); bf16* A2 = (bf16*)(F.ws + WS_A2);
    const f32x4 mu4 = *(const f32x4*)(AR.in[I_MU] + RC_L + 4 * lane);
    for (int m = gw; m < M; m += NGW) {
        const bf16* row = PROJ + (size_t)m * IN_COLS;
        const v2u cu = *(const v2u*)(row + PC_RW + RC_L + 4 * lane);
        v2u pv = (v2u){0u, 0u};
        if ((m & (SEQ - 1)) != 0) pv = *(const v2u*)(row - IN_COLS + PC_RW + RC_L + 4 * lane);
        float c4[4] = {bflo(cu.x), bfhi(cu.x), bflo(cu.y), bfhi(cu.y)}, p4[4] = {bflo(pv.x), bfhi(pv.x), bflo(pv.y), bfhi(pv.y)};
        float xs[4];
#pragma unroll
        for (int i = 0; i < 4; ++i) { const float v = c4[i] + (p4[i] - c4[i]) * mu4[i];
            if (lane < 16) { const float t = __builtin_amdgcn_exp2f(2.f * LOG2E * v); xs[i] = 1.f - 2.f * __builtin_amdgcn_rcpf(t + 1.f); }
            else if (lane < 32) xs[i] = v;
            else xs[i] = fsig(v); }
        *(v2u*)(A2 + (size_t)m * KLORA + 4 * lane) = (v2u){pk2(xs[0], xs[1]), pk2(xs[2], xs[3])};
    }
}

constexpr int CS = 16, NCHUNK = SEQ / CS, NHELP = 4, NSTATE = 4, NIT = (NCHUNK + NHELP - 1) / NHELP;
constexpr int SL_A = 0, SL_R = 2048, SL_B = 4096, SL_K = 6144, SL_V = 8192, SL_T = 10240, SL_LAK = 10752, SL_LRB = 11264, SL_LRK = 11776, SL_G = 12288, SL_BYTES = 12544;
constexpr int SC_CONST = 2 * NHELP * SL_BYTES;
constexpr int SC_YL = SC_CONST + 6 * 64 * 4, YL_BYTES = NHELP * CS * 64 * 2;
static_assert(SC_YL + 2 * YL_BYTES <= RING_BYTES && NHELP * CS * 8 == NWAVES * 64, "scan LDS");
struct HReg { v4u r[2], k[2], v[2], pr[2], pk[2], pv[2], e[2], a[2]; };
__device__ __forceinline__ void helper_load(HReg& R, const bf16* PROJ, const bf16* DAG, int tok, int h, int kg) {
    const GAS bf16* row = (const GAS bf16*)PROJ + (size_t)tok * IN_COLS + PC_RW + h * 64 + 16 * kg;
    const GAS bf16* rowp = row - IN_COLS;
    const GAS bf16* dr = (const GAS bf16*)DAG + (size_t)tok * NLORA + h * 64 + 16 * kg;
    asm volatile("" : "+v"(row)); asm volatile("" : "+v"(rowp)); asm volatile("" : "+v"(dr));
    const bool hp = (tok & (SEQ - 1)) != 0;
#pragma unroll
    for (int i = 0; i < 2; ++i) {
        R.r[i] = *(const GAS v4u*)(row + RC_R + 8 * i); R.k[i] = *(const GAS v4u*)(row + RC_K + 8 * i); R.v[i] = *(const GAS v4u*)(row + RC_V + 8 * i);
        if (hp) { R.pr[i] = *(const GAS v4u*)(rowp + RC_R + 8 * i); R.pk[i] = *(const GAS v4u*)(rowp + RC_K + 8 * i); R.pv[i] = *(const GAS v4u*)(rowp + RC_V + 8 * i); }
        else { R.pr[i] = (v4u){0u, 0u, 0u, 0u}; R.pk[i] = R.pr[i]; R.pv[i] = R.pr[i]; }
        R.e[i] = *(const GAS v4u*)(dr + 8 * i); R.a[i] = *(const GAS v4u*)(dr + 512 + 8 * i);
    }
}
__device__ __forceinline__ void unpack4(const unsigned w0, const unsigned w1, float (&x)[4]) { x[0] = bflo(w0); x[1] = bfhi(w0); x[2] = bflo(w1); x[3] = bfhi(w1); }
__device__ __forceinline__ float dpp_shr(float x, const int ctrl_sel) {
    int r;
    if (ctrl_sel == 1) r = __builtin_amdgcn_update_dpp(0, __builtin_bit_cast(int, x), 0x111, 0xf, 0xf, true);
    else if (ctrl_sel == 2) r = __builtin_amdgcn_update_dpp(0, __builtin_bit_cast(int, x), 0x112, 0xf, 0xf, true);
    else if (ctrl_sel == 4) r = __builtin_amdgcn_update_dpp(0, __builtin_bit_cast(int, x), 0x114, 0xf, 0xf, true);
    else r = __builtin_amdgcn_update_dpp(0, __builtin_bit_cast(int, x), 0x118, 0xf, 0xf, true);
    return __builtin_bit_cast(float, r);
}
typedef float f32x2_t __attribute__((ext_vector_type(2))); typedef __bf16 bf16x2_t __attribute__((ext_vector_type(2)));
__device__ __forceinline__ unsigned cvt2(float lo, float hi) { f32x2_t v = {lo, hi}; bf16x2_t b = __builtin_convertvector(v, bf16x2_t); return __builtin_bit_cast(unsigned, b); }
__device__ __forceinline__ bf16x8 mk8(unsigned a, unsigned b, unsigned c, unsigned d) { return __builtin_bit_cast(bf16x8, (v4u){a, b, c, d}); }
__device__ __forceinline__ bf16x8 accB(const f32x4 v) { return mk8(cvt2(v[0], v[1]), cvt2(v[2], v[3]), 0u, 0u); }
__device__ __forceinline__ v2u trd(const LAS unsigned char* p) { typedef short v4i16_t __attribute__((ext_vector_type(4)));
    return __builtin_bit_cast(v2u, __builtin_amdgcn_ds_read_tr16_b64_v4i16((LAS v4i16_t*)p)); }
#define MFMA16(a, b, c) __builtin_amdgcn_mfma_f32_16x16x32_bf16((a), (b), (c), 0, 0, 0)
#define PIN_PTR(p) asm volatile("" : "+v"(p))

#define HR_UNPACK(dst, arr, gp) do { if ((gp) & 1) unpack4(R.arr[(gp) >> 1].z, R.arr[(gp) >> 1].w, dst); else unpack4(R.arr[(gp) >> 1].x, R.arr[(gp) >> 1].y, dst); } while (0)
__device__ __forceinline__ void helper_chunk(LAS unsigned char* slot, const LAS float* cst, HReg& R, bool prefetch, const bf16* PROJ, const bf16* DAG, float* BON, int tok, int h, int lane) {
    const int t = lane & 15, kg = lane >> 4;
    LAS unsigned char* p_row = slot + t * 128 + kg * 16;
    LAS unsigned char* p_v = slot + SL_V + t * 128 + kg * 32;
    LAS unsigned char* p_tw = slot + t * 32 + kg * 8;
    const LAS unsigned char* p_tr = slot + (4 * kg + ((lane & 15) >> 2)) * 32 + (lane & 3) * 8;
    LAS unsigned char* p_g = slot + SL_G + kg * 16;
    const LAS float* p_c = cst + 16 * kg;
    PIN_PTR(p_row); PIN_PTR(p_v); PIN_PTR(p_tw); PIN_PTR(p_tr); PIN_PTR(p_g); PIN_PTR(p_c);
    float ss = 0.f;
#pragma unroll
    for (int gp = 0; gp < 4; ++gp) {
        float k[4], pk[4]; HR_UNPACK(k, k, gp); HR_UNPACK(pk, pk, gp);
        const f32x4 muk = *(const LAS f32x4*)(p_c + 1 * 64 + 4 * gp), kkc = *(const LAS f32x4*)(p_c + 3 * 64 + 4 * gp);
#pragma unroll
        for (int i = 0; i < 4; ++i) { const float kv = (k[i] + (pk[i] - k[i]) * muk[i]) * kkc[i]; ss += kv * kv; }
    }
    ss += __shfl_xor(ss, 16); ss += __shfl_xor(ss, 32);
    const float inv = 1.f / fmaxf(sqrtf(ss), 1e-12f);
#pragma unroll
    for (int i = 0; i < 2; ++i) { asm volatile("" : "+v"(R.k[i])); asm volatile("" : "+v"(R.pk[i])); }
    unsigned fa[4], fr[4], fb[4], fk[4];
    float bon = 0.f;
#pragma unroll
    for (int gp = 0; gp < 4; ++gp) {
        float r[4], k[4], v[4], pr[4], pk[4], pv[4], a[4], e[4];
        HR_UNPACK(r, r, gp); HR_UNPACK(k, k, gp); HR_UNPACK(v, v, gp); HR_UNPACK(pr, pr, gp); HR_UNPACK(pk, pk, gp); HR_UNPACK(pv, pv, gp); HR_UNPACK(a, a, gp); HR_UNPACK(e, e, gp);
        const f32x4 mur = *(const LAS f32x4*)(p_c + 0 * 64 + 4 * gp), muk = *(const LAS f32x4*)(p_c + 1 * 64 + 4 * gp), muv = *(const LAS f32x4*)(p_c + 2 * 64 + 4 * gp);
        const f32x4 kkc = *(const LAS f32x4*)(p_c + 3 * 64 + 4 * gp), kac = *(const LAS f32x4*)(p_c + 4 * 64 + 4 * gp), rkc = *(const LAS f32x4*)(p_c + 5 * 64 + 4 * gp);
        float xv[4], At[4], Rt[4], Bt[4], Kt[4]; f32x4 gv;
#pragma unroll
        for (int i = 0; i < 4; ++i) {
            const float xr = r[i] + (pr[i] - r[i]) * mur[i], xk = k[i] + (pk[i] - k[i]) * muk[i]; xv[i] = v[i] + (pv[i] - v[i]) * muv[i];
            const float kn = xk * kkc[i] * inv, kpv = xk * (1.f + (a[i] - 1.f) * kac[i]); bon += xr * kpv * rkc[i];
            float x = e[i];
            x += dpp_shr(x, 1); x += dpp_shr(x, 2); x += dpp_shr(x, 4); x += dpp_shr(x, 8);
            const float g = __builtin_amdgcn_exp2f(LOG2E * x), gi = __builtin_amdgcn_exp2f(-LOG2E * x); float gpv = dpp_shr(g, 1); gpv = (t == 0) ? 1.f : gpv;
            At[i] = -kn * gpv; Rt[i] = xr * g; Bt[i] = kn * a[i] * gi; Kt[i] = kpv * gi; gv[i] = g;
            if (i == 1) __builtin_amdgcn_sched_barrier(0); }
        *(LAS v2u*)(p_v + gp * 8) = (v2u){cvt2(xv[0], xv[1]), cvt2(xv[2], xv[3])};
        if (t == 15) *(LAS f32x4*)(p_g + gp * 64) = gv;
        const int hf = gp & 1;
        fa[2 * hf] = cvt2(At[0], At[1]); fa[2 * hf + 1] = cvt2(At[2], At[3]); fr[2 * hf] = cvt2(Rt[0], Rt[1]); fr[2 * hf + 1] = cvt2(Rt[2], Rt[3]);
        fb[2 * hf] = cvt2(Bt[0], Bt[1]); fb[2 * hf + 1] = cvt2(Bt[2], Bt[3]); fk[2 * hf] = cvt2(Kt[0], Kt[1]); fk[2 * hf + 1] = cvt2(Kt[2], Kt[3]);
        if (hf) {
            const int ko = (gp >> 1) * 64;
            *(LAS v4u*)(p_row + SL_A + ko) = (v4u){fa[0], fa[1], fa[2], fa[3]}; *(LAS v4u*)(p_row + SL_R + ko) = (v4u){fr[0], fr[1], fr[2], fr[3]};
            *(LAS v4u*)(p_row + SL_B + ko) = (v4u){fb[0], fb[1], fb[2], fb[3]}; *(LAS v4u*)(p_row + SL_K + ko) = (v4u){fk[0], fk[1], fk[2], fk[3]};
        }
        __builtin_amdgcn_sched_barrier(0);
    }
    bon += __shfl_xor(bon, 16); bon += __shfl_xor(bon, 32);
    if (kg == 0) BON[(size_t)tok * NH + h] = bon;
    if (prefetch) helper_load(R, PROJ, DAG, tok + NHELP * CS, h, kg);
    const bf16x8 FA0 = *(const LAS bf16x8*)(p_row + SL_A), FA1 = *(const LAS bf16x8*)(p_row + SL_A + 64), FR0 = *(const LAS bf16x8*)(p_row + SL_R), FR1 = *(const LAS bf16x8*)(p_row + SL_R + 64);
    const bf16x8 FB0 = *(const LAS bf16x8*)(p_row + SL_B), FB1 = *(const LAS bf16x8*)(p_row + SL_B + 64), FK0 = *(const LAS bf16x8*)(p_row + SL_K), FK1 = *(const LAS bf16x8*)(p_row + SL_K + 64);
    const f32x4 z4 = (f32x4){0.f, 0.f, 0.f, 0.f};
    f32x4 Lab = MFMA16(FA0, FB0, z4); Lab = MFMA16(FA1, FB1, Lab);
    f32x4 Lak = MFMA16(FA0, FK0, z4); Lak = MFMA16(FA1, FK1, Lak);
    f32x4 Lrb = MFMA16(FR0, FB0, z4); Lrb = MFMA16(FR1, FB1, Lrb);
    f32x4 Lrk = MFMA16(FR0, FK0, z4); Lrk = MFMA16(FR1, FK1, Lrk);
    const int s = t;
#pragma unroll
    for (int r = 0; r < 4; ++r) { const int tt = 4 * kg + r;
        Lab[r] = tt > s ? Lab[r] : 0.f; Lak[r] = tt > s ? Lak[r] : 0.f; Lrb[r] = tt >= s ? Lrb[r] : 0.f; Lrk[r] = tt >= s ? Lrk[r] : 0.f; }
#define WR_TILE(off, X) (*(LAS v2u*)(p_tw + (off)) = (v2u){cvt2((X)[0], (X)[1]), cvt2((X)[2], (X)[3])})
#define RD_AFRAG(dst, off) do { const v2u w_ = trd(p_tr + (off)); dst = mk8(w_.x, w_.y, 0u, 0u); } while (0)
    WR_TILE(SL_LAK, Lak); WR_TILE(SL_LRB, Lrb); WR_TILE(SL_LRK, Lrk);
    bf16x8 AL1, AL2, AL4;
    WR_TILE(SL_T, Lab); RD_AFRAG(AL1, SL_T);
    f32x4 L2 = MFMA16(AL1, accB(Lab), z4);
    WR_TILE(SL_T, L2); RD_AFRAG(AL2, SL_T);
    f32x4 L4 = MFMA16(AL2, accB(L2), z4);
    WR_TILE(SL_T, L4); RD_AFRAG(AL4, SL_T);
    f32x4 Rm = MFMA16(AL4, accB(L4), z4);
#pragma unroll
    for (int r = 0; r < 4; ++r) Rm[r] += (4 * kg + r == s) ? 1.f : 0.f;
    Rm = MFMA16(AL4, accB(Rm), Rm);
    Rm = MFMA16(AL2, accB(Rm), Rm);
    Rm = MFMA16(AL1, accB(Rm), Rm);
    WR_TILE(SL_T, Rm);
#undef WR_TILE
#undef RD_AFRAG
}

__device__ __forceinline__ void state_chunk(const LAS unsigned char* slot, f32x4 (&X)[4], LAS unsigned char* yl, int lane, int wv) {
    const int c = lane & 15, g = lane >> 4, q4 = 4 * g + (c >> 2), pp = c & 3;
    const f32x4 z4 = (f32x4){0.f, 0.f, 0.f, 0.f};
    const LAS unsigned char* p128 = slot + c * 128 + g * 16;
    const LAS unsigned char* p_bt = slot + q4 * 128 + pp * 16;
    const LAS unsigned char* p_tr = slot + q4 * 32 + pp * 8;
    const LAS unsigned char* p_v = slot + SL_V + q4 * 128 + wv * 32 + pp * 8;
    const LAS unsigned char* pg = slot + SL_G + g * 16;
    PIN_PTR(p128); PIN_PTR(p_bt); PIN_PTR(p_tr); PIN_PTR(p_v); PIN_PTR(pg);
    const bf16x8 xb0 = mk8(cvt2(X[0][0], X[0][1]), cvt2(X[0][2], X[0][3]), cvt2(X[1][0], X[1][1]), cvt2(X[1][2], X[1][3]));
    const bf16x8 xb1 = mk8(cvt2(X[2][0], X[2][1]), cvt2(X[2][2], X[2][3]), cvt2(X[3][0], X[3][1]), cvt2(X[3][2], X[3][3]));
    const bf16x8 a0 = *(const LAS bf16x8*)(p128 + SL_A), a1 = *(const LAS bf16x8*)(p128 + SL_A + 64);
    const bf16x8 r0 = *(const LAS bf16x8*)(p128 + SL_R), r1 = *(const LAS bf16x8*)(p128 + SL_R + 64);
    const v2u vt = trd(p_v), lak = trd(p_tr + SL_LAK), tt = trd(p_tr + SL_T), lrb = trd(p_tr + SL_LRB), lrk = trd(p_tr + SL_LRK);
    f32x4 Z = MFMA16(a0, xb0, z4); Z = MFMA16(a1, xb1, Z); Z = MFMA16(mk8(lak.x, lak.y, 0u, 0u), mk8(vt.x, vt.y, 0u, 0u), Z);
    const f32x4 U = MFMA16(mk8(tt.x, tt.y, 0u, 0u), accB(Z), z4);
    const bf16x8 uv = mk8(cvt2(U[0], U[1]), cvt2(U[2], U[3]), vt.x, vt.y);
    f32x4 Y = MFMA16(r0, xb0, z4); Y = MFMA16(r1, xb1, Y); Y = MFMA16(mk8(lrb.x, lrb.y, lrk.x, lrk.y), uv, Y);
#pragma unroll
    for (int jb = 0; jb < 4; ++jb) {
        const v2u bb = trd(p_bt + SL_B + (jb >> 1) * 64 + (jb & 1) * 8), kk2 = trd(p_bt + SL_K + (jb >> 1) * 64 + (jb & 1) * 8);
        const f32x4 gm = *(const LAS f32x4*)(pg + jb * 64);
        X[jb] = MFMA16(mk8(bb.x, bb.y, kk2.x, kk2.y), uv, X[jb]) * gm;
    }
    LAS unsigned char* py = yl + (4 * g) * 128 + (16 * wv + c) * 2;
    PIN_PTR(py);
#pragma unroll
    for (int r = 0; r < 4; ++r) *(LAS unsigned short*)(py + r * 128) = (unsigned short)f2bf(Y[r]);
}

__device__ __forceinline__ void p4_scan(Frame& F, const Args& AR) {
    const bf16* PROJ = (const bf16*)(F.ws + WS_PROJ); const bf16* DAG = (const bf16*)(F.ws + WS_DAG);
    float* BON = (float*)(F.ws + WS_BON); bf16* Y = (bf16*)((unsigned char*)F.out + DO_Y);
    LAS unsigned char* lds = F.lds + RING_OFF;
    LAS float* cst = (LAS float*)(lds + SC_CONST);
    const int tid = F.tid, lane = F.lane, wave = F.wave;
    for (int unit = blockIdx.x; unit < BATCH * NH; unit += F.G) {
        const int b = unit >> 3, h = unit & 7;
        const int tok0 = b * SEQ;
        if (tid < 384) { const int a = tid >> 6, c = tid & 63; const float* src = a == 0 ? AR.in[I_MU] + RC_R : a == 1 ? AR.in[I_MU] + RC_K : a == 2 ? AR.in[I_MU] + RC_V : a == 3 ? AR.in[I_KK] : a == 4 ? AR.in[I_KA] : AR.in[I_RK];
            cst[a * 64 + c] = src[h * 64 + c]; }
        __syncthreads();
        const int st_k = tid >> 7, st_t = (tid >> 3) & 15, st_p = tid & 7;
        GAS v4u* ystore = (GAS v4u*)((GAS bf16*)Y + (size_t)(tok0 + st_k * CS + st_t) * RW + h * 64 + 8 * st_p);
        const LAS unsigned char* yl_rd = lds + SC_YL + st_k * (CS * 128) + st_t * 128 + st_p * 16;
        if (wave >= NSTATE) {
            const int hw = wave - NSTATE, kg = lane >> 4, tokl = tok0 + (lane & 15);
            HReg R;
            helper_load(R, PROJ, DAG, tokl + hw * CS, h, kg);
            for (int it = 0; it <= NIT + 1; ++it) {
                if (it >= 2 && NHELP * (it - 2) + st_k < NCHUNK) ystore[(size_t)(NHELP * (it - 2)) * CS * RW / 8] = *(const LAS v4u*)(yl_rd + (it & 1) * YL_BYTES);
                const int ch = NHELP * it + hw;
                if (ch < NCHUNK) helper_chunk(lds + ((it & 1) * NHELP + hw) * SL_BYTES, cst, R, ch + NHELP < NCHUNK, PROJ, DAG, BON, tokl + ch * CS, h, lane);
                __syncthreads();
            }
        } else {
            f32x4 X[4];
#pragma unroll
            for (int jb = 0; jb < 4; ++jb) X[jb] = (f32x4){0.f, 0.f, 0.f, 0.f};
            __builtin_amdgcn_s_setprio(3);
            for (int it = 0; it <= NIT + 1; ++it) {
                if (it >= 2 && NHELP * (it - 2) + st_k < NCHUNK) ystore[(size_t)(NHELP * (it - 2)) * CS * RW / 8] = *(const LAS v4u*)(yl_rd + (it & 1) * YL_BYTES);
                if (it > 0) {
                    for (int k = 0; k < NHELP; ++k) { const int ch = NHELP * (it - 1) + k;
                        if (ch < NCHUNK) state_chunk(lds + (((it - 1) & 1) * NHELP + k) * SL_BYTES, X, lds + SC_YL + ((it - 1) & 1) * YL_BYTES + k * (CS * 128), lane, wave); }
                }
                __syncthreads();
            }
            __builtin_amdgcn_s_setprio(0);
        }
        __syncthreads();
    }
}

__device__ __forceinline__ s16x4 vtr(const LAS unsigned char* p) { typedef short v4i16_t __attribute__((ext_vector_type(4)));
    return __builtin_bit_cast(s16x4, __builtin_amdgcn_ds_read_tr16_b64_v4i16((LAS v4i16_t*)p)); }
constexpr int ATT_UNITS = 3 * BATCH * NH * 16;
__device__ __forceinline__ void p4_attn(Frame& F, const Args& AR) {
    const bf16* PROJ = (const bf16*)(F.ws + WS_PROJ);
    bf16* PO = (bf16*)((unsigned char*)F.out + DO_PO); float* ML = (float*)(F.ws + WS_ML);
    const int tid = F.tid, lane = F.lane, wave = F.wave, half = wave >> 2, wq = wave & 3, th = tid & 255;
    const int r32 = lane & 31, hi = lane >> 5;
    LAS unsigned char* Kl = F.lds + RING_OFF + half * 65536; LAS unsigned char* Vl = Kl + 32768;
    gu32* qctr = F.ctl + CW_ATTQ;
    for (;;) {
        if (tid == 0) F.MISC[16] = __hip_atomic_fetch_add(qctr, 1u, RLX_AGENT);
        __syncthreads();
        const int up = (int)F.MISC[16];
        if (up >= ATT_UNITS / 2) break;
        const int unit = 2 * up + half;
        const int pat = unit / (BATCH * NH * 16), rem = unit % (BATCH * NH * 16), bh = rem >> 4, i16 = rem & 15, b = bh >> 3, h = bh & 7;
        const int dil = pat == 0 ? 1 : (pat == 1 ? 4 : 16);
        const int res = pat == 0 ? 0 : (pat == 1 ? (i16 >> 2) : i16);
        const int n = pat == 0 ? i16 : (pat == 1 ? (i16 & 3) : 0);
        const size_t rowb = (size_t)b * SEQ;
        {
            const int c = th & 7;
#pragma unroll
            for (int i = 0; i < 8; ++i) {
                const int key = (th >> 3) + 32 * i; const int sub = 128 * (n - 1) + key;
                v4u kv = (v4u){0u, 0u, 0u, 0u}, vv = kv;
                if (sub >= 0) { const bf16* src = PROJ + (rowb + res + dil * sub) * IN_COLS + h * 64 + 8 * c; kv = *(const v4u*)(src + PC_K); vv = *(const v4u*)(src + PC_V); }
                *(LAS v4u*)(Kl + key * 128 + ((c ^ ((key >> 1) & 7)) * 16)) = kv;
                *(LAS v4u*)(Vl + (c >> 2) * 16384 + key * 64 + (c & 3) * 16) = vv;
            }
        }
        const int ql = 32 * wq + r32; const size_t qrow = rowb + res + dil * (128 * n + ql);
        bf16x8 qf[4];
#pragma unroll
        for (int d0 = 0; d0 < 4; ++d0) qf[d0] = *(const bf16x8*)(PROJ + qrow * IN_COLS + PC_Q + h * 64 + 16 * d0 + 8 * hi);
        __syncthreads();
        const float slope2 = __builtin_amdgcn_exp2f(-(float)(h + 1)) * (float)dil * LOG2E;
        const int thr = r32 - 4 * hi;
        f32x16 sc[5];
        float mx = -INFINITY;
#pragma unroll
        for (int kt = 0; kt < 5; ++kt) {
            const bool skip = (n == 0) && (wq + kt < 4);
            f32x16 acc;
            if (!skip) {
                const int key = 32 * (wq + kt) + r32;
                const float bk = -slope2 * (float)(128 - 32 * kt + thr);
#pragma unroll
                for (int r = 0; r < 16; ++r) acc[r] = slope2 * (float)((r & 3) + 8 * (r >> 2)) + bk;
#pragma unroll
                for (int d0 = 0; d0 < 4; ++d0) {
                    const bf16x8 kf = *(const LAS bf16x8*)(Kl + key * 128 + (((2 * d0 + hi) ^ ((key >> 1) & 7)) * 16));
                    acc = __builtin_amdgcn_mfma_f32_32x32x16_bf16(kf, qf[d0], acc, 0, 0, 0);
                }
                if (kt == 0) {
#pragma unroll
                    for (int r = 0; r < 16; ++r) acc[r] = ((r & 3) + 8 * (r >> 2)) >= thr ? acc[r] : -INFINITY;
                }
                if (kt == 4) {
#pragma unroll
                    for (int r = 0; r < 16; ++r) acc[r] = ((r & 3) + 8 * (r >> 2)) <= thr ? acc[r] : -INFINITY;
                }
#pragma unroll
                for (int r = 0; r < 16; ++r) mx = fmaxf(mx, acc[r]);
            } else {
#pragma unroll
                for (int r = 0; r < 16; ++r) acc[r] = -INFINITY;
            }
            sc[kt] = acc;
            __builtin_amdgcn_sched_barrier(0);
        }
        mx = fmaxf(mx, __shfl_xor(mx, 32));
        float l = 0.f;
#pragma unroll
        for (int kt = 0; kt < 5; ++kt)
#pragma unroll
            for (int r = 0; r < 16; ++r) { const float p = __builtin_amdgcn_exp2f(sc[kt][r] - mx); sc[kt][r] = p; l += p; }
        l += __shfl_xor(l, 32);
        f32x16 o[2]; o[0] = f32x16{}; o[1] = f32x16{};
        const int voff = ((lane >> 4) & 1) * 32 + (lane & 3) * 8 + (4 * hi + ((lane & 15) >> 2)) * 64;
#pragma unroll
        for (int kt = 0; kt < 5; ++kt) {
            const bool skip = (n == 0) && (wq + kt < 4);
            if (!skip) {
#pragma unroll
            for (int s2 = 0; s2 < 2; ++s2) {
                v4u pw;
                pw.x = pg8::cvt_pk_bf16(sc[kt][8 * s2 + 0], sc[kt][8 * s2 + 1]); pw.y = pg8::cvt_pk_bf16(sc[kt][8 * s2 + 2], sc[kt][8 * s2 + 3]);
                pw.z = pg8::cvt_pk_bf16(sc[kt][8 * s2 + 4], sc[kt][8 * s2 + 5]); pw.w = pg8::cvt_pk_bf16(sc[kt][8 * s2 + 6], sc[kt][8 * s2 + 7]);
                const bf16x8 pf = __builtin_bit_cast(bf16x8, pw);
                const int kb = 32 * (wq + kt) + 16 * s2;
#pragma unroll
                for (int dt = 0; dt < 2; ++dt) {
                    const LAS unsigned char* vp = Vl + dt * 16384 + kb * 64 + voff;
                    const s16x4 lo = vtr(vp), hi4 = vtr(vp + 8 * 64);
                    const bf16x8 vf = (bf16x8){lo[0], lo[1], lo[2], lo[3], hi4[0], hi4[1], hi4[2], hi4[3]};
                    o[dt] = __builtin_amdgcn_mfma_f32_32x32x16_bf16(vf, pf, o[dt], 0, 0, 0);
                }
            }
            }
        }
        const float rl = 1.f / l;
        bf16* po = PO + ((size_t)pat * M + qrow) * AW + h * 64;
#pragma unroll
        for (int dt = 0; dt < 2; ++dt)
#pragma unroll
            for (int g = 0; g < 4; ++g) {
                const v2u w = (v2u){pk2(o[dt][4 * g] * rl, o[dt][4 * g + 1] * rl), pk2(o[dt][4 * g + 2] * rl, o[dt][4 * g + 3] * rl)};
                *(v2u*)(po + 32 * dt + 8 * g + 4 * hi) = w;
            }
        if (hi == 0) *(f32x2*)(ML + (((size_t)pat * M + qrow) * NH + h) * 2) = (f32x2){mx, l};
        __syncthreads();
    }
}

__device__ __forceinline__ void p5_post(Frame& F, const Args& AR) {
    const int gw = F.vcu * NWAVES + F.wave, NGW = F.G * NWAVES, lane = F.lane, hd = lane >> 3;
    const bf16* PROJ = (const bf16*)(F.ws + WS_PROJ); const bf16* DAG = (const bf16*)(F.ws + WS_DAG); const float* BON = (const float*)(F.ws + WS_BON);
    const bf16* PO = (const bf16*)((unsigned char*)F.out + DO_PO); const float* ML = (const float*)(F.ws + WS_ML); const bf16* Y = (const bf16*)((unsigned char*)F.out + DO_Y);
    bf16* MIX = (bf16*)(F.ws + WS_XN);
    float aog[8], lng[8], lnb[8], muv[8];
#pragma unroll
    for (int i = 0; i < 8; ++i) { aog[i] = AR.in[I_AOG][8 * lane + i]; lng[i] = AR.in[I_LNG][8 * lane + i]; lnb[i] = AR.in[I_LNB][8 * lane + i]; muv[i] = AR.in[I_MU][RC_V + 8 * lane + i]; }
    for (int m = gw; m < M; m += NGW) {
        float mp[3], lp[3];
#pragma unroll
        for (int p = 0; p < 3; ++p) { const f32x2 t = *(const f32x2*)(ML + (((size_t)p * M + m) * NH + hd) * 2); mp[p] = t.x; lp[p] = t.y; }
        const float mm = fmaxf(fmaxf(mp[0], mp[1]), mp[2]);
        float wp[3], wsum = 0.f;
#pragma unroll
        for (int p = 0; p < 3; ++p) { wp[p] = __builtin_amdgcn_exp2f(mp[p] - mm) * lp[p]; wsum += wp[p]; }
        const float rws = 1.f / wsum;
        float at[8] = {0.f, 0.f, 0.f, 0.f, 0.f, 0.f, 0.f, 0.f};
#pragma unroll
        for (int p = 0; p < 3; ++p) { const v4u w = *(const v4u*)(PO + ((size_t)p * M + m) * AW + 8 * lane); const float f = wp[p] * rws;
            at[0] += f * bflo(w.x); at[1] += f * bfhi(w.x); at[2] += f * bflo(w.y); at[3] += f * bfhi(w.y); at[4] += f * bflo(w.z); at[5] += f * bfhi(w.z); at[6] += f * bflo(w.w); at[7] += f * bfhi(w.w); }
        float ss = 0.f;
#pragma unroll
        for (int i = 0; i < 8; ++i) ss += at[i] * at[i];
        ss += __shfl_xor(ss, 1); ss += __shfl_xor(ss, 2); ss += __shfl_xor(ss, 4);
        const float rstd = 1.f / sqrtf(ss * (1.f / 64.f) + NORM_EPS);
        v4u oa; oa.x = pk2(at[0] * rstd * aog[0], at[1] * rstd * aog[1]); oa.y = pk2(at[2] * rstd * aog[2], at[3] * rstd * aog[3]);
        oa.z = pk2(at[4] * rstd * aog[4], at[5] * rstd * aog[5]); oa.w = pk2(at[6] * rstd * aog[6], at[7] * rstd * aog[7]);
        *(v4u*)(MIX + (size_t)m * D + 8 * lane) = oa;
        const v4u yw = *(const v4u*)(Y + (size_t)m * RW + 8 * lane);
        float y[8] = {bflo(yw.x), bfhi(yw.x), bflo(yw.y), bfhi(yw.y), bflo(yw.z), bfhi(yw.z), bflo(yw.w), bfhi(yw.w)};
        float sm = 0.f;
#pragma unroll
        for (int i = 0; i < 8; ++i) sm += y[i];
        sm += __shfl_xor(sm, 1); sm += __shfl_xor(sm, 2); sm += __shfl_xor(sm, 4);
        const float mean = sm * (1.f / 64.f); float sv = 0.f;
#pragma unroll
        for (int i = 0; i < 8; ++i) { y[i] -= mean; sv += y[i] * y[i]; }
        sv += __shfl_xor(sv, 1); sv += __shfl_xor(sv, 2); sv += __shfl_xor(sv, 4);
        const float rs = 1.f / sqrtf(sv * (1.f / 64.f) + LNX_EPS);
        const bf16* prow = PROJ + (size_t)m * IN_COLS + PC_RW + RC_V + 8 * lane;
        const v4u vc = *(const v4u*)prow; v4u vp = (v4u){0u, 0u, 0u, 0u};
        if ((m & (SEQ - 1)) != 0) vp = *(const v4u*)(prow - IN_COLS);
        const v4u gw4 = *(const v4u*)(DAG + (size_t)m * NLORA + 1024 + 8 * lane);
        const float bon = BON[(size_t)m * NH + hd];
        const float vcf[8] = {bflo(vc.x), bfhi(vc.x), bflo(vc.y), bfhi(vc.y), bflo(vc.z), bfhi(vc.z), bflo(vc.w), bfhi(vc.w)};
        const float vpf[8] = {bflo(vp.x), bfhi(vp.x), bflo(vp.y), bfhi(vp.y), bflo(vp.z), bfhi(vp.z), bflo(vp.w), bfhi(vp.w)};
        const float gf[8] = {bflo(gw4.x), bfhi(gw4.x), bflo(gw4.y), bfhi(gw4.y), bflo(gw4.z), bfhi(gw4.z), bflo(gw4.w), bfhi(gw4.w)};
        float ro[8];
#pragma unroll
        for (int i = 0; i < 8; ++i) { const float xv = vcf[i] + (vpf[i] - vcf[i]) * muv[i]; ro[i] = (y[i] * rs * lng[i] + lnb[i] + bon * xv) * gf[i]; }
        v4u orw; orw.x = pk2(ro[0], ro[1]); orw.y = pk2(ro[2], ro[3]); orw.z = pk2(ro[4], ro[5]); orw.w = pk2(ro[6], ro[7]);
        *(v4u*)(MIX + (size_t)m * D + AW + 8 * lane) = orw;
    }
}

__global__ void __launch_bounds__(NWAVES * 64, 2) hybrid_fwd(Args args) {
    extern __shared__ __attribute__((aligned(16))) unsigned char lds[];
    Frame F;
    F.lds = (LAS unsigned char*)lds;
    F.MISC = (volatile LAS unsigned*)(F.lds + MISC_OFF);
    F.tid = threadIdx.x; F.lane = F.tid & 63; F.wave = __builtin_amdgcn_readfirstlane(F.tid >> 6);
    F.G = gridDim.x; { const int bx = blockIdx.x; F.vcu = (F.G % 8 == 0) ? (bx % 8) * (F.G / 8) + bx / 8 : bx; }
    F.ws = args.ws; F.out = args.out;
    F.ctl = (gu32*)(args.ws + WS_CTL);
    for (int u = F.tid; u < (LDS_BYTES - LDSCTL_OFF) / 4; u += NWAVES * 64) ((LAS unsigned*)(F.lds + LDSCTL_OFF))[u] = 0u;
    __syncthreads();
    XcdBarrier bar; bar.bar = (unsigned*)(F.ctl + CW_BAR); bar.x = 0; bar.st = nullptr;
    if (N_LAUNCHES != PER_PHASE) bar = xcd_barrier_post((unsigned*)(F.ctl + CW_BAR), F.MISC + 8);
#define GRID_BAR() do { if (N_LAUNCHES != PER_PHASE) xcd_barrier(bar); } while (0)
    const int lo = args.ph_lo, hi = args.ph_hi;
#ifndef PHMASK
#define PHMASK 0x3ff
#endif
#define IN(k) (((PHMASK >> (k)) & 1) && lo <= (k) && (k) < hi)
#define BOTH(k) (IN(k) && IN((k) + 1))
#ifndef REPMASK
#define REPMASK 0
#endif
#define REP(k) for (int rep_ = 0; rep_ <= ((REPMASK >> (k)) & 1); ++rep_)
    bf16* XN = (bf16*)(args.ws + WS_XN); bf16* PROJ = (bf16*)(args.ws + WS_PROJ);

    if (IN(0)) { p0_prologue(F, args); if (BOTH(0)) GRID_BAR(); }
    if (IN(1)) {
        pg8::Gemm g{XN, (const bf16*)(args.ws + WS_WIN), M, IN_COLS, D}; pg8::StaticOrder S; S.init(M, IN_COLS, F.G, (int)blockIdx.x);
        pg8::EpiProj E{PROJ, IN_COLS, args.in[I_QNG], args.in[I_KNG]};
        pg8::gemm_phase<pg8::EpiProj, pg8::StaticOrder, true, true>(F.lds + RING_OFF, g, S, E);
        if (BOTH(1)) GRID_BAR();
    }
    if (IN(2)) { p2_prep(F, args); if (BOTH(2)) GRID_BAR(); }
    if (IN(3)) {
        pg8::Gemm g{(const bf16*)(args.ws + WS_A2), (const bf16*)(args.ws + WS_WL), M, NLORA, KLORA}; pg8::StaticOrder S; S.init(M, NLORA, F.G, (int)blockIdx.x);
        pg8::EpiLora E{(bf16*)(args.ws + WS_DAG), NLORA, args.in[I_W0], args.in[I_A0]};
        pg8::gemm_phase<pg8::EpiLora, pg8::StaticOrder, true, true>(F.lds + RING_OFF, g, S, E);
        if (BOTH(3)) GRID_BAR();
    }
    if (IN(4)) { p4_scan(F, args); p4_attn(F, args); if (BOTH(4)) GRID_BAR(); }
    if (IN(5)) { p5_post(F, args); if (BOTH(5)) GRID_BAR(); }
    if (IN(6)) {
        pg8::Gemm g{XN, (const bf16*)(args.ws + WS_WOUT), M, D, D}; pg8::StaticOrder S; S.init(M, D, F.G, (int)blockIdx.x);
        pg8::EpiOut E{args.in[I_X], F.out, (bf16*)(args.ws + WS_DAG), (float*)(args.ws + WS_SS), D, (LAS float*)(F.lds + RING_OFF + 131072)};
        pg8::gemm_phase<pg8::EpiOut, pg8::StaticOrder, true, true>(F.lds + RING_OFF, g, S, E);
        if (IN(8)) GRID_BAR();
    }
    if (IN(8)) {
        pg8::Gemm g{(const bf16*)(args.ws + WS_DAG), (const bf16*)(args.ws + WS_WGU), M, NGU, D}; pg8::StaticOrder S; S.init(M, NGU, F.G, (int)blockIdx.x);
        pg8::EpiSwiglu E{PROJ, FF, (const float*)(args.ws + WS_SS)};
        pg8::gemm_phase<pg8::EpiSwiglu, pg8::StaticOrder, true, true>(F.lds + RING_OFF, g, S, E);
        if (BOTH(8)) GRID_BAR();
    }
    if (IN(9)) {
        pg8::Gemm g{PROJ, (const bf16*)(args.ws + WS_WDN), M, D, FF}; pg8::StaticOrder S; S.init(M, D, F.G, (int)blockIdx.x);
        pg8::EpiResF32 E{F.out, F.out, D};
        pg8::gemm_phase<pg8::EpiResF32, pg8::StaticOrder, true, true>(F.lds + RING_OFF, g, S, E);
    }
#undef IN
#undef BOTH
}

extern "C" void kernel_launch(void* const* d_in, const int* in_sizes, int n_in, void* d_out, int out_size, void* d_ws, size_t ws_size, hipStream_t stream) {
    static int grid = 0;
    if (grid == 0) {
        if (n_in != 22 || in_sizes[0] != M * D || out_size != M * D || ws_size < WS_END) { fprintf(stderr, "kernel_launch: unexpected shapes (n_in %d, in0 %d, out %d, ws %zu); nothing launched\n", n_in, n_in > 0 ? in_sizes[0] : -1, out_size, ws_size); grid = -1; return; }
        int dev = 0, cus = 0, per_cu = 0;
        if (hipGetDevice(&dev) != hipSuccess || hipDeviceGetAttribute(&cus, hipDeviceAttributeMultiprocessorCount, dev) != hipSuccess) { grid = -1; return; }
        if (hipFuncSetAttribute((const void*)hybrid_fwd, hipFuncAttributeMaxDynamicSharedMemorySize, LDS_BYTES) != hipSuccess) { fprintf(stderr, "kernel_launch: hipFuncSetAttribute failed\n"); grid = -1; return; }
        if (hipOccupancyMaxActiveBlocksPerMultiprocessor(&per_cu, (const void*)hybrid_fwd, NWAVES * 64, LDS_BYTES) != hipSuccess || per_cu < 1)
            fprintf(stderr, "kernel_launch: note: occupancy query reports %d workgroups per CU\n", per_cu);
        (void)hipGetLastError();
        grid = cus;
    }
    if (grid < 0) return;
    if (hipMemsetAsync((char*)d_ws + WS_CTL, 0, CTL_ZERO_BYTES, stream) != hipSuccess) { fprintf(stderr, "kernel_launch: hipMemsetAsync failed\n"); return; }
    Args a{};
    for (int i = 0; i < 22; ++i) a.in[i] = (const float*)d_in[i];
    a.out = (float*)d_out; a.ws = (unsigned char*)d_ws;
    for (int li = 0; li < N_LAUNCHES; ++li) {
        a.ph_lo = (N_LAUNCHES == PER_PHASE) ? li : 0; a.ph_hi = (N_LAUNCHES == PER_PHASE) ? li + 1 : PER_PHASE; a.li = li;
        hipLaunchKernelGGL(hybrid_fwd, dim3(grid), dim3(NWAVES * 64), LDS_BYTES, stream, a);
        const hipError_t le = hipPeekAtLastError();
        if (le != hipSuccess) { fprintf(stderr, "kernel_launch: launch %d failed: %s\n", li, hipGetErrorName(le)); break; }
    }
}
```

```cpp
#include <hip/hip_runtime.h>
#include <cstdio>
#include <cstdint>

#ifndef MK_N_LAUNCHES
#define MK_N_LAUNCHES 1
#endif

namespace pg8 {
#define PG8_LAS __attribute__((address_space(3)))
typedef unsigned short bf16_t;
typedef short bf16x8 __attribute__((ext_vector_type(8)));
typedef float f32x4 __attribute__((ext_vector_type(4)));
typedef float f32x2 __attribute__((ext_vector_type(2)));
typedef unsigned u32x4 __attribute__((ext_vector_type(4)));
constexpr int BM = 256, BK = 64, HALF = 128, HTB = HALF * BK * 2, STAGE_BYTES = 8 * HTB, NXCD = 8, WGM = 8;

__host__ __device__ __forceinline__ int lds_byte(int r, int c) { const int st = (r >> 4) * 2 + (c >> 5), rr = r & 15, cc = c & 31, ob = rr * 64 + cc * 2; return st * 1024 + (ob ^ (((ob >> 9) & 1) << 5)); }
__host__ __device__ __forceinline__ void stage_rc(int b, int& R, int& C) { const int st = b / 1024, sb = b % 1024, swz = sb ^ (((sb >> 9) & 1) << 5); R = (st >> 1) * 16 + swz / 64; C = (st & 1) * 32 + (swz % 64) / 2; }
__host__ __device__ __forceinline__ int perm32(int rho) { const int n = rho >> 4, i = rho & 15; return 8 * (i >> 2) + 4 * n + (i & 3); }

struct Unit { int pm, pn; };
struct Gemm { const bf16_t* A; const bf16_t* Bt; int M, N, K; };

struct StaticOrder {
    int nM, nN, nwg, G, c;
    __host__ __device__ void init(int M, int N, int G_, int c_) { nM = M / BM; nN = N / BM; nwg = nM * nN; G = G_; c = c_; }
    __host__ __device__ bool next(int i, Unit& u) const {
        const long L = (long)i * G + c; if (L >= nwg) return false;
        int wgid = (int)L; { const int q = nwg / NXCD, r = nwg % NXCD, xcd = wgid % NXCD, off = wgid / NXCD; wgid = (xcd < r ? xcd * (q + 1) : r * (q + 1) + (xcd - r) * q) + off; }
        const int nig = WGM * nN, gid = wgid / nig, fm = gid * WGM, gsz = (nM - fm) < WGM ? (nM - fm) : WGM;
        u.pm = fm + ((wgid % nig) % gsz); u.pn = (wgid % nig) / gsz; return true;
    }
    __device__ __forceinline__ void a_ready(const Unit&) const {}
    __device__ __forceinline__ void done(const Unit&) const {}
};

__device__ __forceinline__ unsigned cvt_pk_bf16(float lo, float hi) { unsigned r; asm volatile("v_cvt_pk_bf16_f32 %0, %1, %2" : "=v"(r) : "v"(lo), "v"(hi)); return r; }
__device__ __forceinline__ float fsigmoid(float x) { return __builtin_amdgcn_rcpf(1.0f + __builtin_amdgcn_exp2f(-1.4426950408889634f * x)); }

struct EpiBf16 {
    static constexpr bool PERM = true, AFTER_DRAIN = false;
    bf16_t* O; int ldc;
    __device__ __forceinline__ void operator()(const f32x4 (&acc)[2][2][4][2], const Unit& u, int wr, int wc, int fr, int fq) const {
        const int row0 = u.pm * BM + wr * 64 + fr; const int col0 = u.pn * BM + wc * 32 + 8 * fq;
#pragma unroll
        for (int ai = 0; ai < 2; ++ai)
#pragma unroll
            for (int m = 0; m < 4; ++m) { bf16_t* rowp = O + (size_t)(row0 + ai * HALF + m * 16) * ldc + col0;
#pragma unroll
                for (int bj = 0; bj < 2; ++bj) { const f32x4 v0 = acc[ai][bj][m][0], v1 = acc[ai][bj][m][1];
                    u32x4 w; w.x = cvt_pk_bf16(v0[0], v0[1]); w.y = cvt_pk_bf16(v0[2], v0[3]); w.z = cvt_pk_bf16(v1[0], v1[1]); w.w = cvt_pk_bf16(v1[2], v1[3]);
                    *(u32x4*)(rowp + bj * HALF) = w; } }
    }
};
struct EpiProj {
    static constexpr bool PERM = true, AFTER_DRAIN = false;
    bf16_t* O; int ldc; const float* qg; const float* kg;
    __device__ __forceinline__ void operator()(const f32x4 (&acc)[2][2][4][2], const Unit& u, int wr, int wc, int fr, int fq) const {
        const int row0 = u.pm * BM + wr * 64 + fr;
        if (u.pn >= 4) {
            const int col0 = u.pn * BM + wc * 32 + 8 * fq;
#pragma unroll
            for (int ai = 0; ai < 2; ++ai)
#pragma unroll
                for (int m = 0; m < 4; ++m) { bf16_t* rowp = O + (size_t)(row0 + ai * HALF + m * 16) * ldc + col0;
#pragma unroll
                    for (int bj = 0; bj < 2; ++bj) { const f32x4 v0 = acc[ai][bj][m][0], v1 = acc[ai][bj][m][1];
                        u32x4 w; w.x = cvt_pk_bf16(v0[0], v0[1]); w.y = cvt_pk_bf16(v0[2], v0[3]); w.z = cvt_pk_bf16(v1[0], v1[1]); w.w = cvt_pk_bf16(v1[2], v1[3]);
                        *(u32x4*)(rowp + bj * HALF) = w; } }
        } else {
            const float* gsrc = (u.pn < 2 ? qg : kg) + 8 * fq; const float sc = u.pn < 2 ? 0.125f * 1.4426950408889634f : 1.0f;
            f32x4 g4[2][2];
#pragma unroll
            for (int bj = 0; bj < 2; ++bj)
#pragma unroll
                for (int n = 0; n < 2; ++n) g4[bj][n] = *(const f32x4*)(gsrc + 32 * bj + 4 * n) * sc;
            const int col0 = u.pn * BM + wc * 64 + 8 * fq;
#pragma unroll
            for (int ai = 0; ai < 2; ++ai)
#pragma unroll
                for (int m = 0; m < 4; ++m) {
                    float ss = 0.f;
#pragma unroll
                    for (int bj = 0; bj < 2; ++bj)
#pragma unroll
                        for (int n = 0; n < 2; ++n) { const f32x4 v = acc[ai][bj][m][n]; ss += (v[0] * v[0] + v[1] * v[1]) + (v[2] * v[2] + v[3] * v[3]); }
                    ss += __shfl_xor(ss, 16); ss += __shfl_xor(ss, 32);
                    const float rstd = 1.0f / sqrtf(ss * (1.0f / 64.0f) + 1e-6f);
                    bf16_t* rowp = O + (size_t)(row0 + ai * HALF + m * 16) * ldc + col0;
#pragma unroll
                    for (int bj = 0; bj < 2; ++bj) { const f32x4 v0 = acc[ai][bj][m][0] * g4[bj][0] * rstd, v1 = acc[ai][bj][m][1] * g4[bj][1] * rstd;
                        u32x4 w; w.x = cvt_pk_bf16(v0[0], v0[1]); w.y = cvt_pk_bf16(v0[2], v0[3]); w.z = cvt_pk_bf16(v1[0], v1[1]); w.w = cvt_pk_bf16(v1[2], v1[3]);
                        *(u32x4*)(rowp + 32 * bj) = w; }
                    __builtin_amdgcn_sched_barrier(0); }
        }
    }
};
struct EpiLora {
    static constexpr bool PERM = true, AFTER_DRAIN = false;
    bf16_t* O; int ldc; const float* w0; const float* a0;
    __device__ __forceinline__ void operator()(const f32x4 (&acc)[2][2][4][2], const Unit& u, int wr, int wc, int fr, int fq) const {
        const int row0 = u.pm * BM + wr * 64 + fr; const int col0 = u.pn * BM + wc * 32 + 8 * fq;
        const int kind = u.pn >> 1;
        const float sc = kind == 0 ? -0.6065306597126334f : (kind == 1 ? 1.0f : 0.0f), lin = kind == 2 ? 1.0f : 0.0f;
        const float* bp = kind == 0 ? w0 : a0;
        const float bs = kind == 2 ? 0.0f : 1.0f;
#pragma unroll
        for (int bj = 0; bj < 2; ++bj) {
            const int c = (col0 + bj * HALF) & 511;
            const f32x4 b0 = *(const f32x4*)(bp + c) * bs, b1 = *(const f32x4*)(bp + c + 4) * bs;
#pragma unroll
            for (int ai = 0; ai < 2; ++ai)
#pragma unroll
                for (int m = 0; m < 4; ++m) { bf16_t* rowp = O + (size_t)(row0 + ai * HALF + m * 16) * ldc + col0;
                    f32x4 v0 = acc[ai][bj][m][0] + b0, v1 = acc[ai][bj][m][1] + b1;
#pragma unroll
                    for (int e = 0; e < 4; ++e) { v0[e] = sc * fsigmoid(v0[e]) + lin * v0[e]; v1[e] = sc * fsigmoid(v1[e]) + lin * v1[e]; }
                    u32x4 w; w.x = cvt_pk_bf16(v0[0], v0[1]); w.y = cvt_pk_bf16(v0[2], v0[3]); w.z = cvt_pk_bf16(v1[0], v1[1]); w.w = cvt_pk_bf16(v1[2], v1[3]);
                    *(u32x4*)(rowp + bj * HALF) = w;
                    __builtin_amdgcn_sched_barrier(0); }
        }
    }
};
struct EpiSwiglu {
    static constexpr bool PERM = true, AFTER_DRAIN = false;
    bf16_t* H; int ldh; const float* rstd;
    __device__ __forceinline__ void operator()(const f32x4 (&acc)[2][2][4][2], const Unit& u, int wr, int wc, int fr, int fq) const {
        const int row0 = u.pm * BM + wr * 64 + fr; const int col0 = u.pn * HALF + wc * 32 + 8 * fq;
        float rs[2][4];
#pragma unroll
        for (int ai = 0; ai < 2; ++ai)
#pragma unroll
            for (int m = 0; m < 4; ++m) rs[ai][m] = rstd[row0 + ai * HALF + m * 16];
#pragma unroll
        for (int ai = 0; ai < 2; ++ai)
#pragma unroll
            for (int m = 0; m < 4; ++m) { bf16_t* rowp = H + (size_t)(row0 + ai * HALF + m * 16) * ldh + col0;
                float h[8];
#pragma unroll
                for (int n = 0; n < 2; ++n)
#pragma unroll
                    for (int e = 0; e < 4; ++e) { const float g = acc[ai][0][m][n][e] * rs[ai][m], up = acc[ai][1][m][n][e] * rs[ai][m]; h[4 * n + e] = g * fsigmoid(g) * up; }
                u32x4 w; w.x = cvt_pk_bf16(h[0], h[1]); w.y = cvt_pk_bf16(h[2], h[3]); w.z = cvt_pk_bf16(h[4], h[5]); w.w = cvt_pk_bf16(h[6], h[7]);
                *(u32x4*)rowp = w;
                __builtin_amdgcn_sched_barrier(0); }
    }
};
struct EpiOut {
    static constexpr bool PERM = true, AFTER_DRAIN = false;
    const float* base; bf16_t* xb; float* SS; int ldc; PG8_LAS float* scr;
    __device__ __forceinline__ void operator()(const f32x4 (&acc)[2][2][4][2], const Unit& u, int wr, int wc, int fr, int fq) const {
        const int row0 = u.pm * BM + wr * 64 + fr, col0 = u.pn * BM + wc * 32 + 8 * fq;
#pragma unroll
        for (int ai = 0; ai < 2; ++ai)
#pragma unroll
            for (int m = 0; m < 4; ++m) { const size_t off = (size_t)(row0 + ai * HALF + m * 16) * ldc + col0;
                float ss = 0.f;
#pragma unroll
                for (int bj = 0; bj < 2; ++bj) {
                    const f32x4 o0 = *(const f32x4*)(base + off + bj * HALF) + acc[ai][bj][m][0], o1 = *(const f32x4*)(base + off + bj * HALF + 4) + acc[ai][bj][m][1];
                    u32x4 w; w.x = cvt_pk_bf16(o0[0], o0[1]); w.y = cvt_pk_bf16(o0[2], o0[3]); w.z = cvt_pk_bf16(o1[0], o1[1]); w.w = cvt_pk_bf16(o1[2], o1[3]);
                    *(u32x4*)(xb + off + bj * HALF) = w;
                    ss += ((o0[0] * o0[0] + o0[1] * o0[1]) + (o0[2] * o0[2] + o0[3] * o0[3])) + ((o1[0] * o1[0] + o1[1] * o1[1]) + (o1[2] * o1[2] + o1[3] * o1[3])); }
                ss += __shfl_xor(ss, 16); ss += __shfl_xor(ss, 32);
                if (fq == 0) scr[((((wr * 2 + ai) * 4 + m) * 16) + fr) * 4 + wc] = ss;
                if (m & 1) asm volatile("" ::: "memory"); }
        asm volatile("s_waitcnt lgkmcnt(0)" ::: "memory"); __builtin_amdgcn_s_barrier(); asm volatile("" ::: "memory");
        const int tid = threadIdx.x;
        if (tid < 256) { const f32x4 s4 = *(const PG8_LAS f32x4*)(scr + tid * 4);
            const int row = u.pm * BM + ((tid >> 6) & 1) * HALF + (tid >> 7) * 64 + ((tid >> 4) & 3) * 16 + (tid & 15);
            SS[(size_t)row * 4 + u.pn] = (s4[0] + s4[1]) + (s4[2] + s4[3]); }
    }
};
struct EpiFinal {
    static constexpr bool PERM = true, AFTER_DRAIN = false;
    const bf16_t* xb; float* out; int ldc;
    __device__ __forceinline__ void operator()(const f32x4 (&acc)[2][2][4][2], const Unit& u, int wr, int wc, int fr, int fq) const {
        const int row0 = u.pm * BM + wr * 64 + fr, col0 = u.pn * BM + wc * 32 + 8 * fq;
#pragma unroll
        for (int ai = 0; ai < 2; ++ai)
#pragma unroll
            for (int m = 0; m < 4; ++m) { const size_t off = (size_t)(row0 + ai * HALF + m * 16) * ldc + col0;
#pragma unroll
                for (int bj = 0; bj < 2; ++bj) { const u32x4 w = *(const u32x4*)(xb + off + bj * HALF);
                    const f32x4 b0 = (f32x4){__builtin_bit_cast(float, w.x << 16), __builtin_bit_cast(float, w.x & 0xffff0000u), __builtin_bit_cast(float, w.y << 16), __builtin_bit_cast(float, w.y & 0xffff0000u)};
                    const f32x4 b1 = (f32x4){__builtin_bit_cast(float, w.z << 16), __builtin_bit_cast(float, w.z & 0xffff0000u), __builtin_bit_cast(float, w.w << 16), __builtin_bit_cast(float, w.w & 0xffff0000u)};
                    *(f32x4*)(out + off + bj * HALF) = b0 + acc[ai][bj][m][0]; *(f32x4*)(out + off + bj * HALF + 4) = b1 + acc[ai][bj][m][1]; }
                if (m & 1) asm volatile("" ::: "memory"); }
    }
};

template <class Epi, class Sched, bool ALIGN_EPI = false, bool SP2 = false>
__device__ __forceinline__ void gemm_phase(PG8_LAS unsigned char* lds, const Gemm g, const Sched& S, const Epi& E) {
    const int tid = threadIdx.x, wid = __builtin_amdgcn_readfirstlane(tid >> 6), lane = tid & 63, wr = wid >> 2, wc = wid & 3, fr = lane & 15, fq = lane >> 4;
    const int K = g.K, nt = K / BK;
    unsigned voffA[2], voffB[2];
#pragma unroll
    for (int i = 0; i < 2; ++i) { int R, C; stage_rc(tid * 16 + i * 8192, R, C); const int Rb = Epi::PERM ? ((R & ~31) + perm32(R & 31)) : R;
        voffA[i] = (unsigned)(R * K + C) * 2u; voffB[i] = (unsigned)(Rb * K + C) * 2u; }
    const size_t kstep = (size_t)(BK * 2);
    const size_t hstep = (size_t)HALF * K * 2;
    const size_t tstep = 2 * hstep;
    const unsigned ldsw = (unsigned)wid * 1024u;
    const int aoff = lds_byte(wr * 64 + fr, fq * 8), boff = lds_byte(wc * 32 + fr, fq * 8);
#define PG8_SA(b, h) (((b) * 2 + (h)) * HTB)
#define PG8_SB(b, h) ((4 + (b) * 2 + (h)) * HTB)
#define PG8_STAGE(bufoff, gbase, voff) do { _Pragma("unroll") for (int _i = 0; _i < 2; ++_i) \
        __builtin_amdgcn_global_load_lds((const unsigned*)((const char*)(gbase) + (voff)[_i]), (PG8_LAS unsigned*)(lds + (bufoff) + ldsw + _i * 8192), 16, 0, 0); } while (0)
#define PG8_LDA(dst, b, h) do { _Pragma("unroll") for (int m = 0; m < 4; ++m) _Pragma("unroll") for (int k = 0; k < 2; ++k) dst[m][k] = *(const PG8_LAS bf16x8*)(lds + PG8_SA(b, h) + aoff + m * 2048 + k * 1024); } while (0)
#define PG8_LDB(dst, b, h) do { _Pragma("unroll") for (int n = 0; n < 2; ++n) _Pragma("unroll") for (int k = 0; k < 2; ++k) dst[n][k] = *(const PG8_LAS bf16x8*)(lds + PG8_SB(b, h) + boff + n * 2048 + k * 1024); } while (0)
#define PG8_MMA(ai, bj, At, Bt) do { __builtin_amdgcn_s_setprio(1); _Pragma("unroll") for (int m = 0; m < 4; ++m) _Pragma("unroll") for (int n = 0; n < 2; ++n) _Pragma("unroll") for (int k = 0; k < 2; ++k) \
        acc[ai][bj][m][n] = __builtin_amdgcn_mfma_f32_16x16x32_bf16(Bt[n][k], At[m][k], acc[ai][bj][m][n], 0, 0, 0); __builtin_amdgcn_s_setprio(0); } while (0)
#define PG8_WAIT_V(n) asm volatile("s_waitcnt vmcnt(" #n ")" ::: "memory")
#define PG8_WAIT_L(n) asm volatile("s_waitcnt lgkmcnt(" #n ")" ::: "memory")
#define PG8_BAR __builtin_amdgcn_s_barrier()
#define PG8_SCHED __builtin_amdgcn_sched_barrier(0)
    Unit cur, nxt; int ui = 0;
    if (!S.next(0, cur)) return;
    f32x4 acc[2][2][4][2];
#pragma unroll
    for (int a = 0; a < 2; ++a)
#pragma unroll
        for (int b = 0; b < 2; ++b)
#pragma unroll
            for (int m = 0; m < 4; ++m)
#pragma unroll
                for (int n = 0; n < 2; ++n) acc[a][b][m][n] = (f32x4){0.f, 0.f, 0.f, 0.f};
    bf16x8 At[4][2], B0[2][2], B1[2][2];
    const char* cA = (const char*)g.A + (size_t)cur.pm * tstep; const char* cB = (const char*)g.Bt + (size_t)cur.pn * tstep;
    S.a_ready(cur);
    if constexpr (SP2) {
        PG8_STAGE(PG8_SB(0, 0), cB, voffB); PG8_STAGE(PG8_SB(0, 1), cB + hstep, voffB); PG8_STAGE(PG8_SA(0, 0), cA, voffA); PG8_STAGE(PG8_SA(0, 1), cA + hstep, voffA);
        if (wr == 1) PG8_BAR;
        PG8_WAIT_V(2); PG8_BAR;
        PG8_STAGE(PG8_SB(1, 0), cB + kstep, voffB); PG8_STAGE(PG8_SA(1, 0), cA + kstep, voffA); PG8_STAGE(PG8_SB(1, 1), cB + hstep + kstep, voffB);
        PG8_WAIT_V(6); PG8_BAR;
    } else {
        PG8_STAGE(PG8_SB(0, 0), cB, voffB); PG8_STAGE(PG8_SA(0, 0), cA, voffA); PG8_STAGE(PG8_SB(0, 1), cB + hstep, voffB); PG8_STAGE(PG8_SA(0, 1), cA + hstep, voffA);
        if (wr == 1) PG8_BAR;
        PG8_WAIT_V(4); PG8_BAR;
        PG8_STAGE(PG8_SB(1, 0), cB + kstep, voffB); PG8_STAGE(PG8_SA(1, 0), cA + kstep, voffA); PG8_STAGE(PG8_SB(1, 1), cB + hstep + kstep, voffB);
        PG8_WAIT_V(6); PG8_BAR;
    }
    for (;;) {
        const bool has_next = S.next(ui + 1, nxt);
        const char* nA = has_next ? (const char*)g.A + (size_t)nxt.pm * tstep : cA; const char* nB = has_next ? (const char*)g.Bt + (size_t)nxt.pn * tstep : cB;
#pragma nounroll
        for (int t = 0; t < nt; t += 2) {
            const bool last = (t == nt - 2);
            const char* a1 = cA + (size_t)(t + 1) * kstep;
            const char* a2 = last ? nA : cA + (size_t)(t + 2) * kstep; const char* b2 = last ? nB : cB + (size_t)(t + 2) * kstep;
            const char* a3 = a2 + kstep; const char* b3 = b2 + kstep;
            if (last && has_next) S.a_ready(nxt);
            if constexpr (SP2) {
            PG8_LDB(B0, 0, 0); PG8_LDB(B1, 0, 1); PG8_SCHED; PG8_LDA(At, 0, 0); PG8_STAGE(PG8_SA(1, 1), a1 + hstep, voffA);
            PG8_WAIT_V(8); PG8_WAIT_L(0); PG8_BAR; PG8_MMA(0, 0, At, B0); PG8_MMA(0, 1, At, B1); PG8_BAR; PG8_SCHED;
            PG8_LDA(At, 0, 1); PG8_STAGE(PG8_SB(0, 0), b2, voffB); PG8_STAGE(PG8_SB(0, 1), b2 + hstep, voffB); PG8_STAGE(PG8_SA(0, 0), a2, voffA);
            PG8_WAIT_V(8); PG8_WAIT_L(0); PG8_BAR; PG8_MMA(1, 0, At, B0); PG8_MMA(1, 1, At, B1); PG8_BAR; PG8_SCHED;
            PG8_LDB(B0, 1, 0); PG8_LDB(B1, 1, 1); PG8_SCHED; PG8_LDA(At, 1, 0); PG8_STAGE(PG8_SA(0, 1), a2 + hstep, voffA);
            PG8_WAIT_V(8); PG8_WAIT_L(0); PG8_BAR; PG8_MMA(0, 0, At, B0); PG8_MMA(0, 1, At, B1); PG8_BAR; PG8_SCHED;
            PG8_LDA(At, 1, 1); PG8_STAGE(PG8_SB(1, 0), b3, voffB); PG8_STAGE(PG8_SB(1, 1), b3 + hstep, voffB); PG8_STAGE(PG8_SA(1, 0), a3, voffA);
            PG8_WAIT_V(8); PG8_WAIT_L(0); PG8_BAR; PG8_MMA(1, 0, At, B0); PG8_MMA(1, 1, At, B1); PG8_BAR; PG8_SCHED;
            } else {
            PG8_LDB(B0, 0, 0); PG8_SCHED; PG8_LDA(At, 0, 0); PG8_STAGE(PG8_SA(1, 1), a1 + hstep, voffA);
            PG8_WAIT_L(8); PG8_BAR; PG8_WAIT_L(0); PG8_MMA(0, 0, At, B0); PG8_BAR; PG8_SCHED;
            PG8_LDB(B1, 0, 1); PG8_STAGE(PG8_SB(0, 0), b2, voffB);
            PG8_BAR; PG8_WAIT_L(0); PG8_MMA(0, 1, At, B1); PG8_BAR;
            PG8_LDA(At, 0, 1); PG8_STAGE(PG8_SA(0, 0), a2, voffA);
            PG8_BAR; PG8_WAIT_L(0); PG8_MMA(1, 0, At, B0); PG8_BAR; PG8_SCHED;
            PG8_STAGE(PG8_SB(0, 1), b2 + hstep, voffB);
            PG8_WAIT_V(6); PG8_BAR; PG8_MMA(1, 1, At, B1); PG8_BAR;
            PG8_LDB(B0, 1, 0); PG8_SCHED; PG8_LDA(At, 1, 0); PG8_STAGE(PG8_SA(0, 1), a2 + hstep, voffA);
            PG8_WAIT_L(8); PG8_BAR; PG8_WAIT_L(0); PG8_MMA(0, 0, At, B0); PG8_BAR; PG8_SCHED;
            PG8_LDB(B1, 1, 1); PG8_STAGE(PG8_SB(1, 0), b3, voffB);
            PG8_BAR; PG8_WAIT_L(0); PG8_MMA(0, 1, At, B1); PG8_BAR;
            PG8_LDA(At, 1, 1); PG8_STAGE(PG8_SA(1, 0), a3, voffA);
            PG8_BAR; PG8_WAIT_L(0); PG8_MMA(1, 0, At, B0); PG8_BAR; PG8_SCHED;
            PG8_STAGE(PG8_SB(1, 1), b3 + hstep, voffB);
            PG8_WAIT_V(6); PG8_BAR; PG8_MMA(1, 1, At, B1); PG8_BAR;
            }
        }
        if constexpr (ALIGN_EPI) { if (wr == 0) PG8_BAR; }
        if constexpr (!Epi::AFTER_DRAIN) { E(acc, cur, wr, wc, fr, fq); S.done(cur); }
        if (!has_next) break;
#pragma unroll
        for (int a = 0; a < 2; ++a)
#pragma unroll
            for (int b = 0; b < 2; ++b)
#pragma unroll
                for (int m = 0; m < 4; ++m)
#pragma unroll
                    for (int n = 0; n < 2; ++n) acc[a][b][m][n] = (f32x4){0.f, 0.f, 0.f, 0.f};
        cur = nxt; cA = nA; cB = nB; ++ui;
        if constexpr (ALIGN_EPI) { if (wr == 1) PG8_BAR; }
    }
    PG8_WAIT_V(0);
    if constexpr (!ALIGN_EPI) { if (wr == 0) PG8_BAR; }
    PG8_BAR;
#undef PG8_SA
#undef PG8_SB
#undef PG8_STAGE
#undef PG8_LDA
#undef PG8_LDB
#undef PG8_MMA
#undef PG8_WAIT_V
#undef PG8_WAIT_L
#undef PG8_BAR
#undef PG8_SCHED
}
}

constexpr int NWAVES = 8;
constexpr int N_LAUNCHES = MK_N_LAUNCHES;
constexpr int PER_PHASE = 10;
constexpr int BATCH = 16, SEQ = 2048, D = 1024, M = BATCH * SEQ;
constexpr int NH = 8, HD = 64, AW = 512, RW = 512;
constexpr int RWKV_COLS = 1792, IN_COLS = 3328, FF = 2816, NGU = 2 * FF, NLORA = 1536, KLORA = 256;
constexpr int PC_Q = 0, PC_K = 512, PC_V = 1024, PC_RW = 1536;
constexpr int RC_R = 0, RC_K = 512, RC_V = 1024, RC_L = 1536;
constexpr float NORM_EPS = 1e-6f, LNX_EPS = 64e-5f;
constexpr float LOG2E = 1.4426950408889634f;

constexpr size_t MiB = 1u << 20;
constexpr size_t WS_CTL = 0, CTL_ZERO_BYTES = 1 * MiB;
constexpr size_t WS_WIN = 2 * MiB;
constexpr size_t WS_WOUT = 9 * MiB;
constexpr size_t WS_WGU = 11 * MiB;
constexpr size_t WS_WDN = 22 * MiB;
constexpr size_t WS_WL = 28 * MiB;
constexpr size_t WS_BON = 29 * MiB;
constexpr size_t WS_SS = 30 * MiB;
constexpr size_t WS_XN = 32 * MiB;
constexpr size_t WS_PROJ = 96 * MiB;
constexpr size_t WS_A2 = 304 * MiB;
constexpr size_t WS_DAG = 320 * MiB;
constexpr size_t WS_ML = 416 * MiB;
constexpr size_t WS_END = 424 * MiB;
constexpr size_t DO_PO = 0, DO_Y = 96 * MiB;
constexpr int CW_TMO = 0, CW_CODE = 1;
constexpr int CW_BAR = 4096;
constexpr int CW_ATTQ = 8192;

constexpr int LDS_BYTES = 147456;
constexpr int RING_OFF = 0, RING_BYTES = LDS_BYTES - 1024;
constexpr int LDSCTL_OFF = RING_BYTES, MISC_OFF = LDSCTL_OFF + 320;

#define GAS __attribute__((address_space(1)))
#define LAS __attribute__((address_space(3)))
typedef unsigned short bf16;
typedef unsigned v4u __attribute__((ext_vector_type(4)));
typedef unsigned v2u __attribute__((ext_vector_type(2)));
typedef float f32x4 __attribute__((ext_vector_type(4)));
typedef float f32x2 __attribute__((ext_vector_type(2)));
typedef float f32x16 __attribute__((ext_vector_type(16)));
typedef short bf16x8 __attribute__((ext_vector_type(8)));
typedef short s16x4 __attribute__((ext_vector_type(4)));
typedef GAS unsigned gu32;
#define RLX_AGENT __ATOMIC_RELAXED, __HIP_MEMORY_SCOPE_AGENT
#define LDS_WAIT() asm volatile("s_waitcnt lgkmcnt(0)" ::: "memory")
#define VM_WAIT() asm volatile("s_waitcnt vmcnt(0)" ::: "memory")
__device__ __forceinline__ unsigned f2bf(float f) { unsigned u = __builtin_bit_cast(unsigned, f); return (u + 0x7fffu + ((u >> 16) & 1u)) >> 16; }
__device__ __forceinline__ unsigned pk2(float lo, float hi) { return f2bf(lo) | (f2bf(hi) << 16); }
__device__ __forceinline__ float bflo(unsigned w) { return __builtin_bit_cast(float, w << 16); }
__device__ __forceinline__ float bfhi(unsigned w) { return __builtin_bit_cast(float, w & 0xffff0000u); }
__device__ __forceinline__ float fsig(float x) { return __builtin_amdgcn_rcpf(1.0f + __builtin_amdgcn_exp2f(-LOG2E * x)); }

#define XB_TMO      128
#define XB_XCNT(j)  (256  + 64 * (j))
#define XB_XSUB(j)  (1280 + 64 * (j))
#define XB_XGEN(j)  (2304 + 64 * (j))
#define XB_TOP      3328
#define XB_TOPGEN   3392
#define XCD_BAR_WORDS 3456
#define XB_SPIN_CAP (1u << 18)
__device__ __forceinline__ unsigned xb_ld(unsigned* p)              { return __hip_atomic_load(p, __ATOMIC_RELAXED, __HIP_MEMORY_SCOPE_AGENT); }
__device__ __forceinline__ unsigned xb_add(unsigned* p, unsigned v) { return __hip_atomic_fetch_add(p, v, __ATOMIC_RELAXED, __HIP_MEMORY_SCOPE_AGENT); }
__device__ __forceinline__ unsigned xb_xcc_id() { return (unsigned)__builtin_amdgcn_s_getreg((3 << 11) | 20) & 0xFu; }
#define XB_SPIN(cond, bar) do { unsigned _sp = 0; while (cond) { __builtin_amdgcn_s_sleep(1); \
    if ((++_sp & 255u) == 0u) { if (xb_ld(&(bar)[XB_TMO])) break; if (_sp > XB_SPIN_CAP) { atomicAdd(&(bar)[XB_TMO], 1u); break; } } } } while (0)
struct XcdBarrier { unsigned* bar; unsigned x; volatile LAS unsigned* st; };
__device__ __forceinline__ XcdBarrier xcd_barrier_post(unsigned* bar, volatile LAS unsigned* st) {
    XcdBarrier b; b.bar = bar; b.x = xb_xcc_id(); b.st = st;
    if (threadIdx.x == 0) (void)xb_add(&bar[XB_XCNT(b.x)], 1u);
    return b;
}
__device__ __forceinline__ void xcd_barrier_complete(unsigned* bar, unsigned x, unsigned& nloc, unsigned& nx) {
    const unsigned G = gridDim.x * gridDim.y * gridDim.z;
    unsigned sum, cnt, mine, sp = 0u;
    for (;;) {
        sum = 0u; cnt = 0u; mine = 0u;
#pragma unroll
        for (unsigned j = 0; j < 16; ++j) { const unsigned c = xb_ld(&bar[XB_XCNT(j)]); sum += c; cnt += (c > 0u) ? 1u : 0u; mine = (j == x) ? c : mine; }
        if (sum == G) break;
        __builtin_amdgcn_s_sleep(1);
        if ((++sp & 255u) == 0u) { if (xb_ld(&bar[XB_TMO])) break; if (sp > XB_SPIN_CAP) { atomicAdd(&bar[XB_TMO], 1u); break; } }
    }
    nloc = mine > 0u ? mine : 1u; nx = cnt > 0u ? cnt : 1u;
}
__device__ __forceinline__ void xcd_barrier(const XcdBarrier& b) {
    asm volatile("s_waitcnt vmcnt(0)" ::: "memory");
    __syncthreads();
    if (threadIdx.x == 0) {
        unsigned* bar = b.bar;
        __builtin_amdgcn_s_waitcnt(0);
        unsigned nloc = b.st[0], nx = b.st[1];
        if (nloc == 0u) { xcd_barrier_complete(bar, b.x, nloc, nx); b.st[0] = nloc; b.st[1] = nx; }
        const unsigned old = xb_add(&bar[XB_XSUB(b.x)], 1u);
        const unsigned gen = old / nloc;
        if (old + 1u == (gen + 1u) * nloc) {
            __builtin_amdgcn_fence(__ATOMIC_RELEASE, "agent");
            asm volatile("s_waitcnt vmcnt(0)" ::: "memory");
            const unsigned og = xb_add(&bar[XB_TOP], 1u);
            const unsigned tg = og / nx;
            if (og + 1u == (tg + 1u) * nx) xb_add(&bar[XB_TOPGEN], 1u);
            else XB_SPIN(xb_ld(&bar[XB_TOPGEN]) == tg, bar);
            __builtin_amdgcn_fence(__ATOMIC_ACQUIRE, "agent");
            xb_add(&bar[XB_XGEN(b.x)], 1u);
            asm volatile("s_waitcnt vmcnt(0)" ::: "memory");
        } else {
            XB_SPIN(xb_ld(&bar[XB_XGEN(b.x)]) == gen, bar);
            __builtin_amdgcn_fence(__ATOMIC_ACQUIRE, "agent");
            asm volatile("s_waitcnt vmcnt(0)" ::: "memory");
        }
    }
    __syncthreads();
}

struct Frame {
    LAS unsigned char* lds;
    volatile LAS unsigned* MISC;
    gu32* ctl;
    int tid, lane, wave;
    int vcu, G;
    float* out; unsigned char* ws;
};
struct Args { const float* in[22]; float* out; unsigned char* ws; int ph_lo, ph_hi, li, pad; };
enum { I_X = 0, I_N1G, I_WIN, I_QNG, I_KNG, I_AOG, I_MU, I_W0, I_W2, I_A0, I_A2, I_G2, I_KK, I_KA, I_RK, I_LNG, I_LNB, I_WOUT, I_N2G, I_WG, I_WU, I_WD };

__device__ __forceinline__ float wave_sum(float v) {
#pragma unroll
    for (int o = 1; o < 64; o <<= 1) v += __shfl_xor(v, o);
    return v;
}
__device__ __forceinline__ float red16(float x) {
    x += __builtin_bit_cast(float, __builtin_amdgcn_update_dpp(0, __builtin_bit_cast(int, x), 0x128, 0xf, 0xf, false));
    x += __builtin_bit_cast(float, __builtin_amdgcn_update_dpp(0, __builtin_bit_cast(int, x), 0x124, 0xf, 0xf, false));
    x += __builtin_bit_cast(float, __builtin_amdgcn_update_dpp(0, __builtin_bit_cast(int, x), 0x122, 0xf, 0xf, false));
    x += __builtin_bit_cast(float, __builtin_amdgcn_update_dpp(0, __builtin_bit_cast(int, x), 0x121, 0xf, 0xf, false));
    return x;
}

__device__ __forceinline__ void p0_transpose_item(const float* W, int K, int N, bf16* WT, int rmode, LAS float* scr, int item, int lane, const float* ksc = nullptr) {
    const int nblk = N / 32, kb = item / nblk, nb = item % nblk, k0 = 64 * kb, n0 = 32 * nb;
    const int rbase = rmode == 0 ? n0 : rmode == 3 ? (n0 < 1024 ? ((n0 >> 8) * 256 + ((n0 >> 5) & 1) * 128 + ((n0 >> 6) & 3) * 32) : n0) : ((n0 >> 7) * 256 + (n0 & 127) + (rmode == 2 ? 128 : 0));
#pragma unroll 8
    for (int i = 0; i < 32; ++i) { const int kk = 2 * i + (lane >> 5); scr[kk * 33 + (lane & 31)] = W[(size_t)(k0 + kk) * N + n0 + (lane & 31)] * (ksc ? ksc[k0 + kk] : 1.0f); }
    LDS_WAIT(); asm volatile("" ::: "memory");
    const int c = lane & 7;
#pragma unroll
    for (int j = 0; j < 4; ++j) { const int n = (lane >> 3) + 8 * j; const LAS float* s = scr + (8 * c) * 33 + n;
        v4u o; o.x = pk2(s[0 * 33], s[1 * 33]); o.y = pk2(s[2 * 33], s[3 * 33]); o.z = pk2(s[4 * 33], s[5 * 33]); o.w = pk2(s[6 * 33], s[7 * 33]);
        *(GAS v4u*)(WT + (size_t)(rbase + n) * K + k0 + 8 * c) = o; }
    LDS_WAIT(); asm volatile("" ::: "memory");
}
__device__ __forceinline__ void rms_row_to_bf16(int lane, const float* xrow, const float* g, bf16* orow) {
    const GAS f32x4* xr = (const GAS f32x4*)xrow + lane;
    const GAS f32x4* gr = (const GAS f32x4*)g + lane;
    f32x4 v[4]; float s = 0.f;
#pragma unroll
    for (int j = 0; j < 4; ++j) { v[j] = xr[64 * j]; s += (v[j].x * v[j].x + v[j].y * v[j].y) + (v[j].z * v[j].z + v[j].w * v[j].w); }
    const float rstd = 1.f / sqrtf(wave_sum(s) * (1.f / D) + NORM_EPS);
    GAS unsigned long long* o8 = (GAS unsigned long long*)orow + lane;
#pragma unroll
    for (int j = 0; j < 4; ++j) { const f32x4 gg = gr[64 * j];
        o8[64 * j] = (unsigned long long)pk2(v[j].x * rstd * gg.x, v[j].y * rstd * gg.y) | ((unsigned long long)pk2(v[j].z * rstd * gg.z, v[j].w * rstd * gg.w) << 32); }
}

__device__ __forceinline__ void p0_prologue(Frame& F, const Args& AR) {
    LAS float* scr = (LAS float*)(F.lds + RING_OFF + F.wave * 16384);
    const int gw = F.vcu * NWAVES + F.wave, NGW = F.G * NWAVES;
    bf16* Win_t = (bf16*)(F.ws + WS_WIN); bf16* Wout_t = (bf16*)(F.ws + WS_WOUT); bf16* Wgu_t = (bf16*)(F.ws + WS_WGU); bf16* Wdn_t = (bf16*)(F.ws + WS_WDN); bf16* Wl_t = (bf16*)(F.ws + WS_WL);
    constexpr int I_IN = (D / 64) * (IN_COLS / 32), I_OUT = (D / 64) * (D / 32), I_G = (D / 64) * (FF / 32), I_DN = (FF / 64) * (D / 32);
    constexpr int NITEMS = I_IN + I_OUT + 2 * I_G + I_DN;
    for (int it = gw; it < NITEMS; it += NGW) {
        int r = it;
        if (r < I_IN) { p0_transpose_item(AR.in[I_WIN], D, IN_COLS, Win_t, 3, scr, r, F.lane); continue; } r -= I_IN;
        if (r < I_OUT) { p0_transpose_item(AR.in[I_WOUT], D, D, Wout_t, 0, scr, r, F.lane); continue; } r -= I_OUT;
        if (r < I_G) { p0_transpose_item(AR.in[I_WG], D, FF, Wgu_t, 1, scr, r, F.lane, AR.in[I_N2G]); continue; } r -= I_G;
        if (r < I_G) { p0_transpose_item(AR.in[I_WU], D, FF, Wgu_t, 2, scr, r, F.lane, AR.in[I_N2G]); continue; } r -= I_G;
        p0_transpose_item(AR.in[I_WD], FF, D, Wdn_t, 0, scr, r, F.lane);
    }
    for (int e = (F.vcu * NWAVES * 64 + F.tid); e < NLORA * KLORA; e += F.G * NWAVES * 64) {
        const int row = e / KLORA, k = e % KLORA, kind = row >> 9, c = row & 511; float v = 0.f;
        if (kind == 0) { if (k < 64) v = AR.in[I_W2][k * 512 + c]; }
        else if (kind == 1) { if (k >= 64 && k < 128) v = AR.in[I_A2][(k - 64) * 512 + c]; }
        else { if (k >= 128) v = AR.in[I_G2][(k - 128) * 512 + c]; }
        Wl_t[e] = (bf16)f2bf(v);
    }
    bf16* XN = (bf16*)(F.ws + WS_XN);
    for (int m = gw; m < M; m += NGW) rms_row_to_bf16(F.lane, AR.in[I_X] + (size_t)m * D, AR.in[I_N1G], XN + (size_t)m * D);
}

__device__ __forceinline__ void p2_prep(Frame& F, const Args& AR) {
    const int gw = F.vcu * NWAVES + F.wave, NGW = F.G * NWAVES, lane = F.lane;
    const bf16* PROJ = (const bf16*)(F.ws + WS_PROJ); bf16* A2 = (bf16*)(F.ws + WS_A2);
    const f32x4 mu4 = *(const f32x4*)(AR.in[I_MU] + RC_L + 4 * lane);
    for (int m = gw; m < M; m += NGW) {
        const bf16* row = PROJ + (size_t)m * IN_COLS;
        const v2u cu = *(const v2u*)(row + PC_RW + RC_L + 4 * lane);
        v2u pv = (v2u){0u, 0u};
        if ((m & (SEQ - 1)) != 0) pv = *(const v2u*)(row - IN_COLS + PC_RW + RC_L + 4 * lane);
        float c4[4] = {bflo(cu.x), bfhi(cu.x), bflo(cu.y), bfhi(cu.y)}, p4[4] = {bflo(pv.x), bfhi(pv.x), bflo(pv.y), bfhi(pv.y)};
        float xs[4];
#pragma unroll
        for (int i = 0; i < 4; ++i) { const float v = c4[i] + (p4[i] - c4[i]) * mu4[i];
            if (lane < 16) { const float t = __builtin_amdgcn_exp2f(2.f * LOG2E * v); xs[i] = 1.f - 2.f * __builtin_amdgcn_rcpf(t + 1.f); }
            else if (lane < 32) xs[i] = v;
            else xs[i] = fsig(v); }
        *(v2u*)(A2 + (size_t)m * KLORA + 4 * lane) = (v2u){pk2(xs[0], xs[1]), pk2(xs[2], xs[3])};
    }
}

constexpr int CS = 16, NCHUNK = SEQ / CS, NHELP = 4, NSTATE = 4, NIT = (NCHUNK + NHELP - 1) / NHELP;
constexpr int SL_A = 0, SL_R = 2048, SL_B = 4096, SL_K = 6144, SL_V = 8192, SL_T = 10240, SL_LAK = 10752, SL_LRB = 11264, SL_LRK = 11776, SL_G = 12288, SL_BYTES = 12544;
constexpr int SC_CONST = 2 * NHELP * SL_BYTES;
constexpr int SC_YL = SC_CONST + 6 * 64 * 4, YL_BYTES = NHELP * CS * 64 * 2;
static_assert(SC_YL + 2 * YL_BYTES <= RING_BYTES && NHELP * CS * 8 == NWAVES * 64, "scan LDS");
struct HReg { v4u r[2], k[2], v[2], pr[2], pk[2], pv[2], e[2], a[2]; };
__device__ __forceinline__ void helper_load(HReg& R, const bf16* PROJ, const bf16* DAG, int tok, int h, int kg) {
    const GAS bf16* row = (const GAS bf16*)PROJ + (size_t)tok * IN_COLS + PC_RW + h * 64 + 16 * kg;
    const GAS bf16* rowp = row - IN_COLS;
    const GAS bf16* dr = (const GAS bf16*)DAG + (size_t)tok * NLORA + h * 64 + 16 * kg;
    asm volatile("" : "+v"(row)); asm volatile("" : "+v"(rowp)); asm volatile("" : "+v"(dr));
    const bool hp = (tok & (SEQ - 1)) != 0;
#pragma unroll
    for (int i = 0; i < 2; ++i) {
        R.r[i] = *(const GAS v4u*)(row + RC_R + 8 * i); R.k[i] = *(const GAS v4u*)(row + RC_K + 8 * i); R.v[i] = *(const GAS v4u*)(row + RC_V + 8 * i);
        if (hp) { R.pr[i] = *(const GAS v4u*)(rowp + RC_R + 8 * i); R.pk[i] = *(const GAS v4u*)(rowp + RC_K + 8 * i); R.pv[i] = *(const GAS v4u*)(rowp + RC_V + 8 * i); }
        else { R.pr[i] = (v4u){0u, 0u, 0u, 0u}; R.pk[i] = R.pr[i]; R.pv[i] = R.pr[i]; }
        R.e[i] = *(const GAS v4u*)(dr + 8 * i); R.a[i] = *(const GAS v4u*)(dr + 512 + 8 * i);
    }
}
__device__ __forceinline__ void unpack4(const unsigned w0, const unsigned w1, float (&x)[4]) { x[0] = bflo(w0); x[1] = bfhi(w0); x[2] = bflo(w1); x[3] = bfhi(w1); }
__device__ __forceinline__ float dpp_shr(float x, const int ctrl_sel) {
    int r;
    if (ctrl_sel == 1) r = __builtin_amdgcn_update_dpp(0, __builtin_bit_cast(int, x), 0x111, 0xf, 0xf, true);
    else if (ctrl_sel == 2) r = __builtin_amdgcn_update_dpp(0, __builtin_bit_cast(int, x), 0x112, 0xf, 0xf, true);
    else if (ctrl_sel == 4) r = __builtin_amdgcn_update_dpp(0, __builtin_bit_cast(int, x), 0x114, 0xf, 0xf, true);
    else r = __builtin_amdgcn_update_dpp(0, __builtin_bit_cast(int, x), 0x118, 0xf, 0xf, true);
    return __builtin_bit_cast(float, r);
}
typedef float f32x2_t __attribute__((ext_vector_type(2))); typedef __bf16 bf16x2_t __attribute__((ext_vector_type(2)));
__device__ __forceinline__ unsigned cvt2(float lo, float hi) { f32x2_t v = {lo, hi}; bf16x2_t b = __builtin_convertvector(v, bf16x2_t); return __builtin_bit_cast(unsigned, b); }
__device__ __forceinline__ bf16x8 mk8(unsigned a, unsigned b, unsigned c, unsigned d) { return __builtin_bit_cast(bf16x8, (v4u){a, b, c, d}); }
__device__ __forceinline__ bf16x8 accB(const f32x4 v) { return mk8(cvt2(v[0], v[1]), cvt2(v[2], v[3]), 0u, 0u); }
__device__ __forceinline__ v2u trd(const LAS unsigned char* p) { typedef short v4i16_t __attribute__((ext_vector_type(4)));
    return __builtin_bit_cast(v2u, __builtin_amdgcn_ds_read_tr16_b64_v4i16((LAS v4i16_t*)p)); }
#define MFMA16(a, b, c) __builtin_amdgcn_mfma_f32_16x16x32_bf16((a), (b), (c), 0, 0, 0)
#define PIN_PTR(p) asm volatile("" : "+v"(p))

#define HR_UNPACK(dst, arr, gp) do { if ((gp) & 1) unpack4(R.arr[(gp) >> 1].z, R.arr[(gp) >> 1].w, dst); else unpack4(R.arr[(gp) >> 1].x, R.arr[(gp) >> 1].y, dst); } while (0)
__device__ __forceinline__ void helper_chunk(LAS unsigned char* slot, const LAS float* cst, HReg& R, bool prefetch, const bf16* PROJ, const bf16* DAG, float* BON, int tok, int h, int lane) {
    const int t = lane & 15, kg = lane >> 4;
    LAS unsigned char* p_row = slot + t * 128 + kg * 16;
    LAS unsigned char* p_v = slot + SL_V + t * 128 + kg * 32;
    LAS unsigned char* p_tw = slot + t * 32 + kg * 8;
    const LAS unsigned char* p_tr = slot + (4 * kg + ((lane & 15) >> 2)) * 32 + (lane & 3) * 8;
    LAS unsigned char* p_g = slot + SL_G + kg * 16;
    const LAS float* p_c = cst + 16 * kg;
    PIN_PTR(p_row); PIN_PTR(p_v); PIN_PTR(p_tw); PIN_PTR(p_tr); PIN_PTR(p_g); PIN_PTR(p_c);
    float ss = 0.f;
#pragma unroll
    for (int gp = 0; gp < 4; ++gp) {
        float k[4], pk[4]; HR_UNPACK(k, k, gp); HR_UNPACK(pk, pk, gp);
        const f32x4 muk = *(const LAS f32x4*)(p_c + 1 * 64 + 4 * gp), kkc = *(const LAS f32x4*)(p_c + 3 * 64 + 4 * gp);
#pragma unroll
        for (int i = 0; i < 4; ++i) { const float kv = (k[i] + (pk[i] - k[i]) * muk[i]) * kkc[i]; ss += kv * kv; }
    }
    ss += __shfl_xor(ss, 16); ss += __shfl_xor(ss, 32);
    const float inv = 1.f / fmaxf(sqrtf(ss), 1e-12f);
#pragma unroll
    for (int i = 0; i < 2; ++i) { asm volatile("" : "+v"(R.k[i])); asm volatile("" : "+v"(R.pk[i])); }
    unsigned fa[4], fr[4], fb[4], fk[4];
    float bon = 0.f;
#pragma unroll
    for (int gp = 0; gp < 4; ++gp) {
        float r[4], k[4], v[4], pr[4], pk[4], pv[4], a[4], e[4];
        HR_UNPACK(r, r, gp); HR_UNPACK(k, k, gp); HR_UNPACK(v, v, gp); HR_UNPACK(pr, pr, gp); HR_UNPACK(pk, pk, gp); HR_UNPACK(pv, pv, gp); HR_UNPACK(a, a, gp); HR_UNPACK(e, e, gp);
        const f32x4 mur = *(const LAS f32x4*)(p_c + 0 * 64 + 4 * gp), muk = *(const LAS f32x4*)(p_c + 1 * 64 + 4 * gp), muv = *(const LAS f32x4*)(p_c + 2 * 64 + 4 * gp);
        const f32x4 kkc = *(const LAS f32x4*)(p_c + 3 * 64 + 4 * gp), kac = *(const LAS f32x4*)(p_c + 4 * 64 + 4 * gp), rkc = *(const LAS f32x4*)(p_c + 5 * 64 + 4 * gp);
        float xv[4], At[4], Rt[4], Bt[4], Kt[4]; f32x4 gv;
#pragma unroll
        for (int i = 0; i < 4; ++i) {
            const float xr = r[i] + (pr[i] - r[i]) * mur[i], xk = k[i] + (pk[i] - k[i]) * muk[i]; xv[i] = v[i] + (pv[i] - v[i]) * muv[i];
            const float kn = xk * kkc[i] * inv, kpv = xk * (1.f + (a[i] - 1.f) * kac[i]); bon += xr * kpv * rkc[i];
            float x = e[i];
            x += dpp_shr(x, 1); x += dpp_shr(x, 2); x += dpp_shr(x, 4); x += dpp_shr(x, 8);
            const float g = __builtin_amdgcn_exp2f(LOG2E * x), gi = __builtin_amdgcn_exp2f(-LOG2E * x); float gpv = dpp_shr(g, 1); gpv = (t == 0) ? 1.f : gpv;
            At[i] = -kn * gpv; Rt[i] = xr * g; Bt[i] = kn * a[i] * gi; Kt[i] = kpv * gi; gv[i] = g;
            if (i == 1) __builtin_amdgcn_sched_barrier(0); }
        *(LAS v2u*)(p_v + gp * 8) = (v2u){cvt2(xv[0], xv[1]), cvt2(xv[2], xv[3])};
        if (t == 15) *(LAS f32x4*)(p_g + gp * 64) = gv;
        const int hf = gp & 1;
        fa[2 * hf] = cvt2(At[0], At[1]); fa[2 * hf + 1] = cvt2(At[2], At[3]); fr[2 * hf] = cvt2(Rt[0], Rt[1]); fr[2 * hf + 1] = cvt2(Rt[2], Rt[3]);
        fb[2 * hf] = cvt2(Bt[0], Bt[1]); fb[2 * hf + 1] = cvt2(Bt[2], Bt[3]); fk[2 * hf] = cvt2(Kt[0], Kt[1]); fk[2 * hf + 1] = cvt2(Kt[2], Kt[3]);
        if (hf) {
            const int ko = (gp >> 1) * 64;
            *(LAS v4u*)(p_row + SL_A + ko) = (v4u){fa[0], fa[1], fa[2], fa[3]}; *(LAS v4u*)(p_row + SL_R + ko) = (v4u){fr[0], fr[1], fr[2], fr[3]};
            *(LAS v4u*)(p_row + SL_B + ko) = (v4u){fb[0], fb[1], fb[2], fb[3]}; *(LAS v4u*)(p_row + SL_K + ko) = (v4u){fk[0], fk[1], fk[2], fk[3]};
        }
        __builtin_amdgcn_sched_barrier(0);
    }
    bon += __shfl_xor(bon, 16); bon += __shfl_xor(bon, 32);
    if (kg == 0) BON[(size_t)tok * NH + h] = bon;
    if (prefetch) helper_load(R, PROJ, DAG, tok + NHELP * CS, h, kg);
    const bf16x8 FA0 = *(const LAS bf16x8*)(p_row + SL_A), FA1 = *(const LAS bf16x8*)(p_row + SL_A + 64), FR0 = *(const LAS bf16x8*)(p_row + SL_R), FR1 = *(const LAS bf16x8*)(p_row + SL_R + 64);
    const bf16x8 FB0 = *(const LAS bf16x8*)(p_row + SL_B), FB1 = *(const LAS bf16x8*)(p_row + SL_B + 64), FK0 = *(const LAS bf16x8*)(p_row + SL_K), FK1 = *(const LAS bf16x8*)(p_row + SL_K + 64);
    const f32x4 z4 = (f32x4){0.f, 0.f, 0.f, 0.f};
    f32x4 Lab = MFMA16(FA0, FB0, z4); Lab = MFMA16(FA1, FB1, Lab);
    f32x4 Lak = MFMA16(FA0, FK0, z4); Lak = MFMA16(FA1, FK1, Lak);
    f32x4 Lrb = MFMA16(FR0, FB0, z4); Lrb = MFMA16(FR1, FB1, Lrb);
    f32x4 Lrk = MFMA16(FR0, FK0, z4); Lrk = MFMA16(FR1, FK1, Lrk);
    const int s = t;
#pragma unroll
    for (int r = 0; r < 4; ++r) { const int tt = 4 * kg + r;
        Lab[r] = tt > s ? Lab[r] : 0.f; Lak[r] = tt > s ? Lak[r] : 0.f; Lrb[r] = tt >= s ? Lrb[r] : 0.f; Lrk[r] = tt >= s ? Lrk[r] : 0.f; }
#define WR_TILE(off, X) (*(LAS v2u*)(p_tw + (off)) = (v2u){cvt2((X)[0], (X)[1]), cvt2((X)[2], (X)[3])})
#define RD_AFRAG(dst, off) do { const v2u w_ = trd(p_tr + (off)); dst = mk8(w_.x, w_.y, 0u, 0u); } while (0)
    WR_TILE(SL_LAK, Lak); WR_TILE(SL_LRB, Lrb); WR_TILE(SL_LRK, Lrk);
    bf16x8 AL1, AL2, AL4;
    WR_TILE(SL_T, Lab); RD_AFRAG(AL1, SL_T);
    f32x4 L2 = MFMA16(AL1, accB(Lab), z4);
    WR_TILE(SL_T, L2); RD_AFRAG(AL2, SL_T);
    f32x4 L4 = MFMA16(AL2, accB(L2), z4);
    WR_TILE(SL_T, L4); RD_AFRAG(AL4, SL_T);
    f32x4 Rm = MFMA16(AL4, accB(L4), z4);
#pragma unroll
    for (int r = 0; r < 4; ++r) Rm[r] += (4 * kg + r == s) ? 1.f : 0.f;
    Rm = MFMA16(AL4, accB(Rm), Rm);
    Rm = MFMA16(AL2, accB(Rm), Rm);
    Rm = MFMA16(AL1, accB(Rm), Rm);
    WR_TILE(SL_T, Rm);
#undef WR_TILE
#undef RD_AFRAG
}

__device__ __forceinline__ void state_chunk(const LAS unsigned char* slot, f32x4 (&X)[4], LAS unsigned char* yl, int lane, int wv) {
    const int c = lane & 15, g = lane >> 4, q4 = 4 * g + (c >> 2), pp = c & 3;
    const f32x4 z4 = (f32x4){0.f, 0.f, 0.f, 0.f};
    const LAS unsigned char* p128 = slot + c * 128 + g * 16;
    const LAS unsigned char* p_bt = slot + q4 * 128 + pp * 16;
    const LAS unsigned char* p_tr = slot + q4 * 32 + pp * 8;
    const LAS unsigned char* p_v = slot + SL_V + q4 * 128 + wv * 32 + pp * 8;
    const LAS unsigned char* pg = slot + SL_G + g * 16;
    PIN_PTR(p128); PIN_PTR(p_bt); PIN_PTR(p_tr); PIN_PTR(p_v); PIN_PTR(pg);
    const bf16x8 xb0 = mk8(cvt2(X[0][0], X[0][1]), cvt2(X[0][2], X[0][3]), cvt2(X[1][0], X[1][1]), cvt2(X[1][2], X[1][3]));
    const bf16x8 xb1 = mk8(cvt2(X[2][0], X[2][1]), cvt2(X[2][2], X[2][3]), cvt2(X[3][0], X[3][1]), cvt2(X[3][2], X[3][3]));
    const bf16x8 a0 = *(const LAS bf16x8*)(p128 + SL_A), a1 = *(const LAS bf16x8*)(p128 + SL_A + 64);
    const bf16x8 r0 = *(const LAS bf16x8*)(p128 + SL_R), r1 = *(const LAS bf16x8*)(p128 + SL_R + 64);
    const v2u vt = trd(p_v), lak = trd(p_tr + SL_LAK), tt = trd(p_tr + SL_T), lrb = trd(p_tr + SL_LRB), lrk = trd(p_tr + SL_LRK);
    f32x4 Z = MFMA16(a0, xb0, z4); Z = MFMA16(a1, xb1, Z); Z = MFMA16(mk8(lak.x, lak.y, 0u, 0u), mk8(vt.x, vt.y, 0u, 0u), Z);
    const f32x4 U = MFMA16(mk8(tt.x, tt.y, 0u, 0u), accB(Z), z4);
    const bf16x8 uv = mk8(cvt2(U[0], U[1]), cvt2(U[2], U[3]), vt.x, vt.y);
    f32x4 Y = MFMA16(r0, xb0, z4); Y = MFMA16(r1, xb1, Y); Y = MFMA16(mk8(lrb.x, lrb.y, lrk.x, lrk.y), uv, Y);
#pragma unroll
    for (int jb = 0; jb < 4; ++jb) {
        const v2u bb = trd(p_bt + SL_B + (jb >> 1) * 64 + (jb & 1) * 8), kk2 = trd(p_bt + SL_K + (jb >> 1) * 64 + (jb & 1) * 8);
        const f32x4 gm = *(const LAS f32x4*)(pg + jb * 64);
        X[jb] = MFMA16(mk8(bb.x, bb.y, kk2.x, kk2.y), uv, X[jb]) * gm;
    }
    LAS unsigned char* py = yl + (4 * g) * 128 + (16 * wv + c) * 2;
    PIN_PTR(py);
#pragma unroll
    for (int r = 0; r < 4; ++r) *(LAS unsigned short*)(py + r * 128) = (unsigned short)f2bf(Y[r]);
}

__device__ __forceinline__ void p4_scan(Frame& F, const Args& AR) {
    const bf16* PROJ = (const bf16*)(F.ws + WS_PROJ); const bf16* DAG = (const bf16*)(F.ws + WS_DAG);
    float* BON = (float*)(F.ws + WS_BON); bf16* Y = (bf16*)((unsigned char*)F.out + DO_Y);
    LAS unsigned char* lds = F.lds + RING_OFF;
    LAS float* cst = (LAS float*)(lds + SC_CONST);
    const int tid = F.tid, lane = F.lane, wave = F.wave;
    for (int unit = blockIdx.x; unit < BATCH * NH; unit += F.G) {
        const int b = unit >> 3, h = unit & 7;
        const int tok0 = b * SEQ;
        if (tid < 384) { const int a = tid >> 6, c = tid & 63; const float* src = a == 0 ? AR.in[I_MU] + RC_R : a == 1 ? AR.in[I_MU] + RC_K : a == 2 ? AR.in[I_MU] + RC_V : a == 3 ? AR.in[I_KK] : a == 4 ? AR.in[I_KA] : AR.in[I_RK];
            cst[a * 64 + c] = src[h * 64 + c]; }
        __syncthreads();
        const int st_k = tid >> 7, st_t = (tid >> 3) & 15, st_p = tid & 7;
        GAS v4u* ystore = (GAS v4u*)((GAS bf16*)Y + (size_t)(tok0 + st_k * CS + st_t) * RW + h * 64 + 8 * st_p);
        const LAS unsigned char* yl_rd = lds + SC_YL + st_k * (CS * 128) + st_t * 128 + st_p * 16;
        if (wave >= NSTATE) {
            const int hw = wave - NSTATE, kg = lane >> 4, tokl = tok0 + (lane & 15);
            HReg R;
            helper_load(R, PROJ, DAG, tokl + hw * CS, h, kg);
            for (int it = 0; it <= NIT + 1; ++it) {
                if (it >= 2 && NHELP * (it - 2) + st_k < NCHUNK) ystore[(size_t)(NHELP * (it - 2)) * CS * RW / 8] = *(const LAS v4u*)(yl_rd + (it & 1) * YL_BYTES);
                const int ch = NHELP * it + hw;
                if (ch < NCHUNK) helper_chunk(lds + ((it & 1) * NHELP + hw) * SL_BYTES, cst, R, ch + NHELP < NCHUNK, PROJ, DAG, BON, tokl + ch * CS, h, lane);
                __syncthreads();
            }
        } else {
            f32x4 X[4];
#pragma unroll
            for (int jb = 0; jb < 4; ++jb) X[jb] = (f32x4){0.f, 0.f, 0.f, 0.f};
            __builtin_amdgcn_s_setprio(3);
            for (int it = 0; it <= NIT + 1; ++it) {
                if (it >= 2 && NHELP * (it - 2) + st_k < NCHUNK) ystore[(size_t)(NHELP * (it - 2)) * CS * RW / 8] = *(const LAS v4u*)(yl_rd + (it & 1) * YL_BYTES);
                if (it > 0) {
                    for (int k = 0; k < NHELP; ++k) { const int ch = NHELP * (it - 1) + k;
                        if (ch < NCHUNK) state_chunk(lds + (((it - 1) & 1) * NHELP + k) * SL_BYTES, X, lds + SC_YL + ((it - 1) & 1) * YL_BYTES + k * (CS * 128), lane, wave); }
                }
                __syncthreads();
            }
            __builtin_amdgcn_s_setprio(0);
        }
        __syncthreads();
    }
}

__device__ __forceinline__ s16x4 vtr(const LAS unsigned char* p) { typedef short v4i16_t __attribute__((ext_vector_type(4)));
    return __builtin_bit_cast(s16x4, __builtin_amdgcn_ds_read_tr16_b64_v4i16((LAS v4i16_t*)p)); }
constexpr int ATT_UNITS = 3 * BATCH * NH * 16;
__device__ __forceinline__ void p4_attn(Frame& F, const Args& AR) {
    const bf16* PROJ = (const bf16*)(F.ws + WS_PROJ);
    bf16* PO = (bf16*)((unsigned char*)F.out + DO_PO); float* ML = (float*)(F.ws + WS_ML);
    const int tid = F.tid, lane = F.lane, wave = F.wave, half = wave >> 2, wq = wave & 3, th = tid & 255;
    const int r32 = lane & 31, hi = lane >> 5;
    LAS unsigned char* Kl = F.lds + RING_OFF + half * 65536; LAS unsigned char* Vl = Kl + 32768;
    gu32* qctr = F.ctl + CW_ATTQ;
    for (;;) {
        if (tid == 0) F.MISC[16] = __hip_atomic_fetch_add(qctr, 1u, RLX_AGENT);
        __syncthreads();
        const int up = (int)F.MISC[16];
        if (up >= ATT_UNITS / 2) break;
        const int unit = 2 * up + half;
        const int pat = unit / (BATCH * NH * 16), rem = unit % (BATCH * NH * 16), bh = rem >> 4, i16 = rem & 15, b = bh >> 3, h = bh & 7;
        const int dil = pat == 0 ? 1 : (pat == 1 ? 4 : 16);
        const int res = pat == 0 ? 0 : (pat == 1 ? (i16 >> 2) : i16);
        const int n = pat == 0 ? i16 : (pat == 1 ? (i16 & 3) : 0);
        const size_t rowb = (size_t)b * SEQ;
        {
            const int c = th & 7;
#pragma unroll
            for (int i = 0; i < 8; ++i) {
                const int key = (th >> 3) + 32 * i; const int sub = 128 * (n - 1) + key;
                v4u kv = (v4u){0u, 0u, 0u, 0u}, vv = kv;
                if (sub >= 0) { const bf16* src = PROJ + (rowb + res + dil * sub) * IN_COLS + h * 64 + 8 * c; kv = *(const v4u*)(src + PC_K); vv = *(const v4u*)(src + PC_V); }
                *(LAS v4u*)(Kl + key * 128 + ((c ^ ((key >> 1) & 7)) * 16)) = kv;
                *(LAS v4u*)(Vl + (c >> 2) * 16384 + key * 64 + (c & 3) * 16) = vv;
            }
        }
        const int ql = 32 * wq + r32; const size_t qrow = rowb + res + dil * (128 * n + ql);
        bf16x8 qf[4];
#pragma unroll
        for (int d0 = 0; d0 < 4; ++d0) qf[d0] = *(const bf16x8*)(PROJ + qrow * IN_COLS + PC_Q + h * 64 + 16 * d0 + 8 * hi);
        __syncthreads();
        const float slope2 = __builtin_amdgcn_exp2f(-(float)(h + 1)) * (float)dil * LOG2E;
        const int thr = r32 - 4 * hi;
        f32x16 sc[5];
        float mx = -INFINITY;
#pragma unroll
        for (int kt = 0; kt < 5; ++kt) {
            const bool skip = (n == 0) && (wq + kt < 4);
            f32x16 acc;
            if (!skip) {
                const int key = 32 * (wq + kt) + r32;
                const float bk = -slope2 * (float)(128 - 32 * kt + thr);
#pragma unroll
                for (int r = 0; r < 16; ++r) acc[r] = slope2 * (float)((r & 3) + 8 * (r >> 2)) + bk;
#pragma unroll
                for (int d0 = 0; d0 < 4; ++d0) {
                    const bf16x8 kf = *(const LAS bf16x8*)(Kl + key * 128 + (((2 * d0 + hi) ^ ((key >> 1) & 7)) * 16));
                    acc = __builtin_amdgcn_mfma_f32_32x32x16_bf16(kf, qf[d0], acc, 0, 0, 0);
                }
                if (kt == 0) {
#pragma unroll
                    for (int r = 0; r < 16; ++r) acc[r] = ((r & 3) + 8 * (r >> 2)) >= thr ? acc[r] : -INFINITY;
                }
                if (kt == 4) {
#pragma unroll
                    for (int r = 0; r < 16; ++r) acc[r] = ((r & 3) + 8 * (r >> 2)) <= thr ? acc[r] : -INFINITY;
                }
#pragma unroll
                for (int r = 0; r < 16; ++r) mx = fmaxf(mx, acc[r]);
            } else {
#pragma unroll
                for (int r = 0; r < 16; ++r) acc[r] = -INFINITY;
            }
            sc[kt] = acc;
            __builtin_amdgcn_sched_barrier(0);
        }
        mx = fmaxf(mx, __shfl_xor(mx, 32));
        float l = 0.f;
#pragma unroll
        for (int kt = 0; kt < 5; ++kt)
#pragma unroll
            for (int r = 0; r < 16; ++r) { const float p = __builtin_amdgcn_exp2f(sc[kt][r] - mx); sc[kt][r] = p; l += p; }
        l += __shfl_xor(l, 32);
        f32x16 o[2]; o[0] = f32x16{}; o[1] = f32x16{};
        const int voff = ((lane >> 4) & 1) * 32 + (lane & 3) * 8 + (4 * hi + ((lane & 15) >> 2)) * 64;
#pragma unroll
        for (int kt = 0; kt < 5; ++kt) {
            const bool skip = (n == 0) && (wq + kt < 4);
            if (!skip) {
#pragma unroll
            for (int s2 = 0; s2 < 2; ++s2) {
                v4u pw;
                pw.x = pg8::cvt_pk_bf16(sc[kt][8 * s2 + 0], sc[kt][8 * s2 + 1]); pw.y = pg8::cvt_pk_bf16(sc[kt][8 * s2 + 2], sc[kt][8 * s2 + 3]);
                pw.z = pg8::cvt_pk_bf16(sc[kt][8 * s2 + 4], sc[kt][8 * s2 + 5]); pw.w = pg8::cvt_pk_bf16(sc[kt][8 * s2 + 6], sc[kt][8 * s2 + 7]);
                const bf16x8 pf = __builtin_bit_cast(bf16x8, pw);
                const int kb = 32 * (wq + kt) + 16 * s2;
#pragma unroll
                for (int dt = 0; dt < 2; ++dt) {
                    const LAS unsigned char* vp = Vl + dt * 16384 + kb * 64 + voff;
                    const s16x4 lo = vtr(vp), hi4 = vtr(vp + 8 * 64);
                    const bf16x8 vf = (bf16x8){lo[0], lo[1], lo[2], lo[3], hi4[0], hi4[1], hi4[2], hi4[3]};
                    o[dt] = __builtin_amdgcn_mfma_f32_32x32x16_bf16(vf, pf, o[dt], 0, 0, 0);
                }
            }
            }
        }
        const float rl = 1.f / l;
        bf16* po = PO + ((size_t)pat * M + qrow) * AW + h * 64;
#pragma unroll
        for (int dt = 0; dt < 2; ++dt)
#pragma unroll
            for (int g = 0; g < 4; ++g) {
                const v2u w = (v2u){pk2(o[dt][4 * g] * rl, o[dt][4 * g + 1] * rl), pk2(o[dt][4 * g + 2] * rl, o[dt][4 * g + 3] * rl)};
                *(v2u*)(po + 32 * dt + 8 * g + 4 * hi) = w;
            }
        if (hi == 0) *(f32x2*)(ML + (((size_t)pat * M + qrow) * NH + h) * 2) = (f32x2){mx, l};
        __syncthreads();
    }
}

__device__ __forceinline__ void p5_post(Frame& F, const Args& AR) {
    const int gw = F.vcu * NWAVES + F.wave, NGW = F.G * NWAVES, lane = F.lane, hd = lane >> 3;
    const bf16* PROJ = (const bf16*)(F.ws + WS_PROJ); const bf16* DAG = (const bf16*)(F.ws + WS_DAG); const float* BON = (const float*)(F.ws + WS_BON);
    const bf16* PO = (const bf16*)((unsigned char*)F.out + DO_PO); const float* ML = (const float*)(F.ws + WS_ML); const bf16* Y = (const bf16*)((unsigned char*)F.out + DO_Y);
    bf16* MIX = (bf16*)(F.ws + WS_XN);
    float aog[8], lng[8], lnb[8], muv[8];
#pragma unroll
    for (int i = 0; i < 8; ++i) { aog[i] = AR.in[I_AOG][8 * lane + i]; lng[i] = AR.in[I_LNG][8 * lane + i]; lnb[i] = AR.in[I_LNB][8 * lane + i]; muv[i] = AR.in[I_MU][RC_V + 8 * lane + i]; }
    for (int m = gw; m < M; m += NGW) {
        float mp[3], lp[3];
#pragma unroll
        for (int p = 0; p < 3; ++p) { const f32x2 t = *(const f32x2*)(ML + (((size_t)p * M + m) * NH + hd) * 2); mp[p] = t.x; lp[p] = t.y; }
        const float mm = fmaxf(fmaxf(mp[0], mp[1]), mp[2]);
        float wp[3], wsum = 0.f;
#pragma unroll
        for (int p = 0; p < 3; ++p) { wp[p] = __builtin_amdgcn_exp2f(mp[p] - mm) * lp[p]; wsum += wp[p]; }
        const float rws = 1.f / wsum;
        float at[8] = {0.f, 0.f, 0.f, 0.f, 0.f, 0.f, 0.f, 0.f};
#pragma unroll
        for (int p = 0; p < 3; ++p) { const v4u w = *(const v4u*)(PO + ((size_t)p * M + m) * AW + 8 * lane); const float f = wp[p] * rws;
            at[0] += f * bflo(w.x); at[1] += f * bfhi(w.x); at[2] += f * bflo(w.y); at[3] += f * bfhi(w.y); at[4] += f * bflo(w.z); at[5] += f * bfhi(w.z); at[6] += f * bflo(w.w); at[7] += f * bfhi(w.w); }
        float ss = 0.f;
#pragma unroll
        for (int i = 0; i < 8; ++i) ss += at[i] * at[i];
        ss += __shfl_xor(ss, 1); ss += __shfl_xor(ss, 2); ss += __shfl_xor(ss, 4);
        const float rstd = 1.f / sqrtf(ss * (1.f / 64.f) + NORM_EPS);
        v4u oa; oa.x = pk2(at[0] * rstd * aog[0], at[1] * rstd * aog[1]); oa.y = pk2(at[2] * rstd * aog[2], at[3] * rstd * aog[3]);
        oa.z = pk2(at[4] * rstd * aog[4], at[5] * rstd * aog[5]); oa.w = pk2(at[6] * rstd * aog[6], at[7] * rstd * aog[7]);
        *(v4u*)(MIX + (size_t)m * D + 8 * lane) = oa;
        const v4u yw = *(const v4u*)(Y + (size_t)m * RW + 8 * lane);
        float y[8] = {bflo(yw.x), bfhi(yw.x), bflo(yw.y), bfhi(yw.y), bflo(yw.z), bfhi(yw.z), bflo(yw.w), bfhi(yw.w)};
        float sm = 0.f;
#pragma unroll
        for (int i = 0; i < 8; ++i) sm += y[i];
        sm += __shfl_xor(sm, 1); sm += __shfl_xor(sm, 2); sm += __shfl_xor(sm, 4);
        const float mean = sm * (1.f / 64.f); float sv = 0.f;
#pragma unroll
        for (int i = 0; i < 8; ++i) { y[i] -= mean; sv += y[i] * y[i]; }
        sv += __shfl_xor(sv, 1); sv += __shfl_xor(sv, 2); sv += __shfl_xor(sv, 4);
        const float rs = 1.f / sqrtf(sv * (1.f / 64.f) + LNX_EPS);
        const bf16* prow = PROJ + (size_t)m * IN_COLS + PC_RW + RC_V + 8 * lane;
        const v4u vc = *(const v4u*)prow; v4u vp = (v4u){0u, 0u, 0u, 0u};
        if ((m & (SEQ - 1)) != 0) vp = *(const v4u*)(prow - IN_COLS);
        const v4u gw4 = *(const v4u*)(DAG + (size_t)m * NLORA + 1024 + 8 * lane);
        const float bon = BON[(size_t)m * NH + hd];
        const float vcf[8] = {bflo(vc.x), bfhi(vc.x), bflo(vc.y), bfhi(vc.y), bflo(vc.z), bfhi(vc.z), bflo(vc.w), bfhi(vc.w)};
        const float vpf[8] = {bflo(vp.x), bfhi(vp.x), bflo(vp.y), bfhi(vp.y), bflo(vp.z), bfhi(vp.z), bflo(vp.w), bfhi(vp.w)};
        const float gf[8] = {bflo(gw4.x), bfhi(gw4.x), bflo(gw4.y), bfhi(gw4.y), bflo(gw4.z), bfhi(gw4.z), bflo(gw4.w), bfhi(gw4.w)};
        float ro[8];
#pragma unroll
        for (int i = 0; i < 8; ++i) { const float xv = vcf[i] + (vpf[i] - vcf[i]) * muv[i]; ro[i] = (y[i] * rs * lng[i] + lnb[i] + bon * xv) * gf[i]; }
        v4u orw; orw.x = pk2(ro[0], ro[1]); orw.y = pk2(ro[2], ro[3]); orw.z = pk2(ro[4], ro[5]); orw.w = pk2(ro[6], ro[7]);
        *(v4u*)(MIX + (size_t)m * D + AW + 8 * lane) = orw;
    }
}

__global__ void __launch_bounds__(NWAVES * 64, 2) hybrid_fwd(Args args) {
    extern __shared__ __attribute__((aligned(16))) unsigned char lds[];
    Frame F;
    F.lds = (LAS unsigned char*)lds;
    F.MISC = (volatile LAS unsigned*)(F.lds + MISC_OFF);
    F.tid = threadIdx.x; F.lane = F.tid & 63; F.wave = __builtin_amdgcn_readfirstlane(F.tid >> 6);
    F.G = gridDim.x; { const int bx = blockIdx.x; F.vcu = (F.G % 8 == 0) ? (bx % 8) * (F.G / 8) + bx / 8 : bx; }
    F.ws = args.ws; F.out = args.out;
    F.ctl = (gu32*)(args.ws + WS_CTL);
    for (int u = F.tid; u < (LDS_BYTES - LDSCTL_OFF) / 4; u += NWAVES * 64) ((LAS unsigned*)(F.lds + LDSCTL_OFF))[u] = 0u;
    __syncthreads();
    XcdBarrier bar; bar.bar = (unsigned*)(F.ctl + CW_BAR); bar.x = 0; bar.st = nullptr;
    if (N_LAUNCHES != PER_PHASE) bar = xcd_barrier_post((unsigned*)(F.ctl + CW_BAR), F.MISC + 8);
#define GRID_BAR() do { if (N_LAUNCHES != PER_PHASE) xcd_barrier(bar); } while (0)
    const int lo = args.ph_lo, hi = args.ph_hi;
#ifndef PHMASK
#define PHMASK 0x3ff
#endif
#define IN(k) (((PHMASK >> (k)) & 1) && lo <= (k) && (k) < hi)
#define BOTH(k) (IN(k) && IN((k) + 1))
#ifndef REPMASK
#define REPMASK 0
#endif
#define REP(k) for (int rep_ = 0; rep_ <= ((REPMASK >> (k)) & 1); ++rep_)
    bf16* XN = (bf16*)(args.ws + WS_XN); bf16* PROJ = (bf16*)(args.ws + WS_PROJ);

    if (IN(0)) { p0_prologue(F, args); if (BOTH(0)) GRID_BAR(); }
    if (IN(1)) {
        pg8::Gemm g{XN, (const bf16*)(args.ws + WS_WIN), M, IN_COLS, D}; pg8::StaticOrder S; S.init(M, IN_COLS, F.G, (int)blockIdx.x);
        pg8::EpiProj E{PROJ, IN_COLS, args.in[I_QNG], args.in[I_KNG]};
        pg8::gemm_phase<pg8::EpiProj, pg8::StaticOrder, true, true>(F.lds + RING_OFF, g, S, E);
        if (BOTH(1)) GRID_BAR();
    }
    if (IN(2)) { p2_prep(F, args); if (BOTH(2)) GRID_BAR(); }
    if (IN(3)) {
        pg8::Gemm g{(const bf16*)(args.ws + WS_A2), (const bf16*)(args.ws + WS_WL), M, NLORA, KLORA}; pg8::StaticOrder S; S.init(M, NLORA, F.G, (int)blockIdx.x);
        pg8::EpiLora E{(bf16*)(args.ws + WS_DAG), NLORA, args.in[I_W0], args.in[I_A0]};
        pg8::gemm_phase<pg8::EpiLora, pg8::StaticOrder, true, true>(F.lds + RING_OFF, g, S, E);
        if (BOTH(3)) GRID_BAR();
    }
    if (IN(4)) { p4_scan(F, args); p4_attn(F, args); if (BOTH(4)) GRID_BAR(); }
    if (IN(5)) { p5_post(F, args); if (BOTH(5)) GRID_BAR(); }
    if (IN(6)) {
        pg8::Gemm g{XN, (const bf16*)(args.ws + WS_WOUT), M, D, D}; pg8::StaticOrder S; S.init(M, D, F.G, (int)blockIdx.x);
        pg8::EpiOut E{args.in[I_X], (bf16*)(args.ws + WS_DAG), (float*)(args.ws + WS_SS), D, (LAS float*)(F.lds + RING_OFF + 131072)};
        pg8::gemm_phase<pg8::EpiOut, pg8::StaticOrder, true, true>(F.lds + RING_OFF, g, S, E);
        if (BOTH(6)) GRID_BAR();
    }
    if (IN(7)) {
        const float* SS = (const float*)(args.ws + WS_SS); float* RS = (float*)(args.ws + WS_SS + MiB / 2);
        for (int m = F.vcu * NWAVES * 64 + F.tid; m < M; m += F.G * NWAVES * 64) { const f32x4 s4 = *(const f32x4*)(SS + (size_t)m * 4);
            RS[m] = 1.0f / sqrtf(((s4[0] + s4[1]) + (s4[2] + s4[3])) * (1.0f / D) + NORM_EPS); }
        if (BOTH(7)) GRID_BAR();
    }
    if (IN(8)) {
        pg8::Gemm g{(const bf16*)(args.ws + WS_DAG), (const bf16*)(args.ws + WS_WGU), M, NGU, D}; pg8::StaticOrder S; S.init(M, NGU, F.G, (int)blockIdx.x);
        pg8::EpiSwiglu E{PROJ, FF, (const float*)(args.ws + WS_SS + MiB / 2)};
        pg8::gemm_phase<pg8::EpiSwiglu, pg8::StaticOrder, true, true>(F.lds + RING_OFF, g, S, E);
        if (BOTH(8)) GRID_BAR();
    }
    if (IN(9)) {
        pg8::Gemm g{PROJ, (const bf16*)(args.ws + WS_WDN), M, D, FF}; pg8::StaticOrder S; S.init(M, D, F.G, (int)blockIdx.x);
        pg8::EpiFinal E{(const bf16*)(args.ws + WS_DAG), F.out, D};
        pg8::gemm_phase<pg8::EpiFinal, pg8::StaticOrder, true, true>(F.lds + RING_OFF, g, S, E);
    }
#undef IN
#undef BOTH
}

extern "C" void kernel_launch(void* const* d_in, const int* in_sizes, int n_in, void* d_out, int out_size, void* d_ws, size_t ws_size, hipStream_t stream) {
    static int grid = 0;
    if (grid == 0) {
        if (n_in != 22 || in_sizes[0] != M * D || out_size != M * D || ws_size < WS_END) { fprintf(stderr, "kernel_launch: unexpected shapes (n_in %d, in0 %d, out %d, ws %zu); nothing launched\n", n_in, n_in > 0 ? in_sizes[0] : -1, out_size, ws_size); grid = -1; return; }
        int dev = 0, cus = 0, per_cu = 0;
        if (hipGetDevice(&dev) != hipSuccess || hipDeviceGetAttribute(&cus, hipDeviceAttributeMultiprocessorCount, dev) != hipSuccess) { grid = -1; return; }
        if (hipFuncSetAttribute((const void*)hybrid_fwd, hipFuncAttributeMaxDynamicSharedMemorySize, LDS_BYTES) != hipSuccess) { fprintf(stderr, "kernel_launch: hipFuncSetAttribute failed\n"); grid = -1; return; }
        if (hipOccupancyMaxActiveBlocksPerMultiprocessor(&per_cu, (const void*)hybrid_fwd, NWAVES * 64, LDS_BYTES) != hipSuccess || per_cu < 1)
            fprintf(stderr, "kernel_launch: note: occupancy query reports %d workgroups per CU\n", per_cu);
        (void)hipGetLastError();
        grid = cus;
    }
    if (grid < 0) return;
    if (hipMemsetAsync((char*)d_ws + WS_CTL, 0, CTL_ZERO_BYTES, stream) != hipSuccess) { fprintf(stderr, "kernel_launch: hipMemsetAsync failed\n"); return; }
    Args a{};
    for (int i = 0; i < 22; ++i) a.in[i] = (const float*)d_in[i];
    a.out = (float*)d_out; a.ws = (unsigned char*)d_ws;
    for (int li = 0; li < N_LAUNCHES; ++li) {
        a.ph_lo = (N_LAUNCHES == PER_PHASE) ? li : 0; a.ph_hi = (N_LAUNCHES == PER_PHASE) ? li + 1 : PER_PHASE; a.li = li;
        hipLaunchKernelGGL(hybrid_fwd, dim3(grid), dim3(NWAVES * 64), LDS_BYTES, stream, a);
        const hipError_t le = hipPeekAtLastError();
        if (le != hipSuccess) { fprintf(stderr, "kernel_launch: launch %d failed: %s\n", li, hipGetErrorName(le)); break; }
    }
}
```

```cpp
#include <hip/hip_runtime.h>
#include <cstdio>
#include <cstdint>

#ifndef MK_N_LAUNCHES
#define MK_N_LAUNCHES 1
#endif

namespace pg8 {
#define PG8_LAS __attribute__((address_space(3)))
typedef unsigned short bf16_t;
typedef short bf16x8 __attribute__((ext_vector_type(8)));
typedef float f32x4 __attribute__((ext_vector_type(4)));
typedef float f32x2 __attribute__((ext_vector_type(2)));
typedef unsigned u32x4 __attribute__((ext_vector_type(4)));
constexpr int BM = 256, BK = 64, HALF = 128, HTB = HALF * BK * 2, STAGE_BYTES = 8 * HTB, NXCD = 8, WGM = 8;

__host__ __device__ __forceinline__ int lds_byte(int r, int c) { const int st = (r >> 4) * 2 + (c >> 5), rr = r & 15, cc = c & 31, ob = rr * 64 + cc * 2; return st * 1024 + (ob ^ (((ob >> 9) & 1) << 5)); }
__host__ __device__ __forceinline__ void stage_rc(int b, int& R, int& C) { const int st = b / 1024, sb = b % 1024, swz = sb ^ (((sb >> 9) & 1) << 5); R = (st >> 1) * 16 + swz / 64; C = (st & 1) * 32 + (swz % 64) / 2; }
__host__ __device__ __forceinline__ int perm32(int rho) { const int n = rho >> 4, i = rho & 15; return 8 * (i >> 2) + 4 * n + (i & 3); }

struct Unit { int pm, pn; };
struct Gemm { const bf16_t* A; const bf16_t* Bt; int M, N, K; };

struct StaticOrder {
    int nM, nN, nwg, G, c;
    __host__ __device__ void init(int M, int N, int G_, int c_) { nM = M / BM; nN = N / BM; nwg = nM * nN; G = G_; c = c_; }
    __host__ __device__ bool next(int i, Unit& u) const {
        const long L = (long)i * G + c; if (L >= nwg) return false;
        int wgid = (int)L; { const int q = nwg / NXCD, r = nwg % NXCD, xcd = wgid % NXCD, off = wgid / NXCD; wgid = (xcd < r ? xcd * (q + 1) : r * (q + 1) + (xcd - r) * q) + off; }
        const int nig = WGM * nN, gid = wgid / nig, fm = gid * WGM, gsz = (nM - fm) < WGM ? (nM - fm) : WGM;
        u.pm = fm + ((wgid % nig) % gsz); u.pn = (wgid % nig) / gsz; return true;
    }
    __device__ __forceinline__ void a_ready(const Unit&) const {}
    __device__ __forceinline__ void done(const Unit&) const {}
};

__device__ __forceinline__ unsigned cvt_pk_bf16(float lo, float hi) { unsigned r; asm volatile("v_cvt_pk_bf16_f32 %0, %1, %2" : "=v"(r) : "v"(lo), "v"(hi)); return r; }
__device__ __forceinline__ float fsigmoid(float x) { return __builtin_amdgcn_rcpf(1.0f + __builtin_amdgcn_exp2f(-1.4426950408889634f * x)); }

struct EpiBf16 {
    static constexpr bool PERM = true, AFTER_DRAIN = false;
    bf16_t* O; int ldc;
    __device__ __forceinline__ void operator()(const f32x4 (&acc)[2][2][4][2], const Unit& u, int wr, int wc, int fr, int fq) const {
        const int row0 = u.pm * BM + wr * 64 + fr; const int col0 = u.pn * BM + wc * 32 + 8 * fq;
#pragma unroll
        for (int ai = 0; ai < 2; ++ai)
#pragma unroll
            for (int m = 0; m < 4; ++m) { bf16_t* rowp = O + (size_t)(row0 + ai * HALF + m * 16) * ldc + col0;
#pragma unroll
                for (int bj = 0; bj < 2; ++bj) { const f32x4 v0 = acc[ai][bj][m][0], v1 = acc[ai][bj][m][1];
                    u32x4 w; w.x = cvt_pk_bf16(v0[0], v0[1]); w.y = cvt_pk_bf16(v0[2], v0[3]); w.z = cvt_pk_bf16(v1[0], v1[1]); w.w = cvt_pk_bf16(v1[2], v1[3]);
                    *(u32x4*)(rowp + bj * HALF) = w; } }
    }
};
struct EpiProj {
    static constexpr bool PERM = true, AFTER_DRAIN = false;
    bf16_t* O; int ldc; const float* qg; const float* kg;
    __device__ __forceinline__ void operator()(const f32x4 (&acc)[2][2][4][2], const Unit& u, int wr, int wc, int fr, int fq) const {
        const int row0 = u.pm * BM + wr * 64 + fr;
        if (u.pn >= 4) {
            const int col0 = u.pn * BM + wc * 32 + 8 * fq;
#pragma unroll
            for (int ai = 0; ai < 2; ++ai)
#pragma unroll
                for (int m = 0; m < 4; ++m) { bf16_t* rowp = O + (size_t)(row0 + ai * HALF + m * 16) * ldc + col0;
#pragma unroll
                    for (int bj = 0; bj < 2; ++bj) { const f32x4 v0 = acc[ai][bj][m][0], v1 = acc[ai][bj][m][1];
                        u32x4 w; w.x = cvt_pk_bf16(v0[0], v0[1]); w.y = cvt_pk_bf16(v0[2], v0[3]); w.z = cvt_pk_bf16(v1[0], v1[1]); w.w = cvt_pk_bf16(v1[2], v1[3]);
                        *(u32x4*)(rowp + bj * HALF) = w; } }
        } else {
            const float* gsrc = (u.pn < 2 ? qg : kg) + 8 * fq; const float sc = u.pn < 2 ? 0.125f * 1.4426950408889634f : 1.0f;
            f32x4 g4[2][2];
#pragma unroll
            for (int bj = 0; bj < 2; ++bj)
#pragma unroll
                for (int n = 0; n < 2; ++n) g4[bj][n] = *(const f32x4*)(gsrc + 32 * bj + 4 * n) * sc;
            const int col0 = u.pn * BM + wc * 64 + 8 * fq;
#pragma unroll
            for (int ai = 0; ai < 2; ++ai)
#pragma unroll
                for (int m = 0; m < 4; ++m) {
                    float ss = 0.f;
#pragma unroll
                    for (int bj = 0; bj < 2; ++bj)
#pragma unroll
                        for (int n = 0; n < 2; ++n) { const f32x4 v = acc[ai][bj][m][n]; ss += (v[0] * v[0] + v[1] * v[1]) + (v[2] * v[2] + v[3] * v[3]); }
                    ss += __shfl_xor(ss, 16); ss += __shfl_xor(ss, 32);
                    const float rstd = 1.0f / sqrtf(ss * (1.0f / 64.0f) + 1e-6f);
                    bf16_t* rowp = O + (size_t)(row0 + ai * HALF + m * 16) * ldc + col0;
#pragma unroll
                    for (int bj = 0; bj < 2; ++bj) { const f32x4 v0 = acc[ai][bj][m][0] * g4[bj][0] * rstd, v1 = acc[ai][bj][m][1] * g4[bj][1] * rstd;
                        u32x4 w; w.x = cvt_pk_bf16(v0[0], v0[1]); w.y = cvt_pk_bf16(v0[2], v0[3]); w.z = cvt_pk_bf16(v1[0], v1[1]); w.w = cvt_pk_bf16(v1[2], v1[3]);
                        *(u32x4*)(rowp + 32 * bj) = w; }
                    __builtin_amdgcn_sched_barrier(0); }
        }
    }
};
struct EpiLora {
    static constexpr bool PERM = true, AFTER_DRAIN = false;
    bf16_t* O; int ldc; const float* w0; const float* a0;
    __device__ __forceinline__ void operator()(const f32x4 (&acc)[2][2][4][2], const Unit& u, int wr, int wc, int fr, int fq) const {
        const int row0 = u.pm * BM + wr * 64 + fr; const int col0 = u.pn * BM + wc * 32 + 8 * fq;
        const int kind = u.pn >> 1;
        const float sc = kind == 0 ? -0.6065306597126334f : (kind == 1 ? 1.0f : 0.0f), lin = kind == 2 ? 1.0f : 0.0f;
        const float* bp = kind == 0 ? w0 : a0;
        const float bs = kind == 2 ? 0.0f : 1.0f;
#pragma unroll
        for (int bj = 0; bj < 2; ++bj) {
            const int c = (col0 + bj * HALF) & 511;
            const f32x4 b0 = *(const f32x4*)(bp + c) * bs, b1 = *(const f32x4*)(bp + c + 4) * bs;
#pragma unroll
            for (int ai = 0; ai < 2; ++ai)
#pragma unroll
                for (int m = 0; m < 4; ++m) { bf16_t* rowp = O + (size_t)(row0 + ai * HALF + m * 16) * ldc + col0;
                    f32x4 v0 = acc[ai][bj][m][0] + b0, v1 = acc[ai][bj][m][1] + b1;
#pragma unroll
                    for (int e = 0; e < 4; ++e) { v0[e] = sc * fsigmoid(v0[e]) + lin * v0[e]; v1[e] = sc * fsigmoid(v1[e]) + lin * v1[e]; }
                    u32x4 w; w.x = cvt_pk_bf16(v0[0], v0[1]); w.y = cvt_pk_bf16(v0[2], v0[3]); w.z = cvt_pk_bf16(v1[0], v1[1]); w.w = cvt_pk_bf16(v1[2], v1[3]);
                    *(u32x4*)(rowp + bj * HALF) = w;
                    __builtin_amdgcn_sched_barrier(0); }
        }
    }
};
struct EpiSwiglu {
    static constexpr bool PERM = true, AFTER_DRAIN = false;
    bf16_t* H; int ldh; const float* rstd;
    __device__ __forceinline__ void operator()(const f32x4 (&acc)[2][2][4][2], const Unit& u, int wr, int wc, int fr, int fq) const {
        const int row0 = u.pm * BM + wr * 64 + fr; const int col0 = u.pn * HALF + wc * 32 + 8 * fq;
        float rs[2][4];
#pragma unroll
        for (int ai = 0; ai < 2; ++ai)
#pragma unroll
            for (int m = 0; m < 4; ++m) { const f32x4 s4 = *(const f32x4*)(rstd + (size_t)(row0 + ai * HALF + m * 16) * 4);
                rs[ai][m] = 1.0f / sqrtf(((s4[0] + s4[1]) + (s4[2] + s4[3])) * (1.0f / 1024.0f) + 1e-6f); }
#pragma unroll
        for (int ai = 0; ai < 2; ++ai)
#pragma unroll
            for (int m = 0; m < 4; ++m) { bf16_t* rowp = H + (size_t)(row0 + ai * HALF + m * 16) * ldh + col0;
                float h[8];
#pragma unroll
                for (int n = 0; n < 2; ++n)
#pragma unroll
                    for (int e = 0; e < 4; ++e) { const float g = acc[ai][0][m][n][e] * rs[ai][m], up = acc[ai][1][m][n][e] * rs[ai][m]; h[4 * n + e] = g * fsigmoid(g) * up; }
                u32x4 w; w.x = cvt_pk_bf16(h[0], h[1]); w.y = cvt_pk_bf16(h[2], h[3]); w.z = cvt_pk_bf16(h[4], h[5]); w.w = cvt_pk_bf16(h[6], h[7]);
                *(u32x4*)rowp = w;
                __builtin_amdgcn_sched_barrier(0); }
    }
};
struct EpiOut {
    static constexpr bool PERM = true, AFTER_DRAIN = false;
    const float* base; bf16_t* xb; float* SS; int ldc; PG8_LAS float* scr;
    __device__ __forceinline__ void operator()(const f32x4 (&acc)[2][2][4][2], const Unit& u, int wr, int wc, int fr, int fq) const {
        const int row0 = u.pm * BM + wr * 64 + fr, col0 = u.pn * BM + wc * 32 + 8 * fq;
#pragma unroll
        for (int ai = 0; ai < 2; ++ai)
#pragma unroll
            for (int m = 0; m < 4; ++m) { const size_t off = (size_t)(row0 + ai * HALF + m * 16) * ldc + col0;
                float ss = 0.f;
#pragma unroll
                for (int bj = 0; bj < 2; ++bj) {
                    const f32x4 o0 = *(const f32x4*)(base + off + bj * HALF) + acc[ai][bj][m][0], o1 = *(const f32x4*)(base + off + bj * HALF + 4) + acc[ai][bj][m][1];
                    u32x4 w; w.x = cvt_pk_bf16(o0[0], o0[1]); w.y = cvt_pk_bf16(o0[2], o0[3]); w.z = cvt_pk_bf16(o1[0], o1[1]); w.w = cvt_pk_bf16(o1[2], o1[3]);
                    *(u32x4*)(xb + off + bj * HALF) = w;
                    ss += ((o0[0] * o0[0] + o0[1] * o0[1]) + (o0[2] * o0[2] + o0[3] * o0[3])) + ((o1[0] * o1[0] + o1[1] * o1[1]) + (o1[2] * o1[2] + o1[3] * o1[3])); }
                ss += __shfl_xor(ss, 16); ss += __shfl_xor(ss, 32);
                if (fq == 0) scr[((((wr * 2 + ai) * 4 + m) * 16) + fr) * 4 + wc] = ss;
                if (m & 1) asm volatile("" ::: "memory"); }
        asm volatile("s_waitcnt lgkmcnt(0)" ::: "memory"); __builtin_amdgcn_s_barrier(); asm volatile("" ::: "memory");
        const int tid = threadIdx.x;
        if (tid < 256) { const f32x4 s4 = *(const PG8_LAS f32x4*)(scr + tid * 4);
            const int row = u.pm * BM + ((tid >> 6) & 1) * HALF + (tid >> 7) * 64 + ((tid >> 4) & 3) * 16 + (tid & 15);
            SS[(size_t)row * 4 + u.pn] = (s4[0] + s4[1]) + (s4[2] + s4[3]); }
    }
};
struct EpiFinal {
    static constexpr bool PERM = true, AFTER_DRAIN = false;
    const bf16_t* xb; float* out; int ldc;
    __device__ __forceinline__ void operator()(const f32x4 (&acc)[2][2][4][2], const Unit& u, int wr, int wc, int fr, int fq) const {
        const int row0 = u.pm * BM + wr * 64 + fr, col0 = u.pn * BM + wc * 32 + 8 * fq;
#pragma unroll
        for (int ai = 0; ai < 2; ++ai)
#pragma unroll
            for (int m = 0; m < 4; ++m) { const size_t off = (size_t)(row0 + ai * HALF + m * 16) * ldc + col0;
#pragma unroll
                for (int bj = 0; bj < 2; ++bj) { const u32x4 w = *(const u32x4*)(xb + off + bj * HALF);
                    const f32x4 b0 = (f32x4){__builtin_bit_cast(float, w.x << 16), __builtin_bit_cast(float, w.x & 0xffff0000u), __builtin_bit_cast(float, w.y << 16), __builtin_bit_cast(float, w.y & 0xffff0000u)};
                    const f32x4 b1 = (f32x4){__builtin_bit_cast(float, w.z << 16), __builtin_bit_cast(float, w.z & 0xffff0000u), __builtin_bit_cast(float, w.w << 16), __builtin_bit_cast(float, w.w & 0xffff0000u)};
                    *(f32x4*)(out + off + bj * HALF) = b0 + acc[ai][bj][m][0]; *(f32x4*)(out + off + bj * HALF + 4) = b1 + acc[ai][bj][m][1]; }
                if (m & 1) asm volatile("" ::: "memory"); }
    }
};

template <class Epi, class Sched, bool ALIGN_EPI = false, bool SP2 = false>
__device__ __forceinline__ void gemm_phase(PG8_LAS unsigned char* lds, const Gemm g, const Sched& S, const Epi& E) {
    const int tid = threadIdx.x, wid = __builtin_amdgcn_readfirstlane(tid >> 6), lane = tid & 63, wr = wid >> 2, wc = wid & 3, fr = lane & 15, fq = lane >> 4;
    const int K = g.K, nt = K / BK;
    unsigned voffA[2], voffB[2];
#pragma unroll
    for (int i = 0; i < 2; ++i) { int R, C; stage_rc(tid * 16 + i * 8192, R, C); const int Rb = Epi::PERM ? ((R & ~31) + perm32(R & 31)) : R;
        voffA[i] = (unsigned)(R * K + C) * 2u; voffB[i] = (unsigned)(Rb * K + C) * 2u; }
    const size_t kstep = (size_t)(BK * 2);
    const size_t hstep = (size_t)HALF * K * 2;
    const size_t tstep = 2 * hstep;
    const unsigned ldsw = (unsigned)wid * 1024u;
    const int aoff = lds_byte(wr * 64 + fr, fq * 8), boff = lds_byte(wc * 32 + fr, fq * 8);
#define PG8_SA(b, h) (((b) * 2 + (h)) * HTB)
#define PG8_SB(b, h) ((4 + (b) * 2 + (h)) * HTB)
#define PG8_STAGE(bufoff, gbase, voff) do { _Pragma("unroll") for (int _i = 0; _i < 2; ++_i) \
        __builtin_amdgcn_global_load_lds((const unsigned*)((const char*)(gbase) + (voff)[_i]), (PG8_LAS unsigned*)(lds + (bufoff) + ldsw + _i * 8192), 16, 0, 0); } while (0)
#define PG8_LDA(dst, b, h) do { _Pragma("unroll") for (int m = 0; m < 4; ++m) _Pragma("unroll") for (int k = 0; k < 2; ++k) dst[m][k] = *(const PG8_LAS bf16x8*)(lds + PG8_SA(b, h) + aoff + m * 2048 + k * 1024); } while (0)
#define PG8_LDB(dst, b, h) do { _Pragma("unroll") for (int n = 0; n < 2; ++n) _Pragma("unroll") for (int k = 0; k < 2; ++k) dst[n][k] = *(const PG8_LAS bf16x8*)(lds + PG8_SB(b, h) + boff + n * 2048 + k * 1024); } while (0)
#define PG8_MMA(ai, bj, At, Bt) do { __builtin_amdgcn_s_setprio(1); _Pragma("unroll") for (int m = 0; m < 4; ++m) _Pragma("unroll") for (int n = 0; n < 2; ++n) _Pragma("unroll") for (int k = 0; k < 2; ++k) \
        acc[ai][bj][m][n] = __builtin_amdgcn_mfma_f32_16x16x32_bf16(Bt[n][k], At[m][k], acc[ai][bj][m][n], 0, 0, 0); __builtin_amdgcn_s_setprio(0); } while (0)
#define PG8_WAIT_V(n) asm volatile("s_waitcnt vmcnt(" #n ")" ::: "memory")
#define PG8_WAIT_L(n) asm volatile("s_waitcnt lgkmcnt(" #n ")" ::: "memory")
#define PG8_BAR __builtin_amdgcn_s_barrier()
#define PG8_SCHED __builtin_amdgcn_sched_barrier(0)
    Unit cur, nxt; int ui = 0;
    if (!S.next(0, cur)) return;
    f32x4 acc[2][2][4][2];
#pragma unroll
    for (int a = 0; a < 2; ++a)
#pragma unroll
        for (int b = 0; b < 2; ++b)
#pragma unroll
            for (int m = 0; m < 4; ++m)
#pragma unroll
                for (int n = 0; n < 2; ++n) acc[a][b][m][n] = (f32x4){0.f, 0.f, 0.f, 0.f};
    bf16x8 At[4][2], B0[2][2], B1[2][2];
    const char* cA = (const char*)g.A + (size_t)cur.pm * tstep; const char* cB = (const char*)g.Bt + (size_t)cur.pn * tstep;
    S.a_ready(cur);
    if constexpr (SP2) {
        PG8_STAGE(PG8_SB(0, 0), cB, voffB); PG8_STAGE(PG8_SB(0, 1), cB + hstep, voffB); PG8_STAGE(PG8_SA(0, 0), cA, voffA); PG8_STAGE(PG8_SA(0, 1), cA + hstep, voffA);
        if (wr == 1) PG8_BAR;
        PG8_WAIT_V(2); PG8_BAR;
        PG8_STAGE(PG8_SB(1, 0), cB + kstep, voffB); PG8_STAGE(PG8_SA(1, 0), cA + kstep, voffA); PG8_STAGE(PG8_SB(1, 1), cB + hstep + kstep, voffB);
        PG8_WAIT_V(6); PG8_BAR;
    } else {
        PG8_STAGE(PG8_SB(0, 0), cB, voffB); PG8_STAGE(PG8_SA(0, 0), cA, voffA); PG8_STAGE(PG8_SB(0, 1), cB + hstep, voffB); PG8_STAGE(PG8_SA(0, 1), cA + hstep, voffA);
        if (wr == 1) PG8_BAR;
        PG8_WAIT_V(4); PG8_BAR;
        PG8_STAGE(PG8_SB(1, 0), cB + kstep, voffB); PG8_STAGE(PG8_SA(1, 0), cA + kstep, voffA); PG8_STAGE(PG8_SB(1, 1), cB + hstep + kstep, voffB);
        PG8_WAIT_V(6); PG8_BAR;
    }
    for (;;) {
        const bool has_next = S.next(ui + 1, nxt);
        const char* nA = has_next ? (const char*)g.A + (size_t)nxt.pm * tstep : cA; const char* nB = has_next ? (const char*)g.Bt + (size_t)nxt.pn * tstep : cB;
#pragma nounroll
        for (int t = 0; t < nt; t += 2) {
            const bool last = (t == nt - 2);
            const char* a1 = cA + (size_t)(t + 1) * kstep;
            const char* a2 = last ? nA : cA + (size_t)(t + 2) * kstep; const char* b2 = last ? nB : cB + (size_t)(t + 2) * kstep;
            const char* a3 = a2 + kstep; const char* b3 = b2 + kstep;
            if (last && has_next) S.a_ready(nxt);
            if constexpr (SP2) {
            PG8_LDB(B0, 0, 0); PG8_LDB(B1, 0, 1); PG8_SCHED; PG8_LDA(At, 0, 0); PG8_STAGE(PG8_SA(1, 1), a1 + hstep, voffA);
            PG8_WAIT_V(8); PG8_WAIT_L(0); PG8_BAR; PG8_MMA(0, 0, At, B0); PG8_MMA(0, 1, At, B1); PG8_BAR; PG8_SCHED;
            PG8_LDA(At, 0, 1); PG8_STAGE(PG8_SB(0, 0), b2, voffB); PG8_STAGE(PG8_SB(0, 1), b2 + hstep, voffB); PG8_STAGE(PG8_SA(0, 0), a2, voffA);
            PG8_WAIT_V(8); PG8_WAIT_L(0); PG8_BAR; PG8_MMA(1, 0, At, B0); PG8_MMA(1, 1, At, B1); PG8_BAR; PG8_SCHED;
            PG8_LDB(B0, 1, 0); PG8_LDB(B1, 1, 1); PG8_SCHED; PG8_LDA(At, 1, 0); PG8_STAGE(PG8_SA(0, 1), a2 + hstep, voffA);
            PG8_WAIT_V(8); PG8_WAIT_L(0); PG8_BAR; PG8_MMA(0, 0, At, B0); PG8_MMA(0, 1, At, B1); PG8_BAR; PG8_SCHED;
            PG8_LDA(At, 1, 1); PG8_STAGE(PG8_SB(1, 0), b3, voffB); PG8_STAGE(PG8_SB(1, 1), b3 + hstep, voffB); PG8_STAGE(PG8_SA(1, 0), a3, voffA);
            PG8_WAIT_V(8); PG8_WAIT_L(0); PG8_BAR; PG8_MMA(1, 0, At, B0); PG8_MMA(1, 1, At, B1); PG8_BAR; PG8_SCHED;
            } else {
            PG8_LDB(B0, 0, 0); PG8_SCHED; PG8_LDA(At, 0, 0); PG8_STAGE(PG8_SA(1, 1), a1 + hstep, voffA);
            PG8_WAIT_L(8); PG8_BAR; PG8_WAIT_L(0); PG8_MMA(0, 0, At, B0); PG8_BAR; PG8_SCHED;
            PG8_LDB(B1, 0, 1); PG8_STAGE(PG8_SB(0, 0), b2, voffB);
            PG8_BAR; PG8_WAIT_L(0); PG8_MMA(0, 1, At, B1); PG8_BAR;
            PG8_LDA(At, 0, 1); PG8_STAGE(PG8_SA(0, 0), a2, voffA);
            PG8_BAR; PG8_WAIT_L(0); PG8_MMA(1, 0, At, B0); PG8_BAR; PG8_SCHED;
            PG8_STAGE(PG8_SB(0, 1), b2 + hstep, voffB);
            PG8_WAIT_V(6); PG8_BAR; PG8_MMA(1, 1, At, B1); PG8_BAR;
            PG8_LDB(B0, 1, 0); PG8_SCHED; PG8_LDA(At, 1, 0); PG8_STAGE(PG8_SA(0, 1), a2 + hstep, voffA);
            PG8_WAIT_L(8); PG8_BAR; PG8_WAIT_L(0); PG8_MMA(0, 0, At, B0); PG8_BAR; PG8_SCHED;
            PG8_LDB(B1, 1, 1); PG8_STAGE(PG8_SB(1, 0), b3, voffB);
            PG8_BAR; PG8_WAIT_L(0); PG8_MMA(0, 1, At, B1); PG8_BAR;
            PG8_LDA(At, 1, 1); PG8_STAGE(PG8_SA(1, 0), a3, voffA);
            PG8_BAR; PG8_WAIT_L(0); PG8_MMA(1, 0, At, B0); PG8_BAR; PG8_SCHED;
            PG8_STAGE(PG8_SB(1, 1), b3 + hstep, voffB);
            PG8_WAIT_V(6); PG8_BAR; PG8_MMA(1, 1, At, B1); PG8_BAR;
            }
        }
        if constexpr (ALIGN_EPI) { if (wr == 0) PG8_BAR; }
        if constexpr (!Epi::AFTER_DRAIN) { E(acc, cur, wr, wc, fr, fq); S.done(cur); }
        if (!has_next) break;
#pragma unroll
        for (int a = 0; a < 2; ++a)
#pragma unroll
            for (int b = 0; b < 2; ++b)
#pragma unroll
                for (int m = 0; m < 4; ++m)
#pragma unroll
                    for (int n = 0; n < 2; ++n) acc[a][b][m][n] = (f32x4){0.f, 0.f, 0.f, 0.f};
        cur = nxt; cA = nA; cB = nB; ++ui;
        if constexpr (ALIGN_EPI) { if (wr == 1) PG8_BAR; }
    }
    PG8_WAIT_V(0);
    if constexpr (!ALIGN_EPI) { if (wr == 0) PG8_BAR; }
    PG8_BAR;
#undef PG8_SA
#undef PG8_SB
#undef PG8_STAGE
#undef PG8_LDA
#undef PG8_LDB
#undef PG8_MMA
#undef PG8_WAIT_V
#undef PG8_WAIT_L
#undef PG8_BAR
#undef PG8_SCHED
}
}

constexpr int NWAVES = 8;
constexpr int N_LAUNCHES = MK_N_LAUNCHES;
constexpr int PER_PHASE = 10;
constexpr int BATCH = 16, SEQ = 2048, D = 1024, M = BATCH * SEQ;
constexpr int NH = 8, HD = 64, AW = 512, RW = 512;
constexpr int RWKV_COLS = 1792, IN_COLS = 3328, FF = 2816, NGU = 2 * FF, NLORA = 1536, KLORA = 256;
constexpr int PC_Q = 0, PC_K = 512, PC_V = 1024, PC_RW = 1536;
constexpr int RC_R = 0, RC_K = 512, RC_V = 1024, RC_L = 1536;
constexpr float NORM_EPS = 1e-6f, LNX_EPS = 64e-5f;
constexpr float LOG2E = 1.4426950408889634f;

constexpr size_t MiB = 1u << 20;
constexpr size_t WS_CTL = 0, CTL_ZERO_BYTES = 1 * MiB;
constexpr size_t WS_WIN = 2 * MiB;
constexpr size_t WS_WOUT = 9 * MiB;
constexpr size_t WS_WGU = 11 * MiB;
constexpr size_t WS_WDN = 22 * MiB;
constexpr size_t WS_WL = 28 * MiB;
constexpr size_t WS_BON = 29 * MiB;
constexpr size_t WS_SS = 30 * MiB;
constexpr size_t WS_XN = 32 * MiB;
constexpr size_t WS_PROJ = 96 * MiB;
constexpr size_t WS_A2 = 304 * MiB;
constexpr size_t WS_DAG = 320 * MiB;
constexpr size_t WS_ML = 416 * MiB;
constexpr size_t WS_END = 424 * MiB;
constexpr size_t DO_PO = 0, DO_Y = 96 * MiB;
constexpr int CW_TMO = 0, CW_CODE = 1;
constexpr int CW_BAR = 4096;
constexpr int CW_ATTQ = 8192;

constexpr int LDS_BYTES = 147456;
constexpr int RING_OFF = 0, RING_BYTES = LDS_BYTES - 1024;
constexpr int LDSCTL_OFF = RING_BYTES, MISC_OFF = LDSCTL_OFF + 320;

#define GAS __attribute__((address_space(1)))
#define LAS __attribute__((address_space(3)))
typedef unsigned short bf16;
typedef unsigned v4u __attribute__((ext_vector_type(4)));
typedef unsigned v2u __attribute__((ext_vector_type(2)));
typedef float f32x4 __attribute__((ext_vector_type(4)));
typedef float f32x2 __attribute__((ext_vector_type(2)));
typedef float f32x16 __attribute__((ext_vector_type(16)));
typedef short bf16x8 __attribute__((ext_vector_type(8)));
typedef short s16x4 __attribute__((ext_vector_type(4)));
typedef GAS unsigned gu32;
#define RLX_AGENT __ATOMIC_RELAXED, __HIP_MEMORY_SCOPE_AGENT
#define LDS_WAIT() asm volatile("s_waitcnt lgkmcnt(0)" ::: "memory")
#define VM_WAIT() asm volatile("s_waitcnt vmcnt(0)" ::: "memory")
__device__ __forceinline__ unsigned f2bf(float f) { unsigned u = __builtin_bit_cast(unsigned, f); return (u + 0x7fffu + ((u >> 16) & 1u)) >> 16; }
__device__ __forceinline__ unsigned pk2(float lo, float hi) { return f2bf(lo) | (f2bf(hi) << 16); }
__device__ __forceinline__ float bflo(unsigned w) { return __builtin_bit_cast(float, w << 16); }
__device__ __forceinline__ float bfhi(unsigned w) { return __builtin_bit_cast(float, w & 0xffff0000u); }
__device__ __forceinline__ float fsig(float x) { return __builtin_amdgcn_rcpf(1.0f + __builtin_amdgcn_exp2f(-LOG2E * x)); }

#define XB_TMO      128
#define XB_XCNT(j)  (256  + 64 * (j))
#define XB_XSUB(j)  (1280 + 64 * (j))
#define XB_XGEN(j)  (2304 + 64 * (j))
#define XB_TOP      3328
#define XB_TOPGEN   3392
#define XCD_BAR_WORDS 3456
#define XB_SPIN_CAP (1u << 18)
__device__ __forceinline__ unsigned xb_ld(unsigned* p)              { return __hip_atomic_load(p, __ATOMIC_RELAXED, __HIP_MEMORY_SCOPE_AGENT); }
__device__ __forceinline__ unsigned xb_add(unsigned* p, unsigned v) { return __hip_atomic_fetch_add(p, v, __ATOMIC_RELAXED, __HIP_MEMORY_SCOPE_AGENT); }
__device__ __forceinline__ unsigned xb_xcc_id() { return (unsigned)__builtin_amdgcn_s_getreg((3 << 11) | 20) & 0xFu; }
#define XB_SPIN(cond, bar) do { unsigned _sp = 0; while (cond) { __builtin_amdgcn_s_sleep(1); \
    if ((++_sp & 255u) == 0u) { if (xb_ld(&(bar)[XB_TMO])) break; if (_sp > XB_SPIN_CAP) { atomicAdd(&(bar)[XB_TMO], 1u); break; } } } } while (0)
struct XcdBarrier { unsigned* bar; unsigned x; volatile LAS unsigned* st; };
__device__ __forceinline__ XcdBarrier xcd_barrier_post(unsigned* bar, volatile LAS unsigned* st) {
    XcdBarrier b; b.bar = bar; b.x = xb_xcc_id(); b.st = st;
    if (threadIdx.x == 0) (void)xb_add(&bar[XB_XCNT(b.x)], 1u);
    return b;
}
__device__ __forceinline__ void xcd_barrier_complete(unsigned* bar, unsigned x, unsigned& nloc, unsigned& nx) {
    const unsigned G = gridDim.x * gridDim.y * gridDim.z;
    unsigned sum, cnt, mine, sp = 0u;
    for (;;) {
        sum = 0u; cnt = 0u; mine = 0u;
#pragma unroll
        for (unsigned j = 0; j < 16; ++j) { const unsigned c = xb_ld(&bar[XB_XCNT(j)]); sum += c; cnt += (c > 0u) ? 1u : 0u; mine = (j == x) ? c : mine; }
        if (sum == G) break;
        __builtin_amdgcn_s_sleep(1);
        if ((++sp & 255u) == 0u) { if (xb_ld(&bar[XB_TMO])) break; if (sp > XB_SPIN_CAP) { atomicAdd(&bar[XB_TMO], 1u); break; } }
    }
    nloc = mine > 0u ? mine : 1u; nx = cnt > 0u ? cnt : 1u;
}
__device__ __forceinline__ void xcd_barrier(const XcdBarrier& b) {
    asm volatile("s_waitcnt vmcnt(0)" ::: "memory");
    __syncthreads();
    if (threadIdx.x == 0) {
        unsigned* bar = b.bar;
        __builtin_amdgcn_s_waitcnt(0);
        unsigned nloc = b.st[0], nx = b.st[1];
        if (nloc == 0u) { xcd_barrier_complete(bar, b.x, nloc, nx); b.st[0] = nloc; b.st[1] = nx; }
        const unsigned old = xb_add(&bar[XB_XSUB(b.x)], 1u);
        const unsigned gen = old / nloc;
        if (old + 1u == (gen + 1u) * nloc) {
            __builtin_amdgcn_fence(__ATOMIC_RELEASE, "agent");
            asm volatile("s_waitcnt vmcnt(0)" ::: "memory");
            const unsigned og = xb_add(&bar[XB_TOP], 1u);
            const unsigned tg = og / nx;
            if (og + 1u == (tg + 1u) * nx) xb_add(&bar[XB_TOPGEN], 1u);
            else XB_SPIN(xb_ld(&bar[XB_TOPGEN]) == tg, bar);
            __builtin_amdgcn_fence(__ATOMIC_ACQUIRE, "agent");
            xb_add(&bar[XB_XGEN(b.x)], 1u);
            asm volatile("s_waitcnt vmcnt(0)" ::: "memory");
        } else {
            XB_SPIN(xb_ld(&bar[XB_XGEN(b.x)]) == gen, bar);
            __builtin_amdgcn_fence(__ATOMIC_ACQUIRE, "agent");
            asm volatile("s_waitcnt vmcnt(0)" ::: "memory");
        }
    }
    __syncthreads();
}

struct Frame {
    LAS unsigned char* lds;
    volatile LAS unsigned* MISC;
    gu32* ctl;
    int tid, lane, wave;
    int vcu, G;
    float* out; unsigned char* ws;
};
struct Args { const float* in[22]; float* out; unsigned char* ws; int ph_lo, ph_hi, li, pad; };
enum { I_X = 0, I_N1G, I_WIN, I_QNG, I_KNG, I_AOG, I_MU, I_W0, I_W2, I_A0, I_A2, I_G2, I_KK, I_KA, I_RK, I_LNG, I_LNB, I_WOUT, I_N2G, I_WG, I_WU, I_WD };

__device__ __forceinline__ float wave_sum(float v) {
#pragma unroll
    for (int o = 1; o < 64; o <<= 1) v += __shfl_xor(v, o);
    return v;
}
__device__ __forceinline__ float red16(float x) {
    x += __builtin_bit_cast(float, __builtin_amdgcn_update_dpp(0, __builtin_bit_cast(int, x), 0x128, 0xf, 0xf, false));
    x += __builtin_bit_cast(float, __builtin_amdgcn_update_dpp(0, __builtin_bit_cast(int, x), 0x124, 0xf, 0xf, false));
    x += __builtin_bit_cast(float, __builtin_amdgcn_update_dpp(0, __builtin_bit_cast(int, x), 0x122, 0xf, 0xf, false));
    x += __builtin_bit_cast(float, __builtin_amdgcn_update_dpp(0, __builtin_bit_cast(int, x), 0x121, 0xf, 0xf, false));
    return x;
}

__device__ __forceinline__ void p0_transpose_item(const float* W, int K, int N, bf16* WT, int rmode, LAS float* scr, int item, int lane, const float* ksc = nullptr) {
    const int nblk = N / 32, kb = item / nblk, nb = item % nblk, k0 = 64 * kb, n0 = 32 * nb;
    const int rbase = rmode == 0 ? n0 : rmode == 3 ? (n0 < 1024 ? ((n0 >> 8) * 256 + ((n0 >> 5) & 1) * 128 + ((n0 >> 6) & 3) * 32) : n0) : ((n0 >> 7) * 256 + (n0 & 127) + (rmode == 2 ? 128 : 0));
#pragma unroll 8
    for (int i = 0; i < 32; ++i) { const int kk = 2 * i + (lane >> 5); scr[kk * 33 + (lane & 31)] = W[(size_t)(k0 + kk) * N + n0 + (lane & 31)] * (ksc ? ksc[k0 + kk] : 1.0f); }
    LDS_WAIT(); asm volatile("" ::: "memory");
    const int c = lane & 7;
#pragma unroll
    for (int j = 0; j < 4; ++j) { const int n = (lane >> 3) + 8 * j; const LAS float* s = scr + (8 * c) * 33 + n;
        v4u o; o.x = pk2(s[0 * 33], s[1 * 33]); o.y = pk2(s[2 * 33], s[3 * 33]); o.z = pk2(s[4 * 33], s[5 * 33]); o.w = pk2(s[6 * 33], s[7 * 33]);
        *(GAS v4u*)(WT + (size_t)(rbase + n) * K + k0 + 8 * c) = o; }
    LDS_WAIT(); asm volatile("" ::: "memory");
}
__device__ __forceinline__ void rms_row_to_bf16(int lane, const float* xrow, const float* g, bf16* orow) {
    const GAS f32x4* xr = (const GAS f32x4*)xrow + lane;
    const GAS f32x4* gr = (const GAS f32x4*)g + lane;
    f32x4 v[4]; float s = 0.f;
#pragma unroll
    for (int j = 0; j < 4; ++j) { v[j] = xr[64 * j]; s += (v[j].x * v[j].x + v[j].y * v[j].y) + (v[j].z * v[j].z + v[j].w * v[j].w); }
    const float rstd = 1.f / sqrtf(wave_sum(s) * (1.f / D) + NORM_EPS);
    GAS unsigned long long* o8 = (GAS unsigned long long*)orow + lane;
#pragma unroll
    for (int j = 0; j < 4; ++j) { const f32x4 gg = gr[64 * j];
        o8[64 * j] = (unsigned long long)pk2(v[j].x * rstd * gg.x, v[j].y * rstd * gg.y) | ((unsigned long long)pk2(v[j].z * rstd * gg.z, v[j].w * rstd * gg.w) << 32); }
}

__device__ __forceinline__ void p0_prologue(Frame& F, const Args& AR) {
    LAS float* scr = (LAS float*)(F.lds + RING_OFF + F.wave * 16384);
    const int gw = F.vcu * NWAVES + F.wave, NGW = F.G * NWAVES;
    bf16* Win_t = (bf16*)(F.ws + WS_WIN); bf16* Wout_t = (bf16*)(F.ws + WS_WOUT); bf16* Wgu_t = (bf16*)(F.ws + WS_WGU); bf16* Wdn_t = (bf16*)(F.ws + WS_WDN); bf16* Wl_t = (bf16*)(F.ws + WS_WL);
    constexpr int I_IN = (D / 64) * (IN_COLS / 32), I_OUT = (D / 64) * (D / 32), I_G = (D / 64) * (FF / 32), I_DN = (FF / 64) * (D / 32);
    constexpr int NITEMS = I_IN + I_OUT + 2 * I_G + I_DN;
    for (int it = gw; it < NITEMS; it += NGW) {
        int r = it;
        if (r < I_IN) { p0_transpose_item(AR.in[I_WIN], D, IN_COLS, Win_t, 3, scr, r, F.lane); continue; } r -= I_IN;
        if (r < I_OUT) { p0_transpose_item(AR.in[I_WOUT], D, D, Wout_t, 0, scr, r, F.lane); continue; } r -= I_OUT;
        if (r < I_G) { p0_transpose_item(AR.in[I_WG], D, FF, Wgu_t, 1, scr, r, F.lane, AR.in[I_N2G]); continue; } r -= I_G;
        if (r < I_G) { p0_transpose_item(AR.in[I_WU], D, FF, Wgu_t, 2, scr, r, F.lane, AR.in[I_N2G]); continue; } r -= I_G;
        p0_transpose_item(AR.in[I_WD], FF, D, Wdn_t, 0, scr, r, F.lane);
    }
    for (int e = (F.vcu * NWAVES * 64 + F.tid); e < NLORA * KLORA; e += F.G * NWAVES * 64) {
        const int row = e / KLORA, k = e % KLORA, kind = row >> 9, c = row & 511; float v = 0.f;
        if (kind == 0) { if (k < 64) v = AR.in[I_W2][k * 512 + c]; }
        else if (kind == 1) { if (k >= 64 && k < 128) v = AR.in[I_A2][(k - 64) * 512 + c]; }
        else { if (k >= 128) v = AR.in[I_G2][(k - 128) * 512 + c]; }
        Wl_t[e] = (bf16)f2bf(v);
    }
    bf16* XN = (bf16*)(F.ws + WS_XN);
    for (int m = gw; m < M; m += NGW) rms_row_to_bf16(F.lane, AR.in[I_X] + (size_t)m * D, AR.in[I_N1G], XN + (size_t)m * D);
}

__device__ __forceinline__ void p2_prep(Frame& F, const Args& AR) {
    const int gw = F.vcu * NWAVES + F.wave, NGW = F.G * NWAVES, lane = F.lane;
    const bf16* PROJ = (const bf16*)(F.ws + WS_PROJ); bf16* A2 = (bf16*)(F.ws + WS_A2);
    const f32x4 mu4 = *(const f32x4*)(AR.in[I_MU] + RC_L + 4 * lane);
    for (int m = gw; m < M; m += NGW) {
        const bf16* row = PROJ + (size_t)m * IN_COLS;
        const v2u cu = *(const v2u*)(row + PC_RW + RC_L + 4 * lane);
        v2u pv = (v2u){0u, 0u};
        if ((m & (SEQ - 1)) != 0) pv = *(const v2u*)(row - IN_COLS + PC_RW + RC_L + 4 * lane);
        float c4[4] = {bflo(cu.x), bfhi(cu.x), bflo(cu.y), bfhi(cu.y)}, p4[4] = {bflo(pv.x), bfhi(pv.x), bflo(pv.y), bfhi(pv.y)};
        float xs[4];
#pragma unroll
        for (int i = 0; i < 4; ++i) { const float v = c4[i] + (p4[i] - c4[i]) * mu4[i];
            if (lane < 16) { const float t = __builtin_amdgcn_exp2f(2.f * LOG2E * v); xs[i] = 1.f - 2.f * __builtin_amdgcn_rcpf(t + 1.f); }
            else if (lane < 32) xs[i] = v;
            else xs[i] = fsig(v); }
        *(v2u*)(A2 + (size_t)m * KLORA + 4 * lane) = (v2u){pk2(xs[0], xs[1]), pk2(xs[2], xs[3])};
    }
}

constexpr int CS = 16, NCHUNK = SEQ / CS, NHELP = 4, NSTATE = 4, NIT = (NCHUNK + NHELP - 1) / NHELP;
constexpr int SL_A = 0, SL_R = 2048, SL_B = 4096, SL_K = 6144, SL_V = 8192, SL_T = 10240, SL_LAK = 10752, SL_LRB = 11264, SL_LRK = 11776, SL_G = 12288, SL_BYTES = 12544;
constexpr int SC_CONST = 2 * NHELP * SL_BYTES;
constexpr int SC_YL = SC_CONST + 6 * 64 * 4, YL_BYTES = NHELP * CS * 64 * 2;
static_assert(SC_YL + 2 * YL_BYTES <= RING_BYTES && NHELP * CS * 8 == NWAVES * 64, "scan LDS");
struct HReg { v4u r[2], k[2], v[2], pr[2], pk[2], pv[2], e[2], a[2]; };
__device__ __forceinline__ void helper_load(HReg& R, const bf16* PROJ, const bf16* DAG, int tok, int h, int kg) {
    const GAS bf16* row = (const GAS bf16*)PROJ + (size_t)tok * IN_COLS + PC_RW + h * 64 + 16 * kg;
    const GAS bf16* rowp = row - IN_COLS;
    const GAS bf16* dr = (const GAS bf16*)DAG + (size_t)tok * NLORA + h * 64 + 16 * kg;
    asm volatile("" : "+v"(row)); asm volatile("" : "+v"(rowp)); asm volatile("" : "+v"(dr));
    const bool hp = (tok & (SEQ - 1)) != 0;
#pragma unroll
    for (int i = 0; i < 2; ++i) {
        R.r[i] = *(const GAS v4u*)(row + RC_R + 8 * i); R.k[i] = *(const GAS v4u*)(row + RC_K + 8 * i); R.v[i] = *(const GAS v4u*)(row + RC_V + 8 * i);
        if (hp) { R.pr[i] = *(const GAS v4u*)(rowp + RC_R + 8 * i); R.pk[i] = *(const GAS v4u*)(rowp + RC_K + 8 * i); R.pv[i] = *(const GAS v4u*)(rowp + RC_V + 8 * i); }
        else { R.pr[i] = (v4u){0u, 0u, 0u, 0u}; R.pk[i] = R.pr[i]; R.pv[i] = R.pr[i]; }
        R.e[i] = *(const GAS v4u*)(dr + 8 * i); R.a[i] = *(const GAS v4u*)(dr + 512 + 8 * i);
    }
}
__device__ __forceinline__ void unpack4(const unsigned w0, const unsigned w1, float (&x)[4]) { x[0] = bflo(w0); x[1] = bfhi(w0); x[2] = bflo(w1); x[3] = bfhi(w1); }
__device__ __forceinline__ float dpp_shr(float x, const int ctrl_sel) {
    int r;
    if (ctrl_sel == 1) r = __builtin_amdgcn_update_dpp(0, __builtin_bit_cast(int, x), 0x111, 0xf, 0xf, true);
    else if (ctrl_sel == 2) r = __builtin_amdgcn_update_dpp(0, __builtin_bit_cast(int, x), 0x112, 0xf, 0xf, true);
    else if (ctrl_sel == 4) r = __builtin_amdgcn_update_dpp(0, __builtin_bit_cast(int, x), 0x114, 0xf, 0xf, true);
    else r = __builtin_amdgcn_update_dpp(0, __builtin_bit_cast(int, x), 0x118, 0xf, 0xf, true);
    return __builtin_bit_cast(float, r);
}
typedef float f32x2_t __attribute__((ext_vector_type(2))); typedef __bf16 bf16x2_t __attribute__((ext_vector_type(2)));
__device__ __forceinline__ unsigned cvt2(float lo, float hi) { f32x2_t v = {lo, hi}; bf16x2_t b = __builtin_convertvector(v, bf16x2_t); return __builtin_bit_cast(unsigned, b); }
__device__ __forceinline__ bf16x8 mk8(unsigned a, unsigned b, unsigned c, unsigned d) { return __builtin_bit_cast(bf16x8, (v4u){a, b, c, d}); }
__device__ __forceinline__ bf16x8 accB(const f32x4 v) { return mk8(cvt2(v[0], v[1]), cvt2(v[2], v[3]), 0u, 0u); }
__device__ __forceinline__ v2u trd(const LAS unsigned char* p) { typedef short v4i16_t __attribute__((ext_vector_type(4)));
    return __builtin_bit_cast(v2u, __builtin_amdgcn_ds_read_tr16_b64_v4i16((LAS v4i16_t*)p)); }
#define MFMA16(a, b, c) __builtin_amdgcn_mfma_f32_16x16x32_bf16((a), (b), (c), 0, 0, 0)
#define PIN_PTR(p) asm volatile("" : "+v"(p))

#define HR_UNPACK(dst, arr, gp) do { if ((gp) & 1) unpack4(R.arr[(gp) >> 1].z, R.arr[(gp) >> 1].w, dst); else unpack4(R.arr[(gp) >> 1].x, R.arr[(gp) >> 1].y, dst); } while (0)
__device__ __forceinline__ void helper_chunk(LAS unsigned char* slot, const LAS float* cst, HReg& R, bool prefetch, const bf16* PROJ, const bf16* DAG, float* BON, int tok, int h, int lane) {
    const int t = lane & 15, kg = lane >> 4;
    LAS unsigned char* p_row = slot + t * 128 + kg * 16;
    LAS unsigned char* p_v = slot + SL_V + t * 128 + kg * 32;
    LAS unsigned char* p_tw = slot + t * 32 + kg * 8;
    const LAS unsigned char* p_tr = slot + (4 * kg + ((lane & 15) >> 2)) * 32 + (lane & 3) * 8;
    LAS unsigned char* p_g = slot + SL_G + kg * 16;
    const LAS float* p_c = cst + 16 * kg;
    PIN_PTR(p_row); PIN_PTR(p_v); PIN_PTR(p_tw); PIN_PTR(p_tr); PIN_PTR(p_g); PIN_PTR(p_c);
    float ss = 0.f;
#pragma unroll
    for (int gp = 0; gp < 4; ++gp) {
        float k[4], pk[4]; HR_UNPACK(k, k, gp); HR_UNPACK(pk, pk, gp);
        const f32x4 muk = *(const LAS f32x4*)(p_c + 1 * 64 + 4 * gp), kkc = *(const LAS f32x4*)(p_c + 3 * 64 + 4 * gp);
#pragma unroll
        for (int i = 0; i < 4; ++i) { const float kv = (k[i] + (pk[i] - k[i]) * muk[i]) * kkc[i]; ss += kv * kv; }
    }
    ss += __shfl_xor(ss, 16); ss += __shfl_xor(ss, 32);
    const float inv = 1.f / fmaxf(sqrtf(ss), 1e-12f);
#pragma unroll
    for (int i = 0; i < 2; ++i) { asm volatile("" : "+v"(R.k[i])); asm volatile("" : "+v"(R.pk[i])); }
    unsigned fa[4], fr[4], fb[4], fk[4];
    float bon = 0.f;
#pragma unroll
    for (int gp = 0; gp < 4; ++gp) {
        float r[4], k[4], v[4], pr[4], pk[4], pv[4], a[4], e[4];
        HR_UNPACK(r, r, gp); HR_UNPACK(k, k, gp); HR_UNPACK(v, v, gp); HR_UNPACK(pr, pr, gp); HR_UNPACK(pk, pk, gp); HR_UNPACK(pv, pv, gp); HR_UNPACK(a, a, gp); HR_UNPACK(e, e, gp);
        const f32x4 mur = *(const LAS f32x4*)(p_c + 0 * 64 + 4 * gp), muk = *(const LAS f32x4*)(p_c + 1 * 64 + 4 * gp), muv = *(const LAS f32x4*)(p_c + 2 * 64 + 4 * gp);
        const f32x4 kkc = *(const LAS f32x4*)(p_c + 3 * 64 + 4 * gp), kac = *(const LAS f32x4*)(p_c + 4 * 64 + 4 * gp), rkc = *(const LAS f32x4*)(p_c + 5 * 64 + 4 * gp);
        float xv[4], At[4], Rt[4], Bt[4], Kt[4]; f32x4 gv;
#pragma unroll
        for (int i = 0; i < 4; ++i) {
            const float xr = r[i] + (pr[i] - r[i]) * mur[i], xk = k[i] + (pk[i] - k[i]) * muk[i]; xv[i] = v[i] + (pv[i] - v[i]) * muv[i];
            const float kn = xk * kkc[i] * inv, kpv = xk * (1.f + (a[i] - 1.f) * kac[i]); bon += xr * kpv * rkc[i];
            float x = e[i];
            x += dpp_shr(x, 1); x += dpp_shr(x, 2); x += dpp_shr(x, 4); x += dpp_shr(x, 8);
            const float g = __builtin_amdgcn_exp2f(LOG2E * x), gi = __builtin_amdgcn_exp2f(-LOG2E * x); float gpv = dpp_shr(g, 1); gpv = (t == 0) ? 1.f : gpv;
            At[i] = -kn * gpv; Rt[i] = xr * g; Bt[i] = kn * a[i] * gi; Kt[i] = kpv * gi; gv[i] = g;
            }
        *(LAS v2u*)(p_v + gp * 8) = (v2u){cvt2(xv[0], xv[1]), cvt2(xv[2], xv[3])};
        if (t == 15) *(LAS f32x4*)(p_g + gp * 64) = gv;
        const int hf = gp & 1;
        fa[2 * hf] = cvt2(At[0], At[1]); fa[2 * hf + 1] = cvt2(At[2], At[3]); fr[2 * hf] = cvt2(Rt[0], Rt[1]); fr[2 * hf + 1] = cvt2(Rt[2], Rt[3]);
        fb[2 * hf] = cvt2(Bt[0], Bt[1]); fb[2 * hf + 1] = cvt2(Bt[2], Bt[3]); fk[2 * hf] = cvt2(Kt[0], Kt[1]); fk[2 * hf + 1] = cvt2(Kt[2], Kt[3]);
        if (hf) {
            const int ko = (gp >> 1) * 64;
            *(LAS v4u*)(p_row + SL_A + ko) = (v4u){fa[0], fa[1], fa[2], fa[3]}; *(LAS v4u*)(p_row + SL_R + ko) = (v4u){fr[0], fr[1], fr[2], fr[3]};
            *(LAS v4u*)(p_row + SL_B + ko) = (v4u){fb[0], fb[1], fb[2], fb[3]}; *(LAS v4u*)(p_row + SL_K + ko) = (v4u){fk[0], fk[1], fk[2], fk[3]};
        }

    }
    bon += __shfl_xor(bon, 16); bon += __shfl_xor(bon, 32);
    if (kg == 0) BON[(size_t)tok * NH + h] = bon;
    if (prefetch) helper_load(R, PROJ, DAG, tok + NHELP * CS, h, kg);
    const bf16x8 FA0 = *(const LAS bf16x8*)(p_row + SL_A), FA1 = *(const LAS bf16x8*)(p_row + SL_A + 64), FR0 = *(const LAS bf16x8*)(p_row + SL_R), FR1 = *(const LAS bf16x8*)(p_row + SL_R + 64);
    const bf16x8 FB0 = *(const LAS bf16x8*)(p_row + SL_B), FB1 = *(const LAS bf16x8*)(p_row + SL_B + 64), FK0 = *(const LAS bf16x8*)(p_row + SL_K), FK1 = *(const LAS bf16x8*)(p_row + SL_K + 64);
    const f32x4 z4 = (f32x4){0.f, 0.f, 0.f, 0.f};
    f32x4 Lab = MFMA16(FA0, FB0, z4); Lab = MFMA16(FA1, FB1, Lab);
    f32x4 Lak = MFMA16(FA0, FK0, z4); Lak = MFMA16(FA1, FK1, Lak);
    f32x4 Lrb = MFMA16(FR0, FB0, z4); Lrb = MFMA16(FR1, FB1, Lrb);
    f32x4 Lrk = MFMA16(FR0, FK0, z4); Lrk = MFMA16(FR1, FK1, Lrk);
    const int s = t;
#pragma unroll
    for (int r = 0; r < 4; ++r) { const int tt = 4 * kg + r;
        Lab[r] = tt > s ? Lab[r] : 0.f; Lak[r] = tt > s ? Lak[r] : 0.f; Lrb[r] = tt >= s ? Lrb[r] : 0.f; Lrk[r] = tt >= s ? Lrk[r] : 0.f; }
#define WR_TILE(off, X) (*(LAS v2u*)(p_tw + (off)) = (v2u){cvt2((X)[0], (X)[1]), cvt2((X)[2], (X)[3])})
#define RD_AFRAG(dst, off) do { const v2u w_ = trd(p_tr + (off)); dst = mk8(w_.x, w_.y, 0u, 0u); } while (0)
    WR_TILE(SL_LAK, Lak); WR_TILE(SL_LRB, Lrb); WR_TILE(SL_LRK, Lrk);
    bf16x8 AL1, AL2, AL4;
    WR_TILE(SL_T, Lab); RD_AFRAG(AL1, SL_T);
    f32x4 L2 = MFMA16(AL1, accB(Lab), z4);
    WR_TILE(SL_T, L2); RD_AFRAG(AL2, SL_T);
    f32x4 L4 = MFMA16(AL2, accB(L2), z4);
    WR_TILE(SL_T, L4); RD_AFRAG(AL4, SL_T);
    f32x4 Rm = MFMA16(AL4, accB(L4), z4);
#pragma unroll
    for (int r = 0; r < 4; ++r) Rm[r] += (4 * kg + r == s) ? 1.f : 0.f;
    Rm = MFMA16(AL4, accB(Rm), Rm);
    Rm = MFMA16(AL2, accB(Rm), Rm);
    Rm = MFMA16(AL1, accB(Rm), Rm);
    WR_TILE(SL_T, Rm);
#undef WR_TILE
#undef RD_AFRAG
}

__device__ __forceinline__ void state_chunk(const LAS unsigned char* slot, f32x4 (&X)[4], LAS unsigned char* yl, int lane, int wv) {
    const int c = lane & 15, g = lane >> 4, q4 = 4 * g + (c >> 2), pp = c & 3;
    const f32x4 z4 = (f32x4){0.f, 0.f, 0.f, 0.f};
    const LAS unsigned char* p128 = slot + c * 128 + g * 16;
    const LAS unsigned char* p_bt = slot + q4 * 128 + pp * 16;
    const LAS unsigned char* p_tr = slot + q4 * 32 + pp * 8;
    const LAS unsigned char* p_v = slot + SL_V + q4 * 128 + wv * 32 + pp * 8;
    const LAS unsigned char* pg = slot + SL_G + g * 16;
    PIN_PTR(p128); PIN_PTR(p_bt); PIN_PTR(p_tr); PIN_PTR(p_v); PIN_PTR(pg);
    const bf16x8 xb0 = mk8(cvt2(X[0][0], X[0][1]), cvt2(X[0][2], X[0][3]), cvt2(X[1][0], X[1][1]), cvt2(X[1][2], X[1][3]));
    const bf16x8 xb1 = mk8(cvt2(X[2][0], X[2][1]), cvt2(X[2][2], X[2][3]), cvt2(X[3][0], X[3][1]), cvt2(X[3][2], X[3][3]));
    const bf16x8 a0 = *(const LAS bf16x8*)(p128 + SL_A), a1 = *(const LAS bf16x8*)(p128 + SL_A + 64);
    const bf16x8 r0 = *(const LAS bf16x8*)(p128 + SL_R), r1 = *(const LAS bf16x8*)(p128 + SL_R + 64);
    const v2u vt = trd(p_v), lak = trd(p_tr + SL_LAK), tt = trd(p_tr + SL_T), lrb = trd(p_tr + SL_LRB), lrk = trd(p_tr + SL_LRK);
    f32x4 Z = MFMA16(a0, xb0, z4); Z = MFMA16(a1, xb1, Z); Z = MFMA16(mk8(lak.x, lak.y, 0u, 0u), mk8(vt.x, vt.y, 0u, 0u), Z);
    const f32x4 U = MFMA16(mk8(tt.x, tt.y, 0u, 0u), accB(Z), z4);
    const bf16x8 uv = mk8(cvt2(U[0], U[1]), cvt2(U[2], U[3]), vt.x, vt.y);
    f32x4 Y = MFMA16(r0, xb0, z4); Y = MFMA16(r1, xb1, Y); Y = MFMA16(mk8(lrb.x, lrb.y, lrk.x, lrk.y), uv, Y);
#pragma unroll
    for (int jb = 0; jb < 4; ++jb) {
        const v2u bb = trd(p_bt + SL_B + (jb >> 1) * 64 + (jb & 1) * 8), kk2 = trd(p_bt + SL_K + (jb >> 1) * 64 + (jb & 1) * 8);
        const f32x4 gm = *(const LAS f32x4*)(pg + jb * 64);
        X[jb] = MFMA16(mk8(bb.x, bb.y, kk2.x, kk2.y), uv, X[jb]) * gm;
    }
    LAS unsigned char* py = yl + (4 * g) * 128 + (16 * wv + c) * 2;
    PIN_PTR(py);
#pragma unroll
    for (int r = 0; r < 4; ++r) *(LAS unsigned short*)(py + r * 128) = (unsigned short)f2bf(Y[r]);
}

__device__ __forceinline__ void p4_scan(Frame& F, const Args& AR) {
    const bf16* PROJ = (const bf16*)(F.ws + WS_PROJ); const bf16* DAG = (const bf16*)(F.ws + WS_DAG);
    float* BON = (float*)(F.ws + WS_BON); bf16* Y = (bf16*)((unsigned char*)F.out + DO_Y);
    LAS unsigned char* lds = F.lds + RING_OFF;
    LAS float* cst = (LAS float*)(lds + SC_CONST);
    const int tid = F.tid, lane = F.lane, wave = F.wave;
    for (int unit = blockIdx.x; unit < BATCH * NH; unit += F.G) {
        const int b = unit >> 3, h = unit & 7;
        const int tok0 = b * SEQ;
        if (tid < 384) { const int a = tid >> 6, c = tid & 63; const float* src = a == 0 ? AR.in[I_MU] + RC_R : a == 1 ? AR.in[I_MU] + RC_K : a == 2 ? AR.in[I_MU] + RC_V : a == 3 ? AR.in[I_KK] : a == 4 ? AR.in[I_KA] : AR.in[I_RK];
            cst[a * 64 + c] = src[h * 64 + c]; }
        __syncthreads();
        const int st_k = tid >> 7, st_t = (tid >> 3) & 15, st_p = tid & 7;
        GAS v4u* ystore = (GAS v4u*)((GAS bf16*)Y + (size_t)(tok0 + st_k * CS + st_t) * RW + h * 64 + 8 * st_p);
        const LAS unsigned char* yl_rd = lds + SC_YL + st_k * (CS * 128) + st_t * 128 + st_p * 16;
        if (wave >= NSTATE) {
            const int hw = wave - NSTATE, kg = lane >> 4, tokl = tok0 + (lane & 15);
            HReg R;
            helper_load(R, PROJ, DAG, tokl + hw * CS, h, kg);
            for (int it = 0; it <= NIT + 1; ++it) {
                if (it >= 2 && NHELP * (it - 2) + st_k < NCHUNK) ystore[(size_t)(NHELP * (it - 2)) * CS * RW / 8] = *(const LAS v4u*)(yl_rd + (it & 1) * YL_BYTES);
                const int ch = NHELP * it + hw;
                if (ch < NCHUNK) helper_chunk(lds + ((it & 1) * NHELP + hw) * SL_BYTES, cst, R, ch + NHELP < NCHUNK, PROJ, DAG, BON, tokl + ch * CS, h, lane);
                __syncthreads();
            }
        } else {
            f32x4 X[4];
#pragma unroll
            for (int jb = 0; jb < 4; ++jb) X[jb] = (f32x4){0.f, 0.f, 0.f, 0.f};
            __builtin_amdgcn_s_setprio(3);
            for (int it = 0; it <= NIT + 1; ++it) {
                if (it >= 2 && NHELP * (it - 2) + st_k < NCHUNK) ystore[(size_t)(NHELP * (it - 2)) * CS * RW / 8] = *(const LAS v4u*)(yl_rd + (it & 1) * YL_BYTES);
                if (it > 0) {
                    for (int k = 0; k < NHELP; ++k) { const int ch = NHELP * (it - 1) + k;
                        if (ch < NCHUNK) state_chunk(lds + (((it - 1) & 1) * NHELP + k) * SL_BYTES, X, lds + SC_YL + ((it - 1) & 1) * YL_BYTES + k * (CS * 128), lane, wave); }
                }
                __syncthreads();
            }
            __builtin_amdgcn_s_setprio(0);
        }
        __syncthreads();
    }
}

__device__ __forceinline__ s16x4 vtr(const LAS unsigned char* p) { typedef short v4i16_t __attribute__((ext_vector_type(4)));
    return __builtin_bit_cast(s16x4, __builtin_amdgcn_ds_read_tr16_b64_v4i16((LAS v4i16_t*)p)); }
constexpr int ATT_UNITS = 3 * BATCH * NH * 16;
__device__ __forceinline__ void p4_attn(Frame& F, const Args& AR) {
    const bf16* PROJ = (const bf16*)(F.ws + WS_PROJ);
    bf16* PO = (bf16*)((unsigned char*)F.out + DO_PO); float* ML = (float*)(F.ws + WS_ML);
    const int tid = F.tid, lane = F.lane, wave = F.wave, half = wave >> 2, wq = wave & 3, th = tid & 255;
    const int r32 = lane & 31, hi = lane >> 5;
    LAS unsigned char* Kl = F.lds + RING_OFF + half * 65536; LAS unsigned char* Vl = Kl + 32768;
    gu32* qctr = F.ctl + CW_ATTQ;
    for (;;) {
        if (tid == 0) F.MISC[16] = __hip_atomic_fetch_add(qctr, 1u, RLX_AGENT);
        __syncthreads();
        const int up = (int)F.MISC[16];
        if (up >= ATT_UNITS / 2) break;
        const int unit = 2 * up + half;
        const int pat = unit / (BATCH * NH * 16), rem = unit % (BATCH * NH * 16), bh = rem >> 4, i16 = rem & 15, b = bh >> 3, h = bh & 7;
        const int dil = pat == 0 ? 1 : (pat == 1 ? 4 : 16);
        const int res = pat == 0 ? 0 : (pat == 1 ? (i16 >> 2) : i16);
        const int n = pat == 0 ? i16 : (pat == 1 ? (i16 & 3) : 0);
        const size_t rowb = (size_t)b * SEQ;
        {
            const int c = th & 7;
#pragma unroll
            for (int i = 0; i < 8; ++i) {
                const int key = (th >> 3) + 32 * i; const int sub = 128 * (n - 1) + key;
                v4u kv = (v4u){0u, 0u, 0u, 0u}, vv = kv;
                if (sub >= 0) { const bf16* src = PROJ + (rowb + res + dil * sub) * IN_COLS + h * 64 + 8 * c; kv = *(const v4u*)(src + PC_K); vv = *(const v4u*)(src + PC_V); }
                *(LAS v4u*)(Kl + key * 128 + ((c ^ ((key >> 1) & 7)) * 16)) = kv;
                *(LAS v4u*)(Vl + (c >> 2) * 16384 + key * 64 + (c & 3) * 16) = vv;
            }
        }
        const int ql = 32 * wq + r32; const size_t qrow = rowb + res + dil * (128 * n + ql);
        bf16x8 qf[4];
#pragma unroll
        for (int d0 = 0; d0 < 4; ++d0) qf[d0] = *(const bf16x8*)(PROJ + qrow * IN_COLS + PC_Q + h * 64 + 16 * d0 + 8 * hi);
        __syncthreads();
        const float slope2 = __builtin_amdgcn_exp2f(-(float)(h + 1)) * (float)dil * LOG2E;
        const int thr = r32 - 4 * hi;
        f32x16 sc[5];
        float mx = -INFINITY;
#pragma unroll
        for (int kt = 0; kt < 5; ++kt) {
            const bool skip = (n == 0) && (wq + kt < 4);
            f32x16 acc;
            if (!skip) {
                const int key = 32 * (wq + kt) + r32;
                const float bk = -slope2 * (float)(128 - 32 * kt + thr);
#pragma unroll
                for (int r = 0; r < 16; ++r) acc[r] = slope2 * (float)((r & 3) + 8 * (r >> 2)) + bk;
#pragma unroll
                for (int d0 = 0; d0 < 4; ++d0) {
                    const bf16x8 kf = *(const LAS bf16x8*)(Kl + key * 128 + (((2 * d0 + hi) ^ ((key >> 1) & 7)) * 16));
                    acc = __builtin_amdgcn_mfma_f32_32x32x16_bf16(kf, qf[d0], acc, 0, 0, 0);
                }
                if (kt == 0) {
#pragma unroll
                    for (int r = 0; r < 16; ++r) acc[r] = ((r & 3) + 8 * (r >> 2)) >= thr ? acc[r] : -INFINITY;
                }
                if (kt == 4) {
#pragma unroll
                    for (int r = 0; r < 16; ++r) acc[r] = ((r & 3) + 8 * (r >> 2)) <= thr ? acc[r] : -INFINITY;
                }
#pragma unroll
                for (int r = 0; r < 16; ++r) mx = fmaxf(mx, acc[r]);
            } else {
#pragma unroll
                for (int r = 0; r < 16; ++r) acc[r] = -INFINITY;
            }
            sc[kt] = acc;
            __builtin_amdgcn_sched_barrier(0);
        }
        mx = fmaxf(mx, __shfl_xor(mx, 32));
        float l = 0.f;
#pragma unroll
        for (int kt = 0; kt < 5; ++kt)
#pragma unroll
            for (int r = 0; r < 16; ++r) { const float p = __builtin_amdgcn_exp2f(sc[kt][r] - mx); sc[kt][r] = p; l += p; }
        l += __shfl_xor(l, 32);
        f32x16 o[2]; o[0] = f32x16{}; o[1] = f32x16{};
        const int voff = ((lane >> 4) & 1) * 32 + (lane & 3) * 8 + (4 * hi + ((lane & 15) >> 2)) * 64;
#pragma unroll
        for (int kt = 0; kt < 5; ++kt) {
            const bool skip = (n == 0) && (wq + kt < 4);
            if (!skip) {
#pragma unroll
            for (int s2 = 0; s2 < 2; ++s2) {
                v4u pw;
                pw.x = pg8::cvt_pk_bf16(sc[kt][8 * s2 + 0], sc[kt][8 * s2 + 1]); pw.y = pg8::cvt_pk_bf16(sc[kt][8 * s2 + 2], sc[kt][8 * s2 + 3]);
                pw.z = pg8::cvt_pk_bf16(sc[kt][8 * s2 + 4], sc[kt][8 * s2 + 5]); pw.w = pg8::cvt_pk_bf16(sc[kt][8 * s2 + 6], sc[kt][8 * s2 + 7]);
                const bf16x8 pf = __builtin_bit_cast(bf16x8, pw);
                const int kb = 32 * (wq + kt) + 16 * s2;
#pragma unroll
                for (int dt = 0; dt < 2; ++dt) {
                    const LAS unsigned char* vp = Vl + dt * 16384 + kb * 64 + voff;
                    const s16x4 lo = vtr(vp), hi4 = vtr(vp + 8 * 64);
                    const bf16x8 vf = (bf16x8){lo[0], lo[1], lo[2], lo[3], hi4[0], hi4[1], hi4[2], hi4[3]};
                    o[dt] = __builtin_amdgcn_mfma_f32_32x32x16_bf16(vf, pf, o[dt], 0, 0, 0);
                }
            }
            }
        }
        const float rl = 1.f / l;
        bf16* po = PO + ((size_t)pat * M + qrow) * AW + h * 64;
#pragma unroll
        for (int dt = 0; dt < 2; ++dt)
#pragma unroll
            for (int g = 0; g < 4; ++g) {
                const v2u w = (v2u){pk2(o[dt][4 * g] * rl, o[dt][4 * g + 1] * rl), pk2(o[dt][4 * g + 2] * rl, o[dt][4 * g + 3] * rl)};
                *(v2u*)(po + 32 * dt + 8 * g + 4 * hi) = w;
            }
        if (hi == 0) *(f32x2*)(ML + (((size_t)pat * M + qrow) * NH + h) * 2) = (f32x2){mx, l};
        __syncthreads();
    }
}

__device__ __forceinline__ void p5_post(Frame& F, const Args& AR) {
    const int gw = F.vcu * NWAVES + F.wave, NGW = F.G * NWAVES, lane = F.lane, hd = lane >> 3;
    const bf16* PROJ = (const bf16*)(F.ws + WS_PROJ); const bf16* DAG = (const bf16*)(F.ws + WS_DAG); const float* BON = (const float*)(F.ws + WS_BON);
    const bf16* PO = (const bf16*)((unsigned char*)F.out + DO_PO); const float* ML = (const float*)(F.ws + WS_ML); const bf16* Y = (const bf16*)((unsigned char*)F.out + DO_Y);
    bf16* MIX = (bf16*)(F.ws + WS_XN);
    float aog[8], lng[8], lnb[8], muv[8];
#pragma unroll
    for (int i = 0; i < 8; ++i) { aog[i] = AR.in[I_AOG][8 * lane + i]; lng[i] = AR.in[I_LNG][8 * lane + i]; lnb[i] = AR.in[I_LNB][8 * lane + i]; muv[i] = AR.in[I_MU][RC_V + 8 * lane + i]; }
    for (int m = gw; m < M; m += NGW) {
        float mp[3], lp[3];
#pragma unroll
        for (int p = 0; p < 3; ++p) { const f32x2 t = *(const f32x2*)(ML + (((size_t)p * M + m) * NH + hd) * 2); mp[p] = t.x; lp[p] = t.y; }
        const float mm = fmaxf(fmaxf(mp[0], mp[1]), mp[2]);
        float wp[3], wsum = 0.f;
#pragma unroll
        for (int p = 0; p < 3; ++p) { wp[p] = __builtin_amdgcn_exp2f(mp[p] - mm) * lp[p]; wsum += wp[p]; }
        const float rws = 1.f / wsum;
        float at[8] = {0.f, 0.f, 0.f, 0.f, 0.f, 0.f, 0.f, 0.f};
#pragma unroll
        for (int p = 0; p < 3; ++p) { const v4u w = *(const v4u*)(PO + ((size_t)p * M + m) * AW + 8 * lane); const float f = wp[p] * rws;
            at[0] += f * bflo(w.x); at[1] += f * bfhi(w.x); at[2] += f * bflo(w.y); at[3] += f * bfhi(w.y); at[4] += f * bflo(w.z); at[5] += f * bfhi(w.z); at[6] += f * bflo(w.w); at[7] += f * bfhi(w.w); }
        float ss = 0.f;
#pragma unroll
        for (int i = 0; i < 8; ++i) ss += at[i] * at[i];
        ss += __shfl_xor(ss, 1); ss += __shfl_xor(ss, 2); ss += __shfl_xor(ss, 4);
        const float rstd = 1.f / sqrtf(ss * (1.f / 64.f) + NORM_EPS);
        v4u oa; oa.x = pk2(at[0] * rstd * aog[0], at[1] * rstd * aog[1]); oa.y = pk2(at[2] * rstd * aog[2], at[3] * rstd * aog[3]);
        oa.z = pk2(at[4] * rstd * aog[4], at[5] * rstd * aog[5]); oa.w = pk2(at[6] * rstd * aog[6], at[7] * rstd * aog[7]);
        *(v4u*)(MIX + (size_t)m * D + 8 * lane) = oa;
        const v4u yw = *(const v4u*)(Y + (size_t)m * RW + 8 * lane);
        float y[8] = {bflo(yw.x), bfhi(yw.x), bflo(yw.y), bfhi(yw.y), bflo(yw.z), bfhi(yw.z), bflo(yw.w), bfhi(yw.w)};
        float sm = 0.f;
#pragma unroll
        for (int i = 0; i < 8; ++i) sm += y[i];
        sm += __shfl_xor(sm, 1); sm += __shfl_xor(sm, 2); sm += __shfl_xor(sm, 4);
        const float mean = sm * (1.f / 64.f); float sv = 0.f;
#pragma unroll
        for (int i = 0; i < 8; ++i) { y[i] -= mean; sv += y[i] * y[i]; }
        sv += __shfl_xor(sv, 1); sv += __shfl_xor(sv, 2); sv += __shfl_xor(sv, 4);
        const float rs = 1.f / sqrtf(sv * (1.f / 64.f) + LNX_EPS);
        const bf16* prow = PROJ + (size_t)m * IN_COLS + PC_RW + RC_V + 8 * lane;
        const v4u vc = *(const v4u*)prow; v4u vp = (v4u){0u, 0u, 0u, 0u};
        if ((m & (SEQ - 1)) != 0) vp = *(const v4u*)(prow - IN_COLS);
        const v4u gw4 = *(const v4u*)(DAG + (size_t)m * NLORA + 1024 + 8 * lane);
        const float bon = BON[(size_t)m * NH + hd];
        const float vcf[8] = {bflo(vc.x), bfhi(vc.x), bflo(vc.y), bfhi(vc.y), bflo(vc.z), bfhi(vc.z), bflo(vc.w), bfhi(vc.w)};
        const float vpf[8] = {bflo(vp.x), bfhi(vp.x), bflo(vp.y), bfhi(vp.y), bflo(vp.z), bfhi(vp.z), bflo(vp.w), bfhi(vp.w)};
        const float gf[8] = {bflo(gw4.x), bfhi(gw4.x), bflo(gw4.y), bfhi(gw4.y), bflo(gw4.z), bfhi(gw4.z), bflo(gw4.w), bfhi(gw4.w)};
        float ro[8];
#pragma unroll
        for (int i = 0; i < 8; ++i) { const float xv = vcf[i] + (vpf[i] - vcf[i]) * muv[i]; ro[i] = (y[i] * rs * lng[i] + lnb[i] + bon * xv) * gf[i]; }
        v4u orw; orw.x = pk2(ro[0], ro[1]); orw.y = pk2(ro[2], ro[3]); orw.z = pk2(ro[4], ro[5]); orw.w = pk2(ro[6], ro[7]);
        *(v4u*)(MIX + (size_t)m * D + AW + 8 * lane) = orw;
    }
}

__global__ void __launch_bounds__(NWAVES * 64, 2) hybrid_fwd(Args args) {
    extern __shared__ __attribute__((aligned(16))) unsigned char lds[];
    Frame F;
    F.lds = (LAS unsigned char*)lds;
    F.MISC = (volatile LAS unsigned*)(F.lds + MISC_OFF);
    F.tid = threadIdx.x; F.lane = F.tid & 63; F.wave = __builtin_amdgcn_readfirstlane(F.tid >> 6);
    F.G = gridDim.x; { const int bx = blockIdx.x; F.vcu = (F.G % 8 == 0) ? (bx % 8) * (F.G / 8) + bx / 8 : bx; }
    F.ws = args.ws; F.out = args.out;
    F.ctl = (gu32*)(args.ws + WS_CTL);
    for (int u = F.tid; u < (LDS_BYTES - LDSCTL_OFF) / 4; u += NWAVES * 64) ((LAS unsigned*)(F.lds + LDSCTL_OFF))[u] = 0u;
    __syncthreads();
    XcdBarrier bar; bar.bar = (unsigned*)(F.ctl + CW_BAR); bar.x = 0; bar.st = nullptr;
    if (N_LAUNCHES != PER_PHASE) bar = xcd_barrier_post((unsigned*)(F.ctl + CW_BAR), F.MISC + 8);
#define GRID_BAR() do { if (N_LAUNCHES != PER_PHASE) xcd_barrier(bar); } while (0)
    const int lo = args.ph_lo, hi = args.ph_hi;
#ifndef PHMASK
#define PHMASK 0x3ff
#endif
#define IN(k) (((PHMASK >> (k)) & 1) && lo <= (k) && (k) < hi)
#define BOTH(k) (IN(k) && IN((k) + 1))
#ifndef REPMASK
#define REPMASK 0
#endif
#define REP(k) for (int rep_ = 0; rep_ <= ((REPMASK >> (k)) & 1); ++rep_)
    bf16* XN = (bf16*)(args.ws + WS_XN); bf16* PROJ = (bf16*)(args.ws + WS_PROJ);

    if (IN(0)) { p0_prologue(F, args); if (BOTH(0)) GRID_BAR(); }
    if (IN(1)) {
        pg8::Gemm g{XN, (const bf16*)(args.ws + WS_WIN), M, IN_COLS, D}; pg8::StaticOrder S; S.init(M, IN_COLS, F.G, (int)blockIdx.x);
        pg8::EpiProj E{PROJ, IN_COLS, args.in[I_QNG], args.in[I_KNG]};
        pg8::gemm_phase<pg8::EpiProj, pg8::StaticOrder, true, true>(F.lds + RING_OFF, g, S, E);
        if (BOTH(1)) GRID_BAR();
    }
    if (IN(2)) { p2_prep(F, args); if (BOTH(2)) GRID_BAR(); }
    if (IN(3)) {
        pg8::Gemm g{(const bf16*)(args.ws + WS_A2), (const bf16*)(args.ws + WS_WL), M, NLORA, KLORA}; pg8::StaticOrder S; S.init(M, NLORA, F.G, (int)blockIdx.x);
        pg8::EpiLora E{(bf16*)(args.ws + WS_DAG), NLORA, args.in[I_W0], args.in[I_A0]};
        pg8::gemm_phase<pg8::EpiLora, pg8::StaticOrder, true, true>(F.lds + RING_OFF, g, S, E);
        if (BOTH(3)) GRID_BAR();
    }
    if (IN(4)) { p4_scan(F, args); p4_attn(F, args); if (BOTH(4)) GRID_BAR(); }
    if (IN(5)) { p5_post(F, args); if (BOTH(5)) GRID_BAR(); }
    if (IN(6)) {
        pg8::Gemm g{XN, (const bf16*)(args.ws + WS_WOUT), M, D, D}; pg8::StaticOrder S; S.init(M, D, F.G, (int)blockIdx.x);
        pg8::EpiOut E{args.in[I_X], (bf16*)(args.ws + WS_DAG), (float*)(args.ws + WS_SS), D, (LAS float*)(F.lds + RING_OFF + 131072)};
        pg8::gemm_phase<pg8::EpiOut, pg8::StaticOrder, true, true>(F.lds + RING_OFF, g, S, E);
        if (IN(8)) GRID_BAR();
    }
    if (IN(8)) {
        pg8::Gemm g{(const bf16*)(args.ws + WS_DAG), (const bf16*)(args.ws + WS_WGU), M, NGU, D}; pg8::StaticOrder S; S.init(M, NGU, F.G, (int)blockIdx.x);
        pg8::EpiSwiglu E{PROJ, FF, (const float*)(args.ws + WS_SS)};
        pg8::gemm_phase<pg8::EpiSwiglu, pg8::StaticOrder, true, true>(F.lds + RING_OFF, g, S, E);
        if (BOTH(8)) GRID_BAR();
    }
    if (IN(9)) {
        pg8::Gemm g{PROJ, (const bf16*)(args.ws + WS_WDN), M, D, FF}; pg8::StaticOrder S; S.init(M, D, F.G, (int)blockIdx.x);
        pg8::EpiFinal E{(const bf16*)(args.ws + WS_DAG), F.out, D};
        pg8::gemm_phase<pg8::EpiFinal, pg8::StaticOrder, true, true>(F.lds + RING_OFF, g, S, E);
    }
#undef IN
#undef BOTH
}

extern "C" void kernel_launch(void* const* d_in, const int* in_sizes, int n_in, void* d_out, int out_size, void* d_ws, size_t ws_size, hipStream_t stream) {
    static int grid = 0;
    if (grid == 0) {
        if (n_in != 22 || in_sizes[0] != M * D || out_size != M * D || ws_size < WS_END) { fprintf(stderr, "kernel_launch: unexpected shapes (n_in %d, in0 %d, out %d, ws %zu); nothing launched\n", n_in, n_in > 0 ? in_sizes[0] : -1, out_size, ws_size); grid = -1; return; }
        int dev = 0, cus = 0, per_cu = 0;
        if (hipGetDevice(&dev) != hipSuccess || hipDeviceGetAttribute(&cus, hipDeviceAttributeMultiprocessorCount, dev) != hipSuccess) { grid = -1; return; }
        if (hipFuncSetAttribute((const void*)hybrid_fwd, hipFuncAttributeMaxDynamicSharedMemorySize, LDS_BYTES) != hipSuccess) { fprintf(stderr, "kernel_launch: hipFuncSetAttribute failed\n"); grid = -1; return; }
        if (hipOccupancyMaxActiveBlocksPerMultiprocessor(&per_cu, (const void*)hybrid_fwd, NWAVES * 64, LDS_BYTES) != hipSuccess || per_cu < 1)
            fprintf(stderr, "kernel_launch: note: occupancy query reports %d workgroups per CU\n", per_cu);
        (void)hipGetLastError();
        grid = cus;
    }
    if (grid < 0) return;
    if (hipMemsetAsync((char*)d_ws + WS_CTL, 0, CTL_ZERO_BYTES, stream) != hipSuccess) { fprintf(stderr, "kernel_launch: hipMemsetAsync failed\n"); return; }
    Args a{};
    for (int i = 0; i < 22; ++i) a.in[i] = (const float*)d_in[i];
    a.out = (float*)d_out; a.ws = (unsigned char*)d_ws;
    for (int li = 0; li < N_LAUNCHES; ++li) {
        a.ph_lo = (N_LAUNCHES == PER_PHASE) ? li : 0; a.ph_hi = (N_LAUNCHES == PER_PHASE) ? li + 1 : PER_PHASE; a.li = li;
        hipLaunchKernelGGL(hybrid_fwd, dim3(grid), dim3(NWAVES * 64), LDS_BYTES, stream, a);
        const hipError_t le = hipPeekAtLastError();
        if (le != hipSuccess) { fprintf(stderr, "kernel_launch: launch %d failed: %s\n", li, hipGetErrorName(le)); break; }
    }
}
```

```cpp
#include <hip/hip_runtime.h>
#include <cstdio>
#include <cstdint>

#ifndef MK_N_LAUNCHES
#define MK_N_LAUNCHES 1
#endif

namespace pg8 {
#define PG8_LAS __attribute__((address_space(3)))
typedef unsigned short bf16_t;
typedef short bf16x8 __attribute__((ext_vector_type(8)));
typedef float f32x4 __attribute__((ext_vector_type(4)));
typedef float f32x2 __attribute__((ext_vector_type(2)));
typedef unsigned u32x4 __attribute__((ext_vector_type(4)));
constexpr int BM = 256, BK = 64, HALF = 128, HTB = HALF * BK * 2, STAGE_BYTES = 8 * HTB, NXCD = 8, WGM = 8;

__host__ __device__ __forceinline__ int lds_byte(int r, int c) { const int st = (r >> 4) * 2 + (c >> 5), rr = r & 15, cc = c & 31, ob = rr * 64 + cc * 2; return st * 1024 + (ob ^ (((ob >> 9) & 1) << 5)); }
__host__ __device__ __forceinline__ void stage_rc(int b, int& R, int& C) { const int st = b / 1024, sb = b % 1024, swz = sb ^ (((sb >> 9) & 1) << 5); R = (st >> 1) * 16 + swz / 64; C = (st & 1) * 32 + (swz % 64) / 2; }
__host__ __device__ __forceinline__ int perm32(int rho) { const int n = rho >> 4, i = rho & 15; return 8 * (i >> 2) + 4 * n + (i & 3); }

struct Unit { int pm, pn; };
struct Gemm { const bf16_t* A; const bf16_t* Bt; int M, N, K; };

struct StaticOrder {
    int nM, nN, nwg, G, c;
    __host__ __device__ void init(int M, int N, int G_, int c_) { nM = M / BM; nN = N / BM; nwg = nM * nN; G = G_; c = c_; }
    __host__ __device__ bool next(int i, Unit& u) const {
        const long L = (long)i * G + c; if (L >= nwg) return false;
        int wgid = (int)L; { const int q = nwg / NXCD, r = nwg % NXCD, xcd = wgid % NXCD, off = wgid / NXCD; wgid = (xcd < r ? xcd * (q + 1) : r * (q + 1) + (xcd - r) * q) + off; }
        const int nig = WGM * nN, gid = wgid / nig, fm = gid * WGM, gsz = (nM - fm) < WGM ? (nM - fm) : WGM;
        u.pm = fm + ((wgid % nig) % gsz); u.pn = (wgid % nig) / gsz; return true;
    }
    __device__ __forceinline__ void a_ready(const Unit&) const {}
    __device__ __forceinline__ void done(const Unit&) const {}
};

__device__ __forceinline__ unsigned cvt_pk_bf16(float lo, float hi) { unsigned r; asm volatile("v_cvt_pk_bf16_f32 %0, %1, %2" : "=v"(r) : "v"(lo), "v"(hi)); return r; }
__device__ __forceinline__ float fsigmoid(float x) { return __builtin_amdgcn_rcpf(1.0f + __builtin_amdgcn_exp2f(-1.4426950408889634f * x)); }

struct EpiBf16 {
    static constexpr bool PERM = true, AFTER_DRAIN = false;
    bf16_t* O; int ldc;
    __device__ __forceinline__ void operator()(const f32x4 (&acc)[2][2][4][2], const Unit& u, int wr, int wc, int fr, int fq) const {
        const int row0 = u.pm * BM + wr * 64 + fr; const int col0 = u.pn * BM + wc * 32 + 8 * fq;
#pragma unroll
        for (int ai = 0; ai < 2; ++ai)
#pragma unroll
            for (int m = 0; m < 4; ++m) { bf16_t* rowp = O + (size_t)(row0 + ai * HALF + m * 16) * ldc + col0;
#pragma unroll
                for (int bj = 0; bj < 2; ++bj) { const f32x4 v0 = acc[ai][bj][m][0], v1 = acc[ai][bj][m][1];
                    u32x4 w; w.x = cvt_pk_bf16(v0[0], v0[1]); w.y = cvt_pk_bf16(v0[2], v0[3]); w.z = cvt_pk_bf16(v1[0], v1[1]); w.w = cvt_pk_bf16(v1[2], v1[3]);
                    *(u32x4*)(rowp + bj * HALF) = w; } }
    }
};
struct EpiProj {
    static constexpr bool PERM = true, AFTER_DRAIN = false;
    bf16_t* O; int ldc; const float* qg; const float* kg;
    __device__ __forceinline__ void operator()(const f32x4 (&acc)[2][2][4][2], const Unit& u, int wr, int wc, int fr, int fq) const {
        const int row0 = u.pm * BM + wr * 64 + fr;
        if (u.pn >= 4) {
            const int col0 = u.pn * BM + wc * 32 + 8 * fq;
#pragma unroll
            for (int ai = 0; ai < 2; ++ai)
#pragma unroll
                for (int m = 0; m < 4; ++m) { bf16_t* rowp = O + (size_t)(row0 + ai * HALF + m * 16) * ldc + col0;
#pragma unroll
                    for (int bj = 0; bj < 2; ++bj) { const f32x4 v0 = acc[ai][bj][m][0], v1 = acc[ai][bj][m][1];
                        u32x4 w; w.x = cvt_pk_bf16(v0[0], v0[1]); w.y = cvt_pk_bf16(v0[2], v0[3]); w.z = cvt_pk_bf16(v1[0], v1[1]); w.w = cvt_pk_bf16(v1[2], v1[3]);
                        *(u32x4*)(rowp + bj * HALF) = w; } }
        } else {
            const float* gsrc = (u.pn < 2 ? qg : kg) + 8 * fq; const float sc = u.pn < 2 ? 0.125f * 1.4426950408889634f : 1.0f;
            f32x4 g4[2][2];
#pragma unroll
            for (int bj = 0; bj < 2; ++bj)
#pragma unroll
                for (int n = 0; n < 2; ++n) g4[bj][n] = *(const f32x4*)(gsrc + 32 * bj + 4 * n) * sc;
            const int col0 = u.pn * BM + wc * 64 + 8 * fq;
#pragma unroll
            for (int ai = 0; ai < 2; ++ai)
#pragma unroll
                for (int m = 0; m < 4; ++m) {
                    float ss = 0.f;
#pragma unroll
                    for (int bj = 0; bj < 2; ++bj)
#pragma unroll
                        for (int n = 0; n < 2; ++n) { const f32x4 v = acc[ai][bj][m][n]; ss += (v[0] * v[0] + v[1] * v[1]) + (v[2] * v[2] + v[3] * v[3]); }
                    ss += __shfl_xor(ss, 16); ss += __shfl_xor(ss, 32);
                    const float rstd = 1.0f / sqrtf(ss * (1.0f / 64.0f) + 1e-6f);
                    bf16_t* rowp = O + (size_t)(row0 + ai * HALF + m * 16) * ldc + col0;
#pragma unroll
                    for (int bj = 0; bj < 2; ++bj) { const f32x4 v0 = acc[ai][bj][m][0] * g4[bj][0] * rstd, v1 = acc[ai][bj][m][1] * g4[bj][1] * rstd;
                        u32x4 w; w.x = cvt_pk_bf16(v0[0], v0[1]); w.y = cvt_pk_bf16(v0[2], v0[3]); w.z = cvt_pk_bf16(v1[0], v1[1]); w.w = cvt_pk_bf16(v1[2], v1[3]);
                        *(u32x4*)(rowp + 32 * bj) = w; }
                    __builtin_amdgcn_sched_barrier(0); }
        }
    }
};
struct EpiLora {
    static constexpr bool PERM = true, AFTER_DRAIN = false;
    bf16_t* O; int ldc; const float* w0; const float* a0;
    __device__ __forceinline__ void operator()(const f32x4 (&acc)[2][2][4][2], const Unit& u, int wr, int wc, int fr, int fq) const {
        const int row0 = u.pm * BM + wr * 64 + fr; const int col0 = u.pn * BM + wc * 32 + 8 * fq;
        const int kind = u.pn >> 1;
        const float sc = kind == 0 ? -0.6065306597126334f : (kind == 1 ? 1.0f : 0.0f), lin = kind == 2 ? 1.0f : 0.0f;
        const float* bp = kind == 0 ? w0 : a0;
        const float bs = kind == 2 ? 0.0f : 1.0f;
#pragma unroll
        for (int bj = 0; bj < 2; ++bj) {
            const int c = (col0 + bj * HALF) & 511;
            const f32x4 b0 = *(const f32x4*)(bp + c) * bs, b1 = *(const f32x4*)(bp + c + 4) * bs;
#pragma unroll
            for (int ai = 0; ai < 2; ++ai)
#pragma unroll
                for (int m = 0; m < 4; ++m) { bf16_t* rowp = O + (size_t)(row0 + ai * HALF + m * 16) * ldc + col0;
                    f32x4 v0 = acc[ai][bj][m][0] + b0, v1 = acc[ai][bj][m][1] + b1;
#pragma unroll
                    for (int e = 0; e < 4; ++e) { v0[e] = sc * fsigmoid(v0[e]) + lin * v0[e]; v1[e] = sc * fsigmoid(v1[e]) + lin * v1[e]; }
                    u32x4 w; w.x = cvt_pk_bf16(v0[0], v0[1]); w.y = cvt_pk_bf16(v0[2], v0[3]); w.z = cvt_pk_bf16(v1[0], v1[1]); w.w = cvt_pk_bf16(v1[2], v1[3]);
                    *(u32x4*)(rowp + bj * HALF) = w;
                    __builtin_amdgcn_sched_barrier(0); }
        }
    }
};
struct EpiSwiglu {
    static constexpr bool PERM = true, AFTER_DRAIN = false;
    bf16_t* H; int ldh; const float* rstd;
    __device__ __forceinline__ void operator()(const f32x4 (&acc)[2][2][4][2], const Unit& u, int wr, int wc, int fr, int fq) const {
        const int row0 = u.pm * BM + wr * 64 + fr; const int col0 = u.pn * HALF + wc * 32 + 8 * fq;
        float rs[2][4];
#pragma unroll
        for (int ai = 0; ai < 2; ++ai)
#pragma unroll
            for (int m = 0; m < 4; ++m) { const f32x4 s4 = *(const f32x4*)(rstd + (size_t)(row0 + ai * HALF + m * 16) * 4);
                rs[ai][m] = 1.0f / sqrtf(((s4[0] + s4[1]) + (s4[2] + s4[3])) * (1.0f / 1024.0f) + 1e-6f); }
#pragma unroll
        for (int ai = 0; ai < 2; ++ai)
#pragma unroll
            for (int m = 0; m < 4; ++m) { bf16_t* rowp = H + (size_t)(row0 + ai * HALF + m * 16) * ldh + col0;
                float h[8];
#pragma unroll
                for (int n = 0; n < 2; ++n)
#pragma unroll
                    for (int e = 0; e < 4; ++e) { const float g = acc[ai][0][m][n][e] * rs[ai][m], up = acc[ai][1][m][n][e] * rs[ai][m]; h[4 * n + e] = g * fsigmoid(g) * up; }
                u32x4 w; w.x = cvt_pk_bf16(h[0], h[1]); w.y = cvt_pk_bf16(h[2], h[3]); w.z = cvt_pk_bf16(h[4], h[5]); w.w = cvt_pk_bf16(h[6], h[7]);
                *(u32x4*)rowp = w;
                __builtin_amdgcn_sched_barrier(0); }
    }
};
struct EpiOut {
    static constexpr bool PERM = true, AFTER_DRAIN = false;
    const float* base; bf16_t* xb; float* SS; int ldc; PG8_LAS float* scr;
    __device__ __forceinline__ void operator()(const f32x4 (&acc)[2][2][4][2], const Unit& u, int wr, int wc, int fr, int fq) const {
        const int row0 = u.pm * BM + wr * 64 + fr, col0 = u.pn * BM + wc * 32 + 8 * fq;
#pragma unroll
        for (int ai = 0; ai < 2; ++ai)
#pragma unroll
            for (int m = 0; m < 4; ++m) { const size_t off = (size_t)(row0 + ai * HALF + m * 16) * ldc + col0;
                float ss = 0.f;
#pragma unroll
                for (int bj = 0; bj < 2; ++bj) {
                    const f32x4 o0 = *(const f32x4*)(base + off + bj * HALF) + acc[ai][bj][m][0], o1 = *(const f32x4*)(base + off + bj * HALF + 4) + acc[ai][bj][m][1];
                    u32x4 w; w.x = cvt_pk_bf16(o0[0], o0[1]); w.y = cvt_pk_bf16(o0[2], o0[3]); w.z = cvt_pk_bf16(o1[0], o1[1]); w.w = cvt_pk_bf16(o1[2], o1[3]);
                    *(u32x4*)(xb + off + bj * HALF) = w;
                    ss += ((o0[0] * o0[0] + o0[1] * o0[1]) + (o0[2] * o0[2] + o0[3] * o0[3])) + ((o1[0] * o1[0] + o1[1] * o1[1]) + (o1[2] * o1[2] + o1[3] * o1[3])); }
                ss += __shfl_xor(ss, 16); ss += __shfl_xor(ss, 32);
                if (fq == 0) scr[((((wr * 2 + ai) * 4 + m) * 16) + fr) * 4 + wc] = ss;
                if (m & 1) asm volatile("" ::: "memory"); }
        asm volatile("s_waitcnt lgkmcnt(0)" ::: "memory"); __builtin_amdgcn_s_barrier(); asm volatile("" ::: "memory");
        const int tid = threadIdx.x;
        if (tid < 256) { const f32x4 s4 = *(const PG8_LAS f32x4*)(scr + tid * 4);
            const int row = u.pm * BM + ((tid >> 6) & 1) * HALF + (tid >> 7) * 64 + ((tid >> 4) & 3) * 16 + (tid & 15);
            SS[(size_t)row * 4 + u.pn] = (s4[0] + s4[1]) + (s4[2] + s4[3]); }
    }
};
struct EpiFinal {
    static constexpr bool PERM = true, AFTER_DRAIN = false;
    const bf16_t* xb; float* out; int ldc;
    __device__ __forceinline__ void operator()(const f32x4 (&acc)[2][2][4][2], const Unit& u, int wr, int wc, int fr, int fq) const {
        const int row0 = u.pm * BM + wr * 64 + fr, col0 = u.pn * BM + wc * 32 + 8 * fq;
#pragma unroll
        for (int ai = 0; ai < 2; ++ai)
#pragma unroll
            for (int m = 0; m < 4; ++m) { const size_t off = (size_t)(row0 + ai * HALF + m * 16) * ldc + col0;
#pragma unroll
                for (int bj = 0; bj < 2; ++bj) { const u32x4 w = *(const u32x4*)(xb + off + bj * HALF);
                    const f32x4 b0 = (f32x4){__builtin_bit_cast(float, w.x << 16), __builtin_bit_cast(float, w.x & 0xffff0000u), __builtin_bit_cast(float, w.y << 16), __builtin_bit_cast(float, w.y & 0xffff0000u)};
                    const f32x4 b1 = (f32x4){__builtin_bit_cast(float, w.z << 16), __builtin_bit_cast(float, w.z & 0xffff0000u), __builtin_bit_cast(float, w.w << 16), __builtin_bit_cast(float, w.w & 0xffff0000u)};
                    *(f32x4*)(out + off + bj * HALF) = b0 + acc[ai][bj][m][0]; *(f32x4*)(out + off + bj * HALF + 4) = b1 + acc[ai][bj][m][1]; }
                if (m & 1) asm volatile("" ::: "memory"); }
    }
};

template <class Epi, class Sched, bool ALIGN_EPI = false, bool SP2 = false>
__device__ __forceinline__ void gemm_phase(PG8_LAS unsigned char* lds, const Gemm g, const Sched& S, const Epi& E) {
    const int tid = threadIdx.x, wid = __builtin_amdgcn_readfirstlane(tid >> 6), lane = tid & 63, wr = wid >> 2, wc = wid & 3, fr = lane & 15, fq = lane >> 4;
    const int K = g.K, nt = K / BK;
    unsigned voffA[2], voffB[2];
#pragma unroll
    for (int i = 0; i < 2; ++i) { int R, C; stage_rc(tid * 16 + i * 8192, R, C); const int Rb = Epi::PERM ? ((R & ~31) + perm32(R & 31)) : R;
        voffA[i] = (unsigned)(R * K + C) * 2u; voffB[i] = (unsigned)(Rb * K + C) * 2u; }
    const size_t kstep = (size_t)(BK * 2);
    const size_t hstep = (size_t)HALF * K * 2;
    const size_t tstep = 2 * hstep;
    const unsigned ldsw = (unsigned)wid * 1024u;
    const int aoff = lds_byte(wr * 64 + fr, fq * 8), boff = lds_byte(wc * 32 + fr, fq * 8);
#define PG8_SA(b, h) (((b) * 2 + (h)) * HTB)
#define PG8_SB(b, h) ((4 + (b) * 2 + (h)) * HTB)
#define PG8_STAGE(bufoff, gbase, voff) do { _Pragma("unroll") for (int _i = 0; _i < 2; ++_i) \
        __builtin_amdgcn_global_load_lds((const unsigned*)((const char*)(gbase) + (voff)[_i]), (PG8_LAS unsigned*)(lds + (bufoff) + ldsw + _i * 8192), 16, 0, 0); } while (0)
#define PG8_LDA(dst, b, h) do { _Pragma("unroll") for (int m = 0; m < 4; ++m) _Pragma("unroll") for (int k = 0; k < 2; ++k) dst[m][k] = *(const PG8_LAS bf16x8*)(lds + PG8_SA(b, h) + aoff + m * 2048 + k * 1024); } while (0)
#define PG8_LDB(dst, b, h) do { _Pragma("unroll") for (int n = 0; n < 2; ++n) _Pragma("unroll") for (int k = 0; k < 2; ++k) dst[n][k] = *(const PG8_LAS bf16x8*)(lds + PG8_SB(b, h) + boff + n * 2048 + k * 1024); } while (0)
#define PG8_MMA(ai, bj, At, Bt) do { __builtin_amdgcn_s_setprio(1); _Pragma("unroll") for (int m = 0; m < 4; ++m) _Pragma("unroll") for (int n = 0; n < 2; ++n) _Pragma("unroll") for (int k = 0; k < 2; ++k) \
        acc[ai][bj][m][n] = __builtin_amdgcn_mfma_f32_16x16x32_bf16(Bt[n][k], At[m][k], acc[ai][bj][m][n], 0, 0, 0); __builtin_amdgcn_s_setprio(0); } while (0)
#define PG8_WAIT_V(n) asm volatile("s_waitcnt vmcnt(" #n ")" ::: "memory")
#define PG8_WAIT_L(n) asm volatile("s_waitcnt lgkmcnt(" #n ")" ::: "memory")
#define PG8_BAR __builtin_amdgcn_s_barrier()
#define PG8_SCHED __builtin_amdgcn_sched_barrier(0)
    Unit cur, nxt; int ui = 0;
    if (!S.next(0, cur)) return;
    f32x4 acc[2][2][4][2];
#pragma unroll
    for (int a = 0; a < 2; ++a)
#pragma unroll
        for (int b = 0; b < 2; ++b)
#pragma unroll
            for (int m = 0; m < 4; ++m)
#pragma unroll
                for (int n = 0; n < 2; ++n) acc[a][b][m][n] = (f32x4){0.f, 0.f, 0.f, 0.f};
    bf16x8 At[4][2], B0[2][2], B1[2][2];
    const char* cA = (const char*)g.A + (size_t)cur.pm * tstep; const char* cB = (const char*)g.Bt + (size_t)cur.pn * tstep;
    S.a_ready(cur);
    if constexpr (SP2) {
        PG8_STAGE(PG8_SB(0, 0), cB, voffB); PG8_STAGE(PG8_SB(0, 1), cB + hstep, voffB); PG8_STAGE(PG8_SA(0, 0), cA, voffA); PG8_STAGE(PG8_SA(0, 1), cA + hstep, voffA);
        if (wr == 1) PG8_BAR;
        PG8_WAIT_V(2); PG8_BAR;
        PG8_STAGE(PG8_SB(1, 0), cB + kstep, voffB); PG8_STAGE(PG8_SA(1, 0), cA + kstep, voffA); PG8_STAGE(PG8_SB(1, 1), cB + hstep + kstep, voffB);
        PG8_WAIT_V(6); PG8_BAR;
    } else {
        PG8_STAGE(PG8_SB(0, 0), cB, voffB); PG8_STAGE(PG8_SA(0, 0), cA, voffA); PG8_STAGE(PG8_SB(0, 1), cB + hstep, voffB); PG8_STAGE(PG8_SA(0, 1), cA + hstep, voffA);
        if (wr == 1) PG8_BAR;
        PG8_WAIT_V(4); PG8_BAR;
        PG8_STAGE(PG8_SB(1, 0), cB + kstep, voffB); PG8_STAGE(PG8_SA(1, 0), cA + kstep, voffA); PG8_STAGE(PG8_SB(1, 1), cB + hstep + kstep, voffB);
        PG8_WAIT_V(6); PG8_BAR;
    }
    for (;;) {
        const bool has_next = S.next(ui + 1, nxt);
        const char* nA = has_next ? (const char*)g.A + (size_t)nxt.pm * tstep : cA; const char* nB = has_next ? (const char*)g.Bt + (size_t)nxt.pn * tstep : cB;
#pragma nounroll
        for (int t = 0; t < nt; t += 2) {
            const bool last = (t == nt - 2);
            const char* a1 = cA + (size_t)(t + 1) * kstep;
            const char* a2 = last ? nA : cA + (size_t)(t + 2) * kstep; const char* b2 = last ? nB : cB + (size_t)(t + 2) * kstep;
            const char* a3 = a2 + kstep; const char* b3 = b2 + kstep;
            if (last && has_next) S.a_ready(nxt);
            if constexpr (SP2) {
            PG8_LDB(B0, 0, 0); PG8_LDB(B1, 0, 1); PG8_SCHED; PG8_LDA(At, 0, 0); PG8_STAGE(PG8_SA(1, 1), a1 + hstep, voffA);
            PG8_WAIT_V(8); PG8_WAIT_L(0); PG8_BAR; PG8_MMA(0, 0, At, B0); PG8_MMA(0, 1, At, B1); PG8_BAR; PG8_SCHED;
            PG8_LDA(At, 0, 1); PG8_STAGE(PG8_SB(0, 0), b2, voffB); PG8_STAGE(PG8_SB(0, 1), b2 + hstep, voffB); PG8_STAGE(PG8_SA(0, 0), a2, voffA);
            PG8_WAIT_V(8); PG8_WAIT_L(0); PG8_BAR; PG8_MMA(1, 0, At, B0); PG8_MMA(1, 1, At, B1); PG8_BAR; PG8_SCHED;
            PG8_LDB(B0, 1, 0); PG8_LDB(B1, 1, 1); PG8_SCHED; PG8_LDA(At, 1, 0); PG8_STAGE(PG8_SA(0, 1), a2 + hstep, voffA);
            PG8_WAIT_V(8); PG8_WAIT_L(0); PG8_BAR; PG8_MMA(0, 0, At, B0); PG8_MMA(0, 1, At, B1); PG8_BAR; PG8_SCHED;
            PG8_LDA(At, 1, 1); PG8_STAGE(PG8_SB(1, 0), b3, voffB); PG8_STAGE(PG8_SB(1, 1), b3 + hstep, voffB); PG8_STAGE(PG8_SA(1, 0), a3, voffA);
            PG8_WAIT_V(8); PG8_WAIT_L(0); PG8_BAR; PG8_MMA(1, 0, At, B0); PG8_MMA(1, 1, At, B1); PG8_BAR; PG8_SCHED;
            } else {
            PG8_LDB(B0, 0, 0); PG8_SCHED; PG8_LDA(At, 0, 0); PG8_STAGE(PG8_SA(1, 1), a1 + hstep, voffA);
            PG8_WAIT_L(8); PG8_BAR; PG8_WAIT_L(0); PG8_MMA(0, 0, At, B0); PG8_BAR; PG8_SCHED;
            PG8_LDB(B1, 0, 1); PG8_STAGE(PG8_SB(0, 0), b2, voffB);
            PG8_BAR; PG8_WAIT_L(0); PG8_MMA(0, 1, At, B1); PG8_BAR;
            PG8_LDA(At, 0, 1); PG8_STAGE(PG8_SA(0, 0), a2, voffA);
            PG8_BAR; PG8_WAIT_L(0); PG8_MMA(1, 0, At, B0); PG8_BAR; PG8_SCHED;
            PG8_STAGE(PG8_SB(0, 1), b2 + hstep, voffB);
            PG8_WAIT_V(6); PG8_BAR; PG8_MMA(1, 1, At, B1); PG8_BAR;
            PG8_LDB(B0, 1, 0); PG8_SCHED; PG8_LDA(At, 1, 0); PG8_STAGE(PG8_SA(0, 1), a2 + hstep, voffA);
            PG8_WAIT_L(8); PG8_BAR; PG8_WAIT_L(0); PG8_MMA(0, 0, At, B0); PG8_BAR; PG8_SCHED;
            PG8_LDB(B1, 1, 1); PG8_STAGE(PG8_SB(1, 0), b3, voffB);
            PG8_BAR; PG8_WAIT_L(0); PG8_MMA(0, 1, At, B1); PG8_BAR;
            PG8_LDA(At, 1, 1); PG8_STAGE(PG8_SA(1, 0), a3, voffA);
            PG8_BAR; PG8_WAIT_L(0); PG8_MMA(1, 0, At, B0); PG8_BAR; PG8_SCHED;
            PG8_STAGE(PG8_SB(1, 1), b3 + hstep, voffB);
            PG8_WAIT_V(6); PG8_BAR; PG8_MMA(1, 1, At, B1); PG8_BAR;
            }
        }
        if constexpr (ALIGN_EPI) { if (wr == 0) PG8_BAR; }
        if constexpr (!Epi::AFTER_DRAIN) { E(acc, cur, wr, wc, fr, fq); S.done(cur); }
        if (!has_next) break;
#pragma unroll
        for (int a = 0; a < 2; ++a)
#pragma unroll
            for (int b = 0; b < 2; ++b)
#pragma unroll
                for (int m = 0; m < 4; ++m)
#pragma unroll
                    for (int n = 0; n < 2; ++n) acc[a][b][m][n] = (f32x4){0.f, 0.f, 0.f, 0.f};
        cur = nxt; cA = nA; cB = nB; ++ui;
        if constexpr (ALIGN_EPI) { if (wr == 1) PG8_BAR; }
    }
    PG8_WAIT_V(0);
    if constexpr (!ALIGN_EPI) { if (wr == 0) PG8_BAR; }
    PG8_BAR;
#undef PG8_SA
#undef PG8_SB
#undef PG8_STAGE
#undef PG8_LDA
#undef PG8_LDB
#undef PG8_MMA
#undef PG8_WAIT_V
#undef PG8_WAIT_L
#undef PG8_BAR
#undef PG8_SCHED
}
}

constexpr int NWAVES = 8;
constexpr int N_LAUNCHES = MK_N_LAUNCHES;
constexpr int PER_PHASE = 10;
constexpr int BATCH = 16, SEQ = 2048, D = 1024, M = BATCH * SEQ;
constexpr int NH = 8, HD = 64, AW = 512, RW = 512;
constexpr int RWKV_COLS = 1792, IN_COLS = 3328, FF = 2816, NGU = 2 * FF, NLORA = 1536, KLORA = 256;
constexpr int PC_Q = 0, PC_K = 512, PC_V = 1024, PC_RW = 1536;
constexpr int RC_R = 0, RC_K = 512, RC_V = 1024, RC_L = 1536;
constexpr float NORM_EPS = 1e-6f, LNX_EPS = 64e-5f;
constexpr float LOG2E = 1.4426950408889634f;

constexpr size_t MiB = 1u << 20;
constexpr size_t WS_CTL = 0, CTL_ZERO_BYTES = 1 * MiB;
constexpr size_t WS_WIN = 2 * MiB;
constexpr size_t WS_WOUT = 9 * MiB;
constexpr size_t WS_WGU = 11 * MiB;
constexpr size_t WS_WDN = 22 * MiB;
constexpr size_t WS_WL = 28 * MiB;
constexpr size_t WS_BON = 29 * MiB;
constexpr size_t WS_SS = 30 * MiB;
constexpr size_t WS_XN = 32 * MiB;
constexpr size_t WS_PROJ = 96 * MiB;
constexpr size_t WS_A2 = 304 * MiB;
constexpr size_t WS_DAG = 320 * MiB;
constexpr size_t WS_ML = 416 * MiB;
constexpr size_t WS_END = 424 * MiB;
constexpr size_t DO_PO = 0, DO_Y = 96 * MiB;
constexpr int CW_TMO = 0, CW_CODE = 1;
constexpr int CW_BAR = 4096;
constexpr int CW_ATTQ = 8192;

constexpr int LDS_BYTES = 147456;
constexpr int RING_OFF = 0, RING_BYTES = LDS_BYTES - 1024;
constexpr int LDSCTL_OFF = RING_BYTES, MISC_OFF = LDSCTL_OFF + 320;

#define GAS __attribute__((address_space(1)))
#define LAS __attribute__((address_space(3)))
typedef unsigned short bf16;
typedef unsigned v4u __attribute__((ext_vector_type(4)));
typedef unsigned v2u __attribute__((ext_vector_type(2)));
typedef float f32x4 __attribute__((ext_vector_type(4)));
typedef float f32x2 __attribute__((ext_vector_type(2)));
typedef float f32x16 __attribute__((ext_vector_type(16)));
typedef short bf16x8 __attribute__((ext_vector_type(8)));
typedef short s16x4 __attribute__((ext_vector_type(4)));
typedef GAS unsigned gu32;
#define RLX_AGENT __ATOMIC_RELAXED, __HIP_MEMORY_SCOPE_AGENT
#define LDS_WAIT() asm volatile("s_waitcnt lgkmcnt(0)" ::: "memory")
#define VM_WAIT() asm volatile("s_waitcnt vmcnt(0)" ::: "memory")
__device__ __forceinline__ unsigned f2bf(float f) { unsigned u = __builtin_bit_cast(unsigned, f); return (u + 0x7fffu + ((u >> 16) & 1u)) >> 16; }
__device__ __forceinline__ unsigned pk2(float lo, float hi) { return f2bf(lo) | (f2bf(hi) << 16); }
__device__ __forceinline__ float bflo(unsigned w) { return __builtin_bit_cast(float, w << 16); }
__device__ __forceinline__ float bfhi(unsigned w) { return __builtin_bit_cast(float, w & 0xffff0000u); }
__device__ __forceinline__ float fsig(float x) { return __builtin_amdgcn_rcpf(1.0f + __builtin_amdgcn_exp2f(-LOG2E * x)); }

#define XB_TMO      128
#define XB_XCNT(j)  (256  + 64 * (j))
#define XB_XSUB(j)  (1280 + 64 * (j))
#define XB_XGEN(j)  (2304 + 64 * (j))
#define XB_TOP      3328
#define XB_TOPGEN   3392
#define XCD_BAR_WORDS 3456
#define XB_SPIN_CAP (1u << 18)
__device__ __forceinline__ unsigned xb_ld(unsigned* p)              { return __hip_atomic_load(p, __ATOMIC_RELAXED, __HIP_MEMORY_SCOPE_AGENT); }
__device__ __forceinline__ unsigned xb_add(unsigned* p, unsigned v) { return __hip_atomic_fetch_add(p, v, __ATOMIC_RELAXED, __HIP_MEMORY_SCOPE_AGENT); }
__device__ __forceinline__ unsigned xb_xcc_id() { return (unsigned)__builtin_amdgcn_s_getreg((3 << 11) | 20) & 0xFu; }
#define XB_SPIN(cond, bar) do { unsigned _sp = 0; while (cond) { __builtin_amdgcn_s_sleep(1); \
    if ((++_sp & 255u) == 0u) { if (xb_ld(&(bar)[XB_TMO])) break; if (_sp > XB_SPIN_CAP) { atomicAdd(&(bar)[XB_TMO], 1u); break; } } } } while (0)
struct XcdBarrier { unsigned* bar; unsigned x; volatile LAS unsigned* st; };
__device__ __forceinline__ XcdBarrier xcd_barrier_post(unsigned* bar, volatile LAS unsigned* st) {
    XcdBarrier b; b.bar = bar; b.x = xb_xcc_id(); b.st = st;
    if (threadIdx.x == 0) (void)xb_add(&bar[XB_XCNT(b.x)], 1u);
    return b;
}
__device__ __forceinline__ void xcd_barrier_complete(unsigned* bar, unsigned x, unsigned& nloc, unsigned& nx) {
    const unsigned G = gridDim.x * gridDim.y * gridDim.z;
    unsigned sum, cnt, mine, sp = 0u;
    for (;;) {
        sum = 0u; cnt = 0u; mine = 0u;
#pragma unroll
        for (unsigned j = 0; j < 16; ++j) { const unsigned c = xb_ld(&bar[XB_XCNT(j)]); sum += c; cnt += (c > 0u) ? 1u : 0u; mine = (j == x) ? c : mine; }
        if (sum == G) break;
        __builtin_amdgcn_s_sleep(1);
        if ((++sp & 255u) == 0u) { if (xb_ld(&bar[XB_TMO])) break; if (sp > XB_SPIN_CAP) { atomicAdd(&bar[XB_TMO], 1u); break; } }
    }
    nloc = mine > 0u ? mine : 1u; nx = cnt > 0u ? cnt : 1u;
}
__device__ __forceinline__ void xcd_barrier(const XcdBarrier& b) {
    asm volatile("s_waitcnt vmcnt(0)" ::: "memory");
    __syncthreads();
    if (threadIdx.x == 0) {
        unsigned* bar = b.bar;
        __builtin_amdgcn_s_waitcnt(0);
        unsigned nloc = b.st[0], nx = b.st[1];
        if (nloc == 0u) { xcd_barrier_complete(bar, b.x, nloc, nx); b.st[0] = nloc; b.st[1] = nx; }
        const unsigned old = xb_add(&bar[XB_XSUB(b.x)], 1u);
        const unsigned gen = old / nloc;
        if (old + 1u == (gen + 1u) * nloc) {
            __builtin_amdgcn_fence(__ATOMIC_RELEASE, "agent");
            asm volatile("s_waitcnt vmcnt(0)" ::: "memory");
            const unsigned og = xb_add(&bar[XB_TOP], 1u);
            const unsigned tg = og / nx;
            if (og + 1u == (tg + 1u) * nx) xb_add(&bar[XB_TOPGEN], 1u);
            else XB_SPIN(xb_ld(&bar[XB_TOPGEN]) == tg, bar);
            __builtin_amdgcn_fence(__ATOMIC_ACQUIRE, "agent");
            xb_add(&bar[XB_XGEN(b.x)], 1u);
            asm volatile("s_waitcnt vmcnt(0)" ::: "memory");
        } else {
            XB_SPIN(xb_ld(&bar[XB_XGEN(b.x)]) == gen, bar);
            __builtin_amdgcn_fence(__ATOMIC_ACQUIRE, "agent");
            asm volatile("s_waitcnt vmcnt(0)" ::: "memory");
        }
    }
    __syncthreads();
}

struct Frame {
    LAS unsigned char* lds;
    volatile LAS unsigned* MISC;
    gu32* ctl;
    int tid, lane, wave;
    int vcu, G;
    float* out; unsigned char* ws;
};
struct Args { const float* in[22]; float* out; unsigned char* ws; int ph_lo, ph_hi, li, pad; };
enum { I_X = 0, I_N1G, I_WIN, I_QNG, I_KNG, I_AOG, I_MU, I_W0, I_W2, I_A0, I_A2, I_G2, I_KK, I_KA, I_RK, I_LNG, I_LNB, I_WOUT, I_N2G, I_WG, I_WU, I_WD };

__device__ __forceinline__ float wave_sum(float v) {
#pragma unroll
    for (int o = 1; o < 64; o <<= 1) v += __shfl_xor(v, o);
    return v;
}
__device__ __forceinline__ float red16(float x) {
    x += __builtin_bit_cast(float, __builtin_amdgcn_update_dpp(0, __builtin_bit_cast(int, x), 0x128, 0xf, 0xf, false));
    x += __builtin_bit_cast(float, __builtin_amdgcn_update_dpp(0, __builtin_bit_cast(int, x), 0x124, 0xf, 0xf, false));
    x += __builtin_bit_cast(float, __builtin_amdgcn_update_dpp(0, __builtin_bit_cast(int, x), 0x122, 0xf, 0xf, false));
    x += __builtin_bit_cast(float, __builtin_amdgcn_update_dpp(0, __builtin_bit_cast(int, x), 0x121, 0xf, 0xf, false));
    return x;
}

__device__ __forceinline__ void p0_transpose_item(const float* W, int K, int N, bf16* WT, int rmode, LAS float* scr, int item, int lane, const float* ksc = nullptr) {
    const int nblk = N / 32, kb = item / nblk, nb = item % nblk, k0 = 64 * kb, n0 = 32 * nb;
    const int rbase = rmode == 0 ? n0 : rmode == 3 ? (n0 < 1024 ? ((n0 >> 8) * 256 + ((n0 >> 5) & 1) * 128 + ((n0 >> 6) & 3) * 32) : n0) : ((n0 >> 7) * 256 + (n0 & 127) + (rmode == 2 ? 128 : 0));
#pragma unroll 8
    for (int i = 0; i < 32; ++i) { const int kk = 2 * i + (lane >> 5); scr[kk * 33 + (lane & 31)] = W[(size_t)(k0 + kk) * N + n0 + (lane & 31)] * (ksc ? ksc[k0 + kk] : 1.0f); }
    LDS_WAIT(); asm volatile("" ::: "memory");
    const int c = lane & 7;
#pragma unroll
    for (int j = 0; j < 4; ++j) { const int n = (lane >> 3) + 8 * j; const LAS float* s = scr + (8 * c) * 33 + n;
        v4u o; o.x = pk2(s[0 * 33], s[1 * 33]); o.y = pk2(s[2 * 33], s[3 * 33]); o.z = pk2(s[4 * 33], s[5 * 33]); o.w = pk2(s[6 * 33], s[7 * 33]);
        *(GAS v4u*)(WT + (size_t)(rbase + n) * K + k0 + 8 * c) = o; }
    LDS_WAIT(); asm volatile("" ::: "memory");
}
template <int NR> __device__ __forceinline__ void rms_rows_to_bf16(int lane, const float* x0, size_t rstride, const float* g, bf16* o0, size_t ostride) {
    const GAS f32x4* gr = (const GAS f32x4*)g + lane;
    f32x4 v[NR][4];
#pragma unroll
    for (int r = 0; r < NR; ++r) { const GAS f32x4* xr = (const GAS f32x4*)(x0 + r * rstride) + lane;
#pragma unroll
        for (int j = 0; j < 4; ++j) v[r][j] = xr[64 * j]; }
    f32x4 gg[4];
#pragma unroll
    for (int j = 0; j < 4; ++j) gg[j] = gr[64 * j];
#pragma unroll
    for (int r = 0; r < NR; ++r) { float s = 0.f;
#pragma unroll
        for (int j = 0; j < 4; ++j) s += (v[r][j].x * v[r][j].x + v[r][j].y * v[r][j].y) + (v[r][j].z * v[r][j].z + v[r][j].w * v[r][j].w);
        const float rstd = 1.f / sqrtf(wave_sum(s) * (1.f / D) + NORM_EPS);
        GAS unsigned long long* o8 = (GAS unsigned long long*)(o0 + r * ostride) + lane;
#pragma unroll
        for (int j = 0; j < 4; ++j)
            o8[64 * j] = (unsigned long long)pk2(v[r][j].x * rstd * gg[j].x, v[r][j].y * rstd * gg[j].y) | ((unsigned long long)pk2(v[r][j].z * rstd * gg[j].z, v[r][j].w * rstd * gg[j].w) << 32); }
}

__device__ __forceinline__ void p0_prologue(Frame& F, const Args& AR) {
    LAS float* scr = (LAS float*)(F.lds + RING_OFF + F.wave * 16384);
    const int gw = F.vcu * NWAVES + F.wave, NGW = F.G * NWAVES;
    bf16* Win_t = (bf16*)(F.ws + WS_WIN); bf16* Wout_t = (bf16*)(F.ws + WS_WOUT); bf16* Wgu_t = (bf16*)(F.ws + WS_WGU); bf16* Wdn_t = (bf16*)(F.ws + WS_WDN); bf16* Wl_t = (bf16*)(F.ws + WS_WL);
    constexpr int I_IN = (D / 64) * (IN_COLS / 32), I_OUT = (D / 64) * (D / 32), I_G = (D / 64) * (FF / 32), I_DN = (FF / 64) * (D / 32);
    constexpr int NITEMS = I_IN + I_OUT + 2 * I_G + I_DN;
    for (int it = gw; it < NITEMS; it += NGW) {
        int r = it;
        if (r < I_IN) { p0_transpose_item(AR.in[I_WIN], D, IN_COLS, Win_t, 3, scr, r, F.lane); continue; } r -= I_IN;
        if (r < I_OUT) { p0_transpose_item(AR.in[I_WOUT], D, D, Wout_t, 0, scr, r, F.lane); continue; } r -= I_OUT;
        if (r < I_G) { p0_transpose_item(AR.in[I_WG], D, FF, Wgu_t, 1, scr, r, F.lane, AR.in[I_N2G]); continue; } r -= I_G;
        if (r < I_G) { p0_transpose_item(AR.in[I_WU], D, FF, Wgu_t, 2, scr, r, F.lane, AR.in[I_N2G]); continue; } r -= I_G;
        p0_transpose_item(AR.in[I_WD], FF, D, Wdn_t, 0, scr, r, F.lane);
    }
    for (int e = (F.vcu * NWAVES * 64 + F.tid); e < NLORA * KLORA; e += F.G * NWAVES * 64) {
        const int row = e / KLORA, k = e % KLORA, kind = row >> 9, c = row & 511; float v = 0.f;
        if (kind == 0) { if (k < 64) v = AR.in[I_W2][k * 512 + c]; }
        else if (kind == 1) { if (k >= 64 && k < 128) v = AR.in[I_A2][(k - 64) * 512 + c]; }
        else { if (k >= 128) v = AR.in[I_G2][(k - 128) * 512 + c]; }
        Wl_t[e] = (bf16)f2bf(v);
    }
    bf16* XN = (bf16*)(F.ws + WS_XN);
    for (int m = gw * 4; m < M; m += NGW * 4) rms_rows_to_bf16<4>(F.lane, AR.in[I_X] + (size_t)m * D, D, AR.in[I_N1G], XN + (size_t)m * D, D);
}

__device__ __forceinline__ void p2_prep(Frame& F, const Args& AR) {
    const int gw = F.vcu * NWAVES + F.wave, NGW = F.G * NWAVES, lane = F.lane;
    const bf16* PROJ = (const bf16*)(F.ws + WS_PROJ); bf16* A2 = (bf16*)(F.ws + WS_A2);
    const f32x4 mu4 = *(const f32x4*)(AR.in[I_MU] + RC_L + 4 * lane);
    for (int m0 = 4 * gw; m0 < M; m0 += 4 * NGW) {
        const GAS bf16* row = (const GAS bf16*)PROJ + (size_t)m0 * IN_COLS + PC_RW + RC_L + 4 * lane;
        v2u w[5];
        w[0] = (v2u){0u, 0u};
        if ((m0 & (SEQ - 1)) != 0) w[0] = *(const GAS v2u*)(row - IN_COLS);
#pragma unroll
        for (int i = 0; i < 4; ++i) w[i + 1] = *(const GAS v2u*)(row + (size_t)i * IN_COLS);
#pragma unroll
        for (int i = 0; i < 4; ++i) {
            const v2u cu = w[i + 1], pv = w[i];
            const float c4[4] = {bflo(cu.x), bfhi(cu.x), bflo(cu.y), bfhi(cu.y)}, p4[4] = {bflo(pv.x), bfhi(pv.x), bflo(pv.y), bfhi(pv.y)};
            float xs[4];
#pragma unroll
            for (int e = 0; e < 4; ++e) { const float v = c4[e] + (p4[e] - c4[e]) * mu4[e];
                if (lane < 16) { const float t = __builtin_amdgcn_exp2f(2.f * LOG2E * v); xs[e] = 1.f - 2.f * __builtin_amdgcn_rcpf(t + 1.f); }
                else if (lane < 32) xs[e] = v;
                else xs[e] = fsig(v); }
            *(GAS v2u*)(A2 + (size_t)(m0 + i) * KLORA + 4 * lane) = (v2u){pk2(xs[0], xs[1]), pk2(xs[2], xs[3])};
        }
    }
}

constexpr int CS = 16, NCHUNK = SEQ / CS, NHELP = 4, NSTATE = 4, NIT = (NCHUNK + NHELP - 1) / NHELP;
constexpr int SL_A = 0, SL_R = 2048, SL_B = 4096, SL_K = 6144, SL_V = 8192, SL_T = 10240, SL_LAK = 10752, SL_LRB = 11264, SL_LRK = 11776, SL_G = 12288, SL_BON = 12544, SL_BYTES = 12608;
constexpr int SC_CONST = 2 * NHELP * SL_BYTES;
constexpr int SC_YL = SC_CONST + 6 * 64 * 4, YL_BYTES = NHELP * CS * 256;
static_assert(SC_YL + 2 * YL_BYTES <= RING_BYTES && NHELP * CS * 8 == NWAVES * 64, "scan LDS");
struct HReg { v4u r[2], k[2], v[2], pr[2], pk[2], pv[2], e[2], a[2]; };
__device__ __forceinline__ void helper_load(HReg& R, const bf16* PROJ, const bf16* DAG, int tok, int h, int kg) {
    const GAS bf16* row = (const GAS bf16*)PROJ + (size_t)tok * IN_COLS + PC_RW + h * 64 + 16 * kg;
    const GAS bf16* rowp = row - IN_COLS;
    const GAS bf16* dr = (const GAS bf16*)DAG + (size_t)tok * NLORA + h * 64 + 16 * kg;
    asm volatile("" : "+v"(row)); asm volatile("" : "+v"(rowp)); asm volatile("" : "+v"(dr));
    const bool hp = (tok & (SEQ - 1)) != 0;
#pragma unroll
    for (int i = 0; i < 2; ++i) {
        R.r[i] = *(const GAS v4u*)(row + RC_R + 8 * i); R.k[i] = *(const GAS v4u*)(row + RC_K + 8 * i); R.v[i] = *(const GAS v4u*)(row + RC_V + 8 * i);
        if (hp) { R.pr[i] = *(const GAS v4u*)(rowp + RC_R + 8 * i); R.pk[i] = *(const GAS v4u*)(rowp + RC_K + 8 * i); R.pv[i] = *(const GAS v4u*)(rowp + RC_V + 8 * i); }
        else { R.pr[i] = (v4u){0u, 0u, 0u, 0u}; R.pk[i] = R.pr[i]; R.pv[i] = R.pr[i]; }
        R.e[i] = *(const GAS v4u*)(dr + 8 * i); R.a[i] = *(const GAS v4u*)(dr + 512 + 8 * i);
    }
}
__device__ __forceinline__ void unpack4(const unsigned w0, const unsigned w1, float (&x)[4]) { x[0] = bflo(w0); x[1] = bfhi(w0); x[2] = bflo(w1); x[3] = bfhi(w1); }
__device__ __forceinline__ float dpp_shr(float x, const int ctrl_sel) {
    int r;
    if (ctrl_sel == 1) r = __builtin_amdgcn_update_dpp(0, __builtin_bit_cast(int, x), 0x111, 0xf, 0xf, true);
    else if (ctrl_sel == 2) r = __builtin_amdgcn_update_dpp(0, __builtin_bit_cast(int, x), 0x112, 0xf, 0xf, true);
    else if (ctrl_sel == 4) r = __builtin_amdgcn_update_dpp(0, __builtin_bit_cast(int, x), 0x114, 0xf, 0xf, true);
    else r = __builtin_amdgcn_update_dpp(0, __builtin_bit_cast(int, x), 0x118, 0xf, 0xf, true);
    return __builtin_bit_cast(float, r);
}
typedef float f32x2_t __attribute__((ext_vector_type(2))); typedef __bf16 bf16x2_t __attribute__((ext_vector_type(2)));
__device__ __forceinline__ unsigned cvt2(float lo, float hi) { f32x2_t v = {lo, hi}; bf16x2_t b = __builtin_convertvector(v, bf16x2_t); return __builtin_bit_cast(unsigned, b); }
__device__ __forceinline__ bf16x8 mk8(unsigned a, unsigned b, unsigned c, unsigned d) { return __builtin_bit_cast(bf16x8, (v4u){a, b, c, d}); }
__device__ __forceinline__ bf16x8 accB(const f32x4 v) { return mk8(cvt2(v[0], v[1]), cvt2(v[2], v[3]), 0u, 0u); }
__device__ __forceinline__ v2u trd(const LAS unsigned char* p) { typedef short v4i16_t __attribute__((ext_vector_type(4)));
    return __builtin_bit_cast(v2u, __builtin_amdgcn_ds_read_tr16_b64_v4i16((LAS v4i16_t*)p)); }
#define MFMA16(a, b, c) __builtin_amdgcn_mfma_f32_16x16x32_bf16((a), (b), (c), 0, 0, 0)
#define PIN_PTR(p) asm volatile("" : "+v"(p))

#define HR_UNPACK(dst, arr, gp) do { if ((gp) & 1) unpack4(R.arr[(gp) >> 1].z, R.arr[(gp) >> 1].w, dst); else unpack4(R.arr[(gp) >> 1].x, R.arr[(gp) >> 1].y, dst); } while (0)
__device__ __forceinline__ void helper_chunk(LAS unsigned char* slot, const LAS float* cst, HReg& R, bool prefetch, const bf16* PROJ, const bf16* DAG, float* BON, int tok, int h, int lane) {
    const int t = lane & 15, kg = lane >> 4;
    LAS unsigned char* p_row = slot + t * 128 + kg * 16;
    LAS unsigned char* p_v = slot + SL_V + t * 128 + kg * 32;
    LAS unsigned char* p_tw = slot + t * 32 + kg * 8;
    const LAS unsigned char* p_tr = slot + (4 * kg + ((lane & 15) >> 2)) * 32 + (lane & 3) * 8;
    LAS unsigned char* p_g = slot + SL_G + kg * 16;
    const LAS float* p_c = cst + 16 * kg;
    PIN_PTR(p_row); PIN_PTR(p_v); PIN_PTR(p_tw); PIN_PTR(p_tr); PIN_PTR(p_g); PIN_PTR(p_c);
    float ss = 0.f;
#pragma unroll
    for (int gp = 0; gp < 4; ++gp) {
        float k[4], pk[4]; HR_UNPACK(k, k, gp); HR_UNPACK(pk, pk, gp);
        const f32x4 muk = *(const LAS f32x4*)(p_c + 1 * 64 + 4 * gp), kkc = *(const LAS f32x4*)(p_c + 3 * 64 + 4 * gp);
#pragma unroll
        for (int i = 0; i < 4; ++i) { const float kv = (k[i] + (pk[i] - k[i]) * muk[i]) * kkc[i]; ss += kv * kv; }
    }
    ss += __shfl_xor(ss, 16); ss += __shfl_xor(ss, 32);
    const float inv = 1.f / fmaxf(sqrtf(ss), 1e-12f);
#pragma unroll
    for (int i = 0; i < 2; ++i) { asm volatile("" : "+v"(R.k[i])); asm volatile("" : "+v"(R.pk[i])); }
    unsigned fa[4], fr[4], fb[4], fk[4];
    float bon = 0.f;
#pragma unroll
    for (int gp = 0; gp < 4; ++gp) {
        float r[4], k[4], v[4], pr[4], pk[4], pv[4], a[4], e[4];
        HR_UNPACK(r, r, gp); HR_UNPACK(k, k, gp); HR_UNPACK(v, v, gp); HR_UNPACK(pr, pr, gp); HR_UNPACK(pk, pk, gp); HR_UNPACK(pv, pv, gp); HR_UNPACK(a, a, gp); HR_UNPACK(e, e, gp);
        const f32x4 mur = *(const LAS f32x4*)(p_c + 0 * 64 + 4 * gp), muk = *(const LAS f32x4*)(p_c + 1 * 64 + 4 * gp), muv = *(const LAS f32x4*)(p_c + 2 * 64 + 4 * gp);
        const f32x4 kkc = *(const LAS f32x4*)(p_c + 3 * 64 + 4 * gp), kac = *(const LAS f32x4*)(p_c + 4 * 64 + 4 * gp), rkc = *(const LAS f32x4*)(p_c + 5 * 64 + 4 * gp);
        float xv[4], At[4], Rt[4], Bt[4], Kt[4]; f32x4 gv;
#pragma unroll
        for (int i = 0; i < 4; ++i) {
            const float xr = r[i] + (pr[i] - r[i]) * mur[i], xk = k[i] + (pk[i] - k[i]) * muk[i]; xv[i] = v[i] + (pv[i] - v[i]) * muv[i];
            const float kn = xk * kkc[i] * inv, kpv = xk * (1.f + (a[i] - 1.f) * kac[i]); bon += xr * kpv * rkc[i];
            float x = e[i];
            x += dpp_shr(x, 1); x += dpp_shr(x, 2); x += dpp_shr(x, 4); x += dpp_shr(x, 8);
            const float g = __builtin_amdgcn_exp2f(LOG2E * x), gi = __builtin_amdgcn_exp2f(-LOG2E * x); float gpv = dpp_shr(g, 1); gpv = (t == 0) ? 1.f : gpv;
            At[i] = -kn * gpv; Rt[i] = xr * g; Bt[i] = kn * a[i] * gi; Kt[i] = kpv * gi; gv[i] = g;
            }
        *(LAS v2u*)(p_v + gp * 8) = (v2u){cvt2(xv[0], xv[1]), cvt2(xv[2], xv[3])};
        if (t == 15) *(LAS f32x4*)(p_g + gp * 64) = gv;
        const int hf = gp & 1;
        fa[2 * hf] = cvt2(At[0], At[1]); fa[2 * hf + 1] = cvt2(At[2], At[3]); fr[2 * hf] = cvt2(Rt[0], Rt[1]); fr[2 * hf + 1] = cvt2(Rt[2], Rt[3]);
        fb[2 * hf] = cvt2(Bt[0], Bt[1]); fb[2 * hf + 1] = cvt2(Bt[2], Bt[3]); fk[2 * hf] = cvt2(Kt[0], Kt[1]); fk[2 * hf + 1] = cvt2(Kt[2], Kt[3]);
        if (hf) {
            const int ko = (gp >> 1) * 64;
            *(LAS v4u*)(p_row + SL_A + ko) = (v4u){fa[0], fa[1], fa[2], fa[3]}; *(LAS v4u*)(p_row + SL_R + ko) = (v4u){fr[0], fr[1], fr[2], fr[3]};
            *(LAS v4u*)(p_row + SL_B + ko) = (v4u){fb[0], fb[1], fb[2], fb[3]}; *(LAS v4u*)(p_row + SL_K + ko) = (v4u){fk[0], fk[1], fk[2], fk[3]};
        }

    }
    bon += __shfl_xor(bon, 16); bon += __shfl_xor(bon, 32);
    if (kg == 0) *(LAS float*)(slot + SL_BON + t * 4) = bon;
    if (prefetch) helper_load(R, PROJ, DAG, tok + NHELP * CS, h, kg);
    const bf16x8 FA0 = *(const LAS bf16x8*)(p_row + SL_A), FA1 = *(const LAS bf16x8*)(p_row + SL_A + 64), FR0 = *(const LAS bf16x8*)(p_row + SL_R), FR1 = *(const LAS bf16x8*)(p_row + SL_R + 64);
    const bf16x8 FB0 = *(const LAS bf16x8*)(p_row + SL_B), FB1 = *(const LAS bf16x8*)(p_row + SL_B + 64), FK0 = *(const LAS bf16x8*)(p_row + SL_K), FK1 = *(const LAS bf16x8*)(p_row + SL_K + 64);
    const f32x4 z4 = (f32x4){0.f, 0.f, 0.f, 0.f};
    f32x4 Lab = MFMA16(FA0, FB0, z4); Lab = MFMA16(FA1, FB1, Lab);
    f32x4 Lak = MFMA16(FA0, FK0, z4); Lak = MFMA16(FA1, FK1, Lak);
    f32x4 Lrb = MFMA16(FR0, FB0, z4); Lrb = MFMA16(FR1, FB1, Lrb);
    f32x4 Lrk = MFMA16(FR0, FK0, z4); Lrk = MFMA16(FR1, FK1, Lrk);
    const int s = t;
#pragma unroll
    for (int r = 0; r < 4; ++r) { const int tt = 4 * kg + r;
        Lab[r] = tt > s ? Lab[r] : 0.f; Lak[r] = tt > s ? Lak[r] : 0.f; Lrb[r] = tt >= s ? Lrb[r] : 0.f; Lrk[r] = tt >= s ? Lrk[r] : 0.f; }
#define WR_TILE(off, X) (*(LAS v2u*)(p_tw + (off)) = (v2u){cvt2((X)[0], (X)[1]), cvt2((X)[2], (X)[3])})
#define RD_AFRAG(dst, off) do { const v2u w_ = trd(p_tr + (off)); dst = mk8(w_.x, w_.y, 0u, 0u); } while (0)
    WR_TILE(SL_LAK, Lak); WR_TILE(SL_LRB, Lrb); WR_TILE(SL_LRK, Lrk);
    bf16x8 AL1, AL2, AL4;
    WR_TILE(SL_T, Lab); RD_AFRAG(AL1, SL_T);
    f32x4 L2 = MFMA16(AL1, accB(Lab), z4);
    WR_TILE(SL_T, L2); RD_AFRAG(AL2, SL_T);
    f32x4 L4 = MFMA16(AL2, accB(L2), z4);
    WR_TILE(SL_T, L4); RD_AFRAG(AL4, SL_T);
    f32x4 Rm = MFMA16(AL4, accB(L4), z4);
#pragma unroll
    for (int r = 0; r < 4; ++r) Rm[r] += (4 * kg + r == s) ? 1.f : 0.f;
    Rm = MFMA16(AL4, accB(Rm), Rm);
    Rm = MFMA16(AL2, accB(Rm), Rm);
    Rm = MFMA16(AL1, accB(Rm), Rm);
    WR_TILE(SL_T, Rm);
#undef WR_TILE
#undef RD_AFRAG
}

__device__ __forceinline__ void state_chunk(const LAS unsigned char* slot, f32x4 (&X)[4], LAS unsigned char* yl, int lane, int wv) {
    const int c = lane & 15, g = lane >> 4, q4 = 4 * g + (c >> 2), pp = c & 3;
    const f32x4 z4 = (f32x4){0.f, 0.f, 0.f, 0.f};
    const LAS unsigned char* p128 = slot + c * 128 + g * 16;
    const LAS unsigned char* p_bt = slot + q4 * 128 + pp * 16;
    const LAS unsigned char* p_tr = slot + q4 * 32 + pp * 8;
    const LAS unsigned char* p_v = slot + SL_V + q4 * 128 + wv * 32 + pp * 8;
    const LAS unsigned char* pg = slot + SL_G + g * 16;
    PIN_PTR(p128); PIN_PTR(p_bt); PIN_PTR(p_tr); PIN_PTR(p_v); PIN_PTR(pg);
    const bf16x8 xb0 = mk8(cvt2(X[0][0], X[0][1]), cvt2(X[0][2], X[0][3]), cvt2(X[1][0], X[1][1]), cvt2(X[1][2], X[1][3]));
    const bf16x8 xb1 = mk8(cvt2(X[2][0], X[2][1]), cvt2(X[2][2], X[2][3]), cvt2(X[3][0], X[3][1]), cvt2(X[3][2], X[3][3]));
    const bf16x8 a0 = *(const LAS bf16x8*)(p128 + SL_A), a1 = *(const LAS bf16x8*)(p128 + SL_A + 64);
    const bf16x8 r0 = *(const LAS bf16x8*)(p128 + SL_R), r1 = *(const LAS bf16x8*)(p128 + SL_R + 64);
    const v2u vt = trd(p_v), lak = trd(p_tr + SL_LAK), tt = trd(p_tr + SL_T), lrb = trd(p_tr + SL_LRB), lrk = trd(p_tr + SL_LRK);
    f32x4 Z = MFMA16(a0, xb0, z4); Z = MFMA16(a1, xb1, Z); Z = MFMA16(mk8(lak.x, lak.y, 0u, 0u), mk8(vt.x, vt.y, 0u, 0u), Z);
    const f32x4 U = MFMA16(mk8(tt.x, tt.y, 0u, 0u), accB(Z), z4);
    const bf16x8 uv = mk8(cvt2(U[0], U[1]), cvt2(U[2], U[3]), vt.x, vt.y);
    f32x4 Y = MFMA16(r0, xb0, z4); Y = MFMA16(r1, xb1, Y); Y = MFMA16(mk8(lrb.x, lrb.y, lrk.x, lrk.y), uv, Y);
#pragma unroll
    for (int jb = 0; jb < 4; ++jb) {
        const v2u bb = trd(p_bt + SL_B + (jb >> 1) * 64 + (jb & 1) * 8), kk2 = trd(p_bt + SL_K + (jb >> 1) * 64 + (jb & 1) * 8);
        const f32x4 gm = *(const LAS f32x4*)(pg + jb * 64);
        X[jb] = MFMA16(mk8(bb.x, bb.y, kk2.x, kk2.y), uv, X[jb]) * gm;
    }
    LAS unsigned char* py = yl + (4 * g) * 256 + (16 * wv + c) * 2;
    PIN_PTR(py);
    const f32x4 bn = *(const LAS f32x4*)(slot + SL_BON + 16 * g);
    const float vv[4] = {bflo(vt.x), bfhi(vt.x), bflo(vt.y), bfhi(vt.y)};
#pragma unroll
    for (int r = 0; r < 4; ++r) { *(LAS unsigned short*)(py + r * 256) = (unsigned short)f2bf(Y[r]); *(LAS unsigned short*)(py + r * 256 + 128) = (unsigned short)f2bf(bn[r] * vv[r]); }
}

__device__ __forceinline__ void p4_scan(Frame& F, const Args& AR) {
    const bf16* PROJ = (const bf16*)(F.ws + WS_PROJ); const bf16* DAG = (const bf16*)(F.ws + WS_DAG);
    float* BON = nullptr; bf16* MIX = (bf16*)(F.ws + WS_XN);
    LAS unsigned char* lds = F.lds + RING_OFF;
    LAS float* cst = (LAS float*)(lds + SC_CONST);
    const int tid = F.tid, lane = F.lane, wave = F.wave;
    for (int unit = blockIdx.x; unit < BATCH * NH; unit += F.G) {
        const int b = unit >> 3, h = unit & 7;
        const int tok0 = b * SEQ;
        if (tid < 384) { const int a = tid >> 6, c = tid & 63; const float* src = a == 0 ? AR.in[I_MU] + RC_R : a == 1 ? AR.in[I_MU] + RC_K : a == 2 ? AR.in[I_MU] + RC_V : a == 3 ? AR.in[I_KK] : a == 4 ? AR.in[I_KA] : AR.in[I_RK];
            cst[a * 64 + c] = src[h * 64 + c]; }
        __syncthreads();
        const int st_k = tid >> 7, st_t = (tid >> 3) & 15, st_p = tid & 7;
        GAS v4u* ystore = (GAS v4u*)((GAS bf16*)MIX + (size_t)(tok0 + st_k * CS + st_t) * D + AW + h * 64 + 8 * st_p);
        const GAS v4u* gload = (const GAS v4u*)((const GAS bf16*)DAG + (size_t)(tok0 + st_k * CS + st_t) * NLORA + 1024 + h * 64 + 8 * st_p);
        const LAS unsigned char* yl_rd = lds + SC_YL + st_k * (CS * 256) + st_t * 256 + st_p * 16;
        v4u gnext = (v4u){0u, 0u, 0u, 0u};
        float lng[8], lnb[8];
#pragma unroll
        for (int i = 0; i < 8; ++i) { lng[i] = AR.in[I_LNG][h * 64 + 8 * st_p + i]; lnb[i] = AR.in[I_LNB][h * 64 + 8 * st_p + i]; }
#define RWKV_OUT(it_) do { if ((it_) >= 2 && NHELP * ((it_) - 2) + st_k < NCHUNK) { \
            const v4u gw4 = gnext; \
            const v4u yw = *(const LAS v4u*)(yl_rd + ((it_) & 1) * YL_BYTES), bw = *(const LAS v4u*)(yl_rd + ((it_) & 1) * YL_BYTES + 128); \
            float y[8] = {bflo(yw.x), bfhi(yw.x), bflo(yw.y), bfhi(yw.y), bflo(yw.z), bfhi(yw.z), bflo(yw.w), bfhi(yw.w)}; \
            float sm = ((y[0] + y[1]) + (y[2] + y[3])) + ((y[4] + y[5]) + (y[6] + y[7])); \
            sm += __shfl_xor(sm, 1); sm += __shfl_xor(sm, 2); sm += __shfl_xor(sm, 4); \
            const float mean = sm * (1.f / 64.f); float sv = 0.f; \
            _Pragma("unroll") for (int i = 0; i < 8; ++i) { y[i] -= mean; sv += y[i] * y[i]; } \
            sv += __shfl_xor(sv, 1); sv += __shfl_xor(sv, 2); sv += __shfl_xor(sv, 4); \
            const float rs = 1.f / sqrtf(sv * (1.f / 64.f) + LNX_EPS); \
            const float bf_[8] = {bflo(bw.x), bfhi(bw.x), bflo(bw.y), bfhi(bw.y), bflo(bw.z), bfhi(bw.z), bflo(bw.w), bfhi(bw.w)}; \
            const float gf[8] = {bflo(gw4.x), bfhi(gw4.x), bflo(gw4.y), bfhi(gw4.y), bflo(gw4.z), bfhi(gw4.z), bflo(gw4.w), bfhi(gw4.w)}; \
            float ro[8]; \
            _Pragma("unroll") for (int i = 0; i < 8; ++i) ro[i] = (y[i] * rs * lng[i] + lnb[i] + bf_[i]) * gf[i]; \
            ystore[(size_t)(NHELP * ((it_) - 2)) * CS * D / 8] = (v4u){pk2(ro[0], ro[1]), pk2(ro[2], ro[3]), pk2(ro[4], ro[5]), pk2(ro[6], ro[7])}; } \
            if ((it_) >= 1 && NHELP * ((it_) - 1) + st_k < NCHUNK) gnext = gload[(size_t)(NHELP * ((it_) - 1)) * CS * NLORA / 8]; } while (0)
        if (wave >= NSTATE) {
            const int hw = wave - NSTATE, kg = lane >> 4, tokl = tok0 + (lane & 15);
            HReg R;
            helper_load(R, PROJ, DAG, tokl + hw * CS, h, kg);
            for (int it = 0; it <= NIT + 1; ++it) {
                RWKV_OUT(it);
                const int ch = NHELP * it + hw;
                if (ch < NCHUNK) helper_chunk(lds + ((it & 1) * NHELP + hw) * SL_BYTES, cst, R, ch + NHELP < NCHUNK, PROJ, DAG, BON, tokl + ch * CS, h, lane);
                __syncthreads();
            }
        } else {
            f32x4 X[4];
#pragma unroll
            for (int jb = 0; jb < 4; ++jb) X[jb] = (f32x4){0.f, 0.f, 0.f, 0.f};
            __builtin_amdgcn_s_setprio(3);
            for (int it = 0; it <= NIT + 1; ++it) {
                RWKV_OUT(it);
                if (it > 0) {
                    for (int k = 0; k < NHELP; ++k) { const int ch = NHELP * (it - 1) + k;
                        if (ch < NCHUNK) state_chunk(lds + (((it - 1) & 1) * NHELP + k) * SL_BYTES, X, lds + SC_YL + ((it - 1) & 1) * YL_BYTES + k * (CS * 256), lane, wave); }
                }
                __syncthreads();
            }
            __builtin_amdgcn_s_setprio(0);
        }
        __syncthreads();
    }
}

__device__ __forceinline__ s16x4 vtr(const LAS unsigned char* p) { typedef short v4i16_t __attribute__((ext_vector_type(4)));
    return __builtin_bit_cast(s16x4, __builtin_amdgcn_ds_read_tr16_b64_v4i16((LAS v4i16_t*)p)); }
constexpr int ATT_UNITS = 3 * BATCH * NH * 16;
__device__ __forceinline__ void p4_attn(Frame& F, const Args& AR) {
    const bf16* PROJ = (const bf16*)(F.ws + WS_PROJ);
    bf16* PO = (bf16*)((unsigned char*)F.out + DO_PO); float* ML = (float*)(F.ws + WS_ML);
    const int tid = F.tid, lane = F.lane, wave = F.wave, half = wave >> 2, wq = wave & 3, th = tid & 255;
    const int r32 = lane & 31, hi = lane >> 5;
    LAS unsigned char* Kl = F.lds + RING_OFF + half * 65536; LAS unsigned char* Vl = Kl + 32768;
    gu32* qctr = F.ctl + CW_ATTQ;
    for (;;) {
        if (tid == 0) F.MISC[16] = __hip_atomic_fetch_add(qctr, 1u, RLX_AGENT);
        __syncthreads();
        const int up = (int)F.MISC[16];
        if (up >= ATT_UNITS / 2) break;
        const int unit = 2 * up + half;
        const int pat = unit / (BATCH * NH * 16), rem = unit % (BATCH * NH * 16), bh = rem >> 4, i16 = rem & 15, b = bh >> 3, h = bh & 7;
        const int dil = pat == 0 ? 1 : (pat == 1 ? 4 : 16);
        const int res = pat == 0 ? 0 : (pat == 1 ? (i16 >> 2) : i16);
        const int n = pat == 0 ? i16 : (pat == 1 ? (i16 & 3) : 0);
        const size_t rowb = (size_t)b * SEQ;
        {
            const int c = th & 7;
#pragma unroll
            for (int i = 0; i < 8; ++i) {
                const int key = (th >> 3) + 32 * i; const int sub = 128 * (n - 1) + key;
                v4u kv = (v4u){0u, 0u, 0u, 0u}, vv = kv;
                if (sub >= 0) { const bf16* src = PROJ + (rowb + res + dil * sub) * IN_COLS + h * 64 + 8 * c; kv = *(const v4u*)(src + PC_K); vv = *(const v4u*)(src + PC_V); }
                *(LAS v4u*)(Kl + key * 128 + ((c ^ ((key >> 1) & 7)) * 16)) = kv;
                *(LAS v4u*)(Vl + (c >> 2) * 16384 + key * 64 + (c & 3) * 16) = vv;
            }
        }
        const int ql = 32 * wq + r32; const size_t qrow = rowb + res + dil * (128 * n + ql);
        bf16x8 qf[4];
#pragma unroll
        for (int d0 = 0; d0 < 4; ++d0) qf[d0] = *(const bf16x8*)(PROJ + qrow * IN_COLS + PC_Q + h * 64 + 16 * d0 + 8 * hi);
        __syncthreads();
        const float slope2 = __builtin_amdgcn_exp2f(-(float)(h + 1)) * (float)dil * LOG2E;
        const int thr = r32 - 4 * hi;
        f32x16 sc[5];
        float mx = -INFINITY;
#pragma unroll
        for (int kt = 0; kt < 5; ++kt) {
            const bool skip = (n == 0) && (wq + kt < 4);
            f32x16 acc;
            if (!skip) {
                const int key = 32 * (wq + kt) + r32;
                const float bk = -slope2 * (float)(128 - 32 * kt + thr);
#pragma unroll
                for (int r = 0; r < 16; ++r) acc[r] = slope2 * (float)((r & 3) + 8 * (r >> 2)) + bk;
#pragma unroll
                for (int d0 = 0; d0 < 4; ++d0) {
                    const bf16x8 kf = *(const LAS bf16x8*)(Kl + key * 128 + (((2 * d0 + hi) ^ ((key >> 1) & 7)) * 16));
                    acc = __builtin_amdgcn_mfma_f32_32x32x16_bf16(kf, qf[d0], acc, 0, 0, 0);
                }
                if (kt == 0) {
#pragma unroll
                    for (int r = 0; r < 16; ++r) acc[r] = ((r & 3) + 8 * (r >> 2)) >= thr ? acc[r] : -INFINITY;
                }
                if (kt == 4) {
#pragma unroll
                    for (int r = 0; r < 16; ++r) acc[r] = ((r & 3) + 8 * (r >> 2)) <= thr ? acc[r] : -INFINITY;
                }
#pragma unroll
                for (int r = 0; r < 16; ++r) mx = fmaxf(mx, acc[r]);
            } else {
#pragma unroll
                for (int r = 0; r < 16; ++r) acc[r] = -INFINITY;
            }
            sc[kt] = acc;
            __builtin_amdgcn_sched_barrier(0);
        }
        mx = fmaxf(mx, __shfl_xor(mx, 32));
        float l = 0.f;
#pragma unroll
        for (int kt = 0; kt < 5; ++kt)
#pragma unroll
            for (int r = 0; r < 16; ++r) { const float p = __builtin_amdgcn_exp2f(sc[kt][r] - mx); sc[kt][r] = p; l += p; }
        l += __shfl_xor(l, 32);
        f32x16 o[2]; o[0] = f32x16{}; o[1] = f32x16{};
        const int voff = ((lane >> 4) & 1) * 32 + (lane & 3) * 8 + (4 * hi + ((lane & 15) >> 2)) * 64;
#pragma unroll
        for (int kt = 0; kt < 5; ++kt) {
            const bool skip = (n == 0) && (wq + kt < 4);
            if (!skip) {
#pragma unroll
            for (int s2 = 0; s2 < 2; ++s2) {
                v4u pw;
                pw.x = pg8::cvt_pk_bf16(sc[kt][8 * s2 + 0], sc[kt][8 * s2 + 1]); pw.y = pg8::cvt_pk_bf16(sc[kt][8 * s2 + 2], sc[kt][8 * s2 + 3]);
                pw.z = pg8::cvt_pk_bf16(sc[kt][8 * s2 + 4], sc[kt][8 * s2 + 5]); pw.w = pg8::cvt_pk_bf16(sc[kt][8 * s2 + 6], sc[kt][8 * s2 + 7]);
                const bf16x8 pf = __builtin_bit_cast(bf16x8, pw);
                const int kb = 32 * (wq + kt) + 16 * s2;
#pragma unroll
                for (int dt = 0; dt < 2; ++dt) {
                    const LAS unsigned char* vp = Vl + dt * 16384 + kb * 64 + voff;
                    const s16x4 lo = vtr(vp), hi4 = vtr(vp + 8 * 64);
                    const bf16x8 vf = (bf16x8){lo[0], lo[1], lo[2], lo[3], hi4[0], hi4[1], hi4[2], hi4[3]};
                    o[dt] = __builtin_amdgcn_mfma_f32_32x32x16_bf16(vf, pf, o[dt], 0, 0, 0);
                }
            }
            }
        }
        const float rl = 1.f / l;
        bf16* po = PO + ((size_t)pat * M + qrow) * AW + h * 64;
#pragma unroll
        for (int dt = 0; dt < 2; ++dt)
#pragma unroll
            for (int g = 0; g < 4; ++g) {
                const v2u w = (v2u){pk2(o[dt][4 * g] * rl, o[dt][4 * g + 1] * rl), pk2(o[dt][4 * g + 2] * rl, o[dt][4 * g + 3] * rl)};
                *(v2u*)(po + 32 * dt + 8 * g + 4 * hi) = w;
            }
        if (hi == 0) *(f32x2*)(ML + (((size_t)pat * M + qrow) * NH + h) * 2) = (f32x2){mx, l};
        __syncthreads();
    }
}

struct P5In { v4u po[3]; f32x2 ml[3]; };
__device__ __forceinline__ void p5_load(P5In& I, int m, int lane, const bf16* PO, const float* ML) {
    const int hd = lane >> 3;
#pragma unroll
    for (int p = 0; p < 3; ++p) { I.ml[p] = *(const GAS f32x2*)(ML + (((size_t)p * M + m) * NH + hd) * 2); I.po[p] = *(const GAS v4u*)(PO + ((size_t)p * M + m) * AW + 8 * lane); }
}
__device__ __forceinline__ void p5_token(const P5In& I, int m, int lane, bf16* MIX, const float (&aog)[8]) {
    const float mm = fmaxf(fmaxf(I.ml[0].x, I.ml[1].x), I.ml[2].x);
    float wp[3], wsum = 0.f;
#pragma unroll
    for (int p = 0; p < 3; ++p) { wp[p] = __builtin_amdgcn_exp2f(I.ml[p].x - mm) * I.ml[p].y; wsum += wp[p]; }
    const float rws = 1.f / wsum;
    float at[8] = {0.f, 0.f, 0.f, 0.f, 0.f, 0.f, 0.f, 0.f};
#pragma unroll
    for (int p = 0; p < 3; ++p) { const v4u w = I.po[p]; const float f = wp[p] * rws;
        at[0] += f * bflo(w.x); at[1] += f * bfhi(w.x); at[2] += f * bflo(w.y); at[3] += f * bfhi(w.y); at[4] += f * bflo(w.z); at[5] += f * bfhi(w.z); at[6] += f * bflo(w.w); at[7] += f * bfhi(w.w); }
    float ss = 0.f;
#pragma unroll
    for (int i = 0; i < 8; ++i) ss += at[i] * at[i];
    ss += __shfl_xor(ss, 1); ss += __shfl_xor(ss, 2); ss += __shfl_xor(ss, 4);
    const float rstd = 1.f / sqrtf(ss * (1.f / 64.f) + NORM_EPS);
    v4u oa; oa.x = pk2(at[0] * rstd * aog[0], at[1] * rstd * aog[1]); oa.y = pk2(at[2] * rstd * aog[2], at[3] * rstd * aog[3]);
    oa.z = pk2(at[4] * rstd * aog[4], at[5] * rstd * aog[5]); oa.w = pk2(at[6] * rstd * aog[6], at[7] * rstd * aog[7]);
    *(GAS v4u*)(MIX + (size_t)m * D + 8 * lane) = oa;
}
__device__ __forceinline__ void p5_post(Frame& F, const Args& AR) {
    const int gw = F.vcu * NWAVES + F.wave, NGW = F.G * NWAVES, lane = F.lane;
    const bf16* PO = (const bf16*)((unsigned char*)F.out + DO_PO); const float* ML = (const float*)(F.ws + WS_ML);
    bf16* MIX = (bf16*)(F.ws + WS_XN);
    float aog[8];
#pragma unroll
    for (int i = 0; i < 8; ++i) aog[i] = AR.in[I_AOG][8 * lane + i];
    static_assert(M % 4 == 0, "four tokens per step");
    for (int m = 4 * gw; m < M; m += 4 * NGW) {
        P5In A, B, C, E;
        p5_load(A, m, lane, PO, ML); p5_load(B, m + 1, lane, PO, ML); p5_load(C, m + 2, lane, PO, ML); p5_load(E, m + 3, lane, PO, ML);
        p5_token(A, m, lane, MIX, aog); p5_token(B, m + 1, lane, MIX, aog); p5_token(C, m + 2, lane, MIX, aog); p5_token(E, m + 3, lane, MIX, aog);
    }
}

__global__ void __launch_bounds__(NWAVES * 64, 2) hybrid_fwd(Args args) {
    extern __shared__ __attribute__((aligned(16))) unsigned char lds[];
    Frame F;
    F.lds = (LAS unsigned char*)lds;
    F.MISC = (volatile LAS unsigned*)(F.lds + MISC_OFF);
    F.tid = threadIdx.x; F.lane = F.tid & 63; F.wave = __builtin_amdgcn_readfirstlane(F.tid >> 6);
    F.G = gridDim.x; { const int bx = blockIdx.x; F.vcu = (F.G % 8 == 0) ? (bx % 8) * (F.G / 8) + bx / 8 : bx; }
    F.ws = args.ws; F.out = args.out;
    F.ctl = (gu32*)(args.ws + WS_CTL);
    for (int u = F.tid; u < (LDS_BYTES - LDSCTL_OFF) / 4; u += NWAVES * 64) ((LAS unsigned*)(F.lds + LDSCTL_OFF))[u] = 0u;
    __syncthreads();
    XcdBarrier bar; bar.bar = (unsigned*)(F.ctl + CW_BAR); bar.x = 0; bar.st = nullptr;
    if (N_LAUNCHES != PER_PHASE) bar = xcd_barrier_post((unsigned*)(F.ctl + CW_BAR), F.MISC + 8);
#define GRID_BAR() do { if (N_LAUNCHES != PER_PHASE) xcd_barrier(bar); } while (0)
    const int lo = args.ph_lo, hi = args.ph_hi;
#ifndef PHMASK
#define PHMASK 0x3ff
#endif
#define IN(k) (((PHMASK >> (k)) & 1) && lo <= (k) && (k) < hi)
#define BOTH(k) (IN(k) && IN((k) + 1))
#ifndef REPMASK
#define REPMASK 0
#endif
#define REP(k) for (int rep_ = 0; rep_ <= ((REPMASK >> (k)) & 1); ++rep_)
    bf16* XN = (bf16*)(args.ws + WS_XN); bf16* PROJ = (bf16*)(args.ws + WS_PROJ);

    if (IN(0)) { p0_prologue(F, args); if (BOTH(0)) GRID_BAR(); }
    if (IN(1)) {
        pg8::Gemm g{XN, (const bf16*)(args.ws + WS_WIN), M, IN_COLS, D}; pg8::StaticOrder S; S.init(M, IN_COLS, F.G, (int)blockIdx.x);
        pg8::EpiProj E{PROJ, IN_COLS, args.in[I_QNG], args.in[I_KNG]};
        pg8::gemm_phase<pg8::EpiProj, pg8::StaticOrder, true, true>(F.lds + RING_OFF, g, S, E);
        if (BOTH(1)) GRID_BAR();
    }
    if (IN(2)) { p2_prep(F, args); if (BOTH(2)) GRID_BAR(); }
    if (IN(3)) {
        pg8::Gemm g{(const bf16*)(args.ws + WS_A2), (const bf16*)(args.ws + WS_WL), M, NLORA, KLORA}; pg8::StaticOrder S; S.init(M, NLORA, F.G, (int)blockIdx.x);
        pg8::EpiLora E{(bf16*)(args.ws + WS_DAG), NLORA, args.in[I_W0], args.in[I_A0]};
        pg8::gemm_phase<pg8::EpiLora, pg8::StaticOrder, true, true>(F.lds + RING_OFF, g, S, E);
        if (BOTH(3)) GRID_BAR();
    }
    if (IN(4)) { p4_scan(F, args); p4_attn(F, args); if (BOTH(4)) GRID_BAR(); }
    if (IN(5)) { p5_post(F, args); if (BOTH(5)) GRID_BAR(); }
    if (IN(6)) {
        pg8::Gemm g{XN, (const bf16*)(args.ws + WS_WOUT), M, D, D}; pg8::StaticOrder S; S.init(M, D, F.G, (int)blockIdx.x);
        pg8::EpiOut E{args.in[I_X], (bf16*)(args.ws + WS_DAG), (float*)(args.ws + WS_SS), D, (LAS float*)(F.lds + RING_OFF + 131072)};
        pg8::gemm_phase<pg8::EpiOut, pg8::StaticOrder, true, true>(F.lds + RING_OFF, g, S, E);
        if (IN(8)) GRID_BAR();
    }
    if (IN(8)) {
        pg8::Gemm g{(const bf16*)(args.ws + WS_DAG), (const bf16*)(args.ws + WS_WGU), M, NGU, D}; pg8::StaticOrder S; S.init(M, NGU, F.G, (int)blockIdx.x);
        pg8::EpiSwiglu E{PROJ, FF, (const float*)(args.ws + WS_SS)};
        pg8::gemm_phase<pg8::EpiSwiglu, pg8::StaticOrder, true, true>(F.lds + RING_OFF, g, S, E);
        if (BOTH(8)) GRID_BAR();
    }
    if (IN(9)) {
        pg8::Gemm g{PROJ, (const bf16*)(args.ws + WS_WDN), M, D, FF}; pg8::StaticOrder S; S.init(M, D, F.G, (int)blockIdx.x);
        pg8::EpiFinal E{(const bf16*)(args.ws + WS_DAG), F.out, D};
        pg8::gemm_phase<pg8::EpiFinal, pg8::StaticOrder, true, true>(F.lds + RING_OFF, g, S, E);
    }
#undef IN
#undef BOTH
}

extern "C" void kernel_launch(void* const* d_in, const int* in_sizes, int n_in, void* d_out, int out_size, void* d_ws, size_t ws_size, hipStream_t stream) {
    static int grid = 0;
    if (grid == 0) {
        if (n_in != 22 || in_sizes[0] != M * D || out_size != M * D || ws_size < WS_END) { fprintf(stderr, "kernel_launch: unexpected shapes (n_in %d, in0 %d, out %d, ws %zu); nothing launched\n", n_in, n_in > 0 ? in_sizes[0] : -1, out_size, ws_size); grid = -1; return; }
        int dev = 0, cus = 0, per_cu = 0;
        if (hipGetDevice(&dev) != hipSuccess || hipDeviceGetAttribute(&cus, hipDeviceAttributeMultiprocessorCount, dev) != hipSuccess) { grid = -1; return; }
        if (hipFuncSetAttribute((const void*)hybrid_fwd, hipFuncAttributeMaxDynamicSharedMemorySize, LDS_BYTES) != hipSuccess) { fprintf(stderr, "kernel_launch: hipFuncSetAttribute failed\n"); grid = -1; return; }
        if (hipOccupancyMaxActiveBlocksPerMultiprocessor(&per_cu, (const void*)hybrid_fwd, NWAVES * 64, LDS_BYTES) != hipSuccess || per_cu < 1)
            fprintf(stderr, "kernel_launch: note: occupancy query reports %d workgroups per CU\n", per_cu);
        (void)hipGetLastError();
        grid = cus;
    }
    if (grid < 0) return;
    if (hipMemsetAsync((char*)d_ws + WS_CTL, 0, CTL_ZERO_BYTES, stream) != hipSuccess) { fprintf(stderr, "kernel_launch: hipMemsetAsync failed\n"); return; }
    Args a{};
    for (int i = 0; i < 22; ++i) a.in[i] = (const float*)d_in[i];
    a.out = (float*)d_out; a.ws = (unsigned char*)d_ws;
    for (int li = 0; li < N_LAUNCHES; ++li) {
        a.ph_lo = (N_LAUNCHES == PER_PHASE) ? li : 0; a.ph_hi = (N_LAUNCHES == PER_PHASE) ? li + 1 : PER_PHASE; a.li = li;
        hipLaunchKernelGGL(hybrid_fwd, dim3(grid), dim3(NWAVES * 64), LDS_BYTES, stream, a);
        const hipError_t le = hipPeekAtLastError();
        if (le != hipSuccess) { fprintf(stderr, "kernel_launch: launch %d failed: %s\n", li, hipGetErrorName(le)); break; }
    }
}
```

```cpp
#include <hip/hip_runtime.h>
#include <cstdio>
#include <cstdint>

#ifndef PROBE_SEL
#define PROBE_SEL -1
#endif
#ifndef MK_N_LAUNCHES
#define MK_N_LAUNCHES 1
#endif

namespace pg8 {
#define PG8_LAS __attribute__((address_space(3)))
typedef unsigned short bf16_t;
typedef short bf16x8 __attribute__((ext_vector_type(8)));
typedef float f32x4 __attribute__((ext_vector_type(4)));
typedef float f32x2 __attribute__((ext_vector_type(2)));
typedef unsigned u32x4 __attribute__((ext_vector_type(4)));
constexpr int BM = 256, BK = 64, HALF = 128, HTB = HALF * BK * 2, STAGE_BYTES = 8 * HTB, NXCD = 8, WGM = 8;

__host__ __device__ __forceinline__ int lds_byte(int r, int c) { const int st = (r >> 4) * 2 + (c >> 5), rr = r & 15, cc = c & 31, ob = rr * 64 + cc * 2; return st * 1024 + (ob ^ (((ob >> 9) & 1) << 5)); }
__host__ __device__ __forceinline__ void stage_rc(int b, int& R, int& C) { const int st = b / 1024, sb = b % 1024, swz = sb ^ (((sb >> 9) & 1) << 5); R = (st >> 1) * 16 + swz / 64; C = (st & 1) * 32 + (swz % 64) / 2; }
__host__ __device__ __forceinline__ int perm32(int rho) { const int n = rho >> 4, i = rho & 15; return 8 * (i >> 2) + 4 * n + (i & 3); }

struct Unit { int pm, pn; };
struct Gemm { const bf16_t* A; const bf16_t* Bt; int M, N, K; };

struct StaticOrder {
    int nM, nN, nwg, G, c;
    __host__ __device__ void init(int M, int N, int G_, int c_) { nM = M / BM; nN = N / BM; nwg = nM * nN; G = G_; c = c_; }
    __host__ __device__ bool next(int i, Unit& u) const {
        const long L = (long)i * G + c; if (L >= nwg) return false;
        int wgid = (int)L; { const int q = nwg / NXCD, r = nwg % NXCD, xcd = wgid % NXCD, off = wgid / NXCD; wgid = (xcd < r ? xcd * (q + 1) : r * (q + 1) + (xcd - r) * q) + off; }
        const int nig = WGM * nN, gid = wgid / nig, fm = gid * WGM, gsz = (nM - fm) < WGM ? (nM - fm) : WGM;
        u.pm = fm + ((wgid % nig) % gsz); u.pn = (wgid % nig) / gsz; return true;
    }
    __device__ __forceinline__ void a_ready(const Unit&) const {}
    __device__ __forceinline__ void done(const Unit&) const {}
};

__device__ __forceinline__ unsigned cvt_pk_bf16(float lo, float hi) { unsigned r; asm volatile("v_cvt_pk_bf16_f32 %0, %1, %2" : "=v"(r) : "v"(lo), "v"(hi)); return r; }
__device__ __forceinline__ float fsigmoid(float x) { return __builtin_amdgcn_rcpf(1.0f + __builtin_amdgcn_exp2f(-1.4426950408889634f * x)); }

struct EpiBf16 {
    static constexpr bool PERM = true, AFTER_DRAIN = false;
    bf16_t* O; int ldc;
    __device__ __forceinline__ void operator()(const f32x4 (&acc)[2][2][4][2], const Unit& u, int wr, int wc, int fr, int fq) const {
        const int row0 = u.pm * BM + wr * 64 + fr; const int col0 = u.pn * BM + wc * 32 + 8 * fq;
#pragma unroll
        for (int ai = 0; ai < 2; ++ai)
#pragma unroll
            for (int m = 0; m < 4; ++m) { bf16_t* rowp = O + (size_t)(row0 + ai * HALF + m * 16) * ldc + col0;
#pragma unroll
                for (int bj = 0; bj < 2; ++bj) { const f32x4 v0 = acc[ai][bj][m][0], v1 = acc[ai][bj][m][1];
                    u32x4 w; w.x = cvt_pk_bf16(v0[0], v0[1]); w.y = cvt_pk_bf16(v0[2], v0[3]); w.z = cvt_pk_bf16(v1[0], v1[1]); w.w = cvt_pk_bf16(v1[2], v1[3]);
                    *(u32x4*)(rowp + bj * HALF) = w; } }
    }
};
struct EpiProj {
    static constexpr bool PERM = true, AFTER_DRAIN = false;
    bf16_t* O; int ldc; const float* qg; const float* kg;
    __device__ __forceinline__ void operator()(const f32x4 (&acc)[2][2][4][2], const Unit& u, int wr, int wc, int fr, int fq) const {
        const int row0 = u.pm * BM + wr * 64 + fr;
        if (u.pn >= 4) {
            const int col0 = u.pn * BM + wc * 32 + 8 * fq;
#pragma unroll
            for (int ai = 0; ai < 2; ++ai)
#pragma unroll
                for (int m = 0; m < 4; ++m) { bf16_t* rowp = O + (size_t)(row0 + ai * HALF + m * 16) * ldc + col0;
#pragma unroll
                    for (int bj = 0; bj < 2; ++bj) { const f32x4 v0 = acc[ai][bj][m][0], v1 = acc[ai][bj][m][1];
                        u32x4 w; w.x = cvt_pk_bf16(v0[0], v0[1]); w.y = cvt_pk_bf16(v0[2], v0[3]); w.z = cvt_pk_bf16(v1[0], v1[1]); w.w = cvt_pk_bf16(v1[2], v1[3]);
                        *(u32x4*)(rowp + bj * HALF) = w; } }
        } else {
            const float* gsrc = (u.pn < 2 ? qg : kg) + 8 * fq; const float sc = u.pn < 2 ? 0.125f * 1.4426950408889634f : 1.0f;
            f32x4 g4[2][2];
#pragma unroll
            for (int bj = 0; bj < 2; ++bj)
#pragma unroll
                for (int n = 0; n < 2; ++n) g4[bj][n] = *(const f32x4*)(gsrc + 32 * bj + 4 * n) * sc;
            const int col0 = u.pn * BM + wc * 64 + 8 * fq;
#pragma unroll
            for (int ai = 0; ai < 2; ++ai)
#pragma unroll
                for (int m = 0; m < 4; ++m) {
                    float ss = 0.f;
#pragma unroll
                    for (int bj = 0; bj < 2; ++bj)
#pragma unroll
                        for (int n = 0; n < 2; ++n) { const f32x4 v = acc[ai][bj][m][n]; ss += (v[0] * v[0] + v[1] * v[1]) + (v[2] * v[2] + v[3] * v[3]); }
                    ss += __shfl_xor(ss, 16); ss += __shfl_xor(ss, 32);
                    const float rstd = 1.0f / sqrtf(ss * (1.0f / 64.0f) + 1e-6f);
                    bf16_t* rowp = O + (size_t)(row0 + ai * HALF + m * 16) * ldc + col0;
#pragma unroll
                    for (int bj = 0; bj < 2; ++bj) { const f32x4 v0 = acc[ai][bj][m][0] * g4[bj][0] * rstd, v1 = acc[ai][bj][m][1] * g4[bj][1] * rstd;
                        u32x4 w; w.x = cvt_pk_bf16(v0[0], v0[1]); w.y = cvt_pk_bf16(v0[2], v0[3]); w.z = cvt_pk_bf16(v1[0], v1[1]); w.w = cvt_pk_bf16(v1[2], v1[3]);
                        *(u32x4*)(rowp + 32 * bj) = w; }
                    __builtin_amdgcn_sched_barrier(0); }
        }
    }
};
struct EpiLora {
    static constexpr bool PERM = true, AFTER_DRAIN = false;
    bf16_t* O; int ldc; const float* w0; const float* a0;
    __device__ __forceinline__ void operator()(const f32x4 (&acc)[2][2][4][2], const Unit& u, int wr, int wc, int fr, int fq) const {
        const int row0 = u.pm * BM + wr * 64 + fr; const int col0 = u.pn * BM + wc * 32 + 8 * fq;
        const int kind = u.pn >> 1;
        const float sc = kind == 0 ? -0.6065306597126334f : (kind == 1 ? 1.0f : 0.0f), lin = kind == 2 ? 1.0f : 0.0f;
        const float* bp = kind == 0 ? w0 : a0;
        const float bs = kind == 2 ? 0.0f : 1.0f;
#pragma unroll
        for (int bj = 0; bj < 2; ++bj) {
            const int c = (col0 + bj * HALF) & 511;
            const f32x4 b0 = *(const f32x4*)(bp + c) * bs, b1 = *(const f32x4*)(bp + c + 4) * bs;
#pragma unroll
            for (int ai = 0; ai < 2; ++ai)
#pragma unroll
                for (int m = 0; m < 4; ++m) { bf16_t* rowp = O + (size_t)(row0 + ai * HALF + m * 16) * ldc + col0;
                    f32x4 v0 = acc[ai][bj][m][0] + b0, v1 = acc[ai][bj][m][1] + b1;
#pragma unroll
                    for (int e = 0; e < 4; ++e) { v0[e] = sc * fsigmoid(v0[e]) + lin * v0[e]; v1[e] = sc * fsigmoid(v1[e]) + lin * v1[e]; }
                    u32x4 w; w.x = cvt_pk_bf16(v0[0], v0[1]); w.y = cvt_pk_bf16(v0[2], v0[3]); w.z = cvt_pk_bf16(v1[0], v1[1]); w.w = cvt_pk_bf16(v1[2], v1[3]);
                    *(u32x4*)(rowp + bj * HALF) = w;
                    __builtin_amdgcn_sched_barrier(0); }
        }
    }
};
struct EpiSwiglu {
    static constexpr bool PERM = true, AFTER_DRAIN = false;
    bf16_t* H; int ldh; const float* rstd;
    __device__ __forceinline__ void operator()(const f32x4 (&acc)[2][2][4][2], const Unit& u, int wr, int wc, int fr, int fq) const {
        const int row0 = u.pm * BM + wr * 64 + fr; const int col0 = u.pn * HALF + wc * 32 + 8 * fq;
        float rs[2][4];
#pragma unroll
        for (int ai = 0; ai < 2; ++ai)
#pragma unroll
            for (int m = 0; m < 4; ++m) { const f32x4 s4 = *(const f32x4*)(rstd + (size_t)(row0 + ai * HALF + m * 16) * 4);
                rs[ai][m] = 1.0f / sqrtf(((s4[0] + s4[1]) + (s4[2] + s4[3])) * (1.0f / 1024.0f) + 1e-6f); }
#pragma unroll
        for (int ai = 0; ai < 2; ++ai)
#pragma unroll
            for (int m = 0; m < 4; ++m) { bf16_t* rowp = H + (size_t)(row0 + ai * HALF + m * 16) * ldh + col0;
                float h[8];
#pragma unroll
                for (int n = 0; n < 2; ++n)
#pragma unroll
                    for (int e = 0; e < 4; ++e) { const float g = acc[ai][0][m][n][e] * rs[ai][m], up = acc[ai][1][m][n][e] * rs[ai][m]; h[4 * n + e] = g * fsigmoid(g) * up; }
                u32x4 w; w.x = cvt_pk_bf16(h[0], h[1]); w.y = cvt_pk_bf16(h[2], h[3]); w.z = cvt_pk_bf16(h[4], h[5]); w.w = cvt_pk_bf16(h[6], h[7]);
                *(u32x4*)rowp = w;
                __builtin_amdgcn_sched_barrier(0); }
    }
};
struct EpiOut {
    static constexpr bool PERM = true, AFTER_DRAIN = false;
    const float* base; bf16_t* xb; float* SS; int ldc; PG8_LAS float* scr;
    __device__ __forceinline__ void operator()(const f32x4 (&acc)[2][2][4][2], const Unit& u, int wr, int wc, int fr, int fq) const {
        const int row0 = u.pm * BM + wr * 64 + fr, col0 = u.pn * BM + wc * 32 + 8 * fq;
#pragma unroll
        for (int ai = 0; ai < 2; ++ai)
#pragma unroll
            for (int m = 0; m < 4; ++m) { const size_t off = (size_t)(row0 + ai * HALF + m * 16) * ldc + col0;
                float ss = 0.f;
#pragma unroll
                for (int bj = 0; bj < 2; ++bj) {
                    const f32x4 o0 = *(const f32x4*)(base + off + bj * HALF) + acc[ai][bj][m][0], o1 = *(const f32x4*)(base + off + bj * HALF + 4) + acc[ai][bj][m][1];
                    u32x4 w; w.x = cvt_pk_bf16(o0[0], o0[1]); w.y = cvt_pk_bf16(o0[2], o0[3]); w.z = cvt_pk_bf16(o1[0], o1[1]); w.w = cvt_pk_bf16(o1[2], o1[3]);
                    *(u32x4*)(xb + off + bj * HALF) = w;
                    ss += ((o0[0] * o0[0] + o0[1] * o0[1]) + (o0[2] * o0[2] + o0[3] * o0[3])) + ((o1[0] * o1[0] + o1[1] * o1[1]) + (o1[2] * o1[2] + o1[3] * o1[3])); }
                ss += __shfl_xor(ss, 16); ss += __shfl_xor(ss, 32);
                if (fq == 0) scr[((((wr * 2 + ai) * 4 + m) * 16) + fr) * 4 + wc] = ss;
                if (m & 1) asm volatile("" ::: "memory"); }
        asm volatile("s_waitcnt lgkmcnt(0)" ::: "memory"); __builtin_amdgcn_s_barrier(); asm volatile("" ::: "memory");
        const int tid = threadIdx.x;
        if (tid < 256) { const f32x4 s4 = *(const PG8_LAS f32x4*)(scr + tid * 4);
            const int row = u.pm * BM + ((tid >> 6) & 1) * HALF + (tid >> 7) * 64 + ((tid >> 4) & 3) * 16 + (tid & 15);
            SS[(size_t)row * 4 + u.pn] = (s4[0] + s4[1]) + (s4[2] + s4[3]); }
    }
};
struct EpiFinal {
    static constexpr bool PERM = true, AFTER_DRAIN = false;
    const bf16_t* xb; float* out; int ldc;
    __device__ __forceinline__ void operator()(const f32x4 (&acc)[2][2][4][2], const Unit& u, int wr, int wc, int fr, int fq) const {
        const int row0 = u.pm * BM + wr * 64 + fr, col0 = u.pn * BM + wc * 32 + 8 * fq;
#pragma unroll
        for (int ai = 0; ai < 2; ++ai)
#pragma unroll
            for (int m = 0; m < 4; ++m) { const size_t off = (size_t)(row0 + ai * HALF + m * 16) * ldc + col0;
#pragma unroll
                for (int bj = 0; bj < 2; ++bj) { const u32x4 w = *(const u32x4*)(xb + off + bj * HALF);
                    const f32x4 b0 = (f32x4){__builtin_bit_cast(float, w.x << 16), __builtin_bit_cast(float, w.x & 0xffff0000u), __builtin_bit_cast(float, w.y << 16), __builtin_bit_cast(float, w.y & 0xffff0000u)};
                    const f32x4 b1 = (f32x4){__builtin_bit_cast(float, w.z << 16), __builtin_bit_cast(float, w.z & 0xffff0000u), __builtin_bit_cast(float, w.w << 16), __builtin_bit_cast(float, w.w & 0xffff0000u)};
                    *(f32x4*)(out + off + bj * HALF) = b0 + acc[ai][bj][m][0]; *(f32x4*)(out + off + bj * HALF + 4) = b1 + acc[ai][bj][m][1]; }
                if (m & 1) asm volatile("" ::: "memory"); }
    }
};

template <class Epi, class Sched, bool ALIGN_EPI = false, bool SP2 = false>
__device__ __forceinline__ void gemm_phase(PG8_LAS unsigned char* lds, const Gemm g, const Sched& S, const Epi& E) {
    const int tid = threadIdx.x, wid = __builtin_amdgcn_readfirstlane(tid >> 6), lane = tid & 63, wr = wid >> 2, wc = wid & 3, fr = lane & 15, fq = lane >> 4;
    const int K = g.K, nt = K / BK;
    unsigned voffA[2], voffB[2];
#pragma unroll
    for (int i = 0; i < 2; ++i) { int R, C; stage_rc(tid * 16 + i * 8192, R, C); const int Rb = Epi::PERM ? ((R & ~31) + perm32(R & 31)) : R;
        voffA[i] = (unsigned)(R * K + C) * 2u; voffB[i] = (unsigned)(Rb * K + C) * 2u; }
    const size_t kstep = (size_t)(BK * 2);
    const size_t hstep = (size_t)HALF * K * 2;
    const size_t tstep = 2 * hstep;
    const unsigned ldsw = (unsigned)wid * 1024u;
    const int aoff = lds_byte(wr * 64 + fr, fq * 8), boff = lds_byte(wc * 32 + fr, fq * 8);
#define PG8_SA(b, h) (((b) * 2 + (h)) * HTB)
#define PG8_SB(b, h) ((4 + (b) * 2 + (h)) * HTB)
#define PG8_STAGE(bufoff, gbase, voff) do { _Pragma("unroll") for (int _i = 0; _i < 2; ++_i) \
        __builtin_amdgcn_global_load_lds((const unsigned*)((const char*)(gbase) + (voff)[_i]), (PG8_LAS unsigned*)(lds + (bufoff) + ldsw + _i * 8192), 16, 0, 0); } while (0)
#define PG8_LDA(dst, b, h) do { _Pragma("unroll") for (int m = 0; m < 4; ++m) _Pragma("unroll") for (int k = 0; k < 2; ++k) dst[m][k] = *(const PG8_LAS bf16x8*)(lds + PG8_SA(b, h) + aoff + m * 2048 + k * 1024); } while (0)
#define PG8_LDB(dst, b, h) do { _Pragma("unroll") for (int n = 0; n < 2; ++n) _Pragma("unroll") for (int k = 0; k < 2; ++k) dst[n][k] = *(const PG8_LAS bf16x8*)(lds + PG8_SB(b, h) + boff + n * 2048 + k * 1024); } while (0)
#define PG8_MMA(ai, bj, At, Bt) do { __builtin_amdgcn_s_setprio(1); _Pragma("unroll") for (int m = 0; m < 4; ++m) _Pragma("unroll") for (int n = 0; n < 2; ++n) _Pragma("unroll") for (int k = 0; k < 2; ++k) \
        acc[ai][bj][m][n] = __builtin_amdgcn_mfma_f32_16x16x32_bf16(Bt[n][k], At[m][k], acc[ai][bj][m][n], 0, 0, 0); __builtin_amdgcn_s_setprio(0); } while (0)
#define PG8_WAIT_V(n) asm volatile("s_waitcnt vmcnt(" #n ")" ::: "memory")
#define PG8_WAIT_L(n) asm volatile("s_waitcnt lgkmcnt(" #n ")" ::: "memory")
#define PG8_BAR __builtin_amdgcn_s_barrier()
#define PG8_SCHED __builtin_amdgcn_sched_barrier(0)
    Unit cur, nxt; int ui = 0;
    if (!S.next(0, cur)) return;
    f32x4 acc[2][2][4][2];
#pragma unroll
    for (int a = 0; a < 2; ++a)
#pragma unroll
        for (int b = 0; b < 2; ++b)
#pragma unroll
            for (int m = 0; m < 4; ++m)
#pragma unroll
                for (int n = 0; n < 2; ++n) acc[a][b][m][n] = (f32x4){0.f, 0.f, 0.f, 0.f};
    bf16x8 At[4][2], B0[2][2], B1[2][2];
    const char* cA = (const char*)g.A + (size_t)cur.pm * tstep; const char* cB = (const char*)g.Bt + (size_t)cur.pn * tstep;
    S.a_ready(cur);
    if constexpr (SP2) {
        PG8_STAGE(PG8_SB(0, 0), cB, voffB); PG8_STAGE(PG8_SB(0, 1), cB + hstep, voffB); PG8_STAGE(PG8_SA(0, 0), cA, voffA); PG8_STAGE(PG8_SA(0, 1), cA + hstep, voffA);
        if (wr == 1) PG8_BAR;
        PG8_WAIT_V(2); PG8_BAR;
        PG8_STAGE(PG8_SB(1, 0), cB + kstep, voffB); PG8_STAGE(PG8_SA(1, 0), cA + kstep, voffA); PG8_STAGE(PG8_SB(1, 1), cB + hstep + kstep, voffB);
        PG8_WAIT_V(6); PG8_BAR;
    } else {
        PG8_STAGE(PG8_SB(0, 0), cB, voffB); PG8_STAGE(PG8_SA(0, 0), cA, voffA); PG8_STAGE(PG8_SB(0, 1), cB + hstep, voffB); PG8_STAGE(PG8_SA(0, 1), cA + hstep, voffA);
        if (wr == 1) PG8_BAR;
        PG8_WAIT_V(4); PG8_BAR;
        PG8_STAGE(PG8_SB(1, 0), cB + kstep, voffB); PG8_STAGE(PG8_SA(1, 0), cA + kstep, voffA); PG8_STAGE(PG8_SB(1, 1), cB + hstep + kstep, voffB);
        PG8_WAIT_V(6); PG8_BAR;
    }
    for (;;) {
        const bool has_next = S.next(ui + 1, nxt);
        const char* nA = has_next ? (const char*)g.A + (size_t)nxt.pm * tstep : cA; const char* nB = has_next ? (const char*)g.Bt + (size_t)nxt.pn * tstep : cB;
#pragma nounroll
        for (int t = 0; t < nt; t += 2) {
            const bool last = (t == nt - 2);
            const char* a1 = cA + (size_t)(t + 1) * kstep;
            const char* a2 = last ? nA : cA + (size_t)(t + 2) * kstep; const char* b2 = last ? nB : cB + (size_t)(t + 2) * kstep;
            const char* a3 = a2 + kstep; const char* b3 = b2 + kstep;
            if (last && has_next) S.a_ready(nxt);
            if constexpr (SP2) {
            PG8_LDB(B0, 0, 0); PG8_LDB(B1, 0, 1); PG8_SCHED; PG8_LDA(At, 0, 0); PG8_STAGE(PG8_SA(1, 1), a1 + hstep, voffA);
            PG8_WAIT_V(8); PG8_WAIT_L(0); PG8_BAR; PG8_MMA(0, 0, At, B0); PG8_MMA(0, 1, At, B1); PG8_BAR; PG8_SCHED;
            PG8_LDA(At, 0, 1); PG8_STAGE(PG8_SB(0, 0), b2, voffB); PG8_STAGE(PG8_SB(0, 1), b2 + hstep, voffB); PG8_STAGE(PG8_SA(0, 0), a2, voffA);
            PG8_WAIT_V(8); PG8_WAIT_L(0); PG8_BAR; PG8_MMA(1, 0, At, B0); PG8_MMA(1, 1, At, B1); PG8_BAR; PG8_SCHED;
            PG8_LDB(B0, 1, 0); PG8_LDB(B1, 1, 1); PG8_SCHED; PG8_LDA(At, 1, 0); PG8_STAGE(PG8_SA(0, 1), a2 + hstep, voffA);
            PG8_WAIT_V(8); PG8_WAIT_L(0); PG8_BAR; PG8_MMA(0, 0, At, B0); PG8_MMA(0, 1, At, B1); PG8_BAR; PG8_SCHED;
            PG8_LDA(At, 1, 1); PG8_STAGE(PG8_SB(1, 0), b3, voffB); PG8_STAGE(PG8_SB(1, 1), b3 + hstep, voffB); PG8_STAGE(PG8_SA(1, 0), a3, voffA);
            PG8_WAIT_V(8); PG8_WAIT_L(0); PG8_BAR; PG8_MMA(1, 0, At, B0); PG8_MMA(1, 1, At, B1); PG8_BAR; PG8_SCHED;
            } else {
            PG8_LDB(B0, 0, 0); PG8_SCHED; PG8_LDA(At, 0, 0); PG8_STAGE(PG8_SA(1, 1), a1 + hstep, voffA);
            PG8_WAIT_L(8); PG8_BAR; PG8_WAIT_L(0); PG8_MMA(0, 0, At, B0); PG8_BAR; PG8_SCHED;
            PG8_LDB(B1, 0, 1); PG8_STAGE(PG8_SB(0, 0), b2, voffB);
            PG8_BAR; PG8_WAIT_L(0); PG8_MMA(0, 1, At, B1); PG8_BAR;
            PG8_LDA(At, 0, 1); PG8_STAGE(PG8_SA(0, 0), a2, voffA);
            PG8_BAR; PG8_WAIT_L(0); PG8_MMA(1, 0, At, B0); PG8_BAR; PG8_SCHED;
            PG8_STAGE(PG8_SB(0, 1), b2 + hstep, voffB);
            PG8_WAIT_V(6); PG8_BAR; PG8_MMA(1, 1, At, B1); PG8_BAR;
            PG8_LDB(B0, 1, 0); PG8_SCHED; PG8_LDA(At, 1, 0); PG8_STAGE(PG8_SA(0, 1), a2 + hstep, voffA);
            PG8_WAIT_L(8); PG8_BAR; PG8_WAIT_L(0); PG8_MMA(0, 0, At, B0); PG8_BAR; PG8_SCHED;
            PG8_LDB(B1, 1, 1); PG8_STAGE(PG8_SB(1, 0), b3, voffB);
            PG8_BAR; PG8_WAIT_L(0); PG8_MMA(0, 1, At, B1); PG8_BAR;
            PG8_LDA(At, 1, 1); PG8_STAGE(PG8_SA(1, 0), a3, voffA);
            PG8_BAR; PG8_WAIT_L(0); PG8_MMA(1, 0, At, B0); PG8_BAR; PG8_SCHED;
            PG8_STAGE(PG8_SB(1, 1), b3 + hstep, voffB);
            PG8_WAIT_V(6); PG8_BAR; PG8_MMA(1, 1, At, B1); PG8_BAR;
            }
        }
        if constexpr (ALIGN_EPI) { if (wr == 0) PG8_BAR; }
        if constexpr (!Epi::AFTER_DRAIN) { E(acc, cur, wr, wc, fr, fq); S.done(cur); }
        if (!has_next) break;
#pragma unroll
        for (int a = 0; a < 2; ++a)
#pragma unroll
            for (int b = 0; b < 2; ++b)
#pragma unroll
                for (int m = 0; m < 4; ++m)
#pragma unroll
                    for (int n = 0; n < 2; ++n) acc[a][b][m][n] = (f32x4){0.f, 0.f, 0.f, 0.f};
        cur = nxt; cA = nA; cB = nB; ++ui;
        if constexpr (ALIGN_EPI) { if (wr == 1) PG8_BAR; }
    }
    PG8_WAIT_V(0);
    if constexpr (!ALIGN_EPI) { if (wr == 0) PG8_BAR; }
    PG8_BAR;
#undef PG8_SA
#undef PG8_SB
#undef PG8_STAGE
#undef PG8_LDA
#undef PG8_LDB
#undef PG8_MMA
#undef PG8_WAIT_V
#undef PG8_WAIT_L
#undef PG8_BAR
#undef PG8_SCHED
}
}

constexpr int NWAVES = 8;
constexpr int N_LAUNCHES = MK_N_LAUNCHES;
constexpr int PER_PHASE = 10;
constexpr int BATCH = 16, SEQ = 2048, D = 1024, M = BATCH * SEQ;
constexpr int NH = 8, HD = 64, AW = 512, RW = 512;
constexpr int RWKV_COLS = 1792, IN_COLS = 3328, FF = 2816, NGU = 2 * FF, NLORA = 1536, KLORA = 256;
constexpr int PC_Q = 0, PC_K = 512, PC_V = 1024, PC_RW = 1536;
constexpr int RC_R = 0, RC_K = 512, RC_V = 1024, RC_L = 1536;
constexpr float NORM_EPS = 1e-6f, LNX_EPS = 64e-5f;
constexpr float LOG2E = 1.4426950408889634f;

constexpr size_t MiB = 1u << 20;
constexpr size_t WS_CTL = 0, CTL_ZERO_BYTES = 1 * MiB;
constexpr size_t WS_WIN = 2 * MiB;
constexpr size_t WS_WOUT = 9 * MiB;
constexpr size_t WS_WGU = 11 * MiB;
constexpr size_t WS_WDN = 22 * MiB;
constexpr size_t WS_WL = 28 * MiB;
constexpr size_t WS_BON = 29 * MiB;
constexpr size_t WS_SS = 30 * MiB;
constexpr size_t WS_XN = 32 * MiB;
constexpr size_t WS_PROJ = 96 * MiB;
constexpr size_t WS_A2 = 304 * MiB;
constexpr size_t WS_DAG = 320 * MiB;
constexpr size_t WS_ML = 416 * MiB;
constexpr size_t WS_END = 424 * MiB;
constexpr size_t DO_PO = 0, DO_Y = 96 * MiB;
constexpr int CW_TMO = 0, CW_CODE = 1;
constexpr int CW_BAR = 4096;
constexpr int CW_ATTQ = 8192;

constexpr int LDS_BYTES = 163840;
constexpr int RING_OFF = 0, RING_BYTES = LDS_BYTES - 1024;
constexpr int LDSCTL_OFF = RING_BYTES, MISC_OFF = LDSCTL_OFF + 320;

#define GAS __attribute__((address_space(1)))
#define LAS __attribute__((address_space(3)))
typedef unsigned short bf16;
typedef unsigned v4u __attribute__((ext_vector_type(4)));
typedef unsigned v2u __attribute__((ext_vector_type(2)));
typedef float f32x4 __attribute__((ext_vector_type(4)));
typedef float f32x2 __attribute__((ext_vector_type(2)));
typedef float f32x16 __attribute__((ext_vector_type(16)));
typedef short bf16x8 __attribute__((ext_vector_type(8)));
typedef short s16x4 __attribute__((ext_vector_type(4)));
typedef GAS unsigned gu32;
#define RLX_AGENT __ATOMIC_RELAXED, __HIP_MEMORY_SCOPE_AGENT
#define LDS_WAIT() asm volatile("s_waitcnt lgkmcnt(0)" ::: "memory")
#define VM_WAIT() asm volatile("s_waitcnt vmcnt(0)" ::: "memory")
__device__ __forceinline__ unsigned f2bf(float f) { unsigned u = __builtin_bit_cast(unsigned, f); return (u + 0x7fffu + ((u >> 16) & 1u)) >> 16; }
typedef float f32x2_t __attribute__((ext_vector_type(2))); typedef __bf16 bf16x2_t __attribute__((ext_vector_type(2)));
__device__ __forceinline__ unsigned cvt2(float lo, float hi) { f32x2_t v = {lo, hi}; bf16x2_t b = __builtin_convertvector(v, bf16x2_t); return __builtin_bit_cast(unsigned, b); }
__device__ __forceinline__ unsigned pk2(float lo, float hi) { return cvt2(lo, hi); }
__device__ __forceinline__ float bflo(unsigned w) { return __builtin_bit_cast(float, w << 16); }
__device__ __forceinline__ float bfhi(unsigned w) { return __builtin_bit_cast(float, w & 0xffff0000u); }
__device__ __forceinline__ float fsig(float x) { return __builtin_amdgcn_rcpf(1.0f + __builtin_amdgcn_exp2f(-LOG2E * x)); }

#define XB_TMO      128
#define XB_XCNT(j)  (256  + 64 * (j))
#define XB_XSUB(j)  (1280 + 64 * (j))
#define XB_XGEN(j)  (2304 + 64 * (j))
#define XB_TOP      3328
#define XB_TOPGEN   3392
#define XCD_BAR_WORDS 3456
#define XB_SPIN_CAP (1u << 18)
__device__ __forceinline__ unsigned xb_ld(unsigned* p)              { return __hip_atomic_load(p, __ATOMIC_RELAXED, __HIP_MEMORY_SCOPE_AGENT); }
__device__ __forceinline__ unsigned xb_add(unsigned* p, unsigned v) { return __hip_atomic_fetch_add(p, v, __ATOMIC_RELAXED, __HIP_MEMORY_SCOPE_AGENT); }
__device__ __forceinline__ unsigned xb_xcc_id() { return (unsigned)__builtin_amdgcn_s_getreg((3 << 11) | 20) & 0xFu; }
#define XB_SPIN(cond, bar) do { unsigned _sp = 0; while (cond) { __builtin_amdgcn_s_sleep(1); \
    if ((++_sp & 255u) == 0u) { if (xb_ld(&(bar)[XB_TMO])) break; if (_sp > XB_SPIN_CAP) { atomicAdd(&(bar)[XB_TMO], 1u); break; } } } } while (0)
struct XcdBarrier { unsigned* bar; unsigned x; volatile LAS unsigned* st; };
__device__ __forceinline__ XcdBarrier xcd_barrier_post(unsigned* bar, volatile LAS unsigned* st) {
    XcdBarrier b; b.bar = bar; b.x = xb_xcc_id(); b.st = st;
    if (threadIdx.x == 0) (void)xb_add(&bar[XB_XCNT(b.x)], 1u);
    return b;
}
__device__ __forceinline__ void xcd_barrier_complete(unsigned* bar, unsigned x, unsigned& nloc, unsigned& nx) {
    const unsigned G = gridDim.x * gridDim.y * gridDim.z;
    unsigned sum, cnt, mine, sp = 0u;
    for (;;) {
        sum = 0u; cnt = 0u; mine = 0u;
#pragma unroll
        for (unsigned j = 0; j < 16; ++j) { const unsigned c = xb_ld(&bar[XB_XCNT(j)]); sum += c; cnt += (c > 0u) ? 1u : 0u; mine = (j == x) ? c : mine; }
        if (sum == G) break;
        __builtin_amdgcn_s_sleep(1);
        if ((++sp & 255u) == 0u) { if (xb_ld(&bar[XB_TMO])) break; if (sp > XB_SPIN_CAP) { atomicAdd(&bar[XB_TMO], 1u); break; } }
    }
    nloc = mine > 0u ? mine : 1u; nx = cnt > 0u ? cnt : 1u;
}
__device__ __forceinline__ void xcd_barrier(const XcdBarrier& b) {
    asm volatile("s_waitcnt vmcnt(0)" ::: "memory");
    __syncthreads();
    if (threadIdx.x == 0) {
        unsigned* bar = b.bar;
        __builtin_amdgcn_s_waitcnt(0);
        unsigned nloc = b.st[0], nx = b.st[1];
        if (nloc == 0u) { xcd_barrier_complete(bar, b.x, nloc, nx); b.st[0] = nloc; b.st[1] = nx; }
        const unsigned old = xb_add(&bar[XB_XSUB(b.x)], 1u);
        const unsigned gen = old / nloc;
        if (old + 1u == (gen + 1u) * nloc) {
            __builtin_amdgcn_fence(__ATOMIC_RELEASE, "agent");
            asm volatile("s_waitcnt vmcnt(0)" ::: "memory");
            const unsigned og = xb_add(&bar[XB_TOP], 1u);
            const unsigned tg = og / nx;
            if (og + 1u == (tg + 1u) * nx) xb_add(&bar[XB_TOPGEN], 1u);
            else XB_SPIN(xb_ld(&bar[XB_TOPGEN]) == tg, bar);
            __builtin_amdgcn_fence(__ATOMIC_ACQUIRE, "agent");
            xb_add(&bar[XB_XGEN(b.x)], 1u);
            asm volatile("s_waitcnt vmcnt(0)" ::: "memory");
        } else {
            XB_SPIN(xb_ld(&bar[XB_XGEN(b.x)]) == gen, bar);
            __builtin_amdgcn_fence(__ATOMIC_ACQUIRE, "agent");
            asm volatile("s_waitcnt vmcnt(0)" ::: "memory");
        }
    }
    __syncthreads();
}

struct Frame {
    LAS unsigned char* lds;
    volatile LAS unsigned* MISC;
    gu32* ctl;
    int tid, lane, wave;
    int vcu, G;
    float* out; unsigned char* ws;
};
struct Args { const float* in[22]; float* out; unsigned char* ws; int ph_lo, ph_hi, li, pad; };
enum { I_X = 0, I_N1G, I_WIN, I_QNG, I_KNG, I_AOG, I_MU, I_W0, I_W2, I_A0, I_A2, I_G2, I_KK, I_KA, I_RK, I_LNG, I_LNB, I_WOUT, I_N2G, I_WG, I_WU, I_WD };

__device__ __forceinline__ float wave_sum(float v) {
#pragma unroll
    for (int o = 1; o < 64; o <<= 1) v += __shfl_xor(v, o);
    return v;
}
__device__ __forceinline__ float red16(float x) {
    x += __builtin_bit_cast(float, __builtin_amdgcn_update_dpp(0, __builtin_bit_cast(int, x), 0x128, 0xf, 0xf, false));
    x += __builtin_bit_cast(float, __builtin_amdgcn_update_dpp(0, __builtin_bit_cast(int, x), 0x124, 0xf, 0xf, false));
    x += __builtin_bit_cast(float, __builtin_amdgcn_update_dpp(0, __builtin_bit_cast(int, x), 0x122, 0xf, 0xf, false));
    x += __builtin_bit_cast(float, __builtin_amdgcn_update_dpp(0, __builtin_bit_cast(int, x), 0x121, 0xf, 0xf, false));
    return x;
}

__device__ __forceinline__ void p0_transpose_item(const float* W, int K, int N, bf16* WT, int rmode, LAS float* scr, int item, int lane, const float* ksc = nullptr) {
    const int nblk = N / 32, kb = item / nblk, nb = item % nblk, k0 = 64 * kb, n0 = 32 * nb;
    const int rbase = rmode == 0 ? n0 : rmode == 3 ? (n0 < 1024 ? ((n0 >> 8) * 256 + ((n0 >> 5) & 1) * 128 + ((n0 >> 6) & 3) * 32) : n0) : ((n0 >> 7) * 256 + (n0 & 127) + (rmode == 2 ? 128 : 0));
#pragma unroll 8
    for (int i = 0; i < 32; ++i) { const int kk = 2 * i + (lane >> 5); scr[kk * 33 + (lane & 31)] = W[(size_t)(k0 + kk) * N + n0 + (lane & 31)] * (ksc ? ksc[k0 + kk] : 1.0f); }
    LDS_WAIT(); asm volatile("" ::: "memory");
    const int c = lane & 7;
#pragma unroll
    for (int j = 0; j < 4; ++j) { const int n = (lane >> 3) + 8 * j; const LAS float* s = scr + (8 * c) * 33 + n;
        v4u o; o.x = pk2(s[0 * 33], s[1 * 33]); o.y = pk2(s[2 * 33], s[3 * 33]); o.z = pk2(s[4 * 33], s[5 * 33]); o.w = pk2(s[6 * 33], s[7 * 33]);
        *(GAS v4u*)(WT + (size_t)(rbase + n) * K + k0 + 8 * c) = o; }
    LDS_WAIT(); asm volatile("" ::: "memory");
}
template <int NR> __device__ __forceinline__ void rms_rows_to_bf16(int lane, const float* x0, size_t rstride, const float* g, bf16* o0, size_t ostride) {
    const GAS f32x4* gr = (const GAS f32x4*)g + lane;
    f32x4 v[NR][4];
#pragma unroll
    for (int r = 0; r < NR; ++r) { const GAS f32x4* xr = (const GAS f32x4*)(x0 + r * rstride) + lane;
#pragma unroll
        for (int j = 0; j < 4; ++j) v[r][j] = xr[64 * j]; }
    f32x4 gg[4];
#pragma unroll
    for (int j = 0; j < 4; ++j) gg[j] = gr[64 * j];
#pragma unroll
    for (int r = 0; r < NR; ++r) { float s = 0.f;
#pragma unroll
        for (int j = 0; j < 4; ++j) s += (v[r][j].x * v[r][j].x + v[r][j].y * v[r][j].y) + (v[r][j].z * v[r][j].z + v[r][j].w * v[r][j].w);
        const float rstd = 1.f / sqrtf(wave_sum(s) * (1.f / D) + NORM_EPS);
        GAS unsigned long long* o8 = (GAS unsigned long long*)(o0 + r * ostride) + lane;
#pragma unroll
        for (int j = 0; j < 4; ++j)
            o8[64 * j] = (unsigned long long)pk2(v[r][j].x * rstd * gg[j].x, v[r][j].y * rstd * gg[j].y) | ((unsigned long long)pk2(v[r][j].z * rstd * gg[j].z, v[r][j].w * rstd * gg[j].w) << 32); }
}

__device__ __forceinline__ void p0_prologue(Frame& F, const Args& AR) {
    LAS float* scr = (LAS float*)(F.lds + RING_OFF + F.wave * 16384);
    const int gw = F.vcu * NWAVES + F.wave, NGW = F.G * NWAVES;
    bf16* Win_t = (bf16*)(F.ws + WS_WIN); bf16* Wout_t = (bf16*)(F.ws + WS_WOUT); bf16* Wgu_t = (bf16*)(F.ws + WS_WGU); bf16* Wdn_t = (bf16*)(F.ws + WS_WDN); bf16* Wl_t = (bf16*)(F.ws + WS_WL);
    constexpr int I_IN = (D / 64) * (IN_COLS / 32), I_OUT = (D / 64) * (D / 32), I_G = (D / 64) * (FF / 32), I_DN = (FF / 64) * (D / 32);
    constexpr int NITEMS = I_IN + I_OUT + 2 * I_G + I_DN;
    for (int it = gw; it < NITEMS; it += NGW) {
        int r = it;
        if (r < I_IN) { p0_transpose_item(AR.in[I_WIN], D, IN_COLS, Win_t, 3, scr, r, F.lane); continue; } r -= I_IN;
        if (r < I_OUT) { p0_transpose_item(AR.in[I_WOUT], D, D, Wout_t, 0, scr, r, F.lane); continue; } r -= I_OUT;
        if (r < I_G) { p0_transpose_item(AR.in[I_WG], D, FF, Wgu_t, 1, scr, r, F.lane, AR.in[I_N2G]); continue; } r -= I_G;
        if (r < I_G) { p0_transpose_item(AR.in[I_WU], D, FF, Wgu_t, 2, scr, r, F.lane, AR.in[I_N2G]); continue; } r -= I_G;
        p0_transpose_item(AR.in[I_WD], FF, D, Wdn_t, 0, scr, r, F.lane);
    }
    for (int e = (F.vcu * NWAVES * 64 + F.tid); e < NLORA * KLORA; e += F.G * NWAVES * 64) {
        const int row = e / KLORA, k = e % KLORA, kind = row >> 9, c = row & 511; float v = 0.f;
        if (kind == 0) { if (k < 64) v = AR.in[I_W2][k * 512 + c]; }
        else if (kind == 1) { if (k >= 64 && k < 128) v = AR.in[I_A2][(k - 64) * 512 + c]; }
        else { if (k >= 128) v = AR.in[I_G2][(k - 128) * 512 + c]; }
        Wl_t[e] = (bf16)f2bf(v);
    }
    bf16* XN = (bf16*)(F.ws + WS_XN);
    for (int m = gw * 4; m < M; m += NGW * 4) rms_rows_to_bf16<4>(F.lane, AR.in[I_X] + (size_t)m * D, D, AR.in[I_N1G], XN + (size_t)m * D, D);
}

__device__ __forceinline__ void p2_prep(Frame& F, const Args& AR) {
    const int gw = F.vcu * NWAVES + F.wave, NGW = F.G * NWAVES, lane = F.lane;
    const bf16* PROJ = (const bf16*)(F.ws + WS_PROJ); bf16* A2 = (bf16*)(F.ws + WS_A2);
    const f32x4 mu4 = *(const f32x4*)(AR.in[I_MU] + RC_L + 4 * lane);
    for (int m0 = 4 * gw; m0 < M; m0 += 4 * NGW) {
        const GAS bf16* row = (const GAS bf16*)PROJ + (size_t)m0 * IN_COLS + PC_RW + RC_L + 4 * lane;
        v2u w[5];
        w[0] = (v2u){0u, 0u};
        if ((m0 & (SEQ - 1)) != 0) w[0] = *(const GAS v2u*)(row - IN_COLS);
#pragma unroll
        for (int i = 0; i < 4; ++i) w[i + 1] = *(const GAS v2u*)(row + (size_t)i * IN_COLS);
#pragma unroll
        for (int i = 0; i < 4; ++i) {
            const v2u cu = w[i + 1], pv = w[i];
            const float c4[4] = {bflo(cu.x), bfhi(cu.x), bflo(cu.y), bfhi(cu.y)}, p4[4] = {bflo(pv.x), bfhi(pv.x), bflo(pv.y), bfhi(pv.y)};
            float xs[4];
#pragma unroll
            for (int e = 0; e < 4; ++e) { const float v = c4[e] + (p4[e] - c4[e]) * mu4[e];
                if (lane < 16) { const float t = __builtin_amdgcn_exp2f(2.f * LOG2E * v); xs[e] = 1.f - 2.f * __builtin_amdgcn_rcpf(t + 1.f); }
                else if (lane < 32) xs[e] = v;
                else xs[e] = fsig(v); }
            *(GAS v2u*)(A2 + (size_t)(m0 + i) * KLORA + 4 * lane) = (v2u){pk2(xs[0], xs[1]), pk2(xs[2], xs[3])};
        }
    }
}

constexpr int CS = 16, NCHUNK = SEQ / CS, NHELP = 4, NSTATE = 4, NIT = (NCHUNK + NHELP - 1) / NHELP;
constexpr int ROWB = 144, TILEB = 40;
constexpr int SL_A = 0, SL_R = 16 * ROWB, SL_B = 32 * ROWB, SL_K = 48 * ROWB, SL_V = 64 * ROWB, SL_T = 80 * ROWB, SL_LAK = SL_T + 16 * TILEB, SL_LRB = SL_LAK + 16 * TILEB, SL_LRK = SL_LRB + 16 * TILEB,
              SL_G = SL_LRK + 16 * TILEB, SL_BON = SL_G + 256, SL_INV = SL_BON + 64, SL_BYTES = SL_INV + 64;
static_assert(SL_BYTES % 16 == 0 && SL_T % 8 == 0, "slot alignment");
constexpr int SC_CONST = 2 * NHELP * SL_BYTES;
constexpr int SC_YL = SC_CONST + 6 * 64 * 4, YL_BYTES = NHELP * CS * 256;
constexpr int SC_TS = SC_YL + 2 * YL_BYTES;
static_assert(SC_TS + NSTATE * NHELP * 16 * TILEB <= RING_BYTES && NHELP * CS * 8 == 2 * NSTATE * 64 && NCHUNK % NHELP == 0 && NHELP % 2 == 0, "scan LDS");
struct HReg { v4u r[2], k[2], v[2], pr[2], pk[2], pv[2], e[2], a[2]; };
__device__ __forceinline__ void helper_load(HReg& R, const bf16* PROJ, const bf16* DAG, int tok, int h, int kg) {
    const GAS bf16* row = (const GAS bf16*)PROJ + (size_t)tok * IN_COLS + PC_RW + h * 64 + 16 * kg;
    const GAS bf16* rowp = row - IN_COLS;
    const GAS bf16* dr = (const GAS bf16*)DAG + (size_t)tok * NLORA + h * 64 + 16 * kg;
    asm volatile("" : "+v"(row)); asm volatile("" : "+v"(rowp)); asm volatile("" : "+v"(dr));
    const bool hp = (tok & (SEQ - 1)) != 0;
#pragma unroll
    for (int i = 0; i < 2; ++i) {
        R.r[i] = *(const GAS v4u*)(row + RC_R + 8 * i); R.k[i] = *(const GAS v4u*)(row + RC_K + 8 * i); R.v[i] = *(const GAS v4u*)(row + RC_V + 8 * i);
        if (hp) { R.pr[i] = *(const GAS v4u*)(rowp + RC_R + 8 * i); R.pk[i] = *(const GAS v4u*)(rowp + RC_K + 8 * i); R.pv[i] = *(const GAS v4u*)(rowp + RC_V + 8 * i); }
        else { R.pr[i] = (v4u){0u, 0u, 0u, 0u}; R.pk[i] = R.pr[i]; R.pv[i] = R.pr[i]; }
        R.e[i] = *(const GAS v4u*)(dr + 8 * i); R.a[i] = *(const GAS v4u*)(dr + 512 + 8 * i);
    }
}
__device__ __forceinline__ void unpack4(const unsigned w0, const unsigned w1, float (&x)[4]) { x[0] = bflo(w0); x[1] = bfhi(w0); x[2] = bflo(w1); x[3] = bfhi(w1); }
__device__ __forceinline__ float dpp_shr(float x, const int ctrl_sel) {
    int r;
    if (ctrl_sel == 1) r = __builtin_amdgcn_update_dpp(0, __builtin_bit_cast(int, x), 0x111, 0xf, 0xf, true);
    else if (ctrl_sel == 2) r = __builtin_amdgcn_update_dpp(0, __builtin_bit_cast(int, x), 0x112, 0xf, 0xf, true);
    else if (ctrl_sel == 4) r = __builtin_amdgcn_update_dpp(0, __builtin_bit_cast(int, x), 0x114, 0xf, 0xf, true);
    else r = __builtin_amdgcn_update_dpp(0, __builtin_bit_cast(int, x), 0x118, 0xf, 0xf, true);
    return __builtin_bit_cast(float, r);
}
__device__ __forceinline__ unsigned cvt2s(float lo, float hi) { asm volatile("" : "+v"(lo), "+v"(hi)); return cvt2(lo, hi); }
__device__ __forceinline__ bf16x8 mk8(unsigned a, unsigned b, unsigned c, unsigned d) { return __builtin_bit_cast(bf16x8, (v4u){a, b, c, d}); }
__device__ __forceinline__ bf16x8 accB(const f32x4 v) { return mk8(cvt2(v[0], v[1]), cvt2(v[2], v[3]), 0u, 0u); }
__device__ __forceinline__ v2u trd(const LAS unsigned char* p) { typedef short v4i16_t __attribute__((ext_vector_type(4)));
    return __builtin_bit_cast(v2u, __builtin_amdgcn_ds_read_tr16_b64_v4i16((LAS v4i16_t*)p)); }
#define MFMA16(a, b, c) __builtin_amdgcn_mfma_f32_16x16x32_bf16((a), (b), (c), 0, 0, 0)
#define PIN_PTR(p) asm volatile("" : "+v"(p))

#define HR_UNPACK(dst, arr, gp) do { if ((gp) & 1) unpack4(R.arr[(gp) >> 1].z, R.arr[(gp) >> 1].w, dst); else unpack4(R.arr[(gp) >> 1].x, R.arr[(gp) >> 1].y, dst); } while (0)
__device__ __forceinline__ void helper_chunk(LAS unsigned char* slot, const LAS float* cst, HReg& R, bool prefetch, const bf16* PROJ, const bf16* DAG, float* BON, int tok, int h, int lane) {
    const int t = lane & 15, kg = lane >> 4;
    LAS unsigned char* p_row = slot + t * ROWB + kg * 16;
    LAS unsigned char* p_v = slot + SL_V + t * ROWB + kg * 32;
    LAS unsigned char* p_tw = slot + t * TILEB + kg * 8;
    LAS unsigned char* p_g = slot + SL_G + kg * 16;
    const LAS float* p_c = cst + 16 * kg;
    PIN_PTR(p_row); PIN_PTR(p_v); PIN_PTR(p_tw); PIN_PTR(p_g); PIN_PTR(p_c);
    float E[16], G[16], GI[16], GP[16];
#pragma unroll
    for (int gp = 0; gp < 4; ++gp) { float e[4]; HR_UNPACK(e, e, gp);
#pragma unroll
        for (int i = 0; i < 4; ++i) E[4 * gp + i] = e[i]; }
#pragma unroll
    for (int q = 0; q < 16; ++q) E[q] += dpp_shr(E[q], 1);
#pragma unroll
    for (int q = 0; q < 16; ++q) E[q] += dpp_shr(E[q], 2);
#pragma unroll
    for (int q = 0; q < 16; ++q) E[q] += dpp_shr(E[q], 4);
#pragma unroll
    for (int q = 0; q < 16; ++q) E[q] += dpp_shr(E[q], 8);
#pragma unroll
    for (int q = 0; q < 16; ++q) { G[q] = __builtin_amdgcn_exp2f(LOG2E * E[q]); GI[q] = __builtin_amdgcn_exp2f(-LOG2E * E[q]); }
#pragma unroll
    for (int q = 0; q < 16; ++q) { const float gpv = dpp_shr(G[q], 1); GP[q] = (t == 0) ? 1.f : gpv; }
    if (t == 15) {
#pragma unroll
        for (int gp = 0; gp < 4; ++gp) *(LAS f32x4*)(p_g + gp * 64) = (f32x4){G[4 * gp], G[4 * gp + 1], G[4 * gp + 2], G[4 * gp + 3]};
    }
    float ss = 0.f, bon = 0.f;
#pragma unroll
    for (int gp = 0; gp < 4; ++gp) {
        float r[4], k[4], v[4], pr[4], pk[4], pv[4], a[4];
        HR_UNPACK(r, r, gp); HR_UNPACK(k, k, gp); HR_UNPACK(v, v, gp); HR_UNPACK(pr, pr, gp); HR_UNPACK(pk, pk, gp); HR_UNPACK(pv, pv, gp); HR_UNPACK(a, a, gp);
        const f32x4 mur = *(const LAS f32x4*)(p_c + 0 * 64 + 4 * gp), muk = *(const LAS f32x4*)(p_c + 1 * 64 + 4 * gp), muv = *(const LAS f32x4*)(p_c + 2 * 64 + 4 * gp);
        const f32x4 kkc = *(const LAS f32x4*)(p_c + 3 * 64 + 4 * gp), kac = *(const LAS f32x4*)(p_c + 4 * 64 + 4 * gp), rkc = *(const LAS f32x4*)(p_c + 5 * 64 + 4 * gp);
        float xv[4], At[4], Rt[4], Bt[4], Kt[4];
#pragma unroll
        for (int i = 0; i < 4; ++i) { const int q = 4 * gp + i;
            const float xr = r[i] + (pr[i] - r[i]) * mur[i], xk = k[i] + (pk[i] - k[i]) * muk[i]; xv[i] = v[i] + (pv[i] - v[i]) * muv[i];
            const float kkv = xk * kkc[i], kpv = xk * (1.f + (a[i] - 1.f) * kac[i]); ss += kkv * kkv; bon += xr * kpv * rkc[i];
            At[i] = -kkv * GP[q]; Rt[i] = xr * G[q]; Bt[i] = kkv * a[i] * GI[q]; Kt[i] = kpv * GI[q]; }
        *(LAS v2u*)(p_v + gp * 8) = (v2u){cvt2s(xv[0], xv[1]), cvt2s(xv[2], xv[3])};
        const int co = (gp >> 1) * 64 + (gp & 1) * 8;
        *(LAS v2u*)(p_row + SL_A + co) = (v2u){cvt2s(At[0], At[1]), cvt2s(At[2], At[3])}; *(LAS v2u*)(p_row + SL_R + co) = (v2u){cvt2s(Rt[0], Rt[1]), cvt2s(Rt[2], Rt[3])};
        *(LAS v2u*)(p_row + SL_B + co) = (v2u){cvt2s(Bt[0], Bt[1]), cvt2s(Bt[2], Bt[3])}; *(LAS v2u*)(p_row + SL_K + co) = (v2u){cvt2s(Kt[0], Kt[1]), cvt2s(Kt[2], Kt[3])};
    }
    ss += __shfl_xor(ss, 16); bon += __shfl_xor(bon, 16); ss += __shfl_xor(ss, 32); bon += __shfl_xor(bon, 32);
    const float inv = __builtin_amdgcn_rsqf(fmaxf(ss, 1e-24f));
    if (kg == 0) { *(LAS float*)(slot + SL_BON + t * 4) = bon; *(LAS float*)(slot + SL_INV + t * 4) = inv; }
    if (prefetch) helper_load(R, PROJ, DAG, tok + NHELP * CS, h, kg);
    const bf16x8 FA0 = *(const LAS bf16x8*)(p_row + SL_A), FA1 = *(const LAS bf16x8*)(p_row + SL_A + 64), FR0 = *(const LAS bf16x8*)(p_row + SL_R), FR1 = *(const LAS bf16x8*)(p_row + SL_R + 64);
    const bf16x8 FB0 = *(const LAS bf16x8*)(p_row + SL_B), FB1 = *(const LAS bf16x8*)(p_row + SL_B + 64), FK0 = *(const LAS bf16x8*)(p_row + SL_K), FK1 = *(const LAS bf16x8*)(p_row + SL_K + 64);
    const f32x4 z4 = (f32x4){0.f, 0.f, 0.f, 0.f};
    f32x4 Lab = MFMA16(FA0, FB0, z4); Lab = MFMA16(FA1, FB1, Lab);
    f32x4 Lak = MFMA16(FA0, FK0, z4); Lak = MFMA16(FA1, FK1, Lak);
    f32x4 Lrb = MFMA16(FR0, FB0, z4); Lrb = MFMA16(FR1, FB1, Lrb);
    f32x4 Lrk = MFMA16(FR0, FK0, z4); Lrk = MFMA16(FR1, FK1, Lrk);
    const int s = t;
#pragma unroll
    for (int r = 0; r < 4; ++r) { const int tt = 4 * kg + r;
        Lab[r] = tt > s ? Lab[r] : 0.f; Lak[r] = tt > s ? Lak[r] : 0.f; Lrb[r] = tt >= s ? Lrb[r] : 0.f; Lrk[r] = tt >= s ? Lrk[r] : 0.f; }
    { const f32x4 ir = *(const LAS f32x4*)(slot + SL_INV + 16 * kg);
      Lab = Lab * ir * inv; }
#define WR_TILE(off, X) (*(LAS v2u*)(p_tw + (off)) = (v2u){cvt2((X)[0], (X)[1]), cvt2((X)[2], (X)[3])})
    WR_TILE(SL_LAK, Lak); WR_TILE(SL_LRB, Lrb); WR_TILE(SL_LRK, Lrk); WR_TILE(SL_T, Lab);
#undef WR_TILE
}

struct SOps { bf16x8 a0, a1, r0, r1; v2u vt, lak, lrb, lrk, bb[4], kk2[4]; f32x4 gm[4], bn, iv; };
__device__ __forceinline__ void state_load(SOps& O, const LAS unsigned char* slot, int lane, int wv) {
    const int c = lane & 15, g = lane >> 4, q4 = 4 * g + (c >> 2), pp = c & 3;
    const LAS unsigned char* p128 = slot + c * ROWB + g * 16;
    const LAS unsigned char* p_bt = slot + q4 * ROWB + pp * 16;
    const LAS unsigned char* p_tr = slot + q4 * TILEB + pp * 8;
    const LAS unsigned char* p_v = slot + SL_V + q4 * ROWB + wv * 32 + pp * 8;
    const LAS unsigned char* pg = slot + SL_G + g * 16;
    PIN_PTR(p128); PIN_PTR(p_bt); PIN_PTR(p_tr); PIN_PTR(p_v); PIN_PTR(pg);
    O.a0 = *(const LAS bf16x8*)(p128 + SL_A); O.a1 = *(const LAS bf16x8*)(p128 + SL_A + 64); O.r0 = *(const LAS bf16x8*)(p128 + SL_R); O.r1 = *(const LAS bf16x8*)(p128 + SL_R + 64);
    O.vt = trd(p_v); O.lak = trd(p_tr + SL_LAK); O.lrb = trd(p_tr + SL_LRB); O.lrk = trd(p_tr + SL_LRK);
#pragma unroll
    for (int jb = 0; jb < 4; ++jb) { O.bb[jb] = trd(p_bt + SL_B + (jb >> 1) * 64 + (jb & 1) * 8); O.kk2[jb] = trd(p_bt + SL_K + (jb >> 1) * 64 + (jb & 1) * 8); O.gm[jb] = *(const LAS f32x4*)(pg + jb * 64); }
    O.bn = *(const LAS f32x4*)(slot + SL_BON + 16 * g); O.iv = *(const LAS f32x4*)(slot + SL_INV + 16 * g);
}
__device__ __forceinline__ void state_compute(const SOps& O, const v2u tt, f32x4 (&X)[4], LAS unsigned char* yl, int lane, int wv) {
    const int c = lane & 15, g = lane >> 4;
    const f32x4 z4 = (f32x4){0.f, 0.f, 0.f, 0.f};
    const bf16x8 xb0 = mk8(cvt2(X[0][0], X[0][1]), cvt2(X[0][2], X[0][3]), cvt2(X[1][0], X[1][1]), cvt2(X[1][2], X[1][3]));
    const bf16x8 xb1 = mk8(cvt2(X[2][0], X[2][1]), cvt2(X[2][2], X[2][3]), cvt2(X[3][0], X[3][1]), cvt2(X[3][2], X[3][3]));
    f32x4 Z = MFMA16(O.a0, xb0, z4); Z = MFMA16(O.a1, xb1, Z); Z = MFMA16(mk8(O.lak.x, O.lak.y, 0u, 0u), mk8(O.vt.x, O.vt.y, 0u, 0u), Z) * O.iv;
    const f32x4 U = MFMA16(mk8(tt.x, tt.y, 0u, 0u), accB(Z), z4) * O.iv;
    const bf16x8 uv = mk8(cvt2(U[0], U[1]), cvt2(U[2], U[3]), O.vt.x, O.vt.y);
    f32x4 Y = MFMA16(O.r0, xb0, z4); Y = MFMA16(O.r1, xb1, Y); Y = MFMA16(mk8(O.lrb.x, O.lrb.y, O.lrk.x, O.lrk.y), uv, Y);
#pragma unroll
    for (int jb = 0; jb < 4; ++jb) X[jb] = MFMA16(mk8(O.bb[jb].x, O.bb[jb].y, O.kk2[jb].x, O.kk2[jb].y), uv, X[jb]) * O.gm[jb];
    LAS unsigned char* py = yl + (4 * g) * 256 + (16 * wv + c) * 2;
    PIN_PTR(py);
    const float vv[4] = {bflo(O.vt.x), bfhi(O.vt.x), bflo(O.vt.y), bfhi(O.vt.y)};
#pragma unroll
    for (int r = 0; r < 4; ++r) { *(LAS unsigned short*)(py + r * 256) = (unsigned short)f2bf(Y[r]); *(LAS unsigned short*)(py + r * 256 + 128) = (unsigned short)f2bf(O.bn[r] * vv[r]); }
}
__device__ __forceinline__ void state_T(v2u (&tt)[NHELP], const LAS unsigned char* set0, LAS unsigned char* scr, int lane) {
    const int c = lane & 15, g = lane >> 4;
    const int o_w = c * TILEB + g * 8, o_r = (4 * g + (c >> 2)) * TILEB + (c & 3) * 8;
    const f32x4 z4 = (f32x4){0.f, 0.f, 0.f, 0.f};
    bf16x8 A1[NHELP], A2[NHELP], A4[NHELP]; f32x4 P[NHELP];
#pragma unroll
    for (int k = 0; k < NHELP; ++k) { const LAS unsigned char* tl = set0 + k * SL_BYTES + SL_T;
        const v2u bl = *(const LAS v2u*)(tl + o_w), al = trd(tl + o_r); A1[k] = mk8(al.x, al.y, 0u, 0u); P[k] = MFMA16(A1[k], mk8(bl.x, bl.y, 0u, 0u), z4); }
#pragma unroll
    for (int k = 0; k < NHELP; ++k) *(LAS v2u*)(scr + k * (16 * TILEB) + o_w) = (v2u){cvt2(P[k][0], P[k][1]), cvt2(P[k][2], P[k][3])};
#pragma unroll
    for (int k = 0; k < NHELP; ++k) { const v2u al = trd(scr + k * (16 * TILEB) + o_r); A2[k] = mk8(al.x, al.y, 0u, 0u); P[k] = MFMA16(A2[k], accB(P[k]), z4); }
#pragma unroll
    for (int k = 0; k < NHELP; ++k) *(LAS v2u*)(scr + k * (16 * TILEB) + o_w) = (v2u){cvt2(P[k][0], P[k][1]), cvt2(P[k][2], P[k][3])};
#pragma unroll
    for (int k = 0; k < NHELP; ++k) { const v2u al = trd(scr + k * (16 * TILEB) + o_r); A4[k] = mk8(al.x, al.y, 0u, 0u); P[k] = MFMA16(A4[k], accB(P[k]), z4); }
#pragma unroll
    for (int k = 0; k < NHELP; ++k) {
#pragma unroll
        for (int r = 0; r < 4; ++r) P[k][r] += (4 * g + r == c) ? 1.f : 0.f; }
#pragma unroll
    for (int k = 0; k < NHELP; ++k) P[k] = MFMA16(A4[k], accB(P[k]), P[k]);
#pragma unroll
    for (int k = 0; k < NHELP; ++k) P[k] = MFMA16(A2[k], accB(P[k]), P[k]);
#pragma unroll
    for (int k = 0; k < NHELP; ++k) P[k] = MFMA16(A1[k], accB(P[k]), P[k]);
#pragma unroll
    for (int k = 0; k < NHELP; ++k) *(LAS v2u*)(scr + k * (16 * TILEB) + o_w) = (v2u){cvt2(P[k][0], P[k][1]), cvt2(P[k][2], P[k][3])};
#pragma unroll
    for (int k = 0; k < NHELP; ++k) tt[k] = trd(scr + k * (16 * TILEB) + o_r);
}

__device__ __forceinline__ void p4_scan(Frame& F, const Args& AR) {
    const bf16* PROJ = (const bf16*)(F.ws + WS_PROJ); const bf16* DAG = (const bf16*)(F.ws + WS_DAG);
    float* BON = nullptr; bf16* MIX = (bf16*)(F.ws + WS_XN);
    LAS unsigned char* lds = F.lds + RING_OFF;
    LAS float* cst = (LAS float*)(lds + SC_CONST);
    const int tid = F.tid, lane = F.lane, wave = F.wave;
    for (int unit = blockIdx.x; unit < BATCH * NH; unit += F.G) {
        const int b = unit >> 3, h = unit & 7;
        const int tok0 = b * SEQ;
        if (tid < 384) { const int a = tid >> 6, c = tid & 63; const float* src = a == 0 ? AR.in[I_MU] + RC_R : a == 1 ? AR.in[I_MU] + RC_K : a == 2 ? AR.in[I_MU] + RC_V : a == 3 ? AR.in[I_KK] : a == 4 ? AR.in[I_KA] : AR.in[I_RK];
            cst[a * 64 + c] = src[h * 64 + c]; }
        __syncthreads();
        const int st_k = (tid >> 7) & 1, st_t = (tid >> 3) & 15, st_p = tid & 7;
        GAS v4u* ystore = (GAS v4u*)((GAS bf16*)MIX + (size_t)(tok0 + st_k * CS + st_t) * D + AW + h * 64 + 8 * st_p);
        const GAS v4u* gload = (const GAS v4u*)((const GAS bf16*)DAG + (size_t)(tok0 + st_k * CS + st_t) * NLORA + 1024 + h * 64 + 8 * st_p);
        const LAS unsigned char* yl_rd = lds + SC_YL + st_k * (CS * 256) + st_t * 256 + st_p * 16;
        v4u gnA = (v4u){0u, 0u, 0u, 0u}, gnB = gnA;
        float lng[8], lnb[8];
#pragma unroll
        for (int i = 0; i < 8; ++i) { lng[i] = AR.in[I_LNG][h * 64 + 8 * st_p + i]; lnb[i] = AR.in[I_LNB][h * 64 + 8 * st_p + i]; }
#define RWKV_OUT(it_, KO, gnext) do { if ((it_) >= 2 && NHELP * ((it_) - 2) + st_k + (KO) < NCHUNK) { \
            const v4u gw4 = gnext; \
            const v4u yw = *(const LAS v4u*)(yl_rd + (KO) * (CS * 256) + ((it_) & 1) * YL_BYTES), bw = *(const LAS v4u*)(yl_rd + (KO) * (CS * 256) + ((it_) & 1) * YL_BYTES + 128); \
            float y[8] = {bflo(yw.x), bfhi(yw.x), bflo(yw.y), bfhi(yw.y), bflo(yw.z), bfhi(yw.z), bflo(yw.w), bfhi(yw.w)}; \
            float sm = ((y[0] + y[1]) + (y[2] + y[3])) + ((y[4] + y[5]) + (y[6] + y[7])); \
            sm += __shfl_xor(sm, 1); sm += __shfl_xor(sm, 2); sm += __shfl_xor(sm, 4); \
            const float mean = sm * (1.f / 64.f); float sv = 0.f; \
            _Pragma("unroll") for (int i = 0; i < 8; ++i) { y[i] -= mean; sv += y[i] * y[i]; } \
            sv += __shfl_xor(sv, 1); sv += __shfl_xor(sv, 2); sv += __shfl_xor(sv, 4); \
            const float rs = 1.f / sqrtf(sv * (1.f / 64.f) + LNX_EPS); \
            const float bf_[8] = {bflo(bw.x), bfhi(bw.x), bflo(bw.y), bfhi(bw.y), bflo(bw.z), bfhi(bw.z), bflo(bw.w), bfhi(bw.w)}; \
            const float gf[8] = {bflo(gw4.x), bfhi(gw4.x), bflo(gw4.y), bfhi(gw4.y), bflo(gw4.z), bfhi(gw4.z), bflo(gw4.w), bfhi(gw4.w)}; \
            float ro[8]; \
            _Pragma("unroll") for (int i = 0; i < 8; ++i) ro[i] = (y[i] * rs * lng[i] + lnb[i] + bf_[i]) * gf[i]; \
            ystore[(size_t)(NHELP * ((it_) - 2) + (KO)) * CS * D / 8] = (v4u){pk2(ro[0], ro[1]), pk2(ro[2], ro[3]), pk2(ro[4], ro[5]), pk2(ro[6], ro[7])}; } \
            if ((it_) >= 1 && NHELP * ((it_) - 1) + st_k + (KO) < NCHUNK) gnext = gload[(size_t)(NHELP * ((it_) - 1) + (KO)) * CS * NLORA / 8]; } while (0)
        if (wave >= NSTATE) {
            const int hw = wave - NSTATE, kg = lane >> 4, tokl = tok0 + (lane & 15);
            HReg R;
            helper_load(R, PROJ, DAG, tokl + hw * CS, h, kg);
            unsigned long long pa_ = 0, pb_ = 0;
            for (int it = 0; it <= NIT + 1; ++it) {
                const unsigned long long q0_ = PROBE_SEL >= 30 ? __builtin_amdgcn_s_memtime() : 0ull;
                const int ch = NHELP * it + hw;
                if (ch < NCHUNK) helper_chunk(lds + ((it & 1) * NHELP + hw) * SL_BYTES, cst, R, ch + NHELP < NCHUNK, PROJ, DAG, BON, tokl + ch * CS, h, lane);
                const unsigned long long q1_ = PROBE_SEL >= 30 ? __builtin_amdgcn_s_memtime() : 0ull;
                __syncthreads();
                if (PROBE_SEL >= 30) { const unsigned long long q2_ = __builtin_amdgcn_s_memtime(); pa_ += q1_ - q0_; pb_ += q2_ - q1_; }
            }
            if (PROBE_SEL >= 30 && blockIdx.x == 0 && tid == NSTATE * 64) { __hip_atomic_store(F.ctl + 9130, (unsigned)(pa_ >> 4), RLX_AGENT); __hip_atomic_store(F.ctl + 9131, (unsigned)(pb_ >> 4), RLX_AGENT); }
        } else {
            f32x4 X[4];
#pragma unroll
            for (int jb = 0; jb < 4; ++jb) X[jb] = (f32x4){0.f, 0.f, 0.f, 0.f};
            unsigned long long pa_ = 0, pb_ = 0;
            for (int it = 0; it <= NIT + 1; ++it) {
                const unsigned long long q0_ = PROBE_SEL >= 30 ? __builtin_amdgcn_s_memtime() : 0ull;
                RWKV_OUT(it, 0, gnA); RWKV_OUT(it, 2, gnB);
                if (it > 0 && NHELP * (it - 1) < NCHUNK) {
                    const LAS unsigned char* set0 = lds + (((it - 1) & 1) * NHELP) * SL_BYTES;
                    LAS unsigned char* ylb = lds + SC_YL + ((it - 1) & 1) * YL_BYTES;
                    v2u tt[NHELP];
                    SOps Oa, Ob;
                    state_load(Oa, set0, lane, wave);
                    state_T(tt, set0, lds + SC_TS + wave * (NHELP * 16 * TILEB), lane);
#pragma unroll
                    for (int k = 0; k < NHELP; k += 2) {
                        state_load(Ob, set0 + (k + 1) * SL_BYTES, lane, wave);
                        state_compute(Oa, tt[k], X, ylb + k * (CS * 256), lane, wave);
                        if (k + 2 < NHELP) state_load(Oa, set0 + (k + 2) * SL_BYTES, lane, wave);
                        state_compute(Ob, tt[k + 1], X, ylb + (k + 1) * (CS * 256), lane, wave);
                    }
                }
                const unsigned long long q1_ = PROBE_SEL >= 30 ? __builtin_amdgcn_s_memtime() : 0ull;
                __syncthreads();
                if (PROBE_SEL >= 30) { const unsigned long long q2_ = __builtin_amdgcn_s_memtime(); pa_ += q1_ - q0_; pb_ += q2_ - q1_; }
            }
            if (PROBE_SEL >= 30 && blockIdx.x == 0 && tid == 0) { __hip_atomic_store(F.ctl + 9132, (unsigned)(pa_ >> 4), RLX_AGENT); __hip_atomic_store(F.ctl + 9133, (unsigned)(pb_ >> 4), RLX_AGENT); }
            __builtin_amdgcn_s_setprio(0);
        }
        __syncthreads();
    }
}

__device__ __forceinline__ s16x4 vtr(const LAS unsigned char* p) { typedef short v4i16_t __attribute__((ext_vector_type(4)));
    return __builtin_bit_cast(s16x4, __builtin_amdgcn_ds_read_tr16_b64_v4i16((LAS v4i16_t*)p)); }
constexpr int ATT_UNITS = 3 * BATCH * NH * 16;
__device__ __forceinline__ void p4_attn(Frame& F, const Args& AR) {
    const bf16* PROJ = (const bf16*)(F.ws + WS_PROJ);
    bf16* PO = (bf16*)((unsigned char*)F.out + DO_PO); float* ML = (float*)(F.ws + WS_ML);
    const int tid = F.tid, lane = F.lane, wave = F.wave, half = wave >> 2, wq = wave & 3, th = tid & 255;
    const int r32 = lane & 31, hi = lane >> 5;
    LAS unsigned char* Kl = F.lds + RING_OFF + half * 65536; LAS unsigned char* Vl = Kl + 32768;
    gu32* qctr = F.ctl + CW_ATTQ;
    v4u kst[8], vst[8];
#define ATT_DECODE(up_) const int unit = 2 * (up_) + half; \
        const int pat = unit / (BATCH * NH * 16), rem = unit % (BATCH * NH * 16), bh = rem >> 4, i16 = rem & 15, b = bh >> 3, h = bh & 7; \
        const int dil = pat == 0 ? 1 : (pat == 1 ? 4 : 16); \
        const int res = pat == 0 ? 0 : (pat == 1 ? (i16 >> 2) : i16); \
        const int n = pat == 0 ? i16 : (pat == 1 ? (i16 & 3) : 0); \
        const size_t rowb = (size_t)b * SEQ;
#define ATT_ISSUE(up_) do { ATT_DECODE(up_) const int c = th & 7; \
        _Pragma("unroll") for (int i = 0; i < 8; ++i) { const int key = (th >> 3) + 32 * i; const int sub = 128 * (n - 1) + key; \
            kst[i] = (v4u){0u, 0u, 0u, 0u}; vst[i] = kst[i]; \
            if (sub >= 0) { const GAS bf16* src = (const GAS bf16*)PROJ + (rowb + res + dil * sub) * IN_COLS + h * 64 + 8 * c; kst[i] = *(const GAS v4u*)(src + PC_K); vst[i] = *(const GAS v4u*)(src + PC_V); } } } while (0)
    if (tid == 0) F.MISC[16] = __hip_atomic_fetch_add(qctr, 1u, RLX_AGENT);
    __syncthreads();
    int up = (int)F.MISC[16];
    __syncthreads();
    if (up < ATT_UNITS / 2) ATT_ISSUE(up);
    while (up < ATT_UNITS / 2) {
        if (tid == 0) F.MISC[16] = __hip_atomic_fetch_add(qctr, 1u, RLX_AGENT);
        ATT_DECODE(up)
        const int ql = 32 * wq + r32; const size_t qrow = rowb + res + dil * (128 * n + ql);
        bf16x8 qf[4];
#pragma unroll
        for (int d0 = 0; d0 < 4; ++d0) qf[d0] = *(const GAS bf16x8*)((const GAS bf16*)PROJ + qrow * IN_COLS + PC_Q + h * 64 + 16 * d0 + 8 * hi);
        {
            const int c = th & 7;
#pragma unroll
            for (int i = 0; i < 8; ++i) {
                const int key = (th >> 3) + 32 * i;
                *(LAS v4u*)(Kl + key * 128 + ((c ^ ((key >> 1) & 7)) * 16)) = kst[i];
                *(LAS v4u*)(Vl + (c >> 2) * 16384 + key * 64 + (c & 3) * 16) = vst[i];
            }
        }
        __syncthreads();
        const int upn = (int)F.MISC[16];
        if (upn < ATT_UNITS / 2) { ATT_ISSUE(upn); }
        const float slope2 = __builtin_amdgcn_exp2f(-(float)(h + 1)) * (float)dil * LOG2E;
        const int thr = r32 - 4 * hi;
        f32x16 sc[5];
        float mx = -INFINITY;
#pragma unroll
        for (int kt = 0; kt < 5; ++kt) {
            const bool skip = (n == 0) && (wq + kt < 4);
            f32x16 acc;
            if (!skip) {
                const int key = 32 * (wq + kt) + r32;
                const float bk = -slope2 * (float)(128 - 32 * kt + thr);
#pragma unroll
                for (int r = 0; r < 16; ++r) acc[r] = slope2 * (float)((r & 3) + 8 * (r >> 2)) + bk;
#pragma unroll
                for (int d0 = 0; d0 < 4; ++d0) {
                    const bf16x8 kf = *(const LAS bf16x8*)(Kl + key * 128 + (((2 * d0 + hi) ^ ((key >> 1) & 7)) * 16));
                    acc = __builtin_amdgcn_mfma_f32_32x32x16_bf16(kf, qf[d0], acc, 0, 0, 0);
                }
                if (kt == 0) {
#pragma unroll
                    for (int r = 0; r < 16; ++r) acc[r] = ((r & 3) + 8 * (r >> 2)) >= thr ? acc[r] : -INFINITY;
                }
                if (kt == 4) {
#pragma unroll
                    for (int r = 0; r < 16; ++r) acc[r] = ((r & 3) + 8 * (r >> 2)) <= thr ? acc[r] : -INFINITY;
                }
#pragma unroll
                for (int r = 0; r < 16; ++r) mx = fmaxf(mx, acc[r]);
            } else {
#pragma unroll
                for (int r = 0; r < 16; ++r) acc[r] = -INFINITY;
            }
            sc[kt] = acc;
            __builtin_amdgcn_sched_barrier(0);
        }
        mx = fmaxf(mx, __shfl_xor(mx, 32));
        float l = 0.f;
#pragma unroll
        for (int kt = 0; kt < 5; ++kt)
#pragma unroll
            for (int r = 0; r < 16; ++r) { const float p = __builtin_amdgcn_exp2f(sc[kt][r] - mx); sc[kt][r] = p; l += p; }
        l += __shfl_xor(l, 32);
        f32x16 o[2]; o[0] = f32x16{}; o[1] = f32x16{};
        const int voff = ((lane >> 4) & 1) * 32 + (lane & 3) * 8 + (4 * hi + ((lane & 15) >> 2)) * 64;
#pragma unroll
        for (int kt = 0; kt < 5; ++kt) {
            const bool skip = (n == 0) && (wq + kt < 4);
            if (!skip) {
#pragma unroll
            for (int s2 = 0; s2 < 2; ++s2) {
                v4u pw;
                pw.x = pg8::cvt_pk_bf16(sc[kt][8 * s2 + 0], sc[kt][8 * s2 + 1]); pw.y = pg8::cvt_pk_bf16(sc[kt][8 * s2 + 2], sc[kt][8 * s2 + 3]);
                pw.z = pg8::cvt_pk_bf16(sc[kt][8 * s2 + 4], sc[kt][8 * s2 + 5]); pw.w = pg8::cvt_pk_bf16(sc[kt][8 * s2 + 6], sc[kt][8 * s2 + 7]);
                const bf16x8 pf = __builtin_bit_cast(bf16x8, pw);
                const int kb = 32 * (wq + kt) + 16 * s2;
#pragma unroll
                for (int dt = 0; dt < 2; ++dt) {
                    const LAS unsigned char* vp = Vl + dt * 16384 + kb * 64 + voff;
                    const s16x4 lo = vtr(vp), hi4 = vtr(vp + 8 * 64);
                    const bf16x8 vf = (bf16x8){lo[0], lo[1], lo[2], lo[3], hi4[0], hi4[1], hi4[2], hi4[3]};
                    o[dt] = __builtin_amdgcn_mfma_f32_32x32x16_bf16(vf, pf, o[dt], 0, 0, 0);
                }
            }
            }
        }
        const float rl = 1.f / l;
        bf16* po = PO + ((size_t)pat * M + qrow) * AW + h * 64;
#pragma unroll
        for (int dt = 0; dt < 2; ++dt)
#pragma unroll
            for (int g = 0; g < 4; ++g) {
                const v2u w = (v2u){pk2(o[dt][4 * g] * rl, o[dt][4 * g + 1] * rl), pk2(o[dt][4 * g + 2] * rl, o[dt][4 * g + 3] * rl)};
                *(v2u*)(po + 32 * dt + 8 * g + 4 * hi) = w;
            }
        if (hi == 0) *(f32x2*)(ML + (((size_t)pat * M + qrow) * NH + h) * 2) = (f32x2){mx, l};
        __syncthreads();
        up = upn;
    }
#undef ATT_DECODE
#undef ATT_ISSUE
}

struct P5In { v4u po[3]; f32x2 ml[3]; };
__device__ __forceinline__ void p5_load(P5In& I, int m, int lane, const bf16* PO, const float* ML) {
    const int hd = lane >> 3;
#pragma unroll
    for (int p = 0; p < 3; ++p) { I.ml[p] = *(const GAS f32x2*)(ML + (((size_t)p * M + m) * NH + hd) * 2); I.po[p] = *(const GAS v4u*)(PO + ((size_t)p * M + m) * AW + 8 * lane); }
}
__device__ __forceinline__ void p5_token(const P5In& I, int m, int lane, bf16* MIX, const float (&aog)[8]) {
    const float mm = fmaxf(fmaxf(I.ml[0].x, I.ml[1].x), I.ml[2].x);
    float wp[3], wsum = 0.f;
#pragma unroll
    for (int p = 0; p < 3; ++p) { wp[p] = __builtin_amdgcn_exp2f(I.ml[p].x - mm) * I.ml[p].y; wsum += wp[p]; }
    const float rws = 1.f / wsum;
    float at[8] = {0.f, 0.f, 0.f, 0.f, 0.f, 0.f, 0.f, 0.f};
#pragma unroll
    for (int p = 0; p < 3; ++p) { const v4u w = I.po[p]; const float f = wp[p] * rws;
        at[0] += f * bflo(w.x); at[1] += f * bfhi(w.x); at[2] += f * bflo(w.y); at[3] += f * bfhi(w.y); at[4] += f * bflo(w.z); at[5] += f * bfhi(w.z); at[6] += f * bflo(w.w); at[7] += f * bfhi(w.w); }
    float ss = 0.f;
#pragma unroll
    for (int i = 0; i < 8; ++i) ss += at[i] * at[i];
    ss += __shfl_xor(ss, 1); ss += __shfl_xor(ss, 2); ss += __shfl_xor(ss, 4);
    const float rstd = 1.f / sqrtf(ss * (1.f / 64.f) + NORM_EPS);
    v4u oa; oa.x = pk2(at[0] * rstd * aog[0], at[1] * rstd * aog[1]); oa.y = pk2(at[2] * rstd * aog[2], at[3] * rstd * aog[3]);
    oa.z = pk2(at[4] * rstd * aog[4], at[5] * rstd * aog[5]); oa.w = pk2(at[6] * rstd * aog[6], at[7] * rstd * aog[7]);
    *(GAS v4u*)(MIX + (size_t)m * D + 8 * lane) = oa;
}
__device__ __forceinline__ void p5_post(Frame& F, const Args& AR) {
    const int gw = F.vcu * NWAVES + F.wave, NGW = F.G * NWAVES, lane = F.lane;
    const bf16* PO = (const bf16*)((unsigned char*)F.out + DO_PO); const float* ML = (const float*)(F.ws + WS_ML);
    bf16* MIX = (bf16*)(F.ws + WS_XN);
    float aog[8];
#pragma unroll
    for (int i = 0; i < 8; ++i) aog[i] = AR.in[I_AOG][8 * lane + i];
    static_assert(M % 4 == 0, "four tokens per step");
    for (int m = 4 * gw; m < M; m += 4 * NGW) {
        P5In A, B, C, E;
        p5_load(A, m, lane, PO, ML); p5_load(B, m + 1, lane, PO, ML); p5_load(C, m + 2, lane, PO, ML); p5_load(E, m + 3, lane, PO, ML);
        p5_token(A, m, lane, MIX, aog); p5_token(B, m + 1, lane, MIX, aog); p5_token(C, m + 2, lane, MIX, aog); p5_token(E, m + 3, lane, MIX, aog);
    }
}

__global__ void __launch_bounds__(NWAVES * 64, 2) hybrid_fwd(Args args) {
    extern __shared__ __attribute__((aligned(16))) unsigned char lds[];
    Frame F;
    F.lds = (LAS unsigned char*)lds;
    F.MISC = (volatile LAS unsigned*)(F.lds + MISC_OFF);
    F.tid = threadIdx.x; F.lane = F.tid & 63; F.wave = __builtin_amdgcn_readfirstlane(F.tid >> 6);
    F.G = gridDim.x; { const int bx = blockIdx.x; F.vcu = (F.G % 8 == 0) ? (bx % 8) * (F.G / 8) + bx / 8 : bx; }
    F.ws = args.ws; F.out = args.out;
    F.ctl = (gu32*)(args.ws + WS_CTL);
    for (int u = F.tid; u < (LDS_BYTES - LDSCTL_OFF) / 4; u += NWAVES * 64) ((LAS unsigned*)(F.lds + LDSCTL_OFF))[u] = 0u;
    __syncthreads();
    XcdBarrier bar; bar.bar = (unsigned*)(F.ctl + CW_BAR); bar.x = 0; bar.st = nullptr;
    if (N_LAUNCHES != PER_PHASE) bar = xcd_barrier_post((unsigned*)(F.ctl + CW_BAR), F.MISC + 8);
#define GRID_BAR() do { if (N_LAUNCHES != PER_PHASE) xcd_barrier(bar); } while (0)
    const int lo = args.ph_lo, hi = args.ph_hi;
#ifndef PHMASK
#define PHMASK 0x3ff
#endif
#define IN(k) (((PHMASK >> (k)) & 1) && lo <= (k) && (k) < hi)
#define BOTH(k) (IN(k) && IN((k) + 1))
#define PSTAMP(i) do { if (PROBE_SEL >= 0 && blockIdx.x == 0 && F.tid == 0) { const unsigned long long t_ = __builtin_amdgcn_s_memtime(); __hip_atomic_store(F.ctl + 9100 + (i), (unsigned)(t_ >> 4), RLX_AGENT); } } while (0)
#ifndef REPMASK
#define REPMASK 0
#endif
#define REP(k) for (int rep_ = 0; rep_ <= ((REPMASK >> (k)) & 1); ++rep_)
    bf16* XN = (bf16*)(args.ws + WS_XN); bf16* PROJ = (bf16*)(args.ws + WS_PROJ);

    PSTAMP(0);
    if (IN(0)) { p0_prologue(F, args); if (BOTH(0)) GRID_BAR(); }
    PSTAMP(1);
    if (IN(1)) {
        pg8::Gemm g{XN, (const bf16*)(args.ws + WS_WIN), M, IN_COLS, D}; pg8::StaticOrder S; S.init(M, IN_COLS, F.G, (int)blockIdx.x);
        pg8::EpiProj E{PROJ, IN_COLS, args.in[I_QNG], args.in[I_KNG]};
        pg8::gemm_phase<pg8::EpiProj, pg8::StaticOrder, true, true>(F.lds + RING_OFF, g, S, E);
        if (BOTH(1)) GRID_BAR();
    }
    PSTAMP(2);
    if (IN(2)) { p2_prep(F, args); if (BOTH(2)) GRID_BAR(); }
    PSTAMP(3);
    if (IN(3)) {
        pg8::Gemm g{(const bf16*)(args.ws + WS_A2), (const bf16*)(args.ws + WS_WL), M, NLORA, KLORA}; pg8::StaticOrder S; S.init(M, NLORA, F.G, (int)blockIdx.x);
        pg8::EpiLora E{(bf16*)(args.ws + WS_DAG), NLORA, args.in[I_W0], args.in[I_A0]};
        pg8::gemm_phase<pg8::EpiLora, pg8::StaticOrder, true, true>(F.lds + RING_OFF, g, S, E);
        if (BOTH(3)) GRID_BAR();
    }
    PSTAMP(4);
    if (IN(4)) { p4_scan(F, args); PSTAMP(11); p4_attn(F, args); PSTAMP(12); if (BOTH(4)) GRID_BAR(); }
    PSTAMP(5);
    if (IN(5)) { p5_post(F, args); if (BOTH(5)) GRID_BAR(); }
    PSTAMP(6);
    if (IN(6)) {
        pg8::Gemm g{XN, (const bf16*)(args.ws + WS_WOUT), M, D, D}; pg8::StaticOrder S; S.init(M, D, F.G, (int)blockIdx.x);
        pg8::EpiOut E{args.in[I_X], (bf16*)(args.ws + WS_DAG), (float*)(args.ws + WS_SS), D, (LAS float*)(F.lds + RING_OFF + 131072)};
        pg8::gemm_phase<pg8::EpiOut, pg8::StaticOrder, true, true>(F.lds + RING_OFF, g, S, E);
        if (IN(8)) GRID_BAR();
    }
    PSTAMP(8);
    if (IN(8)) {
        pg8::Gemm g{(const bf16*)(args.ws + WS_DAG), (const bf16*)(args.ws + WS_WGU), M, NGU, D}; pg8::StaticOrder S; S.init(M, NGU, F.G, (int)blockIdx.x);
        pg8::EpiSwiglu E{PROJ, FF, (const float*)(args.ws + WS_SS)};
        pg8::gemm_phase<pg8::EpiSwiglu, pg8::StaticOrder, true, true>(F.lds + RING_OFF, g, S, E);
        if (BOTH(8)) GRID_BAR();
    }
    PSTAMP(9);
    if (IN(9)) {
        pg8::Gemm g{PROJ, (const bf16*)(args.ws + WS_WDN), M, D, FF}; pg8::StaticOrder S; S.init(M, D, F.G, (int)blockIdx.x);
        pg8::EpiFinal E{(const bf16*)(args.ws + WS_DAG), F.out, D};
        pg8::gemm_phase<pg8::EpiFinal, pg8::StaticOrder, true, true>(F.lds + RING_OFF, g, S, E);
    }
    PSTAMP(10);
    if (PROBE_SEL >= 0 && blockIdx.x == 0 && F.tid == 0) {
        unsigned w = 0;
        auto ld = [&](int i) { return __hip_atomic_load(F.ctl + 9100 + i, RLX_AGENT); };
        const int sel = PROBE_SEL;
        if (sel <= 9) { const int nxt = sel == 6 ? 8 : (sel == 9 ? 10 : sel + 1); w = ld(nxt) - ld(sel); }
        else if (sel == 20) w = ld(11) - ld(4);
        else if (sel == 21) w = ld(12) - ld(11);
        else w = ld(sel);
        const unsigned long long t0 = __builtin_amdgcn_s_memtime();
        while (((__builtin_amdgcn_s_memtime() - t0) >> 4) < (unsigned long long)w) __builtin_amdgcn_s_sleep(8);
    }
#undef IN
#undef BOTH
}

extern "C" void kernel_launch(void* const* d_in, const int* in_sizes, int n_in, void* d_out, int out_size, void* d_ws, size_t ws_size, hipStream_t stream) {
    static int grid = 0;
    if (grid == 0) {
        if (n_in != 22 || in_sizes[0] != M * D || out_size != M * D || ws_size < WS_END) { fprintf(stderr, "kernel_launch: unexpected shapes (n_in %d, in0 %d, out %d, ws %zu); nothing launched\n", n_in, n_in > 0 ? in_sizes[0] : -1, out_size, ws_size); grid = -1; return; }
        int dev = 0, cus = 0, per_cu = 0;
        if (hipGetDevice(&dev) != hipSuccess || hipDeviceGetAttribute(&cus, hipDeviceAttributeMultiprocessorCount, dev) != hipSuccess) { grid = -1; return; }
        if (hipFuncSetAttribute((const void*)hybrid_fwd, hipFuncAttributeMaxDynamicSharedMemorySize, LDS_BYTES) != hipSuccess) { fprintf(stderr, "kernel_launch: hipFuncSetAttribute failed\n"); grid = -1; return; }
        if (hipOccupancyMaxActiveBlocksPerMultiprocessor(&per_cu, (const void*)hybrid_fwd, NWAVES * 64, LDS_BYTES) != hipSuccess || per_cu < 1)
            fprintf(stderr, "kernel_launch: note: occupancy query reports %d workgroups per CU\n", per_cu);
        (void)hipGetLastError();
        grid = cus;
    }
    if (grid < 0) return;
    if (hipMemsetAsync((char*)d_ws + WS_CTL, 0, CTL_ZERO_BYTES, stream) != hipSuccess) { fprintf(stderr, "kernel_launch: hipMemsetAsync failed\n"); return; }
    Args a{};
    for (int i = 0; i < 22; ++i) a.in[i] = (const float*)d_in[i];
    a.out = (float*)d_out; a.ws = (unsigned char*)d_ws;
    for (int li = 0; li < N_LAUNCHES; ++li) {
        a.ph_lo = (N_LAUNCHES == PER_PHASE) ? li : 0; a.ph_hi = (N_LAUNCHES == PER_PHASE) ? li + 1 : PER_PHASE; a.li = li;
        hipLaunchKernelGGL(hybrid_fwd, dim3(grid), dim3(NWAVES * 64), LDS_BYTES, stream, a);
        const hipError_t le = hipPeekAtLastError();
        if (le != hipSuccess) { fprintf(stderr, "kernel_launch: launch %d failed: %s\n", li, hipGetErrorName(le)); break; }
    }
}
```

```cpp
#include <hip/hip_runtime.h>
#include <cstdio>
#include <cstdint>

#ifndef PROBE_SEL
#define PROBE_SEL -1
#endif
#ifndef MK_N_LAUNCHES
#define MK_N_LAUNCHES 1
#endif

namespace pg8 {
#define PG8_LAS __attribute__((address_space(3)))
typedef unsigned short bf16_t;
typedef short bf16x8 __attribute__((ext_vector_type(8)));
typedef float f32x4 __attribute__((ext_vector_type(4)));
typedef float f32x2 __attribute__((ext_vector_type(2)));
typedef unsigned u32x4 __attribute__((ext_vector_type(4)));
constexpr int BM = 256, BK = 64, HALF = 128, HTB = HALF * BK * 2, STAGE_BYTES = 8 * HTB, NXCD = 8, WGM = 8;

__host__ __device__ __forceinline__ int lds_byte(int r, int c) { const int st = (r >> 4) * 2 + (c >> 5), rr = r & 15, cc = c & 31, ob = rr * 64 + cc * 2; return st * 1024 + (ob ^ (((ob >> 9) & 1) << 5)); }
__host__ __device__ __forceinline__ void stage_rc(int b, int& R, int& C) { const int st = b / 1024, sb = b % 1024, swz = sb ^ (((sb >> 9) & 1) << 5); R = (st >> 1) * 16 + swz / 64; C = (st & 1) * 32 + (swz % 64) / 2; }
__host__ __device__ __forceinline__ int perm32(int rho) { const int n = rho >> 4, i = rho & 15; return 8 * (i >> 2) + 4 * n + (i & 3); }

struct Unit { int pm, pn; };
struct Gemm { const bf16_t* A; const bf16_t* Bt; int M, N, K; };

struct StaticOrder {
    int nM, nN, nwg, G, c;
    __host__ __device__ void init(int M, int N, int G_, int c_) { nM = M / BM; nN = N / BM; nwg = nM * nN; G = G_; c = c_; }
    __host__ __device__ bool next(int i, Unit& u) const {
        const long L = (long)i * G + c; if (L >= nwg) return false;
        int wgid = (int)L; { const int q = nwg / NXCD, r = nwg % NXCD, xcd = wgid % NXCD, off = wgid / NXCD; wgid = (xcd < r ? xcd * (q + 1) : r * (q + 1) + (xcd - r) * q) + off; }
        const int nig = WGM * nN, gid = wgid / nig, fm = gid * WGM, gsz = (nM - fm) < WGM ? (nM - fm) : WGM;
        u.pm = fm + ((wgid % nig) % gsz); u.pn = (wgid % nig) / gsz; return true;
    }
    __device__ __forceinline__ void a_ready(const Unit&) const {}
    __device__ __forceinline__ void done(const Unit&) const {}
};

__device__ __forceinline__ unsigned cvt_pk_bf16(float lo, float hi) { unsigned r; asm volatile("v_cvt_pk_bf16_f32 %0, %1, %2" : "=v"(r) : "v"(lo), "v"(hi)); return r; }
__device__ __forceinline__ float fsigmoid(float x) { return __builtin_amdgcn_rcpf(1.0f + __builtin_amdgcn_exp2f(-1.4426950408889634f * x)); }

struct EpiBf16 {
    static constexpr bool PERM = true, AFTER_DRAIN = false;
    bf16_t* O; int ldc;
    __device__ __forceinline__ void operator()(const f32x4 (&acc)[2][2][4][2], const Unit& u, int wr, int wc, int fr, int fq) const {
        const int row0 = u.pm * BM + wr * 64 + fr; const int col0 = u.pn * BM + wc * 32 + 8 * fq;
#pragma unroll
        for (int ai = 0; ai < 2; ++ai)
#pragma unroll
            for (int m = 0; m < 4; ++m) { bf16_t* rowp = O + (size_t)(row0 + ai * HALF + m * 16) * ldc + col0;
#pragma unroll
                for (int bj = 0; bj < 2; ++bj) { const f32x4 v0 = acc[ai][bj][m][0], v1 = acc[ai][bj][m][1];
                    u32x4 w; w.x = cvt_pk_bf16(v0[0], v0[1]); w.y = cvt_pk_bf16(v0[2], v0[3]); w.z = cvt_pk_bf16(v1[0], v1[1]); w.w = cvt_pk_bf16(v1[2], v1[3]);
                    *(u32x4*)(rowp + bj * HALF) = w; } }
    }
};
struct EpiProj {
    static constexpr bool PERM = true, AFTER_DRAIN = false;
    bf16_t* O; int ldc; const float* qg; const float* kg;
    __device__ __forceinline__ void operator()(const f32x4 (&acc)[2][2][4][2], const Unit& u, int wr, int wc, int fr, int fq) const {
        const int row0 = u.pm * BM + wr * 64 + fr;
        if (u.pn >= 4) {
            const int col0 = u.pn * BM + wc * 32 + 8 * fq;
#pragma unroll
            for (int ai = 0; ai < 2; ++ai)
#pragma unroll
                for (int m = 0; m < 4; ++m) { bf16_t* rowp = O + (size_t)(row0 + ai * HALF + m * 16) * ldc + col0;
#pragma unroll
                    for (int bj = 0; bj < 2; ++bj) { const f32x4 v0 = acc[ai][bj][m][0], v1 = acc[ai][bj][m][1];
                        u32x4 w; w.x = cvt_pk_bf16(v0[0], v0[1]); w.y = cvt_pk_bf16(v0[2], v0[3]); w.z = cvt_pk_bf16(v1[0], v1[1]); w.w = cvt_pk_bf16(v1[2], v1[3]);
                        *(u32x4*)(rowp + bj * HALF) = w; } }
        } else {
            const float* gsrc = (u.pn < 2 ? qg : kg) + 8 * fq; const float sc = u.pn < 2 ? 0.125f * 1.4426950408889634f : 1.0f;
            f32x4 g4[2][2];
#pragma unroll
            for (int bj = 0; bj < 2; ++bj)
#pragma unroll
                for (int n = 0; n < 2; ++n) g4[bj][n] = *(const f32x4*)(gsrc + 32 * bj + 4 * n) * sc;
            const int col0 = u.pn * BM + wc * 64 + 8 * fq;
#pragma unroll
            for (int ai = 0; ai < 2; ++ai)
#pragma unroll
                for (int m = 0; m < 4; ++m) {
                    float ss = 0.f;
#pragma unroll
                    for (int bj = 0; bj < 2; ++bj)
#pragma unroll
                        for (int n = 0; n < 2; ++n) { const f32x4 v = acc[ai][bj][m][n]; ss += (v[0] * v[0] + v[1] * v[1]) + (v[2] * v[2] + v[3] * v[3]); }
                    ss += __shfl_xor(ss, 16); ss += __shfl_xor(ss, 32);
                    const float rstd = 1.0f / sqrtf(ss * (1.0f / 64.0f) + 1e-6f);
                    bf16_t* rowp = O + (size_t)(row0 + ai * HALF + m * 16) * ldc + col0;
#pragma unroll
                    for (int bj = 0; bj < 2; ++bj) { const f32x4 v0 = acc[ai][bj][m][0] * g4[bj][0] * rstd, v1 = acc[ai][bj][m][1] * g4[bj][1] * rstd;
                        u32x4 w; w.x = cvt_pk_bf16(v0[0], v0[1]); w.y = cvt_pk_bf16(v0[2], v0[3]); w.z = cvt_pk_bf16(v1[0], v1[1]); w.w = cvt_pk_bf16(v1[2], v1[3]);
                        *(u32x4*)(rowp + 32 * bj) = w; }
                    __builtin_amdgcn_sched_barrier(0); }
        }
    }
};
struct EpiLora {
    static constexpr bool PERM = true, AFTER_DRAIN = false;
    bf16_t* O; int ldc; const float* w0; const float* a0;
    __device__ __forceinline__ void operator()(const f32x4 (&acc)[2][2][4][2], const Unit& u, int wr, int wc, int fr, int fq) const {
        const int row0 = u.pm * BM + wr * 64 + fr; const int col0 = u.pn * BM + wc * 32 + 8 * fq;
        const int kind = u.pn >> 1;
        const float sc = kind == 0 ? -0.6065306597126334f : (kind == 1 ? 1.0f : 0.0f), lin = kind == 2 ? 1.0f : 0.0f;
        const float* bp = kind == 0 ? w0 : a0;
        const float bs = kind == 2 ? 0.0f : 1.0f;
#pragma unroll
        for (int bj = 0; bj < 2; ++bj) {
            const int c = (col0 + bj * HALF) & 511;
            const f32x4 b0 = *(const f32x4*)(bp + c) * bs, b1 = *(const f32x4*)(bp + c + 4) * bs;
#pragma unroll
            for (int ai = 0; ai < 2; ++ai)
#pragma unroll
                for (int m = 0; m < 4; ++m) { bf16_t* rowp = O + (size_t)(row0 + ai * HALF + m * 16) * ldc + col0;
                    f32x4 v0 = acc[ai][bj][m][0] + b0, v1 = acc[ai][bj][m][1] + b1;
#pragma unroll
                    for (int e = 0; e < 4; ++e) { v0[e] = sc * fsigmoid(v0[e]) + lin * v0[e]; v1[e] = sc * fsigmoid(v1[e]) + lin * v1[e]; }
                    u32x4 w; w.x = cvt_pk_bf16(v0[0], v0[1]); w.y = cvt_pk_bf16(v0[2], v0[3]); w.z = cvt_pk_bf16(v1[0], v1[1]); w.w = cvt_pk_bf16(v1[2], v1[3]);
                    *(u32x4*)(rowp + bj * HALF) = w;
                    __builtin_amdgcn_sched_barrier(0); }
        }
    }
};
struct EpiSwiglu {
    static constexpr bool PERM = true, AFTER_DRAIN = false;
    bf16_t* H; int ldh; const float* rstd;
    __device__ __forceinline__ void operator()(const f32x4 (&acc)[2][2][4][2], const Unit& u, int wr, int wc, int fr, int fq) const {
        const int row0 = u.pm * BM + wr * 64 + fr; const int col0 = u.pn * HALF + wc * 32 + 8 * fq;
        float rs[2][4];
#pragma unroll
        for (int ai = 0; ai < 2; ++ai)
#pragma unroll
            for (int m = 0; m < 4; ++m) { const f32x4 s4 = *(const f32x4*)(rstd + (size_t)(row0 + ai * HALF + m * 16) * 4);
                rs[ai][m] = 1.0f / sqrtf(((s4[0] + s4[1]) + (s4[2] + s4[3])) * (1.0f / 1024.0f) + 1e-6f); }
#pragma unroll
        for (int ai = 0; ai < 2; ++ai)
#pragma unroll
            for (int m = 0; m < 4; ++m) { bf16_t* rowp = H + (size_t)(row0 + ai * HALF + m * 16) * ldh + col0;
                float h[8];
#pragma unroll
                for (int n = 0; n < 2; ++n)
#pragma unroll
                    for (int e = 0; e < 4; ++e) { const float g = acc[ai][0][m][n][e] * rs[ai][m], up = acc[ai][1][m][n][e] * rs[ai][m]; h[4 * n + e] = g * fsigmoid(g) * up; }
                u32x4 w; w.x = cvt_pk_bf16(h[0], h[1]); w.y = cvt_pk_bf16(h[2], h[3]); w.z = cvt_pk_bf16(h[4], h[5]); w.w = cvt_pk_bf16(h[6], h[7]);
                *(u32x4*)rowp = w;
                __builtin_amdgcn_sched_barrier(0); }
    }
};
struct EpiOut {
    static constexpr bool PERM = true, AFTER_DRAIN = false;
    const float* base; bf16_t* xb; float* SS; int ldc; PG8_LAS float* scr;
    __device__ __forceinline__ void operator()(const f32x4 (&acc)[2][2][4][2], const Unit& u, int wr, int wc, int fr, int fq) const {
        const int row0 = u.pm * BM + wr * 64 + fr, col0 = u.pn * BM + wc * 32 + 8 * fq;
#pragma unroll
        for (int ai = 0; ai < 2; ++ai)
#pragma unroll
            for (int m = 0; m < 4; ++m) { const size_t off = (size_t)(row0 + ai * HALF + m * 16) * ldc + col0;
                float ss = 0.f;
#pragma unroll
                for (int bj = 0; bj < 2; ++bj) {
                    const f32x4 o0 = *(const f32x4*)(base + off + bj * HALF) + acc[ai][bj][m][0], o1 = *(const f32x4*)(base + off + bj * HALF + 4) + acc[ai][bj][m][1];
                    u32x4 w; w.x = cvt_pk_bf16(o0[0], o0[1]); w.y = cvt_pk_bf16(o0[2], o0[3]); w.z = cvt_pk_bf16(o1[0], o1[1]); w.w = cvt_pk_bf16(o1[2], o1[3]);
                    *(u32x4*)(xb + off + bj * HALF) = w;
                    ss += ((o0[0] * o0[0] + o0[1] * o0[1]) + (o0[2] * o0[2] + o0[3] * o0[3])) + ((o1[0] * o1[0] + o1[1] * o1[1]) + (o1[2] * o1[2] + o1[3] * o1[3])); }
                ss += __shfl_xor(ss, 16); ss += __shfl_xor(ss, 32);
                if (fq == 0) scr[((((wr * 2 + ai) * 4 + m) * 16) + fr) * 4 + wc] = ss;
                if (m & 1) asm volatile("" ::: "memory"); }
        asm volatile("s_waitcnt lgkmcnt(0)" ::: "memory"); __builtin_amdgcn_s_barrier(); asm volatile("" ::: "memory");
        const int tid = threadIdx.x;
        if (tid < 256) { const f32x4 s4 = *(const PG8_LAS f32x4*)(scr + tid * 4);
            const int row = u.pm * BM + ((tid >> 6) & 1) * HALF + (tid >> 7) * 64 + ((tid >> 4) & 3) * 16 + (tid & 15);
            SS[(size_t)row * 4 + u.pn] = (s4[0] + s4[1]) + (s4[2] + s4[3]); }
    }
};
struct EpiFinal {
    static constexpr bool PERM = true, AFTER_DRAIN = false;
    const bf16_t* xb; float* out; int ldc;
    __device__ __forceinline__ void operator()(const f32x4 (&acc)[2][2][4][2], const Unit& u, int wr, int wc, int fr, int fq) const {
        const int row0 = u.pm * BM + wr * 64 + fr, col0 = u.pn * BM + wc * 32 + 8 * fq;
#pragma unroll
        for (int ai = 0; ai < 2; ++ai)
#pragma unroll
            for (int m = 0; m < 4; ++m) { const size_t off = (size_t)(row0 + ai * HALF + m * 16) * ldc + col0;
#pragma unroll
                for (int bj = 0; bj < 2; ++bj) { const u32x4 w = *(const u32x4*)(xb + off + bj * HALF);
                    const f32x4 b0 = (f32x4){__builtin_bit_cast(float, w.x << 16), __builtin_bit_cast(float, w.x & 0xffff0000u), __builtin_bit_cast(float, w.y << 16), __builtin_bit_cast(float, w.y & 0xffff0000u)};
                    const f32x4 b1 = (f32x4){__builtin_bit_cast(float, w.z << 16), __builtin_bit_cast(float, w.z & 0xffff0000u), __builtin_bit_cast(float, w.w << 16), __builtin_bit_cast(float, w.w & 0xffff0000u)};
                    *(f32x4*)(out + off + bj * HALF) = b0 + acc[ai][bj][m][0]; *(f32x4*)(out + off + bj * HALF + 4) = b1 + acc[ai][bj][m][1]; }
                if (m & 1) asm volatile("" ::: "memory"); }
    }
};

template <class Epi, class Sched, bool ALIGN_EPI = false, bool SP2 = false>
__device__ __forceinline__ void gemm_phase(PG8_LAS unsigned char* lds, const Gemm g, const Sched& S, const Epi& E) {
    const int tid = threadIdx.x, wid = __builtin_amdgcn_readfirstlane(tid >> 6), lane = tid & 63, wr = wid >> 2, wc = wid & 3, fr = lane & 15, fq = lane >> 4;
    const int K = g.K, nt = K / BK;
    unsigned voffA[2], voffB[2];
#pragma unroll
    for (int i = 0; i < 2; ++i) { int R, C; stage_rc(tid * 16 + i * 8192, R, C); const int Rb = Epi::PERM ? ((R & ~31) + perm32(R & 31)) : R;
        voffA[i] = (unsigned)(R * K + C) * 2u; voffB[i] = (unsigned)(Rb * K + C) * 2u; }
    const size_t kstep = (size_t)(BK * 2);
    const size_t hstep = (size_t)HALF * K * 2;
    const size_t tstep = 2 * hstep;
    const unsigned ldsw = (unsigned)wid * 1024u;
    const int aoff = lds_byte(wr * 64 + fr, fq * 8), boff = lds_byte(wc * 32 + fr, fq * 8);
#define PG8_SA(b, h) (((b) * 2 + (h)) * HTB)
#define PG8_SB(b, h) ((4 + (b) * 2 + (h)) * HTB)
#define PG8_STAGE(bufoff, gbase, voff) do { _Pragma("unroll") for (int _i = 0; _i < 2; ++_i) \
        __builtin_amdgcn_global_load_lds((const unsigned*)((const char*)(gbase) + (voff)[_i]), (PG8_LAS unsigned*)(lds + (bufoff) + ldsw + _i * 8192), 16, 0, 0); } while (0)
#define PG8_LDA(dst, b, h) do { _Pragma("unroll") for (int m = 0; m < 4; ++m) _Pragma("unroll") for (int k = 0; k < 2; ++k) dst[m][k] = *(const PG8_LAS bf16x8*)(lds + PG8_SA(b, h) + aoff + m * 2048 + k * 1024); } while (0)
#define PG8_LDB(dst, b, h) do { _Pragma("unroll") for (int n = 0; n < 2; ++n) _Pragma("unroll") for (int k = 0; k < 2; ++k) dst[n][k] = *(const PG8_LAS bf16x8*)(lds + PG8_SB(b, h) + boff + n * 2048 + k * 1024); } while (0)
#define PG8_MMA(ai, bj, At, Bt) do { __builtin_amdgcn_s_setprio(1); _Pragma("unroll") for (int m = 0; m < 4; ++m) _Pragma("unroll") for (int n = 0; n < 2; ++n) _Pragma("unroll") for (int k = 0; k < 2; ++k) \
        acc[ai][bj][m][n] = __builtin_amdgcn_mfma_f32_16x16x32_bf16(Bt[n][k], At[m][k], acc[ai][bj][m][n], 0, 0, 0); __builtin_amdgcn_s_setprio(0); } while (0)
#define PG8_WAIT_V(n) asm volatile("s_waitcnt vmcnt(" #n ")" ::: "memory")
#define PG8_WAIT_L(n) asm volatile("s_waitcnt lgkmcnt(" #n ")" ::: "memory")
#define PG8_BAR __builtin_amdgcn_s_barrier()
#define PG8_SCHED __builtin_amdgcn_sched_barrier(0)
    Unit cur, nxt; int ui = 0;
    if (!S.next(0, cur)) return;
    f32x4 acc[2][2][4][2];
#pragma unroll
    for (int a = 0; a < 2; ++a)
#pragma unroll
        for (int b = 0; b < 2; ++b)
#pragma unroll
            for (int m = 0; m < 4; ++m)
#pragma unroll
                for (int n = 0; n < 2; ++n) acc[a][b][m][n] = (f32x4){0.f, 0.f, 0.f, 0.f};
    bf16x8 At[4][2], B0[2][2], B1[2][2];
    const char* cA = (const char*)g.A + (size_t)cur.pm * tstep; const char* cB = (const char*)g.Bt + (size_t)cur.pn * tstep;
    S.a_ready(cur);
    if constexpr (SP2) {
        PG8_STAGE(PG8_SB(0, 0), cB, voffB); PG8_STAGE(PG8_SB(0, 1), cB + hstep, voffB); PG8_STAGE(PG8_SA(0, 0), cA, voffA); PG8_STAGE(PG8_SA(0, 1), cA + hstep, voffA);
        if (wr == 1) PG8_BAR;
        PG8_WAIT_V(2); PG8_BAR;
        PG8_STAGE(PG8_SB(1, 0), cB + kstep, voffB); PG8_STAGE(PG8_SA(1, 0), cA + kstep, voffA); PG8_STAGE(PG8_SB(1, 1), cB + hstep + kstep, voffB);
        PG8_WAIT_V(6); PG8_BAR;
    } else {
        PG8_STAGE(PG8_SB(0, 0), cB, voffB); PG8_STAGE(PG8_SA(0, 0), cA, voffA); PG8_STAGE(PG8_SB(0, 1), cB + hstep, voffB); PG8_STAGE(PG8_SA(0, 1), cA + hstep, voffA);
        if (wr == 1) PG8_BAR;
        PG8_WAIT_V(4); PG8_BAR;
        PG8_STAGE(PG8_SB(1, 0), cB + kstep, voffB); PG8_STAGE(PG8_SA(1, 0), cA + kstep, voffA); PG8_STAGE(PG8_SB(1, 1), cB + hstep + kstep, voffB);
        PG8_WAIT_V(6); PG8_BAR;
    }
    for (;;) {
        const bool has_next = S.next(ui + 1, nxt);
        const char* nA = has_next ? (const char*)g.A + (size_t)nxt.pm * tstep : cA; const char* nB = has_next ? (const char*)g.Bt + (size_t)nxt.pn * tstep : cB;
#pragma nounroll
        for (int t = 0; t < nt; t += 2) {
            const bool last = (t == nt - 2);
            const char* a1 = cA + (size_t)(t + 1) * kstep;
            const char* a2 = last ? nA : cA + (size_t)(t + 2) * kstep; const char* b2 = last ? nB : cB + (size_t)(t + 2) * kstep;
            const char* a3 = a2 + kstep; const char* b3 = b2 + kstep;
            if (last && has_next) S.a_ready(nxt);
            if constexpr (SP2) {
            PG8_LDB(B0, 0, 0); PG8_LDB(B1, 0, 1); PG8_SCHED; PG8_LDA(At, 0, 0); PG8_STAGE(PG8_SA(1, 1), a1 + hstep, voffA);
            PG8_WAIT_V(8); PG8_WAIT_L(0); PG8_BAR; PG8_MMA(0, 0, At, B0); PG8_MMA(0, 1, At, B1); PG8_BAR; PG8_SCHED;
            PG8_LDA(At, 0, 1); PG8_STAGE(PG8_SB(0, 0), b2, voffB); PG8_STAGE(PG8_SB(0, 1), b2 + hstep, voffB); PG8_STAGE(PG8_SA(0, 0), a2, voffA);
            PG8_WAIT_V(8); PG8_WAIT_L(0); PG8_BAR; PG8_MMA(1, 0, At, B0); PG8_MMA(1, 1, At, B1); PG8_BAR; PG8_SCHED;
            PG8_LDB(B0, 1, 0); PG8_LDB(B1, 1, 1); PG8_SCHED; PG8_LDA(At, 1, 0); PG8_STAGE(PG8_SA(0, 1), a2 + hstep, voffA);
            PG8_WAIT_V(8); PG8_WAIT_L(0); PG8_BAR; PG8_MMA(0, 0, At, B0); PG8_MMA(0, 1, At, B1); PG8_BAR; PG8_SCHED;
            PG8_LDA(At, 1, 1); PG8_STAGE(PG8_SB(1, 0), b3, voffB); PG8_STAGE(PG8_SB(1, 1), b3 + hstep, voffB); PG8_STAGE(PG8_SA(1, 0), a3, voffA);
            PG8_WAIT_V(8); PG8_WAIT_L(0); PG8_BAR; PG8_MMA(1, 0, At, B0); PG8_MMA(1, 1, At, B1); PG8_BAR; PG8_SCHED;
            } else {
            PG8_LDB(B0, 0, 0); PG8_SCHED; PG8_LDA(At, 0, 0); PG8_STAGE(PG8_SA(1, 1), a1 + hstep, voffA);
            PG8_WAIT_L(8); PG8_BAR; PG8_WAIT_L(0); PG8_MMA(0, 0, At, B0); PG8_BAR; PG8_SCHED;
            PG8_LDB(B1, 0, 1); PG8_STAGE(PG8_SB(0, 0), b2, voffB);
            PG8_BAR; PG8_WAIT_L(0); PG8_MMA(0, 1, At, B1); PG8_BAR;
            PG8_LDA(At, 0, 1); PG8_STAGE(PG8_SA(0, 0), a2, voffA);
            PG8_BAR; PG8_WAIT_L(0); PG8_MMA(1, 0, At, B0); PG8_BAR; PG8_SCHED;
            PG8_STAGE(PG8_SB(0, 1), b2 + hstep, voffB);
            PG8_WAIT_V(6); PG8_BAR; PG8_MMA(1, 1, At, B1); PG8_BAR;
            PG8_LDB(B0, 1, 0); PG8_SCHED; PG8_LDA(At, 1, 0); PG8_STAGE(PG8_SA(0, 1), a2 + hstep, voffA);
            PG8_WAIT_L(8); PG8_BAR; PG8_WAIT_L(0); PG8_MMA(0, 0, At, B0); PG8_BAR; PG8_SCHED;
            PG8_LDB(B1, 1, 1); PG8_STAGE(PG8_SB(1, 0), b3, voffB);
            PG8_BAR; PG8_WAIT_L(0); PG8_MMA(0, 1, At, B1); PG8_BAR;
            PG8_LDA(At, 1, 1); PG8_STAGE(PG8_SA(1, 0), a3, voffA);
            PG8_BAR; PG8_WAIT_L(0); PG8_MMA(1, 0, At, B0); PG8_BAR; PG8_SCHED;
            PG8_STAGE(PG8_SB(1, 1), b3 + hstep, voffB);
            PG8_WAIT_V(6); PG8_BAR; PG8_MMA(1, 1, At, B1); PG8_BAR;
            }
        }
        if constexpr (ALIGN_EPI) { if (wr == 0) PG8_BAR; }
        if constexpr (!Epi::AFTER_DRAIN) { E(acc, cur, wr, wc, fr, fq); S.done(cur); }
        if (!has_next) break;
#pragma unroll
        for (int a = 0; a < 2; ++a)
#pragma unroll
            for (int b = 0; b < 2; ++b)
#pragma unroll
                for (int m = 0; m < 4; ++m)
#pragma unroll
                    for (int n = 0; n < 2; ++n) acc[a][b][m][n] = (f32x4){0.f, 0.f, 0.f, 0.f};
        cur = nxt; cA = nA; cB = nB; ++ui;
        if constexpr (ALIGN_EPI) { if (wr == 1) PG8_BAR; }
    }
    PG8_WAIT_V(0);
    if constexpr (!ALIGN_EPI) { if (wr == 0) PG8_BAR; }
    PG8_BAR;
#undef PG8_SA
#undef PG8_SB
#undef PG8_STAGE
#undef PG8_LDA
#undef PG8_LDB
#undef PG8_MMA
#undef PG8_WAIT_V
#undef PG8_WAIT_L
#undef PG8_BAR
#undef PG8_SCHED
}
}

constexpr int NWAVES = 8;
constexpr int N_LAUNCHES = MK_N_LAUNCHES;
constexpr int PER_PHASE = 10;
constexpr int BATCH = 16, SEQ = 2048, D = 1024, M = BATCH * SEQ;
constexpr int NH = 8, HD = 64, AW = 512, RW = 512;
constexpr int RWKV_COLS = 1792, IN_COLS = 3328, FF = 2816, NGU = 2 * FF, NLORA = 1536, KLORA = 256;
constexpr int PC_Q = 0, PC_K = 512, PC_V = 1024, PC_RW = 1536;
constexpr int RC_R = 0, RC_K = 512, RC_V = 1024, RC_L = 1536;
constexpr float NORM_EPS = 1e-6f, LNX_EPS = 64e-5f;
constexpr float LOG2E = 1.4426950408889634f;

constexpr size_t MiB = 1u << 20;
constexpr size_t WS_CTL = 0, CTL_ZERO_BYTES = 1 * MiB;
constexpr size_t WS_WIN = 2 * MiB;
constexpr size_t WS_WOUT = 9 * MiB;
constexpr size_t WS_WGU = 11 * MiB;
constexpr size_t WS_WDN = 22 * MiB;
constexpr size_t WS_WL = 28 * MiB;
constexpr size_t WS_BON = 29 * MiB;
constexpr size_t WS_SS = 30 * MiB;
constexpr size_t WS_XN = 32 * MiB;
constexpr size_t WS_PROJ = 96 * MiB;
constexpr size_t WS_A2 = 304 * MiB;
constexpr size_t WS_DAG = 320 * MiB;
constexpr size_t WS_ML = 416 * MiB;
constexpr size_t WS_END = 424 * MiB;
constexpr size_t DO_PO = 0, DO_Y = 96 * MiB;
constexpr int CW_TMO = 0, CW_CODE = 1;
constexpr int CW_BAR = 4096;
constexpr int CW_ATTQ = 8192;

constexpr int LDS_BYTES = 163840;
constexpr int RING_OFF = 0, RING_BYTES = LDS_BYTES - 1024;
constexpr int LDSCTL_OFF = RING_BYTES, MISC_OFF = LDSCTL_OFF + 320;

#define GAS __attribute__((address_space(1)))
#define LAS __attribute__((address_space(3)))
typedef unsigned short bf16;
typedef unsigned v4u __attribute__((ext_vector_type(4)));
typedef unsigned v2u __attribute__((ext_vector_type(2)));
typedef float f32x4 __attribute__((ext_vector_type(4)));
typedef float f32x2 __attribute__((ext_vector_type(2)));
typedef float f32x16 __attribute__((ext_vector_type(16)));
typedef short bf16x8 __attribute__((ext_vector_type(8)));
typedef short s16x4 __attribute__((ext_vector_type(4)));
typedef GAS unsigned gu32;
#define RLX_AGENT __ATOMIC_RELAXED, __HIP_MEMORY_SCOPE_AGENT
#define LDS_WAIT() asm volatile("s_waitcnt lgkmcnt(0)" ::: "memory")
#define VM_WAIT() asm volatile("s_waitcnt vmcnt(0)" ::: "memory")
__device__ __forceinline__ unsigned f2bf(float f) { unsigned u = __builtin_bit_cast(unsigned, f); return (u + 0x7fffu + ((u >> 16) & 1u)) >> 16; }
typedef float f32x2_t __attribute__((ext_vector_type(2))); typedef __bf16 bf16x2_t __attribute__((ext_vector_type(2)));
__device__ __forceinline__ unsigned cvt2(float lo, float hi) { f32x2_t v = {lo, hi}; bf16x2_t b = __builtin_convertvector(v, bf16x2_t); return __builtin_bit_cast(unsigned, b); }
__device__ __forceinline__ unsigned pk2(float lo, float hi) { return cvt2(lo, hi); }
__device__ __forceinline__ float bflo(unsigned w) { return __builtin_bit_cast(float, w << 16); }
__device__ __forceinline__ float bfhi(unsigned w) { return __builtin_bit_cast(float, w & 0xffff0000u); }
__device__ __forceinline__ float fsig(float x) { return __builtin_amdgcn_rcpf(1.0f + __builtin_amdgcn_exp2f(-LOG2E * x)); }

#define XB_TMO      128
#define XB_XCNT(j)  (256  + 64 * (j))
#define XB_XSUB(j)  (1280 + 64 * (j))
#define XB_XGEN(j)  (2304 + 64 * (j))
#define XB_TOP      3328
#define XB_TOPGEN   3392
#define XCD_BAR_WORDS 3456
#define XB_SPIN_CAP (1u << 18)
__device__ __forceinline__ unsigned xb_ld(unsigned* p)              { return __hip_atomic_load(p, __ATOMIC_RELAXED, __HIP_MEMORY_SCOPE_AGENT); }
__device__ __forceinline__ unsigned xb_add(unsigned* p, unsigned v) { return __hip_atomic_fetch_add(p, v, __ATOMIC_RELAXED, __HIP_MEMORY_SCOPE_AGENT); }
__device__ __forceinline__ unsigned xb_xcc_id() { return (unsigned)__builtin_amdgcn_s_getreg((3 << 11) | 20) & 0xFu; }
#define XB_SPIN(cond, bar) do { unsigned _sp = 0; while (cond) { __builtin_amdgcn_s_sleep(1); \
    if ((++_sp & 255u) == 0u) { if (xb_ld(&(bar)[XB_TMO])) break; if (_sp > XB_SPIN_CAP) { atomicAdd(&(bar)[XB_TMO], 1u); break; } } } } while (0)
struct XcdBarrier { unsigned* bar; unsigned x; volatile LAS unsigned* st; };
__device__ __forceinline__ XcdBarrier xcd_barrier_post(unsigned* bar, volatile LAS unsigned* st) {
    XcdBarrier b; b.bar = bar; b.x = xb_xcc_id(); b.st = st;
    if (threadIdx.x == 0) (void)xb_add(&bar[XB_XCNT(b.x)], 1u);
    return b;
}
__device__ __forceinline__ void xcd_barrier_complete(unsigned* bar, unsigned x, unsigned& nloc, unsigned& nx) {
    const unsigned G = gridDim.x * gridDim.y * gridDim.z;
    unsigned sum, cnt, mine, sp = 0u;
    for (;;) {
        sum = 0u; cnt = 0u; mine = 0u;
#pragma unroll
        for (unsigned j = 0; j < 16; ++j) { const unsigned c = xb_ld(&bar[XB_XCNT(j)]); sum += c; cnt += (c > 0u) ? 1u : 0u; mine = (j == x) ? c : mine; }
        if (sum == G) break;
        __builtin_amdgcn_s_sleep(1);
        if ((++sp & 255u) == 0u) { if (xb_ld(&bar[XB_TMO])) break; if (sp > XB_SPIN_CAP) { atomicAdd(&bar[XB_TMO], 1u); break; } }
    }
    nloc = mine > 0u ? mine : 1u; nx = cnt > 0u ? cnt : 1u;
}
__device__ __forceinline__ void xcd_barrier(const XcdBarrier& b) {
    asm volatile("s_waitcnt vmcnt(0)" ::: "memory");
    __syncthreads();
    if (threadIdx.x == 0) {
        unsigned* bar = b.bar;
        __builtin_amdgcn_s_waitcnt(0);
        unsigned nloc = b.st[0], nx = b.st[1];
        if (nloc == 0u) { xcd_barrier_complete(bar, b.x, nloc, nx); b.st[0] = nloc; b.st[1] = nx; }
        const unsigned old = xb_add(&bar[XB_XSUB(b.x)], 1u);
        const unsigned gen = old / nloc;
        if (old + 1u == (gen + 1u) * nloc) {
            __builtin_amdgcn_fence(__ATOMIC_RELEASE, "agent");
            asm volatile("s_waitcnt vmcnt(0)" ::: "memory");
            const unsigned og = xb_add(&bar[XB_TOP], 1u);
            const unsigned tg = og / nx;
            if (og + 1u == (tg + 1u) * nx) xb_add(&bar[XB_TOPGEN], 1u);
            else XB_SPIN(xb_ld(&bar[XB_TOPGEN]) == tg, bar);
            __builtin_amdgcn_fence(__ATOMIC_ACQUIRE, "agent");
            xb_add(&bar[XB_XGEN(b.x)], 1u);
            asm volatile("s_waitcnt vmcnt(0)" ::: "memory");
        } else {
            XB_SPIN(xb_ld(&bar[XB_XGEN(b.x)]) == gen, bar);
            __builtin_amdgcn_fence(__ATOMIC_ACQUIRE, "agent");
            asm volatile("s_waitcnt vmcnt(0)" ::: "memory");
        }
    }
    __syncthreads();
}

struct Frame {
    LAS unsigned char* lds;
    volatile LAS unsigned* MISC;
    gu32* ctl;
    int tid, lane, wave;
    int vcu, G;
    float* out; unsigned char* ws;
};
struct Args { const float* in[22]; float* out; unsigned char* ws; int ph_lo, ph_hi, li, pad; };
enum { I_X = 0, I_N1G, I_WIN, I_QNG, I_KNG, I_AOG, I_MU, I_W0, I_W2, I_A0, I_A2, I_G2, I_KK, I_KA, I_RK, I_LNG, I_LNB, I_WOUT, I_N2G, I_WG, I_WU, I_WD };

__device__ __forceinline__ float wave_sum(float v) {
#pragma unroll
    for (int o = 1; o < 64; o <<= 1) v += __shfl_xor(v, o);
    return v;
}
__device__ __forceinline__ float red16(float x) {
    x += __builtin_bit_cast(float, __builtin_amdgcn_update_dpp(0, __builtin_bit_cast(int, x), 0x128, 0xf, 0xf, false));
    x += __builtin_bit_cast(float, __builtin_amdgcn_update_dpp(0, __builtin_bit_cast(int, x), 0x124, 0xf, 0xf, false));
    x += __builtin_bit_cast(float, __builtin_amdgcn_update_dpp(0, __builtin_bit_cast(int, x), 0x122, 0xf, 0xf, false));
    x += __builtin_bit_cast(float, __builtin_amdgcn_update_dpp(0, __builtin_bit_cast(int, x), 0x121, 0xf, 0xf, false));
    return x;
}

constexpr int TR_SCR = 64 * 65 * 4 + 256;
__device__ __forceinline__ int tr_row(int rmode, int n) {
    return rmode == 0 ? n : rmode == 3 ? (n < 1024 ? ((n >> 8) * 256 + ((n >> 5) & 1) * 128 + ((n >> 6) & 3) * 32 + (n & 31)) : n) : ((n >> 7) * 256 + (n & 127) + (rmode == 2 ? 128 : 0));
}
__device__ __forceinline__ void p0_transpose_item(const float* W, int K, int N, bf16* WT, int rmode, LAS float* scr, int item, int lane, const float* ksc = nullptr) {
    const int nblk = N / 64, kb = item / nblk, nb = item % nblk, k0 = 64 * kb, n0 = 64 * nb;
    const int ks = lane >> 4, n4 = (lane & 15) * 4;
    f32x4 v[16];
#pragma unroll
    for (int i = 0; i < 16; ++i) v[i] = *(const GAS f32x4*)((const GAS float*)W + (size_t)(k0 + 4 * i + ks) * N + n0 + n4);
#pragma unroll
    for (int i = 0; i < 16; ++i) { const int kk = 4 * i + ks; const float sc = ksc ? ksc[k0 + kk] : 1.0f;
        scr[kk * 65 + n4 + 0] = v[i].x * sc; scr[kk * 65 + n4 + 1] = v[i].y * sc; scr[kk * 65 + n4 + 2] = v[i].z * sc; scr[kk * 65 + n4 + 3] = v[i].w * sc; }
    LDS_WAIT(); asm volatile("" ::: "memory");
    GAS v4u* dst = (GAS v4u*)(WT + (size_t)tr_row(rmode, n0 + lane) * K + k0);
#pragma unroll
    for (int j = 0; j < 8; ++j) { const LAS float* c = scr + (8 * j) * 65 + lane;
        v4u o; o.x = pk2(c[0 * 65], c[1 * 65]); o.y = pk2(c[2 * 65], c[3 * 65]); o.z = pk2(c[4 * 65], c[5 * 65]); o.w = pk2(c[6 * 65], c[7 * 65]);
        dst[j] = o; }
    LDS_WAIT(); asm volatile("" ::: "memory");
}
template <int NR> __device__ __forceinline__ void rms_rows_to_bf16(int lane, const float* x0, size_t rstride, const float* g, bf16* o0, size_t ostride) {
    const GAS f32x4* gr = (const GAS f32x4*)g + lane;
    f32x4 v[NR][4];
#pragma unroll
    for (int r = 0; r < NR; ++r) { const GAS f32x4* xr = (const GAS f32x4*)(x0 + r * rstride) + lane;
#pragma unroll
        for (int j = 0; j < 4; ++j) v[r][j] = xr[64 * j]; }
    f32x4 gg[4];
#pragma unroll
    for (int j = 0; j < 4; ++j) gg[j] = gr[64 * j];
#pragma unroll
    for (int r = 0; r < NR; ++r) { float s = 0.f;
#pragma unroll
        for (int j = 0; j < 4; ++j) s += (v[r][j].x * v[r][j].x + v[r][j].y * v[r][j].y) + (v[r][j].z * v[r][j].z + v[r][j].w * v[r][j].w);
        const float rstd = 1.f / sqrtf(wave_sum(s) * (1.f / D) + NORM_EPS);
        GAS unsigned long long* o8 = (GAS unsigned long long*)(o0 + r * ostride) + lane;
#pragma unroll
        for (int j = 0; j < 4; ++j)
            o8[64 * j] = (unsigned long long)pk2(v[r][j].x * rstd * gg[j].x, v[r][j].y * rstd * gg[j].y) | ((unsigned long long)pk2(v[r][j].z * rstd * gg[j].z, v[r][j].w * rstd * gg[j].w) << 32); }
}

__device__ __forceinline__ void p0_prologue(Frame& F, const Args& AR) {
    LAS float* scr = (LAS float*)(F.lds + RING_OFF + F.wave * TR_SCR);
    const int gw = F.vcu * NWAVES + F.wave, NGW = F.G * NWAVES;
    bf16* Win_t = (bf16*)(F.ws + WS_WIN); bf16* Wout_t = (bf16*)(F.ws + WS_WOUT); bf16* Wgu_t = (bf16*)(F.ws + WS_WGU); bf16* Wdn_t = (bf16*)(F.ws + WS_WDN); bf16* Wl_t = (bf16*)(F.ws + WS_WL);
    constexpr int I_IN = (D / 64) * (IN_COLS / 64);
    for (int it = gw; it < I_IN; it += NGW) p0_transpose_item(AR.in[I_WIN], D, IN_COLS, Win_t, 3, scr, it, F.lane);
    for (int e = (F.vcu * NWAVES * 64 + F.tid); e < NLORA * KLORA; e += F.G * NWAVES * 64) {
        const int row = e / KLORA, k = e % KLORA, kind = row >> 9, c = row & 511; float v = 0.f;
        if (kind == 0) { if (k < 64) v = AR.in[I_W2][k * 512 + c]; }
        else if (kind == 1) { if (k >= 64 && k < 128) v = AR.in[I_A2][(k - 64) * 512 + c]; }
        else { if (k >= 128) v = AR.in[I_G2][(k - 128) * 512 + c]; }
        Wl_t[e] = (bf16)f2bf(v);
    }
    bf16* XN = (bf16*)(F.ws + WS_XN);
    for (int m = gw * 4; m < M; m += NGW * 4) rms_rows_to_bf16<4>(F.lane, AR.in[I_X] + (size_t)m * D, D, AR.in[I_N1G], XN + (size_t)m * D, D);
}

__device__ __forceinline__ void p2_prep(Frame& F, const Args& AR) {
    const int gw = F.vcu * NWAVES + F.wave, NGW = F.G * NWAVES, lane = F.lane;
    const bf16* PROJ = (const bf16*)(F.ws + WS_PROJ); bf16* A2 = (bf16*)(F.ws + WS_A2);
    const f32x4 mu4 = *(const f32x4*)(AR.in[I_MU] + RC_L + 4 * lane);
    for (int m0 = 4 * gw; m0 < M; m0 += 4 * NGW) {
        const GAS bf16* row = (const GAS bf16*)PROJ + (size_t)m0 * IN_COLS + PC_RW + RC_L + 4 * lane;
        v2u w[5];
        w[0] = (v2u){0u, 0u};
        if ((m0 & (SEQ - 1)) != 0) w[0] = *(const GAS v2u*)(row - IN_COLS);
#pragma unroll
        for (int i = 0; i < 4; ++i) w[i + 1] = *(const GAS v2u*)(row + (size_t)i * IN_COLS);
#pragma unroll
        for (int i = 0; i < 4; ++i) {
            const v2u cu = w[i + 1], pv = w[i];
            const float c4[4] = {bflo(cu.x), bfhi(cu.x), bflo(cu.y), bfhi(cu.y)}, p4[4] = {bflo(pv.x), bfhi(pv.x), bflo(pv.y), bfhi(pv.y)};
            float xs[4];
#pragma unroll
            for (int e = 0; e < 4; ++e) { const float v = c4[e] + (p4[e] - c4[e]) * mu4[e];
                if (lane < 16) { const float t = __builtin_amdgcn_exp2f(2.f * LOG2E * v); xs[e] = 1.f - 2.f * __builtin_amdgcn_rcpf(t + 1.f); }
                else if (lane < 32) xs[e] = v;
                else xs[e] = fsig(v); }
            *(GAS v2u*)(A2 + (size_t)(m0 + i) * KLORA + 4 * lane) = (v2u){pk2(xs[0], xs[1]), pk2(xs[2], xs[3])};
        }
    }
}

constexpr int CS = 16, NCHUNK = SEQ / CS, NHELP = 4, NSTATE = 4, NIT = (NCHUNK + NHELP - 1) / NHELP;
constexpr int ROWB = 144, TILEB = 40;
constexpr int SL_A = 0, SL_R = 16 * ROWB, SL_B = 32 * ROWB, SL_K = 48 * ROWB, SL_V = 64 * ROWB, SL_T = 80 * ROWB, SL_LAK = SL_T + 16 * TILEB, SL_LRB = SL_LAK + 16 * TILEB, SL_LRK = SL_LRB + 16 * TILEB,
              SL_G = SL_LRK + 16 * TILEB, SL_BON = SL_G + 256, SL_INV = SL_BON + 64, SL_BYTES = SL_INV + 64;
static_assert(SL_BYTES % 16 == 0 && SL_T % 8 == 0, "slot alignment");
constexpr int SC_CONST = 2 * NHELP * SL_BYTES;
constexpr int SC_YL = SC_CONST + 6 * 64 * 4, YL_BYTES = NHELP * CS * 256;
constexpr int SC_TS = SC_YL + 2 * YL_BYTES;
static_assert(SC_TS + NSTATE * NHELP * 16 * TILEB <= RING_BYTES && NHELP * CS * 8 == 2 * NSTATE * 64 && NCHUNK % NHELP == 0 && NHELP % 2 == 0, "scan LDS");
struct HReg { v4u r[2], k[2], v[2], pr[2], pk[2], pv[2], e[2], a[2]; };
__device__ __forceinline__ void helper_load(HReg& R, const bf16* PROJ, const bf16* DAG, int tok, int h, int kg) {
    const GAS bf16* row = (const GAS bf16*)PROJ + (size_t)tok * IN_COLS + PC_RW + h * 64 + 16 * kg;
    const GAS bf16* rowp = row - IN_COLS;
    const GAS bf16* dr = (const GAS bf16*)DAG + (size_t)tok * NLORA + h * 64 + 16 * kg;
    asm volatile("" : "+v"(row)); asm volatile("" : "+v"(rowp)); asm volatile("" : "+v"(dr));
    const bool hp = (tok & (SEQ - 1)) != 0;
#pragma unroll
    for (int i = 0; i < 2; ++i) {
        R.r[i] = *(const GAS v4u*)(row + RC_R + 8 * i); R.k[i] = *(const GAS v4u*)(row + RC_K + 8 * i); R.v[i] = *(const GAS v4u*)(row + RC_V + 8 * i);
        if (hp) { R.pr[i] = *(const GAS v4u*)(rowp + RC_R + 8 * i); R.pk[i] = *(const GAS v4u*)(rowp + RC_K + 8 * i); R.pv[i] = *(const GAS v4u*)(rowp + RC_V + 8 * i); }
        else { R.pr[i] = (v4u){0u, 0u, 0u, 0u}; R.pk[i] = R.pr[i]; R.pv[i] = R.pr[i]; }
        R.e[i] = *(const GAS v4u*)(dr + 8 * i); R.a[i] = *(const GAS v4u*)(dr + 512 + 8 * i);
    }
}
__device__ __forceinline__ void unpack4(const unsigned w0, const unsigned w1, float (&x)[4]) { x[0] = bflo(w0); x[1] = bfhi(w0); x[2] = bflo(w1); x[3] = bfhi(w1); }
__device__ __forceinline__ float dpp_shr(float x, const int ctrl_sel) {
    int r;
    if (ctrl_sel == 1) r = __builtin_amdgcn_update_dpp(0, __builtin_bit_cast(int, x), 0x111, 0xf, 0xf, true);
    else if (ctrl_sel == 2) r = __builtin_amdgcn_update_dpp(0, __builtin_bit_cast(int, x), 0x112, 0xf, 0xf, true);
    else if (ctrl_sel == 4) r = __builtin_amdgcn_update_dpp(0, __builtin_bit_cast(int, x), 0x114, 0xf, 0xf, true);
    else r = __builtin_amdgcn_update_dpp(0, __builtin_bit_cast(int, x), 0x118, 0xf, 0xf, true);
    return __builtin_bit_cast(float, r);
}
__device__ __forceinline__ unsigned cvt2s(float lo, float hi) { asm volatile("" : "+v"(lo), "+v"(hi)); return cvt2(lo, hi); }
__device__ __forceinline__ bf16x8 mk8(unsigned a, unsigned b, unsigned c, unsigned d) { return __builtin_bit_cast(bf16x8, (v4u){a, b, c, d}); }
__device__ __forceinline__ bf16x8 accB(const f32x4 v) { return mk8(cvt2(v[0], v[1]), cvt2(v[2], v[3]), 0u, 0u); }
__device__ __forceinline__ v2u trd(const LAS unsigned char* p) { typedef short v4i16_t __attribute__((ext_vector_type(4)));
    return __builtin_bit_cast(v2u, __builtin_amdgcn_ds_read_tr16_b64_v4i16((LAS v4i16_t*)p)); }
#define MFMA16(a, b, c) __builtin_amdgcn_mfma_f32_16x16x32_bf16((a), (b), (c), 0, 0, 0)
#define PIN_PTR(p) asm volatile("" : "+v"(p))

#define HR_UNPACK(dst, arr, gp) do { if ((gp) & 1) unpack4(R.arr[(gp) >> 1].z, R.arr[(gp) >> 1].w, dst); else unpack4(R.arr[(gp) >> 1].x, R.arr[(gp) >> 1].y, dst); } while (0)
__device__ __forceinline__ void helper_chunk(LAS unsigned char* slot, const LAS float* cst, HReg& R, bool prefetch, const bf16* PROJ, const bf16* DAG, float* BON, int tok, int h, int lane) {
    const int t = lane & 15, kg = lane >> 4;
    LAS unsigned char* p_row = slot + t * ROWB + kg * 16;
    LAS unsigned char* p_v = slot + SL_V + t * ROWB + kg * 32;
    LAS unsigned char* p_tw = slot + t * TILEB + kg * 8;
    LAS unsigned char* p_g = slot + SL_G + kg * 16;
    const LAS float* p_c = cst + 16 * kg;
    PIN_PTR(p_row); PIN_PTR(p_v); PIN_PTR(p_tw); PIN_PTR(p_g); PIN_PTR(p_c);
    float E[16], G[16], GI[16], GP[16];
#pragma unroll
    for (int gp = 0; gp < 4; ++gp) { float e[4]; HR_UNPACK(e, e, gp);
#pragma unroll
        for (int i = 0; i < 4; ++i) E[4 * gp + i] = e[i]; }
#pragma unroll
    for (int q = 0; q < 16; ++q) E[q] += dpp_shr(E[q], 1);
#pragma unroll
    for (int q = 0; q < 16; ++q) E[q] += dpp_shr(E[q], 2);
#pragma unroll
    for (int q = 0; q < 16; ++q) E[q] += dpp_shr(E[q], 4);
#pragma unroll
    for (int q = 0; q < 16; ++q) E[q] += dpp_shr(E[q], 8);
#pragma unroll
    for (int q = 0; q < 16; ++q) { G[q] = __builtin_amdgcn_exp2f(LOG2E * E[q]); GI[q] = __builtin_amdgcn_exp2f(-LOG2E * E[q]); }
#pragma unroll
    for (int q = 0; q < 16; ++q) { const float gpv = dpp_shr(G[q], 1); GP[q] = (t == 0) ? 1.f : gpv; }
    if (t == 15) {
#pragma unroll
        for (int gp = 0; gp < 4; ++gp) *(LAS f32x4*)(p_g + gp * 64) = (f32x4){G[4 * gp], G[4 * gp + 1], G[4 * gp + 2], G[4 * gp + 3]};
    }
    float ss = 0.f, bon = 0.f;
#pragma unroll
    for (int gp = 0; gp < 4; ++gp) {
        float r[4], k[4], v[4], pr[4], pk[4], pv[4], a[4];
        HR_UNPACK(r, r, gp); HR_UNPACK(k, k, gp); HR_UNPACK(v, v, gp); HR_UNPACK(pr, pr, gp); HR_UNPACK(pk, pk, gp); HR_UNPACK(pv, pv, gp); HR_UNPACK(a, a, gp);
        const f32x4 mur = *(const LAS f32x4*)(p_c + 0 * 64 + 4 * gp), muk = *(const LAS f32x4*)(p_c + 1 * 64 + 4 * gp), muv = *(const LAS f32x4*)(p_c + 2 * 64 + 4 * gp);
        const f32x4 kkc = *(const LAS f32x4*)(p_c + 3 * 64 + 4 * gp), kac = *(const LAS f32x4*)(p_c + 4 * 64 + 4 * gp), rkc = *(const LAS f32x4*)(p_c + 5 * 64 + 4 * gp);
        float xv[4], At[4], Rt[4], Bt[4], Kt[4];
#pragma unroll
        for (int i = 0; i < 4; ++i) { const int q = 4 * gp + i;
            const float xr = r[i] + (pr[i] - r[i]) * mur[i], xk = k[i] + (pk[i] - k[i]) * muk[i]; xv[i] = v[i] + (pv[i] - v[i]) * muv[i];
            const float kkv = xk * kkc[i], kpv = xk * (1.f + (a[i] - 1.f) * kac[i]); ss += kkv * kkv; bon += xr * kpv * rkc[i];
            At[i] = -kkv * GP[q]; Rt[i] = xr * G[q]; Bt[i] = kkv * a[i] * GI[q]; Kt[i] = kpv * GI[q]; }
        *(LAS v2u*)(p_v + gp * 8) = (v2u){cvt2s(xv[0], xv[1]), cvt2s(xv[2], xv[3])};
        const int co = (gp >> 1) * 64 + (gp & 1) * 8;
        *(LAS v2u*)(p_row + SL_A + co) = (v2u){cvt2s(At[0], At[1]), cvt2s(At[2], At[3])}; *(LAS v2u*)(p_row + SL_R + co) = (v2u){cvt2s(Rt[0], Rt[1]), cvt2s(Rt[2], Rt[3])};
        *(LAS v2u*)(p_row + SL_B + co) = (v2u){cvt2s(Bt[0], Bt[1]), cvt2s(Bt[2], Bt[3])}; *(LAS v2u*)(p_row + SL_K + co) = (v2u){cvt2s(Kt[0], Kt[1]), cvt2s(Kt[2], Kt[3])};
    }
    ss += __shfl_xor(ss, 16); bon += __shfl_xor(bon, 16); ss += __shfl_xor(ss, 32); bon += __shfl_xor(bon, 32);
    const float inv = __builtin_amdgcn_rsqf(fmaxf(ss, 1e-24f));
    if (kg == 0) { *(LAS float*)(slot + SL_BON + t * 4) = bon; *(LAS float*)(slot + SL_INV + t * 4) = inv; }
    if (prefetch) helper_load(R, PROJ, DAG, tok + NHELP * CS, h, kg);
    const bf16x8 FA0 = *(const LAS bf16x8*)(p_row + SL_A), FA1 = *(const LAS bf16x8*)(p_row + SL_A + 64), FR0 = *(const LAS bf16x8*)(p_row + SL_R), FR1 = *(const LAS bf16x8*)(p_row + SL_R + 64);
    const bf16x8 FB0 = *(const LAS bf16x8*)(p_row + SL_B), FB1 = *(const LAS bf16x8*)(p_row + SL_B + 64), FK0 = *(const LAS bf16x8*)(p_row + SL_K), FK1 = *(const LAS bf16x8*)(p_row + SL_K + 64);
    const f32x4 z4 = (f32x4){0.f, 0.f, 0.f, 0.f};
    f32x4 Lab = MFMA16(FA0, FB0, z4); Lab = MFMA16(FA1, FB1, Lab);
    f32x4 Lak = MFMA16(FA0, FK0, z4); Lak = MFMA16(FA1, FK1, Lak);
    f32x4 Lrb = MFMA16(FR0, FB0, z4); Lrb = MFMA16(FR1, FB1, Lrb);
    f32x4 Lrk = MFMA16(FR0, FK0, z4); Lrk = MFMA16(FR1, FK1, Lrk);
    const int s = t;
#pragma unroll
    for (int r = 0; r < 4; ++r) { const int tt = 4 * kg + r;
        Lab[r] = tt > s ? Lab[r] : 0.f; Lak[r] = tt > s ? Lak[r] : 0.f; Lrb[r] = tt >= s ? Lrb[r] : 0.f; Lrk[r] = tt >= s ? Lrk[r] : 0.f; }
    { const f32x4 ir = *(const LAS f32x4*)(slot + SL_INV + 16 * kg);
      Lab = Lab * ir * inv; }
#define WR_TILE(off, X) (*(LAS v2u*)(p_tw + (off)) = (v2u){cvt2((X)[0], (X)[1]), cvt2((X)[2], (X)[3])})
    WR_TILE(SL_LAK, Lak); WR_TILE(SL_LRB, Lrb); WR_TILE(SL_LRK, Lrk); WR_TILE(SL_T, Lab);
#undef WR_TILE
}

struct SOps { bf16x8 a0, a1, r0, r1; v2u vt, lak, lrb, lrk, bb[4], kk2[4]; f32x4 gm[4], bn, iv; };
__device__ __forceinline__ void state_load(SOps& O, const LAS unsigned char* slot, int lane, int wv) {
    const int c = lane & 15, g = lane >> 4, q4 = 4 * g + (c >> 2), pp = c & 3;
    const LAS unsigned char* p128 = slot + c * ROWB + g * 16;
    const LAS unsigned char* p_bt = slot + q4 * ROWB + pp * 16;
    const LAS unsigned char* p_tr = slot + q4 * TILEB + pp * 8;
    const LAS unsigned char* p_v = slot + SL_V + q4 * ROWB + wv * 32 + pp * 8;
    const LAS unsigned char* pg = slot + SL_G + g * 16;
    PIN_PTR(p128); PIN_PTR(p_bt); PIN_PTR(p_tr); PIN_PTR(p_v); PIN_PTR(pg);
    O.a0 = *(const LAS bf16x8*)(p128 + SL_A); O.a1 = *(const LAS bf16x8*)(p128 + SL_A + 64); O.r0 = *(const LAS bf16x8*)(p128 + SL_R); O.r1 = *(const LAS bf16x8*)(p128 + SL_R + 64);
    O.vt = trd(p_v); O.lak = trd(p_tr + SL_LAK); O.lrb = trd(p_tr + SL_LRB); O.lrk = trd(p_tr + SL_LRK);
#pragma unroll
    for (int jb = 0; jb < 4; ++jb) { O.bb[jb] = trd(p_bt + SL_B + (jb >> 1) * 64 + (jb & 1) * 8); O.kk2[jb] = trd(p_bt + SL_K + (jb >> 1) * 64 + (jb & 1) * 8); O.gm[jb] = *(const LAS f32x4*)(pg + jb * 64); }
    O.bn = *(const LAS f32x4*)(slot + SL_BON + 16 * g); O.iv = *(const LAS f32x4*)(slot + SL_INV + 16 * g);
}
__device__ __forceinline__ void state_compute(const SOps& O, const v2u tt, f32x4 (&X)[4], LAS unsigned char* yl, int lane, int wv) {
    const int c = lane & 15, g = lane >> 4;
    const f32x4 z4 = (f32x4){0.f, 0.f, 0.f, 0.f};
    const bf16x8 xb0 = mk8(cvt2(X[0][0], X[0][1]), cvt2(X[0][2], X[0][3]), cvt2(X[1][0], X[1][1]), cvt2(X[1][2], X[1][3]));
    const bf16x8 xb1 = mk8(cvt2(X[2][0], X[2][1]), cvt2(X[2][2], X[2][3]), cvt2(X[3][0], X[3][1]), cvt2(X[3][2], X[3][3]));
    f32x4 Z = MFMA16(O.a0, xb0, z4); Z = MFMA16(O.a1, xb1, Z); Z = MFMA16(mk8(O.lak.x, O.lak.y, 0u, 0u), mk8(O.vt.x, O.vt.y, 0u, 0u), Z) * O.iv;
    const f32x4 U = MFMA16(mk8(tt.x, tt.y, 0u, 0u), accB(Z), z4) * O.iv;
    const bf16x8 uv = mk8(cvt2(U[0], U[1]), cvt2(U[2], U[3]), O.vt.x, O.vt.y);
    f32x4 Y = MFMA16(O.r0, xb0, z4); Y = MFMA16(O.r1, xb1, Y); Y = MFMA16(mk8(O.lrb.x, O.lrb.y, O.lrk.x, O.lrk.y), uv, Y);
#pragma unroll
    for (int jb = 0; jb < 4; ++jb) X[jb] = MFMA16(mk8(O.bb[jb].x, O.bb[jb].y, O.kk2[jb].x, O.kk2[jb].y), uv, X[jb]) * O.gm[jb];
    LAS unsigned char* py = yl + (4 * g) * 256 + (16 * wv + c) * 2;
    PIN_PTR(py);
    const float vv[4] = {bflo(O.vt.x), bfhi(O.vt.x), bflo(O.vt.y), bfhi(O.vt.y)};
#pragma unroll
    for (int r = 0; r < 4; ++r) { *(LAS unsigned short*)(py + r * 256) = (unsigned short)f2bf(Y[r]); *(LAS unsigned short*)(py + r * 256 + 128) = (unsigned short)f2bf(O.bn[r] * vv[r]); }
}
__device__ __forceinline__ void state_T(v2u (&tt)[NHELP], const LAS unsigned char* set0, LAS unsigned char* scr, int lane) {
    const int c = lane & 15, g = lane >> 4;
    const int o_w = c * TILEB + g * 8, o_r = (4 * g + (c >> 2)) * TILEB + (c & 3) * 8;
    const f32x4 z4 = (f32x4){0.f, 0.f, 0.f, 0.f};
    bf16x8 A1[NHELP], A2[NHELP], A4[NHELP]; f32x4 P[NHELP];
#pragma unroll
    for (int k = 0; k < NHELP; ++k) { const LAS unsigned char* tl = set0 + k * SL_BYTES + SL_T;
        const v2u bl = *(const LAS v2u*)(tl + o_w), al = trd(tl + o_r); A1[k] = mk8(al.x, al.y, 0u, 0u); P[k] = MFMA16(A1[k], mk8(bl.x, bl.y, 0u, 0u), z4); }
#pragma unroll
    for (int k = 0; k < NHELP; ++k) *(LAS v2u*)(scr + k * (16 * TILEB) + o_w) = (v2u){cvt2(P[k][0], P[k][1]), cvt2(P[k][2], P[k][3])};
#pragma unroll
    for (int k = 0; k < NHELP; ++k) { const v2u al = trd(scr + k * (16 * TILEB) + o_r); A2[k] = mk8(al.x, al.y, 0u, 0u); P[k] = MFMA16(A2[k], accB(P[k]), z4); }
#pragma unroll
    for (int k = 0; k < NHELP; ++k) *(LAS v2u*)(scr + k * (16 * TILEB) + o_w) = (v2u){cvt2(P[k][0], P[k][1]), cvt2(P[k][2], P[k][3])};
#pragma unroll
    for (int k = 0; k < NHELP; ++k) { const v2u al = trd(scr + k * (16 * TILEB) + o_r); A4[k] = mk8(al.x, al.y, 0u, 0u); P[k] = MFMA16(A4[k], accB(P[k]), z4); }
#pragma unroll
    for (int k = 0; k < NHELP; ++k) {
#pragma unroll
        for (int r = 0; r < 4; ++r) P[k][r] += (4 * g + r == c) ? 1.f : 0.f; }
#pragma unroll
    for (int k = 0; k < NHELP; ++k) P[k] = MFMA16(A4[k], accB(P[k]), P[k]);
#pragma unroll
    for (int k = 0; k < NHELP; ++k) P[k] = MFMA16(A2[k], accB(P[k]), P[k]);
#pragma unroll
    for (int k = 0; k < NHELP; ++k) P[k] = MFMA16(A1[k], accB(P[k]), P[k]);
#pragma unroll
    for (int k = 0; k < NHELP; ++k) *(LAS v2u*)(scr + k * (16 * TILEB) + o_w) = (v2u){cvt2(P[k][0], P[k][1]), cvt2(P[k][2], P[k][3])};
#pragma unroll
    for (int k = 0; k < NHELP; ++k) tt[k] = trd(scr + k * (16 * TILEB) + o_r);
}

__device__ __forceinline__ void p4_scan(Frame& F, const Args& AR) {
    const bf16* PROJ = (const bf16*)(F.ws + WS_PROJ); const bf16* DAG = (const bf16*)(F.ws + WS_DAG);
    float* BON = nullptr; bf16* MIX = (bf16*)(F.ws + WS_XN);
    LAS unsigned char* lds = F.lds + RING_OFF;
    LAS float* cst = (LAS float*)(lds + SC_CONST);
    const int tid = F.tid, lane = F.lane, wave = F.wave;
    for (int unit = blockIdx.x; unit < BATCH * NH; unit += F.G) {
        const int b = unit >> 3, h = unit & 7;
        const int tok0 = b * SEQ;
        if (tid < 384) { const int a = tid >> 6, c = tid & 63; const float* src = a == 0 ? AR.in[I_MU] + RC_R : a == 1 ? AR.in[I_MU] + RC_K : a == 2 ? AR.in[I_MU] + RC_V : a == 3 ? AR.in[I_KK] : a == 4 ? AR.in[I_KA] : AR.in[I_RK];
            cst[a * 64 + c] = src[h * 64 + c]; }
        __syncthreads();
        const int st_k = (tid >> 7) & 1, st_t = (tid >> 3) & 15, st_p = tid & 7;
        GAS v4u* ystore = (GAS v4u*)((GAS bf16*)MIX + (size_t)(tok0 + st_k * CS + st_t) * D + AW + h * 64 + 8 * st_p);
        const GAS v4u* gload = (const GAS v4u*)((const GAS bf16*)DAG + (size_t)(tok0 + st_k * CS + st_t) * NLORA + 1024 + h * 64 + 8 * st_p);
        const LAS unsigned char* yl_rd = lds + SC_YL + st_k * (CS * 256) + st_t * 256 + st_p * 16;
        v4u gnA = (v4u){0u, 0u, 0u, 0u}, gnB = gnA;
        float lng[8], lnb[8];
#pragma unroll
        for (int i = 0; i < 8; ++i) { lng[i] = AR.in[I_LNG][h * 64 + 8 * st_p + i]; lnb[i] = AR.in[I_LNB][h * 64 + 8 * st_p + i]; }
#define RWKV_OUT(it_, KO, gnext) do { if ((it_) >= 2 && NHELP * ((it_) - 2) + st_k + (KO) < NCHUNK) { \
            const v4u gw4 = gnext; \
            const v4u yw = *(const LAS v4u*)(yl_rd + (KO) * (CS * 256) + ((it_) & 1) * YL_BYTES), bw = *(const LAS v4u*)(yl_rd + (KO) * (CS * 256) + ((it_) & 1) * YL_BYTES + 128); \
            float y[8] = {bflo(yw.x), bfhi(yw.x), bflo(yw.y), bfhi(yw.y), bflo(yw.z), bfhi(yw.z), bflo(yw.w), bfhi(yw.w)}; \
            float sm = ((y[0] + y[1]) + (y[2] + y[3])) + ((y[4] + y[5]) + (y[6] + y[7])); \
            sm += __shfl_xor(sm, 1); sm += __shfl_xor(sm, 2); sm += __shfl_xor(sm, 4); \
            const float mean = sm * (1.f / 64.f); float sv = 0.f; \
            _Pragma("unroll") for (int i = 0; i < 8; ++i) { y[i] -= mean; sv += y[i] * y[i]; } \
            sv += __shfl_xor(sv, 1); sv += __shfl_xor(sv, 2); sv += __shfl_xor(sv, 4); \
            const float rs = 1.f / sqrtf(sv * (1.f / 64.f) + LNX_EPS); \
            const float bf_[8] = {bflo(bw.x), bfhi(bw.x), bflo(bw.y), bfhi(bw.y), bflo(bw.z), bfhi(bw.z), bflo(bw.w), bfhi(bw.w)}; \
            const float gf[8] = {bflo(gw4.x), bfhi(gw4.x), bflo(gw4.y), bfhi(gw4.y), bflo(gw4.z), bfhi(gw4.z), bflo(gw4.w), bfhi(gw4.w)}; \
            float ro[8]; \
            _Pragma("unroll") for (int i = 0; i < 8; ++i) ro[i] = (y[i] * rs * lng[i] + lnb[i] + bf_[i]) * gf[i]; \
            ystore[(size_t)(NHELP * ((it_) - 2) + (KO)) * CS * D / 8] = (v4u){pk2(ro[0], ro[1]), pk2(ro[2], ro[3]), pk2(ro[4], ro[5]), pk2(ro[6], ro[7])}; } \
            if ((it_) >= 1 && NHELP * ((it_) - 1) + st_k + (KO) < NCHUNK) gnext = gload[(size_t)(NHELP * ((it_) - 1) + (KO)) * CS * NLORA / 8]; } while (0)
        if (wave >= NSTATE) {
            const int hw = wave - NSTATE, kg = lane >> 4, tokl = tok0 + (lane & 15);
            HReg R;
            helper_load(R, PROJ, DAG, tokl + hw * CS, h, kg);
            unsigned long long pa_ = 0, pb_ = 0;
            for (int it = 0; it <= NIT + 1; ++it) {
                const unsigned long long q0_ = PROBE_SEL >= 30 ? __builtin_amdgcn_s_memtime() : 0ull;
                const int ch = NHELP * it + hw;
                if (ch < NCHUNK) helper_chunk(lds + ((it & 1) * NHELP + hw) * SL_BYTES, cst, R, ch + NHELP < NCHUNK, PROJ, DAG, BON, tokl + ch * CS, h, lane);
                const unsigned long long q1_ = PROBE_SEL >= 30 ? __builtin_amdgcn_s_memtime() : 0ull;
                __syncthreads();
                if (PROBE_SEL >= 30) { const unsigned long long q2_ = __builtin_amdgcn_s_memtime(); pa_ += q1_ - q0_; pb_ += q2_ - q1_; }
            }
            if (PROBE_SEL >= 30 && blockIdx.x == 0 && tid == NSTATE * 64) { __hip_atomic_store(F.ctl + 9130, (unsigned)(pa_ >> 4), RLX_AGENT); __hip_atomic_store(F.ctl + 9131, (unsigned)(pb_ >> 4), RLX_AGENT); }
        } else {
            f32x4 X[4];
#pragma unroll
            for (int jb = 0; jb < 4; ++jb) X[jb] = (f32x4){0.f, 0.f, 0.f, 0.f};
            unsigned long long pa_ = 0, pb_ = 0;
            for (int it = 0; it <= NIT + 1; ++it) {
                const unsigned long long q0_ = PROBE_SEL >= 30 ? __builtin_amdgcn_s_memtime() : 0ull;
                RWKV_OUT(it, 0, gnA); RWKV_OUT(it, 2, gnB);
                if (it > 0 && NHELP * (it - 1) < NCHUNK) {
                    const LAS unsigned char* set0 = lds + (((it - 1) & 1) * NHELP) * SL_BYTES;
                    LAS unsigned char* ylb = lds + SC_YL + ((it - 1) & 1) * YL_BYTES;
                    v2u tt[NHELP];
                    SOps Oa, Ob;
                    state_load(Oa, set0, lane, wave);
                    state_T(tt, set0, lds + SC_TS + wave * (NHELP * 16 * TILEB), lane);
#pragma unroll
                    for (int k = 0; k < NHELP; k += 2) {
                        state_load(Ob, set0 + (k + 1) * SL_BYTES, lane, wave);
                        state_compute(Oa, tt[k], X, ylb + k * (CS * 256), lane, wave);
                        if (k + 2 < NHELP) state_load(Oa, set0 + (k + 2) * SL_BYTES, lane, wave);
                        state_compute(Ob, tt[k + 1], X, ylb + (k + 1) * (CS * 256), lane, wave);
                    }
                }
                const unsigned long long q1_ = PROBE_SEL >= 30 ? __builtin_amdgcn_s_memtime() : 0ull;
                __syncthreads();
                if (PROBE_SEL >= 30) { const unsigned long long q2_ = __builtin_amdgcn_s_memtime(); pa_ += q1_ - q0_; pb_ += q2_ - q1_; }
            }
            if (PROBE_SEL >= 30 && blockIdx.x == 0 && tid == 0) { __hip_atomic_store(F.ctl + 9132, (unsigned)(pa_ >> 4), RLX_AGENT); __hip_atomic_store(F.ctl + 9133, (unsigned)(pb_ >> 4), RLX_AGENT); }
            __builtin_amdgcn_s_setprio(0);
        }
        __syncthreads();
    }
}

__device__ __forceinline__ s16x4 vtr(const LAS unsigned char* p) { typedef short v4i16_t __attribute__((ext_vector_type(4)));
    return __builtin_bit_cast(s16x4, __builtin_amdgcn_ds_read_tr16_b64_v4i16((LAS v4i16_t*)p)); }
constexpr int ATT_UNITS = 3 * BATCH * NH * 16;
__device__ __forceinline__ void p4_attn(Frame& F, const Args& AR) {
    const bf16* PROJ = (const bf16*)(F.ws + WS_PROJ);
    bf16* PO = (bf16*)((unsigned char*)F.out + DO_PO); float* ML = (float*)(F.ws + WS_ML);
    const int tid = F.tid, lane = F.lane, wave = F.wave, half = wave >> 2, wq = wave & 3, th = tid & 255;
    const int r32 = lane & 31, hi = lane >> 5;
    LAS unsigned char* Kl = F.lds + RING_OFF + half * 65536; LAS unsigned char* Vl = Kl + 32768;
    gu32* qctr = F.ctl + CW_ATTQ;
    v4u kst[8], vst[8];
#define ATT_DECODE(up_) const int unit = 2 * (up_) + half; \
        const int pat = unit / (BATCH * NH * 16), rem = unit % (BATCH * NH * 16), bh = rem >> 4, i16 = rem & 15, b = bh >> 3, h = bh & 7; \
        const int dil = pat == 0 ? 1 : (pat == 1 ? 4 : 16); \
        const int res = pat == 0 ? 0 : (pat == 1 ? (i16 >> 2) : i16); \
        const int n = pat == 0 ? i16 : (pat == 1 ? (i16 & 3) : 0); \
        const size_t rowb = (size_t)b * SEQ;
#define ATT_ISSUE(up_) do { ATT_DECODE(up_) const int c = th & 7; \
        _Pragma("unroll") for (int i = 0; i < 8; ++i) { const int key = (th >> 3) + 32 * i; const int sub = 128 * (n - 1) + key; \
            kst[i] = (v4u){0u, 0u, 0u, 0u}; vst[i] = kst[i]; \
            if (sub >= 0) { const GAS bf16* src = (const GAS bf16*)PROJ + (rowb + res + dil * sub) * IN_COLS + h * 64 + 8 * c; kst[i] = *(const GAS v4u*)(src + PC_K); vst[i] = *(const GAS v4u*)(src + PC_V); } } } while (0)
    if (tid == 0) F.MISC[16] = __hip_atomic_fetch_add(qctr, 1u, RLX_AGENT);
    __syncthreads();
    int up = (int)F.MISC[16];
    __syncthreads();
    if (up < ATT_UNITS / 2) ATT_ISSUE(up);
    while (up < ATT_UNITS / 2) {
        if (tid == 0) F.MISC[16] = __hip_atomic_fetch_add(qctr, 1u, RLX_AGENT);
        ATT_DECODE(up)
        const int ql = 32 * wq + r32; const size_t qrow = rowb + res + dil * (128 * n + ql);
        bf16x8 qf[4];
#pragma unroll
        for (int d0 = 0; d0 < 4; ++d0) qf[d0] = *(const GAS bf16x8*)((const GAS bf16*)PROJ + qrow * IN_COLS + PC_Q + h * 64 + 16 * d0 + 8 * hi);
        {
            const int c = th & 7;
#pragma unroll
            for (int i = 0; i < 8; ++i) {
                const int key = (th >> 3) + 32 * i;
                *(LAS v4u*)(Kl + key * 128 + ((c ^ ((key >> 1) & 7)) * 16)) = kst[i];
                *(LAS v4u*)(Vl + (c >> 2) * 16384 + key * 64 + (c & 3) * 16) = vst[i];
            }
        }
        __syncthreads();
        const int upn = (int)F.MISC[16];
        if (upn < ATT_UNITS / 2) { ATT_ISSUE(upn); }
        const float slope2 = __builtin_amdgcn_exp2f(-(float)(h + 1)) * (float)dil * LOG2E;
        const int thr = r32 - 4 * hi;
        f32x16 sc[5];
        float mx = -INFINITY;
#pragma unroll
        for (int kt = 0; kt < 5; ++kt) {
            const bool skip = (n == 0) && (wq + kt < 4);
            f32x16 acc;
            if (!skip) {
                const int key = 32 * (wq + kt) + r32;
                const float bk = -slope2 * (float)(128 - 32 * kt + thr);
#pragma unroll
                for (int r = 0; r < 16; ++r) acc[r] = slope2 * (float)((r & 3) + 8 * (r >> 2)) + bk;
#pragma unroll
                for (int d0 = 0; d0 < 4; ++d0) {
                    const bf16x8 kf = *(const LAS bf16x8*)(Kl + key * 128 + (((2 * d0 + hi) ^ ((key >> 1) & 7)) * 16));
                    acc = __builtin_amdgcn_mfma_f32_32x32x16_bf16(kf, qf[d0], acc, 0, 0, 0);
                }
                if (kt == 0) {
#pragma unroll
                    for (int r = 0; r < 16; ++r) acc[r] = ((r & 3) + 8 * (r >> 2)) >= thr ? acc[r] : -INFINITY;
                }
                if (kt == 4) {
#pragma unroll
                    for (int r = 0; r < 16; ++r) acc[r] = ((r & 3) + 8 * (r >> 2)) <= thr ? acc[r] : -INFINITY;
                }
#pragma unroll
                for (int r = 0; r < 16; ++r) mx = fmaxf(mx, acc[r]);
            } else {
#pragma unroll
                for (int r = 0; r < 16; ++r) acc[r] = -INFINITY;
            }
            sc[kt] = acc;
            __builtin_amdgcn_sched_barrier(0);
        }
        mx = fmaxf(mx, __shfl_xor(mx, 32));
        float l = 0.f;
#pragma unroll
        for (int kt = 0; kt < 5; ++kt)
#pragma unroll
            for (int r = 0; r < 16; ++r) { const float p = __builtin_amdgcn_exp2f(sc[kt][r] - mx); sc[kt][r] = p; l += p; }
        l += __shfl_xor(l, 32);
        f32x16 o[2]; o[0] = f32x16{}; o[1] = f32x16{};
        const int voff = ((lane >> 4) & 1) * 32 + (lane & 3) * 8 + (4 * hi + ((lane & 15) >> 2)) * 64;
#pragma unroll
        for (int kt = 0; kt < 5; ++kt) {
            const bool skip = (n == 0) && (wq + kt < 4);
            if (!skip) {
#pragma unroll
            for (int s2 = 0; s2 < 2; ++s2) {
                v4u pw;
                pw.x = pg8::cvt_pk_bf16(sc[kt][8 * s2 + 0], sc[kt][8 * s2 + 1]); pw.y = pg8::cvt_pk_bf16(sc[kt][8 * s2 + 2], sc[kt][8 * s2 + 3]);
                pw.z = pg8::cvt_pk_bf16(sc[kt][8 * s2 + 4], sc[kt][8 * s2 + 5]); pw.w = pg8::cvt_pk_bf16(sc[kt][8 * s2 + 6], sc[kt][8 * s2 + 7]);
                const bf16x8 pf = __builtin_bit_cast(bf16x8, pw);
                const int kb = 32 * (wq + kt) + 16 * s2;
#pragma unroll
                for (int dt = 0; dt < 2; ++dt) {
                    const LAS unsigned char* vp = Vl + dt * 16384 + kb * 64 + voff;
                    const s16x4 lo = vtr(vp), hi4 = vtr(vp + 8 * 64);
                    const bf16x8 vf = (bf16x8){lo[0], lo[1], lo[2], lo[3], hi4[0], hi4[1], hi4[2], hi4[3]};
                    o[dt] = __builtin_amdgcn_mfma_f32_32x32x16_bf16(vf, pf, o[dt], 0, 0, 0);
                }
            }
            }
        }
        const float rl = 1.f / l;
        bf16* po = PO + ((size_t)pat * M + qrow) * AW + h * 64;
#pragma unroll
        for (int dt = 0; dt < 2; ++dt)
#pragma unroll
            for (int g = 0; g < 4; ++g) {
                const v2u w = (v2u){pk2(o[dt][4 * g] * rl, o[dt][4 * g + 1] * rl), pk2(o[dt][4 * g + 2] * rl, o[dt][4 * g + 3] * rl)};
                *(v2u*)(po + 32 * dt + 8 * g + 4 * hi) = w;
            }
        if (hi == 0) *(f32x2*)(ML + (((size_t)pat * M + qrow) * NH + h) * 2) = (f32x2){mx, l};
        __syncthreads();
        up = upn;
    }
#undef ATT_DECODE
#undef ATT_ISSUE
}

struct P5In { v4u po[3]; f32x2 ml[3]; };
__device__ __forceinline__ void p5_load(P5In& I, int m, int lane, const bf16* PO, const float* ML) {
    const int hd = lane >> 3;
#pragma unroll
    for (int p = 0; p < 3; ++p) { I.ml[p] = *(const GAS f32x2*)(ML + (((size_t)p * M + m) * NH + hd) * 2); I.po[p] = *(const GAS v4u*)(PO + ((size_t)p * M + m) * AW + 8 * lane); }
}
__device__ __forceinline__ void p5_token(const P5In& I, int m, int lane, bf16* MIX, const float (&aog)[8]) {
    const float mm = fmaxf(fmaxf(I.ml[0].x, I.ml[1].x), I.ml[2].x);
    float wp[3], wsum = 0.f;
#pragma unroll
    for (int p = 0; p < 3; ++p) { wp[p] = __builtin_amdgcn_exp2f(I.ml[p].x - mm) * I.ml[p].y; wsum += wp[p]; }
    const float rws = 1.f / wsum;
    float at[8] = {0.f, 0.f, 0.f, 0.f, 0.f, 0.f, 0.f, 0.f};
#pragma unroll
    for (int p = 0; p < 3; ++p) { const v4u w = I.po[p]; const float f = wp[p] * rws;
        at[0] += f * bflo(w.x); at[1] += f * bfhi(w.x); at[2] += f * bflo(w.y); at[3] += f * bfhi(w.y); at[4] += f * bflo(w.z); at[5] += f * bfhi(w.z); at[6] += f * bflo(w.w); at[7] += f * bfhi(w.w); }
    float ss = 0.f;
#pragma unroll
    for (int i = 0; i < 8; ++i) ss += at[i] * at[i];
    ss += __shfl_xor(ss, 1); ss += __shfl_xor(ss, 2); ss += __shfl_xor(ss, 4);
    const float rstd = 1.f / sqrtf(ss * (1.f / 64.f) + NORM_EPS);
    v4u oa; oa.x = pk2(at[0] * rstd * aog[0], at[1] * rstd * aog[1]); oa.y = pk2(at[2] * rstd * aog[2], at[3] * rstd * aog[3]);
    oa.z = pk2(at[4] * rstd * aog[4], at[5] * rstd * aog[5]); oa.w = pk2(at[6] * rstd * aog[6], at[7] * rstd * aog[7]);
    *(GAS v4u*)(MIX + (size_t)m * D + 8 * lane) = oa;
}
__device__ __forceinline__ void p5_post(Frame& F, const Args& AR) {
    const int gw = F.vcu * NWAVES + F.wave, NGW = F.G * NWAVES, lane = F.lane;
    const bf16* PO = (const bf16*)((unsigned char*)F.out + DO_PO); const float* ML = (const float*)(F.ws + WS_ML);
    bf16* MIX = (bf16*)(F.ws + WS_XN);
    float aog[8];
#pragma unroll
    for (int i = 0; i < 8; ++i) aog[i] = AR.in[I_AOG][8 * lane + i];
    static_assert(M % 4 == 0, "four tokens per step");
    for (int m = 4 * gw; m < M; m += 4 * NGW) {
        P5In A, B, C, E;
        p5_load(A, m, lane, PO, ML); p5_load(B, m + 1, lane, PO, ML); p5_load(C, m + 2, lane, PO, ML); p5_load(E, m + 3, lane, PO, ML);
        p5_token(A, m, lane, MIX, aog); p5_token(B, m + 1, lane, MIX, aog); p5_token(C, m + 2, lane, MIX, aog); p5_token(E, m + 3, lane, MIX, aog);
    }
}

__device__ __forceinline__ void p1_tail_weights(Frame& F, const Args& AR, int w0, int nw) {
    LAS float* scr = (LAS float*)(F.lds + RING_OFF + F.wave * TR_SCR);
    bf16* Wout_t = (bf16*)(F.ws + WS_WOUT); bf16* Wgu_t = (bf16*)(F.ws + WS_WGU); bf16* Wdn_t = (bf16*)(F.ws + WS_WDN);
    constexpr int I_OUT = (D / 64) * (D / 64), I_G = (D / 64) * (FF / 64), I_DN = (FF / 64) * (D / 64), NLATE = I_OUT + 2 * I_G + I_DN;
    for (int it = w0; it < NLATE; it += nw) {
        int r = it;
        if (r < I_OUT) { p0_transpose_item(AR.in[I_WOUT], D, D, Wout_t, 0, scr, r, F.lane); continue; } r -= I_OUT;
        if (r < I_G) { p0_transpose_item(AR.in[I_WG], D, FF, Wgu_t, 1, scr, r, F.lane, AR.in[I_N2G]); continue; } r -= I_G;
        if (r < I_G) { p0_transpose_item(AR.in[I_WU], D, FF, Wgu_t, 2, scr, r, F.lane, AR.in[I_N2G]); continue; } r -= I_G;
        p0_transpose_item(AR.in[I_WD], FF, D, Wdn_t, 0, scr, r, F.lane);
    }
}

__global__ void __launch_bounds__(NWAVES * 64, 2) hybrid_fwd(Args args) {
    extern __shared__ __attribute__((aligned(16))) unsigned char lds[];
    Frame F;
    F.lds = (LAS unsigned char*)lds;
    F.MISC = (volatile LAS unsigned*)(F.lds + MISC_OFF);
    F.tid = threadIdx.x; F.lane = F.tid & 63; F.wave = __builtin_amdgcn_readfirstlane(F.tid >> 6);
    F.G = gridDim.x; { const int bx = blockIdx.x; F.vcu = (F.G % 8 == 0) ? (bx % 8) * (F.G / 8) + bx / 8 : bx; }
    F.ws = args.ws; F.out = args.out;
    F.ctl = (gu32*)(args.ws + WS_CTL);
    for (int u = F.tid; u < (LDS_BYTES - LDSCTL_OFF) / 4; u += NWAVES * 64) ((LAS unsigned*)(F.lds + LDSCTL_OFF))[u] = 0u;
    __syncthreads();
    XcdBarrier bar; bar.bar = (unsigned*)(F.ctl + CW_BAR); bar.x = 0; bar.st = nullptr;
    if (N_LAUNCHES != PER_PHASE) bar = xcd_barrier_post((unsigned*)(F.ctl + CW_BAR), F.MISC + 8);
#define GRID_BAR() do { if (N_LAUNCHES != PER_PHASE) xcd_barrier(bar); } while (0)
    const int lo = args.ph_lo, hi = args.ph_hi;
#ifndef PHMASK
#define PHMASK 0x3ff
#endif
#define IN(k) (((PHMASK >> (k)) & 1) && lo <= (k) && (k) < hi)
#define BOTH(k) (IN(k) && IN((k) + 1))
#define PSTAMP(i) do { if (PROBE_SEL >= 0 && blockIdx.x == 0 && F.tid == 0) { const unsigned long long t_ = __builtin_amdgcn_s_memtime(); __hip_atomic_store(F.ctl + 9100 + (i), (unsigned)(t_ >> 4), RLX_AGENT); } } while (0)
#ifndef REPMASK
#define REPMASK 0
#endif
#define REP(k) for (int rep_ = 0; rep_ <= ((REPMASK >> (k)) & 1); ++rep_)
    bf16* XN = (bf16*)(args.ws + WS_XN); bf16* PROJ = (bf16*)(args.ws + WS_PROJ);

    PSTAMP(0);
    if (IN(0)) { p0_prologue(F, args); if (BOTH(0)) GRID_BAR(); }
    PSTAMP(1);
    if (IN(1)) {
        pg8::Gemm g{XN, (const bf16*)(args.ws + WS_WIN), M, IN_COLS, D}; pg8::StaticOrder S; S.init(M, IN_COLS, F.G, (int)blockIdx.x);
        pg8::EpiProj E{PROJ, IN_COLS, args.in[I_QNG], args.in[I_KNG]};
        pg8::gemm_phase<pg8::EpiProj, pg8::StaticOrder, true, true>(F.lds + RING_OFF, g, S, E);
        { const int nu = (M / 256) * (IN_COLS / 256), rem = nu % F.G;
          if (rem == 0) p1_tail_weights(F, args, (int)blockIdx.x * NWAVES + F.wave, F.G * NWAVES);
          else if ((int)blockIdx.x >= rem) p1_tail_weights(F, args, ((int)blockIdx.x - rem) * NWAVES + F.wave, (F.G - rem) * NWAVES); }
        if (BOTH(1)) GRID_BAR();
    }
    PSTAMP(2);
    if (IN(2)) { p2_prep(F, args); if (BOTH(2)) GRID_BAR(); }
    PSTAMP(3);
    if (IN(3)) {
        pg8::Gemm g{(const bf16*)(args.ws + WS_A2), (const bf16*)(args.ws + WS_WL), M, NLORA, KLORA}; pg8::StaticOrder S; S.init(M, NLORA, F.G, (int)blockIdx.x);
        pg8::EpiLora E{(bf16*)(args.ws + WS_DAG), NLORA, args.in[I_W0], args.in[I_A0]};
        pg8::gemm_phase<pg8::EpiLora, pg8::StaticOrder, true, true>(F.lds + RING_OFF, g, S, E);
        if (BOTH(3)) GRID_BAR();
    }
    PSTAMP(4);
    if (IN(4)) { p4_scan(F, args); PSTAMP(11); p4_attn(F, args); PSTAMP(12); if (BOTH(4)) GRID_BAR(); }
    PSTAMP(5);
    if (IN(5)) { p5_post(F, args); if (BOTH(5)) GRID_BAR(); }
    PSTAMP(6);
    if (IN(6)) {
        pg8::Gemm g{XN, (const bf16*)(args.ws + WS_WOUT), M, D, D}; pg8::StaticOrder S; S.init(M, D, F.G, (int)blockIdx.x);
        pg8::EpiOut E{args.in[I_X], (bf16*)(args.ws + WS_DAG), (float*)(args.ws + WS_SS), D, (LAS float*)(F.lds + RING_OFF + 131072)};
        pg8::gemm_phase<pg8::EpiOut, pg8::StaticOrder, true, true>(F.lds + RING_OFF, g, S, E);
        if (IN(8)) GRID_BAR();
    }
    PSTAMP(8);
    if (IN(8)) {
        pg8::Gemm g{(const bf16*)(args.ws + WS_DAG), (const bf16*)(args.ws + WS_WGU), M, NGU, D}; pg8::StaticOrder S; S.init(M, NGU, F.G, (int)blockIdx.x);
        pg8::EpiSwiglu E{PROJ, FF, (const float*)(args.ws + WS_SS)};
        pg8::gemm_phase<pg8::EpiSwiglu, pg8::StaticOrder, true, true>(F.lds + RING_OFF, g, S, E);
        if (BOTH(8)) GRID_BAR();
    }
    PSTAMP(9);
    if (IN(9)) {
        pg8::Gemm g{PROJ, (const bf16*)(args.ws + WS_WDN), M, D, FF}; pg8::StaticOrder S; S.init(M, D, F.G, (int)blockIdx.x);
        pg8::EpiFinal E{(const bf16*)(args.ws + WS_DAG), F.out, D};
        pg8::gemm_phase<pg8::EpiFinal, pg8::StaticOrder, true, true>(F.lds + RING_OFF, g, S, E);
    }
    PSTAMP(10);
    if (PROBE_SEL >= 0 && blockIdx.x == 0 && F.tid == 0) {
        unsigned w = 0;
        auto ld = [&](int i) { return __hip_atomic_load(F.ctl + 9100 + i, RLX_AGENT); };
        const int sel = PROBE_SEL;
        if (sel <= 9) { const int nxt = sel == 6 ? 8 : (sel == 9 ? 10 : sel + 1); w = ld(nxt) - ld(sel); }
        else if (sel == 20) w = ld(11) - ld(4);
        else if (sel == 21) w = ld(12) - ld(11);
        else w = ld(sel);
        const unsigned long long t0 = __builtin_amdgcn_s_memtime();
        while (((__builtin_amdgcn_s_memtime() - t0) >> 4) < (unsigned long long)w) __builtin_amdgcn_s_sleep(8);
    }
#undef IN
#undef BOTH
}

extern "C" void kernel_launch(void* const* d_in, const int* in_sizes, int n_in, void* d_out, int out_size, void* d_ws, size_t ws_size, hipStream_t stream) {
    static int grid = 0;
    if (grid == 0) {
        if (n_in != 22 || in_sizes[0] != M * D || out_size != M * D || ws_size < WS_END) { fprintf(stderr, "kernel_launch: unexpected shapes (n_in %d, in0 %d, out %d, ws %zu); nothing launched\n", n_in, n_in > 0 ? in_sizes[0] : -1, out_size, ws_size); grid = -1; return; }
        int dev = 0, cus = 0, per_cu = 0;
        if (hipGetDevice(&dev) != hipSuccess || hipDeviceGetAttribute(&cus, hipDeviceAttributeMultiprocessorCount, dev) != hipSuccess) { grid = -1; return; }
        if (hipFuncSetAttribute((const void*)hybrid_fwd, hipFuncAttributeMaxDynamicSharedMemorySize, LDS_BYTES) != hipSuccess) { fprintf(stderr, "kernel_launch: hipFuncSetAttribute failed\n"); grid = -1; return; }
        if (hipOccupancyMaxActiveBlocksPerMultiprocessor(&per_cu, (const void*)hybrid_fwd, NWAVES * 64, LDS_BYTES) != hipSuccess || per_cu < 1)
            fprintf(stderr, "kernel_launch: note: occupancy query reports %d workgroups per CU\n", per_cu);
        (void)hipGetLastError();
        grid = cus;
    }
    if (grid < 0) return;
    if (hipMemsetAsync((char*)d_ws + WS_CTL, 0, CTL_ZERO_BYTES, stream) != hipSuccess) { fprintf(stderr, "kernel_launch: hipMemsetAsync failed\n"); return; }
    Args a{};
    for (int i = 0; i < 22; ++i) a.in[i] = (const float*)d_in[i];
    a.out = (float*)d_out; a.ws = (unsigned char*)d_ws;
    for (int li = 0; li < N_LAUNCHES; ++li) {
        a.ph_lo = (N_LAUNCHES == PER_PHASE) ? li : 0; a.ph_hi = (N_LAUNCHES == PER_PHASE) ? li + 1 : PER_PHASE; a.li = li;
        hipLaunchKernelGGL(hybrid_fwd, dim3(grid), dim3(NWAVES * 64), LDS_BYTES, stream, a);
        const hipError_t le = hipPeekAtLastError();
        if (le != hipSuccess) { fprintf(stderr, "kernel_launch: launch %d failed: %s\n", li, hipGetErrorName(le)); break; }
    }
}
```

```cpp
#include <hip/hip_runtime.h>
#include <cstdio>
#include <cstdint>

#ifndef PROBE_SEL
#define PROBE_SEL -1
#endif
#ifndef MK_N_LAUNCHES
#define MK_N_LAUNCHES 1
#endif

namespace pg8 {
#define PG8_LAS __attribute__((address_space(3)))
typedef unsigned short bf16_t;
typedef short bf16x8 __attribute__((ext_vector_type(8)));
typedef float f32x4 __attribute__((ext_vector_type(4)));
typedef float f32x2 __attribute__((ext_vector_type(2)));
typedef unsigned u32x4 __attribute__((ext_vector_type(4)));
constexpr int BM = 256, BK = 64, HALF = 128, HTB = HALF * BK * 2, STAGE_BYTES = 8 * HTB, NXCD = 8, WGM = 8;

__host__ __device__ __forceinline__ int lds_byte(int r, int c) { const int st = (r >> 4) * 2 + (c >> 5), rr = r & 15, cc = c & 31, ob = rr * 64 + cc * 2; return st * 1024 + (ob ^ (((ob >> 9) & 1) << 5)); }
__host__ __device__ __forceinline__ void stage_rc(int b, int& R, int& C) { const int st = b / 1024, sb = b % 1024, swz = sb ^ (((sb >> 9) & 1) << 5); R = (st >> 1) * 16 + swz / 64; C = (st & 1) * 32 + (swz % 64) / 2; }
__host__ __device__ __forceinline__ int perm32(int rho) { const int n = rho >> 4, i = rho & 15; return 8 * (i >> 2) + 4 * n + (i & 3); }

struct Unit { int pm, pn; };
struct Gemm { const bf16_t* A; const bf16_t* Bt; int M, N, K; };

struct StaticOrder {
    int nM, nN, nwg, G, c;
    __host__ __device__ void init(int M, int N, int G_, int c_) { nM = M / BM; nN = N / BM; nwg = nM * nN; G = G_; c = c_; }
    __host__ __device__ bool next(int i, Unit& u) const {
        const long L = (long)i * G + c; if (L >= nwg) return false;
        int wgid = (int)L; { const int q = nwg / NXCD, r = nwg % NXCD, xcd = wgid % NXCD, off = wgid / NXCD; wgid = (xcd < r ? xcd * (q + 1) : r * (q + 1) + (xcd - r) * q) + off; }
        const int nig = WGM * nN, gid = wgid / nig, fm = gid * WGM, gsz = (nM - fm) < WGM ? (nM - fm) : WGM;
        u.pm = fm + ((wgid % nig) % gsz); u.pn = (wgid % nig) / gsz; return true;
    }
    __device__ __forceinline__ void a_ready(const Unit&) const {}
    __device__ __forceinline__ void done(const Unit&) const {}
};

__device__ __forceinline__ unsigned cvt_pk_bf16(float lo, float hi) { unsigned r; asm volatile("v_cvt_pk_bf16_f32 %0, %1, %2" : "=v"(r) : "v"(lo), "v"(hi)); return r; }
__device__ __forceinline__ float fsigmoid(float x) { return __builtin_amdgcn_rcpf(1.0f + __builtin_amdgcn_exp2f(-1.4426950408889634f * x)); }

struct EpiBf16 {
    static constexpr bool PERM = true, AFTER_DRAIN = false;
    bf16_t* O; int ldc;
    __device__ __forceinline__ void operator()(const f32x4 (&acc)[2][2][4][2], const Unit& u, int wr, int wc, int fr, int fq) const {
        const int row0 = u.pm * BM + wr * 64 + fr; const int col0 = u.pn * BM + wc * 32 + 8 * fq;
#pragma unroll
        for (int ai = 0; ai < 2; ++ai)
#pragma unroll
            for (int m = 0; m < 4; ++m) { bf16_t* rowp = O + (size_t)(row0 + ai * HALF + m * 16) * ldc + col0;
#pragma unroll
                for (int bj = 0; bj < 2; ++bj) { const f32x4 v0 = acc[ai][bj][m][0], v1 = acc[ai][bj][m][1];
                    u32x4 w; w.x = cvt_pk_bf16(v0[0], v0[1]); w.y = cvt_pk_bf16(v0[2], v0[3]); w.z = cvt_pk_bf16(v1[0], v1[1]); w.w = cvt_pk_bf16(v1[2], v1[3]);
                    *(u32x4*)(rowp + bj * HALF) = w; } }
    }
};
struct EpiProj {
    static constexpr bool PERM = true, AFTER_DRAIN = false;
    bf16_t* O; int ldc; const float* qg; const float* kg;
    __device__ __forceinline__ void operator()(const f32x4 (&acc)[2][2][4][2], const Unit& u, int wr, int wc, int fr, int fq) const {
        const int row0 = u.pm * BM + wr * 64 + fr;
        if (u.pn >= 4) {
            const int col0 = u.pn * BM + wc * 32 + 8 * fq;
#pragma unroll
            for (int ai = 0; ai < 2; ++ai)
#pragma unroll
                for (int m = 0; m < 4; ++m) { bf16_t* rowp = O + (size_t)(row0 + ai * HALF + m * 16) * ldc + col0;
#pragma unroll
                    for (int bj = 0; bj < 2; ++bj) { const f32x4 v0 = acc[ai][bj][m][0], v1 = acc[ai][bj][m][1];
                        u32x4 w; w.x = cvt_pk_bf16(v0[0], v0[1]); w.y = cvt_pk_bf16(v0[2], v0[3]); w.z = cvt_pk_bf16(v1[0], v1[1]); w.w = cvt_pk_bf16(v1[2], v1[3]);
                        *(u32x4*)(rowp + bj * HALF) = w; } }
        } else {
            const float* gsrc = (u.pn < 2 ? qg : kg) + 8 * fq; const float sc = u.pn < 2 ? 0.125f * 1.4426950408889634f : 1.0f;
            f32x4 g4[2][2];
#pragma unroll
            for (int bj = 0; bj < 2; ++bj)
#pragma unroll
                for (int n = 0; n < 2; ++n) g4[bj][n] = *(const f32x4*)(gsrc + 32 * bj + 4 * n) * sc;
            const int col0 = u.pn * BM + wc * 64 + 8 * fq;
#pragma unroll
            for (int ai = 0; ai < 2; ++ai)
#pragma unroll
                for (int m = 0; m < 4; ++m) {
                    float ss = 0.f;
#pragma unroll
                    for (int bj = 0; bj < 2; ++bj)
#pragma unroll
                        for (int n = 0; n < 2; ++n) { const f32x4 v = acc[ai][bj][m][n]; ss += (v[0] * v[0] + v[1] * v[1]) + (v[2] * v[2] + v[3] * v[3]); }
                    ss += __shfl_xor(ss, 16); ss += __shfl_xor(ss, 32);
                    const float rstd = 1.0f / sqrtf(ss * (1.0f / 64.0f) + 1e-6f);
                    bf16_t* rowp = O + (size_t)(row0 + ai * HALF + m * 16) * ldc + col0;
#pragma unroll
                    for (int bj = 0; bj < 2; ++bj) { const f32x4 v0 = acc[ai][bj][m][0] * g4[bj][0] * rstd, v1 = acc[ai][bj][m][1] * g4[bj][1] * rstd;
                        u32x4 w; w.x = cvt_pk_bf16(v0[0], v0[1]); w.y = cvt_pk_bf16(v0[2], v0[3]); w.z = cvt_pk_bf16(v1[0], v1[1]); w.w = cvt_pk_bf16(v1[2], v1[3]);
                        *(u32x4*)(rowp + 32 * bj) = w; }
                    __builtin_amdgcn_sched_barrier(0); }
        }
    }
};
struct EpiLora {
    static constexpr bool PERM = true, AFTER_DRAIN = false;
    bf16_t* O; int ldc; const float* w0; const float* a0;
    __device__ __forceinline__ void operator()(const f32x4 (&acc)[2][2][4][2], const Unit& u, int wr, int wc, int fr, int fq) const {
        const int row0 = u.pm * BM + wr * 64 + fr; const int col0 = u.pn * BM + wc * 32 + 8 * fq;
        const int kind = u.pn >> 1;
        const float sc = kind == 0 ? -0.6065306597126334f : (kind == 1 ? 1.0f : 0.0f), lin = kind == 2 ? 1.0f : 0.0f;
        const float* bp = kind == 0 ? w0 : a0;
        const float bs = kind == 2 ? 0.0f : 1.0f;
#pragma unroll
        for (int bj = 0; bj < 2; ++bj) {
            const int c = (col0 + bj * HALF) & 511;
            const f32x4 b0 = *(const f32x4*)(bp + c) * bs, b1 = *(const f32x4*)(bp + c + 4) * bs;
#pragma unroll
            for (int ai = 0; ai < 2; ++ai)
#pragma unroll
                for (int m = 0; m < 4; ++m) { bf16_t* rowp = O + (size_t)(row0 + ai * HALF + m * 16) * ldc + col0;
                    f32x4 v0 = acc[ai][bj][m][0] + b0, v1 = acc[ai][bj][m][1] + b1;
#pragma unroll
                    for (int e = 0; e < 4; ++e) { v0[e] = sc * fsigmoid(v0[e]) + lin * v0[e]; v1[e] = sc * fsigmoid(v1[e]) + lin * v1[e]; }
                    u32x4 w; w.x = cvt_pk_bf16(v0[0], v0[1]); w.y = cvt_pk_bf16(v0[2], v0[3]); w.z = cvt_pk_bf16(v1[0], v1[1]); w.w = cvt_pk_bf16(v1[2], v1[3]);
                    *(u32x4*)(rowp + bj * HALF) = w;
                    __builtin_amdgcn_sched_barrier(0); }
        }
    }
};
struct EpiSwiglu {
    static constexpr bool PERM = true, AFTER_DRAIN = false;
    bf16_t* H; int ldh; const float* rstd;
    __device__ __forceinline__ void operator()(const f32x4 (&acc)[2][2][4][2], const Unit& u, int wr, int wc, int fr, int fq) const {
        const int row0 = u.pm * BM + wr * 64 + fr; const int col0 = u.pn * HALF + wc * 32 + 8 * fq;
        float rs[2][4];
#pragma unroll
        for (int ai = 0; ai < 2; ++ai)
#pragma unroll
            for (int m = 0; m < 4; ++m) { const f32x4 s4 = *(const f32x4*)(rstd + (size_t)(row0 + ai * HALF + m * 16) * 4);
                rs[ai][m] = 1.0f / sqrtf(((s4[0] + s4[1]) + (s4[2] + s4[3])) * (1.0f / 1024.0f) + 1e-6f); }
#pragma unroll
        for (int ai = 0; ai < 2; ++ai)
#pragma unroll
            for (int m = 0; m < 4; ++m) { bf16_t* rowp = H + (size_t)(row0 + ai * HALF + m * 16) * ldh + col0;
                float h[8];
#pragma unroll
                for (int n = 0; n < 2; ++n)
#pragma unroll
                    for (int e = 0; e < 4; ++e) { const float g = acc[ai][0][m][n][e] * rs[ai][m], up = acc[ai][1][m][n][e] * rs[ai][m]; h[4 * n + e] = g * fsigmoid(g) * up; }
                u32x4 w; w.x = cvt_pk_bf16(h[0], h[1]); w.y = cvt_pk_bf16(h[2], h[3]); w.z = cvt_pk_bf16(h[4], h[5]); w.w = cvt_pk_bf16(h[6], h[7]);
                *(u32x4*)rowp = w;
                __builtin_amdgcn_sched_barrier(0); }
    }
};
struct EpiOut {
    static constexpr bool PERM = true, AFTER_DRAIN = false;
    const float* base; bf16_t* xb; float* SS; int ldc; PG8_LAS float* scr;
    __device__ __forceinline__ void operator()(const f32x4 (&acc)[2][2][4][2], const Unit& u, int wr, int wc, int fr, int fq) const {
        const int row0 = u.pm * BM + wr * 64 + fr, col0 = u.pn * BM + wc * 32 + 8 * fq;
#pragma unroll
        for (int ai = 0; ai < 2; ++ai)
#pragma unroll
            for (int m = 0; m < 4; ++m) { const size_t off = (size_t)(row0 + ai * HALF + m * 16) * ldc + col0;
                float ss = 0.f;
#pragma unroll
                for (int bj = 0; bj < 2; ++bj) {
                    const f32x4 o0 = *(const f32x4*)(base + off + bj * HALF) + acc[ai][bj][m][0], o1 = *(const f32x4*)(base + off + bj * HALF + 4) + acc[ai][bj][m][1];
                    u32x4 w; w.x = cvt_pk_bf16(o0[0], o0[1]); w.y = cvt_pk_bf16(o0[2], o0[3]); w.z = cvt_pk_bf16(o1[0], o1[1]); w.w = cvt_pk_bf16(o1[2], o1[3]);
                    *(u32x4*)(xb + off + bj * HALF) = w;
                    ss += ((o0[0] * o0[0] + o0[1] * o0[1]) + (o0[2] * o0[2] + o0[3] * o0[3])) + ((o1[0] * o1[0] + o1[1] * o1[1]) + (o1[2] * o1[2] + o1[3] * o1[3])); }
                ss += __shfl_xor(ss, 16); ss += __shfl_xor(ss, 32);
                if (fq == 0) scr[((((wr * 2 + ai) * 4 + m) * 16) + fr) * 4 + wc] = ss;
                if (m & 1) asm volatile("" ::: "memory"); }
        asm volatile("s_waitcnt lgkmcnt(0)" ::: "memory"); __builtin_amdgcn_s_barrier(); asm volatile("" ::: "memory");
        const int tid = threadIdx.x;
        if (tid < 256) { const f32x4 s4 = *(const PG8_LAS f32x4*)(scr + tid * 4);
            const int row = u.pm * BM + ((tid >> 6) & 1) * HALF + (tid >> 7) * 64 + ((tid >> 4) & 3) * 16 + (tid & 15);
            SS[(size_t)row * 4 + u.pn] = (s4[0] + s4[1]) + (s4[2] + s4[3]); }
    }
};
struct EpiFinal {
    static constexpr bool PERM = true, AFTER_DRAIN = false;
    const bf16_t* xb; float* out; int ldc;
    __device__ __forceinline__ void operator()(const f32x4 (&acc)[2][2][4][2], const Unit& u, int wr, int wc, int fr, int fq) const {
        const int row0 = u.pm * BM + wr * 64 + fr, col0 = u.pn * BM + wc * 32 + 8 * fq;
#pragma unroll
        for (int ai = 0; ai < 2; ++ai)
#pragma unroll
            for (int m = 0; m < 4; ++m) { const size_t off = (size_t)(row0 + ai * HALF + m * 16) * ldc + col0;
#pragma unroll
                for (int bj = 0; bj < 2; ++bj) { const u32x4 w = *(const u32x4*)(xb + off + bj * HALF);
                    const f32x4 b0 = (f32x4){__builtin_bit_cast(float, w.x << 16), __builtin_bit_cast(float, w.x & 0xffff0000u), __builtin_bit_cast(float, w.y << 16), __builtin_bit_cast(float, w.y & 0xffff0000u)};
                    const f32x4 b1 = (f32x4){__builtin_bit_cast(float, w.z << 16), __builtin_bit_cast(float, w.z & 0xffff0000u), __builtin_bit_cast(float, w.w << 16), __builtin_bit_cast(float, w.w & 0xffff0000u)};
                    *(f32x4*)(out + off + bj * HALF) = b0 + acc[ai][bj][m][0]; *(f32x4*)(out + off + bj * HALF + 4) = b1 + acc[ai][bj][m][1]; }
                if (m & 1) asm volatile("" ::: "memory"); }
    }
};

template <class Epi, class Sched, bool ALIGN_EPI = false, bool SP2 = false>
__device__ __forceinline__ void gemm_phase(PG8_LAS unsigned char* lds, const Gemm g, const Sched& S, const Epi& E) {
    const int tid = threadIdx.x, wid = __builtin_amdgcn_readfirstlane(tid >> 6), lane = tid & 63, wr = wid >> 2, wc = wid & 3, fr = lane & 15, fq = lane >> 4;
    const int K = g.K, nt = K / BK;
    unsigned voffA[2], voffB[2];
#pragma unroll
    for (int i = 0; i < 2; ++i) { int R, C; stage_rc(tid * 16 + i * 8192, R, C); const int Rb = Epi::PERM ? ((R & ~31) + perm32(R & 31)) : R;
        voffA[i] = (unsigned)(R * K + C) * 2u; voffB[i] = (unsigned)(Rb * K + C) * 2u; }
    const size_t kstep = (size_t)(BK * 2);
    const size_t hstep = (size_t)HALF * K * 2;
    const size_t tstep = 2 * hstep;
    const unsigned ldsw = (unsigned)wid * 1024u;
    const int aoff = lds_byte(wr * 64 + fr, fq * 8), boff = lds_byte(wc * 32 + fr, fq * 8);
#define PG8_SA(b, h) (((b) * 2 + (h)) * HTB)
#define PG8_SB(b, h) ((4 + (b) * 2 + (h)) * HTB)
#define PG8_STAGE(bufoff, gbase, voff) do { _Pragma("unroll") for (int _i = 0; _i < 2; ++_i) \
        __builtin_amdgcn_global_load_lds((const unsigned*)((const char*)(gbase) + (voff)[_i]), (PG8_LAS unsigned*)(lds + (bufoff) + ldsw + _i * 8192), 16, 0, 0); } while (0)
#define PG8_LDA(dst, b, h) do { _Pragma("unroll") for (int m = 0; m < 4; ++m) _Pragma("unroll") for (int k = 0; k < 2; ++k) dst[m][k] = *(const PG8_LAS bf16x8*)(lds + PG8_SA(b, h) + aoff + m * 2048 + k * 1024); } while (0)
#define PG8_LDB(dst, b, h) do { _Pragma("unroll") for (int n = 0; n < 2; ++n) _Pragma("unroll") for (int k = 0; k < 2; ++k) dst[n][k] = *(const PG8_LAS bf16x8*)(lds + PG8_SB(b, h) + boff + n * 2048 + k * 1024); } while (0)
#define PG8_MMA(ai, bj, At, Bt) do { __builtin_amdgcn_s_setprio(1); _Pragma("unroll") for (int m = 0; m < 4; ++m) _Pragma("unroll") for (int n = 0; n < 2; ++n) _Pragma("unroll") for (int k = 0; k < 2; ++k) \
        acc[ai][bj][m][n] = __builtin_amdgcn_mfma_f32_16x16x32_bf16(Bt[n][k], At[m][k], acc[ai][bj][m][n], 0, 0, 0); __builtin_amdgcn_s_setprio(0); } while (0)
#define PG8_WAIT_V(n) asm volatile("s_waitcnt vmcnt(" #n ")" ::: "memory")
#define PG8_WAIT_L(n) asm volatile("s_waitcnt lgkmcnt(" #n ")" ::: "memory")
#define PG8_BAR __builtin_amdgcn_s_barrier()
#define PG8_SCHED __builtin_amdgcn_sched_barrier(0)
    Unit cur, nxt; int ui = 0;
    if (!S.next(0, cur)) return;
    f32x4 acc[2][2][4][2];
#pragma unroll
    for (int a = 0; a < 2; ++a)
#pragma unroll
        for (int b = 0; b < 2; ++b)
#pragma unroll
            for (int m = 0; m < 4; ++m)
#pragma unroll
                for (int n = 0; n < 2; ++n) acc[a][b][m][n] = (f32x4){0.f, 0.f, 0.f, 0.f};
    bf16x8 At[4][2], B0[2][2], B1[2][2];
    const char* cA = (const char*)g.A + (size_t)cur.pm * tstep; const char* cB = (const char*)g.Bt + (size_t)cur.pn * tstep;
    S.a_ready(cur);
    if constexpr (SP2) {
        PG8_STAGE(PG8_SB(0, 0), cB, voffB); PG8_STAGE(PG8_SB(0, 1), cB + hstep, voffB); PG8_STAGE(PG8_SA(0, 0), cA, voffA); PG8_STAGE(PG8_SA(0, 1), cA + hstep, voffA);
        if (wr == 1) PG8_BAR;
        PG8_WAIT_V(2); PG8_BAR;
        PG8_STAGE(PG8_SB(1, 0), cB + kstep, voffB); PG8_STAGE(PG8_SA(1, 0), cA + kstep, voffA); PG8_STAGE(PG8_SB(1, 1), cB + hstep + kstep, voffB);
        PG8_WAIT_V(6); PG8_BAR;
    } else {
        PG8_STAGE(PG8_SB(0, 0), cB, voffB); PG8_STAGE(PG8_SA(0, 0), cA, voffA); PG8_STAGE(PG8_SB(0, 1), cB + hstep, voffB); PG8_STAGE(PG8_SA(0, 1), cA + hstep, voffA);
        if (wr == 1) PG8_BAR;
        PG8_WAIT_V(4); PG8_BAR;
        PG8_STAGE(PG8_SB(1, 0), cB + kstep, voffB); PG8_STAGE(PG8_SA(1, 0), cA + kstep, voffA); PG8_STAGE(PG8_SB(1, 1), cB + hstep + kstep, voffB);
        PG8_WAIT_V(6); PG8_BAR;
    }
    for (;;) {
        const bool has_next = S.next(ui + 1, nxt);
        const char* nA = has_next ? (const char*)g.A + (size_t)nxt.pm * tstep : cA; const char* nB = has_next ? (const char*)g.Bt + (size_t)nxt.pn * tstep : cB;
#pragma nounroll
        for (int t = 0; t < nt; t += 2) {
            const bool last = (t == nt - 2);
            const char* a1 = cA + (size_t)(t + 1) * kstep;
            const char* a2 = last ? nA : cA + (size_t)(t + 2) * kstep; const char* b2 = last ? nB : cB + (size_t)(t + 2) * kstep;
            const char* a3 = a2 + kstep; const char* b3 = b2 + kstep;
            if (last && has_next) S.a_ready(nxt);
            if constexpr (SP2) {
            PG8_LDB(B0, 0, 0); PG8_LDB(B1, 0, 1); PG8_SCHED; PG8_LDA(At, 0, 0); PG8_STAGE(PG8_SA(1, 1), a1 + hstep, voffA);
            PG8_WAIT_V(8); PG8_WAIT_L(0); PG8_BAR; PG8_MMA(0, 0, At, B0); PG8_MMA(0, 1, At, B1); PG8_BAR; PG8_SCHED;
            PG8_LDA(At, 0, 1); PG8_STAGE(PG8_SB(0, 0), b2, voffB); PG8_STAGE(PG8_SB(0, 1), b2 + hstep, voffB); PG8_STAGE(PG8_SA(0, 0), a2, voffA);
            PG8_WAIT_V(8); PG8_WAIT_L(0); PG8_BAR; PG8_MMA(1, 0, At, B0); PG8_MMA(1, 1, At, B1); PG8_BAR; PG8_SCHED;
            PG8_LDB(B0, 1, 0); PG8_LDB(B1, 1, 1); PG8_SCHED; PG8_LDA(At, 1, 0); PG8_STAGE(PG8_SA(0, 1), a2 + hstep, voffA);
            PG8_WAIT_V(8); PG8_WAIT_L(0); PG8_BAR; PG8_MMA(0, 0, At, B0); PG8_MMA(0, 1, At, B1); PG8_BAR; PG8_SCHED;
            PG8_LDA(At, 1, 1); PG8_STAGE(PG8_SB(1, 0), b3, voffB); PG8_STAGE(PG8_SB(1, 1), b3 + hstep, voffB); PG8_STAGE(PG8_SA(1, 0), a3, voffA);
            PG8_WAIT_V(8); PG8_WAIT_L(0); PG8_BAR; PG8_MMA(1, 0, At, B0); PG8_MMA(1, 1, At, B1); PG8_BAR; PG8_SCHED;
            } else {
            PG8_LDB(B0, 0, 0); PG8_SCHED; PG8_LDA(At, 0, 0); PG8_STAGE(PG8_SA(1, 1), a1 + hstep, voffA);
            PG8_WAIT_L(8); PG8_BAR; PG8_WAIT_L(0); PG8_MMA(0, 0, At, B0); PG8_BAR; PG8_SCHED;
            PG8_LDB(B1, 0, 1); PG8_STAGE(PG8_SB(0, 0), b2, voffB);
            PG8_BAR; PG8_WAIT_L(0); PG8_MMA(0, 1, At, B1); PG8_BAR;
            PG8_LDA(At, 0, 1); PG8_STAGE(PG8_SA(0, 0), a2, voffA);
            PG8_BAR; PG8_WAIT_L(0); PG8_MMA(1, 0, At, B0); PG8_BAR; PG8_SCHED;
            PG8_STAGE(PG8_SB(0, 1), b2 + hstep, voffB);
            PG8_WAIT_V(6); PG8_BAR; PG8_MMA(1, 1, At, B1); PG8_BAR;
            PG8_LDB(B0, 1, 0); PG8_SCHED; PG8_LDA(At, 1, 0); PG8_STAGE(PG8_SA(0, 1), a2 + hstep, voffA);
            PG8_WAIT_L(8); PG8_BAR; PG8_WAIT_L(0); PG8_MMA(0, 0, At, B0); PG8_BAR; PG8_SCHED;
            PG8_LDB(B1, 1, 1); PG8_STAGE(PG8_SB(1, 0), b3, voffB);
            PG8_BAR; PG8_WAIT_L(0); PG8_MMA(0, 1, At, B1); PG8_BAR;
            PG8_LDA(At, 1, 1); PG8_STAGE(PG8_SA(1, 0), a3, voffA);
            PG8_BAR; PG8_WAIT_L(0); PG8_MMA(1, 0, At, B0); PG8_BAR; PG8_SCHED;
            PG8_STAGE(PG8_SB(1, 1), b3 + hstep, voffB);
            PG8_WAIT_V(6); PG8_BAR; PG8_MMA(1, 1, At, B1); PG8_BAR;
            }
        }
        if constexpr (ALIGN_EPI) { if (wr == 0) PG8_BAR; }
        if constexpr (!Epi::AFTER_DRAIN) { E(acc, cur, wr, wc, fr, fq); S.done(cur); }
        if (!has_next) break;
#pragma unroll
        for (int a = 0; a < 2; ++a)
#pragma unroll
            for (int b = 0; b < 2; ++b)
#pragma unroll
                for (int m = 0; m < 4; ++m)
#pragma unroll
                    for (int n = 0; n < 2; ++n) acc[a][b][m][n] = (f32x4){0.f, 0.f, 0.f, 0.f};
        cur = nxt; cA = nA; cB = nB; ++ui;
        if constexpr (ALIGN_EPI) { if (wr == 1) PG8_BAR; }
    }
    PG8_WAIT_V(0);
    if constexpr (!ALIGN_EPI) { if (wr == 0) PG8_BAR; }
    PG8_BAR;
#undef PG8_SA
#undef PG8_SB
#undef PG8_STAGE
#undef PG8_LDA
#undef PG8_LDB
#undef PG8_MMA
#undef PG8_WAIT_V
#undef PG8_WAIT_L
#undef PG8_BAR
#undef PG8_SCHED
}
}

constexpr int NWAVES = 8;
constexpr int N_LAUNCHES = MK_N_LAUNCHES;
constexpr int PER_PHASE = 10;
constexpr int BATCH = 16, SEQ = 2048, D = 1024, M = BATCH * SEQ;
constexpr int NH = 8, HD = 64, AW = 512, RW = 512;
constexpr int RWKV_COLS = 1792, IN_COLS = 3328, FF = 2816, NGU = 2 * FF, NLORA = 1536, KLORA = 256;
constexpr int PC_Q = 0, PC_K = 512, PC_V = 1024, PC_RW = 1536;
constexpr int RC_R = 0, RC_K = 512, RC_V = 1024, RC_L = 1536;
constexpr float NORM_EPS = 1e-6f, LNX_EPS = 64e-5f;
constexpr float LOG2E = 1.4426950408889634f;

constexpr size_t MiB = 1u << 20;
constexpr size_t WS_CTL = 0, CTL_ZERO_BYTES = 1 * MiB;
constexpr size_t WS_WIN = 2 * MiB;
constexpr size_t WS_WOUT = 9 * MiB;
constexpr size_t WS_WGU = 11 * MiB;
constexpr size_t WS_WDN = 22 * MiB;
constexpr size_t WS_WL = 28 * MiB;
constexpr size_t WS_BON = 29 * MiB;
constexpr size_t WS_SS = 30 * MiB;
constexpr size_t WS_XN = 32 * MiB;
constexpr size_t WS_PROJ = 96 * MiB;
constexpr size_t WS_A2 = 304 * MiB;
constexpr size_t WS_DAG = 320 * MiB;
constexpr size_t WS_ML = 416 * MiB;
constexpr size_t WS_END = 424 * MiB;
constexpr size_t DO_PO = 0, DO_Y = 96 * MiB;
constexpr int CW_TMO = 0, CW_CODE = 1;
constexpr int CW_BAR = 4096;
constexpr int CW_ATTQ = 8192;

constexpr int LDS_BYTES = 163840;
constexpr int RING_OFF = 0, RING_BYTES = LDS_BYTES - 1024;
constexpr int LDSCTL_OFF = RING_BYTES, MISC_OFF = LDSCTL_OFF + 320;

#define GAS __attribute__((address_space(1)))
#define LAS __attribute__((address_space(3)))
typedef unsigned short bf16;
typedef unsigned v4u __attribute__((ext_vector_type(4)));
typedef unsigned v2u __attribute__((ext_vector_type(2)));
typedef float f32x4 __attribute__((ext_vector_type(4)));
typedef float f32x2 __attribute__((ext_vector_type(2)));
typedef float f32x16 __attribute__((ext_vector_type(16)));
typedef short bf16x8 __attribute__((ext_vector_type(8)));
typedef short s16x4 __attribute__((ext_vector_type(4)));
typedef GAS unsigned gu32;
#define RLX_AGENT __ATOMIC_RELAXED, __HIP_MEMORY_SCOPE_AGENT
#define LDS_WAIT() asm volatile("s_waitcnt lgkmcnt(0)" ::: "memory")
#define VM_WAIT() asm volatile("s_waitcnt vmcnt(0)" ::: "memory")
__device__ __forceinline__ unsigned f2bf(float f) { unsigned u = __builtin_bit_cast(unsigned, f); return (u + 0x7fffu + ((u >> 16) & 1u)) >> 16; }
typedef float f32x2_t __attribute__((ext_vector_type(2))); typedef __bf16 bf16x2_t __attribute__((ext_vector_type(2)));
__device__ __forceinline__ unsigned cvt2(float lo, float hi) { f32x2_t v = {lo, hi}; bf16x2_t b = __builtin_convertvector(v, bf16x2_t); return __builtin_bit_cast(unsigned, b); }
__device__ __forceinline__ unsigned pk2(float lo, float hi) { return cvt2(lo, hi); }
__device__ __forceinline__ float bflo(unsigned w) { return __builtin_bit_cast(float, w << 16); }
__device__ __forceinline__ float bfhi(unsigned w) { return __builtin_bit_cast(float, w & 0xffff0000u); }
__device__ __forceinline__ float fsig(float x) { return __builtin_amdgcn_rcpf(1.0f + __builtin_amdgcn_exp2f(-LOG2E * x)); }

#define XB_TMO      128
#define XB_XCNT(j)  (256  + 64 * (j))
#define XB_XSUB(j)  (1280 + 64 * (j))
#define XB_XGEN(j)  (2304 + 64 * (j))
#define XB_TOP      3328
#define XB_TOPGEN   3392
#define XCD_BAR_WORDS 3456
#define XB_SPIN_CAP (1u << 18)
__device__ __forceinline__ unsigned xb_ld(unsigned* p)              { return __hip_atomic_load(p, __ATOMIC_RELAXED, __HIP_MEMORY_SCOPE_AGENT); }
__device__ __forceinline__ unsigned xb_add(unsigned* p, unsigned v) { return __hip_atomic_fetch_add(p, v, __ATOMIC_RELAXED, __HIP_MEMORY_SCOPE_AGENT); }
__device__ __forceinline__ unsigned xb_xcc_id() { return (unsigned)__builtin_amdgcn_s_getreg((3 << 11) | 20) & 0xFu; }
#define XB_SPIN(cond, bar) do { unsigned _sp = 0; while (cond) { __builtin_amdgcn_s_sleep(1); \
    if ((++_sp & 255u) == 0u) { if (xb_ld(&(bar)[XB_TMO])) break; if (_sp > XB_SPIN_CAP) { atomicAdd(&(bar)[XB_TMO], 1u); break; } } } } while (0)
struct XcdBarrier { unsigned* bar; unsigned x; volatile LAS unsigned* st; };
__device__ __forceinline__ XcdBarrier xcd_barrier_post(unsigned* bar, volatile LAS unsigned* st) {
    XcdBarrier b; b.bar = bar; b.x = xb_xcc_id(); b.st = st;
    if (threadIdx.x == 0) (void)xb_add(&bar[XB_XCNT(b.x)], 1u);
    return b;
}
__device__ __forceinline__ void xcd_barrier_complete(unsigned* bar, unsigned x, unsigned& nloc, unsigned& nx) {
    const unsigned G = gridDim.x * gridDim.y * gridDim.z;
    unsigned sum, cnt, mine, sp = 0u;
    for (;;) {
        sum = 0u; cnt = 0u; mine = 0u;
#pragma unroll
        for (unsigned j = 0; j < 16; ++j) { const unsigned c = xb_ld(&bar[XB_XCNT(j)]); sum += c; cnt += (c > 0u) ? 1u : 0u; mine = (j == x) ? c : mine; }
        if (sum == G) break;
        __builtin_amdgcn_s_sleep(1);
        if ((++sp & 255u) == 0u) { if (xb_ld(&bar[XB_TMO])) break; if (sp > XB_SPIN_CAP) { atomicAdd(&bar[XB_TMO], 1u); break; } }
    }
    nloc = mine > 0u ? mine : 1u; nx = cnt > 0u ? cnt : 1u;
}
__device__ __forceinline__ void xcd_barrier(const XcdBarrier& b) {
    asm volatile("s_waitcnt vmcnt(0)" ::: "memory");
    __syncthreads();
    if (threadIdx.x == 0) {
        unsigned* bar = b.bar;
        __builtin_amdgcn_s_waitcnt(0);
        unsigned nloc = b.st[0], nx = b.st[1];
        if (nloc == 0u) { xcd_barrier_complete(bar, b.x, nloc, nx); b.st[0] = nloc; b.st[1] = nx; }
        const unsigned old = xb_add(&bar[XB_XSUB(b.x)], 1u);
        const unsigned gen = old / nloc;
        if (old + 1u == (gen + 1u) * nloc) {
            __builtin_amdgcn_fence(__ATOMIC_RELEASE, "agent");
            asm volatile("s_waitcnt vmcnt(0)" ::: "memory");
            const unsigned og = xb_add(&bar[XB_TOP], 1u);
            const unsigned tg = og / nx;
            if (og + 1u == (tg + 1u) * nx) xb_add(&bar[XB_TOPGEN], 1u);
            else XB_SPIN(xb_ld(&bar[XB_TOPGEN]) == tg, bar);
            __builtin_amdgcn_fence(__ATOMIC_ACQUIRE, "agent");
            xb_add(&bar[XB_XGEN(b.x)], 1u);
            asm volatile("s_waitcnt vmcnt(0)" ::: "memory");
        } else {
            XB_SPIN(xb_ld(&bar[XB_XGEN(b.x)]) == gen, bar);
            __builtin_amdgcn_fence(__ATOMIC_ACQUIRE, "agent");
            asm volatile("s_waitcnt vmcnt(0)" ::: "memory");
        }
    }
    __syncthreads();
}

struct Frame {
    LAS unsigned char* lds;
    volatile LAS unsigned* MISC;
    gu32* ctl;
    int tid, lane, wave;
    int vcu, G;
    float* out; unsigned char* ws;
};
struct Args { const float* in[22]; float* out; unsigned char* ws; int ph_lo, ph_hi, li, pad; };
enum { I_X = 0, I_N1G, I_WIN, I_QNG, I_KNG, I_AOG, I_MU, I_W0, I_W2, I_A0, I_A2, I_G2, I_KK, I_KA, I_RK, I_LNG, I_LNB, I_WOUT, I_N2G, I_WG, I_WU, I_WD };

__device__ __forceinline__ float wave_sum(float v) {
#pragma unroll
    for (int o = 1; o < 64; o <<= 1) v += __shfl_xor(v, o);
    return v;
}
__device__ __forceinline__ float red16(float x) {
    x += __builtin_bit_cast(float, __builtin_amdgcn_update_dpp(0, __builtin_bit_cast(int, x), 0x128, 0xf, 0xf, false));
    x += __builtin_bit_cast(float, __builtin_amdgcn_update_dpp(0, __builtin_bit_cast(int, x), 0x124, 0xf, 0xf, false));
    x += __builtin_bit_cast(float, __builtin_amdgcn_update_dpp(0, __builtin_bit_cast(int, x), 0x122, 0xf, 0xf, false));
    x += __builtin_bit_cast(float, __builtin_amdgcn_update_dpp(0, __builtin_bit_cast(int, x), 0x121, 0xf, 0xf, false));
    return x;
}

constexpr int TR_SCR = 64 * 65 * 4 + 256;
__device__ __forceinline__ int tr_row(int rmode, int n) {
    return rmode == 0 ? n : rmode == 3 ? (n < 1024 ? ((n >> 8) * 256 + ((n >> 5) & 1) * 128 + ((n >> 6) & 3) * 32 + (n & 31)) : n) : ((n >> 7) * 256 + (n & 127) + (rmode == 2 ? 128 : 0));
}
__device__ __forceinline__ void p0_transpose_item(const float* W, int K, int N, bf16* WT, int rmode, LAS float* scr, int item, int lane, const float* ksc = nullptr) {
    const int nblk = N / 64, kb = item / nblk, nb = item % nblk, k0 = 64 * kb, n0 = 64 * nb;
    const int ks = lane >> 4, n4 = (lane & 15) * 4;
    f32x4 v[16];
#pragma unroll
    for (int i = 0; i < 16; ++i) v[i] = *(const GAS f32x4*)((const GAS float*)W + (size_t)(k0 + 4 * i + ks) * N + n0 + n4);
#pragma unroll
    for (int i = 0; i < 16; ++i) { const int kk = 4 * i + ks; const float sc = ksc ? ksc[k0 + kk] : 1.0f;
        scr[kk * 65 + n4 + 0] = v[i].x * sc; scr[kk * 65 + n4 + 1] = v[i].y * sc; scr[kk * 65 + n4 + 2] = v[i].z * sc; scr[kk * 65 + n4 + 3] = v[i].w * sc; }
    LDS_WAIT(); asm volatile("" ::: "memory");
    GAS v4u* dst = (GAS v4u*)(WT + (size_t)tr_row(rmode, n0 + lane) * K + k0);
#pragma unroll
    for (int j = 0; j < 8; ++j) { const LAS float* c = scr + (8 * j) * 65 + lane;
        v4u o; o.x = pk2(c[0 * 65], c[1 * 65]); o.y = pk2(c[2 * 65], c[3 * 65]); o.z = pk2(c[4 * 65], c[5 * 65]); o.w = pk2(c[6 * 65], c[7 * 65]);
        dst[j] = o; }
    LDS_WAIT(); asm volatile("" ::: "memory");
}
template <int NR> __device__ __forceinline__ void rms_rows_to_bf16(int lane, const float* x0, size_t rstride, const float* g, bf16* o0, size_t ostride) {
    const GAS f32x4* gr = (const GAS f32x4*)g + lane;
    f32x4 v[NR][4];
#pragma unroll
    for (int r = 0; r < NR; ++r) { const GAS f32x4* xr = (const GAS f32x4*)(x0 + r * rstride) + lane;
#pragma unroll
        for (int j = 0; j < 4; ++j) v[r][j] = xr[64 * j]; }
    f32x4 gg[4];
#pragma unroll
    for (int j = 0; j < 4; ++j) gg[j] = gr[64 * j];
#pragma unroll
    for (int r = 0; r < NR; ++r) { float s = 0.f;
#pragma unroll
        for (int j = 0; j < 4; ++j) s += (v[r][j].x * v[r][j].x + v[r][j].y * v[r][j].y) + (v[r][j].z * v[r][j].z + v[r][j].w * v[r][j].w);
        const float rstd = 1.f / sqrtf(wave_sum(s) * (1.f / D) + NORM_EPS);
        GAS unsigned long long* o8 = (GAS unsigned long long*)(o0 + r * ostride) + lane;
#pragma unroll
        for (int j = 0; j < 4; ++j)
            o8[64 * j] = (unsigned long long)pk2(v[r][j].x * rstd * gg[j].x, v[r][j].y * rstd * gg[j].y) | ((unsigned long long)pk2(v[r][j].z * rstd * gg[j].z, v[r][j].w * rstd * gg[j].w) << 32); }
}

__device__ __forceinline__ void p0_prologue(Frame& F, const Args& AR) {
    LAS float* scr = (LAS float*)(F.lds + RING_OFF + F.wave * TR_SCR);
    const int gw = F.vcu * NWAVES + F.wave, NGW = F.G * NWAVES;
    bf16* Win_t = (bf16*)(F.ws + WS_WIN); bf16* Wout_t = (bf16*)(F.ws + WS_WOUT); bf16* Wgu_t = (bf16*)(F.ws + WS_WGU); bf16* Wdn_t = (bf16*)(F.ws + WS_WDN); bf16* Wl_t = (bf16*)(F.ws + WS_WL);
    constexpr int I_IN = (D / 64) * (IN_COLS / 64);
    for (int it = gw; it < I_IN; it += NGW) p0_transpose_item(AR.in[I_WIN], D, IN_COLS, Win_t, 3, scr, it, F.lane);
    for (int e = (F.vcu * NWAVES * 64 + F.tid); e < NLORA * KLORA; e += F.G * NWAVES * 64) {
        const int row = e / KLORA, k = e % KLORA, kind = row >> 9, c = row & 511; float v = 0.f;
        if (kind == 0) { if (k < 64) v = AR.in[I_W2][k * 512 + c]; }
        else if (kind == 1) { if (k >= 64 && k < 128) v = AR.in[I_A2][(k - 64) * 512 + c]; }
        else { if (k >= 128) v = AR.in[I_G2][(k - 128) * 512 + c]; }
        Wl_t[e] = (bf16)f2bf(v);
    }
    bf16* XN = (bf16*)(F.ws + WS_XN);
    for (int m = gw * 4; m < M; m += NGW * 4) rms_rows_to_bf16<4>(F.lane, AR.in[I_X] + (size_t)m * D, D, AR.in[I_N1G], XN + (size_t)m * D, D);
}

__device__ __forceinline__ void p2_prep(Frame& F, const Args& AR) {
    const int gw = F.vcu * NWAVES + F.wave, NGW = F.G * NWAVES, lane = F.lane;
    const bf16* PROJ = (const bf16*)(F.ws + WS_PROJ); bf16* A2 = (bf16*)(F.ws + WS_A2);
    const f32x4 mu4 = *(const f32x4*)(AR.in[I_MU] + RC_L + 4 * lane);
    for (int m0 = 4 * gw; m0 < M; m0 += 4 * NGW) {
        const GAS bf16* row = (const GAS bf16*)PROJ + (size_t)m0 * IN_COLS + PC_RW + RC_L + 4 * lane;
        v2u w[5];
        w[0] = (v2u){0u, 0u};
        if ((m0 & (SEQ - 1)) != 0) w[0] = *(const GAS v2u*)(row - IN_COLS);
#pragma unroll
        for (int i = 0; i < 4; ++i) w[i + 1] = *(const GAS v2u*)(row + (size_t)i * IN_COLS);
#pragma unroll
        for (int i = 0; i < 4; ++i) {
            const v2u cu = w[i + 1], pv = w[i];
            const float c4[4] = {bflo(cu.x), bfhi(cu.x), bflo(cu.y), bfhi(cu.y)}, p4[4] = {bflo(pv.x), bfhi(pv.x), bflo(pv.y), bfhi(pv.y)};
            float xs[4];
#pragma unroll
            for (int e = 0; e < 4; ++e) { const float v = c4[e] + (p4[e] - c4[e]) * mu4[e];
                if (lane < 16) { const float t = __builtin_amdgcn_exp2f(2.f * LOG2E * v); xs[e] = 1.f - 2.f * __builtin_amdgcn_rcpf(t + 1.f); }
                else if (lane < 32) xs[e] = v;
                else xs[e] = fsig(v); }
            *(GAS v2u*)(A2 + (size_t)(m0 + i) * KLORA + 4 * lane) = (v2u){pk2(xs[0], xs[1]), pk2(xs[2], xs[3])};
        }
    }
}

__device__ __forceinline__ float red8(float x) {
    x += __builtin_bit_cast(float, __builtin_amdgcn_update_dpp(0, __builtin_bit_cast(int, x), 0xB1, 0xf, 0xf, false));
    x += __builtin_bit_cast(float, __builtin_amdgcn_update_dpp(0, __builtin_bit_cast(int, x), 0x4E, 0xf, 0xf, false));
    x += __builtin_bit_cast(float, __builtin_amdgcn_update_dpp(0, __builtin_bit_cast(int, x), 0x141, 0xf, 0xf, false));
    return x;
}
__device__ __forceinline__ float redrows(float x) {
    { auto r = __builtin_amdgcn_permlane16_swap(__float_as_uint(x), __float_as_uint(x), false, false); x = __uint_as_float(r[0]) + __uint_as_float(r[1]); }
    { auto r = __builtin_amdgcn_permlane32_swap(__float_as_uint(x), __float_as_uint(x), false, false); x = __uint_as_float(r[0]) + __uint_as_float(r[1]); }
    return x;
}
constexpr int CS = 16, NCHUNK = SEQ / CS, NHELP = 4, NSTATE = 4, NIT = (NCHUNK + NHELP - 1) / NHELP;
constexpr int ROWB = 144, TILEB = 40;
constexpr int SL_A = 0, SL_R = 16 * ROWB, SL_B = 32 * ROWB, SL_K = 48 * ROWB, SL_V = 64 * ROWB, SL_T = 80 * ROWB, SL_LAK = SL_T + 16 * TILEB, SL_LRB = SL_LAK + 16 * TILEB, SL_LRK = SL_LRB + 16 * TILEB,
              SL_G = SL_LRK + 16 * TILEB, SL_BON = SL_G + 256, SL_INV = SL_BON + 64, SL_BYTES = SL_INV + 64;
static_assert(SL_BYTES % 16 == 0 && SL_T % 8 == 0, "slot alignment");
constexpr int SC_CONST = 2 * NHELP * SL_BYTES;
constexpr int SC_YL = SC_CONST + 6 * 64 * 4, YL_BYTES = NHELP * CS * 256;
constexpr int SC_TS = SC_YL + 2 * YL_BYTES;
static_assert(SC_TS + NSTATE * NHELP * 16 * TILEB <= RING_BYTES && NHELP * CS * 8 == 2 * NSTATE * 64 && NCHUNK % NHELP == 0 && NHELP % 2 == 0, "scan LDS");
struct HReg { v4u r[2], k[2], v[2], pr[2], pk[2], pv[2], e[2], a[2]; };
__device__ __forceinline__ void helper_load(HReg& R, const bf16* PROJ, const bf16* DAG, int tok, int h, int kg) {
    const GAS bf16* row = (const GAS bf16*)PROJ + (size_t)tok * IN_COLS + PC_RW + h * 64 + 16 * kg;
    const GAS bf16* rowp = row - IN_COLS;
    const GAS bf16* dr = (const GAS bf16*)DAG + (size_t)tok * NLORA + h * 64 + 16 * kg;
    asm volatile("" : "+v"(row)); asm volatile("" : "+v"(rowp)); asm volatile("" : "+v"(dr));
    const bool hp = (tok & (SEQ - 1)) != 0;
#pragma unroll
    for (int i = 0; i < 2; ++i) {
        R.r[i] = *(const GAS v4u*)(row + RC_R + 8 * i); R.k[i] = *(const GAS v4u*)(row + RC_K + 8 * i); R.v[i] = *(const GAS v4u*)(row + RC_V + 8 * i);
        if (hp) { R.pr[i] = *(const GAS v4u*)(rowp + RC_R + 8 * i); R.pk[i] = *(const GAS v4u*)(rowp + RC_K + 8 * i); R.pv[i] = *(const GAS v4u*)(rowp + RC_V + 8 * i); }
        else { R.pr[i] = (v4u){0u, 0u, 0u, 0u}; R.pk[i] = R.pr[i]; R.pv[i] = R.pr[i]; }
        R.e[i] = *(const GAS v4u*)(dr + 8 * i); R.a[i] = *(const GAS v4u*)(dr + 512 + 8 * i);
    }
}
__device__ __forceinline__ void unpack4(const unsigned w0, const unsigned w1, float (&x)[4]) { x[0] = bflo(w0); x[1] = bfhi(w0); x[2] = bflo(w1); x[3] = bfhi(w1); }
__device__ __forceinline__ float dpp_shr(float x, const int ctrl_sel) {
    int r;
    if (ctrl_sel == 1) r = __builtin_amdgcn_update_dpp(0, __builtin_bit_cast(int, x), 0x111, 0xf, 0xf, true);
    else if (ctrl_sel == 2) r = __builtin_amdgcn_update_dpp(0, __builtin_bit_cast(int, x), 0x112, 0xf, 0xf, true);
    else if (ctrl_sel == 4) r = __builtin_amdgcn_update_dpp(0, __builtin_bit_cast(int, x), 0x114, 0xf, 0xf, true);
    else r = __builtin_amdgcn_update_dpp(0, __builtin_bit_cast(int, x), 0x118, 0xf, 0xf, true);
    return __builtin_bit_cast(float, r);
}
__device__ __forceinline__ unsigned cvt2s(float lo, float hi) { asm volatile("" : "+v"(lo), "+v"(hi)); return cvt2(lo, hi); }
__device__ __forceinline__ bf16x8 mk8(unsigned a, unsigned b, unsigned c, unsigned d) { return __builtin_bit_cast(bf16x8, (v4u){a, b, c, d}); }
__device__ __forceinline__ bf16x8 accB(const f32x4 v) { return mk8(cvt2(v[0], v[1]), cvt2(v[2], v[3]), 0u, 0u); }
__device__ __forceinline__ v2u trd(const LAS unsigned char* p) { typedef short v4i16_t __attribute__((ext_vector_type(4)));
    return __builtin_bit_cast(v2u, __builtin_amdgcn_ds_read_tr16_b64_v4i16((LAS v4i16_t*)p)); }
#define MFMA16(a, b, c) __builtin_amdgcn_mfma_f32_16x16x32_bf16((a), (b), (c), 0, 0, 0)
#define PIN_PTR(p) asm volatile("" : "+v"(p))

#define HR_UNPACK(dst, arr, gp) do { if ((gp) & 1) unpack4(R.arr[(gp) >> 1].z, R.arr[(gp) >> 1].w, dst); else unpack4(R.arr[(gp) >> 1].x, R.arr[(gp) >> 1].y, dst); } while (0)
__device__ __forceinline__ void helper_chunk(LAS unsigned char* slot, const LAS float* cst, HReg& R, bool prefetch, const bf16* PROJ, const bf16* DAG, float* BON, int tok, int h, int lane) {
    const int t = lane & 15, kg = lane >> 4;
    LAS unsigned char* p_row = slot + t * ROWB + kg * 16;
    LAS unsigned char* p_v = slot + SL_V + t * ROWB + kg * 32;
    LAS unsigned char* p_tw = slot + t * TILEB + kg * 8;
    LAS unsigned char* p_g = slot + SL_G + kg * 16;
    const LAS float* p_c = cst + 16 * kg;
    PIN_PTR(p_row); PIN_PTR(p_v); PIN_PTR(p_tw); PIN_PTR(p_g); PIN_PTR(p_c);
    float E[16], G[16], GI[16], GP[16];
#pragma unroll
    for (int gp = 0; gp < 4; ++gp) { float e[4]; HR_UNPACK(e, e, gp);
#pragma unroll
        for (int i = 0; i < 4; ++i) E[4 * gp + i] = e[i]; }
#pragma unroll
    for (int q = 0; q < 16; ++q) E[q] += dpp_shr(E[q], 1);
#pragma unroll
    for (int q = 0; q < 16; ++q) E[q] += dpp_shr(E[q], 2);
#pragma unroll
    for (int q = 0; q < 16; ++q) E[q] += dpp_shr(E[q], 4);
#pragma unroll
    for (int q = 0; q < 16; ++q) E[q] += dpp_shr(E[q], 8);
#pragma unroll
    for (int q = 0; q < 16; ++q) { G[q] = __builtin_amdgcn_exp2f(LOG2E * E[q]); GI[q] = __builtin_amdgcn_exp2f(-LOG2E * E[q]); }
#pragma unroll
    for (int q = 0; q < 16; ++q) { const float gpv = dpp_shr(G[q], 1); GP[q] = (t == 0) ? 1.f : gpv; }
    if (t == 15) {
#pragma unroll
        for (int gp = 0; gp < 4; ++gp) *(LAS f32x4*)(p_g + gp * 64) = (f32x4){G[4 * gp], G[4 * gp + 1], G[4 * gp + 2], G[4 * gp + 3]};
    }
    float ss = 0.f, bon = 0.f;
#pragma unroll
    for (int gp = 0; gp < 4; ++gp) {
        float r[4], k[4], v[4], pr[4], pk[4], pv[4], a[4];
        HR_UNPACK(r, r, gp); HR_UNPACK(k, k, gp); HR_UNPACK(v, v, gp); HR_UNPACK(pr, pr, gp); HR_UNPACK(pk, pk, gp); HR_UNPACK(pv, pv, gp); HR_UNPACK(a, a, gp);
        const f32x4 mur = *(const LAS f32x4*)(p_c + 0 * 64 + 4 * gp), muk = *(const LAS f32x4*)(p_c + 1 * 64 + 4 * gp), muv = *(const LAS f32x4*)(p_c + 2 * 64 + 4 * gp);
        const f32x4 kkc = *(const LAS f32x4*)(p_c + 3 * 64 + 4 * gp), kac = *(const LAS f32x4*)(p_c + 4 * 64 + 4 * gp), rkc = *(const LAS f32x4*)(p_c + 5 * 64 + 4 * gp);
        float xv[4], At[4], Rt[4], Bt[4], Kt[4];
#pragma unroll
        for (int i = 0; i < 4; ++i) { const int q = 4 * gp + i;
            const float xr = r[i] + (pr[i] - r[i]) * mur[i], xk = k[i] + (pk[i] - k[i]) * muk[i]; xv[i] = v[i] + (pv[i] - v[i]) * muv[i];
            const float kkv = xk * kkc[i], kpv = xk * (1.f + (a[i] - 1.f) * kac[i]); ss += kkv * kkv; bon += xr * kpv * rkc[i];
            At[i] = -kkv * GP[q]; Rt[i] = xr * G[q]; Bt[i] = kkv * a[i] * GI[q]; Kt[i] = kpv * GI[q]; }
        *(LAS v2u*)(p_v + gp * 8) = (v2u){cvt2s(xv[0], xv[1]), cvt2s(xv[2], xv[3])};
        const int co = (gp >> 1) * 64 + (gp & 1) * 8;
        *(LAS v2u*)(p_row + SL_A + co) = (v2u){cvt2s(At[0], At[1]), cvt2s(At[2], At[3])}; *(LAS v2u*)(p_row + SL_R + co) = (v2u){cvt2s(Rt[0], Rt[1]), cvt2s(Rt[2], Rt[3])};
        *(LAS v2u*)(p_row + SL_B + co) = (v2u){cvt2s(Bt[0], Bt[1]), cvt2s(Bt[2], Bt[3])}; *(LAS v2u*)(p_row + SL_K + co) = (v2u){cvt2s(Kt[0], Kt[1]), cvt2s(Kt[2], Kt[3])};
    }
    ss = redrows(ss); bon = redrows(bon);
    const float inv = __builtin_amdgcn_rsqf(fmaxf(ss, 1e-24f));
    if (kg == 0) { *(LAS float*)(slot + SL_BON + t * 4) = bon; *(LAS float*)(slot + SL_INV + t * 4) = inv; }
    if (prefetch) helper_load(R, PROJ, DAG, tok + NHELP * CS, h, kg);
    const bf16x8 FA0 = *(const LAS bf16x8*)(p_row + SL_A), FA1 = *(const LAS bf16x8*)(p_row + SL_A + 64), FR0 = *(const LAS bf16x8*)(p_row + SL_R), FR1 = *(const LAS bf16x8*)(p_row + SL_R + 64);
    const bf16x8 FB0 = *(const LAS bf16x8*)(p_row + SL_B), FB1 = *(const LAS bf16x8*)(p_row + SL_B + 64), FK0 = *(const LAS bf16x8*)(p_row + SL_K), FK1 = *(const LAS bf16x8*)(p_row + SL_K + 64);
    const f32x4 z4 = (f32x4){0.f, 0.f, 0.f, 0.f};
    f32x4 Lab = MFMA16(FA0, FB0, z4); Lab = MFMA16(FA1, FB1, Lab);
    f32x4 Lak = MFMA16(FA0, FK0, z4); Lak = MFMA16(FA1, FK1, Lak);
    f32x4 Lrb = MFMA16(FR0, FB0, z4); Lrb = MFMA16(FR1, FB1, Lrb);
    f32x4 Lrk = MFMA16(FR0, FK0, z4); Lrk = MFMA16(FR1, FK1, Lrk);
    const int s = t;
#pragma unroll
    for (int r = 0; r < 4; ++r) { const int tt = 4 * kg + r;
        Lab[r] = tt > s ? Lab[r] : 0.f; Lak[r] = tt > s ? Lak[r] : 0.f; Lrb[r] = tt >= s ? Lrb[r] : 0.f; Lrk[r] = tt >= s ? Lrk[r] : 0.f; }
    { const f32x4 ir = *(const LAS f32x4*)(slot + SL_INV + 16 * kg);
      Lab = Lab * ir * inv; }
#define WR_TILE(off, X) (*(LAS v2u*)(p_tw + (off)) = (v2u){cvt2((X)[0], (X)[1]), cvt2((X)[2], (X)[3])})
    WR_TILE(SL_LAK, Lak); WR_TILE(SL_LRB, Lrb); WR_TILE(SL_LRK, Lrk); WR_TILE(SL_T, Lab);
#undef WR_TILE
}

struct SOps { bf16x8 a0, a1, r0, r1; v2u vt, lak, lrb, lrk, bb[4], kk2[4]; f32x4 gm[4], bn, iv; };
__device__ __forceinline__ void state_load(SOps& O, const LAS unsigned char* slot, int lane, int wv) {
    const int c = lane & 15, g = lane >> 4, q4 = 4 * g + (c >> 2), pp = c & 3;
    const LAS unsigned char* p128 = slot + c * ROWB + g * 16;
    const LAS unsigned char* p_bt = slot + q4 * ROWB + pp * 16;
    const LAS unsigned char* p_tr = slot + q4 * TILEB + pp * 8;
    const LAS unsigned char* p_v = slot + SL_V + q4 * ROWB + wv * 32 + pp * 8;
    const LAS unsigned char* pg = slot + SL_G + g * 16;
    PIN_PTR(p128); PIN_PTR(p_bt); PIN_PTR(p_tr); PIN_PTR(p_v); PIN_PTR(pg);
    O.a0 = *(const LAS bf16x8*)(p128 + SL_A); O.a1 = *(const LAS bf16x8*)(p128 + SL_A + 64); O.r0 = *(const LAS bf16x8*)(p128 + SL_R); O.r1 = *(const LAS bf16x8*)(p128 + SL_R + 64);
    O.vt = trd(p_v); O.lak = trd(p_tr + SL_LAK); O.lrb = trd(p_tr + SL_LRB); O.lrk = trd(p_tr + SL_LRK);
#pragma unroll
    for (int jb = 0; jb < 4; ++jb) { O.bb[jb] = trd(p_bt + SL_B + (jb >> 1) * 64 + (jb & 1) * 8); O.kk2[jb] = trd(p_bt + SL_K + (jb >> 1) * 64 + (jb & 1) * 8); O.gm[jb] = *(const LAS f32x4*)(pg + jb * 64); }
    O.bn = *(const LAS f32x4*)(slot + SL_BON + 16 * g); O.iv = *(const LAS f32x4*)(slot + SL_INV + 16 * g);
}
__device__ __forceinline__ void state_compute(const SOps& O, const v2u tt, f32x4 (&X)[4], LAS unsigned char* yl, int lane, int wv) {
    const int c = lane & 15, g = lane >> 4;
    const f32x4 z4 = (f32x4){0.f, 0.f, 0.f, 0.f};
    const bf16x8 xb0 = mk8(cvt2(X[0][0], X[0][1]), cvt2(X[0][2], X[0][3]), cvt2(X[1][0], X[1][1]), cvt2(X[1][2], X[1][3]));
    const bf16x8 xb1 = mk8(cvt2(X[2][0], X[2][1]), cvt2(X[2][2], X[2][3]), cvt2(X[3][0], X[3][1]), cvt2(X[3][2], X[3][3]));
    f32x4 Z = MFMA16(O.a0, xb0, z4); Z = MFMA16(O.a1, xb1, Z); Z = MFMA16(mk8(O.lak.x, O.lak.y, 0u, 0u), mk8(O.vt.x, O.vt.y, 0u, 0u), Z) * O.iv;
    const f32x4 U = MFMA16(mk8(tt.x, tt.y, 0u, 0u), accB(Z), z4) * O.iv;
    const bf16x8 uv = mk8(cvt2(U[0], U[1]), cvt2(U[2], U[3]), O.vt.x, O.vt.y);
    f32x4 Y = MFMA16(O.r0, xb0, z4); Y = MFMA16(O.r1, xb1, Y); Y = MFMA16(mk8(O.lrb.x, O.lrb.y, O.lrk.x, O.lrk.y), uv, Y);
#pragma unroll
    for (int jb = 0; jb < 4; ++jb) X[jb] = MFMA16(mk8(O.bb[jb].x, O.bb[jb].y, O.kk2[jb].x, O.kk2[jb].y), uv, X[jb]) * O.gm[jb];
    LAS unsigned char* py = yl + (4 * g) * 256 + (16 * wv + c) * 2;
    PIN_PTR(py);
    const float vv[4] = {bflo(O.vt.x), bfhi(O.vt.x), bflo(O.vt.y), bfhi(O.vt.y)};
#pragma unroll
    for (int r = 0; r < 4; ++r) { *(LAS unsigned short*)(py + r * 256) = (unsigned short)f2bf(Y[r]); *(LAS unsigned short*)(py + r * 256 + 128) = (unsigned short)f2bf(O.bn[r] * vv[r]); }
}
__device__ __forceinline__ void state_T(v2u (&tt)[NHELP], const LAS unsigned char* set0, LAS unsigned char* scr, int lane) {
    const int c = lane & 15, g = lane >> 4;
    const int o_w = c * TILEB + g * 8, o_r = (4 * g + (c >> 2)) * TILEB + (c & 3) * 8;
    const f32x4 z4 = (f32x4){0.f, 0.f, 0.f, 0.f};
    bf16x8 A1[NHELP], A2[NHELP], A4[NHELP]; f32x4 P[NHELP];
#pragma unroll
    for (int k = 0; k < NHELP; ++k) { const LAS unsigned char* tl = set0 + k * SL_BYTES + SL_T;
        const v2u bl = *(const LAS v2u*)(tl + o_w), al = trd(tl + o_r); A1[k] = mk8(al.x, al.y, 0u, 0u); P[k] = MFMA16(A1[k], mk8(bl.x, bl.y, 0u, 0u), z4); }
#pragma unroll
    for (int k = 0; k < NHELP; ++k) *(LAS v2u*)(scr + k * (16 * TILEB) + o_w) = (v2u){cvt2(P[k][0], P[k][1]), cvt2(P[k][2], P[k][3])};
#pragma unroll
    for (int k = 0; k < NHELP; ++k) { const v2u al = trd(scr + k * (16 * TILEB) + o_r); A2[k] = mk8(al.x, al.y, 0u, 0u); P[k] = MFMA16(A2[k], accB(P[k]), z4); }
#pragma unroll
    for (int k = 0; k < NHELP; ++k) *(LAS v2u*)(scr + k * (16 * TILEB) + o_w) = (v2u){cvt2(P[k][0], P[k][1]), cvt2(P[k][2], P[k][3])};
#pragma unroll
    for (int k = 0; k < NHELP; ++k) { const v2u al = trd(scr + k * (16 * TILEB) + o_r); A4[k] = mk8(al.x, al.y, 0u, 0u); P[k] = MFMA16(A4[k], accB(P[k]), z4); }
#pragma unroll
    for (int k = 0; k < NHELP; ++k) {
#pragma unroll
        for (int r = 0; r < 4; ++r) P[k][r] += (4 * g + r == c) ? 1.f : 0.f; }
#pragma unroll
    for (int k = 0; k < NHELP; ++k) P[k] = MFMA16(A4[k], accB(P[k]), P[k]);
#pragma unroll
    for (int k = 0; k < NHELP; ++k) P[k] = MFMA16(A2[k], accB(P[k]), P[k]);
#pragma unroll
    for (int k = 0; k < NHELP; ++k) P[k] = MFMA16(A1[k], accB(P[k]), P[k]);
#pragma unroll
    for (int k = 0; k < NHELP; ++k) *(LAS v2u*)(scr + k * (16 * TILEB) + o_w) = (v2u){cvt2(P[k][0], P[k][1]), cvt2(P[k][2], P[k][3])};
#pragma unroll
    for (int k = 0; k < NHELP; ++k) tt[k] = trd(scr + k * (16 * TILEB) + o_r);
}

__device__ __forceinline__ void p4_scan(Frame& F, const Args& AR) {
    const bf16* PROJ = (const bf16*)(F.ws + WS_PROJ); const bf16* DAG = (const bf16*)(F.ws + WS_DAG);
    float* BON = nullptr; bf16* MIX = (bf16*)(F.ws + WS_XN);
    LAS unsigned char* lds = F.lds + RING_OFF;
    LAS float* cst = (LAS float*)(lds + SC_CONST);
    const int tid = F.tid, lane = F.lane, wave = F.wave;
    for (int unit = blockIdx.x; unit < BATCH * NH; unit += F.G) {
        const int b = unit >> 3, h = unit & 7;
        const int tok0 = b * SEQ;
        if (tid < 384) { const int a = tid >> 6, c = tid & 63; const float* src = a == 0 ? AR.in[I_MU] + RC_R : a == 1 ? AR.in[I_MU] + RC_K : a == 2 ? AR.in[I_MU] + RC_V : a == 3 ? AR.in[I_KK] : a == 4 ? AR.in[I_KA] : AR.in[I_RK];
            cst[a * 64 + c] = src[h * 64 + c]; }
        __syncthreads();
        const int st_k = (tid >> 7) & 1, st_t = (tid >> 3) & 15, st_p = tid & 7;
        GAS v4u* ystore = (GAS v4u*)((GAS bf16*)MIX + (size_t)(tok0 + st_k * CS + st_t) * D + AW + h * 64 + 8 * st_p);
        const GAS v4u* gload = (const GAS v4u*)((const GAS bf16*)DAG + (size_t)(tok0 + st_k * CS + st_t) * NLORA + 1024 + h * 64 + 8 * st_p);
        const LAS unsigned char* yl_rd = lds + SC_YL + st_k * (CS * 256) + st_t * 256 + st_p * 16;
        v4u gnA = (v4u){0u, 0u, 0u, 0u}, gnB = gnA;
        float lng[8], lnb[8];
#pragma unroll
        for (int i = 0; i < 8; ++i) { lng[i] = AR.in[I_LNG][h * 64 + 8 * st_p + i]; lnb[i] = AR.in[I_LNB][h * 64 + 8 * st_p + i]; }
#define RWKV_OUT(it_, KO, gnext) do { if ((it_) >= 2 && NHELP * ((it_) - 2) + st_k + (KO) < NCHUNK) { \
            const v4u gw4 = gnext; \
            const v4u yw = *(const LAS v4u*)(yl_rd + (KO) * (CS * 256) + ((it_) & 1) * YL_BYTES), bw = *(const LAS v4u*)(yl_rd + (KO) * (CS * 256) + ((it_) & 1) * YL_BYTES + 128); \
            float y[8] = {bflo(yw.x), bfhi(yw.x), bflo(yw.y), bfhi(yw.y), bflo(yw.z), bfhi(yw.z), bflo(yw.w), bfhi(yw.w)}; \
            float sm = ((y[0] + y[1]) + (y[2] + y[3])) + ((y[4] + y[5]) + (y[6] + y[7])); \
            sm = red8(sm); \
            const float mean = sm * (1.f / 64.f); float sv = 0.f; \
            _Pragma("unroll") for (int i = 0; i < 8; ++i) { y[i] -= mean; sv += y[i] * y[i]; } \
            sv = red8(sv); \
            const float rs = 1.f / sqrtf(sv * (1.f / 64.f) + LNX_EPS); \
            const float bf_[8] = {bflo(bw.x), bfhi(bw.x), bflo(bw.y), bfhi(bw.y), bflo(bw.z), bfhi(bw.z), bflo(bw.w), bfhi(bw.w)}; \
            const float gf[8] = {bflo(gw4.x), bfhi(gw4.x), bflo(gw4.y), bfhi(gw4.y), bflo(gw4.z), bfhi(gw4.z), bflo(gw4.w), bfhi(gw4.w)}; \
            float ro[8]; \
            _Pragma("unroll") for (int i = 0; i < 8; ++i) ro[i] = (y[i] * rs * lng[i] + lnb[i] + bf_[i]) * gf[i]; \
            ystore[(size_t)(NHELP * ((it_) - 2) + (KO)) * CS * D / 8] = (v4u){pk2(ro[0], ro[1]), pk2(ro[2], ro[3]), pk2(ro[4], ro[5]), pk2(ro[6], ro[7])}; } \
            if ((it_) >= 1 && NHELP * ((it_) - 1) + st_k + (KO) < NCHUNK) gnext = gload[(size_t)(NHELP * ((it_) - 1) + (KO)) * CS * NLORA / 8]; } while (0)
        volatile LAS unsigned* cnt = (volatile LAS unsigned*)(F.lds + LDSCTL_OFF + 128);
        if (tid < 8) cnt[tid] = 0u;
        __syncthreads();
#define LDS_WAIT_GE(idx, target) do { while (cnt[idx] < (unsigned)(target)) __builtin_amdgcn_s_sleep(1); asm volatile("" ::: "memory"); } while (0)
#define LDS_SIGNAL(idx) do { asm volatile("s_waitcnt lgkmcnt(0)" ::: "memory"); if (lane == 0) __hip_atomic_fetch_add((LAS unsigned*)(cnt + (idx)), 1u, __ATOMIC_RELAXED, __HIP_MEMORY_SCOPE_WORKGROUP); } while (0)
        if (wave >= NSTATE) {
            const int hw = wave - NSTATE, kg = lane >> 4, tokl = tok0 + (lane & 15);
            HReg R;
            helper_load(R, PROJ, DAG, tokl + hw * CS, h, kg);
            for (int it = 0; it < NIT; ++it) {
                const int ch = NHELP * it + hw, s_ = it & 1;
                if (it >= 2) LDS_WAIT_GE(2 + s_, NSTATE * (it >> 1));
                helper_chunk(lds + (s_ * NHELP + hw) * SL_BYTES, cst, R, ch + NHELP < NCHUNK, PROJ, DAG, BON, tokl + ch * CS, h, lane);
                LDS_SIGNAL(0 + s_);
            }
        } else {
            f32x4 X[4];
#pragma unroll
            for (int jb = 0; jb < 4; ++jb) X[jb] = (f32x4){0.f, 0.f, 0.f, 0.f};
            for (int j = 0; j <= NIT; ++j) {
                if (j >= 1) { LDS_WAIT_GE(4 + ((j - 1) & 1), NSTATE * (((j - 1) >> 1) + 1));
                    RWKV_OUT(j + 1, 0, gnA); RWKV_OUT(j + 1, 2, gnB);
                    LDS_SIGNAL(6 + ((j - 1) & 1)); }
                else { RWKV_OUT(j + 1, 0, gnA); RWKV_OUT(j + 1, 2, gnB); }
                if (j < NIT) {
                    const int s_ = j & 1;
                    LDS_WAIT_GE(0 + s_, NHELP * ((j >> 1) + 1));
                    if (j >= 2) LDS_WAIT_GE(6 + s_, NSTATE * (j >> 1));
                    const LAS unsigned char* set0 = lds + (s_ * NHELP) * SL_BYTES;
                    LAS unsigned char* ylb = lds + SC_YL + s_ * YL_BYTES;
                    v2u tt[NHELP];
                    SOps Oa, Ob;
                    state_load(Oa, set0, lane, wave);
                    state_T(tt, set0, lds + SC_TS + wave * (NHELP * 16 * TILEB), lane);
#pragma unroll
                    for (int k = 0; k < NHELP; k += 2) {
                        state_load(Ob, set0 + (k + 1) * SL_BYTES, lane, wave);
                        state_compute(Oa, tt[k], X, ylb + k * (CS * 256), lane, wave);
                        if (k + 2 < NHELP) state_load(Oa, set0 + (k + 2) * SL_BYTES, lane, wave);
                        state_compute(Ob, tt[k + 1], X, ylb + (k + 1) * (CS * 256), lane, wave);
                    }
                    LDS_SIGNAL(2 + s_); LDS_SIGNAL(4 + s_);
                }
            }
        }
#undef LDS_WAIT_GE
#undef LDS_SIGNAL
        __syncthreads();
    }
}

__device__ __forceinline__ s16x4 vtr(const LAS unsigned char* p) { typedef short v4i16_t __attribute__((ext_vector_type(4)));
    return __builtin_bit_cast(s16x4, __builtin_amdgcn_ds_read_tr16_b64_v4i16((LAS v4i16_t*)p)); }
constexpr int ATT_UNITS = 3 * BATCH * NH * 16;
__device__ __forceinline__ void p4_attn(Frame& F, const Args& AR) {
    const bf16* PROJ = (const bf16*)(F.ws + WS_PROJ);
    bf16* PO = (bf16*)((unsigned char*)F.out + DO_PO); float* ML = (float*)(F.ws + WS_ML);
    const int tid = F.tid, lane = F.lane, wave = F.wave, half = wave >> 2, wq = wave & 3, th = tid & 255;
    const int r32 = lane & 31, hi = lane >> 5;
    LAS unsigned char* Kl = F.lds + RING_OFF + half * 65536; LAS unsigned char* Vl = Kl + 32768;
    gu32* qctr = F.ctl + CW_ATTQ;
    v4u kst[8], vst[8];
#define ATT_DECODE(up_) const int unit = 2 * (up_) + half; \
        const int pat = unit / (BATCH * NH * 16), rem = unit % (BATCH * NH * 16), bh = rem >> 4, i16 = rem & 15, b = bh >> 3, h = bh & 7; \
        const int dil = pat == 0 ? 1 : (pat == 1 ? 4 : 16); \
        const int res = pat == 0 ? 0 : (pat == 1 ? (i16 >> 2) : i16); \
        const int n = pat == 0 ? i16 : (pat == 1 ? (i16 & 3) : 0); \
        const size_t rowb = (size_t)b * SEQ;
#define ATT_ISSUE(up_) do { ATT_DECODE(up_) const int c = th & 7; \
        _Pragma("unroll") for (int i = 0; i < 8; ++i) { const int key = (th >> 3) + 32 * i; const int sub = 128 * (n - 1) + key; \
            kst[i] = (v4u){0u, 0u, 0u, 0u}; vst[i] = kst[i]; \
            if (sub >= 0) { const GAS bf16* src = (const GAS bf16*)PROJ + (rowb + res + dil * sub) * IN_COLS + h * 64 + 8 * c; kst[i] = *(const GAS v4u*)(src + PC_K); vst[i] = *(const GAS v4u*)(src + PC_V); } } } while (0)
    if (tid == 0) F.MISC[16] = __hip_atomic_fetch_add(qctr, 1u, RLX_AGENT);
    __syncthreads();
    int up = (int)F.MISC[16];
    __syncthreads();
    if (up < ATT_UNITS / 2) ATT_ISSUE(up);
    while (up < ATT_UNITS / 2) {
        if (tid == 0) F.MISC[16] = __hip_atomic_fetch_add(qctr, 1u, RLX_AGENT);
        ATT_DECODE(up)
        const int ql = 32 * wq + r32; const size_t qrow = rowb + res + dil * (128 * n + ql);
        bf16x8 qf[4];
#pragma unroll
        for (int d0 = 0; d0 < 4; ++d0) qf[d0] = *(const GAS bf16x8*)((const GAS bf16*)PROJ + qrow * IN_COLS + PC_Q + h * 64 + 16 * d0 + 8 * hi);
        {
            const int c = th & 7;
#pragma unroll
            for (int i = 0; i < 8; ++i) {
                const int key = (th >> 3) + 32 * i;
                *(LAS v4u*)(Kl + key * 128 + ((c ^ ((key >> 1) & 7)) * 16)) = kst[i];
                *(LAS v4u*)(Vl + (c >> 2) * 16384 + key * 64 + (c & 3) * 16) = vst[i];
            }
        }
        __syncthreads();
        const int upn = (int)F.MISC[16];
        if (upn < ATT_UNITS / 2) { ATT_ISSUE(upn); }
        const float slope2 = __builtin_amdgcn_exp2f(-(float)(h + 1)) * (float)dil * LOG2E;
        const int thr = r32 - 4 * hi;
        f32x16 sc[5];
        float mx = -INFINITY;
#pragma unroll
        for (int kt = 0; kt < 5; ++kt) {
            const bool skip = (n == 0) && (wq + kt < 4);
            f32x16 acc;
            if (!skip) {
                const int key = 32 * (wq + kt) + r32;
                const float bk = -slope2 * (float)(128 - 32 * kt + thr);
#pragma unroll
                for (int r = 0; r < 16; ++r) acc[r] = slope2 * (float)((r & 3) + 8 * (r >> 2)) + bk;
#pragma unroll
                for (int d0 = 0; d0 < 4; ++d0) {
                    const bf16x8 kf = *(const LAS bf16x8*)(Kl + key * 128 + (((2 * d0 + hi) ^ ((key >> 1) & 7)) * 16));
                    acc = __builtin_amdgcn_mfma_f32_32x32x16_bf16(kf, qf[d0], acc, 0, 0, 0);
                }
                if (kt == 0) {
#pragma unroll
                    for (int r = 0; r < 16; ++r) acc[r] = ((r & 3) + 8 * (r >> 2)) >= thr ? acc[r] : -INFINITY;
                }
                if (kt == 4) {
#pragma unroll
                    for (int r = 0; r < 16; ++r) acc[r] = ((r & 3) + 8 * (r >> 2)) <= thr ? acc[r] : -INFINITY;
                }
#pragma unroll
                for (int r = 0; r < 16; ++r) mx = fmaxf(mx, acc[r]);
            } else {
#pragma unroll
                for (int r = 0; r < 16; ++r) acc[r] = -INFINITY;
            }
            sc[kt] = acc;
            __builtin_amdgcn_sched_barrier(0);
        }
        mx = fmaxf(mx, __shfl_xor(mx, 32));
        float l = 0.f;
#pragma unroll
        for (int kt = 0; kt < 5; ++kt)
#pragma unroll
            for (int r = 0; r < 16; ++r) { const float p = __builtin_amdgcn_exp2f(sc[kt][r] - mx); sc[kt][r] = p; l += p; }
        l += __shfl_xor(l, 32);
        f32x16 o[2]; o[0] = f32x16{}; o[1] = f32x16{};
        const int voff = ((lane >> 4) & 1) * 32 + (lane & 3) * 8 + (4 * hi + ((lane & 15) >> 2)) * 64;
#pragma unroll
        for (int kt = 0; kt < 5; ++kt) {
            const bool skip = (n == 0) && (wq + kt < 4);
            if (!skip) {
#pragma unroll
            for (int s2 = 0; s2 < 2; ++s2) {
                v4u pw;
                pw.x = pg8::cvt_pk_bf16(sc[kt][8 * s2 + 0], sc[kt][8 * s2 + 1]); pw.y = pg8::cvt_pk_bf16(sc[kt][8 * s2 + 2], sc[kt][8 * s2 + 3]);
                pw.z = pg8::cvt_pk_bf16(sc[kt][8 * s2 + 4], sc[kt][8 * s2 + 5]); pw.w = pg8::cvt_pk_bf16(sc[kt][8 * s2 + 6], sc[kt][8 * s2 + 7]);
                const bf16x8 pf = __builtin_bit_cast(bf16x8, pw);
                const int kb = 32 * (wq + kt) + 16 * s2;
#pragma unroll
                for (int dt = 0; dt < 2; ++dt) {
                    const LAS unsigned char* vp = Vl + dt * 16384 + kb * 64 + voff;
                    const s16x4 lo = vtr(vp), hi4 = vtr(vp + 8 * 64);
                    const bf16x8 vf = (bf16x8){lo[0], lo[1], lo[2], lo[3], hi4[0], hi4[1], hi4[2], hi4[3]};
                    o[dt] = __builtin_amdgcn_mfma_f32_32x32x16_bf16(vf, pf, o[dt], 0, 0, 0);
                }
            }
            }
        }
        const float rl = 1.f / l;
        bf16* po = PO + ((size_t)pat * M + qrow) * AW + h * 64;
#pragma unroll
        for (int dt = 0; dt < 2; ++dt)
#pragma unroll
            for (int g = 0; g < 4; ++g) {
                const v2u w = (v2u){pk2(o[dt][4 * g] * rl, o[dt][4 * g + 1] * rl), pk2(o[dt][4 * g + 2] * rl, o[dt][4 * g + 3] * rl)};
                *(v2u*)(po + 32 * dt + 8 * g + 4 * hi) = w;
            }
        if (hi == 0) *(f32x2*)(ML + (((size_t)pat * M + qrow) * NH + h) * 2) = (f32x2){mx, l};
        __syncthreads();
        up = upn;
    }
#undef ATT_DECODE
#undef ATT_ISSUE
}

struct P5In { v4u po[3]; f32x2 ml[3]; };
__device__ __forceinline__ void p5_load(P5In& I, int m, int lane, const bf16* PO, const float* ML) {
    const int hd = lane >> 3;
#pragma unroll
    for (int p = 0; p < 3; ++p) { I.ml[p] = *(const GAS f32x2*)(ML + (((size_t)p * M + m) * NH + hd) * 2); I.po[p] = *(const GAS v4u*)(PO + ((size_t)p * M + m) * AW + 8 * lane); }
}
__device__ __forceinline__ void p5_token(const P5In& I, int m, int lane, bf16* MIX, const float (&aog)[8]) {
    const float mm = fmaxf(fmaxf(I.ml[0].x, I.ml[1].x), I.ml[2].x);
    float wp[3], wsum = 0.f;
#pragma unroll
    for (int p = 0; p < 3; ++p) { wp[p] = __builtin_amdgcn_exp2f(I.ml[p].x - mm) * I.ml[p].y; wsum += wp[p]; }
    const float rws = 1.f / wsum;
    float at[8] = {0.f, 0.f, 0.f, 0.f, 0.f, 0.f, 0.f, 0.f};
#pragma unroll
    for (int p = 0; p < 3; ++p) { const v4u w = I.po[p]; const float f = wp[p] * rws;
        at[0] += f * bflo(w.x); at[1] += f * bfhi(w.x); at[2] += f * bflo(w.y); at[3] += f * bfhi(w.y); at[4] += f * bflo(w.z); at[5] += f * bfhi(w.z); at[6] += f * bflo(w.w); at[7] += f * bfhi(w.w); }
    float ss = 0.f;
#pragma unroll
    for (int i = 0; i < 8; ++i) ss += at[i] * at[i];
    ss += __shfl_xor(ss, 1); ss += __shfl_xor(ss, 2); ss += __shfl_xor(ss, 4);
    const float rstd = 1.f / sqrtf(ss * (1.f / 64.f) + NORM_EPS);
    v4u oa; oa.x = pk2(at[0] * rstd * aog[0], at[1] * rstd * aog[1]); oa.y = pk2(at[2] * rstd * aog[2], at[3] * rstd * aog[3]);
    oa.z = pk2(at[4] * rstd * aog[4], at[5] * rstd * aog[5]); oa.w = pk2(at[6] * rstd * aog[6], at[7] * rstd * aog[7]);
    *(GAS v4u*)(MIX + (size_t)m * D + 8 * lane) = oa;
}
__device__ __forceinline__ void p5_post(Frame& F, const Args& AR) {
    const int gw = F.vcu * NWAVES + F.wave, NGW = F.G * NWAVES, lane = F.lane;
    const bf16* PO = (const bf16*)((unsigned char*)F.out + DO_PO); const float* ML = (const float*)(F.ws + WS_ML);
    bf16* MIX = (bf16*)(F.ws + WS_XN);
    float aog[8];
#pragma unroll
    for (int i = 0; i < 8; ++i) aog[i] = AR.in[I_AOG][8 * lane + i];
    static_assert(M % 4 == 0, "four tokens per step");
    for (int m = 4 * gw; m < M; m += 4 * NGW) {
        P5In A, B, C, E;
        p5_load(A, m, lane, PO, ML); p5_load(B, m + 1, lane, PO, ML); p5_load(C, m + 2, lane, PO, ML); p5_load(E, m + 3, lane, PO, ML);
        p5_token(A, m, lane, MIX, aog); p5_token(B, m + 1, lane, MIX, aog); p5_token(C, m + 2, lane, MIX, aog); p5_token(E, m + 3, lane, MIX, aog);
    }
}

__device__ __forceinline__ void p1_tail_weights(Frame& F, const Args& AR, int w0, int nw) {
    LAS float* scr = (LAS float*)(F.lds + RING_OFF + F.wave * TR_SCR);
    bf16* Wout_t = (bf16*)(F.ws + WS_WOUT); bf16* Wgu_t = (bf16*)(F.ws + WS_WGU); bf16* Wdn_t = (bf16*)(F.ws + WS_WDN);
    constexpr int I_OUT = (D / 64) * (D / 64), I_G = (D / 64) * (FF / 64), I_DN = (FF / 64) * (D / 64), NLATE = I_OUT + 2 * I_G + I_DN;
    for (int it = w0; it < NLATE; it += nw) {
        int r = it;
        if (r < I_OUT) { p0_transpose_item(AR.in[I_WOUT], D, D, Wout_t, 0, scr, r, F.lane); continue; } r -= I_OUT;
        if (r < I_G) { p0_transpose_item(AR.in[I_WG], D, FF, Wgu_t, 1, scr, r, F.lane, AR.in[I_N2G]); continue; } r -= I_G;
        if (r < I_G) { p0_transpose_item(AR.in[I_WU], D, FF, Wgu_t, 2, scr, r, F.lane, AR.in[I_N2G]); continue; } r -= I_G;
        p0_transpose_item(AR.in[I_WD], FF, D, Wdn_t, 0, scr, r, F.lane);
    }
}

__global__ void __launch_bounds__(NWAVES * 64, 2) hybrid_fwd(Args args) {
    extern __shared__ __attribute__((aligned(16))) unsigned char lds[];
    Frame F;
    F.lds = (LAS unsigned char*)lds;
    F.MISC = (volatile LAS unsigned*)(F.lds + MISC_OFF);
    F.tid = threadIdx.x; F.lane = F.tid & 63; F.wave = __builtin_amdgcn_readfirstlane(F.tid >> 6);
    F.G = gridDim.x; { const int bx = blockIdx.x; F.vcu = (F.G % 8 == 0) ? (bx % 8) * (F.G / 8) + bx / 8 : bx; }
    F.ws = args.ws; F.out = args.out;
    F.ctl = (gu32*)(args.ws + WS_CTL);
    for (int u = F.tid; u < (LDS_BYTES - LDSCTL_OFF) / 4; u += NWAVES * 64) ((LAS unsigned*)(F.lds + LDSCTL_OFF))[u] = 0u;
    __syncthreads();
    XcdBarrier bar; bar.bar = (unsigned*)(F.ctl + CW_BAR); bar.x = 0; bar.st = nullptr;
    if (N_LAUNCHES != PER_PHASE) bar = xcd_barrier_post((unsigned*)(F.ctl + CW_BAR), F.MISC + 8);
#define GRID_BAR() do { if (N_LAUNCHES != PER_PHASE) xcd_barrier(bar); } while (0)
    const int lo = args.ph_lo, hi = args.ph_hi;
#ifndef PHMASK
#define PHMASK 0x3ff
#endif
#define IN(k) (((PHMASK >> (k)) & 1) && lo <= (k) && (k) < hi)
#define BOTH(k) (IN(k) && IN((k) + 1))
#define PSTAMP(i) do { if (PROBE_SEL >= 0 && blockIdx.x == 0 && F.tid == 0) { const unsigned long long t_ = __builtin_amdgcn_s_memtime(); __hip_atomic_store(F.ctl + 9100 + (i), (unsigned)(t_ >> 4), RLX_AGENT); } } while (0)
#ifndef REPMASK
#define REPMASK 0
#endif
#define REP(k) for (int rep_ = 0; rep_ <= ((REPMASK >> (k)) & 1); ++rep_)
    bf16* XN = (bf16*)(args.ws + WS_XN); bf16* PROJ = (bf16*)(args.ws + WS_PROJ);

    PSTAMP(0);
    if (IN(0)) { p0_prologue(F, args); if (BOTH(0)) GRID_BAR(); }
    PSTAMP(1);
    if (IN(1)) {
        pg8::Gemm g{XN, (const bf16*)(args.ws + WS_WIN), M, IN_COLS, D}; pg8::StaticOrder S; S.init(M, IN_COLS, F.G, (int)blockIdx.x);
        pg8::EpiProj E{PROJ, IN_COLS, args.in[I_QNG], args.in[I_KNG]};
        pg8::gemm_phase<pg8::EpiProj, pg8::StaticOrder, true, true>(F.lds + RING_OFF, g, S, E);
        { const int nu = (M / 256) * (IN_COLS / 256), rem = nu % F.G;
          if (rem == 0) p1_tail_weights(F, args, (int)blockIdx.x * NWAVES + F.wave, F.G * NWAVES);
          else if ((int)blockIdx.x >= rem) p1_tail_weights(F, args, ((int)blockIdx.x - rem) * NWAVES + F.wave, (F.G - rem) * NWAVES); }
        if (BOTH(1)) GRID_BAR();
    }
    PSTAMP(2);
    if (IN(2)) { p2_prep(F, args); if (BOTH(2)) GRID_BAR(); }
    PSTAMP(3);
    if (IN(3)) {
        pg8::Gemm g{(const bf16*)(args.ws + WS_A2), (const bf16*)(args.ws + WS_WL), M, NLORA, KLORA}; pg8::StaticOrder S; S.init(M, NLORA, F.G, (int)blockIdx.x);
        pg8::EpiLora E{(bf16*)(args.ws + WS_DAG), NLORA, args.in[I_W0], args.in[I_A0]};
        pg8::gemm_phase<pg8::EpiLora, pg8::StaticOrder, true, true>(F.lds + RING_OFF, g, S, E);
        if (BOTH(3)) GRID_BAR();
    }
    PSTAMP(4);
    if (IN(4)) { p4_scan(F, args); PSTAMP(11); p4_attn(F, args); PSTAMP(12); if (BOTH(4)) GRID_BAR(); }
    PSTAMP(5);
    if (IN(5)) { p5_post(F, args); if (BOTH(5)) GRID_BAR(); }
    PSTAMP(6);
    if (IN(6)) {
        pg8::Gemm g{XN, (const bf16*)(args.ws + WS_WOUT), M, D, D}; pg8::StaticOrder S; S.init(M, D, F.G, (int)blockIdx.x);
        pg8::EpiOut E{args.in[I_X], (bf16*)(args.ws + WS_DAG), (float*)(args.ws + WS_SS), D, (LAS float*)(F.lds + RING_OFF + 131072)};
        pg8::gemm_phase<pg8::EpiOut, pg8::StaticOrder, true, true>(F.lds + RING_OFF, g, S, E);
        if (IN(8)) GRID_BAR();
    }
    PSTAMP(8);
    if (IN(8)) {
        pg8::Gemm g{(const bf16*)(args.ws + WS_DAG), (const bf16*)(args.ws + WS_WGU), M, NGU, D}; pg8::StaticOrder S; S.init(M, NGU, F.G, (int)blockIdx.x);
        pg8::EpiSwiglu E{PROJ, FF, (const float*)(args.ws + WS_SS)};
        pg8::gemm_phase<pg8::EpiSwiglu, pg8::StaticOrder, true, true>(F.lds + RING_OFF, g, S, E);
        if (BOTH(8)) GRID_BAR();
    }
    PSTAMP(9);
    if (IN(9)) {
        pg8::Gemm g{PROJ, (const bf16*)(args.ws + WS_WDN), M, D, FF}; pg8::StaticOrder S; S.init(M, D, F.G, (int)blockIdx.x);
        pg8::EpiFinal E{(const bf16*)(args.ws + WS_DAG), F.out, D};
        pg8::gemm_phase<pg8::EpiFinal, pg8::StaticOrder, true, true>(F.lds + RING_OFF, g, S, E);
    }
    PSTAMP(10);
    if (PROBE_SEL >= 0 && blockIdx.x == 0 && F.tid == 0) {
        unsigned w = 0;
        auto ld = [&](int i) { return __hip_atomic_load(F.ctl + 9100 + i, RLX_AGENT); };
        const int sel = PROBE_SEL;
        if (sel <= 9) { const int nxt = sel == 6 ? 8 : (sel == 9 ? 10 : sel + 1); w = ld(nxt) - ld(sel); }
        else if (sel == 20) w = ld(11) - ld(4);
        else if (sel == 21) w = ld(12) - ld(11);
        else w = ld(sel);
        const unsigned long long t0 = __builtin_amdgcn_s_memtime();
        while (((__builtin_amdgcn_s_memtime() - t0) >> 4) < (unsigned long long)w) __builtin_amdgcn_s_sleep(8);
    }
#undef IN
#undef BOTH
}

extern "C" void kernel_launch(void* const* d_in, const int* in_sizes, int n_in, void* d_out, int out_size, void* d_ws, size_t ws_size, hipStream_t stream) {
    static int grid = 0;
    if (grid == 0) {
        if (n_in != 22 || in_sizes[0] != M * D || out_size != M * D || ws_size < WS_END) { fprintf(stderr, "kernel_launch: unexpected shapes (n_in %d, in0 %d, out %d, ws %zu); nothing launched\n", n_in, n_in > 0 ? in_sizes[0] : -1, out_size, ws_size); grid = -1; return; }
        int dev = 0, cus = 0, per_cu = 0;
        if (hipGetDevice(&dev) != hipSuccess || hipDeviceGetAttribute(&cus, hipDeviceAttributeMultiprocessorCount, dev) != hipSuccess) { grid = -1; return; }
        if (hipFuncSetAttribute((const void*)hybrid_fwd, hipFuncAttributeMaxDynamicSharedMemorySize, LDS_BYTES) != hipSuccess) { fprintf(stderr, "kernel_launch: hipFuncSetAttribute failed\n"); grid = -1; return; }
        if (hipOccupancyMaxActiveBlocksPerMultiprocessor(&per_cu, (const void*)hybrid_fwd, NWAVES * 64, LDS_BYTES) != hipSuccess || per_cu < 1)
            fprintf(stderr, "kernel_launch: note: occupancy query reports %d workgroups per CU\n", per_cu);
        (void)hipGetLastError();
        grid = cus;
    }
    if (grid < 0) return;
    if (hipMemsetAsync((char*)d_ws + WS_CTL, 0, CTL_ZERO_BYTES, stream) != hipSuccess) { fprintf(stderr, "kernel_launch: hipMemsetAsync failed\n"); return; }
    Args a{};
    for (int i = 0; i < 22; ++i) a.in[i] = (const float*)d_in[i];
    a.out = (float*)d_out; a.ws = (unsigned char*)d_ws;
    for (int li = 0; li < N_LAUNCHES; ++li) {
        a.ph_lo = (N_LAUNCHES == PER_PHASE) ? li : 0; a.ph_hi = (N_LAUNCHES == PER_PHASE) ? li + 1 : PER_PHASE; a.li = li;
        hipLaunchKernelGGL(hybrid_fwd, dim3(grid), dim3(NWAVES * 64), LDS_BYTES, stream, a);
        const hipError_t le = hipPeekAtLastError();
        if (le != hipSuccess) { fprintf(stderr, "kernel_launch: launch %d failed: %s\n", li, hipGetErrorName(le)); break; }
    }
}
```

```cpp
#include <hip/hip_runtime.h>
#include <cstdio>
#include <cstdint>

#ifndef PROBE_SEL
#define PROBE_SEL -1
#endif
#ifndef MK_N_LAUNCHES
#define MK_N_LAUNCHES 1
#endif

namespace pg8 {
#define PG8_LAS __attribute__((address_space(3)))
typedef unsigned short bf16_t;
typedef short bf16x8 __attribute__((ext_vector_type(8)));
typedef float f32x4 __attribute__((ext_vector_type(4)));
typedef float f32x2 __attribute__((ext_vector_type(2)));
typedef unsigned u32x4 __attribute__((ext_vector_type(4)));
constexpr int BM = 256, BK = 64, HALF = 128, HTB = HALF * BK * 2, STAGE_BYTES = 8 * HTB, NXCD = 8, WGM = 8;

__host__ __device__ __forceinline__ int lds_byte(int r, int c) { const int st = (r >> 4) * 2 + (c >> 5), rr = r & 15, cc = c & 31, ob = rr * 64 + cc * 2; return st * 1024 + (ob ^ (((ob >> 9) & 1) << 5)); }
__host__ __device__ __forceinline__ void stage_rc(int b, int& R, int& C) { const int st = b / 1024, sb = b % 1024, swz = sb ^ (((sb >> 9) & 1) << 5); R = (st >> 1) * 16 + swz / 64; C = (st & 1) * 32 + (swz % 64) / 2; }
__host__ __device__ __forceinline__ int perm32(int rho) { const int n = rho >> 4, i = rho & 15; return 8 * (i >> 2) + 4 * n + (i & 3); }

struct Unit { int pm, pn; };
struct Gemm { const bf16_t* A; const bf16_t* Bt; int M, N, K; };

struct StaticOrder {
    int nM, nN, nwg, G, c;
    __host__ __device__ void init(int M, int N, int G_, int c_) { nM = M / BM; nN = N / BM; nwg = nM * nN; G = G_; c = c_; }
    __host__ __device__ bool next(int i, Unit& u) const {
        const long L = (long)i * G + c; if (L >= nwg) return false;
        int wgid = (int)L; { const int q = nwg / NXCD, r = nwg % NXCD, xcd = wgid % NXCD, off = wgid / NXCD; wgid = (xcd < r ? xcd * (q + 1) : r * (q + 1) + (xcd - r) * q) + off; }
        const int nig = WGM * nN, gid = wgid / nig, fm = gid * WGM, gsz = (nM - fm) < WGM ? (nM - fm) : WGM;
        u.pm = fm + ((wgid % nig) % gsz); u.pn = (wgid % nig) / gsz; return true;
    }
    __device__ __forceinline__ void a_ready(const Unit&) const {}
    __device__ __forceinline__ void done(const Unit&) const {}
};

__device__ __forceinline__ unsigned cvt_pk_bf16(float lo, float hi) { unsigned r; asm volatile("v_cvt_pk_bf16_f32 %0, %1, %2" : "=v"(r) : "v"(lo), "v"(hi)); return r; }
__device__ __forceinline__ float fsigmoid(float x) { return __builtin_amdgcn_rcpf(1.0f + __builtin_amdgcn_exp2f(-1.4426950408889634f * x)); }

struct EpiBf16 {
    static constexpr bool PERM = true, AFTER_DRAIN = false;
    bf16_t* O; int ldc;
    __device__ __forceinline__ void operator()(const f32x4 (&acc)[2][2][4][2], const Unit& u, int wr, int wc, int fr, int fq) const {
        const int row0 = u.pm * BM + wr * 64 + fr; const int col0 = u.pn * BM + wc * 32 + 8 * fq;
#pragma unroll
        for (int ai = 0; ai < 2; ++ai)
#pragma unroll
            for (int m = 0; m < 4; ++m) { bf16_t* rowp = O + (size_t)(row0 + ai * HALF + m * 16) * ldc + col0;
#pragma unroll
                for (int bj = 0; bj < 2; ++bj) { const f32x4 v0 = acc[ai][bj][m][0], v1 = acc[ai][bj][m][1];
                    u32x4 w; w.x = cvt_pk_bf16(v0[0], v0[1]); w.y = cvt_pk_bf16(v0[2], v0[3]); w.z = cvt_pk_bf16(v1[0], v1[1]); w.w = cvt_pk_bf16(v1[2], v1[3]);
                    *(u32x4*)(rowp + bj * HALF) = w; } }
    }
};
struct EpiProj {
    static constexpr bool PERM = true, AFTER_DRAIN = false;
    bf16_t* O; int ldc; const float* qg; const float* kg;
    __device__ __forceinline__ void operator()(const f32x4 (&acc)[2][2][4][2], const Unit& u, int wr, int wc, int fr, int fq) const {
        const int row0 = u.pm * BM + wr * 64 + fr;
        if (u.pn >= 4) {
            const int col0 = u.pn * BM + wc * 32 + 8 * fq;
#pragma unroll
            for (int ai = 0; ai < 2; ++ai)
#pragma unroll
                for (int m = 0; m < 4; ++m) { bf16_t* rowp = O + (size_t)(row0 + ai * HALF + m * 16) * ldc + col0;
#pragma unroll
                    for (int bj = 0; bj < 2; ++bj) { const f32x4 v0 = acc[ai][bj][m][0], v1 = acc[ai][bj][m][1];
                        u32x4 w; w.x = cvt_pk_bf16(v0[0], v0[1]); w.y = cvt_pk_bf16(v0[2], v0[3]); w.z = cvt_pk_bf16(v1[0], v1[1]); w.w = cvt_pk_bf16(v1[2], v1[3]);
                        *(u32x4*)(rowp + bj * HALF) = w; } }
        } else {
            const float* gsrc = (u.pn < 2 ? qg : kg) + 8 * fq; const float sc = u.pn < 2 ? 0.125f * 1.4426950408889634f : 1.0f;
            f32x4 g4[2][2];
#pragma unroll
            for (int bj = 0; bj < 2; ++bj)
#pragma unroll
                for (int n = 0; n < 2; ++n) g4[bj][n] = *(const f32x4*)(gsrc + 32 * bj + 4 * n) * sc;
            const int col0 = u.pn * BM + wc * 64 + 8 * fq;
#pragma unroll
            for (int ai = 0; ai < 2; ++ai)
#pragma unroll
                for (int m = 0; m < 4; ++m) {
                    float ss = 0.f;
#pragma unroll
                    for (int bj = 0; bj < 2; ++bj)
#pragma unroll
                        for (int n = 0; n < 2; ++n) { const f32x4 v = acc[ai][bj][m][n]; ss += (v[0] * v[0] + v[1] * v[1]) + (v[2] * v[2] + v[3] * v[3]); }
                    ss += __shfl_xor(ss, 16); ss += __shfl_xor(ss, 32);
                    const float rstd = 1.0f / sqrtf(ss * (1.0f / 64.0f) + 1e-6f);
                    bf16_t* rowp = O + (size_t)(row0 + ai * HALF + m * 16) * ldc + col0;
#pragma unroll
                    for (int bj = 0; bj < 2; ++bj) { const f32x4 v0 = acc[ai][bj][m][0] * g4[bj][0] * rstd, v1 = acc[ai][bj][m][1] * g4[bj][1] * rstd;
                        u32x4 w; w.x = cvt_pk_bf16(v0[0], v0[1]); w.y = cvt_pk_bf16(v0[2], v0[3]); w.z = cvt_pk_bf16(v1[0], v1[1]); w.w = cvt_pk_bf16(v1[2], v1[3]);
                        *(u32x4*)(rowp + 32 * bj) = w; }
                    __builtin_amdgcn_sched_barrier(0); }
        }
    }
};
struct EpiLora {
    static constexpr bool PERM = true, AFTER_DRAIN = false;
    bf16_t* O; int ldc; const float* w0; const float* a0;
    __device__ __forceinline__ void operator()(const f32x4 (&acc)[2][2][4][2], const Unit& u, int wr, int wc, int fr, int fq) const {
        const int row0 = u.pm * BM + wr * 64 + fr; const int col0 = u.pn * BM + wc * 32 + 8 * fq;
        const int kind = u.pn >> 1;
        const float sc = kind == 0 ? -0.6065306597126334f : (kind == 1 ? 1.0f : 0.0f), lin = kind == 2 ? 1.0f : 0.0f;
        const float* bp = kind == 0 ? w0 : a0;
        const float bs = kind == 2 ? 0.0f : 1.0f;
#pragma unroll
        for (int bj = 0; bj < 2; ++bj) {
            const int c = (col0 + bj * HALF) & 511;
            const f32x4 b0 = *(const f32x4*)(bp + c) * bs, b1 = *(const f32x4*)(bp + c + 4) * bs;
#pragma unroll
            for (int ai = 0; ai < 2; ++ai)
#pragma unroll
                for (int m = 0; m < 4; ++m) { bf16_t* rowp = O + (size_t)(row0 + ai * HALF + m * 16) * ldc + col0;
                    f32x4 v0 = acc[ai][bj][m][0] + b0, v1 = acc[ai][bj][m][1] + b1;
#pragma unroll
                    for (int e = 0; e < 4; ++e) { v0[e] = sc * fsigmoid(v0[e]) + lin * v0[e]; v1[e] = sc * fsigmoid(v1[e]) + lin * v1[e]; }
                    u32x4 w; w.x = cvt_pk_bf16(v0[0], v0[1]); w.y = cvt_pk_bf16(v0[2], v0[3]); w.z = cvt_pk_bf16(v1[0], v1[1]); w.w = cvt_pk_bf16(v1[2], v1[3]);
                    *(u32x4*)(rowp + bj * HALF) = w;
                    __builtin_amdgcn_sched_barrier(0); }
        }
    }
};
struct EpiSwiglu {
    static constexpr bool PERM = true, AFTER_DRAIN = false;
    bf16_t* H; int ldh; const float* rstd;
    __device__ __forceinline__ void operator()(const f32x4 (&acc)[2][2][4][2], const Unit& u, int wr, int wc, int fr, int fq) const {
        const int row0 = u.pm * BM + wr * 64 + fr; const int col0 = u.pn * HALF + wc * 32 + 8 * fq;
        float rs[2][4];
#pragma unroll
        for (int ai = 0; ai < 2; ++ai)
#pragma unroll
            for (int m = 0; m < 4; ++m) { const f32x4 s4 = *(const f32x4*)(rstd + (size_t)(row0 + ai * HALF + m * 16) * 4);
                rs[ai][m] = 1.0f / sqrtf(((s4[0] + s4[1]) + (s4[2] + s4[3])) * (1.0f / 1024.0f) + 1e-6f); }
#pragma unroll
        for (int ai = 0; ai < 2; ++ai)
#pragma unroll
            for (int m = 0; m < 4; ++m) { bf16_t* rowp = H + (size_t)(row0 + ai * HALF + m * 16) * ldh + col0;
                float h[8];
#pragma unroll
                for (int n = 0; n < 2; ++n)
#pragma unroll
                    for (int e = 0; e < 4; ++e) { const float g = acc[ai][0][m][n][e] * rs[ai][m], up = acc[ai][1][m][n][e] * rs[ai][m]; h[4 * n + e] = g * fsigmoid(g) * up; }
                u32x4 w; w.x = cvt_pk_bf16(h[0], h[1]); w.y = cvt_pk_bf16(h[2], h[3]); w.z = cvt_pk_bf16(h[4], h[5]); w.w = cvt_pk_bf16(h[6], h[7]);
                *(u32x4*)rowp = w;
                __builtin_amdgcn_sched_barrier(0); }
    }
};
struct EpiOut {
    static constexpr bool PERM = true, AFTER_DRAIN = false;
    const float* base; bf16_t* xb; float* SS; int ldc; PG8_LAS float* scr;
    __device__ __forceinline__ void operator()(const f32x4 (&acc)[2][2][4][2], const Unit& u, int wr, int wc, int fr, int fq) const {
        const int row0 = u.pm * BM + wr * 64 + fr, col0 = u.pn * BM + wc * 32 + 8 * fq;
#pragma unroll
        for (int ai = 0; ai < 2; ++ai)
#pragma unroll
            for (int m = 0; m < 4; ++m) { const size_t off = (size_t)(row0 + ai * HALF + m * 16) * ldc + col0;
                float ss = 0.f;
#pragma unroll
                for (int bj = 0; bj < 2; ++bj) {
                    const f32x4 o0 = *(const f32x4*)(base + off + bj * HALF) + acc[ai][bj][m][0], o1 = *(const f32x4*)(base + off + bj * HALF + 4) + acc[ai][bj][m][1];
                    u32x4 w; w.x = cvt_pk_bf16(o0[0], o0[1]); w.y = cvt_pk_bf16(o0[2], o0[3]); w.z = cvt_pk_bf16(o1[0], o1[1]); w.w = cvt_pk_bf16(o1[2], o1[3]);
                    *(u32x4*)(xb + off + bj * HALF) = w;
                    ss += ((o0[0] * o0[0] + o0[1] * o0[1]) + (o0[2] * o0[2] + o0[3] * o0[3])) + ((o1[0] * o1[0] + o1[1] * o1[1]) + (o1[2] * o1[2] + o1[3] * o1[3])); }
                ss += __shfl_xor(ss, 16); ss += __shfl_xor(ss, 32);
                if (fq == 0) scr[((((wr * 2 + ai) * 4 + m) * 16) + fr) * 4 + wc] = ss;
                if (m & 1) asm volatile("" ::: "memory"); }
        asm volatile("s_waitcnt lgkmcnt(0)" ::: "memory"); __builtin_amdgcn_s_barrier(); asm volatile("" ::: "memory");
        const int tid = threadIdx.x;
        if (tid < 256) { const f32x4 s4 = *(const PG8_LAS f32x4*)(scr + tid * 4);
            const int row = u.pm * BM + ((tid >> 6) & 1) * HALF + (tid >> 7) * 64 + ((tid >> 4) & 3) * 16 + (tid & 15);
            SS[(size_t)row * 4 + u.pn] = (s4[0] + s4[1]) + (s4[2] + s4[3]); }
    }
};
struct EpiFinal {
    static constexpr bool PERM = true, AFTER_DRAIN = false;
    const bf16_t* xb; float* out; int ldc;
    __device__ __forceinline__ void operator()(const f32x4 (&acc)[2][2][4][2], const Unit& u, int wr, int wc, int fr, int fq) const {
        const int row0 = u.pm * BM + wr * 64 + fr, col0 = u.pn * BM + wc * 32 + 8 * fq;
#pragma unroll
        for (int ai = 0; ai < 2; ++ai)
#pragma unroll
            for (int m = 0; m < 4; ++m) { const size_t off = (size_t)(row0 + ai * HALF + m * 16) * ldc + col0;
#pragma unroll
                for (int bj = 0; bj < 2; ++bj) { const u32x4 w = *(const u32x4*)(xb + off + bj * HALF);
                    const f32x4 b0 = (f32x4){__builtin_bit_cast(float, w.x << 16), __builtin_bit_cast(float, w.x & 0xffff0000u), __builtin_bit_cast(float, w.y << 16), __builtin_bit_cast(float, w.y & 0xffff0000u)};
                    const f32x4 b1 = (f32x4){__builtin_bit_cast(float, w.z << 16), __builtin_bit_cast(float, w.z & 0xffff0000u), __builtin_bit_cast(float, w.w << 16), __builtin_bit_cast(float, w.w & 0xffff0000u)};
                    *(f32x4*)(out + off + bj * HALF) = b0 + acc[ai][bj][m][0]; *(f32x4*)(out + off + bj * HALF + 4) = b1 + acc[ai][bj][m][1]; }
                if (m & 1) asm volatile("" ::: "memory"); }
    }
};

template <class Epi, class Sched, bool ALIGN_EPI = false, bool SP2 = false>
__device__ __forceinline__ void gemm_phase(PG8_LAS unsigned char* lds, const Gemm g, const Sched& S, const Epi& E) {
    const int tid = threadIdx.x, wid = __builtin_amdgcn_readfirstlane(tid >> 6), lane = tid & 63, wr = wid >> 2, wc = wid & 3, fr = lane & 15, fq = lane >> 4;
    const int K = g.K, nt = K / BK;
    unsigned voffA[2], voffB[2];
#pragma unroll
    for (int i = 0; i < 2; ++i) { int R, C; stage_rc(tid * 16 + i * 8192, R, C); const int Rb = Epi::PERM ? ((R & ~31) + perm32(R & 31)) : R;
        voffA[i] = (unsigned)(R * K + C) * 2u; voffB[i] = (unsigned)(Rb * K + C) * 2u; }
    const size_t kstep = (size_t)(BK * 2);
    const size_t hstep = (size_t)HALF * K * 2;
    const size_t tstep = 2 * hstep;
    const unsigned ldsw = (unsigned)wid * 1024u;
    const int aoff = lds_byte(wr * 64 + fr, fq * 8), boff = lds_byte(wc * 32 + fr, fq * 8);
#define PG8_SA(b, h) (((b) * 2 + (h)) * HTB)
#define PG8_SB(b, h) ((4 + (b) * 2 + (h)) * HTB)
#define PG8_STAGE(bufoff, gbase, voff) do { _Pragma("unroll") for (int _i = 0; _i < 2; ++_i) \
        __builtin_amdgcn_global_load_lds((const unsigned*)((const char*)(gbase) + (voff)[_i]), (PG8_LAS unsigned*)(lds + (bufoff) + ldsw + _i * 8192), 16, 0, 0); } while (0)
#define PG8_LDA(dst, b, h) do { _Pragma("unroll") for (int m = 0; m < 4; ++m) _Pragma("unroll") for (int k = 0; k < 2; ++k) dst[m][k] = *(const PG8_LAS bf16x8*)(lds + PG8_SA(b, h) + aoff + m * 2048 + k * 1024); } while (0)
#define PG8_LDB(dst, b, h) do { _Pragma("unroll") for (int n = 0; n < 2; ++n) _Pragma("unroll") for (int k = 0; k < 2; ++k) dst[n][k] = *(const PG8_LAS bf16x8*)(lds + PG8_SB(b, h) + boff + n * 2048 + k * 1024); } while (0)
#define PG8_MMA(ai, bj, At, Bt) do { __builtin_amdgcn_s_setprio(1); _Pragma("unroll") for (int m = 0; m < 4; ++m) _Pragma("unroll") for (int n = 0; n < 2; ++n) _Pragma("unroll") for (int k = 0; k < 2; ++k) \
        acc[ai][bj][m][n] = __builtin_amdgcn_mfma_f32_16x16x32_bf16(Bt[n][k], At[m][k], acc[ai][bj][m][n], 0, 0, 0); __builtin_amdgcn_s_setprio(0); } while (0)
#define PG8_WAIT_V(n) asm volatile("s_waitcnt vmcnt(" #n ")" ::: "memory")
#define PG8_WAIT_L(n) asm volatile("s_waitcnt lgkmcnt(" #n ")" ::: "memory")
#define PG8_BAR __builtin_amdgcn_s_barrier()
#define PG8_SCHED __builtin_amdgcn_sched_barrier(0)
    Unit cur, nxt; int ui = 0;
    if (!S.next(0, cur)) return;
    f32x4 acc[2][2][4][2];
#pragma unroll
    for (int a = 0; a < 2; ++a)
#pragma unroll
        for (int b = 0; b < 2; ++b)
#pragma unroll
            for (int m = 0; m < 4; ++m)
#pragma unroll
                for (int n = 0; n < 2; ++n) acc[a][b][m][n] = (f32x4){0.f, 0.f, 0.f, 0.f};
    bf16x8 At[4][2], B0[2][2], B1[2][2];
    const char* cA = (const char*)g.A + (size_t)cur.pm * tstep; const char* cB = (const char*)g.Bt + (size_t)cur.pn * tstep;
    S.a_ready(cur);
    if constexpr (SP2) {
        PG8_STAGE(PG8_SB(0, 0), cB, voffB); PG8_STAGE(PG8_SB(0, 1), cB + hstep, voffB); PG8_STAGE(PG8_SA(0, 0), cA, voffA); PG8_STAGE(PG8_SA(0, 1), cA + hstep, voffA);
        if (wr == 1) PG8_BAR;
        PG8_WAIT_V(2); PG8_BAR;
        PG8_STAGE(PG8_SB(1, 0), cB + kstep, voffB); PG8_STAGE(PG8_SA(1, 0), cA + kstep, voffA); PG8_STAGE(PG8_SB(1, 1), cB + hstep + kstep, voffB);
        PG8_WAIT_V(6); PG8_BAR;
    } else {
        PG8_STAGE(PG8_SB(0, 0), cB, voffB); PG8_STAGE(PG8_SA(0, 0), cA, voffA); PG8_STAGE(PG8_SB(0, 1), cB + hstep, voffB); PG8_STAGE(PG8_SA(0, 1), cA + hstep, voffA);
        if (wr == 1) PG8_BAR;
        PG8_WAIT_V(4); PG8_BAR;
        PG8_STAGE(PG8_SB(1, 0), cB + kstep, voffB); PG8_STAGE(PG8_SA(1, 0), cA + kstep, voffA); PG8_STAGE(PG8_SB(1, 1), cB + hstep + kstep, voffB);
        PG8_WAIT_V(6); PG8_BAR;
    }
    for (;;) {
        const bool has_next = S.next(ui + 1, nxt);
        const char* nA = has_next ? (const char*)g.A + (size_t)nxt.pm * tstep : cA; const char* nB = has_next ? (const char*)g.Bt + (size_t)nxt.pn * tstep : cB;
#pragma nounroll
        for (int t = 0; t < nt; t += 2) {
            const bool last = (t == nt - 2);
            const char* a1 = cA + (size_t)(t + 1) * kstep;
            const char* a2 = last ? nA : cA + (size_t)(t + 2) * kstep; const char* b2 = last ? nB : cB + (size_t)(t + 2) * kstep;
            const char* a3 = a2 + kstep; const char* b3 = b2 + kstep;
            if (last && has_next) S.a_ready(nxt);
            if constexpr (SP2) {
            PG8_LDB(B0, 0, 0); PG8_LDB(B1, 0, 1); PG8_SCHED; PG8_LDA(At, 0, 0); PG8_STAGE(PG8_SA(1, 1), a1 + hstep, voffA);
            PG8_WAIT_V(8); PG8_WAIT_L(0); PG8_BAR; PG8_MMA(0, 0, At, B0); PG8_MMA(0, 1, At, B1); PG8_BAR; PG8_SCHED;
            PG8_LDA(At, 0, 1); PG8_STAGE(PG8_SB(0, 0), b2, voffB); PG8_STAGE(PG8_SB(0, 1), b2 + hstep, voffB); PG8_STAGE(PG8_SA(0, 0), a2, voffA);
            PG8_WAIT_V(8); PG8_WAIT_L(0); PG8_BAR; PG8_MMA(1, 0, At, B0); PG8_MMA(1, 1, At, B1); PG8_BAR; PG8_SCHED;
            PG8_LDB(B0, 1, 0); PG8_LDB(B1, 1, 1); PG8_SCHED; PG8_LDA(At, 1, 0); PG8_STAGE(PG8_SA(0, 1), a2 + hstep, voffA);
            PG8_WAIT_V(8); PG8_WAIT_L(0); PG8_BAR; PG8_MMA(0, 0, At, B0); PG8_MMA(0, 1, At, B1); PG8_BAR; PG8_SCHED;
            PG8_LDA(At, 1, 1); PG8_STAGE(PG8_SB(1, 0), b3, voffB); PG8_STAGE(PG8_SB(1, 1), b3 + hstep, voffB); PG8_STAGE(PG8_SA(1, 0), a3, voffA);
            PG8_WAIT_V(8); PG8_WAIT_L(0); PG8_BAR; PG8_MMA(1, 0, At, B0); PG8_MMA(1, 1, At, B1); PG8_BAR; PG8_SCHED;
            } else {
            PG8_LDB(B0, 0, 0); PG8_SCHED; PG8_LDA(At, 0, 0); PG8_STAGE(PG8_SA(1, 1), a1 + hstep, voffA);
            PG8_WAIT_L(8); PG8_BAR; PG8_WAIT_L(0); PG8_MMA(0, 0, At, B0); PG8_BAR; PG8_SCHED;
            PG8_LDB(B1, 0, 1); PG8_STAGE(PG8_SB(0, 0), b2, voffB);
            PG8_BAR; PG8_WAIT_L(0); PG8_MMA(0, 1, At, B1); PG8_BAR;
            PG8_LDA(At, 0, 1); PG8_STAGE(PG8_SA(0, 0), a2, voffA);
            PG8_BAR; PG8_WAIT_L(0); PG8_MMA(1, 0, At, B0); PG8_BAR; PG8_SCHED;
            PG8_STAGE(PG8_SB(0, 1), b2 + hstep, voffB);
            PG8_WAIT_V(6); PG8_BAR; PG8_MMA(1, 1, At, B1); PG8_BAR;
            PG8_LDB(B0, 1, 0); PG8_SCHED; PG8_LDA(At, 1, 0); PG8_STAGE(PG8_SA(0, 1), a2 + hstep, voffA);
            PG8_WAIT_L(8); PG8_BAR; PG8_WAIT_L(0); PG8_MMA(0, 0, At, B0); PG8_BAR; PG8_SCHED;
            PG8_LDB(B1, 1, 1); PG8_STAGE(PG8_SB(1, 0), b3, voffB);
            PG8_BAR; PG8_WAIT_L(0); PG8_MMA(0, 1, At, B1); PG8_BAR;
            PG8_LDA(At, 1, 1); PG8_STAGE(PG8_SA(1, 0), a3, voffA);
            PG8_BAR; PG8_WAIT_L(0); PG8_MMA(1, 0, At, B0); PG8_BAR; PG8_SCHED;
            PG8_STAGE(PG8_SB(1, 1), b3 + hstep, voffB);
            PG8_WAIT_V(6); PG8_BAR; PG8_MMA(1, 1, At, B1); PG8_BAR;
            }
        }
        if constexpr (ALIGN_EPI) { if (wr == 0) PG8_BAR; }
        if constexpr (!Epi::AFTER_DRAIN) { E(acc, cur, wr, wc, fr, fq); S.done(cur); }
        if (!has_next) break;
#pragma unroll
        for (int a = 0; a < 2; ++a)
#pragma unroll
            for (int b = 0; b < 2; ++b)
#pragma unroll
                for (int m = 0; m < 4; ++m)
#pragma unroll
                    for (int n = 0; n < 2; ++n) acc[a][b][m][n] = (f32x4){0.f, 0.f, 0.f, 0.f};
        cur = nxt; cA = nA; cB = nB; ++ui;
        if constexpr (ALIGN_EPI) { if (wr == 1) PG8_BAR; }
    }
    PG8_WAIT_V(0);
    if constexpr (!ALIGN_EPI) { if (wr == 0) PG8_BAR; }
    PG8_BAR;
#undef PG8_SA
#undef PG8_SB
#undef PG8_STAGE
#undef PG8_LDA
#undef PG8_LDB
#undef PG8_MMA
#undef PG8_WAIT_V
#undef PG8_WAIT_L
#undef PG8_BAR
#undef PG8_SCHED
}
}

constexpr int NWAVES = 8;
constexpr int N_LAUNCHES = MK_N_LAUNCHES;
constexpr int PER_PHASE = 10;
constexpr int BATCH = 16, SEQ = 2048, D = 1024, M = BATCH * SEQ;
constexpr int NH = 8, HD = 64, AW = 512, RW = 512;
constexpr int RWKV_COLS = 1792, IN_COLS = 3328, FF = 2816, NGU = 2 * FF, NLORA = 1536, KLORA = 256;
constexpr int PC_Q = 0, PC_K = 512, PC_V = 1024, PC_RW = 1536;
constexpr int RC_R = 0, RC_K = 512, RC_V = 1024, RC_L = 1536;
constexpr int WLF_K01 = 8 * 2 * 4 * 64 * 8, WLF_ELEMS = 4 * WLF_K01;
constexpr float NORM_EPS = 1e-6f, LNX_EPS = 64e-5f;
constexpr float LOG2E = 1.4426950408889634f;

constexpr size_t MiB = 1u << 20;
constexpr size_t WS_CTL = 0, CTL_ZERO_BYTES = 1 * MiB;
constexpr size_t WS_WIN = 2 * MiB;
constexpr size_t WS_WOUT = 9 * MiB;
constexpr size_t WS_WGU = 11 * MiB;
constexpr size_t WS_WDN = 22 * MiB;
constexpr size_t WS_WL = 28 * MiB;
constexpr size_t WS_BON = 29 * MiB;
constexpr size_t WS_SS = 30 * MiB;
constexpr size_t WS_XN = 32 * MiB;
constexpr size_t WS_PROJ = 96 * MiB;
constexpr size_t WS_A2 = 304 * MiB;
constexpr size_t WS_DAG = 320 * MiB;
constexpr size_t WS_ML = 416 * MiB;
constexpr size_t WS_END = 424 * MiB;
constexpr size_t DO_PO = 0, DO_Y = 96 * MiB;
constexpr int CW_TMO = 0, CW_CODE = 1;
constexpr int CW_BAR = 4096;
constexpr int CW_ATTQ = 8192;

constexpr int LDS_BYTES = 163840;
constexpr int RING_OFF = 0, RING_BYTES = LDS_BYTES - 1024;
constexpr int LDSCTL_OFF = RING_BYTES, MISC_OFF = LDSCTL_OFF + 320;

#define GAS __attribute__((address_space(1)))
#define LAS __attribute__((address_space(3)))
typedef unsigned short bf16;
typedef unsigned v4u __attribute__((ext_vector_type(4)));
typedef unsigned v2u __attribute__((ext_vector_type(2)));
typedef float f32x4 __attribute__((ext_vector_type(4)));
typedef float f32x2 __attribute__((ext_vector_type(2)));
typedef float f32x16 __attribute__((ext_vector_type(16)));
typedef short bf16x8 __attribute__((ext_vector_type(8)));
typedef short s16x4 __attribute__((ext_vector_type(4)));
typedef GAS unsigned gu32;
#define RLX_AGENT __ATOMIC_RELAXED, __HIP_MEMORY_SCOPE_AGENT
#define LDS_WAIT() asm volatile("s_waitcnt lgkmcnt(0)" ::: "memory")
#define VM_WAIT() asm volatile("s_waitcnt vmcnt(0)" ::: "memory")
__device__ __forceinline__ unsigned f2bf(float f) { unsigned u = __builtin_bit_cast(unsigned, f); return (u + 0x7fffu + ((u >> 16) & 1u)) >> 16; }
typedef float f32x2_t __attribute__((ext_vector_type(2))); typedef __bf16 bf16x2_t __attribute__((ext_vector_type(2)));
__device__ __forceinline__ unsigned cvt2(float lo, float hi) { f32x2_t v = {lo, hi}; bf16x2_t b = __builtin_convertvector(v, bf16x2_t); return __builtin_bit_cast(unsigned, b); }
__device__ __forceinline__ unsigned pk2(float lo, float hi) { return cvt2(lo, hi); }
__device__ __forceinline__ float bflo(unsigned w) { return __builtin_bit_cast(float, w << 16); }
__device__ __forceinline__ float bfhi(unsigned w) { return __builtin_bit_cast(float, w & 0xffff0000u); }
__device__ __forceinline__ float fsig(float x) { return __builtin_amdgcn_rcpf(1.0f + __builtin_amdgcn_exp2f(-LOG2E * x)); }

#define XB_TMO      128
#define XB_XCNT(j)  (256  + 64 * (j))
#define XB_XSUB(j)  (1280 + 64 * (j))
#define XB_XGEN(j)  (2304 + 64 * (j))
#define XB_TOP      3328
#define XB_TOPGEN   3392
#define XCD_BAR_WORDS 3456
#define XB_SPIN_CAP (1u << 18)
__device__ __forceinline__ unsigned xb_ld(unsigned* p)              { return __hip_atomic_load(p, __ATOMIC_RELAXED, __HIP_MEMORY_SCOPE_AGENT); }
__device__ __forceinline__ unsigned xb_add(unsigned* p, unsigned v) { return __hip_atomic_fetch_add(p, v, __ATOMIC_RELAXED, __HIP_MEMORY_SCOPE_AGENT); }
__device__ __forceinline__ unsigned xb_xcc_id() { return (unsigned)__builtin_amdgcn_s_getreg((3 << 11) | 20) & 0xFu; }
#define XB_SPIN(cond, bar) do { unsigned _sp = 0; while (cond) { __builtin_amdgcn_s_sleep(1); \
    if ((++_sp & 255u) == 0u) { if (xb_ld(&(bar)[XB_TMO])) break; if (_sp > XB_SPIN_CAP) { atomicAdd(&(bar)[XB_TMO], 1u); break; } } } } while (0)
struct XcdBarrier { unsigned* bar; unsigned x; volatile LAS unsigned* st; };
__device__ __forceinline__ XcdBarrier xcd_barrier_post(unsigned* bar, volatile LAS unsigned* st) {
    XcdBarrier b; b.bar = bar; b.x = xb_xcc_id(); b.st = st;
    if (threadIdx.x == 0) (void)xb_add(&bar[XB_XCNT(b.x)], 1u);
    return b;
}
__device__ __forceinline__ void xcd_barrier_complete(unsigned* bar, unsigned x, unsigned& nloc, unsigned& nx) {
    const unsigned G = gridDim.x * gridDim.y * gridDim.z;
    unsigned sum, cnt, mine, sp = 0u;
    for (;;) {
        sum = 0u; cnt = 0u; mine = 0u;
#pragma unroll
        for (unsigned j = 0; j < 16; ++j) { const unsigned c = xb_ld(&bar[XB_XCNT(j)]); sum += c; cnt += (c > 0u) ? 1u : 0u; mine = (j == x) ? c : mine; }
        if (sum == G) break;
        __builtin_amdgcn_s_sleep(1);
        if ((++sp & 255u) == 0u) { if (xb_ld(&bar[XB_TMO])) break; if (sp > XB_SPIN_CAP) { atomicAdd(&bar[XB_TMO], 1u); break; } }
    }
    nloc = mine > 0u ? mine : 1u; nx = cnt > 0u ? cnt : 1u;
}
__device__ __forceinline__ void xcd_barrier(const XcdBarrier& b) {
    asm volatile("s_waitcnt vmcnt(0)" ::: "memory");
    __syncthreads();
    if (threadIdx.x == 0) {
        unsigned* bar = b.bar;
        __builtin_amdgcn_s_waitcnt(0);
        unsigned nloc = b.st[0], nx = b.st[1];
        if (nloc == 0u) { xcd_barrier_complete(bar, b.x, nloc, nx); b.st[0] = nloc; b.st[1] = nx; }
        const unsigned old = xb_add(&bar[XB_XSUB(b.x)], 1u);
        const unsigned gen = old / nloc;
        if (old + 1u == (gen + 1u) * nloc) {
            __builtin_amdgcn_fence(__ATOMIC_RELEASE, "agent");
            asm volatile("s_waitcnt vmcnt(0)" ::: "memory");
            const unsigned og = xb_add(&bar[XB_TOP], 1u);
            const unsigned tg = og / nx;
            if (og + 1u == (tg + 1u) * nx) xb_add(&bar[XB_TOPGEN], 1u);
            else XB_SPIN(xb_ld(&bar[XB_TOPGEN]) == tg, bar);
            __builtin_amdgcn_fence(__ATOMIC_ACQUIRE, "agent");
            xb_add(&bar[XB_XGEN(b.x)], 1u);
            asm volatile("s_waitcnt vmcnt(0)" ::: "memory");
        } else {
            XB_SPIN(xb_ld(&bar[XB_XGEN(b.x)]) == gen, bar);
            __builtin_amdgcn_fence(__ATOMIC_ACQUIRE, "agent");
            asm volatile("s_waitcnt vmcnt(0)" ::: "memory");
        }
    }
    __syncthreads();
}

struct Frame {
    LAS unsigned char* lds;
    volatile LAS unsigned* MISC;
    gu32* ctl;
    int tid, lane, wave;
    int vcu, G;
    float* out; unsigned char* ws;
};
struct Args { const float* in[22]; float* out; unsigned char* ws; int ph_lo, ph_hi, li, pad; };
enum { I_X = 0, I_N1G, I_WIN, I_QNG, I_KNG, I_AOG, I_MU, I_W0, I_W2, I_A0, I_A2, I_G2, I_KK, I_KA, I_RK, I_LNG, I_LNB, I_WOUT, I_N2G, I_WG, I_WU, I_WD };

__device__ __forceinline__ float wave_sum(float v) {
#pragma unroll
    for (int o = 1; o < 64; o <<= 1) v += __shfl_xor(v, o);
    return v;
}
__device__ __forceinline__ float red16(float x) {
    x += __builtin_bit_cast(float, __builtin_amdgcn_update_dpp(0, __builtin_bit_cast(int, x), 0x128, 0xf, 0xf, false));
    x += __builtin_bit_cast(float, __builtin_amdgcn_update_dpp(0, __builtin_bit_cast(int, x), 0x124, 0xf, 0xf, false));
    x += __builtin_bit_cast(float, __builtin_amdgcn_update_dpp(0, __builtin_bit_cast(int, x), 0x122, 0xf, 0xf, false));
    x += __builtin_bit_cast(float, __builtin_amdgcn_update_dpp(0, __builtin_bit_cast(int, x), 0x121, 0xf, 0xf, false));
    return x;
}

constexpr int TR_SCR = 64 * 65 * 4 + 256;
__device__ __forceinline__ int tr_row(int rmode, int n) {
    return rmode == 0 ? n : rmode == 3 ? (n < 1024 ? ((n >> 8) * 256 + ((n >> 5) & 1) * 128 + ((n >> 6) & 3) * 32 + (n & 31)) : n) : ((n >> 7) * 256 + (n & 127) + (rmode == 2 ? 128 : 0));
}
__device__ __forceinline__ void p0_transpose_item(const float* W, int K, int N, bf16* WT, int rmode, LAS float* scr, int item, int lane, const float* ksc = nullptr) {
    const int nblk = N / 64, kb = item / nblk, nb = item % nblk, k0 = 64 * kb, n0 = 64 * nb;
    const int ks = lane >> 4, n4 = (lane & 15) * 4;
    f32x4 v[16];
#pragma unroll
    for (int i = 0; i < 16; ++i) v[i] = *(const GAS f32x4*)((const GAS float*)W + (size_t)(k0 + 4 * i + ks) * N + n0 + n4);
#pragma unroll
    for (int i = 0; i < 16; ++i) { const int kk = 4 * i + ks; const float sc = ksc ? ksc[k0 + kk] : 1.0f;
        scr[kk * 65 + n4 + 0] = v[i].x * sc; scr[kk * 65 + n4 + 1] = v[i].y * sc; scr[kk * 65 + n4 + 2] = v[i].z * sc; scr[kk * 65 + n4 + 3] = v[i].w * sc; }
    LDS_WAIT(); asm volatile("" ::: "memory");
    GAS v4u* dst = (GAS v4u*)(WT + (size_t)tr_row(rmode, n0 + lane) * K + k0);
#pragma unroll
    for (int j = 0; j < 8; ++j) { const LAS float* c = scr + (8 * j) * 65 + lane;
        v4u o; o.x = pk2(c[0 * 65], c[1 * 65]); o.y = pk2(c[2 * 65], c[3 * 65]); o.z = pk2(c[4 * 65], c[5 * 65]); o.w = pk2(c[6 * 65], c[7 * 65]);
        dst[j] = o; }
    LDS_WAIT(); asm volatile("" ::: "memory");
}
template <int NR> __device__ __forceinline__ void rms_rows_to_bf16(int lane, const float* x0, size_t rstride, const float* g, bf16* o0, size_t ostride) {
    const GAS f32x4* gr = (const GAS f32x4*)g + lane;
    f32x4 v[NR][4];
#pragma unroll
    for (int r = 0; r < NR; ++r) { const GAS f32x4* xr = (const GAS f32x4*)(x0 + r * rstride) + lane;
#pragma unroll
        for (int j = 0; j < 4; ++j) v[r][j] = xr[64 * j]; }
    f32x4 gg[4];
#pragma unroll
    for (int j = 0; j < 4; ++j) gg[j] = gr[64 * j];
#pragma unroll
    for (int r = 0; r < NR; ++r) { float s = 0.f;
#pragma unroll
        for (int j = 0; j < 4; ++j) s += (v[r][j].x * v[r][j].x + v[r][j].y * v[r][j].y) + (v[r][j].z * v[r][j].z + v[r][j].w * v[r][j].w);
        const float rstd = 1.f / sqrtf(wave_sum(s) * (1.f / D) + NORM_EPS);
        GAS unsigned long long* o8 = (GAS unsigned long long*)(o0 + r * ostride) + lane;
#pragma unroll
        for (int j = 0; j < 4; ++j)
            o8[64 * j] = (unsigned long long)pk2(v[r][j].x * rstd * gg[j].x, v[r][j].y * rstd * gg[j].y) | ((unsigned long long)pk2(v[r][j].z * rstd * gg[j].z, v[r][j].w * rstd * gg[j].w) << 32); }
}

__device__ __forceinline__ void p0_prologue(Frame& F, const Args& AR) {
    LAS float* scr = (LAS float*)(F.lds + RING_OFF + F.wave * TR_SCR);
    const int gw = F.vcu * NWAVES + F.wave, NGW = F.G * NWAVES;
    bf16* Win_t = (bf16*)(F.ws + WS_WIN); bf16* Wout_t = (bf16*)(F.ws + WS_WOUT); bf16* Wgu_t = (bf16*)(F.ws + WS_WGU); bf16* Wdn_t = (bf16*)(F.ws + WS_WDN); bf16* Wl_t = (bf16*)(F.ws + WS_WL);
    constexpr int I_IN = (D / 64) * (IN_COLS / 64);
    for (int it = gw; it < I_IN; it += NGW) p0_transpose_item(AR.in[I_WIN], D, IN_COLS, Win_t, 3, scr, it, F.lane);
    for (int e = (F.vcu * NWAVES * 64 + F.tid); e < WLF_ELEMS; e += F.G * NWAVES * 64) {
        const int kind = e < WLF_K01 ? 0 : (e < 2 * WLF_K01 ? 1 : 2), r = e - (kind == 2 ? 2 * WLF_K01 : kind * WLF_K01);
        const int ee = r & 7, ln = (r >> 3) & 63, b = (r >> 9) & 3, s = kind == 2 ? (r >> 11) & 3 : (r >> 11) & 1, g = kind == 2 ? r >> 13 : r >> 12;
        const int k = 32 * s + 8 * (ln >> 4) + ee, c = 64 * g + 32 * (b >> 1) + 8 * ((ln & 15) >> 2) + 4 * (b & 1) + (ln & 3);
        const float* W = kind == 0 ? AR.in[I_W2] : (kind == 1 ? AR.in[I_A2] : AR.in[I_G2]);
        Wl_t[e] = (bf16)f2bf(W[k * 512 + c]);
    }
    bf16* XN = (bf16*)(F.ws + WS_XN);
    for (int m = gw * 4; m < M; m += NGW * 4) rms_rows_to_bf16<4>(F.lane, AR.in[I_X] + (size_t)m * D, D, AR.in[I_N1G], XN + (size_t)m * D, D);
}

constexpr int LR_ROWB = 528;
#define MFMA16(a, b, c) __builtin_amdgcn_mfma_f32_16x16x32_bf16((a), (b), (c), 0, 0, 0)
template <int KIND> __device__ __forceinline__ void p3_kind(const LAS unsigned char* At, const bf16* WLF, bf16* DAG, const float* bias, int m0, int wave, int lane) {
    constexpr int KS = KIND == 2 ? 4 : 2, KOFF = KIND == 0 ? 0 : (KIND == 1 ? 64 : 128);
    const int q = lane >> 4, t = lane & 15;
    const GAS v4u* wf = (const GAS v4u*)(WLF + (KIND == 2 ? 2 * WLF_K01 : KIND * WLF_K01)) + (size_t)wave * KS * 4 * 64 + lane;
    bf16x8 Af[KS][4];
#pragma unroll
    for (int s = 0; s < KS; ++s)
#pragma unroll
        for (int b = 0; b < 4; ++b) Af[s][b] = __builtin_bit_cast(bf16x8, wf[(s * 4 + b) * 64]);
    f32x4 bs[2][2];
    if (KIND != 2) {
#pragma unroll
        for (int p = 0; p < 2; ++p) { const GAS f32x4* bp = (const GAS f32x4*)((const GAS float*)bias + 64 * wave + 32 * p + 8 * q); bs[p][0] = bp[0]; bs[p][1] = bp[1]; }
    }
    const LAS unsigned char* ap = At + t * LR_ROWB + (KOFF + 8 * q) * 2;
    GAS bf16* dp = (GAS bf16*)DAG + (size_t)(m0 + t) * NLORA + KIND * 512 + 64 * wave + 8 * q;
    const f32x4 z4 = {0.f, 0.f, 0.f, 0.f};
#pragma unroll 2
    for (int tb = 0; tb < 8; ++tb) {
        bf16x8 Bf[KS];
#pragma unroll
        for (int s = 0; s < KS; ++s) Bf[s] = *(const LAS bf16x8*)(ap + tb * 16 * LR_ROWB + 64 * s);
        f32x4 acc[4];
#pragma unroll
        for (int b = 0; b < 4; ++b) { acc[b] = MFMA16(Af[0][b], Bf[0], z4);
#pragma unroll
            for (int s = 1; s < KS; ++s) acc[b] = MFMA16(Af[s][b], Bf[s], acc[b]); }
#pragma unroll
        for (int p = 0; p < 2; ++p) {
            f32x4 v0 = acc[2 * p], v1 = acc[2 * p + 1];
            if (KIND != 2) {
                v0 += bs[p][0]; v1 += bs[p][1];
#pragma unroll
                for (int e = 0; e < 4; ++e) { v0[e] = fsig(v0[e]); v1[e] = fsig(v1[e]); }
                if (KIND == 0) { v0 *= -0.6065306597126334f; v1 *= -0.6065306597126334f; }
            }
            v4u w; w.x = cvt2(v0[0], v0[1]); w.y = cvt2(v0[2], v0[3]); w.z = cvt2(v1[0], v1[1]); w.w = cvt2(v1[2], v1[3]);
            *(GAS v4u*)(dp + (size_t)tb * 16 * NLORA + 32 * p) = w;
        }
    }
}
__device__ __forceinline__ void p3_lora(Frame& F, const Args& AR) {
    const int lane = F.lane, wave = F.wave;
    const bf16* PROJ = (const bf16*)(F.ws + WS_PROJ); const bf16* WLF = (const bf16*)(F.ws + WS_WL); bf16* DAG = (bf16*)(F.ws + WS_DAG);
    LAS unsigned char* At = F.lds + RING_OFF;
    const f32x4 mu4 = *(const f32x4*)(AR.in[I_MU] + RC_L + 4 * lane);
    for (int u = F.vcu; u < M / 128; u += F.G) {
        const int m0 = u * 128, t0 = 16 * wave;
        const GAS bf16* row = (const GAS bf16*)PROJ + (size_t)(m0 + t0) * IN_COLS + PC_RW + RC_L + 4 * lane;
        v2u w[17];
        w[0] = (v2u){0u, 0u};
        if (((m0 + t0) & (SEQ - 1)) != 0) w[0] = *(const GAS v2u*)(row - IN_COLS);
#pragma unroll
        for (int i = 0; i < 16; ++i) w[i + 1] = *(const GAS v2u*)(row + (size_t)i * IN_COLS);
#pragma unroll
        for (int i = 0; i < 16; ++i) {
            const v2u cu = w[i + 1], pv = w[i];
            const float c4[4] = {bflo(cu.x), bfhi(cu.x), bflo(cu.y), bfhi(cu.y)}, p4[4] = {bflo(pv.x), bfhi(pv.x), bflo(pv.y), bfhi(pv.y)};
            float xs[4];
#pragma unroll
            for (int e = 0; e < 4; ++e) { const float v = c4[e] + (p4[e] - c4[e]) * mu4[e];
                if (lane < 16) { const float tt = __builtin_amdgcn_exp2f(2.f * LOG2E * v); xs[e] = 1.f - 2.f * __builtin_amdgcn_rcpf(tt + 1.f); }
                else if (lane < 32) xs[e] = v;
                else xs[e] = fsig(v); }
            *(LAS v2u*)(At + (t0 + i) * LR_ROWB + 8 * lane) = (v2u){pk2(xs[0], xs[1]), pk2(xs[2], xs[3])};
        }
        __syncthreads();
        p3_kind<0>(At, WLF, DAG, AR.in[I_W0], m0, wave, lane);
        p3_kind<1>(At, WLF, DAG, AR.in[I_A0], m0, wave, lane);
        p3_kind<2>(At, WLF, DAG, nullptr, m0, wave, lane);
        __syncthreads();
    }
}

__device__ __forceinline__ float red8(float x) {
    x += __builtin_bit_cast(float, __builtin_amdgcn_update_dpp(0, __builtin_bit_cast(int, x), 0xB1, 0xf, 0xf, false));
    x += __builtin_bit_cast(float, __builtin_amdgcn_update_dpp(0, __builtin_bit_cast(int, x), 0x4E, 0xf, 0xf, false));
    x += __builtin_bit_cast(float, __builtin_amdgcn_update_dpp(0, __builtin_bit_cast(int, x), 0x141, 0xf, 0xf, false));
    return x;
}
__device__ __forceinline__ float redrows(float x) {
    { auto r = __builtin_amdgcn_permlane16_swap(__float_as_uint(x), __float_as_uint(x), false, false); x = __uint_as_float(r[0]) + __uint_as_float(r[1]); }
    { auto r = __builtin_amdgcn_permlane32_swap(__float_as_uint(x), __float_as_uint(x), false, false); x = __uint_as_float(r[0]) + __uint_as_float(r[1]); }
    return x;
}
constexpr int CS = 16, NCHUNK = SEQ / CS, NHELP = 4, NSTATE = 4, NIT = (NCHUNK + NHELP - 1) / NHELP;
constexpr int ROWB = 144, TILEB = 40;
constexpr int SL_A = 0, SL_R = 16 * ROWB, SL_B = 32 * ROWB, SL_K = 48 * ROWB, SL_V = 64 * ROWB, SL_T = 80 * ROWB, SL_LAK = SL_T + 16 * TILEB, SL_LRB = SL_LAK + 16 * TILEB, SL_LRK = SL_LRB + 16 * TILEB,
              SL_G = SL_LRK + 16 * TILEB, SL_BON = SL_G + 256, SL_INV = SL_BON + 64, SL_BYTES = SL_INV + 64;
static_assert(SL_BYTES % 16 == 0 && SL_T % 8 == 0, "slot alignment");
constexpr int SC_CONST = 2 * NHELP * SL_BYTES;
constexpr int SC_YL = SC_CONST + 6 * 64 * 4, YL_BYTES = NHELP * CS * 256;
constexpr int SC_TS = SC_YL + 2 * YL_BYTES;
static_assert(SC_TS + NSTATE * NHELP * 16 * TILEB <= RING_BYTES && NHELP * CS * 8 == 2 * NSTATE * 64 && NCHUNK % NHELP == 0 && NHELP % 2 == 0, "scan LDS");
struct HReg { v4u r[2], k[2], v[2], pr[2], pk[2], pv[2], e[2], a[2]; };
__device__ __forceinline__ void helper_load(HReg& R, const bf16* PROJ, const bf16* DAG, int tok, int h, int kg) {
    const GAS bf16* row = (const GAS bf16*)PROJ + (size_t)tok * IN_COLS + PC_RW + h * 64 + 16 * kg;
    const GAS bf16* rowp = row - IN_COLS;
    const GAS bf16* dr = (const GAS bf16*)DAG + (size_t)tok * NLORA + h * 64 + 16 * kg;
    asm volatile("" : "+v"(row)); asm volatile("" : "+v"(rowp)); asm volatile("" : "+v"(dr));
    const bool hp = (tok & (SEQ - 1)) != 0;
#pragma unroll
    for (int i = 0; i < 2; ++i) {
        R.r[i] = *(const GAS v4u*)(row + RC_R + 8 * i); R.k[i] = *(const GAS v4u*)(row + RC_K + 8 * i); R.v[i] = *(const GAS v4u*)(row + RC_V + 8 * i);
        if (hp) { R.pr[i] = *(const GAS v4u*)(rowp + RC_R + 8 * i); R.pk[i] = *(const GAS v4u*)(rowp + RC_K + 8 * i); R.pv[i] = *(const GAS v4u*)(rowp + RC_V + 8 * i); }
        else { R.pr[i] = (v4u){0u, 0u, 0u, 0u}; R.pk[i] = R.pr[i]; R.pv[i] = R.pr[i]; }
        R.e[i] = *(const GAS v4u*)(dr + 8 * i); R.a[i] = *(const GAS v4u*)(dr + 512 + 8 * i);
    }
}
__device__ __forceinline__ void unpack4(const unsigned w0, const unsigned w1, float (&x)[4]) { x[0] = bflo(w0); x[1] = bfhi(w0); x[2] = bflo(w1); x[3] = bfhi(w1); }
__device__ __forceinline__ float dpp_shr(float x, const int ctrl_sel) {
    int r;
    if (ctrl_sel == 1) r = __builtin_amdgcn_update_dpp(0, __builtin_bit_cast(int, x), 0x111, 0xf, 0xf, true);
    else if (ctrl_sel == 2) r = __builtin_amdgcn_update_dpp(0, __builtin_bit_cast(int, x), 0x112, 0xf, 0xf, true);
    else if (ctrl_sel == 4) r = __builtin_amdgcn_update_dpp(0, __builtin_bit_cast(int, x), 0x114, 0xf, 0xf, true);
    else r = __builtin_amdgcn_update_dpp(0, __builtin_bit_cast(int, x), 0x118, 0xf, 0xf, true);
    return __builtin_bit_cast(float, r);
}
__device__ __forceinline__ unsigned cvt2s(float lo, float hi) { asm volatile("" : "+v"(lo), "+v"(hi)); return cvt2(lo, hi); }
__device__ __forceinline__ bf16x8 mk8(unsigned a, unsigned b, unsigned c, unsigned d) { return __builtin_bit_cast(bf16x8, (v4u){a, b, c, d}); }
__device__ __forceinline__ bf16x8 accB(const f32x4 v) { return mk8(cvt2(v[0], v[1]), cvt2(v[2], v[3]), 0u, 0u); }
__device__ __forceinline__ v2u trd(const LAS unsigned char* p) { typedef short v4i16_t __attribute__((ext_vector_type(4)));
    return __builtin_bit_cast(v2u, __builtin_amdgcn_ds_read_tr16_b64_v4i16((LAS v4i16_t*)p)); }
#define PIN_PTR(p) asm volatile("" : "+v"(p))

#define HR_UNPACK(dst, arr, gp) do { if ((gp) & 1) unpack4(R.arr[(gp) >> 1].z, R.arr[(gp) >> 1].w, dst); else unpack4(R.arr[(gp) >> 1].x, R.arr[(gp) >> 1].y, dst); } while (0)
__device__ __forceinline__ void helper_chunk(LAS unsigned char* slot, const LAS float* cst, HReg& R, bool prefetch, const bf16* PROJ, const bf16* DAG, float* BON, int tok, int h, int lane) {
    const int t = lane & 15, kg = lane >> 4;
    LAS unsigned char* p_row = slot + t * ROWB + kg * 16;
    LAS unsigned char* p_v = slot + SL_V + t * ROWB + kg * 32;
    LAS unsigned char* p_tw = slot + t * TILEB + kg * 8;
    LAS unsigned char* p_g = slot + SL_G + kg * 16;
    const LAS float* p_c = cst + 16 * kg;
    PIN_PTR(p_row); PIN_PTR(p_v); PIN_PTR(p_tw); PIN_PTR(p_g); PIN_PTR(p_c);
    float E[16], G[16], GI[16], GP[16];
#pragma unroll
    for (int gp = 0; gp < 4; ++gp) { float e[4]; HR_UNPACK(e, e, gp);
#pragma unroll
        for (int i = 0; i < 4; ++i) E[4 * gp + i] = e[i]; }
#pragma unroll
    for (int q = 0; q < 16; ++q) E[q] += dpp_shr(E[q], 1);
#pragma unroll
    for (int q = 0; q < 16; ++q) E[q] += dpp_shr(E[q], 2);
#pragma unroll
    for (int q = 0; q < 16; ++q) E[q] += dpp_shr(E[q], 4);
#pragma unroll
    for (int q = 0; q < 16; ++q) E[q] += dpp_shr(E[q], 8);
#pragma unroll
    for (int q = 0; q < 16; ++q) { G[q] = __builtin_amdgcn_exp2f(LOG2E * E[q]); GI[q] = __builtin_amdgcn_exp2f(-LOG2E * E[q]); }
#pragma unroll
    for (int q = 0; q < 16; ++q) { const float gpv = dpp_shr(G[q], 1); GP[q] = (t == 0) ? 1.f : gpv; }
    if (t == 15) {
#pragma unroll
        for (int gp = 0; gp < 4; ++gp) *(LAS f32x4*)(p_g + gp * 64) = (f32x4){G[4 * gp], G[4 * gp + 1], G[4 * gp + 2], G[4 * gp + 3]};
    }
    float ss = 0.f, bon = 0.f;
#pragma unroll
    for (int gp = 0; gp < 4; ++gp) {
        float r[4], k[4], v[4], pr[4], pk[4], pv[4], a[4];
        HR_UNPACK(r, r, gp); HR_UNPACK(k, k, gp); HR_UNPACK(v, v, gp); HR_UNPACK(pr, pr, gp); HR_UNPACK(pk, pk, gp); HR_UNPACK(pv, pv, gp); HR_UNPACK(a, a, gp);
        const f32x4 mur = *(const LAS f32x4*)(p_c + 0 * 64 + 4 * gp), muk = *(const LAS f32x4*)(p_c + 1 * 64 + 4 * gp), muv = *(const LAS f32x4*)(p_c + 2 * 64 + 4 * gp);
        const f32x4 kkc = *(const LAS f32x4*)(p_c + 3 * 64 + 4 * gp), kac = *(const LAS f32x4*)(p_c + 4 * 64 + 4 * gp), rkc = *(const LAS f32x4*)(p_c + 5 * 64 + 4 * gp);
        float xv[4], At[4], Rt[4], Bt[4], Kt[4];
#pragma unroll
        for (int i = 0; i < 4; ++i) { const int q = 4 * gp + i;
            const float xr = r[i] + (pr[i] - r[i]) * mur[i], xk = k[i] + (pk[i] - k[i]) * muk[i]; xv[i] = v[i] + (pv[i] - v[i]) * muv[i];
            const float kkv = xk * kkc[i], kpv = xk * (1.f + (a[i] - 1.f) * kac[i]); ss += kkv * kkv; bon += xr * kpv * rkc[i];
            At[i] = -kkv * GP[q]; Rt[i] = xr * G[q]; Bt[i] = kkv * a[i] * GI[q]; Kt[i] = kpv * GI[q]; }
        *(LAS v2u*)(p_v + gp * 8) = (v2u){cvt2s(xv[0], xv[1]), cvt2s(xv[2], xv[3])};
        const int co = (gp >> 1) * 64 + (gp & 1) * 8;
        *(LAS v2u*)(p_row + SL_A + co) = (v2u){cvt2s(At[0], At[1]), cvt2s(At[2], At[3])}; *(LAS v2u*)(p_row + SL_R + co) = (v2u){cvt2s(Rt[0], Rt[1]), cvt2s(Rt[2], Rt[3])};
        *(LAS v2u*)(p_row + SL_B + co) = (v2u){cvt2s(Bt[0], Bt[1]), cvt2s(Bt[2], Bt[3])}; *(LAS v2u*)(p_row + SL_K + co) = (v2u){cvt2s(Kt[0], Kt[1]), cvt2s(Kt[2], Kt[3])};
    }
    ss = redrows(ss); bon = redrows(bon);
    const float inv = __builtin_amdgcn_rsqf(fmaxf(ss, 1e-24f));
    if (kg == 0) { *(LAS float*)(slot + SL_BON + t * 4) = bon; *(LAS float*)(slot + SL_INV + t * 4) = inv; }
    if (prefetch) helper_load(R, PROJ, DAG, tok + NHELP * CS, h, kg);
    const bf16x8 FA0 = *(const LAS bf16x8*)(p_row + SL_A), FA1 = *(const LAS bf16x8*)(p_row + SL_A + 64), FR0 = *(const LAS bf16x8*)(p_row + SL_R), FR1 = *(const LAS bf16x8*)(p_row + SL_R + 64);
    const bf16x8 FB0 = *(const LAS bf16x8*)(p_row + SL_B), FB1 = *(const LAS bf16x8*)(p_row + SL_B + 64), FK0 = *(const LAS bf16x8*)(p_row + SL_K), FK1 = *(const LAS bf16x8*)(p_row + SL_K + 64);
    const f32x4 z4 = (f32x4){0.f, 0.f, 0.f, 0.f};
    f32x4 Lab = MFMA16(FA0, FB0, z4); Lab = MFMA16(FA1, FB1, Lab);
    f32x4 Lak = MFMA16(FA0, FK0, z4); Lak = MFMA16(FA1, FK1, Lak);
    f32x4 Lrb = MFMA16(FR0, FB0, z4); Lrb = MFMA16(FR1, FB1, Lrb);
    f32x4 Lrk = MFMA16(FR0, FK0, z4); Lrk = MFMA16(FR1, FK1, Lrk);
    const int s = t;
#pragma unroll
    for (int r = 0; r < 4; ++r) { const int tt = 4 * kg + r;
        Lab[r] = tt > s ? Lab[r] : 0.f; Lak[r] = tt > s ? Lak[r] : 0.f; Lrb[r] = tt >= s ? Lrb[r] : 0.f; Lrk[r] = tt >= s ? Lrk[r] : 0.f; }
    { const f32x4 ir = *(const LAS f32x4*)(slot + SL_INV + 16 * kg);
      Lab = Lab * ir * inv; }
#define WR_TILE(off, X) (*(LAS v2u*)(p_tw + (off)) = (v2u){cvt2((X)[0], (X)[1]), cvt2((X)[2], (X)[3])})
    WR_TILE(SL_LAK, Lak); WR_TILE(SL_LRB, Lrb); WR_TILE(SL_LRK, Lrk); WR_TILE(SL_T, Lab);
#undef WR_TILE
}

struct SOps { bf16x8 a0, a1, r0, r1; v2u vt, lak, lrb, lrk, bb[4], kk2[4]; f32x4 gm[4], bn, iv; };
__device__ __forceinline__ void state_load(SOps& O, const LAS unsigned char* slot, int lane, int wv) {
    const int c = lane & 15, g = lane >> 4, q4 = 4 * g + (c >> 2), pp = c & 3;
    const LAS unsigned char* p128 = slot + c * ROWB + g * 16;
    const LAS unsigned char* p_bt = slot + q4 * ROWB + pp * 16;
    const LAS unsigned char* p_tr = slot + q4 * TILEB + pp * 8;
    const LAS unsigned char* p_v = slot + SL_V + q4 * ROWB + wv * 32 + pp * 8;
    const LAS unsigned char* pg = slot + SL_G + g * 16;
    PIN_PTR(p128); PIN_PTR(p_bt); PIN_PTR(p_tr); PIN_PTR(p_v); PIN_PTR(pg);
    O.a0 = *(const LAS bf16x8*)(p128 + SL_A); O.a1 = *(const LAS bf16x8*)(p128 + SL_A + 64); O.r0 = *(const LAS bf16x8*)(p128 + SL_R); O.r1 = *(const LAS bf16x8*)(p128 + SL_R + 64);
    O.vt = trd(p_v); O.lak = trd(p_tr + SL_LAK); O.lrb = trd(p_tr + SL_LRB); O.lrk = trd(p_tr + SL_LRK);
#pragma unroll
    for (int jb = 0; jb < 4; ++jb) { O.bb[jb] = trd(p_bt + SL_B + (jb >> 1) * 64 + (jb & 1) * 8); O.kk2[jb] = trd(p_bt + SL_K + (jb >> 1) * 64 + (jb & 1) * 8); O.gm[jb] = *(const LAS f32x4*)(pg + jb * 64); }
    O.bn = *(const LAS f32x4*)(slot + SL_BON + 16 * g); O.iv = *(const LAS f32x4*)(slot + SL_INV + 16 * g);
}
__device__ __forceinline__ void state_compute(const SOps& O, const v2u tt, f32x4 (&X)[4], LAS unsigned char* yl, int lane, int wv) {
    const int c = lane & 15, g = lane >> 4;
    const f32x4 z4 = (f32x4){0.f, 0.f, 0.f, 0.f};
    const bf16x8 xb0 = mk8(cvt2(X[0][0], X[0][1]), cvt2(X[0][2], X[0][3]), cvt2(X[1][0], X[1][1]), cvt2(X[1][2], X[1][3]));
    const bf16x8 xb1 = mk8(cvt2(X[2][0], X[2][1]), cvt2(X[2][2], X[2][3]), cvt2(X[3][0], X[3][1]), cvt2(X[3][2], X[3][3]));
    f32x4 Z = MFMA16(O.a0, xb0, z4); Z = MFMA16(O.a1, xb1, Z); Z = MFMA16(mk8(O.lak.x, O.lak.y, 0u, 0u), mk8(O.vt.x, O.vt.y, 0u, 0u), Z) * O.iv;
    const f32x4 U = MFMA16(mk8(tt.x, tt.y, 0u, 0u), accB(Z), z4) * O.iv;
    const bf16x8 uv = mk8(cvt2(U[0], U[1]), cvt2(U[2], U[3]), O.vt.x, O.vt.y);
    f32x4 Y = MFMA16(O.r0, xb0, z4); Y = MFMA16(O.r1, xb1, Y); Y = MFMA16(mk8(O.lrb.x, O.lrb.y, O.lrk.x, O.lrk.y), uv, Y);
#pragma unroll
    for (int jb = 0; jb < 4; ++jb) X[jb] = MFMA16(mk8(O.bb[jb].x, O.bb[jb].y, O.kk2[jb].x, O.kk2[jb].y), uv, X[jb]) * O.gm[jb];
    LAS unsigned char* py = yl + (4 * g) * 256 + (16 * wv + c) * 2;
    PIN_PTR(py);
    const float vv[4] = {bflo(O.vt.x), bfhi(O.vt.x), bflo(O.vt.y), bfhi(O.vt.y)};
#pragma unroll
    for (int r = 0; r < 4; ++r) { *(LAS unsigned short*)(py + r * 256) = (unsigned short)f2bf(Y[r]); *(LAS unsigned short*)(py + r * 256 + 128) = (unsigned short)f2bf(O.bn[r] * vv[r]); }
}
__device__ __forceinline__ void state_T(v2u (&tt)[NHELP], const LAS unsigned char* set0, LAS unsigned char* scr, int lane) {
    const int c = lane & 15, g = lane >> 4;
    const int o_w = c * TILEB + g * 8, o_r = (4 * g + (c >> 2)) * TILEB + (c & 3) * 8;
    const f32x4 z4 = (f32x4){0.f, 0.f, 0.f, 0.f};
    bf16x8 A1[NHELP], A2[NHELP], A4[NHELP]; f32x4 P[NHELP];
#pragma unroll
    for (int k = 0; k < NHELP; ++k) { const LAS unsigned char* tl = set0 + k * SL_BYTES + SL_T;
        const v2u bl = *(const LAS v2u*)(tl + o_w), al = trd(tl + o_r); A1[k] = mk8(al.x, al.y, 0u, 0u); P[k] = MFMA16(A1[k], mk8(bl.x, bl.y, 0u, 0u), z4); }
#pragma unroll
    for (int k = 0; k < NHELP; ++k) *(LAS v2u*)(scr + k * (16 * TILEB) + o_w) = (v2u){cvt2(P[k][0], P[k][1]), cvt2(P[k][2], P[k][3])};
#pragma unroll
    for (int k = 0; k < NHELP; ++k) { const v2u al = trd(scr + k * (16 * TILEB) + o_r); A2[k] = mk8(al.x, al.y, 0u, 0u); P[k] = MFMA16(A2[k], accB(P[k]), z4); }
#pragma unroll
    for (int k = 0; k < NHELP; ++k) *(LAS v2u*)(scr + k * (16 * TILEB) + o_w) = (v2u){cvt2(P[k][0], P[k][1]), cvt2(P[k][2], P[k][3])};
#pragma unroll
    for (int k = 0; k < NHELP; ++k) { const v2u al = trd(scr + k * (16 * TILEB) + o_r); A4[k] = mk8(al.x, al.y, 0u, 0u); P[k] = MFMA16(A4[k], accB(P[k]), z4); }
#pragma unroll
    for (int k = 0; k < NHELP; ++k) {
#pragma unroll
        for (int r = 0; r < 4; ++r) P[k][r] += (4 * g + r == c) ? 1.f : 0.f; }
#pragma unroll
    for (int k = 0; k < NHELP; ++k) P[k] = MFMA16(A4[k], accB(P[k]), P[k]);
#pragma unroll
    for (int k = 0; k < NHELP; ++k) P[k] = MFMA16(A2[k], accB(P[k]), P[k]);
#pragma unroll
    for (int k = 0; k < NHELP; ++k) P[k] = MFMA16(A1[k], accB(P[k]), P[k]);
#pragma unroll
    for (int k = 0; k < NHELP; ++k) *(LAS v2u*)(scr + k * (16 * TILEB) + o_w) = (v2u){cvt2(P[k][0], P[k][1]), cvt2(P[k][2], P[k][3])};
#pragma unroll
    for (int k = 0; k < NHELP; ++k) tt[k] = trd(scr + k * (16 * TILEB) + o_r);
}

__device__ __forceinline__ void p4_scan(Frame& F, const Args& AR) {
    const bf16* PROJ = (const bf16*)(F.ws + WS_PROJ); const bf16* DAG = (const bf16*)(F.ws + WS_DAG);
    float* BON = nullptr; bf16* MIX = (bf16*)(F.ws + WS_XN);
    LAS unsigned char* lds = F.lds + RING_OFF;
    LAS float* cst = (LAS float*)(lds + SC_CONST);
    const int tid = F.tid, lane = F.lane, wave = F.wave;
    for (int unit = blockIdx.x; unit < BATCH * NH; unit += F.G) {
        const int b = unit >> 3, h = unit & 7;
        const int tok0 = b * SEQ;
        if (tid < 384) { const int a = tid >> 6, c = tid & 63; const float* src = a == 0 ? AR.in[I_MU] + RC_R : a == 1 ? AR.in[I_MU] + RC_K : a == 2 ? AR.in[I_MU] + RC_V : a == 3 ? AR.in[I_KK] : a == 4 ? AR.in[I_KA] : AR.in[I_RK];
            cst[a * 64 + c] = src[h * 64 + c]; }
        __syncthreads();
        const int st_k = (tid >> 7) & 1, st_t = (tid >> 3) & 15, st_p = tid & 7;
        GAS v4u* ystore = (GAS v4u*)((GAS bf16*)MIX + (size_t)(tok0 + st_k * CS + st_t) * D + AW + h * 64 + 8 * st_p);
        const GAS v4u* gload = (const GAS v4u*)((const GAS bf16*)DAG + (size_t)(tok0 + st_k * CS + st_t) * NLORA + 1024 + h * 64 + 8 * st_p);
        const LAS unsigned char* yl_rd = lds + SC_YL + st_k * (CS * 256) + st_t * 256 + st_p * 16;
        v4u gnA = (v4u){0u, 0u, 0u, 0u}, gnB = gnA;
        float lng[8], lnb[8];
#pragma unroll
        for (int i = 0; i < 8; ++i) { lng[i] = AR.in[I_LNG][h * 64 + 8 * st_p + i]; lnb[i] = AR.in[I_LNB][h * 64 + 8 * st_p + i]; }
#define RWKV_OUT(it_, KO, gnext) do { if ((it_) >= 2 && NHELP * ((it_) - 2) + st_k + (KO) < NCHUNK) { \
            const v4u gw4 = gnext; \
            const v4u yw = *(const LAS v4u*)(yl_rd + (KO) * (CS * 256) + ((it_) & 1) * YL_BYTES), bw = *(const LAS v4u*)(yl_rd + (KO) * (CS * 256) + ((it_) & 1) * YL_BYTES + 128); \
            float y[8] = {bflo(yw.x), bfhi(yw.x), bflo(yw.y), bfhi(yw.y), bflo(yw.z), bfhi(yw.z), bflo(yw.w), bfhi(yw.w)}; \
            float sm = ((y[0] + y[1]) + (y[2] + y[3])) + ((y[4] + y[5]) + (y[6] + y[7])); \
            sm = red8(sm); \
            const float mean = sm * (1.f / 64.f); float sv = 0.f; \
            _Pragma("unroll") for (int i = 0; i < 8; ++i) { y[i] -= mean; sv += y[i] * y[i]; } \
            sv = red8(sv); \
            const float rs = 1.f / sqrtf(sv * (1.f / 64.f) + LNX_EPS); \
            const float bf_[8] = {bflo(bw.x), bfhi(bw.x), bflo(bw.y), bfhi(bw.y), bflo(bw.z), bfhi(bw.z), bflo(bw.w), bfhi(bw.w)}; \
            const float gf[8] = {bflo(gw4.x), bfhi(gw4.x), bflo(gw4.y), bfhi(gw4.y), bflo(gw4.z), bfhi(gw4.z), bflo(gw4.w), bfhi(gw4.w)}; \
            float ro[8]; \
            _Pragma("unroll") for (int i = 0; i < 8; ++i) ro[i] = (y[i] * rs * lng[i] + lnb[i] + bf_[i]) * gf[i]; \
            ystore[(size_t)(NHELP * ((it_) - 2) + (KO)) * CS * D / 8] = (v4u){pk2(ro[0], ro[1]), pk2(ro[2], ro[3]), pk2(ro[4], ro[5]), pk2(ro[6], ro[7])}; } \
            if ((it_) >= 1 && NHELP * ((it_) - 1) + st_k + (KO) < NCHUNK) gnext = gload[(size_t)(NHELP * ((it_) - 1) + (KO)) * CS * NLORA / 8]; } while (0)
        volatile LAS unsigned* cnt = (volatile LAS unsigned*)(F.lds + LDSCTL_OFF + 128);
        if (tid < 8) cnt[tid] = 0u;
        __syncthreads();
#define LDS_WAIT_GE(idx, target) do { while (cnt[idx] < (unsigned)(target)) __builtin_amdgcn_s_sleep(1); asm volatile("" ::: "memory"); } while (0)
#define LDS_SIGNAL(idx) do { asm volatile("s_waitcnt lgkmcnt(0)" ::: "memory"); if (lane == 0) __hip_atomic_fetch_add((LAS unsigned*)(cnt + (idx)), 1u, __ATOMIC_RELAXED, __HIP_MEMORY_SCOPE_WORKGROUP); } while (0)
        if (wave >= NSTATE) {
            const int hw = wave - NSTATE, kg = lane >> 4, tokl = tok0 + (lane & 15);
            HReg R;
            helper_load(R, PROJ, DAG, tokl + hw * CS, h, kg);
            for (int it = 0; it < NIT; ++it) {
                const int ch = NHELP * it + hw, s_ = it & 1;
                if (it >= 2) LDS_WAIT_GE(2 + s_, NSTATE * (it >> 1));
                helper_chunk(lds + (s_ * NHELP + hw) * SL_BYTES, cst, R, ch + NHELP < NCHUNK, PROJ, DAG, BON, tokl + ch * CS, h, lane);
                LDS_SIGNAL(0 + s_);
            }
        } else {
            f32x4 X[4];
#pragma unroll
            for (int jb = 0; jb < 4; ++jb) X[jb] = (f32x4){0.f, 0.f, 0.f, 0.f};
            for (int j = 0; j <= NIT; ++j) {
                if (j >= 1) { LDS_WAIT_GE(4 + ((j - 1) & 1), NSTATE * (((j - 1) >> 1) + 1));
                    RWKV_OUT(j + 1, 0, gnA); RWKV_OUT(j + 1, 2, gnB);
                    LDS_SIGNAL(6 + ((j - 1) & 1)); }
                else { RWKV_OUT(j + 1, 0, gnA); RWKV_OUT(j + 1, 2, gnB); }
                if (j < NIT) {
                    const int s_ = j & 1;
                    LDS_WAIT_GE(0 + s_, NHELP * ((j >> 1) + 1));
                    if (j >= 2) LDS_WAIT_GE(6 + s_, NSTATE * (j >> 1));
                    const LAS unsigned char* set0 = lds + (s_ * NHELP) * SL_BYTES;
                    LAS unsigned char* ylb = lds + SC_YL + s_ * YL_BYTES;
                    v2u tt[NHELP];
                    SOps Oa, Ob;
                    state_load(Oa, set0, lane, wave);
                    state_T(tt, set0, lds + SC_TS + wave * (NHELP * 16 * TILEB), lane);
#pragma unroll
                    for (int k = 0; k < NHELP; k += 2) {
                        state_load(Ob, set0 + (k + 1) * SL_BYTES, lane, wave);
                        state_compute(Oa, tt[k], X, ylb + k * (CS * 256), lane, wave);
                        if (k + 2 < NHELP) state_load(Oa, set0 + (k + 2) * SL_BYTES, lane, wave);
                        state_compute(Ob, tt[k + 1], X, ylb + (k + 1) * (CS * 256), lane, wave);
                    }
                    LDS_SIGNAL(2 + s_); LDS_SIGNAL(4 + s_);
                }
            }
        }
#undef LDS_WAIT_GE
#undef LDS_SIGNAL
        __syncthreads();
    }
}

__device__ __forceinline__ s16x4 vtr(const LAS unsigned char* p) { typedef short v4i16_t __attribute__((ext_vector_type(4)));
    return __builtin_bit_cast(s16x4, __builtin_amdgcn_ds_read_tr16_b64_v4i16((LAS v4i16_t*)p)); }
constexpr int ATT_UNITS = 3 * BATCH * NH * 16;
__device__ __forceinline__ void p4_attn(Frame& F, const Args& AR) {
    const bf16* PROJ = (const bf16*)(F.ws + WS_PROJ);
    bf16* PO = (bf16*)((unsigned char*)F.out + DO_PO); float* ML = (float*)(F.ws + WS_ML);
    const int tid = F.tid, lane = F.lane, wave = F.wave, half = wave >> 2, wq = wave & 3, th = tid & 255;
    const int r32 = lane & 31, hi = lane >> 5;
    LAS unsigned char* Kl = F.lds + RING_OFF + half * 65536; LAS unsigned char* Vl = Kl + 32768;
    gu32* qctr = F.ctl + CW_ATTQ;
    v4u kst[8], vst[8];
#define ATT_DECODE(up_) const int unit = 2 * (up_) + half; \
        const int pat = unit / (BATCH * NH * 16), rem = unit % (BATCH * NH * 16), bh = rem >> 4, i16 = rem & 15, b = bh >> 3, h = bh & 7; \
        const int dil = pat == 0 ? 1 : (pat == 1 ? 4 : 16); \
        const int res = pat == 0 ? 0 : (pat == 1 ? (i16 >> 2) : i16); \
        const int n = pat == 0 ? i16 : (pat == 1 ? (i16 & 3) : 0); \
        const size_t rowb = (size_t)b * SEQ;
#define ATT_ISSUE(up_) do { ATT_DECODE(up_) const int c = th & 7; \
        _Pragma("unroll") for (int i = 0; i < 8; ++i) { const int key = (th >> 3) + 32 * i; const int sub = 128 * (n - 1) + key; \
            kst[i] = (v4u){0u, 0u, 0u, 0u}; vst[i] = kst[i]; \
            if (sub >= 0) { const GAS bf16* src = (const GAS bf16*)PROJ + (rowb + res + dil * sub) * IN_COLS + h * 64 + 8 * c; kst[i] = *(const GAS v4u*)(src + PC_K); vst[i] = *(const GAS v4u*)(src + PC_V); } } } while (0)
    if (tid == 0) F.MISC[16] = __hip_atomic_fetch_add(qctr, 1u, RLX_AGENT);
    __syncthreads();
    int up = (int)F.MISC[16];
    __syncthreads();
    if (up < ATT_UNITS / 2) ATT_ISSUE(up);
    while (up < ATT_UNITS / 2) {
        if (tid == 0) F.MISC[16] = __hip_atomic_fetch_add(qctr, 1u, RLX_AGENT);
        ATT_DECODE(up)
        const int ql = 32 * wq + r32; const size_t qrow = rowb + res + dil * (128 * n + ql);
        bf16x8 qf[4];
#pragma unroll
        for (int d0 = 0; d0 < 4; ++d0) qf[d0] = *(const GAS bf16x8*)((const GAS bf16*)PROJ + qrow * IN_COLS + PC_Q + h * 64 + 16 * d0 + 8 * hi);
        {
            const int c = th & 7;
#pragma unroll
            for (int i = 0; i < 8; ++i) {
                const int key = (th >> 3) + 32 * i;
                *(LAS v4u*)(Kl + key * 128 + ((c ^ ((key >> 1) & 7)) * 16)) = kst[i];
                *(LAS v4u*)(Vl + (c >> 2) * 16384 + key * 64 + (c & 3) * 16) = vst[i];
            }
        }
        __syncthreads();
        const int upn = (int)F.MISC[16];
        if (upn < ATT_UNITS / 2) { ATT_ISSUE(upn); }
        const float slope2 = __builtin_amdgcn_exp2f(-(float)(h + 1)) * (float)dil * LOG2E;
        const int thr = r32 - 4 * hi;
        f32x16 sc[5];
        float mx = -INFINITY;
#pragma unroll
        for (int kt = 0; kt < 5; ++kt) {
            const bool skip = (n == 0) && (wq + kt < 4);
            f32x16 acc;
            if (!skip) {
                const int key = 32 * (wq + kt) + r32;
                const float bk = -slope2 * (float)(128 - 32 * kt + thr);
#pragma unroll
                for (int r = 0; r < 16; ++r) acc[r] = slope2 * (float)((r & 3) + 8 * (r >> 2)) + bk;
#pragma unroll
                for (int d0 = 0; d0 < 4; ++d0) {
                    const bf16x8 kf = *(const LAS bf16x8*)(Kl + key * 128 + (((2 * d0 + hi) ^ ((key >> 1) & 7)) * 16));
                    acc = __builtin_amdgcn_mfma_f32_32x32x16_bf16(kf, qf[d0], acc, 0, 0, 0);
                }
                if (kt == 0) {
#pragma unroll
                    for (int r = 0; r < 16; ++r) acc[r] = ((r & 3) + 8 * (r >> 2)) >= thr ? acc[r] : -INFINITY;
                }
                if (kt == 4) {
#pragma unroll
                    for (int r = 0; r < 16; ++r) acc[r] = ((r & 3) + 8 * (r >> 2)) <= thr ? acc[r] : -INFINITY;
                }
#pragma unroll
                for (int r = 0; r < 16; ++r) mx = fmaxf(mx, acc[r]);
            } else {
#pragma unroll
                for (int r = 0; r < 16; ++r) acc[r] = -INFINITY;
            }
            sc[kt] = acc;
            __builtin_amdgcn_sched_barrier(0);
        }
        mx = fmaxf(mx, __shfl_xor(mx, 32));
        float l = 0.f;
#pragma unroll
        for (int kt = 0; kt < 5; ++kt)
#pragma unroll
            for (int r = 0; r < 16; ++r) { const float p = __builtin_amdgcn_exp2f(sc[kt][r] - mx); sc[kt][r] = p; l += p; }
        l += __shfl_xor(l, 32);
        f32x16 o[2]; o[0] = f32x16{}; o[1] = f32x16{};
        const int voff = ((lane >> 4) & 1) * 32 + (lane & 3) * 8 + (4 * hi + ((lane & 15) >> 2)) * 64;
#pragma unroll
        for (int kt = 0; kt < 5; ++kt) {
            const bool skip = (n == 0) && (wq + kt < 4);
            if (!skip) {
#pragma unroll
            for (int s2 = 0; s2 < 2; ++s2) {
                v4u pw;
                pw.x = pg8::cvt_pk_bf16(sc[kt][8 * s2 + 0], sc[kt][8 * s2 + 1]); pw.y = pg8::cvt_pk_bf16(sc[kt][8 * s2 + 2], sc[kt][8 * s2 + 3]);
                pw.z = pg8::cvt_pk_bf16(sc[kt][8 * s2 + 4], sc[kt][8 * s2 + 5]); pw.w = pg8::cvt_pk_bf16(sc[kt][8 * s2 + 6], sc[kt][8 * s2 + 7]);
                const bf16x8 pf = __builtin_bit_cast(bf16x8, pw);
                const int kb = 32 * (wq + kt) + 16 * s2;
#pragma unroll
                for (int dt = 0; dt < 2; ++dt) {
                    const LAS unsigned char* vp = Vl + dt * 16384 + kb * 64 + voff;
                    const s16x4 lo = vtr(vp), hi4 = vtr(vp + 8 * 64);
                    const bf16x8 vf = (bf16x8){lo[0], lo[1], lo[2], lo[3], hi4[0], hi4[1], hi4[2], hi4[3]};
                    o[dt] = __builtin_amdgcn_mfma_f32_32x32x16_bf16(vf, pf, o[dt], 0, 0, 0);
                }
            }
            }
        }
        const float rl = 1.f / l;
        bf16* po = PO + ((size_t)pat * M + qrow) * AW + h * 64;
#pragma unroll
        for (int dt = 0; dt < 2; ++dt)
#pragma unroll
            for (int g = 0; g < 4; ++g) {
                const v2u w = (v2u){pk2(o[dt][4 * g] * rl, o[dt][4 * g + 1] * rl), pk2(o[dt][4 * g + 2] * rl, o[dt][4 * g + 3] * rl)};
                *(v2u*)(po + 32 * dt + 8 * g + 4 * hi) = w;
            }
        if (hi == 0) *(f32x2*)(ML + (((size_t)pat * M + qrow) * NH + h) * 2) = (f32x2){mx, l};
        __syncthreads();
        up = upn;
    }
#undef ATT_DECODE
#undef ATT_ISSUE
}

struct P5In { v4u po[3]; f32x2 ml[3]; };
__device__ __forceinline__ void p5_load(P5In& I, int m, int lane, const bf16* PO, const float* ML) {
    const int hd = lane >> 3;
#pragma unroll
    for (int p = 0; p < 3; ++p) { I.ml[p] = *(const GAS f32x2*)(ML + (((size_t)p * M + m) * NH + hd) * 2); I.po[p] = *(const GAS v4u*)(PO + ((size_t)p * M + m) * AW + 8 * lane); }
}
__device__ __forceinline__ void p5_token(const P5In& I, int m, int lane, bf16* MIX, const float (&aog)[8]) {
    const float mm = fmaxf(fmaxf(I.ml[0].x, I.ml[1].x), I.ml[2].x);
    float wp[3], wsum = 0.f;
#pragma unroll
    for (int p = 0; p < 3; ++p) { wp[p] = __builtin_amdgcn_exp2f(I.ml[p].x - mm) * I.ml[p].y; wsum += wp[p]; }
    const float rws = 1.f / wsum;
    float at[8] = {0.f, 0.f, 0.f, 0.f, 0.f, 0.f, 0.f, 0.f};
#pragma unroll
    for (int p = 0; p < 3; ++p) { const v4u w = I.po[p]; const float f = wp[p] * rws;
        at[0] += f * bflo(w.x); at[1] += f * bfhi(w.x); at[2] += f * bflo(w.y); at[3] += f * bfhi(w.y); at[4] += f * bflo(w.z); at[5] += f * bfhi(w.z); at[6] += f * bflo(w.w); at[7] += f * bfhi(w.w); }
    float ss = 0.f;
#pragma unroll
    for (int i = 0; i < 8; ++i) ss += at[i] * at[i];
    ss += __shfl_xor(ss, 1); ss += __shfl_xor(ss, 2); ss += __shfl_xor(ss, 4);
    const float rstd = 1.f / sqrtf(ss * (1.f / 64.f) + NORM_EPS);
    v4u oa; oa.x = pk2(at[0] * rstd * aog[0], at[1] * rstd * aog[1]); oa.y = pk2(at[2] * rstd * aog[2], at[3] * rstd * aog[3]);
    oa.z = pk2(at[4] * rstd * aog[4], at[5] * rstd * aog[5]); oa.w = pk2(at[6] * rstd * aog[6], at[7] * rstd * aog[7]);
    *(GAS v4u*)(MIX + (size_t)m * D + 8 * lane) = oa;
}
__device__ __forceinline__ void p5_post(Frame& F, const Args& AR) {
    const int gw = F.vcu * NWAVES + F.wave, NGW = F.G * NWAVES, lane = F.lane;
    const bf16* PO = (const bf16*)((unsigned char*)F.out + DO_PO); const float* ML = (const float*)(F.ws + WS_ML);
    bf16* MIX = (bf16*)(F.ws + WS_XN);
    float aog[8];
#pragma unroll
    for (int i = 0; i < 8; ++i) aog[i] = AR.in[I_AOG][8 * lane + i];
    static_assert(M % 4 == 0, "four tokens per step");
    for (int m = 4 * gw; m < M; m += 4 * NGW) {
        P5In A, B, C, E;
        p5_load(A, m, lane, PO, ML); p5_load(B, m + 1, lane, PO, ML); p5_load(C, m + 2, lane, PO, ML); p5_load(E, m + 3, lane, PO, ML);
        p5_token(A, m, lane, MIX, aog); p5_token(B, m + 1, lane, MIX, aog); p5_token(C, m + 2, lane, MIX, aog); p5_token(E, m + 3, lane, MIX, aog);
    }
}

__device__ __forceinline__ void p1_tail_weights(Frame& F, const Args& AR, int w0, int nw) {
    LAS float* scr = (LAS float*)(F.lds + RING_OFF + F.wave * TR_SCR);
    bf16* Wout_t = (bf16*)(F.ws + WS_WOUT); bf16* Wgu_t = (bf16*)(F.ws + WS_WGU); bf16* Wdn_t = (bf16*)(F.ws + WS_WDN);
    constexpr int I_OUT = (D / 64) * (D / 64), I_G = (D / 64) * (FF / 64), I_DN = (FF / 64) * (D / 64), NLATE = I_OUT + 2 * I_G + I_DN;
    for (int it = w0; it < NLATE; it += nw) {
        int r = it;
        if (r < I_OUT) { p0_transpose_item(AR.in[I_WOUT], D, D, Wout_t, 0, scr, r, F.lane); continue; } r -= I_OUT;
        if (r < I_G) { p0_transpose_item(AR.in[I_WG], D, FF, Wgu_t, 1, scr, r, F.lane, AR.in[I_N2G]); continue; } r -= I_G;
        if (r < I_G) { p0_transpose_item(AR.in[I_WU], D, FF, Wgu_t, 2, scr, r, F.lane, AR.in[I_N2G]); continue; } r -= I_G;
        p0_transpose_item(AR.in[I_WD], FF, D, Wdn_t, 0, scr, r, F.lane);
    }
}

__global__ void __launch_bounds__(NWAVES * 64, 2) hybrid_fwd(Args args) {
    extern __shared__ __attribute__((aligned(16))) unsigned char lds[];
    Frame F;
    F.lds = (LAS unsigned char*)lds;
    F.MISC = (volatile LAS unsigned*)(F.lds + MISC_OFF);
    F.tid = threadIdx.x; F.lane = F.tid & 63; F.wave = __builtin_amdgcn_readfirstlane(F.tid >> 6);
    F.G = gridDim.x; { const int bx = blockIdx.x; F.vcu = (F.G % 8 == 0) ? (bx % 8) * (F.G / 8) + bx / 8 : bx; }
    F.ws = args.ws; F.out = args.out;
    F.ctl = (gu32*)(args.ws + WS_CTL);
    for (int u = F.tid; u < (LDS_BYTES - LDSCTL_OFF) / 4; u += NWAVES * 64) ((LAS unsigned*)(F.lds + LDSCTL_OFF))[u] = 0u;
    __syncthreads();
    XcdBarrier bar; bar.bar = (unsigned*)(F.ctl + CW_BAR); bar.x = 0; bar.st = nullptr;
    if (N_LAUNCHES != PER_PHASE) bar = xcd_barrier_post((unsigned*)(F.ctl + CW_BAR), F.MISC + 8);
#define GRID_BAR() do { if (N_LAUNCHES != PER_PHASE) xcd_barrier(bar); } while (0)
    const int lo = args.ph_lo, hi = args.ph_hi;
#ifndef PHMASK
#define PHMASK 0x3ff
#endif
#define IN(k) (((PHMASK >> (k)) & 1) && lo <= (k) && (k) < hi)
#define BOTH(k) (IN(k) && IN((k) + 1))
#define PSTAMP(i) do { if (PROBE_SEL >= 0 && blockIdx.x == 0 && F.tid == 0) { const unsigned long long t_ = __builtin_amdgcn_s_memtime(); __hip_atomic_store(F.ctl + 9100 + (i), (unsigned)(t_ >> 4), RLX_AGENT); } } while (0)
#ifndef REPMASK
#define REPMASK 0
#endif
#define REP(k) for (int rep_ = 0; rep_ <= ((REPMASK >> (k)) & 1); ++rep_)
    bf16* XN = (bf16*)(args.ws + WS_XN); bf16* PROJ = (bf16*)(args.ws + WS_PROJ);

    PSTAMP(0);
    if (IN(0)) { p0_prologue(F, args); if (BOTH(0)) GRID_BAR(); }
    PSTAMP(1);
    if (IN(1)) {
        pg8::Gemm g{XN, (const bf16*)(args.ws + WS_WIN), M, IN_COLS, D}; pg8::StaticOrder S; S.init(M, IN_COLS, F.G, (int)blockIdx.x);
        pg8::EpiProj E{PROJ, IN_COLS, args.in[I_QNG], args.in[I_KNG]};
        pg8::gemm_phase<pg8::EpiProj, pg8::StaticOrder, true, true>(F.lds + RING_OFF, g, S, E);
        { const int nu = (M / 256) * (IN_COLS / 256), rem = nu % F.G;
          if (rem == 0) p1_tail_weights(F, args, (int)blockIdx.x * NWAVES + F.wave, F.G * NWAVES);
          else if ((int)blockIdx.x >= rem) p1_tail_weights(F, args, ((int)blockIdx.x - rem) * NWAVES + F.wave, (F.G - rem) * NWAVES); }
        if (BOTH(1)) GRID_BAR();
    }
    PSTAMP(2);
    PSTAMP(3);
    if (IN(3)) { p3_lora(F, args); if (BOTH(3)) GRID_BAR(); }
    PSTAMP(4);
    if (IN(4)) { p4_scan(F, args); PSTAMP(11); p4_attn(F, args); PSTAMP(12); if (BOTH(4)) GRID_BAR(); }
    PSTAMP(5);
    if (IN(5)) { p5_post(F, args); if (BOTH(5)) GRID_BAR(); }
    PSTAMP(6);
    if (IN(6)) {
        pg8::Gemm g{XN, (const bf16*)(args.ws + WS_WOUT), M, D, D}; pg8::StaticOrder S; S.init(M, D, F.G, (int)blockIdx.x);
        pg8::EpiOut E{args.in[I_X], (bf16*)(args.ws + WS_DAG), (float*)(args.ws + WS_SS), D, (LAS float*)(F.lds + RING_OFF + 131072)};
        pg8::gemm_phase<pg8::EpiOut, pg8::StaticOrder, true, true>(F.lds + RING_OFF, g, S, E);
        if (IN(8)) GRID_BAR();
    }
    PSTAMP(8);
    if (IN(8)) {
        pg8::Gemm g{(const bf16*)(args.ws + WS_DAG), (const bf16*)(args.ws + WS_WGU), M, NGU, D}; pg8::StaticOrder S; S.init(M, NGU, F.G, (int)blockIdx.x);
        pg8::EpiSwiglu E{PROJ, FF, (const float*)(args.ws + WS_SS)};
        pg8::gemm_phase<pg8::EpiSwiglu, pg8::StaticOrder, true, true>(F.lds + RING_OFF, g, S, E);
        if (BOTH(8)) GRID_BAR();
    }
    PSTAMP(9);
    if (IN(9)) {
        pg8::Gemm g{PROJ, (const bf16*)(args.ws + WS_WDN), M, D, FF}; pg8::StaticOrder S; S.init(M, D, F.G, (int)blockIdx.x);
        pg8::EpiFinal E{(const bf16*)(args.ws + WS_DAG), F.out, D};
        pg8::gemm_phase<pg8::EpiFinal, pg8::StaticOrder, true, true>(F.lds + RING_OFF, g, S, E);
    }
    PSTAMP(10);
    if (PROBE_SEL >= 0 && blockIdx.x == 0 && F.tid == 0) {
        unsigned w = 0;
        auto ld = [&](int i) { return __hip_atomic_load(F.ctl + 9100 + i, RLX_AGENT); };
        const int sel = PROBE_SEL;
        if (sel <= 9) { const int nxt = sel == 6 ? 8 : (sel == 9 ? 10 : sel + 1); w = ld(nxt) - ld(sel); }
        else if (sel == 20) w = ld(11) - ld(4);
        else if (sel == 21) w = ld(12) - ld(11);
        else w = ld(sel);
        const unsigned long long t0 = __builtin_amdgcn_s_memtime();
        while (((__builtin_amdgcn_s_memtime() - t0) >> 4) < (unsigned long long)w) __builtin_amdgcn_s_sleep(8);
    }
#undef IN
#undef BOTH
}

extern "C" void kernel_launch(void* const* d_in, const int* in_sizes, int n_in, void* d_out, int out_size, void* d_ws, size_t ws_size, hipStream_t stream) {
    static int grid = 0;
    if (grid == 0) {
        if (n_in != 22 || in_sizes[0] != M * D || out_size != M * D || ws_size < WS_END) { fprintf(stderr, "kernel_launch: unexpected shapes (n_in %d, in0 %d, out %d, ws %zu); nothing launched\n", n_in, n_in > 0 ? in_sizes[0] : -1, out_size, ws_size); grid = -1; return; }
        int dev = 0, cus = 0, per_cu = 0;
        if (hipGetDevice(&dev) != hipSuccess || hipDeviceGetAttribute(&cus, hipDeviceAttributeMultiprocessorCount, dev) != hipSuccess) { grid = -1; return; }
        if (hipFuncSetAttribute((const void*)hybrid_fwd, hipFuncAttributeMaxDynamicSharedMemorySize, LDS_BYTES) != hipSuccess) { fprintf(stderr, "kernel_launch: hipFuncSetAttribute failed\n"); grid = -1; return; }
        if (hipOccupancyMaxActiveBlocksPerMultiprocessor(&per_cu, (const void*)hybrid_fwd, NWAVES * 64, LDS_BYTES) != hipSuccess || per_cu < 1)
            fprintf(stderr, "kernel_launch: note: occupancy query reports %d workgroups per CU\n", per_cu);
        (void)hipGetLastError();
        grid = cus;
    }
    if (grid < 0) return;
    if (hipMemsetAsync((char*)d_ws + WS_CTL, 0, CTL_ZERO_BYTES, stream) != hipSuccess) { fprintf(stderr, "kernel_launch: hipMemsetAsync failed\n"); return; }
    Args a{};
    for (int i = 0; i < 22; ++i) a.in[i] = (const float*)d_in[i];
    a.out = (float*)d_out; a.ws = (unsigned char*)d_ws;
    for (int li = 0; li < N_LAUNCHES; ++li) {
        a.ph_lo = (N_LAUNCHES == PER_PHASE) ? li : 0; a.ph_hi = (N_LAUNCHES == PER_PHASE) ? li + 1 : PER_PHASE; a.li = li;
        hipLaunchKernelGGL(hybrid_fwd, dim3(grid), dim3(NWAVES * 64), LDS_BYTES, stream, a);
        const hipError_t le = hipPeekAtLastError();
        if (le != hipSuccess) { fprintf(stderr, "kernel_launch: launch %d failed: %s\n", li, hipGetErrorName(le)); break; }
    }
}
```

```cpp
#include <hip/hip_runtime.h>
#include <cstdio>
#include <cstdint>

#ifndef PROBE_SEL
#define PROBE_SEL -1
#endif
#ifndef MK_N_LAUNCHES
#define MK_N_LAUNCHES 1
#endif

namespace pg8 {
#define PG8_LAS __attribute__((address_space(3)))
typedef unsigned short bf16_t;
typedef short bf16x8 __attribute__((ext_vector_type(8)));
typedef float f32x4 __attribute__((ext_vector_type(4)));
typedef float f32x2 __attribute__((ext_vector_type(2)));
typedef unsigned u32x4 __attribute__((ext_vector_type(4)));
constexpr int BM = 256, BK = 64, HALF = 128, HTB = HALF * BK * 2, STAGE_BYTES = 8 * HTB, NXCD = 8, WGM = 8;

__host__ __device__ __forceinline__ int lds_byte(int r, int c) { const int st = (r >> 4) * 2 + (c >> 5), rr = r & 15, cc = c & 31, ob = rr * 64 + cc * 2; return st * 1024 + (ob ^ (((ob >> 9) & 1) << 5)); }
__host__ __device__ __forceinline__ void stage_rc(int b, int& R, int& C) { const int st = b / 1024, sb = b % 1024, swz = sb ^ (((sb >> 9) & 1) << 5); R = (st >> 1) * 16 + swz / 64; C = (st & 1) * 32 + (swz % 64) / 2; }
__host__ __device__ __forceinline__ int perm32(int rho) { const int n = rho >> 4, i = rho & 15; return 8 * (i >> 2) + 4 * n + (i & 3); }

struct Unit { int pm, pn; };
struct Gemm { const bf16_t* A; const bf16_t* Bt; int M, N, K; };

struct StaticOrder {
    int nM, nN, nwg, G, c;
    __host__ __device__ void init(int M, int N, int G_, int c_) { nM = M / BM; nN = N / BM; nwg = nM * nN; G = G_; c = c_; }
    __host__ __device__ bool next(int i, Unit& u) const {
        const long L = (long)i * G + c; if (L >= nwg) return false;
        int wgid = (int)L; { const int q = nwg / NXCD, r = nwg % NXCD, xcd = wgid % NXCD, off = wgid / NXCD; wgid = (xcd < r ? xcd * (q + 1) : r * (q + 1) + (xcd - r) * q) + off; }
        const int nig = WGM * nN, gid = wgid / nig, fm = gid * WGM, gsz = (nM - fm) < WGM ? (nM - fm) : WGM;
        u.pm = fm + ((wgid % nig) % gsz); u.pn = (wgid % nig) / gsz; return true;
    }
    __device__ __forceinline__ void a_ready(const Unit&) const {}
    __device__ __forceinline__ void done(const Unit&) const {}
};

__device__ __forceinline__ unsigned cvt_pk_bf16(float lo, float hi) { unsigned r; asm volatile("v_cvt_pk_bf16_f32 %0, %1, %2" : "=v"(r) : "v"(lo), "v"(hi)); return r; }
__device__ __forceinline__ float fsigmoid(float x) { return __builtin_amdgcn_rcpf(1.0f + __builtin_amdgcn_exp2f(-1.4426950408889634f * x)); }

struct EpiBf16 {
    static constexpr bool PERM = true, AFTER_DRAIN = false;
    bf16_t* O; int ldc;
    __device__ __forceinline__ void operator()(const f32x4 (&acc)[2][2][4][2], const Unit& u, int wr, int wc, int fr, int fq) const {
        const int row0 = u.pm * BM + wr * 64 + fr; const int col0 = u.pn * BM + wc * 32 + 8 * fq;
#pragma unroll
        for (int ai = 0; ai < 2; ++ai)
#pragma unroll
            for (int m = 0; m < 4; ++m) { bf16_t* rowp = O + (size_t)(row0 + ai * HALF + m * 16) * ldc + col0;
#pragma unroll
                for (int bj = 0; bj < 2; ++bj) { const f32x4 v0 = acc[ai][bj][m][0], v1 = acc[ai][bj][m][1];
                    u32x4 w; w.x = cvt_pk_bf16(v0[0], v0[1]); w.y = cvt_pk_bf16(v0[2], v0[3]); w.z = cvt_pk_bf16(v1[0], v1[1]); w.w = cvt_pk_bf16(v1[2], v1[3]);
                    *(u32x4*)(rowp + bj * HALF) = w; } }
    }
};
struct EpiProj {
    static constexpr bool PERM = true, AFTER_DRAIN = false;
    bf16_t* O; int ldc; const float* qg; const float* kg;
    __device__ __forceinline__ void operator()(const f32x4 (&acc)[2][2][4][2], const Unit& u, int wr, int wc, int fr, int fq) const {
        const int row0 = u.pm * BM + wr * 64 + fr;
        if (u.pn >= 4) {
            const int col0 = u.pn * BM + wc * 32 + 8 * fq;
#pragma unroll
            for (int ai = 0; ai < 2; ++ai)
#pragma unroll
                for (int m = 0; m < 4; ++m) { bf16_t* rowp = O + (size_t)(row0 + ai * HALF + m * 16) * ldc + col0;
#pragma unroll
                    for (int bj = 0; bj < 2; ++bj) { const f32x4 v0 = acc[ai][bj][m][0], v1 = acc[ai][bj][m][1];
                        u32x4 w; w.x = cvt_pk_bf16(v0[0], v0[1]); w.y = cvt_pk_bf16(v0[2], v0[3]); w.z = cvt_pk_bf16(v1[0], v1[1]); w.w = cvt_pk_bf16(v1[2], v1[3]);
                        *(u32x4*)(rowp + bj * HALF) = w; } }
        } else {
            const float* gsrc = (u.pn < 2 ? qg : kg) + 8 * fq; const float sc = u.pn < 2 ? 0.125f * 1.4426950408889634f : 1.0f;
            f32x4 g4[2][2];
#pragma unroll
            for (int bj = 0; bj < 2; ++bj)
#pragma unroll
                for (int n = 0; n < 2; ++n) g4[bj][n] = *(const f32x4*)(gsrc + 32 * bj + 4 * n) * sc;
            const int col0 = u.pn * BM + wc * 64 + 8 * fq;
#pragma unroll
            for (int ai = 0; ai < 2; ++ai)
#pragma unroll
                for (int m = 0; m < 4; ++m) {
                    float ss = 0.f;
#pragma unroll
                    for (int bj = 0; bj < 2; ++bj)
#pragma unroll
                        for (int n = 0; n < 2; ++n) { const f32x4 v = acc[ai][bj][m][n]; ss += (v[0] * v[0] + v[1] * v[1]) + (v[2] * v[2] + v[3] * v[3]); }
                    ss += __shfl_xor(ss, 16); ss += __shfl_xor(ss, 32);
                    const float rstd = 1.0f / sqrtf(ss * (1.0f / 64.0f) + 1e-6f);
                    bf16_t* rowp = O + (size_t)(row0 + ai * HALF + m * 16) * ldc + col0;
#pragma unroll
                    for (int bj = 0; bj < 2; ++bj) { const f32x4 v0 = acc[ai][bj][m][0] * g4[bj][0] * rstd, v1 = acc[ai][bj][m][1] * g4[bj][1] * rstd;
                        u32x4 w; w.x = cvt_pk_bf16(v0[0], v0[1]); w.y = cvt_pk_bf16(v0[2], v0[3]); w.z = cvt_pk_bf16(v1[0], v1[1]); w.w = cvt_pk_bf16(v1[2], v1[3]);
                        *(u32x4*)(rowp + 32 * bj) = w; }
                    __builtin_amdgcn_sched_barrier(0); }
        }
    }
};
struct EpiLora {
    static constexpr bool PERM = true, AFTER_DRAIN = false;
    bf16_t* O; int ldc; const float* w0; const float* a0;
    __device__ __forceinline__ void operator()(const f32x4 (&acc)[2][2][4][2], const Unit& u, int wr, int wc, int fr, int fq) const {
        const int row0 = u.pm * BM + wr * 64 + fr; const int col0 = u.pn * BM + wc * 32 + 8 * fq;
        const int kind = u.pn >> 1;
        const float sc = kind == 0 ? -0.6065306597126334f : (kind == 1 ? 1.0f : 0.0f), lin = kind == 2 ? 1.0f : 0.0f;
        const float* bp = kind == 0 ? w0 : a0;
        const float bs = kind == 2 ? 0.0f : 1.0f;
#pragma unroll
        for (int bj = 0; bj < 2; ++bj) {
            const int c = (col0 + bj * HALF) & 511;
            const f32x4 b0 = *(const f32x4*)(bp + c) * bs, b1 = *(const f32x4*)(bp + c + 4) * bs;
#pragma unroll
            for (int ai = 0; ai < 2; ++ai)
#pragma unroll
                for (int m = 0; m < 4; ++m) { bf16_t* rowp = O + (size_t)(row0 + ai * HALF + m * 16) * ldc + col0;
                    f32x4 v0 = acc[ai][bj][m][0] + b0, v1 = acc[ai][bj][m][1] + b1;
#pragma unroll
                    for (int e = 0; e < 4; ++e) { v0[e] = sc * fsigmoid(v0[e]) + lin * v0[e]; v1[e] = sc * fsigmoid(v1[e]) + lin * v1[e]; }
                    u32x4 w; w.x = cvt_pk_bf16(v0[0], v0[1]); w.y = cvt_pk_bf16(v0[2], v0[3]); w.z = cvt_pk_bf16(v1[0], v1[1]); w.w = cvt_pk_bf16(v1[2], v1[3]);
                    *(u32x4*)(rowp + bj * HALF) = w;
                    __builtin_amdgcn_sched_barrier(0); }
        }
    }
};
struct EpiSwiglu {
    static constexpr bool PERM = true, AFTER_DRAIN = false;
    bf16_t* H; int ldh; const float* rstd;
    __device__ __forceinline__ void operator()(const f32x4 (&acc)[2][2][4][2], const Unit& u, int wr, int wc, int fr, int fq) const {
        const int row0 = u.pm * BM + wr * 64 + fr; const int col0 = u.pn * HALF + wc * 32 + 8 * fq;
        float rs[2][4];
#pragma unroll
        for (int ai = 0; ai < 2; ++ai)
#pragma unroll
            for (int m = 0; m < 4; ++m) { const f32x4 s4 = *(const f32x4*)(rstd + (size_t)(row0 + ai * HALF + m * 16) * 4);
                rs[ai][m] = 1.0f / sqrtf(((s4[0] + s4[1]) + (s4[2] + s4[3])) * (1.0f / 1024.0f) + 1e-6f); }
#pragma unroll
        for (int ai = 0; ai < 2; ++ai)
#pragma unroll
            for (int m = 0; m < 4; ++m) { bf16_t* rowp = H + (size_t)(row0 + ai * HALF + m * 16) * ldh + col0;
                float h[8];
#pragma unroll
                for (int n = 0; n < 2; ++n)
#pragma unroll
                    for (int e = 0; e < 4; ++e) { const float g = acc[ai][0][m][n][e] * rs[ai][m], up = acc[ai][1][m][n][e] * rs[ai][m]; h[4 * n + e] = g * fsigmoid(g) * up; }
                u32x4 w; w.x = cvt_pk_bf16(h[0], h[1]); w.y = cvt_pk_bf16(h[2], h[3]); w.z = cvt_pk_bf16(h[4], h[5]); w.w = cvt_pk_bf16(h[6], h[7]);
                *(u32x4*)rowp = w;
                __builtin_amdgcn_sched_barrier(0); }
    }
};
struct EpiOut {
    static constexpr bool PERM = true, AFTER_DRAIN = false;
    const float* base; bf16_t* xb; float* SS; int ldc; PG8_LAS float* scr;
#define EPO_LOAD(dst, g) do { _Pragma("unroll") for (int mm = 0; mm < 2; ++mm) _Pragma("unroll") for (int bj = 0; bj < 2; ++bj) { \
        const size_t o_ = (size_t)(((g) >> 1) * HALF + (((g) & 1) * 2 + mm) * 16) * ldc + bj * HALF; dst[mm * 4 + bj * 2] = *(const f32x4*)(bp + o_); dst[mm * 4 + bj * 2 + 1] = *(const f32x4*)(bp + o_ + 4); } } while (0)
    __device__ __forceinline__ void operator()(const f32x4 (&acc)[2][2][4][2], const Unit& u, int wr, int wc, int fr, int fq) const {
        const int row0 = u.pm * BM + wr * 64 + fr, col0 = u.pn * BM + wc * 32 + 8 * fq;
        const float* bp = base + (size_t)row0 * ldc + col0; bf16_t* xp = xb + (size_t)row0 * ldc + col0;
        f32x4 xa[8], xc[8];
        EPO_LOAD(xa, 0); EPO_LOAD(xc, 1);
        __builtin_amdgcn_sched_barrier(0);
#pragma unroll
        for (int g = 0; g < 4; ++g) {
            const int ai = g >> 1;
            u32x4 wo[4]; float ssv[2];
#pragma unroll
            for (int mm = 0; mm < 2; ++mm) { const int m = (g & 1) * 2 + mm; float ss = 0.f;
#pragma unroll
                for (int bj = 0; bj < 2; ++bj) {
                    const f32x4 o0 = ((g & 1) ? xc : xa)[mm * 4 + bj * 2] + acc[ai][bj][m][0], o1 = ((g & 1) ? xc : xa)[mm * 4 + bj * 2 + 1] + acc[ai][bj][m][1];
                    u32x4 w; w.x = cvt_pk_bf16(o0[0], o0[1]); w.y = cvt_pk_bf16(o0[2], o0[3]); w.z = cvt_pk_bf16(o1[0], o1[1]); w.w = cvt_pk_bf16(o1[2], o1[3]);
                    wo[mm * 2 + bj] = w;
                    ss += ((o0[0] * o0[0] + o0[1] * o0[1]) + (o0[2] * o0[2] + o0[3] * o0[3])) + ((o1[0] * o1[0] + o1[1] * o1[1]) + (o1[2] * o1[2] + o1[3] * o1[3])); }
                ss += __shfl_xor(ss, 16); ss += __shfl_xor(ss, 32); ssv[mm] = ss; }
            __builtin_amdgcn_sched_barrier(0);
            if (g == 0) EPO_LOAD(xa, 2);
            if (g == 1) EPO_LOAD(xc, 3);
            __builtin_amdgcn_sched_barrier(0);
#pragma unroll
            for (int mm = 0; mm < 2; ++mm) { const int m = (g & 1) * 2 + mm;
#pragma unroll
                for (int bj = 0; bj < 2; ++bj) *(u32x4*)(xp + (size_t)(ai * HALF + m * 16) * ldc + bj * HALF) = wo[mm * 2 + bj];
                if (fq == 0) scr[((((wr * 2 + ai) * 4 + m) * 16) + fr) * 4 + wc] = ssv[mm]; }
            __builtin_amdgcn_sched_barrier(0);
        }
        asm volatile("s_waitcnt lgkmcnt(0)" ::: "memory"); __builtin_amdgcn_s_barrier(); asm volatile("" ::: "memory");
        const int tid = threadIdx.x;
        if (tid < 256) { const f32x4 s4 = *(const PG8_LAS f32x4*)(scr + tid * 4);
            const int row = u.pm * BM + ((tid >> 6) & 1) * HALF + (tid >> 7) * 64 + ((tid >> 4) & 3) * 16 + (tid & 15);
            SS[(size_t)row * 4 + u.pn] = (s4[0] + s4[1]) + (s4[2] + s4[3]); }
    }
#undef EPO_LOAD
};
struct EpiFinal {
    static constexpr bool PERM = true, AFTER_DRAIN = false;
    const bf16_t* xb; float* out; int ldc;
    __device__ __forceinline__ void operator()(const f32x4 (&acc)[2][2][4][2], const Unit& u, int wr, int wc, int fr, int fq) const {
        const int row0 = u.pm * BM + wr * 64 + fr, col0 = u.pn * BM + wc * 32 + 8 * fq;
#pragma unroll
        for (int ai = 0; ai < 2; ++ai)
#pragma unroll
            for (int m = 0; m < 4; ++m) { const size_t off = (size_t)(row0 + ai * HALF + m * 16) * ldc + col0;
#pragma unroll
                for (int bj = 0; bj < 2; ++bj) { const u32x4 w = *(const u32x4*)(xb + off + bj * HALF);
                    const f32x4 b0 = (f32x4){__builtin_bit_cast(float, w.x << 16), __builtin_bit_cast(float, w.x & 0xffff0000u), __builtin_bit_cast(float, w.y << 16), __builtin_bit_cast(float, w.y & 0xffff0000u)};
                    const f32x4 b1 = (f32x4){__builtin_bit_cast(float, w.z << 16), __builtin_bit_cast(float, w.z & 0xffff0000u), __builtin_bit_cast(float, w.w << 16), __builtin_bit_cast(float, w.w & 0xffff0000u)};
                    *(f32x4*)(out + off + bj * HALF) = b0 + acc[ai][bj][m][0]; *(f32x4*)(out + off + bj * HALF + 4) = b1 + acc[ai][bj][m][1]; }
                if (m & 1) asm volatile("" ::: "memory"); }
    }
};

template <class Epi, class Sched, bool ALIGN_EPI = false, bool SP2 = false>
__device__ __forceinline__ void gemm_phase(PG8_LAS unsigned char* lds, const Gemm g, const Sched& S, const Epi& E) {
    const int tid = threadIdx.x, wid = __builtin_amdgcn_readfirstlane(tid >> 6), lane = tid & 63, wr = wid >> 2, wc = wid & 3, fr = lane & 15, fq = lane >> 4;
    const int K = g.K, nt = K / BK;
    unsigned voffA[2], voffB[2];
#pragma unroll
    for (int i = 0; i < 2; ++i) { int R, C; stage_rc(tid * 16 + i * 8192, R, C); const int Rb = Epi::PERM ? ((R & ~31) + perm32(R & 31)) : R;
        voffA[i] = (unsigned)(R * K + C) * 2u; voffB[i] = (unsigned)(Rb * K + C) * 2u; }
    const size_t kstep = (size_t)(BK * 2);
    const size_t hstep = (size_t)HALF * K * 2;
    const size_t tstep = 2 * hstep;
    const unsigned ldsw = (unsigned)wid * 1024u;
    const int aoff = lds_byte(wr * 64 + fr, fq * 8), boff = lds_byte(wc * 32 + fr, fq * 8);
#define PG8_SA(b, h) (((b) * 2 + (h)) * HTB)
#define PG8_SB(b, h) ((4 + (b) * 2 + (h)) * HTB)
#define PG8_STAGE(bufoff, gbase, voff) do { _Pragma("unroll") for (int _i = 0; _i < 2; ++_i) \
        __builtin_amdgcn_global_load_lds((const unsigned*)((const char*)(gbase) + (voff)[_i]), (PG8_LAS unsigned*)(lds + (bufoff) + ldsw + _i * 8192), 16, 0, 0); } while (0)
#define PG8_LDA(dst, b, h) do { _Pragma("unroll") for (int m = 0; m < 4; ++m) _Pragma("unroll") for (int k = 0; k < 2; ++k) dst[m][k] = *(const PG8_LAS bf16x8*)(lds + PG8_SA(b, h) + aoff + m * 2048 + k * 1024); } while (0)
#define PG8_LDB(dst, b, h) do { _Pragma("unroll") for (int n = 0; n < 2; ++n) _Pragma("unroll") for (int k = 0; k < 2; ++k) dst[n][k] = *(const PG8_LAS bf16x8*)(lds + PG8_SB(b, h) + boff + n * 2048 + k * 1024); } while (0)
#define PG8_MMA(ai, bj, At, Bt) do { __builtin_amdgcn_s_setprio(1); _Pragma("unroll") for (int m = 0; m < 4; ++m) _Pragma("unroll") for (int n = 0; n < 2; ++n) _Pragma("unroll") for (int k = 0; k < 2; ++k) \
        acc[ai][bj][m][n] = __builtin_amdgcn_mfma_f32_16x16x32_bf16(Bt[n][k], At[m][k], acc[ai][bj][m][n], 0, 0, 0); __builtin_amdgcn_s_setprio(0); } while (0)
#define PG8_WAIT_V(n) asm volatile("s_waitcnt vmcnt(" #n ")" ::: "memory")
#define PG8_WAIT_L(n) asm volatile("s_waitcnt lgkmcnt(" #n ")" ::: "memory")
#define PG8_BAR __builtin_amdgcn_s_barrier()
#define PG8_SCHED __builtin_amdgcn_sched_barrier(0)
    Unit cur, nxt; int ui = 0;
    if (!S.next(0, cur)) return;
    f32x4 acc[2][2][4][2];
#pragma unroll
    for (int a = 0; a < 2; ++a)
#pragma unroll
        for (int b = 0; b < 2; ++b)
#pragma unroll
            for (int m = 0; m < 4; ++m)
#pragma unroll
                for (int n = 0; n < 2; ++n) acc[a][b][m][n] = (f32x4){0.f, 0.f, 0.f, 0.f};
    bf16x8 At[4][2], B0[2][2], B1[2][2];
    const char* cA = (const char*)g.A + (size_t)cur.pm * tstep; const char* cB = (const char*)g.Bt + (size_t)cur.pn * tstep;
    S.a_ready(cur);
    if constexpr (SP2) {
        PG8_STAGE(PG8_SB(0, 0), cB, voffB); PG8_STAGE(PG8_SB(0, 1), cB + hstep, voffB); PG8_STAGE(PG8_SA(0, 0), cA, voffA); PG8_STAGE(PG8_SA(0, 1), cA + hstep, voffA);
        if (wr == 1) PG8_BAR;
        PG8_WAIT_V(2); PG8_BAR;
        PG8_STAGE(PG8_SB(1, 0), cB + kstep, voffB); PG8_STAGE(PG8_SA(1, 0), cA + kstep, voffA); PG8_STAGE(PG8_SB(1, 1), cB + hstep + kstep, voffB);
        PG8_WAIT_V(6); PG8_BAR;
    } else {
        PG8_STAGE(PG8_SB(0, 0), cB, voffB); PG8_STAGE(PG8_SA(0, 0), cA, voffA); PG8_STAGE(PG8_SB(0, 1), cB + hstep, voffB); PG8_STAGE(PG8_SA(0, 1), cA + hstep, voffA);
        if (wr == 1) PG8_BAR;
        PG8_WAIT_V(4); PG8_BAR;
        PG8_STAGE(PG8_SB(1, 0), cB + kstep, voffB); PG8_STAGE(PG8_SA(1, 0), cA + kstep, voffA); PG8_STAGE(PG8_SB(1, 1), cB + hstep + kstep, voffB);
        PG8_WAIT_V(6); PG8_BAR;
    }
    for (;;) {
        const bool has_next = S.next(ui + 1, nxt);
        const char* nA = has_next ? (const char*)g.A + (size_t)nxt.pm * tstep : cA; const char* nB = has_next ? (const char*)g.Bt + (size_t)nxt.pn * tstep : cB;
#pragma nounroll
        for (int t = 0; t < nt; t += 2) {
            const bool last = (t == nt - 2);
            const char* a1 = cA + (size_t)(t + 1) * kstep;
            const char* a2 = last ? nA : cA + (size_t)(t + 2) * kstep; const char* b2 = last ? nB : cB + (size_t)(t + 2) * kstep;
            const char* a3 = a2 + kstep; const char* b3 = b2 + kstep;
            if (last && has_next) S.a_ready(nxt);
            if constexpr (SP2) {
            PG8_LDB(B0, 0, 0); PG8_LDB(B1, 0, 1); PG8_SCHED; PG8_LDA(At, 0, 0); PG8_STAGE(PG8_SA(1, 1), a1 + hstep, voffA);
            PG8_WAIT_V(8); PG8_WAIT_L(0); PG8_BAR; PG8_MMA(0, 0, At, B0); PG8_MMA(0, 1, At, B1); PG8_BAR; PG8_SCHED;
            PG8_LDA(At, 0, 1); PG8_STAGE(PG8_SB(0, 0), b2, voffB); PG8_STAGE(PG8_SB(0, 1), b2 + hstep, voffB); PG8_STAGE(PG8_SA(0, 0), a2, voffA);
            PG8_WAIT_V(8); PG8_WAIT_L(0); PG8_BAR; PG8_MMA(1, 0, At, B0); PG8_MMA(1, 1, At, B1); PG8_BAR; PG8_SCHED;
            PG8_LDB(B0, 1, 0); PG8_LDB(B1, 1, 1); PG8_SCHED; PG8_LDA(At, 1, 0); PG8_STAGE(PG8_SA(0, 1), a2 + hstep, voffA);
            PG8_WAIT_V(8); PG8_WAIT_L(0); PG8_BAR; PG8_MMA(0, 0, At, B0); PG8_MMA(0, 1, At, B1); PG8_BAR; PG8_SCHED;
            PG8_LDA(At, 1, 1); PG8_STAGE(PG8_SB(1, 0), b3, voffB); PG8_STAGE(PG8_SB(1, 1), b3 + hstep, voffB); PG8_STAGE(PG8_SA(1, 0), a3, voffA);
            PG8_WAIT_V(8); PG8_WAIT_L(0); PG8_BAR; PG8_MMA(1, 0, At, B0); PG8_MMA(1, 1, At, B1); PG8_BAR; PG8_SCHED;
            } else {
            PG8_LDB(B0, 0, 0); PG8_SCHED; PG8_LDA(At, 0, 0); PG8_STAGE(PG8_SA(1, 1), a1 + hstep, voffA);
            PG8_WAIT_L(8); PG8_BAR; PG8_WAIT_L(0); PG8_MMA(0, 0, At, B0); PG8_BAR; PG8_SCHED;
            PG8_LDB(B1, 0, 1); PG8_STAGE(PG8_SB(0, 0), b2, voffB);
            PG8_BAR; PG8_WAIT_L(0); PG8_MMA(0, 1, At, B1); PG8_BAR;
            PG8_LDA(At, 0, 1); PG8_STAGE(PG8_SA(0, 0), a2, voffA);
            PG8_BAR; PG8_WAIT_L(0); PG8_MMA(1, 0, At, B0); PG8_BAR; PG8_SCHED;
            PG8_STAGE(PG8_SB(0, 1), b2 + hstep, voffB);
            PG8_WAIT_V(6); PG8_BAR; PG8_MMA(1, 1, At, B1); PG8_BAR;
            PG8_LDB(B0, 1, 0); PG8_SCHED; PG8_LDA(At, 1, 0); PG8_STAGE(PG8_SA(0, 1), a2 + hstep, voffA);
            PG8_WAIT_L(8); PG8_BAR; PG8_WAIT_L(0); PG8_MMA(0, 0, At, B0); PG8_BAR; PG8_SCHED;
            PG8_LDB(B1, 1, 1); PG8_STAGE(PG8_SB(1, 0), b3, voffB);
            PG8_BAR; PG8_WAIT_L(0); PG8_MMA(0, 1, At, B1); PG8_BAR;
            PG8_LDA(At, 1, 1); PG8_STAGE(PG8_SA(1, 0), a3, voffA);
            PG8_BAR; PG8_WAIT_L(0); PG8_MMA(1, 0, At, B0); PG8_BAR; PG8_SCHED;
            PG8_STAGE(PG8_SB(1, 1), b3 + hstep, voffB);
            PG8_WAIT_V(6); PG8_BAR; PG8_MMA(1, 1, At, B1); PG8_BAR;
            }
        }
        if constexpr (ALIGN_EPI) { if (wr == 0) PG8_BAR; }
        if constexpr (!Epi::AFTER_DRAIN) { E(acc, cur, wr, wc, fr, fq); S.done(cur); }
        if (!has_next) break;
#pragma unroll
        for (int a = 0; a < 2; ++a)
#pragma unroll
            for (int b = 0; b < 2; ++b)
#pragma unroll
                for (int m = 0; m < 4; ++m)
#pragma unroll
                    for (int n = 0; n < 2; ++n) acc[a][b][m][n] = (f32x4){0.f, 0.f, 0.f, 0.f};
        cur = nxt; cA = nA; cB = nB; ++ui;
        if constexpr (ALIGN_EPI) { if (wr == 1) PG8_BAR; }
    }
    PG8_WAIT_V(0);
    if constexpr (!ALIGN_EPI) { if (wr == 0) PG8_BAR; }
    PG8_BAR;
#undef PG8_SA
#undef PG8_SB
#undef PG8_STAGE
#undef PG8_LDA
#undef PG8_LDB
#undef PG8_MMA
#undef PG8_WAIT_V
#undef PG8_WAIT_L
#undef PG8_BAR
#undef PG8_SCHED
}
}

constexpr int NWAVES = 8;
constexpr int N_LAUNCHES = MK_N_LAUNCHES;
constexpr int PER_PHASE = 10;
constexpr int BATCH = 16, SEQ = 2048, D = 1024, M = BATCH * SEQ;
constexpr int NH = 8, HD = 64, AW = 512, RW = 512;
constexpr int RWKV_COLS = 1792, IN_COLS = 3328, FF = 2816, NGU = 2 * FF, NLORA = 1536, KLORA = 256;
constexpr int PC_Q = 0, PC_K = 512, PC_V = 1024, PC_RW = 1536;
constexpr int RC_R = 0, RC_K = 512, RC_V = 1024, RC_L = 1536;
constexpr int WLF_K01 = 8 * 2 * 4 * 64 * 8, WLF_ELEMS = 4 * WLF_K01;
constexpr float NORM_EPS = 1e-6f, LNX_EPS = 64e-5f;
constexpr float LOG2E = 1.4426950408889634f;

constexpr size_t MiB = 1u << 20;
constexpr size_t WS_CTL = 0, CTL_ZERO_BYTES = 1 * MiB;
constexpr size_t WS_WIN = 2 * MiB;
constexpr size_t WS_WOUT = 9 * MiB;
constexpr size_t WS_WGU = 11 * MiB;
constexpr size_t WS_WDN = 22 * MiB;
constexpr size_t WS_WL = 28 * MiB;
constexpr size_t WS_BON = 29 * MiB;
constexpr size_t WS_SS = 30 * MiB;
constexpr size_t WS_XN = 32 * MiB;
constexpr size_t WS_PROJ = 96 * MiB;
constexpr size_t WS_A2 = 304 * MiB;
constexpr size_t WS_DAG = 320 * MiB;
constexpr size_t WS_ML = 416 * MiB;
constexpr size_t WS_END = 424 * MiB;
constexpr size_t DO_PO = 0, DO_Y = 96 * MiB;
constexpr int CW_TMO = 0, CW_CODE = 1;
constexpr int CW_BAR = 4096;
constexpr int CW_ATTQ = 8192;

constexpr int LDS_BYTES = 163840;
constexpr int RING_OFF = 0, RING_BYTES = LDS_BYTES - 1024;
constexpr int LDSCTL_OFF = RING_BYTES, MISC_OFF = LDSCTL_OFF + 320;

#define GAS __attribute__((address_space(1)))
#define LAS __attribute__((address_space(3)))
typedef unsigned short bf16;
typedef unsigned v4u __attribute__((ext_vector_type(4)));
typedef unsigned v2u __attribute__((ext_vector_type(2)));
typedef float f32x4 __attribute__((ext_vector_type(4)));
typedef float f32x2 __attribute__((ext_vector_type(2)));
typedef float f32x16 __attribute__((ext_vector_type(16)));
typedef short bf16x8 __attribute__((ext_vector_type(8)));
typedef short s16x4 __attribute__((ext_vector_type(4)));
typedef GAS unsigned gu32;
#define RLX_AGENT __ATOMIC_RELAXED, __HIP_MEMORY_SCOPE_AGENT
#define LDS_WAIT() asm volatile("s_waitcnt lgkmcnt(0)" ::: "memory")
#define VM_WAIT() asm volatile("s_waitcnt vmcnt(0)" ::: "memory")
__device__ __forceinline__ unsigned f2bf(float f) { unsigned u = __builtin_bit_cast(unsigned, f); return (u + 0x7fffu + ((u >> 16) & 1u)) >> 16; }
typedef float f32x2_t __attribute__((ext_vector_type(2))); typedef __bf16 bf16x2_t __attribute__((ext_vector_type(2)));
__device__ __forceinline__ unsigned cvt2(float lo, float hi) { f32x2_t v = {lo, hi}; bf16x2_t b = __builtin_convertvector(v, bf16x2_t); return __builtin_bit_cast(unsigned, b); }
__device__ __forceinline__ unsigned pk2(float lo, float hi) { return cvt2(lo, hi); }
__device__ __forceinline__ float bflo(unsigned w) { return __builtin_bit_cast(float, w << 16); }
__device__ __forceinline__ float bfhi(unsigned w) { return __builtin_bit_cast(float, w & 0xffff0000u); }
__device__ __forceinline__ float fsig(float x) { return __builtin_amdgcn_rcpf(1.0f + __builtin_amdgcn_exp2f(-LOG2E * x)); }

#define XB_TMO      128
#define XB_XCNT(j)  (256  + 64 * (j))
#define XB_XSUB(j)  (1280 + 64 * (j))
#define XB_XGEN(j)  (2304 + 64 * (j))
#define XB_TOP      3328
#define XB_TOPGEN   3392
#define XCD_BAR_WORDS 3456
#define XB_SPIN_CAP (1u << 18)
__device__ __forceinline__ unsigned xb_ld(unsigned* p)              { return __hip_atomic_load(p, __ATOMIC_RELAXED, __HIP_MEMORY_SCOPE_AGENT); }
__device__ __forceinline__ unsigned xb_add(unsigned* p, unsigned v) { return __hip_atomic_fetch_add(p, v, __ATOMIC_RELAXED, __HIP_MEMORY_SCOPE_AGENT); }
__device__ __forceinline__ unsigned xb_xcc_id() { return (unsigned)__builtin_amdgcn_s_getreg((3 << 11) | 20) & 0xFu; }
#define XB_SPIN(cond, bar) do { unsigned _sp = 0; while (cond) { __builtin_amdgcn_s_sleep(1); \
    if ((++_sp & 255u) == 0u) { if (xb_ld(&(bar)[XB_TMO])) break; if (_sp > XB_SPIN_CAP) { atomicAdd(&(bar)[XB_TMO], 1u); break; } } } } while (0)
struct XcdBarrier { unsigned* bar; unsigned x; volatile LAS unsigned* st; };
__device__ __forceinline__ XcdBarrier xcd_barrier_post(unsigned* bar, volatile LAS unsigned* st) {
    XcdBarrier b; b.bar = bar; b.x = xb_xcc_id(); b.st = st;
    if (threadIdx.x == 0) (void)xb_add(&bar[XB_XCNT(b.x)], 1u);
    return b;
}
__device__ __forceinline__ void xcd_barrier_complete(unsigned* bar, unsigned x, unsigned& nloc, unsigned& nx) {
    const unsigned G = gridDim.x * gridDim.y * gridDim.z;
    unsigned sum, cnt, mine, sp = 0u;
    for (;;) {
        sum = 0u; cnt = 0u; mine = 0u;
#pragma unroll
        for (unsigned j = 0; j < 16; ++j) { const unsigned c = xb_ld(&bar[XB_XCNT(j)]); sum += c; cnt += (c > 0u) ? 1u : 0u; mine = (j == x) ? c : mine; }
        if (sum == G) break;
        __builtin_amdgcn_s_sleep(1);
        if ((++sp & 255u) == 0u) { if (xb_ld(&bar[XB_TMO])) break; if (sp > XB_SPIN_CAP) { atomicAdd(&bar[XB_TMO], 1u); break; } }
    }
    nloc = mine > 0u ? mine : 1u; nx = cnt > 0u ? cnt : 1u;
}
__device__ __forceinline__ void xcd_barrier(const XcdBarrier& b) {
    asm volatile("s_waitcnt vmcnt(0)" ::: "memory");
    __syncthreads();
    if (threadIdx.x == 0) {
        unsigned* bar = b.bar;
        __builtin_amdgcn_s_waitcnt(0);
        unsigned nloc = b.st[0], nx = b.st[1];
        if (nloc == 0u) { xcd_barrier_complete(bar, b.x, nloc, nx); b.st[0] = nloc; b.st[1] = nx; }
        const unsigned old = xb_add(&bar[XB_XSUB(b.x)], 1u);
        const unsigned gen = old / nloc;
        if (old + 1u == (gen + 1u) * nloc) {
            __builtin_amdgcn_fence(__ATOMIC_RELEASE, "agent");
            asm volatile("s_waitcnt vmcnt(0)" ::: "memory");
            const unsigned og = xb_add(&bar[XB_TOP], 1u);
            const unsigned tg = og / nx;
            if (og + 1u == (tg + 1u) * nx) xb_add(&bar[XB_TOPGEN], 1u);
            else XB_SPIN(xb_ld(&bar[XB_TOPGEN]) == tg, bar);
            __builtin_amdgcn_fence(__ATOMIC_ACQUIRE, "agent");
            xb_add(&bar[XB_XGEN(b.x)], 1u);
            asm volatile("s_waitcnt vmcnt(0)" ::: "memory");
        } else {
            XB_SPIN(xb_ld(&bar[XB_XGEN(b.x)]) == gen, bar);
            __builtin_amdgcn_fence(__ATOMIC_ACQUIRE, "agent");
            asm volatile("s_waitcnt vmcnt(0)" ::: "memory");
        }
    }
    __syncthreads();
}

struct Frame {
    LAS unsigned char* lds;
    volatile LAS unsigned* MISC;
    gu32* ctl;
    int tid, lane, wave;
    int vcu, G;
    float* out; unsigned char* ws;
};
struct Args { const float* in[22]; float* out; unsigned char* ws; int ph_lo, ph_hi, li, pad; };
enum { I_X = 0, I_N1G, I_WIN, I_QNG, I_KNG, I_AOG, I_MU, I_W0, I_W2, I_A0, I_A2, I_G2, I_KK, I_KA, I_RK, I_LNG, I_LNB, I_WOUT, I_N2G, I_WG, I_WU, I_WD };

__device__ __forceinline__ float wave_sum(float v) {
#pragma unroll
    for (int o = 1; o < 64; o <<= 1) v += __shfl_xor(v, o);
    return v;
}
__device__ __forceinline__ float red16(float x) {
    x += __builtin_bit_cast(float, __builtin_amdgcn_update_dpp(0, __builtin_bit_cast(int, x), 0x128, 0xf, 0xf, false));
    x += __builtin_bit_cast(float, __builtin_amdgcn_update_dpp(0, __builtin_bit_cast(int, x), 0x124, 0xf, 0xf, false));
    x += __builtin_bit_cast(float, __builtin_amdgcn_update_dpp(0, __builtin_bit_cast(int, x), 0x122, 0xf, 0xf, false));
    x += __builtin_bit_cast(float, __builtin_amdgcn_update_dpp(0, __builtin_bit_cast(int, x), 0x121, 0xf, 0xf, false));
    return x;
}

constexpr int TR_SCR = 64 * 65 * 4 + 256;
__device__ __forceinline__ int tr_row(int rmode, int n) {
    return rmode == 0 ? n : rmode == 3 ? (n < 1024 ? ((n >> 8) * 256 + ((n >> 5) & 1) * 128 + ((n >> 6) & 3) * 32 + (n & 31)) : n) : ((n >> 7) * 256 + (n & 127) + (rmode == 2 ? 128 : 0));
}
__device__ __forceinline__ void p0_transpose_item(const float* W, int K, int N, bf16* WT, int rmode, LAS float* scr, int item, int lane, const float* ksc = nullptr) {
    const int nblk = N / 64, kb = item / nblk, nb = item % nblk, k0 = 64 * kb, n0 = 64 * nb;
    const int ks = lane >> 4, n4 = (lane & 15) * 4;
    f32x4 v[16];
#pragma unroll
    for (int i = 0; i < 16; ++i) v[i] = *(const GAS f32x4*)((const GAS float*)W + (size_t)(k0 + 4 * i + ks) * N + n0 + n4);
#pragma unroll
    for (int i = 0; i < 16; ++i) { const int kk = 4 * i + ks; const float sc = ksc ? ksc[k0 + kk] : 1.0f;
        scr[kk * 65 + n4 + 0] = v[i].x * sc; scr[kk * 65 + n4 + 1] = v[i].y * sc; scr[kk * 65 + n4 + 2] = v[i].z * sc; scr[kk * 65 + n4 + 3] = v[i].w * sc; }
    LDS_WAIT(); asm volatile("" ::: "memory");
    GAS v4u* dst = (GAS v4u*)(WT + (size_t)tr_row(rmode, n0 + lane) * K + k0);
#pragma unroll
    for (int j = 0; j < 8; ++j) { const LAS float* c = scr + (8 * j) * 65 + lane;
        v4u o; o.x = pk2(c[0 * 65], c[1 * 65]); o.y = pk2(c[2 * 65], c[3 * 65]); o.z = pk2(c[4 * 65], c[5 * 65]); o.w = pk2(c[6 * 65], c[7 * 65]);
        dst[j] = o; }
    LDS_WAIT(); asm volatile("" ::: "memory");
}
template <int NR> __device__ __forceinline__ void rms_rows_to_bf16(int lane, const float* x0, size_t rstride, const float* g, bf16* o0, size_t ostride) {
    const GAS f32x4* gr = (const GAS f32x4*)g + lane;
    f32x4 v[NR][4];
#pragma unroll
    for (int r = 0; r < NR; ++r) { const GAS f32x4* xr = (const GAS f32x4*)(x0 + r * rstride) + lane;
#pragma unroll
        for (int j = 0; j < 4; ++j) v[r][j] = xr[64 * j]; }
    f32x4 gg[4];
#pragma unroll
    for (int j = 0; j < 4; ++j) gg[j] = gr[64 * j];
#pragma unroll
    for (int r = 0; r < NR; ++r) { float s = 0.f;
#pragma unroll
        for (int j = 0; j < 4; ++j) s += (v[r][j].x * v[r][j].x + v[r][j].y * v[r][j].y) + (v[r][j].z * v[r][j].z + v[r][j].w * v[r][j].w);
        const float rstd = 1.f / sqrtf(wave_sum(s) * (1.f / D) + NORM_EPS);
        GAS unsigned long long* o8 = (GAS unsigned long long*)(o0 + r * ostride) + lane;
#pragma unroll
        for (int j = 0; j < 4; ++j)
            o8[64 * j] = (unsigned long long)pk2(v[r][j].x * rstd * gg[j].x, v[r][j].y * rstd * gg[j].y) | ((unsigned long long)pk2(v[r][j].z * rstd * gg[j].z, v[r][j].w * rstd * gg[j].w) << 32); }
}

__device__ __forceinline__ void p0_prologue(Frame& F, const Args& AR) {
    LAS float* scr = (LAS float*)(F.lds + RING_OFF + F.wave * TR_SCR);
    const int gw = F.vcu * NWAVES + F.wave, NGW = F.G * NWAVES;
    bf16* Win_t = (bf16*)(F.ws + WS_WIN); bf16* Wout_t = (bf16*)(F.ws + WS_WOUT); bf16* Wgu_t = (bf16*)(F.ws + WS_WGU); bf16* Wdn_t = (bf16*)(F.ws + WS_WDN); bf16* Wl_t = (bf16*)(F.ws + WS_WL);
    constexpr int I_IN = (D / 64) * (IN_COLS / 64);
    for (int it = gw; it < I_IN; it += NGW) p0_transpose_item(AR.in[I_WIN], D, IN_COLS, Win_t, 3, scr, it, F.lane);
    for (int e = (F.vcu * NWAVES * 64 + F.tid); e < WLF_ELEMS; e += F.G * NWAVES * 64) {
        const int kind = e < WLF_K01 ? 0 : (e < 2 * WLF_K01 ? 1 : 2), r = e - (kind == 2 ? 2 * WLF_K01 : kind * WLF_K01);
        const int ee = r & 7, ln = (r >> 3) & 63, b = (r >> 9) & 3, s = kind == 2 ? (r >> 11) & 3 : (r >> 11) & 1, g = kind == 2 ? r >> 13 : r >> 12;
        const int k = 32 * s + 8 * (ln >> 4) + ee, c = 64 * g + 32 * (b >> 1) + 8 * ((ln & 15) >> 2) + 4 * (b & 1) + (ln & 3);
        const float* W = kind == 0 ? AR.in[I_W2] : (kind == 1 ? AR.in[I_A2] : AR.in[I_G2]);
        Wl_t[e] = (bf16)f2bf(W[k * 512 + c]);
    }
    bf16* XN = (bf16*)(F.ws + WS_XN);
    for (int m = gw * 4; m < M; m += NGW * 4) rms_rows_to_bf16<4>(F.lane, AR.in[I_X] + (size_t)m * D, D, AR.in[I_N1G], XN + (size_t)m * D, D);
}

constexpr int LR_ROWB = 528;
#define MFMA16(a, b, c) __builtin_amdgcn_mfma_f32_16x16x32_bf16((a), (b), (c), 0, 0, 0)
template <int KIND> __device__ __forceinline__ void p3_kind(const LAS unsigned char* At, const bf16* WLF, bf16* DAG, const float* bias, int m0, int wave, int lane) {
    constexpr int KS = KIND == 2 ? 4 : 2, KOFF = KIND == 0 ? 0 : (KIND == 1 ? 64 : 128);
    const int q = lane >> 4, t = lane & 15;
    const GAS v4u* wf = (const GAS v4u*)(WLF + (KIND == 2 ? 2 * WLF_K01 : KIND * WLF_K01)) + (size_t)wave * KS * 4 * 64 + lane;
    bf16x8 Af[KS][4];
#pragma unroll
    for (int s = 0; s < KS; ++s)
#pragma unroll
        for (int b = 0; b < 4; ++b) Af[s][b] = __builtin_bit_cast(bf16x8, wf[(s * 4 + b) * 64]);
    f32x4 bs[2][2];
    if (KIND != 2) {
#pragma unroll
        for (int p = 0; p < 2; ++p) { const GAS f32x4* bp = (const GAS f32x4*)((const GAS float*)bias + 64 * wave + 32 * p + 8 * q); bs[p][0] = bp[0]; bs[p][1] = bp[1]; }
    }
    const LAS unsigned char* ap = At + t * LR_ROWB + (KOFF + 8 * q) * 2;
    GAS bf16* dp = (GAS bf16*)DAG + (size_t)(m0 + t) * NLORA + KIND * 512 + 64 * wave + 8 * q;
    const f32x4 z4 = {0.f, 0.f, 0.f, 0.f};
#pragma unroll 2
    for (int tb = 0; tb < 8; ++tb) {
        bf16x8 Bf[KS];
#pragma unroll
        for (int s = 0; s < KS; ++s) Bf[s] = *(const LAS bf16x8*)(ap + tb * 16 * LR_ROWB + 64 * s);
        f32x4 acc[4];
#pragma unroll
        for (int b = 0; b < 4; ++b) { acc[b] = MFMA16(Af[0][b], Bf[0], z4);
#pragma unroll
            for (int s = 1; s < KS; ++s) acc[b] = MFMA16(Af[s][b], Bf[s], acc[b]); }
#pragma unroll
        for (int p = 0; p < 2; ++p) {
            f32x4 v0 = acc[2 * p], v1 = acc[2 * p + 1];
            if (KIND != 2) {
                v0 += bs[p][0]; v1 += bs[p][1];
#pragma unroll
                for (int e = 0; e < 4; ++e) { v0[e] = fsig(v0[e]); v1[e] = fsig(v1[e]); }
                if (KIND == 0) { v0 *= -0.6065306597126334f; v1 *= -0.6065306597126334f; }
            }
            v4u w; w.x = cvt2(v0[0], v0[1]); w.y = cvt2(v0[2], v0[3]); w.z = cvt2(v1[0], v1[1]); w.w = cvt2(v1[2], v1[3]);
            *(GAS v4u*)(dp + (size_t)tb * 16 * NLORA + 32 * p) = w;
        }
    }
}
__device__ __forceinline__ void p3_lora(Frame& F, const Args& AR) {
    const int lane = F.lane, wave = F.wave;
    const bf16* PROJ = (const bf16*)(F.ws + WS_PROJ); const bf16* WLF = (const bf16*)(F.ws + WS_WL); bf16* DAG = (bf16*)(F.ws + WS_DAG);
    LAS unsigned char* At = F.lds + RING_OFF;
    const f32x4 mu4 = *(const f32x4*)(AR.in[I_MU] + RC_L + 4 * lane);
    for (int u = F.vcu; u < M / 128; u += F.G) {
        const int m0 = u * 128, t0 = 16 * wave;
        const GAS bf16* row = (const GAS bf16*)PROJ + (size_t)(m0 + t0) * IN_COLS + PC_RW + RC_L + 4 * lane;
        v2u w[17];
        w[0] = (v2u){0u, 0u};
        if (((m0 + t0) & (SEQ - 1)) != 0) w[0] = *(const GAS v2u*)(row - IN_COLS);
#pragma unroll
        for (int i = 0; i < 16; ++i) w[i + 1] = *(const GAS v2u*)(row + (size_t)i * IN_COLS);
#pragma unroll
        for (int i = 0; i < 16; ++i) {
            const v2u cu = w[i + 1], pv = w[i];
            const float c4[4] = {bflo(cu.x), bfhi(cu.x), bflo(cu.y), bfhi(cu.y)}, p4[4] = {bflo(pv.x), bfhi(pv.x), bflo(pv.y), bfhi(pv.y)};
            float xs[4];
#pragma unroll
            for (int e = 0; e < 4; ++e) { const float v = c4[e] + (p4[e] - c4[e]) * mu4[e];
                if (lane < 16) { const float tt = __builtin_amdgcn_exp2f(2.f * LOG2E * v); xs[e] = 1.f - 2.f * __builtin_amdgcn_rcpf(tt + 1.f); }
                else if (lane < 32) xs[e] = v;
                else xs[e] = fsig(v); }
            *(LAS v2u*)(At + (t0 + i) * LR_ROWB + 8 * lane) = (v2u){pk2(xs[0], xs[1]), pk2(xs[2], xs[3])};
        }
        __syncthreads();
        p3_kind<0>(At, WLF, DAG, AR.in[I_W0], m0, wave, lane);
        p3_kind<1>(At, WLF, DAG, AR.in[I_A0], m0, wave, lane);
        p3_kind<2>(At, WLF, DAG, nullptr, m0, wave, lane);
        __syncthreads();
    }
}

__device__ __forceinline__ float red8(float x) {
    x += __builtin_bit_cast(float, __builtin_amdgcn_update_dpp(0, __builtin_bit_cast(int, x), 0xB1, 0xf, 0xf, false));
    x += __builtin_bit_cast(float, __builtin_amdgcn_update_dpp(0, __builtin_bit_cast(int, x), 0x4E, 0xf, 0xf, false));
    x += __builtin_bit_cast(float, __builtin_amdgcn_update_dpp(0, __builtin_bit_cast(int, x), 0x141, 0xf, 0xf, false));
    return x;
}
__device__ __forceinline__ float redrows(float x) {
    { auto r = __builtin_amdgcn_permlane16_swap(__float_as_uint(x), __float_as_uint(x), false, false); x = __uint_as_float(r[0]) + __uint_as_float(r[1]); }
    { auto r = __builtin_amdgcn_permlane32_swap(__float_as_uint(x), __float_as_uint(x), false, false); x = __uint_as_float(r[0]) + __uint_as_float(r[1]); }
    return x;
}
constexpr int CS = 16, NCHUNK = SEQ / CS, NHELP = 4, NSTATE = 4, NIT = (NCHUNK + NHELP - 1) / NHELP;
constexpr int ROWB = 144, TILEB = 40;
constexpr int SL_A = 0, SL_R = 16 * ROWB, SL_B = 32 * ROWB, SL_K = 48 * ROWB, SL_V = 64 * ROWB, SL_T = 80 * ROWB, SL_LAK = SL_T + 16 * TILEB, SL_LRB = SL_LAK + 16 * TILEB, SL_LRK = SL_LRB + 16 * TILEB,
              SL_G = SL_LRK + 16 * TILEB, SL_BON = SL_G + 256, SL_INV = SL_BON + 64, SL_BYTES = SL_INV + 64;
static_assert(SL_BYTES % 16 == 0 && SL_T % 8 == 0, "slot alignment");
constexpr int SC_CONST = 2 * NHELP * SL_BYTES;
constexpr int SC_YL = SC_CONST + 6 * 64 * 4, YL_BYTES = NHELP * CS * 256;
constexpr int SC_TS = SC_YL + 2 * YL_BYTES;
static_assert(SC_TS + NSTATE * NHELP * 16 * TILEB <= RING_BYTES && NHELP * CS * 8 == 2 * NSTATE * 64 && NCHUNK % NHELP == 0 && NHELP % 2 == 0, "scan LDS");
struct HReg { v4u r[2], k[2], v[2], pr[2], pk[2], pv[2], e[2], a[2]; };
__device__ __forceinline__ void helper_load(HReg& R, const bf16* PROJ, const bf16* DAG, int tok, int h, int kg) {
    const GAS bf16* row = (const GAS bf16*)PROJ + (size_t)tok * IN_COLS + PC_RW + h * 64 + 16 * kg;
    const GAS bf16* rowp = row - IN_COLS;
    const GAS bf16* dr = (const GAS bf16*)DAG + (size_t)tok * NLORA + h * 64 + 16 * kg;
    asm volatile("" : "+v"(row)); asm volatile("" : "+v"(rowp)); asm volatile("" : "+v"(dr));
    const bool hp = (tok & (SEQ - 1)) != 0;
#pragma unroll
    for (int i = 0; i < 2; ++i) {
        R.r[i] = *(const GAS v4u*)(row + RC_R + 8 * i); R.k[i] = *(const GAS v4u*)(row + RC_K + 8 * i); R.v[i] = *(const GAS v4u*)(row + RC_V + 8 * i);
        if (hp) { R.pr[i] = *(const GAS v4u*)(rowp + RC_R + 8 * i); R.pk[i] = *(const GAS v4u*)(rowp + RC_K + 8 * i); R.pv[i] = *(const GAS v4u*)(rowp + RC_V + 8 * i); }
        else { R.pr[i] = (v4u){0u, 0u, 0u, 0u}; R.pk[i] = R.pr[i]; R.pv[i] = R.pr[i]; }
        R.e[i] = *(const GAS v4u*)(dr + 8 * i); R.a[i] = *(const GAS v4u*)(dr + 512 + 8 * i);
    }
}
__device__ __forceinline__ void unpack4(const unsigned w0, const unsigned w1, float (&x)[4]) { x[0] = bflo(w0); x[1] = bfhi(w0); x[2] = bflo(w1); x[3] = bfhi(w1); }
__device__ __forceinline__ float dpp_shr(float x, const int ctrl_sel) {
    int r;
    if (ctrl_sel == 1) r = __builtin_amdgcn_update_dpp(0, __builtin_bit_cast(int, x), 0x111, 0xf, 0xf, true);
    else if (ctrl_sel == 2) r = __builtin_amdgcn_update_dpp(0, __builtin_bit_cast(int, x), 0x112, 0xf, 0xf, true);
    else if (ctrl_sel == 4) r = __builtin_amdgcn_update_dpp(0, __builtin_bit_cast(int, x), 0x114, 0xf, 0xf, true);
    else r = __builtin_amdgcn_update_dpp(0, __builtin_bit_cast(int, x), 0x118, 0xf, 0xf, true);
    return __builtin_bit_cast(float, r);
}
__device__ __forceinline__ unsigned cvt2s(float lo, float hi) { asm volatile("" : "+v"(lo), "+v"(hi)); return cvt2(lo, hi); }
__device__ __forceinline__ bf16x8 mk8(unsigned a, unsigned b, unsigned c, unsigned d) { return __builtin_bit_cast(bf16x8, (v4u){a, b, c, d}); }
__device__ __forceinline__ bf16x8 accB(const f32x4 v) { return mk8(cvt2(v[0], v[1]), cvt2(v[2], v[3]), 0u, 0u); }
__device__ __forceinline__ v2u trd(const LAS unsigned char* p) { typedef short v4i16_t __attribute__((ext_vector_type(4)));
    return __builtin_bit_cast(v2u, __builtin_amdgcn_ds_read_tr16_b64_v4i16((LAS v4i16_t*)p)); }
#define PIN_PTR(p) asm volatile("" : "+v"(p))

#define HR_UNPACK(dst, arr, gp) do { if ((gp) & 1) unpack4(R.arr[(gp) >> 1].z, R.arr[(gp) >> 1].w, dst); else unpack4(R.arr[(gp) >> 1].x, R.arr[(gp) >> 1].y, dst); } while (0)
__device__ __forceinline__ void helper_chunk(LAS unsigned char* slot, const LAS float* cst, HReg& R, bool prefetch, const bf16* PROJ, const bf16* DAG, float* BON, int tok, int h, int lane) {
    const int t = lane & 15, kg = lane >> 4;
    LAS unsigned char* p_row = slot + t * ROWB + kg * 16;
    LAS unsigned char* p_v = slot + SL_V + t * ROWB + kg * 32;
    LAS unsigned char* p_tw = slot + t * TILEB + kg * 8;
    LAS unsigned char* p_g = slot + SL_G + kg * 16;
    const LAS float* p_c = cst + 16 * kg;
    PIN_PTR(p_row); PIN_PTR(p_v); PIN_PTR(p_tw); PIN_PTR(p_g); PIN_PTR(p_c);
    float E[16], G[16], GI[16], GP[16];
#pragma unroll
    for (int gp = 0; gp < 4; ++gp) { float e[4]; HR_UNPACK(e, e, gp);
#pragma unroll
        for (int i = 0; i < 4; ++i) E[4 * gp + i] = e[i]; }
#pragma unroll
    for (int q = 0; q < 16; ++q) E[q] += dpp_shr(E[q], 1);
#pragma unroll
    for (int q = 0; q < 16; ++q) E[q] += dpp_shr(E[q], 2);
#pragma unroll
    for (int q = 0; q < 16; ++q) E[q] += dpp_shr(E[q], 4);
#pragma unroll
    for (int q = 0; q < 16; ++q) E[q] += dpp_shr(E[q], 8);
#pragma unroll
    for (int q = 0; q < 16; ++q) { G[q] = __builtin_amdgcn_exp2f(LOG2E * E[q]); GI[q] = __builtin_amdgcn_exp2f(-LOG2E * E[q]); }
#pragma unroll
    for (int q = 0; q < 16; ++q) { const float gpv = dpp_shr(G[q], 1); GP[q] = (t == 0) ? 1.f : gpv; }
    if (t == 15) {
#pragma unroll
        for (int gp = 0; gp < 4; ++gp) *(LAS f32x4*)(p_g + gp * 64) = (f32x4){G[4 * gp], G[4 * gp + 1], G[4 * gp + 2], G[4 * gp + 3]};
    }
    float ss = 0.f, bon = 0.f;
#pragma unroll
    for (int gp = 0; gp < 4; ++gp) {
        float r[4], k[4], v[4], pr[4], pk[4], pv[4], a[4];
        HR_UNPACK(r, r, gp); HR_UNPACK(k, k, gp); HR_UNPACK(v, v, gp); HR_UNPACK(pr, pr, gp); HR_UNPACK(pk, pk, gp); HR_UNPACK(pv, pv, gp); HR_UNPACK(a, a, gp);
        const f32x4 mur = *(const LAS f32x4*)(p_c + 0 * 64 + 4 * gp), muk = *(const LAS f32x4*)(p_c + 1 * 64 + 4 * gp), muv = *(const LAS f32x4*)(p_c + 2 * 64 + 4 * gp);
        const f32x4 kkc = *(const LAS f32x4*)(p_c + 3 * 64 + 4 * gp), kac = *(const LAS f32x4*)(p_c + 4 * 64 + 4 * gp), rkc = *(const LAS f32x4*)(p_c + 5 * 64 + 4 * gp);
        float xv[4], At[4], Rt[4], Bt[4], Kt[4];
#pragma unroll
        for (int i = 0; i < 4; ++i) { const int q = 4 * gp + i;
            const float xr = r[i] + (pr[i] - r[i]) * mur[i], xk = k[i] + (pk[i] - k[i]) * muk[i]; xv[i] = v[i] + (pv[i] - v[i]) * muv[i];
            const float kkv = xk * kkc[i], kpv = xk * (1.f + (a[i] - 1.f) * kac[i]); ss += kkv * kkv; bon += xr * kpv * rkc[i];
            At[i] = -kkv * GP[q]; Rt[i] = xr * G[q]; Bt[i] = kkv * a[i] * GI[q]; Kt[i] = kpv * GI[q]; }
        *(LAS v2u*)(p_v + gp * 8) = (v2u){cvt2s(xv[0], xv[1]), cvt2s(xv[2], xv[3])};
        const int co = (gp >> 1) * 64 + (gp & 1) * 8;
        *(LAS v2u*)(p_row + SL_A + co) = (v2u){cvt2s(At[0], At[1]), cvt2s(At[2], At[3])}; *(LAS v2u*)(p_row + SL_R + co) = (v2u){cvt2s(Rt[0], Rt[1]), cvt2s(Rt[2], Rt[3])};
        *(LAS v2u*)(p_row + SL_B + co) = (v2u){cvt2s(Bt[0], Bt[1]), cvt2s(Bt[2], Bt[3])}; *(LAS v2u*)(p_row + SL_K + co) = (v2u){cvt2s(Kt[0], Kt[1]), cvt2s(Kt[2], Kt[3])};
    }
    ss = redrows(ss); bon = redrows(bon);
    const float inv = __builtin_amdgcn_rsqf(fmaxf(ss, 1e-24f));
    if (kg == 0) { *(LAS float*)(slot + SL_BON + t * 4) = bon; *(LAS float*)(slot + SL_INV + t * 4) = inv; }
    if (prefetch) helper_load(R, PROJ, DAG, tok + NHELP * CS, h, kg);
    const bf16x8 FA0 = *(const LAS bf16x8*)(p_row + SL_A), FA1 = *(const LAS bf16x8*)(p_row + SL_A + 64), FR0 = *(const LAS bf16x8*)(p_row + SL_R), FR1 = *(const LAS bf16x8*)(p_row + SL_R + 64);
    const bf16x8 FB0 = *(const LAS bf16x8*)(p_row + SL_B), FB1 = *(const LAS bf16x8*)(p_row + SL_B + 64), FK0 = *(const LAS bf16x8*)(p_row + SL_K), FK1 = *(const LAS bf16x8*)(p_row + SL_K + 64);
    const f32x4 z4 = (f32x4){0.f, 0.f, 0.f, 0.f};
    f32x4 Lab = MFMA16(FA0, FB0, z4); Lab = MFMA16(FA1, FB1, Lab);
    f32x4 Lak = MFMA16(FA0, FK0, z4); Lak = MFMA16(FA1, FK1, Lak);
    f32x4 Lrb = MFMA16(FR0, FB0, z4); Lrb = MFMA16(FR1, FB1, Lrb);
    f32x4 Lrk = MFMA16(FR0, FK0, z4); Lrk = MFMA16(FR1, FK1, Lrk);
    const int s = t;
#pragma unroll
    for (int r = 0; r < 4; ++r) { const int tt = 4 * kg + r;
        Lab[r] = tt > s ? Lab[r] : 0.f; Lak[r] = tt > s ? Lak[r] : 0.f; Lrb[r] = tt >= s ? Lrb[r] : 0.f; Lrk[r] = tt >= s ? Lrk[r] : 0.f; }
    { const f32x4 ir = *(const LAS f32x4*)(slot + SL_INV + 16 * kg);
      Lab = Lab * ir * inv; }
#define WR_TILE(off, X) (*(LAS v2u*)(p_tw + (off)) = (v2u){cvt2((X)[0], (X)[1]), cvt2((X)[2], (X)[3])})
    WR_TILE(SL_LAK, Lak); WR_TILE(SL_LRB, Lrb); WR_TILE(SL_LRK, Lrk); WR_TILE(SL_T, Lab);
#undef WR_TILE
}

struct SOps { bf16x8 a0, a1, r0, r1; v2u vt, lak, lrb, lrk, bb[4], kk2[4]; f32x4 gm[4], bn, iv; };
__device__ __forceinline__ void state_load(SOps& O, const LAS unsigned char* slot, int lane, int wv) {
    const int c = lane & 15, g = lane >> 4, q4 = 4 * g + (c >> 2), pp = c & 3;
    const LAS unsigned char* p128 = slot + c * ROWB + g * 16;
    const LAS unsigned char* p_bt = slot + q4 * ROWB + pp * 16;
    const LAS unsigned char* p_tr = slot + q4 * TILEB + pp * 8;
    const LAS unsigned char* p_v = slot + SL_V + q4 * ROWB + wv * 32 + pp * 8;
    const LAS unsigned char* pg = slot + SL_G + g * 16;
    PIN_PTR(p128); PIN_PTR(p_bt); PIN_PTR(p_tr); PIN_PTR(p_v); PIN_PTR(pg);
    O.a0 = *(const LAS bf16x8*)(p128 + SL_A); O.a1 = *(const LAS bf16x8*)(p128 + SL_A + 64); O.r0 = *(const LAS bf16x8*)(p128 + SL_R); O.r1 = *(const LAS bf16x8*)(p128 + SL_R + 64);
    O.vt = trd(p_v); O.lak = trd(p_tr + SL_LAK); O.lrb = trd(p_tr + SL_LRB); O.lrk = trd(p_tr + SL_LRK);
#pragma unroll
    for (int jb = 0; jb < 4; ++jb) { O.bb[jb] = trd(p_bt + SL_B + (jb >> 1) * 64 + (jb & 1) * 8); O.kk2[jb] = trd(p_bt + SL_K + (jb >> 1) * 64 + (jb & 1) * 8); O.gm[jb] = *(const LAS f32x4*)(pg + jb * 64); }
    O.bn = *(const LAS f32x4*)(slot + SL_BON + 16 * g); O.iv = *(const LAS f32x4*)(slot + SL_INV + 16 * g);
}
__device__ __forceinline__ void state_compute(const SOps& O, const v2u tt, f32x4 (&X)[4], LAS unsigned char* yl, int lane, int wv) {
    const int c = lane & 15, g = lane >> 4;
    const f32x4 z4 = (f32x4){0.f, 0.f, 0.f, 0.f};
    const bf16x8 xb0 = mk8(cvt2(X[0][0], X[0][1]), cvt2(X[0][2], X[0][3]), cvt2(X[1][0], X[1][1]), cvt2(X[1][2], X[1][3]));
    const bf16x8 xb1 = mk8(cvt2(X[2][0], X[2][1]), cvt2(X[2][2], X[2][3]), cvt2(X[3][0], X[3][1]), cvt2(X[3][2], X[3][3]));
    f32x4 Z = MFMA16(O.a0, xb0, z4); Z = MFMA16(O.a1, xb1, Z); Z = MFMA16(mk8(O.lak.x, O.lak.y, 0u, 0u), mk8(O.vt.x, O.vt.y, 0u, 0u), Z) * O.iv;
    const f32x4 U = MFMA16(mk8(tt.x, tt.y, 0u, 0u), accB(Z), z4) * O.iv;
    const bf16x8 uv = mk8(cvt2(U[0], U[1]), cvt2(U[2], U[3]), O.vt.x, O.vt.y);
    f32x4 Y = MFMA16(O.r0, xb0, z4); Y = MFMA16(O.r1, xb1, Y); Y = MFMA16(mk8(O.lrb.x, O.lrb.y, O.lrk.x, O.lrk.y), uv, Y);
#pragma unroll
    for (int jb = 0; jb < 4; ++jb) X[jb] = MFMA16(mk8(O.bb[jb].x, O.bb[jb].y, O.kk2[jb].x, O.kk2[jb].y), uv, X[jb]) * O.gm[jb];
    LAS unsigned char* py = yl + (4 * g) * 256 + (16 * wv + c) * 2;
    PIN_PTR(py);
    const float vv[4] = {bflo(O.vt.x), bfhi(O.vt.x), bflo(O.vt.y), bfhi(O.vt.y)};
#pragma unroll
    for (int r = 0; r < 4; ++r) { *(LAS unsigned short*)(py + r * 256) = (unsigned short)f2bf(Y[r]); *(LAS unsigned short*)(py + r * 256 + 128) = (unsigned short)f2bf(O.bn[r] * vv[r]); }
}
__device__ __forceinline__ void state_T(v2u (&tt)[NHELP], const LAS unsigned char* set0, LAS unsigned char* scr, int lane) {
    const int c = lane & 15, g = lane >> 4;
    const int o_w = c * TILEB + g * 8, o_r = (4 * g + (c >> 2)) * TILEB + (c & 3) * 8;
    const f32x4 z4 = (f32x4){0.f, 0.f, 0.f, 0.f};
    bf16x8 A1[NHELP], A2[NHELP], A4[NHELP]; f32x4 P[NHELP];
#pragma unroll
    for (int k = 0; k < NHELP; ++k) { const LAS unsigned char* tl = set0 + k * SL_BYTES + SL_T;
        const v2u bl = *(const LAS v2u*)(tl + o_w), al = trd(tl + o_r); A1[k] = mk8(al.x, al.y, 0u, 0u); P[k] = MFMA16(A1[k], mk8(bl.x, bl.y, 0u, 0u), z4); }
#pragma unroll
    for (int k = 0; k < NHELP; ++k) *(LAS v2u*)(scr + k * (16 * TILEB) + o_w) = (v2u){cvt2(P[k][0], P[k][1]), cvt2(P[k][2], P[k][3])};
#pragma unroll
    for (int k = 0; k < NHELP; ++k) { const v2u al = trd(scr + k * (16 * TILEB) + o_r); A2[k] = mk8(al.x, al.y, 0u, 0u); P[k] = MFMA16(A2[k], accB(P[k]), z4); }
#pragma unroll
    for (int k = 0; k < NHELP; ++k) *(LAS v2u*)(scr + k * (16 * TILEB) + o_w) = (v2u){cvt2(P[k][0], P[k][1]), cvt2(P[k][2], P[k][3])};
#pragma unroll
    for (int k = 0; k < NHELP; ++k) { const v2u al = trd(scr + k * (16 * TILEB) + o_r); A4[k] = mk8(al.x, al.y, 0u, 0u); P[k] = MFMA16(A4[k], accB(P[k]), z4); }
#pragma unroll
    for (int k = 0; k < NHELP; ++k) {
#pragma unroll
        for (int r = 0; r < 4; ++r) P[k][r] += (4 * g + r == c) ? 1.f : 0.f; }
#pragma unroll
    for (int k = 0; k < NHELP; ++k) P[k] = MFMA16(A4[k], accB(P[k]), P[k]);
#pragma unroll
    for (int k = 0; k < NHELP; ++k) P[k] = MFMA16(A2[k], accB(P[k]), P[k]);
#pragma unroll
    for (int k = 0; k < NHELP; ++k) P[k] = MFMA16(A1[k], accB(P[k]), P[k]);
#pragma unroll
    for (int k = 0; k < NHELP; ++k) *(LAS v2u*)(scr + k * (16 * TILEB) + o_w) = (v2u){cvt2(P[k][0], P[k][1]), cvt2(P[k][2], P[k][3])};
#pragma unroll
    for (int k = 0; k < NHELP; ++k) tt[k] = trd(scr + k * (16 * TILEB) + o_r);
}

__device__ __forceinline__ void p4_scan(Frame& F, const Args& AR) {
    const bf16* PROJ = (const bf16*)(F.ws + WS_PROJ); const bf16* DAG = (const bf16*)(F.ws + WS_DAG);
    float* BON = nullptr; bf16* MIX = (bf16*)(F.ws + WS_XN);
    LAS unsigned char* lds = F.lds + RING_OFF;
    LAS float* cst = (LAS float*)(lds + SC_CONST);
    const int tid = F.tid, lane = F.lane, wave = F.wave;
    for (int unit = blockIdx.x; unit < BATCH * NH; unit += F.G) {
        const int b = unit >> 3, h = unit & 7;
        const int tok0 = b * SEQ;
        if (tid < 384) { const int a = tid >> 6, c = tid & 63; const float* src = a == 0 ? AR.in[I_MU] + RC_R : a == 1 ? AR.in[I_MU] + RC_K : a == 2 ? AR.in[I_MU] + RC_V : a == 3 ? AR.in[I_KK] : a == 4 ? AR.in[I_KA] : AR.in[I_RK];
            cst[a * 64 + c] = src[h * 64 + c]; }
        __syncthreads();
        const int st_k = (tid >> 7) & 1, st_t = (tid >> 3) & 15, st_p = tid & 7;
        GAS v4u* ystore = (GAS v4u*)((GAS bf16*)MIX + (size_t)(tok0 + st_k * CS + st_t) * D + AW + h * 64 + 8 * st_p);
        const GAS v4u* gload = (const GAS v4u*)((const GAS bf16*)DAG + (size_t)(tok0 + st_k * CS + st_t) * NLORA + 1024 + h * 64 + 8 * st_p);
        const LAS unsigned char* yl_rd = lds + SC_YL + st_k * (CS * 256) + st_t * 256 + st_p * 16;
        v4u gnA = (v4u){0u, 0u, 0u, 0u}, gnB = gnA;
        float lng[8], lnb[8];
#pragma unroll
        for (int i = 0; i < 8; ++i) { lng[i] = AR.in[I_LNG][h * 64 + 8 * st_p + i]; lnb[i] = AR.in[I_LNB][h * 64 + 8 * st_p + i]; }
#define RWKV_OUT(it_, KO, gnext) do { if ((it_) >= 2 && NHELP * ((it_) - 2) + st_k + (KO) < NCHUNK) { \
            const v4u gw4 = gnext; \
            const v4u yw = *(const LAS v4u*)(yl_rd + (KO) * (CS * 256) + ((it_) & 1) * YL_BYTES), bw = *(const LAS v4u*)(yl_rd + (KO) * (CS * 256) + ((it_) & 1) * YL_BYTES + 128); \
            float y[8] = {bflo(yw.x), bfhi(yw.x), bflo(yw.y), bfhi(yw.y), bflo(yw.z), bfhi(yw.z), bflo(yw.w), bfhi(yw.w)}; \
            float sm = ((y[0] + y[1]) + (y[2] + y[3])) + ((y[4] + y[5]) + (y[6] + y[7])); \
            sm = red8(sm); \
            const float mean = sm * (1.f / 64.f); float sv = 0.f; \
            _Pragma("unroll") for (int i = 0; i < 8; ++i) { y[i] -= mean; sv += y[i] * y[i]; } \
            sv = red8(sv); \
            const float rs = 1.f / sqrtf(sv * (1.f / 64.f) + LNX_EPS); \
            const float bf_[8] = {bflo(bw.x), bfhi(bw.x), bflo(bw.y), bfhi(bw.y), bflo(bw.z), bfhi(bw.z), bflo(bw.w), bfhi(bw.w)}; \
            const float gf[8] = {bflo(gw4.x), bfhi(gw4.x), bflo(gw4.y), bfhi(gw4.y), bflo(gw4.z), bfhi(gw4.z), bflo(gw4.w), bfhi(gw4.w)}; \
            float ro[8]; \
            _Pragma("unroll") for (int i = 0; i < 8; ++i) ro[i] = (y[i] * rs * lng[i] + lnb[i] + bf_[i]) * gf[i]; \
            ystore[(size_t)(NHELP * ((it_) - 2) + (KO)) * CS * D / 8] = (v4u){pk2(ro[0], ro[1]), pk2(ro[2], ro[3]), pk2(ro[4], ro[5]), pk2(ro[6], ro[7])}; } \
            if ((it_) >= 1 && NHELP * ((it_) - 1) + st_k + (KO) < NCHUNK) gnext = gload[(size_t)(NHELP * ((it_) - 1) + (KO)) * CS * NLORA / 8]; } while (0)
        volatile LAS unsigned* cnt = (volatile LAS unsigned*)(F.lds + LDSCTL_OFF + 128);
        if (tid < 8) cnt[tid] = 0u;
        __syncthreads();
#define LDS_WAIT_GE(idx, target) do { while (cnt[idx] < (unsigned)(target)) __builtin_amdgcn_s_sleep(1); asm volatile("" ::: "memory"); } while (0)
#define LDS_SIGNAL(idx) do { asm volatile("s_waitcnt lgkmcnt(0)" ::: "memory"); if (lane == 0) __hip_atomic_fetch_add((LAS unsigned*)(cnt + (idx)), 1u, __ATOMIC_RELAXED, __HIP_MEMORY_SCOPE_WORKGROUP); } while (0)
        if (wave >= NSTATE) {
            const int hw = wave - NSTATE, kg = lane >> 4, tokl = tok0 + (lane & 15);
            HReg R;
            helper_load(R, PROJ, DAG, tokl + hw * CS, h, kg);
            for (int it = 0; it < NIT; ++it) {
                const int ch = NHELP * it + hw, s_ = it & 1;
                if (it >= 2) LDS_WAIT_GE(2 + s_, NSTATE * (it >> 1));
                helper_chunk(lds + (s_ * NHELP + hw) * SL_BYTES, cst, R, ch + NHELP < NCHUNK, PROJ, DAG, BON, tokl + ch * CS, h, lane);
                LDS_SIGNAL(0 + s_);
            }
        } else {
            f32x4 X[4];
#pragma unroll
            for (int jb = 0; jb < 4; ++jb) X[jb] = (f32x4){0.f, 0.f, 0.f, 0.f};
            for (int j = 0; j <= NIT; ++j) {
                if (j >= 1) { LDS_WAIT_GE(4 + ((j - 1) & 1), NSTATE * (((j - 1) >> 1) + 1));
                    RWKV_OUT(j + 1, 0, gnA); RWKV_OUT(j + 1, 2, gnB);
                    LDS_SIGNAL(6 + ((j - 1) & 1)); }
                else { RWKV_OUT(j + 1, 0, gnA); RWKV_OUT(j + 1, 2, gnB); }
                if (j < NIT) {
                    const int s_ = j & 1;
                    LDS_WAIT_GE(0 + s_, NHELP * ((j >> 1) + 1));
                    if (j >= 2) LDS_WAIT_GE(6 + s_, NSTATE * (j >> 1));
                    const LAS unsigned char* set0 = lds + (s_ * NHELP) * SL_BYTES;
                    LAS unsigned char* ylb = lds + SC_YL + s_ * YL_BYTES;
                    v2u tt[NHELP];
                    SOps Oa, Ob;
                    state_load(Oa, set0, lane, wave);
                    state_T(tt, set0, lds + SC_TS + wave * (NHELP * 16 * TILEB), lane);
#pragma unroll
                    for (int k = 0; k < NHELP; k += 2) {
                        state_load(Ob, set0 + (k + 1) * SL_BYTES, lane, wave);
                        state_compute(Oa, tt[k], X, ylb + k * (CS * 256), lane, wave);
                        if (k + 2 < NHELP) state_load(Oa, set0 + (k + 2) * SL_BYTES, lane, wave);
                        state_compute(Ob, tt[k + 1], X, ylb + (k + 1) * (CS * 256), lane, wave);
                    }
                    LDS_SIGNAL(2 + s_); LDS_SIGNAL(4 + s_);
                }
            }
        }
#undef LDS_WAIT_GE
#undef LDS_SIGNAL
        __syncthreads();
    }
}

__device__ __forceinline__ s16x4 vtr(const LAS unsigned char* p) { typedef short v4i16_t __attribute__((ext_vector_type(4)));
    return __builtin_bit_cast(s16x4, __builtin_amdgcn_ds_read_tr16_b64_v4i16((LAS v4i16_t*)p)); }
constexpr int ATT_UNITS = 3 * BATCH * NH * 16;
__device__ __forceinline__ void p4_attn(Frame& F, const Args& AR) {
    const bf16* PROJ = (const bf16*)(F.ws + WS_PROJ);
    bf16* PO = (bf16*)((unsigned char*)F.out + DO_PO); float* ML = (float*)(F.ws + WS_ML);
    const int tid = F.tid, lane = F.lane, wave = F.wave, half = wave >> 2, wq = wave & 3, th = tid & 255;
    const int r32 = lane & 31, hi = lane >> 5;
    LAS unsigned char* Kl = F.lds + RING_OFF + half * 65536; LAS unsigned char* Vl = Kl + 32768;
    gu32* qctr = F.ctl + CW_ATTQ;
    v4u kst[8], vst[8];
#define ATT_DECODE(up_) const int unit = 2 * (up_) + half; \
        const int pat = unit / (BATCH * NH * 16), rem = unit % (BATCH * NH * 16), bh = rem >> 4, i16 = rem & 15, b = bh >> 3, h = bh & 7; \
        const int dil = pat == 0 ? 1 : (pat == 1 ? 4 : 16); \
        const int res = pat == 0 ? 0 : (pat == 1 ? (i16 >> 2) : i16); \
        const int n = pat == 0 ? i16 : (pat == 1 ? (i16 & 3) : 0); \
        const size_t rowb = (size_t)b * SEQ;
#define ATT_ISSUE(up_) do { ATT_DECODE(up_) const int c = th & 7; \
        _Pragma("unroll") for (int i = 0; i < 8; ++i) { const int key = (th >> 3) + 32 * i; const int sub = 128 * (n - 1) + key; \
            kst[i] = (v4u){0u, 0u, 0u, 0u}; vst[i] = kst[i]; \
            if (sub >= 0) { const GAS bf16* src = (const GAS bf16*)PROJ + (rowb + res + dil * sub) * IN_COLS + h * 64 + 8 * c; kst[i] = *(const GAS v4u*)(src + PC_K); vst[i] = *(const GAS v4u*)(src + PC_V); } } } while (0)
    if (tid == 0) F.MISC[16] = __hip_atomic_fetch_add(qctr, 1u, RLX_AGENT);
    __syncthreads();
    int up = (int)F.MISC[16];
    __syncthreads();
    if (up < ATT_UNITS / 2) ATT_ISSUE(up);
    while (up < ATT_UNITS / 2) {
        if (tid == 0) F.MISC[16] = __hip_atomic_fetch_add(qctr, 1u, RLX_AGENT);
        ATT_DECODE(up)
        const int ql = 32 * wq + r32; const size_t qrow = rowb + res + dil * (128 * n + ql);
        bf16x8 qf[4];
#pragma unroll
        for (int d0 = 0; d0 < 4; ++d0) qf[d0] = *(const GAS bf16x8*)((const GAS bf16*)PROJ + qrow * IN_COLS + PC_Q + h * 64 + 16 * d0 + 8 * hi);
        {
            const int c = th & 7;
#pragma unroll
            for (int i = 0; i < 8; ++i) {
                const int key = (th >> 3) + 32 * i;
                *(LAS v4u*)(Kl + key * 128 + ((c ^ ((key >> 1) & 7)) * 16)) = kst[i];
                *(LAS v4u*)(Vl + (c >> 2) * 16384 + key * 64 + (c & 3) * 16) = vst[i];
            }
        }
        __syncthreads();
        const int upn = (int)F.MISC[16];
        if (upn < ATT_UNITS / 2) { ATT_ISSUE(upn); }
        const float slope2 = __builtin_amdgcn_exp2f(-(float)(h + 1)) * (float)dil * LOG2E;
        const int thr = r32 - 4 * hi;
        f32x16 sc[5];
        float mx = -INFINITY;
#pragma unroll
        for (int kt = 0; kt < 5; ++kt) {
            const bool skip = (n == 0) && (wq + kt < 4);
            f32x16 acc;
            if (!skip) {
                const int key = 32 * (wq + kt) + r32;
                const float bk = -slope2 * (float)(128 - 32 * kt + thr);
#pragma unroll
                for (int r = 0; r < 16; ++r) acc[r] = slope2 * (float)((r & 3) + 8 * (r >> 2)) + bk;
#pragma unroll
                for (int d0 = 0; d0 < 4; ++d0) {
                    const bf16x8 kf = *(const LAS bf16x8*)(Kl + key * 128 + (((2 * d0 + hi) ^ ((key >> 1) & 7)) * 16));
                    acc = __builtin_amdgcn_mfma_f32_32x32x16_bf16(kf, qf[d0], acc, 0, 0, 0);
                }
                if (kt == 0) {
#pragma unroll
                    for (int r = 0; r < 16; ++r) acc[r] = ((r & 3) + 8 * (r >> 2)) >= thr ? acc[r] : -INFINITY;
                }
                if (kt == 4) {
#pragma unroll
                    for (int r = 0; r < 16; ++r) acc[r] = ((r & 3) + 8 * (r >> 2)) <= thr ? acc[r] : -INFINITY;
                }
#pragma unroll
                for (int r = 0; r < 16; ++r) mx = fmaxf(mx, acc[r]);
            } else {
#pragma unroll
                for (int r = 0; r < 16; ++r) acc[r] = -INFINITY;
            }
            sc[kt] = acc;
            __builtin_amdgcn_sched_barrier(0);
        }
        mx = fmaxf(mx, __shfl_xor(mx, 32));
        float l = 0.f;
#pragma unroll
        for (int kt = 0; kt < 5; ++kt)
#pragma unroll
            for (int r = 0; r < 16; ++r) { const float p = __builtin_amdgcn_exp2f(sc[kt][r] - mx); sc[kt][r] = p; l += p; }
        l += __shfl_xor(l, 32);
        f32x16 o[2]; o[0] = f32x16{}; o[1] = f32x16{};
        const int voff = ((lane >> 4) & 1) * 32 + (lane & 3) * 8 + (4 * hi + ((lane & 15) >> 2)) * 64;
#pragma unroll
        for (int kt = 0; kt < 5; ++kt) {
            const bool skip = (n == 0) && (wq + kt < 4);
            if (!skip) {
#pragma unroll
            for (int s2 = 0; s2 < 2; ++s2) {
                v4u pw;
                pw.x = pg8::cvt_pk_bf16(sc[kt][8 * s2 + 0], sc[kt][8 * s2 + 1]); pw.y = pg8::cvt_pk_bf16(sc[kt][8 * s2 + 2], sc[kt][8 * s2 + 3]);
                pw.z = pg8::cvt_pk_bf16(sc[kt][8 * s2 + 4], sc[kt][8 * s2 + 5]); pw.w = pg8::cvt_pk_bf16(sc[kt][8 * s2 + 6], sc[kt][8 * s2 + 7]);
                const bf16x8 pf = __builtin_bit_cast(bf16x8, pw);
                const int kb = 32 * (wq + kt) + 16 * s2;
#pragma unroll
                for (int dt = 0; dt < 2; ++dt) {
                    const LAS unsigned char* vp = Vl + dt * 16384 + kb * 64 + voff;
                    const s16x4 lo = vtr(vp), hi4 = vtr(vp + 8 * 64);
                    const bf16x8 vf = (bf16x8){lo[0], lo[1], lo[2], lo[3], hi4[0], hi4[1], hi4[2], hi4[3]};
                    o[dt] = __builtin_amdgcn_mfma_f32_32x32x16_bf16(vf, pf, o[dt], 0, 0, 0);
                }
            }
            }
        }
        const float rl = 1.f / l;
        bf16* po = PO + ((size_t)pat * M + qrow) * AW + h * 64;
#pragma unroll
        for (int dt = 0; dt < 2; ++dt)
#pragma unroll
            for (int g = 0; g < 4; ++g) {
                const v2u w = (v2u){pk2(o[dt][4 * g] * rl, o[dt][4 * g + 1] * rl), pk2(o[dt][4 * g + 2] * rl, o[dt][4 * g + 3] * rl)};
                *(v2u*)(po + 32 * dt + 8 * g + 4 * hi) = w;
            }
        if (hi == 0) *(f32x2*)(ML + (((size_t)pat * M + qrow) * NH + h) * 2) = (f32x2){mx, l};
        __syncthreads();
        up = upn;
    }
#undef ATT_DECODE
#undef ATT_ISSUE
}

struct P5In { v4u po[3]; f32x2 ml[3]; };
__device__ __forceinline__ void p5_load(P5In& I, int m, int lane, const bf16* PO, const float* ML) {
    const int hd = lane >> 3;
#pragma unroll
    for (int p = 0; p < 3; ++p) { I.ml[p] = *(const GAS f32x2*)(ML + (((size_t)p * M + m) * NH + hd) * 2); I.po[p] = *(const GAS v4u*)(PO + ((size_t)p * M + m) * AW + 8 * lane); }
}
__device__ __forceinline__ void p5_token(const P5In& I, int m, int lane, bf16* MIX, const float (&aog)[8]) {
    const float mm = fmaxf(fmaxf(I.ml[0].x, I.ml[1].x), I.ml[2].x);
    float wp[3], wsum = 0.f;
#pragma unroll
    for (int p = 0; p < 3; ++p) { wp[p] = __builtin_amdgcn_exp2f(I.ml[p].x - mm) * I.ml[p].y; wsum += wp[p]; }
    const float rws = 1.f / wsum;
    float at[8] = {0.f, 0.f, 0.f, 0.f, 0.f, 0.f, 0.f, 0.f};
#pragma unroll
    for (int p = 0; p < 3; ++p) { const v4u w = I.po[p]; const float f = wp[p] * rws;
        at[0] += f * bflo(w.x); at[1] += f * bfhi(w.x); at[2] += f * bflo(w.y); at[3] += f * bfhi(w.y); at[4] += f * bflo(w.z); at[5] += f * bfhi(w.z); at[6] += f * bflo(w.w); at[7] += f * bfhi(w.w); }
    float ss = 0.f;
#pragma unroll
    for (int i = 0; i < 8; ++i) ss += at[i] * at[i];
    ss += __shfl_xor(ss, 1); ss += __shfl_xor(ss, 2); ss += __shfl_xor(ss, 4);
    const float rstd = 1.f / sqrtf(ss * (1.f / 64.f) + NORM_EPS);
    v4u oa; oa.x = pk2(at[0] * rstd * aog[0], at[1] * rstd * aog[1]); oa.y = pk2(at[2] * rstd * aog[2], at[3] * rstd * aog[3]);
    oa.z = pk2(at[4] * rstd * aog[4], at[5] * rstd * aog[5]); oa.w = pk2(at[6] * rstd * aog[6], at[7] * rstd * aog[7]);
    *(GAS v4u*)(MIX + (size_t)m * D + 8 * lane) = oa;
}
__device__ __forceinline__ void p5_post(Frame& F, const Args& AR) {
    const int gw = F.vcu * NWAVES + F.wave, NGW = F.G * NWAVES, lane = F.lane;
    const bf16* PO = (const bf16*)((unsigned char*)F.out + DO_PO); const float* ML = (const float*)(F.ws + WS_ML);
    bf16* MIX = (bf16*)(F.ws + WS_XN);
    float aog[8];
#pragma unroll
    for (int i = 0; i < 8; ++i) aog[i] = AR.in[I_AOG][8 * lane + i];
    static_assert(M % 4 == 0, "four tokens per step");
    for (int m = 4 * gw; m < M; m += 4 * NGW) {
        P5In A, B, C, E;
        p5_load(A, m, lane, PO, ML); p5_load(B, m + 1, lane, PO, ML); p5_load(C, m + 2, lane, PO, ML); p5_load(E, m + 3, lane, PO, ML);
        p5_token(A, m, lane, MIX, aog); p5_token(B, m + 1, lane, MIX, aog); p5_token(C, m + 2, lane, MIX, aog); p5_token(E, m + 3, lane, MIX, aog);
    }
}

__device__ __forceinline__ void p1_tail_weights(Frame& F, const Args& AR, int w0, int nw) {
    LAS float* scr = (LAS float*)(F.lds + RING_OFF + F.wave * TR_SCR);
    bf16* Wout_t = (bf16*)(F.ws + WS_WOUT); bf16* Wgu_t = (bf16*)(F.ws + WS_WGU); bf16* Wdn_t = (bf16*)(F.ws + WS_WDN);
    constexpr int I_OUT = (D / 64) * (D / 64), I_G = (D / 64) * (FF / 64), I_DN = (FF / 64) * (D / 64), NLATE = I_OUT + 2 * I_G + I_DN;
    for (int it = w0; it < NLATE; it += nw) {
        int r = it;
        if (r < I_OUT) { p0_transpose_item(AR.in[I_WOUT], D, D, Wout_t, 0, scr, r, F.lane); continue; } r -= I_OUT;
        if (r < I_G) { p0_transpose_item(AR.in[I_WG], D, FF, Wgu_t, 1, scr, r, F.lane, AR.in[I_N2G]); continue; } r -= I_G;
        if (r < I_G) { p0_transpose_item(AR.in[I_WU], D, FF, Wgu_t, 2, scr, r, F.lane, AR.in[I_N2G]); continue; } r -= I_G;
        p0_transpose_item(AR.in[I_WD], FF, D, Wdn_t, 0, scr, r, F.lane);
    }
}

__global__ void __launch_bounds__(NWAVES * 64, 2) hybrid_fwd(Args args) {
    extern __shared__ __attribute__((aligned(16))) unsigned char lds[];
    Frame F;
    F.lds = (LAS unsigned char*)lds;
    F.MISC = (volatile LAS unsigned*)(F.lds + MISC_OFF);
    F.tid = threadIdx.x; F.lane = F.tid & 63; F.wave = __builtin_amdgcn_readfirstlane(F.tid >> 6);
    F.G = gridDim.x; { const int bx = blockIdx.x; F.vcu = (F.G % 8 == 0) ? (bx % 8) * (F.G / 8) + bx / 8 : bx; }
    F.ws = args.ws; F.out = args.out;
    F.ctl = (gu32*)(args.ws + WS_CTL);
    for (int u = F.tid; u < (LDS_BYTES - LDSCTL_OFF) / 4; u += NWAVES * 64) ((LAS unsigned*)(F.lds + LDSCTL_OFF))[u] = 0u;
    __syncthreads();
    XcdBarrier bar; bar.bar = (unsigned*)(F.ctl + CW_BAR); bar.x = 0; bar.st = nullptr;
    if (N_LAUNCHES != PER_PHASE) bar = xcd_barrier_post((unsigned*)(F.ctl + CW_BAR), F.MISC + 8);
#define GRID_BAR() do { if (N_LAUNCHES != PER_PHASE) xcd_barrier(bar); } while (0)
    const int lo = args.ph_lo, hi = args.ph_hi;
#ifndef PHMASK
#define PHMASK 0x3ff
#endif
#define IN(k) (((PHMASK >> (k)) & 1) && lo <= (k) && (k) < hi)
#define BOTH(k) (IN(k) && IN((k) + 1))
#define PSTAMP(i) do { if (PROBE_SEL >= 0 && blockIdx.x == 0 && F.tid == 0) { const unsigned long long t_ = __builtin_amdgcn_s_memtime(); __hip_atomic_store(F.ctl + 9100 + (i), (unsigned)(t_ >> 4), RLX_AGENT); } } while (0)
#ifndef REPMASK
#define REPMASK 0
#endif
#define REP(k) for (int rep_ = 0; rep_ <= ((REPMASK >> (k)) & 1); ++rep_)
    bf16* XN = (bf16*)(args.ws + WS_XN); bf16* PROJ = (bf16*)(args.ws + WS_PROJ);

    PSTAMP(0);
    if (IN(0)) { p0_prologue(F, args); if (BOTH(0)) GRID_BAR(); }
    PSTAMP(1);
    if (IN(1)) {
        pg8::Gemm g{XN, (const bf16*)(args.ws + WS_WIN), M, IN_COLS, D}; pg8::StaticOrder S; S.init(M, IN_COLS, F.G, (int)blockIdx.x);
        pg8::EpiProj E{PROJ, IN_COLS, args.in[I_QNG], args.in[I_KNG]};
        const int nu = (M / 256) * (IN_COLS / 256), rem = nu % F.G;
        if (rem != 0 && (int)blockIdx.x >= rem) { p1_tail_weights(F, args, ((int)blockIdx.x - rem) * NWAVES + F.wave, (F.G - rem) * NWAVES); __syncthreads(); }
        pg8::gemm_phase<pg8::EpiProj, pg8::StaticOrder, true, true>(F.lds + RING_OFF, g, S, E);
        if (rem == 0) p1_tail_weights(F, args, (int)blockIdx.x * NWAVES + F.wave, F.G * NWAVES);
        if (BOTH(1)) GRID_BAR();
    }
    PSTAMP(2);
    PSTAMP(3);
    if (IN(3)) { p3_lora(F, args); if (BOTH(3)) GRID_BAR(); }
    PSTAMP(4);
    if (IN(4)) { p4_scan(F, args); PSTAMP(11); p4_attn(F, args); PSTAMP(12); if (BOTH(4)) GRID_BAR(); }
    PSTAMP(5);
    if (IN(5)) { p5_post(F, args); if (BOTH(5)) GRID_BAR(); }
    PSTAMP(6);
    if (IN(6)) {
        pg8::Gemm g{XN, (const bf16*)(args.ws + WS_WOUT), M, D, D}; pg8::StaticOrder S; S.init(M, D, F.G, (int)blockIdx.x);
        pg8::EpiOut E{args.in[I_X], (bf16*)(args.ws + WS_DAG), (float*)(args.ws + WS_SS), D, (LAS float*)(F.lds + RING_OFF + 131072)};
        pg8::gemm_phase<pg8::EpiOut, pg8::StaticOrder, true, true>(F.lds + RING_OFF, g, S, E);
        if (IN(8)) GRID_BAR();
    }
    PSTAMP(8);
    if (IN(8)) {
        pg8::Gemm g{(const bf16*)(args.ws + WS_DAG), (const bf16*)(args.ws + WS_WGU), M, NGU, D}; pg8::StaticOrder S; S.init(M, NGU, F.G, (int)blockIdx.x);
        pg8::EpiSwiglu E{PROJ, FF, (const float*)(args.ws + WS_SS)};
        pg8::gemm_phase<pg8::EpiSwiglu, pg8::StaticOrder, true, true>(F.lds + RING_OFF, g, S, E);
        if (BOTH(8)) GRID_BAR();
    }
    PSTAMP(9);
    if (IN(9)) {
        pg8::Gemm g{PROJ, (const bf16*)(args.ws + WS_WDN), M, D, FF}; pg8::StaticOrder S; S.init(M, D, F.G, (int)blockIdx.x);
        pg8::EpiFinal E{(const bf16*)(args.ws + WS_DAG), F.out, D};
        pg8::gemm_phase<pg8::EpiFinal, pg8::StaticOrder, true, true>(F.lds + RING_OFF, g, S, E);
    }
    PSTAMP(10);
    if (PROBE_SEL >= 0 && blockIdx.x == 0 && F.tid == 0) {
        unsigned w = 0;
        auto ld = [&](int i) { return __hip_atomic_load(F.ctl + 9100 + i, RLX_AGENT); };
        const int sel = PROBE_SEL;
        if (sel <= 9) { const int nxt = sel == 6 ? 8 : (sel == 9 ? 10 : sel + 1); w = ld(nxt) - ld(sel); }
        else if (sel == 20) w = ld(11) - ld(4);
        else if (sel == 21) w = ld(12) - ld(11);
        else w = ld(sel);
        const unsigned long long t0 = __builtin_amdgcn_s_memtime();
        while (((__builtin_amdgcn_s_memtime() - t0) >> 4) < (unsigned long long)w) __builtin_amdgcn_s_sleep(8);
    }
#undef IN
#undef BOTH
}

extern "C" void kernel_launch(void* const* d_in, const int* in_sizes, int n_in, void* d_out, int out_size, void* d_ws, size_t ws_size, hipStream_t stream) {
    static int grid = 0;
    if (grid == 0) {
        if (n_in != 22 || in_sizes[0] != M * D || out_size != M * D || ws_size < WS_END) { fprintf(stderr, "kernel_launch: unexpected shapes (n_in %d, in0 %d, out %d, ws %zu); nothing launched\n", n_in, n_in > 0 ? in_sizes[0] : -1, out_size, ws_size); grid = -1; return; }
        int dev = 0, cus = 0, per_cu = 0;
        if (hipGetDevice(&dev) != hipSuccess || hipDeviceGetAttribute(&cus, hipDeviceAttributeMultiprocessorCount, dev) != hipSuccess) { grid = -1; return; }
        if (hipFuncSetAttribute((const void*)hybrid_fwd, hipFuncAttributeMaxDynamicSharedMemorySize, LDS_BYTES) != hipSuccess) { fprintf(stderr, "kernel_launch: hipFuncSetAttribute failed\n"); grid = -1; return; }
        if (hipOccupancyMaxActiveBlocksPerMultiprocessor(&per_cu, (const void*)hybrid_fwd, NWAVES * 64, LDS_BYTES) != hipSuccess || per_cu < 1)
            fprintf(stderr, "kernel_launch: note: occupancy query reports %d workgroups per CU\n", per_cu);
        (void)hipGetLastError();
        grid = cus;
    }
    if (grid < 0) return;
    if (hipMemsetAsync((char*)d_ws + WS_CTL, 0, CTL_ZERO_BYTES, stream) != hipSuccess) { fprintf(stderr, "kernel_launch: hipMemsetAsync failed\n"); return; }
    Args a{};
    for (int i = 0; i < 22; ++i) a.in[i] = (const float*)d_in[i];
    a.out = (float*)d_out; a.ws = (unsigned char*)d_ws;
    for (int li = 0; li < N_LAUNCHES; ++li) {
        a.ph_lo = (N_LAUNCHES == PER_PHASE) ? li : 0; a.ph_hi = (N_LAUNCHES == PER_PHASE) ? li + 1 : PER_PHASE; a.li = li;
        hipLaunchKernelGGL(hybrid_fwd, dim3(grid), dim3(NWAVES * 64), LDS_BYTES, stream, a);
        const hipError_t le = hipPeekAtLastError();
        if (le != hipSuccess) { fprintf(stderr, "kernel_launch: launch %d failed: %s\n", li, hipGetErrorName(le)); break; }
    }
}
```

```cpp
#include <hip/hip_runtime.h>
#include <cstdio>
#include <cstdint>

#ifndef P5A_16
#define P5A_16 12
#endif
#ifndef PROBE_SEL
#define PROBE_SEL -1
#endif
#ifndef MK_N_LAUNCHES
#define MK_N_LAUNCHES 1
#endif

namespace pg8 {
#define PG8_LAS __attribute__((address_space(3)))
typedef unsigned short bf16_t;
typedef short bf16x8 __attribute__((ext_vector_type(8)));
typedef float f32x4 __attribute__((ext_vector_type(4)));
typedef float f32x2 __attribute__((ext_vector_type(2)));
typedef unsigned u32x4 __attribute__((ext_vector_type(4)));
constexpr int BM = 256, BK = 64, HALF = 128, HTB = HALF * BK * 2, STAGE_BYTES = 8 * HTB, NXCD = 8, WGM = 8;

__host__ __device__ __forceinline__ int lds_byte(int r, int c) { const int st = (r >> 4) * 2 + (c >> 5), rr = r & 15, cc = c & 31, ob = rr * 64 + cc * 2; return st * 1024 + (ob ^ (((ob >> 9) & 1) << 5)); }
__host__ __device__ __forceinline__ void stage_rc(int b, int& R, int& C) { const int st = b / 1024, sb = b % 1024, swz = sb ^ (((sb >> 9) & 1) << 5); R = (st >> 1) * 16 + swz / 64; C = (st & 1) * 32 + (swz % 64) / 2; }
__host__ __device__ __forceinline__ int perm32(int rho) { const int n = rho >> 4, i = rho & 15; return 8 * (i >> 2) + 4 * n + (i & 3); }

struct Unit { int pm, pn; };
struct Gemm { const bf16_t* A; const bf16_t* Bt; int M, N, K; };

struct StaticOrder {
    int nM, nN, nwg, G, c, nx;
    __host__ __device__ void init(int M, int N, int G_, int c_, int nx_ = NXCD) { nM = M / BM; nN = N / BM; nwg = nM * nN; G = G_; c = c_; nx = nx_; }
    __host__ __device__ bool next(int i, Unit& u) const {
        const long L = (long)i * G + c; if (L >= nwg) return false;
        int wgid = (int)L; { const int q = nwg / nx, r = nwg % nx, xcd = wgid % nx, off = wgid / nx; wgid = (xcd < r ? xcd * (q + 1) : r * (q + 1) + (xcd - r) * q) + off; }
        const int nig = WGM * nN, gid = wgid / nig, fm = gid * WGM, gsz = (nM - fm) < WGM ? (nM - fm) : WGM;
        u.pm = fm + ((wgid % nig) % gsz); u.pn = (wgid % nig) / gsz; return true;
    }
    __device__ __forceinline__ void a_ready(const Unit&) const {}
    __device__ __forceinline__ void done(const Unit&) const {}
};

__device__ __forceinline__ unsigned cvt_pk_bf16(float lo, float hi) { unsigned r; asm volatile("v_cvt_pk_bf16_f32 %0, %1, %2" : "=v"(r) : "v"(lo), "v"(hi)); return r; }
__device__ __forceinline__ float fsigmoid(float x) { return __builtin_amdgcn_rcpf(1.0f + __builtin_amdgcn_exp2f(-1.4426950408889634f * x)); }

struct EpiBf16 {
    static constexpr bool PERM = true, AFTER_DRAIN = false;
    bf16_t* O; int ldc;
    __device__ __forceinline__ void operator()(const f32x4 (&acc)[2][2][4][2], const Unit& u, int wr, int wc, int fr, int fq) const {
        const int row0 = u.pm * BM + wr * 64 + fr; const int col0 = u.pn * BM + wc * 32 + 8 * fq;
#pragma unroll
        for (int ai = 0; ai < 2; ++ai)
#pragma unroll
            for (int m = 0; m < 4; ++m) { bf16_t* rowp = O + (size_t)(row0 + ai * HALF + m * 16) * ldc + col0;
#pragma unroll
                for (int bj = 0; bj < 2; ++bj) { const f32x4 v0 = acc[ai][bj][m][0], v1 = acc[ai][bj][m][1];
                    u32x4 w; w.x = cvt_pk_bf16(v0[0], v0[1]); w.y = cvt_pk_bf16(v0[2], v0[3]); w.z = cvt_pk_bf16(v1[0], v1[1]); w.w = cvt_pk_bf16(v1[2], v1[3]);
                    *(u32x4*)(rowp + bj * HALF) = w; } }
    }
};
struct EpiProj {
    static constexpr bool PERM = true, AFTER_DRAIN = false;
    bf16_t* O; int ldc; const float* qg; const float* kg;
    __device__ __forceinline__ void operator()(const f32x4 (&acc)[2][2][4][2], const Unit& u, int wr, int wc, int fr, int fq) const {
        const int row0 = u.pm * BM + wr * 64 + fr;
        if (u.pn >= 4) {
            const int col0 = u.pn * BM + wc * 32 + 8 * fq;
#pragma unroll
            for (int ai = 0; ai < 2; ++ai)
#pragma unroll
                for (int m = 0; m < 4; ++m) { bf16_t* rowp = O + (size_t)(row0 + ai * HALF + m * 16) * ldc + col0;
#pragma unroll
                    for (int bj = 0; bj < 2; ++bj) { const f32x4 v0 = acc[ai][bj][m][0], v1 = acc[ai][bj][m][1];
                        u32x4 w; w.x = cvt_pk_bf16(v0[0], v0[1]); w.y = cvt_pk_bf16(v0[2], v0[3]); w.z = cvt_pk_bf16(v1[0], v1[1]); w.w = cvt_pk_bf16(v1[2], v1[3]);
                        *(u32x4*)(rowp + bj * HALF) = w; } }
        } else {
            const float* gsrc = (u.pn < 2 ? qg : kg) + 8 * fq; const float sc = u.pn < 2 ? 0.125f * 1.4426950408889634f : 1.0f;
            f32x4 g4[2][2];
#pragma unroll
            for (int bj = 0; bj < 2; ++bj)
#pragma unroll
                for (int n = 0; n < 2; ++n) g4[bj][n] = *(const f32x4*)(gsrc + 32 * bj + 4 * n) * sc;
            const int col0 = u.pn * BM + wc * 64 + 8 * fq;
#pragma unroll
            for (int ai = 0; ai < 2; ++ai)
#pragma unroll
                for (int m = 0; m < 4; ++m) {
                    float ss = 0.f;
#pragma unroll
                    for (int bj = 0; bj < 2; ++bj)
#pragma unroll
                        for (int n = 0; n < 2; ++n) { const f32x4 v = acc[ai][bj][m][n]; ss += (v[0] * v[0] + v[1] * v[1]) + (v[2] * v[2] + v[3] * v[3]); }
                    ss += __shfl_xor(ss, 16); ss += __shfl_xor(ss, 32);
                    const float rstd = 1.0f / sqrtf(ss * (1.0f / 64.0f) + 1e-6f);
                    bf16_t* rowp = O + (size_t)(row0 + ai * HALF + m * 16) * ldc + col0;
#pragma unroll
                    for (int bj = 0; bj < 2; ++bj) { const f32x4 v0 = acc[ai][bj][m][0] * g4[bj][0] * rstd, v1 = acc[ai][bj][m][1] * g4[bj][1] * rstd;
                        u32x4 w; w.x = cvt_pk_bf16(v0[0], v0[1]); w.y = cvt_pk_bf16(v0[2], v0[3]); w.z = cvt_pk_bf16(v1[0], v1[1]); w.w = cvt_pk_bf16(v1[2], v1[3]);
                        *(u32x4*)(rowp + 32 * bj) = w; }
                    __builtin_amdgcn_sched_barrier(0); }
        }
    }
};
struct EpiLora {
    static constexpr bool PERM = true, AFTER_DRAIN = false;
    bf16_t* O; int ldc; const float* w0; const float* a0;
    __device__ __forceinline__ void operator()(const f32x4 (&acc)[2][2][4][2], const Unit& u, int wr, int wc, int fr, int fq) const {
        const int row0 = u.pm * BM + wr * 64 + fr; const int col0 = u.pn * BM + wc * 32 + 8 * fq;
        const int kind = u.pn >> 1;
        const float sc = kind == 0 ? -0.6065306597126334f : (kind == 1 ? 1.0f : 0.0f), lin = kind == 2 ? 1.0f : 0.0f;
        const float* bp = kind == 0 ? w0 : a0;
        const float bs = kind == 2 ? 0.0f : 1.0f;
#pragma unroll
        for (int bj = 0; bj < 2; ++bj) {
            const int c = (col0 + bj * HALF) & 511;
            const f32x4 b0 = *(const f32x4*)(bp + c) * bs, b1 = *(const f32x4*)(bp + c + 4) * bs;
#pragma unroll
            for (int ai = 0; ai < 2; ++ai)
#pragma unroll
                for (int m = 0; m < 4; ++m) { bf16_t* rowp = O + (size_t)(row0 + ai * HALF + m * 16) * ldc + col0;
                    f32x4 v0 = acc[ai][bj][m][0] + b0, v1 = acc[ai][bj][m][1] + b1;
#pragma unroll
                    for (int e = 0; e < 4; ++e) { v0[e] = sc * fsigmoid(v0[e]) + lin * v0[e]; v1[e] = sc * fsigmoid(v1[e]) + lin * v1[e]; }
                    u32x4 w; w.x = cvt_pk_bf16(v0[0], v0[1]); w.y = cvt_pk_bf16(v0[2], v0[3]); w.z = cvt_pk_bf16(v1[0], v1[1]); w.w = cvt_pk_bf16(v1[2], v1[3]);
                    *(u32x4*)(rowp + bj * HALF) = w;
                    __builtin_amdgcn_sched_barrier(0); }
        }
    }
};
struct EpiSwiglu {
    static constexpr bool PERM = true, AFTER_DRAIN = false;
    bf16_t* H; int ldh; const float* rstd;
    __device__ __forceinline__ void operator()(const f32x4 (&acc)[2][2][4][2], const Unit& u, int wr, int wc, int fr, int fq) const {
        const int row0 = u.pm * BM + wr * 64 + fr; const int col0 = u.pn * HALF + wc * 32 + 8 * fq;
        float rs[2][4];
#pragma unroll
        for (int ai = 0; ai < 2; ++ai)
#pragma unroll
            for (int m = 0; m < 4; ++m) { const f32x4 s4 = *(const f32x4*)(rstd + (size_t)(row0 + ai * HALF + m * 16) * 4);
                rs[ai][m] = 1.0f / sqrtf(((s4[0] + s4[1]) + (s4[2] + s4[3])) * (1.0f / 1024.0f) + 1e-6f); }
#pragma unroll
        for (int ai = 0; ai < 2; ++ai)
#pragma unroll
            for (int m = 0; m < 4; ++m) { bf16_t* rowp = H + (size_t)(row0 + ai * HALF + m * 16) * ldh + col0;
                float h[8];
#pragma unroll
                for (int n = 0; n < 2; ++n)
#pragma unroll
                    for (int e = 0; e < 4; ++e) { const float g = acc[ai][0][m][n][e] * rs[ai][m], up = acc[ai][1][m][n][e] * rs[ai][m]; h[4 * n + e] = g * fsigmoid(g) * up; }
                u32x4 w; w.x = cvt_pk_bf16(h[0], h[1]); w.y = cvt_pk_bf16(h[2], h[3]); w.z = cvt_pk_bf16(h[4], h[5]); w.w = cvt_pk_bf16(h[6], h[7]);
                *(u32x4*)rowp = w;
                __builtin_amdgcn_sched_barrier(0); }
    }
};
struct EpiOut {
    static constexpr bool PERM = true, AFTER_DRAIN = false;
    const float* base; bf16_t* xb; float* SS; int ldc; PG8_LAS float* scr;
#define EPO_LOAD(dst, g) do { _Pragma("unroll") for (int mm = 0; mm < 2; ++mm) _Pragma("unroll") for (int bj = 0; bj < 2; ++bj) { \
        const size_t o_ = (size_t)(((g) >> 1) * HALF + (((g) & 1) * 2 + mm) * 16) * ldc + bj * HALF; dst[mm * 4 + bj * 2] = *(const f32x4*)(bp + o_); dst[mm * 4 + bj * 2 + 1] = *(const f32x4*)(bp + o_ + 4); } } while (0)
    __device__ __forceinline__ void operator()(const f32x4 (&acc)[2][2][4][2], const Unit& u, int wr, int wc, int fr, int fq) const {
        const int row0 = u.pm * BM + wr * 64 + fr, col0 = u.pn * BM + wc * 32 + 8 * fq;
        const float* bp = base + (size_t)row0 * ldc + col0; bf16_t* xp = xb + (size_t)row0 * ldc + col0;
        f32x4 xa[8], xc[8];
        EPO_LOAD(xa, 0); EPO_LOAD(xc, 1);
        __builtin_amdgcn_sched_barrier(0);
#pragma unroll
        for (int g = 0; g < 4; ++g) {
            const int ai = g >> 1;
            u32x4 wo[4]; float ssv[2];
#pragma unroll
            for (int mm = 0; mm < 2; ++mm) { const int m = (g & 1) * 2 + mm; float ss = 0.f;
#pragma unroll
                for (int bj = 0; bj < 2; ++bj) {
                    const f32x4 o0 = ((g & 1) ? xc : xa)[mm * 4 + bj * 2] + acc[ai][bj][m][0], o1 = ((g & 1) ? xc : xa)[mm * 4 + bj * 2 + 1] + acc[ai][bj][m][1];
                    u32x4 w; w.x = cvt_pk_bf16(o0[0], o0[1]); w.y = cvt_pk_bf16(o0[2], o0[3]); w.z = cvt_pk_bf16(o1[0], o1[1]); w.w = cvt_pk_bf16(o1[2], o1[3]);
                    wo[mm * 2 + bj] = w;
                    ss += ((o0[0] * o0[0] + o0[1] * o0[1]) + (o0[2] * o0[2] + o0[3] * o0[3])) + ((o1[0] * o1[0] + o1[1] * o1[1]) + (o1[2] * o1[2] + o1[3] * o1[3])); }
                ss += __shfl_xor(ss, 16); ss += __shfl_xor(ss, 32); ssv[mm] = ss; }
            __builtin_amdgcn_sched_barrier(0);
            if (g == 0) EPO_LOAD(xa, 2);
            if (g == 1) EPO_LOAD(xc, 3);
            __builtin_amdgcn_sched_barrier(0);
#pragma unroll
            for (int mm = 0; mm < 2; ++mm) { const int m = (g & 1) * 2 + mm;
#pragma unroll
                for (int bj = 0; bj < 2; ++bj) *(u32x4*)(xp + (size_t)(ai * HALF + m * 16) * ldc + bj * HALF) = wo[mm * 2 + bj];
                if (fq == 0) scr[((((wr * 2 + ai) * 4 + m) * 16) + fr) * 4 + wc] = ssv[mm]; }
            __builtin_amdgcn_sched_barrier(0);
        }
        asm volatile("s_waitcnt lgkmcnt(0)" ::: "memory"); __builtin_amdgcn_s_barrier(); asm volatile("" ::: "memory");
        const int tid = threadIdx.x;
        if (tid < 256) { const f32x4 s4 = *(const PG8_LAS f32x4*)(scr + tid * 4);
            const int row = u.pm * BM + ((tid >> 6) & 1) * HALF + (tid >> 7) * 64 + ((tid >> 4) & 3) * 16 + (tid & 15);
            SS[(size_t)row * 4 + u.pn] = (s4[0] + s4[1]) + (s4[2] + s4[3]); }
    }
#undef EPO_LOAD
};
struct EpiFinal {
    static constexpr bool PERM = true, AFTER_DRAIN = false;
    const bf16_t* xb; float* out; int ldc;
    __device__ __forceinline__ void operator()(const f32x4 (&acc)[2][2][4][2], const Unit& u, int wr, int wc, int fr, int fq) const {
        const int row0 = u.pm * BM + wr * 64 + fr, col0 = u.pn * BM + wc * 32 + 8 * fq;
#pragma unroll
        for (int ai = 0; ai < 2; ++ai)
#pragma unroll
            for (int m = 0; m < 4; ++m) { const size_t off = (size_t)(row0 + ai * HALF + m * 16) * ldc + col0;
#pragma unroll
                for (int bj = 0; bj < 2; ++bj) { const u32x4 w = *(const u32x4*)(xb + off + bj * HALF);
                    const f32x4 b0 = (f32x4){__builtin_bit_cast(float, w.x << 16), __builtin_bit_cast(float, w.x & 0xffff0000u), __builtin_bit_cast(float, w.y << 16), __builtin_bit_cast(float, w.y & 0xffff0000u)};
                    const f32x4 b1 = (f32x4){__builtin_bit_cast(float, w.z << 16), __builtin_bit_cast(float, w.z & 0xffff0000u), __builtin_bit_cast(float, w.w << 16), __builtin_bit_cast(float, w.w & 0xffff0000u)};
                    *(f32x4*)(out + off + bj * HALF) = b0 + acc[ai][bj][m][0]; *(f32x4*)(out + off + bj * HALF + 4) = b1 + acc[ai][bj][m][1]; }
                if (m & 1) asm volatile("" ::: "memory"); }
    }
};

template <class Epi, class Sched, bool ALIGN_EPI = false, bool SP2 = false>
__device__ __forceinline__ void gemm_phase(PG8_LAS unsigned char* lds, const Gemm g, const Sched& S, const Epi& E) {
    const int tid = threadIdx.x, wid = __builtin_amdgcn_readfirstlane(tid >> 6), lane = tid & 63, wr = wid >> 2, wc = wid & 3, fr = lane & 15, fq = lane >> 4;
    const int K = g.K, nt = K / BK;
    unsigned voffA[2], voffB[2];
#pragma unroll
    for (int i = 0; i < 2; ++i) { int R, C; stage_rc(tid * 16 + i * 8192, R, C); const int Rb = Epi::PERM ? ((R & ~31) + perm32(R & 31)) : R;
        voffA[i] = (unsigned)(R * K + C) * 2u; voffB[i] = (unsigned)(Rb * K + C) * 2u; }
    const size_t kstep = (size_t)(BK * 2);
    const size_t hstep = (size_t)HALF * K * 2;
    const size_t tstep = 2 * hstep;
    const unsigned ldsw = (unsigned)wid * 1024u;
    const int aoff = lds_byte(wr * 64 + fr, fq * 8), boff = lds_byte(wc * 32 + fr, fq * 8);
#define PG8_SA(b, h) (((b) * 2 + (h)) * HTB)
#define PG8_SB(b, h) ((4 + (b) * 2 + (h)) * HTB)
#define PG8_STAGE(bufoff, gbase, voff) do { _Pragma("unroll") for (int _i = 0; _i < 2; ++_i) \
        __builtin_amdgcn_global_load_lds((const unsigned*)((const char*)(gbase) + (voff)[_i]), (PG8_LAS unsigned*)(lds + (bufoff) + ldsw + _i * 8192), 16, 0, 0); } while (0)
#define PG8_LDA(dst, b, h) do { _Pragma("unroll") for (int m = 0; m < 4; ++m) _Pragma("unroll") for (int k = 0; k < 2; ++k) dst[m][k] = *(const PG8_LAS bf16x8*)(lds + PG8_SA(b, h) + aoff + m * 2048 + k * 1024); } while (0)
#define PG8_LDB(dst, b, h) do { _Pragma("unroll") for (int n = 0; n < 2; ++n) _Pragma("unroll") for (int k = 0; k < 2; ++k) dst[n][k] = *(const PG8_LAS bf16x8*)(lds + PG8_SB(b, h) + boff + n * 2048 + k * 1024); } while (0)
#define PG8_MMA(ai, bj, At, Bt) do { __builtin_amdgcn_s_setprio(1); _Pragma("unroll") for (int m = 0; m < 4; ++m) _Pragma("unroll") for (int n = 0; n < 2; ++n) _Pragma("unroll") for (int k = 0; k < 2; ++k) \
        acc[ai][bj][m][n] = __builtin_amdgcn_mfma_f32_16x16x32_bf16(Bt[n][k], At[m][k], acc[ai][bj][m][n], 0, 0, 0); __builtin_amdgcn_s_setprio(0); } while (0)
#define PG8_WAIT_V(n) asm volatile("s_waitcnt vmcnt(" #n ")" ::: "memory")
#define PG8_WAIT_L(n) asm volatile("s_waitcnt lgkmcnt(" #n ")" ::: "memory")
#define PG8_BAR __builtin_amdgcn_s_barrier()
#define PG8_SCHED __builtin_amdgcn_sched_barrier(0)
    Unit cur, nxt; int ui = 0;
    if (!S.next(0, cur)) return;
    f32x4 acc[2][2][4][2];
#pragma unroll
    for (int a = 0; a < 2; ++a)
#pragma unroll
        for (int b = 0; b < 2; ++b)
#pragma unroll
            for (int m = 0; m < 4; ++m)
#pragma unroll
                for (int n = 0; n < 2; ++n) acc[a][b][m][n] = (f32x4){0.f, 0.f, 0.f, 0.f};
    bf16x8 At[4][2], B0[2][2], B1[2][2];
    const char* cA = (const char*)g.A + (size_t)cur.pm * tstep; const char* cB = (const char*)g.Bt + (size_t)cur.pn * tstep;
    S.a_ready(cur);
    if constexpr (SP2) {
        PG8_STAGE(PG8_SB(0, 0), cB, voffB); PG8_STAGE(PG8_SB(0, 1), cB + hstep, voffB); PG8_STAGE(PG8_SA(0, 0), cA, voffA); PG8_STAGE(PG8_SA(0, 1), cA + hstep, voffA);
        if (wr == 1) PG8_BAR;
        PG8_WAIT_V(2); PG8_BAR;
        PG8_STAGE(PG8_SB(1, 0), cB + kstep, voffB); PG8_STAGE(PG8_SA(1, 0), cA + kstep, voffA); PG8_STAGE(PG8_SB(1, 1), cB + hstep + kstep, voffB);
        PG8_WAIT_V(6); PG8_BAR;
    } else {
        PG8_STAGE(PG8_SB(0, 0), cB, voffB); PG8_STAGE(PG8_SA(0, 0), cA, voffA); PG8_STAGE(PG8_SB(0, 1), cB + hstep, voffB); PG8_STAGE(PG8_SA(0, 1), cA + hstep, voffA);
        if (wr == 1) PG8_BAR;
        PG8_WAIT_V(4); PG8_BAR;
        PG8_STAGE(PG8_SB(1, 0), cB + kstep, voffB); PG8_STAGE(PG8_SA(1, 0), cA + kstep, voffA); PG8_STAGE(PG8_SB(1, 1), cB + hstep + kstep, voffB);
        PG8_WAIT_V(6); PG8_BAR;
    }
    for (;;) {
        const bool has_next = S.next(ui + 1, nxt);
        const char* nA = has_next ? (const char*)g.A + (size_t)nxt.pm * tstep : cA; const char* nB = has_next ? (const char*)g.Bt + (size_t)nxt.pn * tstep : cB;
#pragma nounroll
        for (int t = 0; t < nt; t += 2) {
            const bool last = (t == nt - 2);
            const char* a1 = cA + (size_t)(t + 1) * kstep;
            const char* a2 = last ? nA : cA + (size_t)(t + 2) * kstep; const char* b2 = last ? nB : cB + (size_t)(t + 2) * kstep;
            const char* a3 = a2 + kstep; const char* b3 = b2 + kstep;
            if (last && has_next) S.a_ready(nxt);
            if constexpr (SP2) {
            PG8_LDB(B0, 0, 0); PG8_LDB(B1, 0, 1); PG8_SCHED; PG8_LDA(At, 0, 0); PG8_STAGE(PG8_SA(1, 1), a1 + hstep, voffA);
            PG8_WAIT_V(8); PG8_WAIT_L(0); PG8_BAR; PG8_MMA(0, 0, At, B0); PG8_MMA(0, 1, At, B1); PG8_BAR; PG8_SCHED;
            PG8_LDA(At, 0, 1); PG8_STAGE(PG8_SB(0, 0), b2, voffB); PG8_STAGE(PG8_SB(0, 1), b2 + hstep, voffB); PG8_STAGE(PG8_SA(0, 0), a2, voffA);
            PG8_WAIT_V(8); PG8_WAIT_L(0); PG8_BAR; PG8_MMA(1, 0, At, B0); PG8_MMA(1, 1, At, B1); PG8_BAR; PG8_SCHED;
            PG8_LDB(B0, 1, 0); PG8_LDB(B1, 1, 1); PG8_SCHED; PG8_LDA(At, 1, 0); PG8_STAGE(PG8_SA(0, 1), a2 + hstep, voffA);
            PG8_WAIT_V(8); PG8_WAIT_L(0); PG8_BAR; PG8_MMA(0, 0, At, B0); PG8_MMA(0, 1, At, B1); PG8_BAR; PG8_SCHED;
            PG8_LDA(At, 1, 1); PG8_STAGE(PG8_SB(1, 0), b3, voffB); PG8_STAGE(PG8_SB(1, 1), b3 + hstep, voffB); PG8_STAGE(PG8_SA(1, 0), a3, voffA);
            PG8_WAIT_V(8); PG8_WAIT_L(0); PG8_BAR; PG8_MMA(1, 0, At, B0); PG8_MMA(1, 1, At, B1); PG8_BAR; PG8_SCHED;
            } else {
            PG8_LDB(B0, 0, 0); PG8_SCHED; PG8_LDA(At, 0, 0); PG8_STAGE(PG8_SA(1, 1), a1 + hstep, voffA);
            PG8_WAIT_L(8); PG8_BAR; PG8_WAIT_L(0); PG8_MMA(0, 0, At, B0); PG8_BAR; PG8_SCHED;
            PG8_LDB(B1, 0, 1); PG8_STAGE(PG8_SB(0, 0), b2, voffB);
            PG8_BAR; PG8_WAIT_L(0); PG8_MMA(0, 1, At, B1); PG8_BAR;
            PG8_LDA(At, 0, 1); PG8_STAGE(PG8_SA(0, 0), a2, voffA);
            PG8_BAR; PG8_WAIT_L(0); PG8_MMA(1, 0, At, B0); PG8_BAR; PG8_SCHED;
            PG8_STAGE(PG8_SB(0, 1), b2 + hstep, voffB);
            PG8_WAIT_V(6); PG8_BAR; PG8_MMA(1, 1, At, B1); PG8_BAR;
            PG8_LDB(B0, 1, 0); PG8_SCHED; PG8_LDA(At, 1, 0); PG8_STAGE(PG8_SA(0, 1), a2 + hstep, voffA);
            PG8_WAIT_L(8); PG8_BAR; PG8_WAIT_L(0); PG8_MMA(0, 0, At, B0); PG8_BAR; PG8_SCHED;
            PG8_LDB(B1, 1, 1); PG8_STAGE(PG8_SB(1, 0), b3, voffB);
            PG8_BAR; PG8_WAIT_L(0); PG8_MMA(0, 1, At, B1); PG8_BAR;
            PG8_LDA(At, 1, 1); PG8_STAGE(PG8_SA(1, 0), a3, voffA);
            PG8_BAR; PG8_WAIT_L(0); PG8_MMA(1, 0, At, B0); PG8_BAR; PG8_SCHED;
            PG8_STAGE(PG8_SB(1, 1), b3 + hstep, voffB);
            PG8_WAIT_V(6); PG8_BAR; PG8_MMA(1, 1, At, B1); PG8_BAR;
            }
        }
        if constexpr (ALIGN_EPI) { if (wr == 0) PG8_BAR; }
        if constexpr (!Epi::AFTER_DRAIN) { E(acc, cur, wr, wc, fr, fq); S.done(cur); }
        if (!has_next) break;
#pragma unroll
        for (int a = 0; a < 2; ++a)
#pragma unroll
            for (int b = 0; b < 2; ++b)
#pragma unroll
                for (int m = 0; m < 4; ++m)
#pragma unroll
                    for (int n = 0; n < 2; ++n) acc[a][b][m][n] = (f32x4){0.f, 0.f, 0.f, 0.f};
        cur = nxt; cA = nA; cB = nB; ++ui;
        if constexpr (ALIGN_EPI) { if (wr == 1) PG8_BAR; }
    }
    PG8_WAIT_V(0);
    if constexpr (!ALIGN_EPI) { if (wr == 0) PG8_BAR; }
    PG8_BAR;
#undef PG8_SA
#undef PG8_SB
#undef PG8_STAGE
#undef PG8_LDA
#undef PG8_LDB
#undef PG8_MMA
#undef PG8_WAIT_V
#undef PG8_WAIT_L
#undef PG8_BAR
#undef PG8_SCHED
}
}

constexpr int NWAVES = 8;
constexpr int N_LAUNCHES = MK_N_LAUNCHES;
constexpr int PER_PHASE = 10;
constexpr int BATCH = 16, SEQ = 2048, D = 1024, M = BATCH * SEQ;
constexpr int NH = 8, HD = 64, AW = 512, RW = 512;
constexpr int RWKV_COLS = 1792, IN_COLS = 3328, FF = 2816, NGU = 2 * FF, NLORA = 1536, KLORA = 256;
constexpr int PC_Q = 0, PC_K = 512, PC_V = 1024, PC_RW = 1536;
constexpr int RC_R = 0, RC_K = 512, RC_V = 1024, RC_L = 1536;
constexpr int WLF_K01 = 8 * 2 * 4 * 64 * 8, WLF_ELEMS = 4 * WLF_K01;
constexpr float NORM_EPS = 1e-6f, LNX_EPS = 64e-5f;
constexpr float LOG2E = 1.4426950408889634f;

constexpr size_t MiB = 1u << 20;
constexpr size_t WS_CTL = 0, CTL_ZERO_BYTES = 1 * MiB;
constexpr size_t WS_WIN = 2 * MiB;
constexpr size_t WS_WOUT = 9 * MiB;
constexpr size_t WS_WGU = 11 * MiB;
constexpr size_t WS_WDN = 22 * MiB;
constexpr size_t WS_WL = 28 * MiB;
constexpr size_t WS_BON = 29 * MiB;
constexpr size_t WS_SS = 30 * MiB;
constexpr size_t WS_XN = 32 * MiB;
constexpr size_t WS_PROJ = 96 * MiB;
constexpr size_t WS_A2 = 304 * MiB;
constexpr size_t WS_DAG = 320 * MiB;
constexpr size_t WS_ML = 416 * MiB;
constexpr size_t WS_END = 424 * MiB;
constexpr size_t DO_PO = 0, DO_Y = 96 * MiB;
constexpr int CW_TMO = 0, CW_CODE = 1;
constexpr int CW_BAR = 4096;
constexpr int CW_ATTQ = 8192;
constexpr int CW_P5B = 8448;
constexpr int P5A_ROWS = (M / 16) * P5A_16;
constexpr int CW_BAR_SUB = 16384;

constexpr int LDS_BYTES = 163840;
constexpr int RING_OFF = 0, RING_BYTES = LDS_BYTES - 1024;
constexpr int LDSCTL_OFF = RING_BYTES, MISC_OFF = LDSCTL_OFF + 320;

#define GAS __attribute__((address_space(1)))
#define LAS __attribute__((address_space(3)))
typedef unsigned short bf16;
typedef unsigned v4u __attribute__((ext_vector_type(4)));
typedef unsigned v2u __attribute__((ext_vector_type(2)));
typedef float f32x4 __attribute__((ext_vector_type(4)));
typedef float f32x2 __attribute__((ext_vector_type(2)));
typedef float f32x16 __attribute__((ext_vector_type(16)));
typedef short bf16x8 __attribute__((ext_vector_type(8)));
typedef short s16x4 __attribute__((ext_vector_type(4)));
typedef GAS unsigned gu32;
#define RLX_AGENT __ATOMIC_RELAXED, __HIP_MEMORY_SCOPE_AGENT
#define LDS_WAIT() asm volatile("s_waitcnt lgkmcnt(0)" ::: "memory")
#define VM_WAIT() asm volatile("s_waitcnt vmcnt(0)" ::: "memory")
__device__ __forceinline__ unsigned f2bf(float f) { unsigned u = __builtin_bit_cast(unsigned, f); return (u + 0x7fffu + ((u >> 16) & 1u)) >> 16; }
typedef float f32x2_t __attribute__((ext_vector_type(2))); typedef __bf16 bf16x2_t __attribute__((ext_vector_type(2)));
__device__ __forceinline__ unsigned cvt2(float lo, float hi) { f32x2_t v = {lo, hi}; bf16x2_t b = __builtin_convertvector(v, bf16x2_t); return __builtin_bit_cast(unsigned, b); }
__device__ __forceinline__ unsigned pk2(float lo, float hi) { return cvt2(lo, hi); }
__device__ __forceinline__ float bflo(unsigned w) { return __builtin_bit_cast(float, w << 16); }
__device__ __forceinline__ float bfhi(unsigned w) { return __builtin_bit_cast(float, w & 0xffff0000u); }
__device__ __forceinline__ float fsig(float x) { return __builtin_amdgcn_rcpf(1.0f + __builtin_amdgcn_exp2f(-LOG2E * x)); }

#define XB_TMO      128
#define XB_XCNT(j)  (256  + 64 * (j))
#define XB_XSUB(j)  (1280 + 64 * (j))
#define XB_XGEN(j)  (2304 + 64 * (j))
#define XB_TOP      3328
#define XB_TOPGEN   3392
#define XCD_BAR_WORDS 3456
#define XB_SPIN_CAP (1u << 18)
__device__ __forceinline__ unsigned xb_ld(unsigned* p)              { return __hip_atomic_load(p, __ATOMIC_RELAXED, __HIP_MEMORY_SCOPE_AGENT); }
__device__ __forceinline__ unsigned xb_add(unsigned* p, unsigned v) { return __hip_atomic_fetch_add(p, v, __ATOMIC_RELAXED, __HIP_MEMORY_SCOPE_AGENT); }
__device__ __forceinline__ unsigned xb_xcc_id() { return (unsigned)__builtin_amdgcn_s_getreg((3 << 11) | 20) & 0xFu; }
#define XB_SPIN(cond, bar) do { unsigned _sp = 0; while (cond) { __builtin_amdgcn_s_sleep(1); \
    if ((++_sp & 255u) == 0u) { if (xb_ld(&(bar)[XB_TMO])) break; if (_sp > XB_SPIN_CAP) { atomicAdd(&(bar)[XB_TMO], 1u); break; } } } } while (0)
struct XcdBarrier { unsigned* bar; unsigned x; volatile LAS unsigned* st; unsigned total; };
__device__ __forceinline__ XcdBarrier xcd_barrier_post(unsigned* bar, volatile LAS unsigned* st, unsigned total) {
    XcdBarrier b; b.bar = bar; b.x = xb_xcc_id(); b.st = st; b.total = total;
    if (threadIdx.x == 0) (void)xb_add(&bar[XB_XCNT(b.x)], 1u);
    return b;
}
__device__ __forceinline__ void xcd_barrier_complete(unsigned* bar, unsigned x, unsigned G, unsigned& nloc, unsigned& nx) {
    unsigned sum, cnt, mine, sp = 0u;
    for (;;) {
        sum = 0u; cnt = 0u; mine = 0u;
#pragma unroll
        for (unsigned j = 0; j < 16; ++j) { const unsigned c = xb_ld(&bar[XB_XCNT(j)]); sum += c; cnt += (c > 0u) ? 1u : 0u; mine = (j == x) ? c : mine; }
        if (sum == G) break;
        __builtin_amdgcn_s_sleep(1);
        if ((++sp & 255u) == 0u) { if (xb_ld(&bar[XB_TMO])) break; if (sp > XB_SPIN_CAP) { atomicAdd(&bar[XB_TMO], 1u); break; } }
    }
    nloc = mine > 0u ? mine : 1u; nx = cnt > 0u ? cnt : 1u;
}
__device__ __forceinline__ void xcd_barrier(const XcdBarrier& b) {
    asm volatile("s_waitcnt vmcnt(0)" ::: "memory");
    __syncthreads();
    if (threadIdx.x == 0) {
        unsigned* bar = b.bar;
        __builtin_amdgcn_s_waitcnt(0);
        unsigned nloc = b.st[0], nx = b.st[1];
        if (nloc == 0u) { xcd_barrier_complete(bar, b.x, b.total, nloc, nx); b.st[0] = nloc; b.st[1] = nx; }
        const unsigned old = xb_add(&bar[XB_XSUB(b.x)], 1u);
        const unsigned gen = old / nloc;
        if (old + 1u == (gen + 1u) * nloc) {
            __builtin_amdgcn_fence(__ATOMIC_RELEASE, "agent");
            asm volatile("s_waitcnt vmcnt(0)" ::: "memory");
            const unsigned og = xb_add(&bar[XB_TOP], 1u);
            const unsigned tg = og / nx;
            if (og + 1u == (tg + 1u) * nx) xb_add(&bar[XB_TOPGEN], 1u);
            else XB_SPIN(xb_ld(&bar[XB_TOPGEN]) == tg, bar);
            __builtin_amdgcn_fence(__ATOMIC_ACQUIRE, "agent");
            xb_add(&bar[XB_XGEN(b.x)], 1u);
            asm volatile("s_waitcnt vmcnt(0)" ::: "memory");
        } else {
            XB_SPIN(xb_ld(&bar[XB_XGEN(b.x)]) == gen, bar);
            __builtin_amdgcn_fence(__ATOMIC_ACQUIRE, "agent");
            asm volatile("s_waitcnt vmcnt(0)" ::: "memory");
        }
    }
    __syncthreads();
}

struct Frame {
    LAS unsigned char* lds;
    volatile LAS unsigned* MISC;
    gu32* ctl;
    int tid, lane, wave;
    int vcu, G;
    float* out; unsigned char* ws;
};
struct Args { const float* in[22]; float* out; unsigned char* ws; int ph_lo, ph_hi, li, pad; };
enum { I_X = 0, I_N1G, I_WIN, I_QNG, I_KNG, I_AOG, I_MU, I_W0, I_W2, I_A0, I_A2, I_G2, I_KK, I_KA, I_RK, I_LNG, I_LNB, I_WOUT, I_N2G, I_WG, I_WU, I_WD };

__device__ __forceinline__ float wave_sum(float v) {
#pragma unroll
    for (int o = 1; o < 64; o <<= 1) v += __shfl_xor(v, o);
    return v;
}
__device__ __forceinline__ float red16(float x) {
    x += __builtin_bit_cast(float, __builtin_amdgcn_update_dpp(0, __builtin_bit_cast(int, x), 0x128, 0xf, 0xf, false));
    x += __builtin_bit_cast(float, __builtin_amdgcn_update_dpp(0, __builtin_bit_cast(int, x), 0x124, 0xf, 0xf, false));
    x += __builtin_bit_cast(float, __builtin_amdgcn_update_dpp(0, __builtin_bit_cast(int, x), 0x122, 0xf, 0xf, false));
    x += __builtin_bit_cast(float, __builtin_amdgcn_update_dpp(0, __builtin_bit_cast(int, x), 0x121, 0xf, 0xf, false));
    return x;
}

constexpr int TR_SCR = 64 * 65 * 4 + 256;
__device__ __forceinline__ int tr_row(int rmode, int n) {
    return rmode == 0 ? n : rmode == 3 ? (n < 1024 ? ((n >> 8) * 256 + ((n >> 5) & 1) * 128 + ((n >> 6) & 3) * 32 + (n & 31)) : n) : ((n >> 7) * 256 + (n & 127) + (rmode == 2 ? 128 : 0));
}
__device__ __forceinline__ void p0_transpose_item(const float* W, int K, int N, bf16* WT, int rmode, LAS float* scr, int item, int lane, const float* ksc = nullptr) {
    const int nblk = N / 64, kb = item / nblk, nb = item % nblk, k0 = 64 * kb, n0 = 64 * nb;
    const int ks = lane >> 4, n4 = (lane & 15) * 4;
    f32x4 v[16];
#pragma unroll
    for (int i = 0; i < 16; ++i) v[i] = *(const GAS f32x4*)((const GAS float*)W + (size_t)(k0 + 4 * i + ks) * N + n0 + n4);
#pragma unroll
    for (int i = 0; i < 16; ++i) { const int kk = 4 * i + ks; const float sc = ksc ? ksc[k0 + kk] : 1.0f;
        scr[kk * 65 + n4 + 0] = v[i].x * sc; scr[kk * 65 + n4 + 1] = v[i].y * sc; scr[kk * 65 + n4 + 2] = v[i].z * sc; scr[kk * 65 + n4 + 3] = v[i].w * sc; }
    LDS_WAIT(); asm volatile("" ::: "memory");
    GAS v4u* dst = (GAS v4u*)(WT + (size_t)tr_row(rmode, n0 + lane) * K + k0);
#pragma unroll
    for (int j = 0; j < 8; ++j) { const LAS float* c = scr + (8 * j) * 65 + lane;
        v4u o; o.x = pk2(c[0 * 65], c[1 * 65]); o.y = pk2(c[2 * 65], c[3 * 65]); o.z = pk2(c[4 * 65], c[5 * 65]); o.w = pk2(c[6 * 65], c[7 * 65]);
        dst[j] = o; }
    LDS_WAIT(); asm volatile("" ::: "memory");
}
template <int NR> __device__ __forceinline__ void rms_rows_to_bf16(int lane, const float* x0, size_t rstride, const float* g, bf16* o0, size_t ostride) {
    const GAS f32x4* gr = (const GAS f32x4*)g + lane;
    f32x4 v[NR][4];
#pragma unroll
    for (int r = 0; r < NR; ++r) { const GAS f32x4* xr = (const GAS f32x4*)(x0 + r * rstride) + lane;
#pragma unroll
        for (int j = 0; j < 4; ++j) v[r][j] = xr[64 * j]; }
    f32x4 gg[4];
#pragma unroll
    for (int j = 0; j < 4; ++j) gg[j] = gr[64 * j];
#pragma unroll
    for (int r = 0; r < NR; ++r) { float s = 0.f;
#pragma unroll
        for (int j = 0; j < 4; ++j) s += (v[r][j].x * v[r][j].x + v[r][j].y * v[r][j].y) + (v[r][j].z * v[r][j].z + v[r][j].w * v[r][j].w);
        const float rstd = 1.f / sqrtf(wave_sum(s) * (1.f / D) + NORM_EPS);
        GAS unsigned long long* o8 = (GAS unsigned long long*)(o0 + r * ostride) + lane;
#pragma unroll
        for (int j = 0; j < 4; ++j)
            o8[64 * j] = (unsigned long long)pk2(v[r][j].x * rstd * gg[j].x, v[r][j].y * rstd * gg[j].y) | ((unsigned long long)pk2(v[r][j].z * rstd * gg[j].z, v[r][j].w * rstd * gg[j].w) << 32); }
}

__device__ __forceinline__ void p0_prologue(Frame& F, const Args& AR) {
    LAS float* scr = (LAS float*)(F.lds + RING_OFF + F.wave * TR_SCR);
    const int gw = F.vcu * NWAVES + F.wave, NGW = F.G * NWAVES;
    bf16* Win_t = (bf16*)(F.ws + WS_WIN); bf16* Wout_t = (bf16*)(F.ws + WS_WOUT); bf16* Wgu_t = (bf16*)(F.ws + WS_WGU); bf16* Wdn_t = (bf16*)(F.ws + WS_WDN); bf16* Wl_t = (bf16*)(F.ws + WS_WL);
    constexpr int I_IN = (D / 64) * (IN_COLS / 64);
    for (int it = gw; it < I_IN; it += NGW) p0_transpose_item(AR.in[I_WIN], D, IN_COLS, Win_t, 3, scr, it, F.lane);
    for (int e = (F.vcu * NWAVES * 64 + F.tid); e < WLF_ELEMS; e += F.G * NWAVES * 64) {
        const int kind = e < WLF_K01 ? 0 : (e < 2 * WLF_K01 ? 1 : 2), r = e - (kind == 2 ? 2 * WLF_K01 : kind * WLF_K01);
        const int ee = r & 7, ln = (r >> 3) & 63, b = (r >> 9) & 3, s = kind == 2 ? (r >> 11) & 3 : (r >> 11) & 1, g = kind == 2 ? r >> 13 : r >> 12;
        const int k = 32 * s + 8 * (ln >> 4) + ee, c = 64 * g + 32 * (b >> 1) + 8 * ((ln & 15) >> 2) + 4 * (b & 1) + (ln & 3);
        const float* W = kind == 0 ? AR.in[I_W2] : (kind == 1 ? AR.in[I_A2] : AR.in[I_G2]);
        Wl_t[e] = (bf16)f2bf(W[k * 512 + c]);
    }
    bf16* XN = (bf16*)(F.ws + WS_XN);
    for (int m = gw * 4; m < M; m += NGW * 4) rms_rows_to_bf16<4>(F.lane, AR.in[I_X] + (size_t)m * D, D, AR.in[I_N1G], XN + (size_t)m * D, D);
}

constexpr int LR_ROWB = 528;
#define MFMA16(a, b, c) __builtin_amdgcn_mfma_f32_16x16x32_bf16((a), (b), (c), 0, 0, 0)
template <int KIND> __device__ __forceinline__ void p3_kind(const LAS unsigned char* At, const bf16* WLF, bf16* DAG, const float* bias, int m0, int wave, int lane) {
    constexpr int KS = KIND == 2 ? 4 : 2, KOFF = KIND == 0 ? 0 : (KIND == 1 ? 64 : 128);
    const int q = lane >> 4, t = lane & 15;
    const GAS v4u* wf = (const GAS v4u*)(WLF + (KIND == 2 ? 2 * WLF_K01 : KIND * WLF_K01)) + (size_t)wave * KS * 4 * 64 + lane;
    bf16x8 Af[KS][4];
#pragma unroll
    for (int s = 0; s < KS; ++s)
#pragma unroll
        for (int b = 0; b < 4; ++b) Af[s][b] = __builtin_bit_cast(bf16x8, wf[(s * 4 + b) * 64]);
    f32x4 bs[2][2];
    if (KIND != 2) {
#pragma unroll
        for (int p = 0; p < 2; ++p) { const GAS f32x4* bp = (const GAS f32x4*)((const GAS float*)bias + 64 * wave + 32 * p + 8 * q); bs[p][0] = bp[0]; bs[p][1] = bp[1]; }
    }
    const LAS unsigned char* ap = At + t * LR_ROWB + (KOFF + 8 * q) * 2;
    GAS bf16* dp = (GAS bf16*)DAG + (size_t)(m0 + t) * NLORA + KIND * 512 + 64 * wave + 8 * q;
    const f32x4 z4 = {0.f, 0.f, 0.f, 0.f};
#pragma unroll 2
    for (int tb = 0; tb < 8; ++tb) {
        bf16x8 Bf[KS];
#pragma unroll
        for (int s = 0; s < KS; ++s) Bf[s] = *(const LAS bf16x8*)(ap + tb * 16 * LR_ROWB + 64 * s);
        f32x4 acc[4];
#pragma unroll
        for (int b = 0; b < 4; ++b) { acc[b] = MFMA16(Af[0][b], Bf[0], z4);
#pragma unroll
            for (int s = 1; s < KS; ++s) acc[b] = MFMA16(Af[s][b], Bf[s], acc[b]); }
#pragma unroll
        for (int p = 0; p < 2; ++p) {
            f32x4 v0 = acc[2 * p], v1 = acc[2 * p + 1];
            if (KIND != 2) {
                v0 += bs[p][0]; v1 += bs[p][1];
#pragma unroll
                for (int e = 0; e < 4; ++e) { v0[e] = fsig(v0[e]); v1[e] = fsig(v1[e]); }
                if (KIND == 0) { v0 *= -0.6065306597126334f; v1 *= -0.6065306597126334f; }
            }
            v4u w; w.x = cvt2(v0[0], v0[1]); w.y = cvt2(v0[2], v0[3]); w.z = cvt2(v1[0], v1[1]); w.w = cvt2(v1[2], v1[3]);
            *(GAS v4u*)(dp + (size_t)tb * 16 * NLORA + 32 * p) = w;
        }
    }
}
__device__ __forceinline__ void p3_lora(Frame& F, const Args& AR) {
    const int lane = F.lane, wave = F.wave;
    const bf16* PROJ = (const bf16*)(F.ws + WS_PROJ); const bf16* WLF = (const bf16*)(F.ws + WS_WL); bf16* DAG = (bf16*)(F.ws + WS_DAG);
    LAS unsigned char* At = F.lds + RING_OFF;
    const f32x4 mu4 = *(const f32x4*)(AR.in[I_MU] + RC_L + 4 * lane);
    for (int u = F.vcu; u < M / 128; u += F.G) {
        const int m0 = u * 128, t0 = 16 * wave;
        const GAS bf16* row = (const GAS bf16*)PROJ + (size_t)(m0 + t0) * IN_COLS + PC_RW + RC_L + 4 * lane;
        v2u w[17];
        w[0] = (v2u){0u, 0u};
        if (((m0 + t0) & (SEQ - 1)) != 0) w[0] = *(const GAS v2u*)(row - IN_COLS);
#pragma unroll
        for (int i = 0; i < 16; ++i) w[i + 1] = *(const GAS v2u*)(row + (size_t)i * IN_COLS);
#pragma unroll
        for (int i = 0; i < 16; ++i) {
            const v2u cu = w[i + 1], pv = w[i];
            const float c4[4] = {bflo(cu.x), bfhi(cu.x), bflo(cu.y), bfhi(cu.y)}, p4[4] = {bflo(pv.x), bfhi(pv.x), bflo(pv.y), bfhi(pv.y)};
            float xs[4];
#pragma unroll
            for (int e = 0; e < 4; ++e) { const float v = c4[e] + (p4[e] - c4[e]) * mu4[e];
                if (lane < 16) { const float tt = __builtin_amdgcn_exp2f(2.f * LOG2E * v); xs[e] = 1.f - 2.f * __builtin_amdgcn_rcpf(tt + 1.f); }
                else if (lane < 32) xs[e] = v;
                else xs[e] = fsig(v); }
            *(LAS v2u*)(At + (t0 + i) * LR_ROWB + 8 * lane) = (v2u){pk2(xs[0], xs[1]), pk2(xs[2], xs[3])};
        }
        __syncthreads();
        p3_kind<0>(At, WLF, DAG, AR.in[I_W0], m0, wave, lane);
        p3_kind<1>(At, WLF, DAG, AR.in[I_A0], m0, wave, lane);
        p3_kind<2>(At, WLF, DAG, nullptr, m0, wave, lane);
        __syncthreads();
    }
}

__device__ __forceinline__ float red8(float x) {
    x += __builtin_bit_cast(float, __builtin_amdgcn_update_dpp(0, __builtin_bit_cast(int, x), 0xB1, 0xf, 0xf, false));
    x += __builtin_bit_cast(float, __builtin_amdgcn_update_dpp(0, __builtin_bit_cast(int, x), 0x4E, 0xf, 0xf, false));
    x += __builtin_bit_cast(float, __builtin_amdgcn_update_dpp(0, __builtin_bit_cast(int, x), 0x141, 0xf, 0xf, false));
    return x;
}
__device__ __forceinline__ float redrows(float x) {
    { auto r = __builtin_amdgcn_permlane16_swap(__float_as_uint(x), __float_as_uint(x), false, false); x = __uint_as_float(r[0]) + __uint_as_float(r[1]); }
    { auto r = __builtin_amdgcn_permlane32_swap(__float_as_uint(x), __float_as_uint(x), false, false); x = __uint_as_float(r[0]) + __uint_as_float(r[1]); }
    return x;
}
constexpr int CS = 16, NCHUNK = SEQ / CS, NHELP = 4, NSTATE = 4, NIT = (NCHUNK + NHELP - 1) / NHELP;
constexpr int ROWB = 144, TILEB = 40;
constexpr int SL_A = 0, SL_R = 16 * ROWB, SL_B = 32 * ROWB, SL_K = 48 * ROWB, SL_V = 64 * ROWB, SL_T = 80 * ROWB, SL_LAK = SL_T + 16 * TILEB, SL_LRB = SL_LAK + 16 * TILEB, SL_LRK = SL_LRB + 16 * TILEB,
              SL_G = SL_LRK + 16 * TILEB, SL_BON = SL_G + 256, SL_INV = SL_BON + 64, SL_BYTES = SL_INV + 64;
static_assert(SL_BYTES % 16 == 0 && SL_T % 8 == 0, "slot alignment");
constexpr int SC_CONST = 2 * NHELP * SL_BYTES;
constexpr int SC_YL = SC_CONST + 6 * 64 * 4, YL_BYTES = NHELP * CS * 256;
constexpr int SC_TS = SC_YL + 2 * YL_BYTES;
static_assert(SC_TS + NSTATE * NHELP * 16 * TILEB <= RING_BYTES && NHELP * CS * 8 == 2 * NSTATE * 64 && NCHUNK % NHELP == 0 && NHELP % 2 == 0, "scan LDS");
struct HReg { v4u r[2], k[2], v[2], pr[2], pk[2], pv[2], e[2], a[2]; };
__device__ __forceinline__ void helper_load(HReg& R, const bf16* PROJ, const bf16* DAG, int tok, int h, int kg) {
    const GAS bf16* row = (const GAS bf16*)PROJ + (size_t)tok * IN_COLS + PC_RW + h * 64 + 16 * kg;
    const GAS bf16* rowp = row - IN_COLS;
    const GAS bf16* dr = (const GAS bf16*)DAG + (size_t)tok * NLORA + h * 64 + 16 * kg;
    asm volatile("" : "+v"(row)); asm volatile("" : "+v"(rowp)); asm volatile("" : "+v"(dr));
    const bool hp = (tok & (SEQ - 1)) != 0;
#pragma unroll
    for (int i = 0; i < 2; ++i) {
        R.r[i] = *(const GAS v4u*)(row + RC_R + 8 * i); R.k[i] = *(const GAS v4u*)(row + RC_K + 8 * i); R.v[i] = *(const GAS v4u*)(row + RC_V + 8 * i);
        if (hp) { R.pr[i] = *(const GAS v4u*)(rowp + RC_R + 8 * i); R.pk[i] = *(const GAS v4u*)(rowp + RC_K + 8 * i); R.pv[i] = *(const GAS v4u*)(rowp + RC_V + 8 * i); }
        else { R.pr[i] = (v4u){0u, 0u, 0u, 0u}; R.pk[i] = R.pr[i]; R.pv[i] = R.pr[i]; }
        R.e[i] = *(const GAS v4u*)(dr + 8 * i); R.a[i] = *(const GAS v4u*)(dr + 512 + 8 * i);
    }
}
__device__ __forceinline__ void unpack4(const unsigned w0, const unsigned w1, float (&x)[4]) { x[0] = bflo(w0); x[1] = bfhi(w0); x[2] = bflo(w1); x[3] = bfhi(w1); }
__device__ __forceinline__ float dpp_shr(float x, const int ctrl_sel) {
    int r;
    if (ctrl_sel == 1) r = __builtin_amdgcn_update_dpp(0, __builtin_bit_cast(int, x), 0x111, 0xf, 0xf, true);
    else if (ctrl_sel == 2) r = __builtin_amdgcn_update_dpp(0, __builtin_bit_cast(int, x), 0x112, 0xf, 0xf, true);
    else if (ctrl_sel == 4) r = __builtin_amdgcn_update_dpp(0, __builtin_bit_cast(int, x), 0x114, 0xf, 0xf, true);
    else r = __builtin_amdgcn_update_dpp(0, __builtin_bit_cast(int, x), 0x118, 0xf, 0xf, true);
    return __builtin_bit_cast(float, r);
}
__device__ __forceinline__ unsigned cvt2s(float lo, float hi) { asm volatile("" : "+v"(lo), "+v"(hi)); return cvt2(lo, hi); }
__device__ __forceinline__ bf16x8 mk8(unsigned a, unsigned b, unsigned c, unsigned d) { return __builtin_bit_cast(bf16x8, (v4u){a, b, c, d}); }
__device__ __forceinline__ bf16x8 accB(const f32x4 v) { return mk8(cvt2(v[0], v[1]), cvt2(v[2], v[3]), 0u, 0u); }
__device__ __forceinline__ v2u trd(const LAS unsigned char* p) { typedef short v4i16_t __attribute__((ext_vector_type(4)));
    return __builtin_bit_cast(v2u, __builtin_amdgcn_ds_read_tr16_b64_v4i16((LAS v4i16_t*)p)); }
#define PIN_PTR(p) asm volatile("" : "+v"(p))

#define HR_UNPACK(dst, arr, gp) do { if ((gp) & 1) unpack4(R.arr[(gp) >> 1].z, R.arr[(gp) >> 1].w, dst); else unpack4(R.arr[(gp) >> 1].x, R.arr[(gp) >> 1].y, dst); } while (0)
__device__ __forceinline__ void helper_chunk(LAS unsigned char* slot, const LAS float* cst, HReg& R, bool prefetch, const bf16* PROJ, const bf16* DAG, float* BON, int tok, int h, int lane) {
    const int t = lane & 15, kg = lane >> 4;
    LAS unsigned char* p_row = slot + t * ROWB + kg * 16;
    LAS unsigned char* p_v = slot + SL_V + t * ROWB + kg * 32;
    LAS unsigned char* p_tw = slot + t * TILEB + kg * 8;
    LAS unsigned char* p_g = slot + SL_G + kg * 16;
    const LAS float* p_c = cst + 16 * kg;
    PIN_PTR(p_row); PIN_PTR(p_v); PIN_PTR(p_tw); PIN_PTR(p_g); PIN_PTR(p_c);
    float E[16], G[16], GI[16], GP[16];
#pragma unroll
    for (int gp = 0; gp < 4; ++gp) { float e[4]; HR_UNPACK(e, e, gp);
#pragma unroll
        for (int i = 0; i < 4; ++i) E[4 * gp + i] = e[i]; }
#pragma unroll
    for (int q = 0; q < 16; ++q) E[q] += dpp_shr(E[q], 1);
#pragma unroll
    for (int q = 0; q < 16; ++q) E[q] += dpp_shr(E[q], 2);
#pragma unroll
    for (int q = 0; q < 16; ++q) E[q] += dpp_shr(E[q], 4);
#pragma unroll
    for (int q = 0; q < 16; ++q) E[q] += dpp_shr(E[q], 8);
#pragma unroll
    for (int q = 0; q < 16; ++q) { G[q] = __builtin_amdgcn_exp2f(LOG2E * E[q]); GI[q] = __builtin_amdgcn_exp2f(-LOG2E * E[q]); }
#pragma unroll
    for (int q = 0; q < 16; ++q) { const float gpv = dpp_shr(G[q], 1); GP[q] = (t == 0) ? 1.f : gpv; }
    if (t == 15) {
#pragma unroll
        for (int gp = 0; gp < 4; ++gp) *(LAS f32x4*)(p_g + gp * 64) = (f32x4){G[4 * gp], G[4 * gp + 1], G[4 * gp + 2], G[4 * gp + 3]};
    }
    float ss = 0.f, bon = 0.f;
#pragma unroll
    for (int gp = 0; gp < 4; ++gp) {
        float r[4], k[4], v[4], pr[4], pk[4], pv[4], a[4];
        HR_UNPACK(r, r, gp); HR_UNPACK(k, k, gp); HR_UNPACK(v, v, gp); HR_UNPACK(pr, pr, gp); HR_UNPACK(pk, pk, gp); HR_UNPACK(pv, pv, gp); HR_UNPACK(a, a, gp);
        const f32x4 mur = *(const LAS f32x4*)(p_c + 0 * 64 + 4 * gp), muk = *(const LAS f32x4*)(p_c + 1 * 64 + 4 * gp), muv = *(const LAS f32x4*)(p_c + 2 * 64 + 4 * gp);
        const f32x4 kkc = *(const LAS f32x4*)(p_c + 3 * 64 + 4 * gp), kac = *(const LAS f32x4*)(p_c + 4 * 64 + 4 * gp), rkc = *(const LAS f32x4*)(p_c + 5 * 64 + 4 * gp);
        float xv[4], At[4], Rt[4], Bt[4], Kt[4];
#pragma unroll
        for (int i = 0; i < 4; ++i) { const int q = 4 * gp + i;
            const float xr = r[i] + (pr[i] - r[i]) * mur[i], xk = k[i] + (pk[i] - k[i]) * muk[i]; xv[i] = v[i] + (pv[i] - v[i]) * muv[i];
            const float kkv = xk * kkc[i], kpv = xk * (1.f + (a[i] - 1.f) * kac[i]); ss += kkv * kkv; bon += xr * kpv * rkc[i];
            At[i] = -kkv * GP[q]; Rt[i] = xr * G[q]; Bt[i] = kkv * a[i] * GI[q]; Kt[i] = kpv * GI[q]; }
        *(LAS v2u*)(p_v + gp * 8) = (v2u){cvt2s(xv[0], xv[1]), cvt2s(xv[2], xv[3])};
        const int co = (gp >> 1) * 64 + (gp & 1) * 8;
        *(LAS v2u*)(p_row + SL_A + co) = (v2u){cvt2s(At[0], At[1]), cvt2s(At[2], At[3])}; *(LAS v2u*)(p_row + SL_R + co) = (v2u){cvt2s(Rt[0], Rt[1]), cvt2s(Rt[2], Rt[3])};
        *(LAS v2u*)(p_row + SL_B + co) = (v2u){cvt2s(Bt[0], Bt[1]), cvt2s(Bt[2], Bt[3])}; *(LAS v2u*)(p_row + SL_K + co) = (v2u){cvt2s(Kt[0], Kt[1]), cvt2s(Kt[2], Kt[3])};
    }
    ss = redrows(ss); bon = redrows(bon);
    const float inv = __builtin_amdgcn_rsqf(fmaxf(ss, 1e-24f));
    if (kg == 0) { *(LAS float*)(slot + SL_BON + t * 4) = bon; *(LAS float*)(slot + SL_INV + t * 4) = inv; }
    if (prefetch) helper_load(R, PROJ, DAG, tok + NHELP * CS, h, kg);
    const bf16x8 FA0 = *(const LAS bf16x8*)(p_row + SL_A), FA1 = *(const LAS bf16x8*)(p_row + SL_A + 64), FR0 = *(const LAS bf16x8*)(p_row + SL_R), FR1 = *(const LAS bf16x8*)(p_row + SL_R + 64);
    const bf16x8 FB0 = *(const LAS bf16x8*)(p_row + SL_B), FB1 = *(const LAS bf16x8*)(p_row + SL_B + 64), FK0 = *(const LAS bf16x8*)(p_row + SL_K), FK1 = *(const LAS bf16x8*)(p_row + SL_K + 64);
    const f32x4 z4 = (f32x4){0.f, 0.f, 0.f, 0.f};
    f32x4 Lab = MFMA16(FA0, FB0, z4); Lab = MFMA16(FA1, FB1, Lab);
    f32x4 Lak = MFMA16(FA0, FK0, z4); Lak = MFMA16(FA1, FK1, Lak);
    f32x4 Lrb = MFMA16(FR0, FB0, z4); Lrb = MFMA16(FR1, FB1, Lrb);
    f32x4 Lrk = MFMA16(FR0, FK0, z4); Lrk = MFMA16(FR1, FK1, Lrk);
    const int s = t;
#pragma unroll
    for (int r = 0; r < 4; ++r) { const int tt = 4 * kg + r;
        Lab[r] = tt > s ? Lab[r] : 0.f; Lak[r] = tt > s ? Lak[r] : 0.f; Lrb[r] = tt >= s ? Lrb[r] : 0.f; Lrk[r] = tt >= s ? Lrk[r] : 0.f; }
    { const f32x4 ir = *(const LAS f32x4*)(slot + SL_INV + 16 * kg);
      Lab = Lab * ir * inv; }
#define WR_TILE(off, X) (*(LAS v2u*)(p_tw + (off)) = (v2u){cvt2((X)[0], (X)[1]), cvt2((X)[2], (X)[3])})
    WR_TILE(SL_LAK, Lak); WR_TILE(SL_LRB, Lrb); WR_TILE(SL_LRK, Lrk); WR_TILE(SL_T, Lab);
#undef WR_TILE
}

struct SOps { bf16x8 a0, a1, r0, r1; v2u vt, lak, lrb, lrk, bb[4], kk2[4]; f32x4 gm[4], bn, iv; };
__device__ __forceinline__ void state_load(SOps& O, const LAS unsigned char* slot, int lane, int wv) {
    const int c = lane & 15, g = lane >> 4, q4 = 4 * g + (c >> 2), pp = c & 3;
    const LAS unsigned char* p128 = slot + c * ROWB + g * 16;
    const LAS unsigned char* p_bt = slot + q4 * ROWB + pp * 16;
    const LAS unsigned char* p_tr = slot + q4 * TILEB + pp * 8;
    const LAS unsigned char* p_v = slot + SL_V + q4 * ROWB + wv * 32 + pp * 8;
    const LAS unsigned char* pg = slot + SL_G + g * 16;
    PIN_PTR(p128); PIN_PTR(p_bt); PIN_PTR(p_tr); PIN_PTR(p_v); PIN_PTR(pg);
    O.a0 = *(const LAS bf16x8*)(p128 + SL_A); O.a1 = *(const LAS bf16x8*)(p128 + SL_A + 64); O.r0 = *(const LAS bf16x8*)(p128 + SL_R); O.r1 = *(const LAS bf16x8*)(p128 + SL_R + 64);
    O.vt = trd(p_v); O.lak = trd(p_tr + SL_LAK); O.lrb = trd(p_tr + SL_LRB); O.lrk = trd(p_tr + SL_LRK);
#pragma unroll
    for (int jb = 0; jb < 4; ++jb) { O.bb[jb] = trd(p_bt + SL_B + (jb >> 1) * 64 + (jb & 1) * 8); O.kk2[jb] = trd(p_bt + SL_K + (jb >> 1) * 64 + (jb & 1) * 8); O.gm[jb] = *(const LAS f32x4*)(pg + jb * 64); }
    O.bn = *(const LAS f32x4*)(slot + SL_BON + 16 * g); O.iv = *(const LAS f32x4*)(slot + SL_INV + 16 * g);
}
__device__ __forceinline__ void state_compute(const SOps& O, const v2u tt, f32x4 (&X)[4], LAS unsigned char* yl, int lane, int wv) {
    const int c = lane & 15, g = lane >> 4;
    const f32x4 z4 = (f32x4){0.f, 0.f, 0.f, 0.f};
    const bf16x8 xb0 = mk8(cvt2(X[0][0], X[0][1]), cvt2(X[0][2], X[0][3]), cvt2(X[1][0], X[1][1]), cvt2(X[1][2], X[1][3]));
    const bf16x8 xb1 = mk8(cvt2(X[2][0], X[2][1]), cvt2(X[2][2], X[2][3]), cvt2(X[3][0], X[3][1]), cvt2(X[3][2], X[3][3]));
    f32x4 Z = MFMA16(O.a0, xb0, z4); Z = MFMA16(O.a1, xb1, Z); Z = MFMA16(mk8(O.lak.x, O.lak.y, 0u, 0u), mk8(O.vt.x, O.vt.y, 0u, 0u), Z) * O.iv;
    const f32x4 U = MFMA16(mk8(tt.x, tt.y, 0u, 0u), accB(Z), z4) * O.iv;
    const bf16x8 uv = mk8(cvt2(U[0], U[1]), cvt2(U[2], U[3]), O.vt.x, O.vt.y);
    f32x4 Y = MFMA16(O.r0, xb0, z4); Y = MFMA16(O.r1, xb1, Y); Y = MFMA16(mk8(O.lrb.x, O.lrb.y, O.lrk.x, O.lrk.y), uv, Y);
#pragma unroll
    for (int jb = 0; jb < 4; ++jb) X[jb] = MFMA16(mk8(O.bb[jb].x, O.bb[jb].y, O.kk2[jb].x, O.kk2[jb].y), uv, X[jb]) * O.gm[jb];
    LAS unsigned char* py = yl + (4 * g) * 256 + (16 * wv + c) * 2;
    PIN_PTR(py);
    const float vv[4] = {bflo(O.vt.x), bfhi(O.vt.x), bflo(O.vt.y), bfhi(O.vt.y)};
#pragma unroll
    for (int r = 0; r < 4; ++r) { *(LAS unsigned short*)(py + r * 256) = (unsigned short)f2bf(Y[r]); *(LAS unsigned short*)(py + r * 256 + 128) = (unsigned short)f2bf(O.bn[r] * vv[r]); }
}
__device__ __forceinline__ void state_T(v2u (&tt)[NHELP], const LAS unsigned char* set0, LAS unsigned char* scr, int lane) {
    const int c = lane & 15, g = lane >> 4;
    const int o_w = c * TILEB + g * 8, o_r = (4 * g + (c >> 2)) * TILEB + (c & 3) * 8;
    const f32x4 z4 = (f32x4){0.f, 0.f, 0.f, 0.f};
    bf16x8 A1[NHELP], A2[NHELP], A4[NHELP]; f32x4 P[NHELP];
#pragma unroll
    for (int k = 0; k < NHELP; ++k) { const LAS unsigned char* tl = set0 + k * SL_BYTES + SL_T;
        const v2u bl = *(const LAS v2u*)(tl + o_w), al = trd(tl + o_r); A1[k] = mk8(al.x, al.y, 0u, 0u); P[k] = MFMA16(A1[k], mk8(bl.x, bl.y, 0u, 0u), z4); }
#pragma unroll
    for (int k = 0; k < NHELP; ++k) *(LAS v2u*)(scr + k * (16 * TILEB) + o_w) = (v2u){cvt2(P[k][0], P[k][1]), cvt2(P[k][2], P[k][3])};
#pragma unroll
    for (int k = 0; k < NHELP; ++k) { const v2u al = trd(scr + k * (16 * TILEB) + o_r); A2[k] = mk8(al.x, al.y, 0u, 0u); P[k] = MFMA16(A2[k], accB(P[k]), z4); }
#pragma unroll
    for (int k = 0; k < NHELP; ++k) *(LAS v2u*)(scr + k * (16 * TILEB) + o_w) = (v2u){cvt2(P[k][0], P[k][1]), cvt2(P[k][2], P[k][3])};
#pragma unroll
    for (int k = 0; k < NHELP; ++k) { const v2u al = trd(scr + k * (16 * TILEB) + o_r); A4[k] = mk8(al.x, al.y, 0u, 0u); P[k] = MFMA16(A4[k], accB(P[k]), z4); }
#pragma unroll
    for (int k = 0; k < NHELP; ++k) {
#pragma unroll
        for (int r = 0; r < 4; ++r) P[k][r] += (4 * g + r == c) ? 1.f : 0.f; }
#pragma unroll
    for (int k = 0; k < NHELP; ++k) P[k] = MFMA16(A4[k], accB(P[k]), P[k]);
#pragma unroll
    for (int k = 0; k < NHELP; ++k) P[k] = MFMA16(A2[k], accB(P[k]), P[k]);
#pragma unroll
    for (int k = 0; k < NHELP; ++k) P[k] = MFMA16(A1[k], accB(P[k]), P[k]);
#pragma unroll
    for (int k = 0; k < NHELP; ++k) *(LAS v2u*)(scr + k * (16 * TILEB) + o_w) = (v2u){cvt2(P[k][0], P[k][1]), cvt2(P[k][2], P[k][3])};
#pragma unroll
    for (int k = 0; k < NHELP; ++k) tt[k] = trd(scr + k * (16 * TILEB) + o_r);
}

__device__ __forceinline__ void p4_scan(Frame& F, const Args& AR) {
    const bf16* PROJ = (const bf16*)(F.ws + WS_PROJ); const bf16* DAG = (const bf16*)(F.ws + WS_DAG);
    float* BON = nullptr; bf16* MIX = (bf16*)(F.ws + WS_XN);
    LAS unsigned char* lds = F.lds + RING_OFF;
    LAS float* cst = (LAS float*)(lds + SC_CONST);
    const int tid = F.tid, lane = F.lane, wave = F.wave;
    for (int unit = blockIdx.x; unit < BATCH * NH; unit += F.G) {
        const int b = unit >> 3, h = unit & 7;
        const int tok0 = b * SEQ;
        if (tid < 384) { const int a = tid >> 6, c = tid & 63; const float* src = a == 0 ? AR.in[I_MU] + RC_R : a == 1 ? AR.in[I_MU] + RC_K : a == 2 ? AR.in[I_MU] + RC_V : a == 3 ? AR.in[I_KK] : a == 4 ? AR.in[I_KA] : AR.in[I_RK];
            cst[a * 64 + c] = src[h * 64 + c]; }
        __syncthreads();
        const int st_k = (tid >> 7) & 1, st_t = (tid >> 3) & 15, st_p = tid & 7;
        GAS v4u* ystore = (GAS v4u*)((GAS bf16*)MIX + (size_t)(tok0 + st_k * CS + st_t) * D + AW + h * 64 + 8 * st_p);
        const GAS v4u* gload = (const GAS v4u*)((const GAS bf16*)DAG + (size_t)(tok0 + st_k * CS + st_t) * NLORA + 1024 + h * 64 + 8 * st_p);
        const LAS unsigned char* yl_rd = lds + SC_YL + st_k * (CS * 256) + st_t * 256 + st_p * 16;
        v4u gnA = (v4u){0u, 0u, 0u, 0u}, gnB = gnA;
        float lng[8], lnb[8];
#pragma unroll
        for (int i = 0; i < 8; ++i) { lng[i] = AR.in[I_LNG][h * 64 + 8 * st_p + i]; lnb[i] = AR.in[I_LNB][h * 64 + 8 * st_p + i]; }
#define RWKV_OUT(it_, KO, gnext) do { if ((it_) >= 2 && NHELP * ((it_) - 2) + st_k + (KO) < NCHUNK) { \
            const v4u gw4 = gnext; \
            const v4u yw = *(const LAS v4u*)(yl_rd + (KO) * (CS * 256) + ((it_) & 1) * YL_BYTES), bw = *(const LAS v4u*)(yl_rd + (KO) * (CS * 256) + ((it_) & 1) * YL_BYTES + 128); \
            float y[8] = {bflo(yw.x), bfhi(yw.x), bflo(yw.y), bfhi(yw.y), bflo(yw.z), bfhi(yw.z), bflo(yw.w), bfhi(yw.w)}; \
            float sm = ((y[0] + y[1]) + (y[2] + y[3])) + ((y[4] + y[5]) + (y[6] + y[7])); \
            sm = red8(sm); \
            const float mean = sm * (1.f / 64.f); float sv = 0.f; \
            _Pragma("unroll") for (int i = 0; i < 8; ++i) { y[i] -= mean; sv += y[i] * y[i]; } \
            sv = red8(sv); \
            const float rs = 1.f / sqrtf(sv * (1.f / 64.f) + LNX_EPS); \
            const float bf_[8] = {bflo(bw.x), bfhi(bw.x), bflo(bw.y), bfhi(bw.y), bflo(bw.z), bfhi(bw.z), bflo(bw.w), bfhi(bw.w)}; \
            const float gf[8] = {bflo(gw4.x), bfhi(gw4.x), bflo(gw4.y), bfhi(gw4.y), bflo(gw4.z), bfhi(gw4.z), bflo(gw4.w), bfhi(gw4.w)}; \
            float ro[8]; \
            _Pragma("unroll") for (int i = 0; i < 8; ++i) ro[i] = (y[i] * rs * lng[i] + lnb[i] + bf_[i]) * gf[i]; \
            ystore[(size_t)(NHELP * ((it_) - 2) + (KO)) * CS * D / 8] = (v4u){pk2(ro[0], ro[1]), pk2(ro[2], ro[3]), pk2(ro[4], ro[5]), pk2(ro[6], ro[7])}; } \
            if ((it_) >= 1 && NHELP * ((it_) - 1) + st_k + (KO) < NCHUNK) gnext = gload[(size_t)(NHELP * ((it_) - 1) + (KO)) * CS * NLORA / 8]; } while (0)
        volatile LAS unsigned* cnt = (volatile LAS unsigned*)(F.lds + LDSCTL_OFF + 128);
        if (tid < 8) cnt[tid] = 0u;
        __syncthreads();
#define LDS_WAIT_GE(idx, target) do { while (cnt[idx] < (unsigned)(target)) __builtin_amdgcn_s_sleep(1); asm volatile("" ::: "memory"); } while (0)
#define LDS_SIGNAL(idx) do { asm volatile("s_waitcnt lgkmcnt(0)" ::: "memory"); if (lane == 0) __hip_atomic_fetch_add((LAS unsigned*)(cnt + (idx)), 1u, __ATOMIC_RELAXED, __HIP_MEMORY_SCOPE_WORKGROUP); } while (0)
        if (wave >= NSTATE) {
            const int hw = wave - NSTATE, kg = lane >> 4, tokl = tok0 + (lane & 15);
            HReg R;
            helper_load(R, PROJ, DAG, tokl + hw * CS, h, kg);
            for (int it = 0; it < NIT; ++it) {
                const int ch = NHELP * it + hw, s_ = it & 1;
                if (it >= 2) LDS_WAIT_GE(2 + s_, NSTATE * (it >> 1));
                helper_chunk(lds + (s_ * NHELP + hw) * SL_BYTES, cst, R, ch + NHELP < NCHUNK, PROJ, DAG, BON, tokl + ch * CS, h, lane);
                LDS_SIGNAL(0 + s_);
            }
        } else {
            f32x4 X[4];
#pragma unroll
            for (int jb = 0; jb < 4; ++jb) X[jb] = (f32x4){0.f, 0.f, 0.f, 0.f};
            for (int j = 0; j <= NIT; ++j) {
                if (j >= 1) { LDS_WAIT_GE(4 + ((j - 1) & 1), NSTATE * (((j - 1) >> 1) + 1));
                    RWKV_OUT(j + 1, 0, gnA); RWKV_OUT(j + 1, 2, gnB);
                    LDS_SIGNAL(6 + ((j - 1) & 1)); }
                else { RWKV_OUT(j + 1, 0, gnA); RWKV_OUT(j + 1, 2, gnB); }
                if (j < NIT) {
                    const int s_ = j & 1;
                    LDS_WAIT_GE(0 + s_, NHELP * ((j >> 1) + 1));
                    if (j >= 2) LDS_WAIT_GE(6 + s_, NSTATE * (j >> 1));
                    const LAS unsigned char* set0 = lds + (s_ * NHELP) * SL_BYTES;
                    LAS unsigned char* ylb = lds + SC_YL + s_ * YL_BYTES;
                    v2u tt[NHELP];
                    SOps Oa, Ob;
                    state_load(Oa, set0, lane, wave);
                    state_T(tt, set0, lds + SC_TS + wave * (NHELP * 16 * TILEB), lane);
#pragma unroll
                    for (int k = 0; k < NHELP; k += 2) {
                        state_load(Ob, set0 + (k + 1) * SL_BYTES, lane, wave);
                        state_compute(Oa, tt[k], X, ylb + k * (CS * 256), lane, wave);
                        if (k + 2 < NHELP) state_load(Oa, set0 + (k + 2) * SL_BYTES, lane, wave);
                        state_compute(Ob, tt[k + 1], X, ylb + (k + 1) * (CS * 256), lane, wave);
                    }
                    LDS_SIGNAL(2 + s_); LDS_SIGNAL(4 + s_);
                }
            }
        }
#undef LDS_WAIT_GE
#undef LDS_SIGNAL
        __syncthreads();
    }
}

__device__ __forceinline__ s16x4 vtr(const LAS unsigned char* p) { typedef short v4i16_t __attribute__((ext_vector_type(4)));
    return __builtin_bit_cast(s16x4, __builtin_amdgcn_ds_read_tr16_b64_v4i16((LAS v4i16_t*)p)); }
constexpr int ATT_UNITS = 3 * BATCH * NH * 16;
__device__ __forceinline__ void p4_attn(Frame& F, const Args& AR) {
    const bf16* PROJ = (const bf16*)(F.ws + WS_PROJ);
    bf16* PO = (bf16*)((unsigned char*)F.out + DO_PO); float* ML = (float*)(F.ws + WS_ML);
    const int tid = F.tid, lane = F.lane, wave = F.wave, half = wave >> 2, wq = wave & 3, th = tid & 255;
    const int r32 = lane & 31, hi = lane >> 5;
    LAS unsigned char* Kl = F.lds + RING_OFF + half * 65536; LAS unsigned char* Vl = Kl + 32768;
    gu32* qctr = F.ctl + CW_ATTQ;
    v4u kst[8], vst[8];
#define ATT_DECODE(up_) const int unit = 2 * (up_) + half; \
        const int pat = unit / (BATCH * NH * 16), rem = unit % (BATCH * NH * 16), bh = rem >> 4, i16 = rem & 15, b = bh >> 3, h = bh & 7; \
        const int dil = pat == 0 ? 1 : (pat == 1 ? 4 : 16); \
        const int res = pat == 0 ? 0 : (pat == 1 ? (i16 >> 2) : i16); \
        const int n = pat == 0 ? i16 : (pat == 1 ? (i16 & 3) : 0); \
        const size_t rowb = (size_t)b * SEQ;
#define ATT_ISSUE(up_) do { ATT_DECODE(up_) const int c = th & 7; \
        _Pragma("unroll") for (int i = 0; i < 8; ++i) { const int key = (th >> 3) + 32 * i; const int sub = 128 * (n - 1) + key; \
            kst[i] = (v4u){0u, 0u, 0u, 0u}; vst[i] = kst[i]; \
            if (sub >= 0) { const GAS bf16* src = (const GAS bf16*)PROJ + (rowb + res + dil * sub) * IN_COLS + h * 64 + 8 * c; kst[i] = *(const GAS v4u*)(src + PC_K); vst[i] = *(const GAS v4u*)(src + PC_V); } } } while (0)
    if (tid == 0) F.MISC[16] = __hip_atomic_fetch_add(qctr, 1u, RLX_AGENT);
    __syncthreads();
    int up = (int)F.MISC[16];
    __syncthreads();
    if (up < ATT_UNITS / 2) ATT_ISSUE(up);
    while (up < ATT_UNITS / 2) {
        if (tid == 0) F.MISC[16] = __hip_atomic_fetch_add(qctr, 1u, RLX_AGENT);
        ATT_DECODE(up)
        const int ql = 32 * wq + r32; const size_t qrow = rowb + res + dil * (128 * n + ql);
        bf16x8 qf[4];
#pragma unroll
        for (int d0 = 0; d0 < 4; ++d0) qf[d0] = *(const GAS bf16x8*)((const GAS bf16*)PROJ + qrow * IN_COLS + PC_Q + h * 64 + 16 * d0 + 8 * hi);
        {
            const int c = th & 7;
#pragma unroll
            for (int i = 0; i < 8; ++i) {
                const int key = (th >> 3) + 32 * i;
                *(LAS v4u*)(Kl + key * 128 + ((c ^ ((key >> 1) & 7)) * 16)) = kst[i];
                *(LAS v4u*)(Vl + (c >> 2) * 16384 + key * 64 + (c & 3) * 16) = vst[i];
            }
        }
        __syncthreads();
        const int upn = (int)F.MISC[16];
        if (upn < ATT_UNITS / 2) { ATT_ISSUE(upn); }
        const float slope2 = __builtin_amdgcn_exp2f(-(float)(h + 1)) * (float)dil * LOG2E;
        const int thr = r32 - 4 * hi;
        f32x16 sc[5];
        float mx = -INFINITY;
#pragma unroll
        for (int kt = 0; kt < 5; ++kt) {
            const bool skip = (n == 0) && (wq + kt < 4);
            f32x16 acc;
            if (!skip) {
                const int key = 32 * (wq + kt) + r32;
                const float bk = -slope2 * (float)(128 - 32 * kt + thr);
#pragma unroll
                for (int r = 0; r < 16; ++r) acc[r] = slope2 * (float)((r & 3) + 8 * (r >> 2)) + bk;
#pragma unroll
                for (int d0 = 0; d0 < 4; ++d0) {
                    const bf16x8 kf = *(const LAS bf16x8*)(Kl + key * 128 + (((2 * d0 + hi) ^ ((key >> 1) & 7)) * 16));
                    acc = __builtin_amdgcn_mfma_f32_32x32x16_bf16(kf, qf[d0], acc, 0, 0, 0);
                }
                if (kt == 0) {
#pragma unroll
                    for (int r = 0; r < 16; ++r) acc[r] = ((r & 3) + 8 * (r >> 2)) >= thr ? acc[r] : -INFINITY;
                }
                if (kt == 4) {
#pragma unroll
                    for (int r = 0; r < 16; ++r) acc[r] = ((r & 3) + 8 * (r >> 2)) <= thr ? acc[r] : -INFINITY;
                }
#pragma unroll
                for (int r = 0; r < 16; ++r) mx = fmaxf(mx, acc[r]);
            } else {
#pragma unroll
                for (int r = 0; r < 16; ++r) acc[r] = -INFINITY;
            }
            sc[kt] = acc;
            __builtin_amdgcn_sched_barrier(0);
        }
        mx = fmaxf(mx, __shfl_xor(mx, 32));
        float l = 0.f;
#pragma unroll
        for (int kt = 0; kt < 5; ++kt)
#pragma unroll
            for (int r = 0; r < 16; ++r) { const float p = __builtin_amdgcn_exp2f(sc[kt][r] - mx); sc[kt][r] = p; l += p; }
        l += __shfl_xor(l, 32);
        f32x16 o[2]; o[0] = f32x16{}; o[1] = f32x16{};
        const int voff = ((lane >> 4) & 1) * 32 + (lane & 3) * 8 + (4 * hi + ((lane & 15) >> 2)) * 64;
#pragma unroll
        for (int kt = 0; kt < 5; ++kt) {
            const bool skip = (n == 0) && (wq + kt < 4);
            if (!skip) {
#pragma unroll
            for (int s2 = 0; s2 < 2; ++s2) {
                v4u pw;
                pw.x = pg8::cvt_pk_bf16(sc[kt][8 * s2 + 0], sc[kt][8 * s2 + 1]); pw.y = pg8::cvt_pk_bf16(sc[kt][8 * s2 + 2], sc[kt][8 * s2 + 3]);
                pw.z = pg8::cvt_pk_bf16(sc[kt][8 * s2 + 4], sc[kt][8 * s2 + 5]); pw.w = pg8::cvt_pk_bf16(sc[kt][8 * s2 + 6], sc[kt][8 * s2 + 7]);
                const bf16x8 pf = __builtin_bit_cast(bf16x8, pw);
                const int kb = 32 * (wq + kt) + 16 * s2;
#pragma unroll
                for (int dt = 0; dt < 2; ++dt) {
                    const LAS unsigned char* vp = Vl + dt * 16384 + kb * 64 + voff;
                    const s16x4 lo = vtr(vp), hi4 = vtr(vp + 8 * 64);
                    const bf16x8 vf = (bf16x8){lo[0], lo[1], lo[2], lo[3], hi4[0], hi4[1], hi4[2], hi4[3]};
                    o[dt] = __builtin_amdgcn_mfma_f32_32x32x16_bf16(vf, pf, o[dt], 0, 0, 0);
                }
            }
            }
        }
        const float rl = 1.f / l;
        bf16* po = PO + ((size_t)pat * M + qrow) * AW + h * 64;
#pragma unroll
        for (int dt = 0; dt < 2; ++dt)
#pragma unroll
            for (int g = 0; g < 4; ++g) {
                const v2u w = (v2u){pk2(o[dt][4 * g] * rl, o[dt][4 * g + 1] * rl), pk2(o[dt][4 * g + 2] * rl, o[dt][4 * g + 3] * rl)};
                *(v2u*)(po + 32 * dt + 8 * g + 4 * hi) = w;
            }
        if (hi == 0) *(f32x2*)(ML + (((size_t)pat * M + qrow) * NH + h) * 2) = (f32x2){mx, l};
        __syncthreads();
        up = upn;
    }
#undef ATT_DECODE
#undef ATT_ISSUE
}

struct P5In { v4u po[3]; f32x2 ml[3]; };
__device__ __forceinline__ void p5_load(P5In& I, int m, int lane, const bf16* PO, const float* ML) {
    const int hd = lane >> 3;
#pragma unroll
    for (int p = 0; p < 3; ++p) { I.ml[p] = *(const GAS f32x2*)(ML + (((size_t)p * M + m) * NH + hd) * 2); I.po[p] = *(const GAS v4u*)(PO + ((size_t)p * M + m) * AW + 8 * lane); }
}
__device__ __forceinline__ void p5_token(const P5In& I, int m, int lane, bf16* MIX, const float (&aog)[8]) {
    const float mm = fmaxf(fmaxf(I.ml[0].x, I.ml[1].x), I.ml[2].x);
    float wp[3], wsum = 0.f;
#pragma unroll
    for (int p = 0; p < 3; ++p) { wp[p] = __builtin_amdgcn_exp2f(I.ml[p].x - mm) * I.ml[p].y; wsum += wp[p]; }
    const float rws = 1.f / wsum;
    float at[8] = {0.f, 0.f, 0.f, 0.f, 0.f, 0.f, 0.f, 0.f};
#pragma unroll
    for (int p = 0; p < 3; ++p) { const v4u w = I.po[p]; const float f = wp[p] * rws;
        at[0] += f * bflo(w.x); at[1] += f * bfhi(w.x); at[2] += f * bflo(w.y); at[3] += f * bfhi(w.y); at[4] += f * bflo(w.z); at[5] += f * bfhi(w.z); at[6] += f * bflo(w.w); at[7] += f * bfhi(w.w); }
    float ss = 0.f;
#pragma unroll
    for (int i = 0; i < 8; ++i) ss += at[i] * at[i];
    ss += __shfl_xor(ss, 1); ss += __shfl_xor(ss, 2); ss += __shfl_xor(ss, 4);
    const float rstd = 1.f / sqrtf(ss * (1.f / 64.f) + NORM_EPS);
    v4u oa; oa.x = pk2(at[0] * rstd * aog[0], at[1] * rstd * aog[1]); oa.y = pk2(at[2] * rstd * aog[2], at[3] * rstd * aog[3]);
    oa.z = pk2(at[4] * rstd * aog[4], at[5] * rstd * aog[5]); oa.w = pk2(at[6] * rstd * aog[6], at[7] * rstd * aog[7]);
    *(GAS v4u*)(MIX + (size_t)m * D + 8 * lane) = oa;
}
__device__ __forceinline__ void p5_post(Frame& F, const Args& AR, int m_lo, int m_hi, int wg, int nwg) {
    const int gw = wg * NWAVES + F.wave, NGW = nwg * NWAVES, lane = F.lane;
    const bf16* PO = (const bf16*)((unsigned char*)F.out + DO_PO); const float* ML = (const float*)(F.ws + WS_ML);
    bf16* MIX = (bf16*)(F.ws + WS_XN);
    float aog[8];
#pragma unroll
    for (int i = 0; i < 8; ++i) aog[i] = AR.in[I_AOG][8 * lane + i];
    static_assert(M % 4 == 0, "four tokens per step");
    for (int m = m_lo + 4 * gw; m < m_hi; m += 4 * NGW) {
        P5In A, B, C, E;
        p5_load(A, m, lane, PO, ML); p5_load(B, m + 1, lane, PO, ML); p5_load(C, m + 2, lane, PO, ML); p5_load(E, m + 3, lane, PO, ML);
        p5_token(A, m, lane, MIX, aog); p5_token(B, m + 1, lane, MIX, aog); p5_token(C, m + 2, lane, MIX, aog); p5_token(E, m + 3, lane, MIX, aog);
    }
}

__device__ __forceinline__ void p1_tail_weights(Frame& F, const Args& AR, int w0, int nw) {
    LAS float* scr = (LAS float*)(F.lds + RING_OFF + F.wave * TR_SCR);
    bf16* Wout_t = (bf16*)(F.ws + WS_WOUT); bf16* Wgu_t = (bf16*)(F.ws + WS_WGU); bf16* Wdn_t = (bf16*)(F.ws + WS_WDN);
    constexpr int I_OUT = (D / 64) * (D / 64), I_G = (D / 64) * (FF / 64), I_DN = (FF / 64) * (D / 64), NLATE = I_OUT + 2 * I_G + I_DN;
    for (int it = w0; it < NLATE; it += nw) {
        int r = it;
        if (r < I_OUT) { p0_transpose_item(AR.in[I_WOUT], D, D, Wout_t, 0, scr, r, F.lane); continue; } r -= I_OUT;
        if (r < I_G) { p0_transpose_item(AR.in[I_WG], D, FF, Wgu_t, 1, scr, r, F.lane, AR.in[I_N2G]); continue; } r -= I_G;
        if (r < I_G) { p0_transpose_item(AR.in[I_WU], D, FF, Wgu_t, 2, scr, r, F.lane, AR.in[I_N2G]); continue; } r -= I_G;
        p0_transpose_item(AR.in[I_WD], FF, D, Wdn_t, 0, scr, r, F.lane);
    }
}

__global__ void __launch_bounds__(NWAVES * 64, 2) hybrid_fwd(Args args) {
    extern __shared__ __attribute__((aligned(16))) unsigned char lds[];
    Frame F;
    F.lds = (LAS unsigned char*)lds;
    F.MISC = (volatile LAS unsigned*)(F.lds + MISC_OFF);
    F.tid = threadIdx.x; F.lane = F.tid & 63; F.wave = __builtin_amdgcn_readfirstlane(F.tid >> 6);
    F.G = gridDim.x; { const int bx = blockIdx.x; F.vcu = (F.G % 8 == 0) ? (bx % 8) * (F.G / 8) + bx / 8 : bx; }
    F.ws = args.ws; F.out = args.out;
    F.ctl = (gu32*)(args.ws + WS_CTL);
    for (int u = F.tid; u < (LDS_BYTES - LDSCTL_OFF) / 4; u += NWAVES * 64) ((LAS unsigned*)(F.lds + LDSCTL_OFF))[u] = 0u;
    __syncthreads();
    XcdBarrier bar; bar.bar = (unsigned*)(F.ctl + CW_BAR); bar.x = 0; bar.st = nullptr;
    if (N_LAUNCHES != PER_PHASE) bar = xcd_barrier_post((unsigned*)(F.ctl + CW_BAR), F.MISC + 8, (unsigned)F.G);
    const bool SPLIT = (N_LAUNCHES == 1) && (F.G % 16 == 0) && ((M / 256) % 2 == 0);
    const int sg = SPLIT ? ((int)blockIdx.x & 1) : 0, sgG = SPLIT ? F.G / 2 : F.G, sgc = SPLIT ? ((int)blockIdx.x >> 3) * 4 + (((int)blockIdx.x & 7) >> 1) : (int)blockIdx.x, sgM = SPLIT ? M / 2 : M, sgX = SPLIT ? 4 : 8;
    const size_t sgr = (size_t)sg * sgM;
    XcdBarrier sbar = bar;
    if (SPLIT) sbar = xcd_barrier_post((unsigned*)(F.ctl + CW_BAR_SUB + 4096 * sg), F.MISC + 10, (unsigned)sgG);
#define SUB_BAR() do { if (SPLIT) xcd_barrier(sbar); else GRID_BAR(); } while (0)
#define GRID_BAR() do { if (N_LAUNCHES != PER_PHASE) xcd_barrier(bar); } while (0)
    const int lo = args.ph_lo, hi = args.ph_hi;
#ifndef PHMASK
#define PHMASK 0x3ff
#endif
#define IN(k) (((PHMASK >> (k)) & 1) && lo <= (k) && (k) < hi)
#define BOTH(k) (IN(k) && IN((k) + 1))
#define PSTAMP(i) do { if (PROBE_SEL >= 0 && blockIdx.x == 0 && F.tid == 0) { const unsigned long long t_ = __builtin_amdgcn_s_memtime(); __hip_atomic_store(F.ctl + 9100 + (i), (unsigned)(t_ >> 4), RLX_AGENT); } } while (0)
#ifndef REPMASK
#define REPMASK 0
#endif
#define REP(k) for (int rep_ = 0; rep_ <= ((REPMASK >> (k)) & 1); ++rep_)
    bf16* XN = (bf16*)(args.ws + WS_XN); bf16* PROJ = (bf16*)(args.ws + WS_PROJ);

    PSTAMP(0);
    if (IN(0)) { p0_prologue(F, args); if (BOTH(0)) GRID_BAR(); }
    PSTAMP(1);
    if (IN(1)) {
        pg8::Gemm g{XN, (const bf16*)(args.ws + WS_WIN), M, IN_COLS, D}; pg8::StaticOrder S; S.init(M, IN_COLS, F.G, (int)blockIdx.x);
        pg8::EpiProj E{PROJ, IN_COLS, args.in[I_QNG], args.in[I_KNG]};
        const int nu = (M / 256) * (IN_COLS / 256), rem = nu % F.G;
        if (rem != 0 && (int)blockIdx.x >= rem) { p1_tail_weights(F, args, ((int)blockIdx.x - rem) * NWAVES + F.wave, (F.G - rem) * NWAVES); __syncthreads(); }
        pg8::gemm_phase<pg8::EpiProj, pg8::StaticOrder, true, true>(F.lds + RING_OFF, g, S, E);
        if (rem == 0) p1_tail_weights(F, args, (int)blockIdx.x * NWAVES + F.wave, F.G * NWAVES);
        if (BOTH(1)) GRID_BAR();
    }
    PSTAMP(2);
    PSTAMP(3);
    if (IN(3)) { p3_lora(F, args); if (BOTH(3)) GRID_BAR(); }
    PSTAMP(4);
    if (IN(4)) { p4_scan(F, args); PSTAMP(11); p4_attn(F, args); PSTAMP(12); if (BOTH(4)) GRID_BAR(); }
    PSTAMP(5);
    const int p5a = SPLIT ? P5A_ROWS : M;
    if (IN(5)) { p5_post(F, args, 0, p5a, F.vcu, F.G); if (BOTH(5)) GRID_BAR(); }
    PSTAMP(6);
    if (IN(6)) {
        if (SPLIT && sg == 1) {
            p5_post(F, args, p5a, M, sgc, sgG);
            asm volatile("s_waitcnt vmcnt(0)" ::: "memory"); __syncthreads();
            if (F.tid == 0) __hip_atomic_fetch_add(F.ctl + CW_P5B, 1u, __ATOMIC_RELEASE, __HIP_MEMORY_SCOPE_AGENT);
            SUB_BAR();
        }
        pg8::Gemm g{XN + sgr * D, (const bf16*)(args.ws + WS_WOUT), sgM, D, D}; pg8::StaticOrder S; S.init(sgM, D, sgG, sgc, sgX);
        pg8::EpiOut E{args.in[I_X] + sgr * D, (bf16*)(args.ws + WS_DAG) + sgr * D, (float*)(args.ws + WS_SS) + sgr * 4, D, (LAS float*)(F.lds + RING_OFF + 131072)};
        pg8::gemm_phase<pg8::EpiOut, pg8::StaticOrder, true, true>(F.lds + RING_OFF, g, S, E);
        if (IN(8)) SUB_BAR();
    }
    PSTAMP(8);
    if (IN(8)) {
        pg8::Gemm g{(const bf16*)(args.ws + WS_DAG) + sgr * D, (const bf16*)(args.ws + WS_WGU), sgM, NGU, D}; pg8::StaticOrder S; S.init(sgM, NGU, sgG, sgc, sgX);
        pg8::EpiSwiglu E{PROJ + sgr * FF, FF, (const float*)(args.ws + WS_SS) + sgr * 4};
        pg8::gemm_phase<pg8::EpiSwiglu, pg8::StaticOrder, true, true>(F.lds + RING_OFF, g, S, E);
        if (BOTH(8)) SUB_BAR();
    }
    PSTAMP(9);
    if (IN(9)) {
        if (SPLIT && sg == 0) {
            if (F.tid == 0) { unsigned sp_ = 0; while (__hip_atomic_load(F.ctl + CW_P5B, __ATOMIC_ACQUIRE, __HIP_MEMORY_SCOPE_AGENT) < (unsigned)sgG && ++sp_ < (1u << 24)) __builtin_amdgcn_s_sleep(8); }
            __syncthreads();
        }
        pg8::Gemm g{PROJ + sgr * FF, (const bf16*)(args.ws + WS_WDN), sgM, D, FF}; pg8::StaticOrder S; S.init(sgM, D, sgG, sgc, sgX);
        pg8::EpiFinal E{(const bf16*)(args.ws + WS_DAG) + sgr * D, F.out + sgr * D, D};
        pg8::gemm_phase<pg8::EpiFinal, pg8::StaticOrder, true, true>(F.lds + RING_OFF, g, S, E);
    }
    PSTAMP(10);
    if (PROBE_SEL >= 0 && blockIdx.x == 0 && F.tid == 0) {
        unsigned w = 0;
        auto ld = [&](int i) { return __hip_atomic_load(F.ctl + 9100 + i, RLX_AGENT); };
        const int sel = PROBE_SEL;
        if (sel <= 9) { const int nxt = sel == 6 ? 8 : (sel == 9 ? 10 : sel + 1); w = ld(nxt) - ld(sel); }
        else if (sel == 20) w = ld(11) - ld(4);
        else if (sel == 21) w = ld(12) - ld(11);
        else w = ld(sel);
        const unsigned long long t0 = __builtin_amdgcn_s_memtime();
        while (((__builtin_amdgcn_s_memtime() - t0) >> 4) < (unsigned long long)w) __builtin_amdgcn_s_sleep(8);
    }
#undef IN
#undef BOTH
}

extern "C" void kernel_launch(void* const* d_in, const int* in_sizes, int n_in, void* d_out, int out_size, void* d_ws, size_t ws_size, hipStream_t stream) {
    static int grid = 0;
    if (grid == 0) {
        if (n_in != 22 || in_sizes[0] != M * D || out_size != M * D || ws_size < WS_END) { fprintf(stderr, "kernel_launch: unexpected shapes (n_in %d, in0 %d, out %d, ws %zu); nothing launched\n", n_in, n_in > 0 ? in_sizes[0] : -1, out_size, ws_size); grid = -1; return; }
        int dev = 0, cus = 0, per_cu = 0;
        if (hipGetDevice(&dev) != hipSuccess || hipDeviceGetAttribute(&cus, hipDeviceAttributeMultiprocessorCount, dev) != hipSuccess) { grid = -1; return; }
        if (hipFuncSetAttribute((const void*)hybrid_fwd, hipFuncAttributeMaxDynamicSharedMemorySize, LDS_BYTES) != hipSuccess) { fprintf(stderr, "kernel_launch: hipFuncSetAttribute failed\n"); grid = -1; return; }
        if (hipOccupancyMaxActiveBlocksPerMultiprocessor(&per_cu, (const void*)hybrid_fwd, NWAVES * 64, LDS_BYTES) != hipSuccess || per_cu < 1)
            fprintf(stderr, "kernel_launch: note: occupancy query reports %d workgroups per CU\n", per_cu);
        (void)hipGetLastError();
        grid = cus;
    }
    if (grid < 0) return;
    if (hipMemsetAsync((char*)d_ws + WS_CTL, 0, CTL_ZERO_BYTES, stream) != hipSuccess) { fprintf(stderr, "kernel_launch: hipMemsetAsync failed\n"); return; }
    Args a{};
    for (int i = 0; i < 22; ++i) a.in[i] = (const float*)d_in[i];
    a.out = (float*)d_out; a.ws = (unsigned char*)d_ws;
    for (int li = 0; li < N_LAUNCHES; ++li) {
        a.ph_lo = (N_LAUNCHES == PER_PHASE) ? li : 0; a.ph_hi = (N_LAUNCHES == PER_PHASE) ? li + 1 : PER_PHASE; a.li = li;
        hipLaunchKernelGGL(hybrid_fwd, dim3(grid), dim3(NWAVES * 64), LDS_BYTES, stream, a);
        const hipError_t le = hipPeekAtLastError();
        if (le != hipSuccess) { fprintf(stderr, "kernel_launch: launch %d failed: %s\n", li, hipGetErrorName(le)); break; }
    }
}
```

```cpp
#include <hip/hip_runtime.h>
#include <cstdio>
#include <cstdint>

#ifndef P5A_16
#define P5A_16 12
#endif
#ifndef PROBE_SEL
#define PROBE_SEL -1
#endif
#ifndef MK_N_LAUNCHES
#define MK_N_LAUNCHES 1
#endif

namespace pg8 {
#define PG8_LAS __attribute__((address_space(3)))
typedef unsigned short bf16_t;
typedef short bf16x8 __attribute__((ext_vector_type(8)));
typedef float f32x4 __attribute__((ext_vector_type(4)));
typedef float f32x2 __attribute__((ext_vector_type(2)));
typedef unsigned u32x4 __attribute__((ext_vector_type(4)));
constexpr int BM = 256, BK = 64, HALF = 128, HTB = HALF * BK * 2, STAGE_BYTES = 8 * HTB, NXCD = 8, WGM = 8;

__host__ __device__ __forceinline__ int lds_byte(int r, int c) { const int st = (r >> 4) * 2 + (c >> 5), rr = r & 15, cc = c & 31, ob = rr * 64 + cc * 2; return st * 1024 + (ob ^ (((ob >> 9) & 1) << 5)); }
__host__ __device__ __forceinline__ void stage_rc(int b, int& R, int& C) { const int st = b / 1024, sb = b % 1024, swz = sb ^ (((sb >> 9) & 1) << 5); R = (st >> 1) * 16 + swz / 64; C = (st & 1) * 32 + (swz % 64) / 2; }
__host__ __device__ __forceinline__ int perm32(int rho) { const int n = rho >> 4, i = rho & 15; return 8 * (i >> 2) + 4 * n + (i & 3); }

struct Unit { int pm, pn; };
struct Gemm { const bf16_t* A; const bf16_t* Bt; int M, N, K; };

struct StaticOrder {
    int nM, nN, nwg, G, c, nx;
    __host__ __device__ void init(int M, int N, int G_, int c_, int nx_ = NXCD) { nM = M / BM; nN = N / BM; nwg = nM * nN; G = G_; c = c_; nx = nx_; }
    __host__ __device__ bool next(int i, Unit& u) const {
        const long L = (long)i * G + c; if (L >= nwg) return false;
        int wgid = (int)L; { const int q = nwg / nx, r = nwg % nx, xcd = wgid % nx, off = wgid / nx; wgid = (xcd < r ? xcd * (q + 1) : r * (q + 1) + (xcd - r) * q) + off; }
        const int nig = WGM * nN, gid = wgid / nig, fm = gid * WGM, gsz = (nM - fm) < WGM ? (nM - fm) : WGM;
        u.pm = fm + ((wgid % nig) % gsz); u.pn = (wgid % nig) / gsz; return true;
    }
    __device__ __forceinline__ void a_ready(const Unit&) const {}
    __device__ __forceinline__ void done(const Unit&) const {}
};

__device__ __forceinline__ unsigned cvt_pk_bf16(float lo, float hi) { unsigned r; asm volatile("v_cvt_pk_bf16_f32 %0, %1, %2" : "=v"(r) : "v"(lo), "v"(hi)); return r; }
__device__ __forceinline__ float fsigmoid(float x) { return __builtin_amdgcn_rcpf(1.0f + __builtin_amdgcn_exp2f(-1.4426950408889634f * x)); }

struct EpiBf16 {
    static constexpr bool PERM = true, AFTER_DRAIN = false;
    bf16_t* O; int ldc;
    __device__ __forceinline__ void operator()(const f32x4 (&acc)[2][2][4][2], const Unit& u, int wr, int wc, int fr, int fq) const {
        const int row0 = u.pm * BM + wr * 64 + fr; const int col0 = u.pn * BM + wc * 32 + 8 * fq;
#pragma unroll
        for (int ai = 0; ai < 2; ++ai)
#pragma unroll
            for (int m = 0; m < 4; ++m) { bf16_t* rowp = O + (size_t)(row0 + ai * HALF + m * 16) * ldc + col0;
#pragma unroll
                for (int bj = 0; bj < 2; ++bj) { const f32x4 v0 = acc[ai][bj][m][0], v1 = acc[ai][bj][m][1];
                    u32x4 w; w.x = cvt_pk_bf16(v0[0], v0[1]); w.y = cvt_pk_bf16(v0[2], v0[3]); w.z = cvt_pk_bf16(v1[0], v1[1]); w.w = cvt_pk_bf16(v1[2], v1[3]);
                    *(u32x4*)(rowp + bj * HALF) = w; } }
    }
};
struct EpiProj {
    static constexpr bool PERM = true, AFTER_DRAIN = false;
    bf16_t* O; int ldc; const float* qg; const float* kg;
    __device__ __forceinline__ void operator()(const f32x4 (&acc)[2][2][4][2], const Unit& u, int wr, int wc, int fr, int fq) const {
        const int row0 = u.pm * BM + wr * 64 + fr;
        if (u.pn >= 4) {
            const int col0 = u.pn * BM + wc * 32 + 8 * fq;
#pragma unroll
            for (int ai = 0; ai < 2; ++ai)
#pragma unroll
                for (int m = 0; m < 4; ++m) { bf16_t* rowp = O + (size_t)(row0 + ai * HALF + m * 16) * ldc + col0;
#pragma unroll
                    for (int bj = 0; bj < 2; ++bj) { const f32x4 v0 = acc[ai][bj][m][0], v1 = acc[ai][bj][m][1];
                        u32x4 w; w.x = cvt_pk_bf16(v0[0], v0[1]); w.y = cvt_pk_bf16(v0[2], v0[3]); w.z = cvt_pk_bf16(v1[0], v1[1]); w.w = cvt_pk_bf16(v1[2], v1[3]);
                        *(u32x4*)(rowp + bj * HALF) = w; } }
        } else {
            const float* gsrc = (u.pn < 2 ? qg : kg) + 8 * fq; const float sc = u.pn < 2 ? 0.125f * 1.4426950408889634f : 1.0f;
            f32x4 g4[2][2];
#pragma unroll
            for (int bj = 0; bj < 2; ++bj)
#pragma unroll
                for (int n = 0; n < 2; ++n) g4[bj][n] = *(const f32x4*)(gsrc + 32 * bj + 4 * n) * sc;
            const int col0 = u.pn * BM + wc * 64 + 8 * fq;
#pragma unroll
            for (int ai = 0; ai < 2; ++ai)
#pragma unroll
                for (int m = 0; m < 4; ++m) {
                    float ss = 0.f;
#pragma unroll
                    for (int bj = 0; bj < 2; ++bj)
#pragma unroll
                        for (int n = 0; n < 2; ++n) { const f32x4 v = acc[ai][bj][m][n]; ss += (v[0] * v[0] + v[1] * v[1]) + (v[2] * v[2] + v[3] * v[3]); }
                    ss += __shfl_xor(ss, 16); ss += __shfl_xor(ss, 32);
                    const float rstd = 1.0f / sqrtf(ss * (1.0f / 64.0f) + 1e-6f);
                    bf16_t* rowp = O + (size_t)(row0 + ai * HALF + m * 16) * ldc + col0;
#pragma unroll
                    for (int bj = 0; bj < 2; ++bj) { const f32x4 v0 = acc[ai][bj][m][0] * g4[bj][0] * rstd, v1 = acc[ai][bj][m][1] * g4[bj][1] * rstd;
                        u32x4 w; w.x = cvt_pk_bf16(v0[0], v0[1]); w.y = cvt_pk_bf16(v0[2], v0[3]); w.z = cvt_pk_bf16(v1[0], v1[1]); w.w = cvt_pk_bf16(v1[2], v1[3]);
                        *(u32x4*)(rowp + 32 * bj) = w; }
                    __builtin_amdgcn_sched_barrier(0); }
        }
    }
};
struct EpiLora {
    static constexpr bool PERM = true, AFTER_DRAIN = false;
    bf16_t* O; int ldc; const float* w0; const float* a0;
    __device__ __forceinline__ void operator()(const f32x4 (&acc)[2][2][4][2], const Unit& u, int wr, int wc, int fr, int fq) const {
        const int row0 = u.pm * BM + wr * 64 + fr; const int col0 = u.pn * BM + wc * 32 + 8 * fq;
        const int kind = u.pn >> 1;
        const float sc = kind == 0 ? -0.6065306597126334f : (kind == 1 ? 1.0f : 0.0f), lin = kind == 2 ? 1.0f : 0.0f;
        const float* bp = kind == 0 ? w0 : a0;
        const float bs = kind == 2 ? 0.0f : 1.0f;
#pragma unroll
        for (int bj = 0; bj < 2; ++bj) {
            const int c = (col0 + bj * HALF) & 511;
            const f32x4 b0 = *(const f32x4*)(bp + c) * bs, b1 = *(const f32x4*)(bp + c + 4) * bs;
#pragma unroll
            for (int ai = 0; ai < 2; ++ai)
#pragma unroll
                for (int m = 0; m < 4; ++m) { bf16_t* rowp = O + (size_t)(row0 + ai * HALF + m * 16) * ldc + col0;
                    f32x4 v0 = acc[ai][bj][m][0] + b0, v1 = acc[ai][bj][m][1] + b1;
#pragma unroll
                    for (int e = 0; e < 4; ++e) { v0[e] = sc * fsigmoid(v0[e]) + lin * v0[e]; v1[e] = sc * fsigmoid(v1[e]) + lin * v1[e]; }
                    u32x4 w; w.x = cvt_pk_bf16(v0[0], v0[1]); w.y = cvt_pk_bf16(v0[2], v0[3]); w.z = cvt_pk_bf16(v1[0], v1[1]); w.w = cvt_pk_bf16(v1[2], v1[3]);
                    *(u32x4*)(rowp + bj * HALF) = w;
                    __builtin_amdgcn_sched_barrier(0); }
        }
    }
};
struct EpiSwiglu {
    static constexpr bool PERM = true, AFTER_DRAIN = false;
    bf16_t* H; int ldh; const float* rstd;
    __device__ __forceinline__ void operator()(const f32x4 (&acc)[2][2][4][2], const Unit& u, int wr, int wc, int fr, int fq) const {
        const int row0 = u.pm * BM + wr * 64 + fr; const int col0 = u.pn * HALF + wc * 32 + 8 * fq;
        float rs[2][4];
#pragma unroll
        for (int ai = 0; ai < 2; ++ai)
#pragma unroll
            for (int m = 0; m < 4; ++m) { const f32x4 s4 = *(const f32x4*)(rstd + (size_t)(row0 + ai * HALF + m * 16) * 4);
                rs[ai][m] = 1.0f / sqrtf(((s4[0] + s4[1]) + (s4[2] + s4[3])) * (1.0f / 1024.0f) + 1e-6f); }
#pragma unroll
        for (int ai = 0; ai < 2; ++ai)
#pragma unroll
            for (int m = 0; m < 4; ++m) { bf16_t* rowp = H + (size_t)(row0 + ai * HALF + m * 16) * ldh + col0;
                float h[8];
#pragma unroll
                for (int n = 0; n < 2; ++n)
#pragma unroll
                    for (int e = 0; e < 4; ++e) { const float g = acc[ai][0][m][n][e] * rs[ai][m], up = acc[ai][1][m][n][e] * rs[ai][m]; h[4 * n + e] = g * fsigmoid(g) * up; }
                u32x4 w; w.x = cvt_pk_bf16(h[0], h[1]); w.y = cvt_pk_bf16(h[2], h[3]); w.z = cvt_pk_bf16(h[4], h[5]); w.w = cvt_pk_bf16(h[6], h[7]);
                *(u32x4*)rowp = w;
                __builtin_amdgcn_sched_barrier(0); }
    }
};
struct EpiOut {
    static constexpr bool PERM = true, AFTER_DRAIN = false;
    const float* base; bf16_t* xb; float* SS; int ldc; PG8_LAS float* scr;
#define EPO_LOAD(dst, g) do { _Pragma("unroll") for (int mm = 0; mm < 2; ++mm) _Pragma("unroll") for (int bj = 0; bj < 2; ++bj) { \
        const size_t o_ = (size_t)(((g) >> 1) * HALF + (((g) & 1) * 2 + mm) * 16) * ldc + bj * HALF; dst[mm * 4 + bj * 2] = *(const f32x4*)(bp + o_); dst[mm * 4 + bj * 2 + 1] = *(const f32x4*)(bp + o_ + 4); } } while (0)
    __device__ __forceinline__ void operator()(const f32x4 (&acc)[2][2][4][2], const Unit& u, int wr, int wc, int fr, int fq) const {
        const int row0 = u.pm * BM + wr * 64 + fr, col0 = u.pn * BM + wc * 32 + 8 * fq;
        const float* bp = base + (size_t)row0 * ldc + col0; bf16_t* xp = xb + (size_t)row0 * ldc + col0;
        f32x4 xa[8], xc[8];
        EPO_LOAD(xa, 0); EPO_LOAD(xc, 1);
        __builtin_amdgcn_sched_barrier(0);
#pragma unroll
        for (int g = 0; g < 4; ++g) {
            const int ai = g >> 1;
            u32x4 wo[4]; float ssv[2];
#pragma unroll
            for (int mm = 0; mm < 2; ++mm) { const int m = (g & 1) * 2 + mm; float ss = 0.f;
#pragma unroll
                for (int bj = 0; bj < 2; ++bj) {
                    const f32x4 o0 = ((g & 1) ? xc : xa)[mm * 4 + bj * 2] + acc[ai][bj][m][0], o1 = ((g & 1) ? xc : xa)[mm * 4 + bj * 2 + 1] + acc[ai][bj][m][1];
                    u32x4 w; w.x = cvt_pk_bf16(o0[0], o0[1]); w.y = cvt_pk_bf16(o0[2], o0[3]); w.z = cvt_pk_bf16(o1[0], o1[1]); w.w = cvt_pk_bf16(o1[2], o1[3]);
                    wo[mm * 2 + bj] = w;
                    ss += ((o0[0] * o0[0] + o0[1] * o0[1]) + (o0[2] * o0[2] + o0[3] * o0[3])) + ((o1[0] * o1[0] + o1[1] * o1[1]) + (o1[2] * o1[2] + o1[3] * o1[3])); }
                ss += __shfl_xor(ss, 16); ss += __shfl_xor(ss, 32); ssv[mm] = ss; }
            __builtin_amdgcn_sched_barrier(0);
            if (g == 0) EPO_LOAD(xa, 2);
            if (g == 1) EPO_LOAD(xc, 3);
            __builtin_amdgcn_sched_barrier(0);
#pragma unroll
            for (int mm = 0; mm < 2; ++mm) { const int m = (g & 1) * 2 + mm;
#pragma unroll
                for (int bj = 0; bj < 2; ++bj) *(u32x4*)(xp + (size_t)(ai * HALF + m * 16) * ldc + bj * HALF) = wo[mm * 2 + bj];
                if (fq == 0) scr[((((wr * 2 + ai) * 4 + m) * 16) + fr) * 4 + wc] = ssv[mm]; }
            __builtin_amdgcn_sched_barrier(0);
        }
        asm volatile("s_waitcnt lgkmcnt(0)" ::: "memory"); __builtin_amdgcn_s_barrier(); asm volatile("" ::: "memory");
        const int tid = threadIdx.x;
        if (tid < 256) { const f32x4 s4 = *(const PG8_LAS f32x4*)(scr + tid * 4);
            const int row = u.pm * BM + ((tid >> 6) & 1) * HALF + (tid >> 7) * 64 + ((tid >> 4) & 3) * 16 + (tid & 15);
            SS[(size_t)row * 4 + u.pn] = (s4[0] + s4[1]) + (s4[2] + s4[3]); }
    }
#undef EPO_LOAD
};
struct EpiFinal {
    static constexpr bool PERM = true, AFTER_DRAIN = false;
    const bf16_t* xb; float* out; int ldc;
    __device__ __forceinline__ void operator()(const f32x4 (&acc)[2][2][4][2], const Unit& u, int wr, int wc, int fr, int fq) const {
        const int row0 = u.pm * BM + wr * 64 + fr, col0 = u.pn * BM + wc * 32 + 8 * fq;
#pragma unroll
        for (int ai = 0; ai < 2; ++ai)
#pragma unroll
            for (int m = 0; m < 4; ++m) { const size_t off = (size_t)(row0 + ai * HALF + m * 16) * ldc + col0;
#pragma unroll
                for (int bj = 0; bj < 2; ++bj) { const u32x4 w = *(const u32x4*)(xb + off + bj * HALF);
                    const f32x4 b0 = (f32x4){__builtin_bit_cast(float, w.x << 16), __builtin_bit_cast(float, w.x & 0xffff0000u), __builtin_bit_cast(float, w.y << 16), __builtin_bit_cast(float, w.y & 0xffff0000u)};
                    const f32x4 b1 = (f32x4){__builtin_bit_cast(float, w.z << 16), __builtin_bit_cast(float, w.z & 0xffff0000u), __builtin_bit_cast(float, w.w << 16), __builtin_bit_cast(float, w.w & 0xffff0000u)};
                    __builtin_nontemporal_store(b0 + acc[ai][bj][m][0], (f32x4*)(out + off + bj * HALF)); __builtin_nontemporal_store(b1 + acc[ai][bj][m][1], (f32x4*)(out + off + bj * HALF + 4)); }
                if (m & 1) asm volatile("" ::: "memory"); }
    }
};

template <class Epi, class Sched, bool ALIGN_EPI = false, bool SP2 = false>
__device__ __forceinline__ void gemm_phase(PG8_LAS unsigned char* lds, const Gemm g, const Sched& S, const Epi& E) {
    const int tid = threadIdx.x, wid = __builtin_amdgcn_readfirstlane(tid >> 6), lane = tid & 63, wr = wid >> 2, wc = wid & 3, fr = lane & 15, fq = lane >> 4;
    const int K = g.K, nt = K / BK;
    unsigned voffA[2], voffB[2];
#pragma unroll
    for (int i = 0; i < 2; ++i) { int R, C; stage_rc(tid * 16 + i * 8192, R, C); const int Rb = Epi::PERM ? ((R & ~31) + perm32(R & 31)) : R;
        voffA[i] = (unsigned)(R * K + C) * 2u; voffB[i] = (unsigned)(Rb * K + C) * 2u; }
    const size_t kstep = (size_t)(BK * 2);
    const size_t hstep = (size_t)HALF * K * 2;
    const size_t tstep = 2 * hstep;
    const unsigned ldsw = (unsigned)wid * 1024u;
    const int aoff = lds_byte(wr * 64 + fr, fq * 8), boff = lds_byte(wc * 32 + fr, fq * 8);
#define PG8_SA(b, h) (((b) * 2 + (h)) * HTB)
#define PG8_SB(b, h) ((4 + (b) * 2 + (h)) * HTB)
#define PG8_STAGE(bufoff, gbase, voff) do { _Pragma("unroll") for (int _i = 0; _i < 2; ++_i) \
        __builtin_amdgcn_global_load_lds((const unsigned*)((const char*)(gbase) + (voff)[_i]), (PG8_LAS unsigned*)(lds + (bufoff) + ldsw + _i * 8192), 16, 0, 0); } while (0)
#define PG8_LDA(dst, b, h) do { _Pragma("unroll") for (int m = 0; m < 4; ++m) _Pragma("unroll") for (int k = 0; k < 2; ++k) dst[m][k] = *(const PG8_LAS bf16x8*)(lds + PG8_SA(b, h) + aoff + m * 2048 + k * 1024); } while (0)
#define PG8_LDB(dst, b, h) do { _Pragma("unroll") for (int n = 0; n < 2; ++n) _Pragma("unroll") for (int k = 0; k < 2; ++k) dst[n][k] = *(const PG8_LAS bf16x8*)(lds + PG8_SB(b, h) + boff + n * 2048 + k * 1024); } while (0)
#define PG8_MMA(ai, bj, At, Bt) do { __builtin_amdgcn_s_setprio(1); _Pragma("unroll") for (int m = 0; m < 4; ++m) _Pragma("unroll") for (int n = 0; n < 2; ++n) _Pragma("unroll") for (int k = 0; k < 2; ++k) \
        acc[ai][bj][m][n] = __builtin_amdgcn_mfma_f32_16x16x32_bf16(Bt[n][k], At[m][k], acc[ai][bj][m][n], 0, 0, 0); __builtin_amdgcn_s_setprio(0); } while (0)
#define PG8_WAIT_V(n) asm volatile("s_waitcnt vmcnt(" #n ")" ::: "memory")
#define PG8_WAIT_L(n) asm volatile("s_waitcnt lgkmcnt(" #n ")" ::: "memory")
#define PG8_BAR __builtin_amdgcn_s_barrier()
#define PG8_SCHED __builtin_amdgcn_sched_barrier(0)
    Unit cur, nxt; int ui = 0;
    if (!S.next(0, cur)) return;
    f32x4 acc[2][2][4][2];
#pragma unroll
    for (int a = 0; a < 2; ++a)
#pragma unroll
        for (int b = 0; b < 2; ++b)
#pragma unroll
            for (int m = 0; m < 4; ++m)
#pragma unroll
                for (int n = 0; n < 2; ++n) acc[a][b][m][n] = (f32x4){0.f, 0.f, 0.f, 0.f};
    bf16x8 At[4][2], B0[2][2], B1[2][2];
    const char* cA = (const char*)g.A + (size_t)cur.pm * tstep; const char* cB = (const char*)g.Bt + (size_t)cur.pn * tstep;
    S.a_ready(cur);
    if constexpr (SP2) {
        PG8_STAGE(PG8_SB(0, 0), cB, voffB); PG8_STAGE(PG8_SB(0, 1), cB + hstep, voffB); PG8_STAGE(PG8_SA(0, 0), cA, voffA); PG8_STAGE(PG8_SA(0, 1), cA + hstep, voffA);
        if (wr == 1) PG8_BAR;
        PG8_WAIT_V(2); PG8_BAR;
        PG8_STAGE(PG8_SB(1, 0), cB + kstep, voffB); PG8_STAGE(PG8_SA(1, 0), cA + kstep, voffA); PG8_STAGE(PG8_SB(1, 1), cB + hstep + kstep, voffB);
        PG8_WAIT_V(6); PG8_BAR;
    } else {
        PG8_STAGE(PG8_SB(0, 0), cB, voffB); PG8_STAGE(PG8_SA(0, 0), cA, voffA); PG8_STAGE(PG8_SB(0, 1), cB + hstep, voffB); PG8_STAGE(PG8_SA(0, 1), cA + hstep, voffA);
        if (wr == 1) PG8_BAR;
        PG8_WAIT_V(4); PG8_BAR;
        PG8_STAGE(PG8_SB(1, 0), cB + kstep, voffB); PG8_STAGE(PG8_SA(1, 0), cA + kstep, voffA); PG8_STAGE(PG8_SB(1, 1), cB + hstep + kstep, voffB);
        PG8_WAIT_V(6); PG8_BAR;
    }
    for (;;) {
        const bool has_next = S.next(ui + 1, nxt);
        const char* nA = has_next ? (const char*)g.A + (size_t)nxt.pm * tstep : cA; const char* nB = has_next ? (const char*)g.Bt + (size_t)nxt.pn * tstep : cB;
#pragma nounroll
        for (int t = 0; t < nt; t += 2) {
            const bool last = (t == nt - 2);
            const char* a1 = cA + (size_t)(t + 1) * kstep;
            const char* a2 = last ? nA : cA + (size_t)(t + 2) * kstep; const char* b2 = last ? nB : cB + (size_t)(t + 2) * kstep;
            const char* a3 = a2 + kstep; const char* b3 = b2 + kstep;
            if (last && has_next) S.a_ready(nxt);
            if constexpr (SP2) {
            PG8_LDB(B0, 0, 0); PG8_LDB(B1, 0, 1); PG8_SCHED; PG8_LDA(At, 0, 0); PG8_STAGE(PG8_SA(1, 1), a1 + hstep, voffA);
            PG8_WAIT_V(8); PG8_WAIT_L(0); PG8_BAR; PG8_MMA(0, 0, At, B0); PG8_MMA(0, 1, At, B1); PG8_BAR; PG8_SCHED;
            PG8_LDA(At, 0, 1); PG8_STAGE(PG8_SB(0, 0), b2, voffB); PG8_STAGE(PG8_SB(0, 1), b2 + hstep, voffB); PG8_STAGE(PG8_SA(0, 0), a2, voffA);
            PG8_WAIT_V(8); PG8_WAIT_L(0); PG8_BAR; PG8_MMA(1, 0, At, B0); PG8_MMA(1, 1, At, B1); PG8_BAR; PG8_SCHED;
            PG8_LDB(B0, 1, 0); PG8_LDB(B1, 1, 1); PG8_SCHED; PG8_LDA(At, 1, 0); PG8_STAGE(PG8_SA(0, 1), a2 + hstep, voffA);
            PG8_WAIT_V(8); PG8_WAIT_L(0); PG8_BAR; PG8_MMA(0, 0, At, B0); PG8_MMA(0, 1, At, B1); PG8_BAR; PG8_SCHED;
            PG8_LDA(At, 1, 1); PG8_STAGE(PG8_SB(1, 0), b3, voffB); PG8_STAGE(PG8_SB(1, 1), b3 + hstep, voffB); PG8_STAGE(PG8_SA(1, 0), a3, voffA);
            PG8_WAIT_V(8); PG8_WAIT_L(0); PG8_BAR; PG8_MMA(1, 0, At, B0); PG8_MMA(1, 1, At, B1); PG8_BAR; PG8_SCHED;
            } else {
            PG8_LDB(B0, 0, 0); PG8_SCHED; PG8_LDA(At, 0, 0); PG8_STAGE(PG8_SA(1, 1), a1 + hstep, voffA);
            PG8_WAIT_L(8); PG8_BAR; PG8_WAIT_L(0); PG8_MMA(0, 0, At, B0); PG8_BAR; PG8_SCHED;
            PG8_LDB(B1, 0, 1); PG8_STAGE(PG8_SB(0, 0), b2, voffB);
            PG8_BAR; PG8_WAIT_L(0); PG8_MMA(0, 1, At, B1); PG8_BAR;
            PG8_LDA(At, 0, 1); PG8_STAGE(PG8_SA(0, 0), a2, voffA);
            PG8_BAR; PG8_WAIT_L(0); PG8_MMA(1, 0, At, B0); PG8_BAR; PG8_SCHED;
            PG8_STAGE(PG8_SB(0, 1), b2 + hstep, voffB);
            PG8_WAIT_V(6); PG8_BAR; PG8_MMA(1, 1, At, B1); PG8_BAR;
            PG8_LDB(B0, 1, 0); PG8_SCHED; PG8_LDA(At, 1, 0); PG8_STAGE(PG8_SA(0, 1), a2 + hstep, voffA);
            PG8_WAIT_L(8); PG8_BAR; PG8_WAIT_L(0); PG8_MMA(0, 0, At, B0); PG8_BAR; PG8_SCHED;
            PG8_LDB(B1, 1, 1); PG8_STAGE(PG8_SB(1, 0), b3, voffB);
            PG8_BAR; PG8_WAIT_L(0); PG8_MMA(0, 1, At, B1); PG8_BAR;
            PG8_LDA(At, 1, 1); PG8_STAGE(PG8_SA(1, 0), a3, voffA);
            PG8_BAR; PG8_WAIT_L(0); PG8_MMA(1, 0, At, B0); PG8_BAR; PG8_SCHED;
            PG8_STAGE(PG8_SB(1, 1), b3 + hstep, voffB);
            PG8_WAIT_V(6); PG8_BAR; PG8_MMA(1, 1, At, B1); PG8_BAR;
            }
        }
        if constexpr (ALIGN_EPI) { if (wr == 0) PG8_BAR; }
        if constexpr (!Epi::AFTER_DRAIN) { E(acc, cur, wr, wc, fr, fq); S.done(cur); }
        if (!has_next) break;
#pragma unroll
        for (int a = 0; a < 2; ++a)
#pragma unroll
            for (int b = 0; b < 2; ++b)
#pragma unroll
                for (int m = 0; m < 4; ++m)
#pragma unroll
                    for (int n = 0; n < 2; ++n) acc[a][b][m][n] = (f32x4){0.f, 0.f, 0.f, 0.f};
        cur = nxt; cA = nA; cB = nB; ++ui;
        if constexpr (ALIGN_EPI) { if (wr == 1) PG8_BAR; }
    }
    PG8_WAIT_V(0);
    if constexpr (!ALIGN_EPI) { if (wr == 0) PG8_BAR; }
    PG8_BAR;
#undef PG8_SA
#undef PG8_SB
#undef PG8_STAGE
#undef PG8_LDA
#undef PG8_LDB
#undef PG8_MMA
#undef PG8_WAIT_V
#undef PG8_WAIT_L
#undef PG8_BAR
#undef PG8_SCHED
}
}

constexpr int NWAVES = 8;
constexpr int N_LAUNCHES = MK_N_LAUNCHES;
constexpr int PER_PHASE = 10;
constexpr int BATCH = 16, SEQ = 2048, D = 1024, M = BATCH * SEQ;
constexpr int NH = 8, HD = 64, AW = 512, RW = 512;
constexpr int RWKV_COLS = 1792, IN_COLS = 3328, FF = 2816, NGU = 2 * FF, NLORA = 1536, KLORA = 256;
constexpr int PC_Q = 0, PC_K = 512, PC_V = 1024, PC_RW = 1536;
constexpr int RC_R = 0, RC_K = 512, RC_V = 1024, RC_L = 1536;
constexpr int WLF_K01 = 8 * 2 * 4 * 64 * 8, WLF_ELEMS = 4 * WLF_K01;
constexpr float NORM_EPS = 1e-6f, LNX_EPS = 64e-5f;
constexpr float LOG2E = 1.4426950408889634f;

constexpr size_t MiB = 1u << 20;
constexpr size_t WS_CTL = 0, CTL_ZERO_BYTES = 1 * MiB;
constexpr size_t WS_WIN = 2 * MiB;
constexpr size_t WS_WOUT = 9 * MiB;
constexpr size_t WS_WGU = 11 * MiB;
constexpr size_t WS_WDN = 22 * MiB;
constexpr size_t WS_WL = 28 * MiB;
constexpr size_t WS_BON = 29 * MiB;
constexpr size_t WS_SS = 30 * MiB;
constexpr size_t WS_XN = 32 * MiB;
constexpr size_t WS_PROJ = 96 * MiB;
constexpr size_t WS_A2 = 304 * MiB;
constexpr size_t WS_DAG = 320 * MiB;
constexpr size_t WS_ML = 416 * MiB;
constexpr size_t WS_END = 424 * MiB;
constexpr size_t DO_PO = 0, DO_Y = 96 * MiB;
constexpr int CW_TMO = 0, CW_CODE = 1;
constexpr int CW_BAR = 4096;
constexpr int CW_ATTQ = 8192;
constexpr int CW_P5B = 8448;
constexpr int P5A_ROWS = (M / 16) * P5A_16;
constexpr int CW_BAR_SUB = 16384;

constexpr int LDS_BYTES = 163840;
constexpr int RING_OFF = 0, RING_BYTES = LDS_BYTES - 1024;
constexpr int LDSCTL_OFF = RING_BYTES, MISC_OFF = LDSCTL_OFF + 320;

#define GAS __attribute__((address_space(1)))
#define LAS __attribute__((address_space(3)))
typedef unsigned short bf16;
typedef unsigned v4u __attribute__((ext_vector_type(4)));
typedef unsigned v2u __attribute__((ext_vector_type(2)));
typedef float f32x4 __attribute__((ext_vector_type(4)));
typedef float f32x2 __attribute__((ext_vector_type(2)));
typedef float f32x16 __attribute__((ext_vector_type(16)));
typedef short bf16x8 __attribute__((ext_vector_type(8)));
typedef short s16x4 __attribute__((ext_vector_type(4)));
typedef GAS unsigned gu32;
#define RLX_AGENT __ATOMIC_RELAXED, __HIP_MEMORY_SCOPE_AGENT
#define LDS_WAIT() asm volatile("s_waitcnt lgkmcnt(0)" ::: "memory")
#define VM_WAIT() asm volatile("s_waitcnt vmcnt(0)" ::: "memory")
__device__ __forceinline__ unsigned f2bf(float f) { unsigned u = __builtin_bit_cast(unsigned, f); return (u + 0x7fffu + ((u >> 16) & 1u)) >> 16; }
typedef float f32x2_t __attribute__((ext_vector_type(2))); typedef __bf16 bf16x2_t __attribute__((ext_vector_type(2)));
__device__ __forceinline__ unsigned cvt2(float lo, float hi) { f32x2_t v = {lo, hi}; bf16x2_t b = __builtin_convertvector(v, bf16x2_t); return __builtin_bit_cast(unsigned, b); }
__device__ __forceinline__ unsigned pk2(float lo, float hi) { return cvt2(lo, hi); }
__device__ __forceinline__ float bflo(unsigned w) { return __builtin_bit_cast(float, w << 16); }
__device__ __forceinline__ float bfhi(unsigned w) { return __builtin_bit_cast(float, w & 0xffff0000u); }
__device__ __forceinline__ float fsig(float x) { return __builtin_amdgcn_rcpf(1.0f + __builtin_amdgcn_exp2f(-LOG2E * x)); }

#define XB_TMO      128
#define XB_XCNT(j)  (256  + 64 * (j))
#define XB_XSUB(j)  (1280 + 64 * (j))
#define XB_XGEN(j)  (2304 + 64 * (j))
#define XB_TOP      3328
#define XB_TOPGEN   3392
#define XCD_BAR_WORDS 3456
#define XB_SPIN_CAP (1u << 18)
__device__ __forceinline__ unsigned xb_ld(unsigned* p)              { return __hip_atomic_load(p, __ATOMIC_RELAXED, __HIP_MEMORY_SCOPE_AGENT); }
__device__ __forceinline__ unsigned xb_add(unsigned* p, unsigned v) { return __hip_atomic_fetch_add(p, v, __ATOMIC_RELAXED, __HIP_MEMORY_SCOPE_AGENT); }
__device__ __forceinline__ unsigned xb_xcc_id() { return (unsigned)__builtin_amdgcn_s_getreg((3 << 11) | 20) & 0xFu; }
#define XB_SPIN(cond, bar) do { unsigned _sp = 0; while (cond) { __builtin_amdgcn_s_sleep(1); \
    if ((++_sp & 255u) == 0u) { if (xb_ld(&(bar)[XB_TMO])) break; if (_sp > XB_SPIN_CAP) { atomicAdd(&(bar)[XB_TMO], 1u); break; } } } } while (0)
struct XcdBarrier { unsigned* bar; unsigned x; volatile LAS unsigned* st; unsigned total; };
__device__ __forceinline__ XcdBarrier xcd_barrier_post(unsigned* bar, volatile LAS unsigned* st, unsigned total) {
    XcdBarrier b; b.bar = bar; b.x = xb_xcc_id(); b.st = st; b.total = total;
    if (threadIdx.x == 0) (void)xb_add(&bar[XB_XCNT(b.x)], 1u);
    return b;
}
__device__ __forceinline__ void xcd_barrier_complete(unsigned* bar, unsigned x, unsigned G, unsigned& nloc, unsigned& nx) {
    unsigned sum, cnt, mine, sp = 0u;
    for (;;) {
        sum = 0u; cnt = 0u; mine = 0u;
#pragma unroll
        for (unsigned j = 0; j < 16; ++j) { const unsigned c = xb_ld(&bar[XB_XCNT(j)]); sum += c; cnt += (c > 0u) ? 1u : 0u; mine = (j == x) ? c : mine; }
        if (sum == G) break;
        __builtin_amdgcn_s_sleep(1);
        if ((++sp & 255u) == 0u) { if (xb_ld(&bar[XB_TMO])) break; if (sp > XB_SPIN_CAP) { atomicAdd(&bar[XB_TMO], 1u); break; } }
    }
    nloc = mine > 0u ? mine : 1u; nx = cnt > 0u ? cnt : 1u;
}
__device__ __forceinline__ void xcd_barrier(const XcdBarrier& b) {
    asm volatile("s_waitcnt vmcnt(0)" ::: "memory");
    __syncthreads();
    if (threadIdx.x == 0) {
        unsigned* bar = b.bar;
        __builtin_amdgcn_s_waitcnt(0);
        unsigned nloc = b.st[0], nx = b.st[1];
        if (nloc == 0u) { xcd_barrier_complete(bar, b.x, b.total, nloc, nx); b.st[0] = nloc; b.st[1] = nx; }
        const unsigned old = xb_add(&bar[XB_XSUB(b.x)], 1u);
        const unsigned gen = old / nloc;
        if (old + 1u == (gen + 1u) * nloc) {
            __builtin_amdgcn_fence(__ATOMIC_RELEASE, "agent");
            asm volatile("s_waitcnt vmcnt(0)" ::: "memory");
            const unsigned og = xb_add(&bar[XB_TOP], 1u);
            const unsigned tg = og / nx;
            if (og + 1u == (tg + 1u) * nx) xb_add(&bar[XB_TOPGEN], 1u);
            else XB_SPIN(xb_ld(&bar[XB_TOPGEN]) == tg, bar);
            __builtin_amdgcn_fence(__ATOMIC_ACQUIRE, "agent");
            xb_add(&bar[XB_XGEN(b.x)], 1u);
            asm volatile("s_waitcnt vmcnt(0)" ::: "memory");
        } else {
            XB_SPIN(xb_ld(&bar[XB_XGEN(b.x)]) == gen, bar);
            __builtin_amdgcn_fence(__ATOMIC_ACQUIRE, "agent");
            asm volatile("s_waitcnt vmcnt(0)" ::: "memory");
        }
    }
    __syncthreads();
}

struct Frame {
    LAS unsigned char* lds;
    volatile LAS unsigned* MISC;
    gu32* ctl;
    int tid, lane, wave;
    int vcu, G;
    float* out; unsigned char* ws;
};
struct Args { const float* in[22]; float* out; unsigned char* ws; int ph_lo, ph_hi, li, pad; };
enum { I_X = 0, I_N1G, I_WIN, I_QNG, I_KNG, I_AOG, I_MU, I_W0, I_W2, I_A0, I_A2, I_G2, I_KK, I_KA, I_RK, I_LNG, I_LNB, I_WOUT, I_N2G, I_WG, I_WU, I_WD };

__device__ __forceinline__ float wave_sum(float v) {
#pragma unroll
    for (int o = 1; o < 64; o <<= 1) v += __shfl_xor(v, o);
    return v;
}
__device__ __forceinline__ float red16(float x) {
    x += __builtin_bit_cast(float, __builtin_amdgcn_update_dpp(0, __builtin_bit_cast(int, x), 0x128, 0xf, 0xf, false));
    x += __builtin_bit_cast(float, __builtin_amdgcn_update_dpp(0, __builtin_bit_cast(int, x), 0x124, 0xf, 0xf, false));
    x += __builtin_bit_cast(float, __builtin_amdgcn_update_dpp(0, __builtin_bit_cast(int, x), 0x122, 0xf, 0xf, false));
    x += __builtin_bit_cast(float, __builtin_amdgcn_update_dpp(0, __builtin_bit_cast(int, x), 0x121, 0xf, 0xf, false));
    return x;
}

constexpr int TR_SCR = 64 * 65 * 4 + 256;
__device__ __forceinline__ int tr_row(int rmode, int n) {
    return rmode == 0 ? n : rmode == 3 ? (n < 1024 ? ((n >> 8) * 256 + ((n >> 5) & 1) * 128 + ((n >> 6) & 3) * 32 + (n & 31)) : n) : ((n >> 7) * 256 + (n & 127) + (rmode == 2 ? 128 : 0));
}
__device__ __forceinline__ void p0_transpose_item(const float* W, int K, int N, bf16* WT, int rmode, LAS float* scr, int item, int lane, const float* ksc = nullptr) {
    const int nblk = N / 64, kb = item / nblk, nb = item % nblk, k0 = 64 * kb, n0 = 64 * nb;
    const int ks = lane >> 4, n4 = (lane & 15) * 4;
    f32x4 v[16];
#pragma unroll
    for (int i = 0; i < 16; ++i) v[i] = *(const GAS f32x4*)((const GAS float*)W + (size_t)(k0 + 4 * i + ks) * N + n0 + n4);
#pragma unroll
    for (int i = 0; i < 16; ++i) { const int kk = 4 * i + ks; const float sc = ksc ? ksc[k0 + kk] : 1.0f;
        scr[kk * 65 + n4 + 0] = v[i].x * sc; scr[kk * 65 + n4 + 1] = v[i].y * sc; scr[kk * 65 + n4 + 2] = v[i].z * sc; scr[kk * 65 + n4 + 3] = v[i].w * sc; }
    LDS_WAIT(); asm volatile("" ::: "memory");
    GAS v4u* dst = (GAS v4u*)(WT + (size_t)tr_row(rmode, n0 + lane) * K + k0);
#pragma unroll
    for (int j = 0; j < 8; ++j) { const LAS float* c = scr + (8 * j) * 65 + lane;
        v4u o; o.x = pk2(c[0 * 65], c[1 * 65]); o.y = pk2(c[2 * 65], c[3 * 65]); o.z = pk2(c[4 * 65], c[5 * 65]); o.w = pk2(c[6 * 65], c[7 * 65]);
        dst[j] = o; }
    LDS_WAIT(); asm volatile("" ::: "memory");
}
template <int NR> __device__ __forceinline__ void rms_rows_to_bf16(int lane, const float* x0, size_t rstride, const float* g, bf16* o0, size_t ostride) {
    const GAS f32x4* gr = (const GAS f32x4*)g + lane;
    f32x4 v[NR][4];
#pragma unroll
    for (int r = 0; r < NR; ++r) { const GAS f32x4* xr = (const GAS f32x4*)(x0 + r * rstride) + lane;
#pragma unroll
        for (int j = 0; j < 4; ++j) v[r][j] = xr[64 * j]; }
    f32x4 gg[4];
#pragma unroll
    for (int j = 0; j < 4; ++j) gg[j] = gr[64 * j];
#pragma unroll
    for (int r = 0; r < NR; ++r) { float s = 0.f;
#pragma unroll
        for (int j = 0; j < 4; ++j) s += (v[r][j].x * v[r][j].x + v[r][j].y * v[r][j].y) + (v[r][j].z * v[r][j].z + v[r][j].w * v[r][j].w);
        const float rstd = 1.f / sqrtf(wave_sum(s) * (1.f / D) + NORM_EPS);
        GAS unsigned long long* o8 = (GAS unsigned long long*)(o0 + r * ostride) + lane;
#pragma unroll
        for (int j = 0; j < 4; ++j)
            o8[64 * j] = (unsigned long long)pk2(v[r][j].x * rstd * gg[j].x, v[r][j].y * rstd * gg[j].y) | ((unsigned long long)pk2(v[r][j].z * rstd * gg[j].z, v[r][j].w * rstd * gg[j].w) << 32); }
}

__device__ __forceinline__ void p0_prologue(Frame& F, const Args& AR) {
    LAS float* scr = (LAS float*)(F.lds + RING_OFF + F.wave * TR_SCR);
    const int gw = F.vcu * NWAVES + F.wave, NGW = F.G * NWAVES;
    bf16* Win_t = (bf16*)(F.ws + WS_WIN); bf16* Wout_t = (bf16*)(F.ws + WS_WOUT); bf16* Wgu_t = (bf16*)(F.ws + WS_WGU); bf16* Wdn_t = (bf16*)(F.ws + WS_WDN); bf16* Wl_t = (bf16*)(F.ws + WS_WL);
    constexpr int I_IN = (D / 64) * (IN_COLS / 64);
    for (int it = gw; it < I_IN; it += NGW) p0_transpose_item(AR.in[I_WIN], D, IN_COLS, Win_t, 3, scr, it, F.lane);
    for (int e = (F.vcu * NWAVES * 64 + F.tid); e < WLF_ELEMS; e += F.G * NWAVES * 64) {
        const int kind = e < WLF_K01 ? 0 : (e < 2 * WLF_K01 ? 1 : 2), r = e - (kind == 2 ? 2 * WLF_K01 : kind * WLF_K01);
        const int ee = r & 7, ln = (r >> 3) & 63, b = (r >> 9) & 3, s = kind == 2 ? (r >> 11) & 3 : (r >> 11) & 1, g = kind == 2 ? r >> 13 : r >> 12;
        const int k = 32 * s + 8 * (ln >> 4) + ee, c = 64 * g + 32 * (b >> 1) + 8 * ((ln & 15) >> 2) + 4 * (b & 1) + (ln & 3);
        const float* W = kind == 0 ? AR.in[I_W2] : (kind == 1 ? AR.in[I_A2] : AR.in[I_G2]);
        Wl_t[e] = (bf16)f2bf(W[k * 512 + c]);
    }
    bf16* XN = (bf16*)(F.ws + WS_XN);
    for (int m = gw * 4; m < M; m += NGW * 4) rms_rows_to_bf16<4>(F.lane, AR.in[I_X] + (size_t)m * D, D, AR.in[I_N1G], XN + (size_t)m * D, D);
}

constexpr int LR_ROWB = 528;
#define MFMA16(a, b, c) __builtin_amdgcn_mfma_f32_16x16x32_bf16((a), (b), (c), 0, 0, 0)
template <int KIND> __device__ __forceinline__ void p3_kind(const LAS unsigned char* At, const bf16* WLF, bf16* DAG, const float* bias, int m0, int wave, int lane) {
    constexpr int KS = KIND == 2 ? 4 : 2, KOFF = KIND == 0 ? 0 : (KIND == 1 ? 64 : 128);
    const int q = lane >> 4, t = lane & 15;
    const GAS v4u* wf = (const GAS v4u*)(WLF + (KIND == 2 ? 2 * WLF_K01 : KIND * WLF_K01)) + (size_t)wave * KS * 4 * 64 + lane;
    bf16x8 Af[KS][4];
#pragma unroll
    for (int s = 0; s < KS; ++s)
#pragma unroll
        for (int b = 0; b < 4; ++b) Af[s][b] = __builtin_bit_cast(bf16x8, wf[(s * 4 + b) * 64]);
    f32x4 bs[2][2];
    if (KIND != 2) {
#pragma unroll
        for (int p = 0; p < 2; ++p) { const GAS f32x4* bp = (const GAS f32x4*)((const GAS float*)bias + 64 * wave + 32 * p + 8 * q); bs[p][0] = bp[0]; bs[p][1] = bp[1]; }
    }
    const LAS unsigned char* ap = At + t * LR_ROWB + (KOFF + 8 * q) * 2;
    GAS bf16* dp = (GAS bf16*)DAG + (size_t)(m0 + t) * NLORA + KIND * 512 + 64 * wave + 8 * q;
    const f32x4 z4 = {0.f, 0.f, 0.f, 0.f};
#pragma unroll 2
    for (int tb = 0; tb < 8; ++tb) {
        bf16x8 Bf[KS];
#pragma unroll
        for (int s = 0; s < KS; ++s) Bf[s] = *(const LAS bf16x8*)(ap + tb * 16 * LR_ROWB + 64 * s);
        f32x4 acc[4];
#pragma unroll
        for (int b = 0; b < 4; ++b) { acc[b] = MFMA16(Af[0][b], Bf[0], z4);
#pragma unroll
            for (int s = 1; s < KS; ++s) acc[b] = MFMA16(Af[s][b], Bf[s], acc[b]); }
#pragma unroll
        for (int p = 0; p < 2; ++p) {
            f32x4 v0 = acc[2 * p], v1 = acc[2 * p + 1];
            if (KIND != 2) {
                v0 += bs[p][0]; v1 += bs[p][1];
#pragma unroll
                for (int e = 0; e < 4; ++e) { v0[e] = fsig(v0[e]); v1[e] = fsig(v1[e]); }
                if (KIND == 0) { v0 *= -0.6065306597126334f; v1 *= -0.6065306597126334f; }
            }
            v4u w; w.x = cvt2(v0[0], v0[1]); w.y = cvt2(v0[2], v0[3]); w.z = cvt2(v1[0], v1[1]); w.w = cvt2(v1[2], v1[3]);
            *(GAS v4u*)(dp + (size_t)tb * 16 * NLORA + 32 * p) = w;
        }
    }
}
__device__ __forceinline__ void p3_lora(Frame& F, const Args& AR) {
    const int lane = F.lane, wave = F.wave;
    const bf16* PROJ = (const bf16*)(F.ws + WS_PROJ); const bf16* WLF = (const bf16*)(F.ws + WS_WL); bf16* DAG = (bf16*)(F.ws + WS_DAG);
    LAS unsigned char* At = F.lds + RING_OFF;
    const f32x4 mu4 = *(const f32x4*)(AR.in[I_MU] + RC_L + 4 * lane);
    for (int u = F.vcu; u < M / 128; u += F.G) {
        const int m0 = u * 128, t0 = 16 * wave;
        const GAS bf16* row = (const GAS bf16*)PROJ + (size_t)(m0 + t0) * IN_COLS + PC_RW + RC_L + 4 * lane;
        v2u w[17];
        w[0] = (v2u){0u, 0u};
        if (((m0 + t0) & (SEQ - 1)) != 0) w[0] = *(const GAS v2u*)(row - IN_COLS);
#pragma unroll
        for (int i = 0; i < 16; ++i) w[i + 1] = *(const GAS v2u*)(row + (size_t)i * IN_COLS);
#pragma unroll
        for (int i = 0; i < 16; ++i) {
            const v2u cu = w[i + 1], pv = w[i];
            const float c4[4] = {bflo(cu.x), bfhi(cu.x), bflo(cu.y), bfhi(cu.y)}, p4[4] = {bflo(pv.x), bfhi(pv.x), bflo(pv.y), bfhi(pv.y)};
            float xs[4];
#pragma unroll
            for (int e = 0; e < 4; ++e) { const float v = c4[e] + (p4[e] - c4[e]) * mu4[e];
                if (lane < 16) { const float tt = __builtin_amdgcn_exp2f(2.f * LOG2E * v); xs[e] = 1.f - 2.f * __builtin_amdgcn_rcpf(tt + 1.f); }
                else if (lane < 32) xs[e] = v;
                else xs[e] = fsig(v); }
            *(LAS v2u*)(At + (t0 + i) * LR_ROWB + 8 * lane) = (v2u){pk2(xs[0], xs[1]), pk2(xs[2], xs[3])};
        }
        __syncthreads();
        p3_kind<0>(At, WLF, DAG, AR.in[I_W0], m0, wave, lane);
        p3_kind<1>(At, WLF, DAG, AR.in[I_A0], m0, wave, lane);
        p3_kind<2>(At, WLF, DAG, nullptr, m0, wave, lane);
        __syncthreads();
    }
}

__device__ __forceinline__ float red8(float x) {
    x += __builtin_bit_cast(float, __builtin_amdgcn_update_dpp(0, __builtin_bit_cast(int, x), 0xB1, 0xf, 0xf, false));
    x += __builtin_bit_cast(float, __builtin_amdgcn_update_dpp(0, __builtin_bit_cast(int, x), 0x4E, 0xf, 0xf, false));
    x += __builtin_bit_cast(float, __builtin_amdgcn_update_dpp(0, __builtin_bit_cast(int, x), 0x141, 0xf, 0xf, false));
    return x;
}
__device__ __forceinline__ float redrows(float x) {
    { auto r = __builtin_amdgcn_permlane16_swap(__float_as_uint(x), __float_as_uint(x), false, false); x = __uint_as_float(r[0]) + __uint_as_float(r[1]); }
    { auto r = __builtin_amdgcn_permlane32_swap(__float_as_uint(x), __float_as_uint(x), false, false); x = __uint_as_float(r[0]) + __uint_as_float(r[1]); }
    return x;
}
constexpr int CS = 16, NCHUNK = SEQ / CS, NHELP = 4, NSTATE = 4, NIT = (NCHUNK + NHELP - 1) / NHELP;
constexpr int ROWB = 144, TILEB = 40;
constexpr int SL_A = 0, SL_R = 16 * ROWB, SL_B = 32 * ROWB, SL_K = 48 * ROWB, SL_V = 64 * ROWB, SL_T = 80 * ROWB, SL_LAK = SL_T + 16 * TILEB, SL_LRB = SL_LAK + 16 * TILEB, SL_LRK = SL_LRB + 16 * TILEB,
              SL_G = SL_LRK + 16 * TILEB, SL_BON = SL_G + 256, SL_INV = SL_BON + 64, SL_BYTES = SL_INV + 64;
static_assert(SL_BYTES % 16 == 0 && SL_T % 8 == 0, "slot alignment");
constexpr int SC_CONST = 2 * NHELP * SL_BYTES;
constexpr int SC_YL = SC_CONST + 6 * 64 * 4, YL_BYTES = NHELP * CS * 256;
constexpr int SC_TS = SC_YL + 2 * YL_BYTES;
static_assert(SC_TS + NSTATE * NHELP * 16 * TILEB <= RING_BYTES && NHELP * CS * 8 == 2 * NSTATE * 64 && NCHUNK % NHELP == 0 && NHELP % 2 == 0, "scan LDS");
struct HReg { v4u r[2], k[2], v[2], pr[2], pk[2], pv[2], e[2], a[2]; };
__device__ __forceinline__ void helper_load(HReg& R, const bf16* PROJ, const bf16* DAG, int tok, int h, int kg) {
    const GAS bf16* row = (const GAS bf16*)PROJ + (size_t)tok * IN_COLS + PC_RW + h * 64 + 16 * kg;
    const GAS bf16* rowp = row - IN_COLS;
    const GAS bf16* dr = (const GAS bf16*)DAG + (size_t)tok * NLORA + h * 64 + 16 * kg;
    asm volatile("" : "+v"(row)); asm volatile("" : "+v"(rowp)); asm volatile("" : "+v"(dr));
    const bool hp = (tok & (SEQ - 1)) != 0;
#pragma unroll
    for (int i = 0; i < 2; ++i) {
        R.r[i] = *(const GAS v4u*)(row + RC_R + 8 * i); R.k[i] = *(const GAS v4u*)(row + RC_K + 8 * i); R.v[i] = *(const GAS v4u*)(row + RC_V + 8 * i);
        if (hp) { R.pr[i] = *(const GAS v4u*)(rowp + RC_R + 8 * i); R.pk[i] = *(const GAS v4u*)(rowp + RC_K + 8 * i); R.pv[i] = *(const GAS v4u*)(rowp + RC_V + 8 * i); }
        else { R.pr[i] = (v4u){0u, 0u, 0u, 0u}; R.pk[i] = R.pr[i]; R.pv[i] = R.pr[i]; }
        R.e[i] = *(const GAS v4u*)(dr + 8 * i); R.a[i] = *(const GAS v4u*)(dr + 512 + 8 * i);
    }
}
__device__ __forceinline__ void unpack4(const unsigned w0, const unsigned w1, float (&x)[4]) { x[0] = bflo(w0); x[1] = bfhi(w0); x[2] = bflo(w1); x[3] = bfhi(w1); }
__device__ __forceinline__ float dpp_shr(float x, const int ctrl_sel) {
    int r;
    if (ctrl_sel == 1) r = __builtin_amdgcn_update_dpp(0, __builtin_bit_cast(int, x), 0x111, 0xf, 0xf, true);
    else if (ctrl_sel == 2) r = __builtin_amdgcn_update_dpp(0, __builtin_bit_cast(int, x), 0x112, 0xf, 0xf, true);
    else if (ctrl_sel == 4) r = __builtin_amdgcn_update_dpp(0, __builtin_bit_cast(int, x), 0x114, 0xf, 0xf, true);
    else r = __builtin_amdgcn_update_dpp(0, __builtin_bit_cast(int, x), 0x118, 0xf, 0xf, true);
    return __builtin_bit_cast(float, r);
}
__device__ __forceinline__ unsigned cvt2s(float lo, float hi) { asm volatile("" : "+v"(lo), "+v"(hi)); return cvt2(lo, hi); }
__device__ __forceinline__ bf16x8 mk8(unsigned a, unsigned b, unsigned c, unsigned d) { return __builtin_bit_cast(bf16x8, (v4u){a, b, c, d}); }
__device__ __forceinline__ bf16x8 accB(const f32x4 v) { return mk8(cvt2(v[0], v[1]), cvt2(v[2], v[3]), 0u, 0u); }
__device__ __forceinline__ v2u trd(const LAS unsigned char* p) { typedef short v4i16_t __attribute__((ext_vector_type(4)));
    return __builtin_bit_cast(v2u, __builtin_amdgcn_ds_read_tr16_b64_v4i16((LAS v4i16_t*)p)); }
#define PIN_PTR(p) asm volatile("" : "+v"(p))

#define HR_UNPACK(dst, arr, gp) do { if ((gp) & 1) unpack4(R.arr[(gp) >> 1].z, R.arr[(gp) >> 1].w, dst); else unpack4(R.arr[(gp) >> 1].x, R.arr[(gp) >> 1].y, dst); } while (0)
__device__ __forceinline__ void helper_chunk(LAS unsigned char* slot, const LAS float* cst, HReg& R, bool prefetch, const bf16* PROJ, const bf16* DAG, float* BON, int tok, int h, int lane) {
    const int t = lane & 15, kg = lane >> 4;
    LAS unsigned char* p_row = slot + t * ROWB + kg * 16;
    LAS unsigned char* p_v = slot + SL_V + t * ROWB + kg * 32;
    LAS unsigned char* p_tw = slot + t * TILEB + kg * 8;
    LAS unsigned char* p_g = slot + SL_G + kg * 16;
    const LAS float* p_c = cst + 16 * kg;
    PIN_PTR(p_row); PIN_PTR(p_v); PIN_PTR(p_tw); PIN_PTR(p_g); PIN_PTR(p_c);
    float E[16], G[16], GI[16], GP[16];
#pragma unroll
    for (int gp = 0; gp < 4; ++gp) { float e[4]; HR_UNPACK(e, e, gp);
#pragma unroll
        for (int i = 0; i < 4; ++i) E[4 * gp + i] = e[i]; }
#pragma unroll
    for (int q = 0; q < 16; ++q) E[q] += dpp_shr(E[q], 1);
#pragma unroll
    for (int q = 0; q < 16; ++q) E[q] += dpp_shr(E[q], 2);
#pragma unroll
    for (int q = 0; q < 16; ++q) E[q] += dpp_shr(E[q], 4);
#pragma unroll
    for (int q = 0; q < 16; ++q) E[q] += dpp_shr(E[q], 8);
#pragma unroll
    for (int q = 0; q < 16; ++q) { G[q] = __builtin_amdgcn_exp2f(LOG2E * E[q]); GI[q] = __builtin_amdgcn_exp2f(-LOG2E * E[q]); }
#pragma unroll
    for (int q = 0; q < 16; ++q) { const float gpv = dpp_shr(G[q], 1); GP[q] = (t == 0) ? 1.f : gpv; }
    if (t == 15) {
#pragma unroll
        for (int gp = 0; gp < 4; ++gp) *(LAS f32x4*)(p_g + gp * 64) = (f32x4){G[4 * gp], G[4 * gp + 1], G[4 * gp + 2], G[4 * gp + 3]};
    }
    float ss = 0.f, bon = 0.f;
#pragma unroll
    for (int gp = 0; gp < 4; ++gp) {
        float r[4], k[4], v[4], pr[4], pk[4], pv[4], a[4];
        HR_UNPACK(r, r, gp); HR_UNPACK(k, k, gp); HR_UNPACK(v, v, gp); HR_UNPACK(pr, pr, gp); HR_UNPACK(pk, pk, gp); HR_UNPACK(pv, pv, gp); HR_UNPACK(a, a, gp);
        const f32x4 mur = *(const LAS f32x4*)(p_c + 0 * 64 + 4 * gp), muk = *(const LAS f32x4*)(p_c + 1 * 64 + 4 * gp), muv = *(const LAS f32x4*)(p_c + 2 * 64 + 4 * gp);
        const f32x4 kkc = *(const LAS f32x4*)(p_c + 3 * 64 + 4 * gp), kac = *(const LAS f32x4*)(p_c + 4 * 64 + 4 * gp), rkc = *(const LAS f32x4*)(p_c + 5 * 64 + 4 * gp);
        float xv[4], At[4], Rt[4], Bt[4], Kt[4];
#pragma unroll
        for (int i = 0; i < 4; ++i) { const int q = 4 * gp + i;
            const float xr = r[i] + (pr[i] - r[i]) * mur[i], xk = k[i] + (pk[i] - k[i]) * muk[i]; xv[i] = v[i] + (pv[i] - v[i]) * muv[i];
            const float kkv = xk * kkc[i], kpv = xk * (1.f + (a[i] - 1.f) * kac[i]); ss += kkv * kkv; bon += xr * kpv * rkc[i];
            At[i] = -kkv * GP[q]; Rt[i] = xr * G[q]; Bt[i] = kkv * a[i] * GI[q]; Kt[i] = kpv * GI[q]; }
        *(LAS v2u*)(p_v + gp * 8) = (v2u){cvt2s(xv[0], xv[1]), cvt2s(xv[2], xv[3])};
        const int co = (gp >> 1) * 64 + (gp & 1) * 8;
        *(LAS v2u*)(p_row + SL_A + co) = (v2u){cvt2s(At[0], At[1]), cvt2s(At[2], At[3])}; *(LAS v2u*)(p_row + SL_R + co) = (v2u){cvt2s(Rt[0], Rt[1]), cvt2s(Rt[2], Rt[3])};
        *(LAS v2u*)(p_row + SL_B + co) = (v2u){cvt2s(Bt[0], Bt[1]), cvt2s(Bt[2], Bt[3])}; *(LAS v2u*)(p_row + SL_K + co) = (v2u){cvt2s(Kt[0], Kt[1]), cvt2s(Kt[2], Kt[3])};
    }
    ss = redrows(ss); bon = redrows(bon);
    const float inv = __builtin_amdgcn_rsqf(fmaxf(ss, 1e-24f));
    if (kg == 0) { *(LAS float*)(slot + SL_BON + t * 4) = bon; *(LAS float*)(slot + SL_INV + t * 4) = inv; }
    if (prefetch) helper_load(R, PROJ, DAG, tok + NHELP * CS, h, kg);
    const bf16x8 FA0 = *(const LAS bf16x8*)(p_row + SL_A), FA1 = *(const LAS bf16x8*)(p_row + SL_A + 64), FR0 = *(const LAS bf16x8*)(p_row + SL_R), FR1 = *(const LAS bf16x8*)(p_row + SL_R + 64);
    const bf16x8 FB0 = *(const LAS bf16x8*)(p_row + SL_B), FB1 = *(const LAS bf16x8*)(p_row + SL_B + 64), FK0 = *(const LAS bf16x8*)(p_row + SL_K), FK1 = *(const LAS bf16x8*)(p_row + SL_K + 64);
    const f32x4 z4 = (f32x4){0.f, 0.f, 0.f, 0.f};
    f32x4 Lab = MFMA16(FA0, FB0, z4); Lab = MFMA16(FA1, FB1, Lab);
    f32x4 Lak = MFMA16(FA0, FK0, z4); Lak = MFMA16(FA1, FK1, Lak);
    f32x4 Lrb = MFMA16(FR0, FB0, z4); Lrb = MFMA16(FR1, FB1, Lrb);
    f32x4 Lrk = MFMA16(FR0, FK0, z4); Lrk = MFMA16(FR1, FK1, Lrk);
    const int s = t;
#pragma unroll
    for (int r = 0; r < 4; ++r) { const int tt = 4 * kg + r;
        Lab[r] = tt > s ? Lab[r] : 0.f; Lak[r] = tt > s ? Lak[r] : 0.f; Lrb[r] = tt >= s ? Lrb[r] : 0.f; Lrk[r] = tt >= s ? Lrk[r] : 0.f; }
    { const f32x4 ir = *(const LAS f32x4*)(slot + SL_INV + 16 * kg);
      Lab = Lab * ir * inv; }
#define WR_TILE(off, X) (*(LAS v2u*)(p_tw + (off)) = (v2u){cvt2((X)[0], (X)[1]), cvt2((X)[2], (X)[3])})
    WR_TILE(SL_LAK, Lak); WR_TILE(SL_LRB, Lrb); WR_TILE(SL_LRK, Lrk); WR_TILE(SL_T, Lab);
#undef WR_TILE
}

struct SOps { bf16x8 a0, a1, r0, r1; v2u vt, lak, lrb, lrk, bb[4], kk2[4]; f32x4 gm[4], bn, iv; };
__device__ __forceinline__ void state_load(SOps& O, const LAS unsigned char* slot, int lane, int wv) {
    const int c = lane & 15, g = lane >> 4, q4 = 4 * g + (c >> 2), pp = c & 3;
    const LAS unsigned char* p128 = slot + c * ROWB + g * 16;
    const LAS unsigned char* p_bt = slot + q4 * ROWB + pp * 16;
    const LAS unsigned char* p_tr = slot + q4 * TILEB + pp * 8;
    const LAS unsigned char* p_v = slot + SL_V + q4 * ROWB + wv * 32 + pp * 8;
    const LAS unsigned char* pg = slot + SL_G + g * 16;
    PIN_PTR(p128); PIN_PTR(p_bt); PIN_PTR(p_tr); PIN_PTR(p_v); PIN_PTR(pg);
    O.a0 = *(const LAS bf16x8*)(p128 + SL_A); O.a1 = *(const LAS bf16x8*)(p128 + SL_A + 64); O.r0 = *(const LAS bf16x8*)(p128 + SL_R); O.r1 = *(const LAS bf16x8*)(p128 + SL_R + 64);
    O.vt = trd(p_v); O.lak = trd(p_tr + SL_LAK); O.lrb = trd(p_tr + SL_LRB); O.lrk = trd(p_tr + SL_LRK);
#pragma unroll
    for (int jb = 0; jb < 4; ++jb) { O.bb[jb] = trd(p_bt + SL_B + (jb >> 1) * 64 + (jb & 1) * 8); O.kk2[jb] = trd(p_bt + SL_K + (jb >> 1) * 64 + (jb & 1) * 8); O.gm[jb] = *(const LAS f32x4*)(pg + jb * 64); }
    O.bn = *(const LAS f32x4*)(slot + SL_BON + 16 * g); O.iv = *(const LAS f32x4*)(slot + SL_INV + 16 * g);
}
__device__ __forceinline__ void state_compute(const SOps& O, const v2u tt, f32x4 (&X)[4], LAS unsigned char* yl, int lane, int wv) {
    const int c = lane & 15, g = lane >> 4;
    const f32x4 z4 = (f32x4){0.f, 0.f, 0.f, 0.f};
    const bf16x8 xb0 = mk8(cvt2(X[0][0], X[0][1]), cvt2(X[0][2], X[0][3]), cvt2(X[1][0], X[1][1]), cvt2(X[1][2], X[1][3]));
    const bf16x8 xb1 = mk8(cvt2(X[2][0], X[2][1]), cvt2(X[2][2], X[2][3]), cvt2(X[3][0], X[3][1]), cvt2(X[3][2], X[3][3]));
    f32x4 Z = MFMA16(O.a0, xb0, z4); Z = MFMA16(O.a1, xb1, Z); Z = MFMA16(mk8(O.lak.x, O.lak.y, 0u, 0u), mk8(O.vt.x, O.vt.y, 0u, 0u), Z) * O.iv;
    const f32x4 U = MFMA16(mk8(tt.x, tt.y, 0u, 0u), accB(Z), z4) * O.iv;
    const bf16x8 uv = mk8(cvt2(U[0], U[1]), cvt2(U[2], U[3]), O.vt.x, O.vt.y);
    f32x4 Y = MFMA16(O.r0, xb0, z4); Y = MFMA16(O.r1, xb1, Y); Y = MFMA16(mk8(O.lrb.x, O.lrb.y, O.lrk.x, O.lrk.y), uv, Y);
#pragma unroll
    for (int jb = 0; jb < 4; ++jb) X[jb] = MFMA16(mk8(O.bb[jb].x, O.bb[jb].y, O.kk2[jb].x, O.kk2[jb].y), uv, X[jb]) * O.gm[jb];
    LAS unsigned char* py = yl + (4 * g) * 256 + (16 * wv + c) * 2;
    PIN_PTR(py);
    const float vv[4] = {bflo(O.vt.x), bfhi(O.vt.x), bflo(O.vt.y), bfhi(O.vt.y)};
#pragma unroll
    for (int r = 0; r < 4; ++r) { *(LAS unsigned short*)(py + r * 256) = (unsigned short)f2bf(Y[r]); *(LAS unsigned short*)(py + r * 256 + 128) = (unsigned short)f2bf(O.bn[r] * vv[r]); }
}
__device__ __forceinline__ void state_T(v2u (&tt)[NHELP], const LAS unsigned char* set0, LAS unsigned char* scr, int lane) {
    const int c = lane & 15, g = lane >> 4;
    const int o_w = c * TILEB + g * 8, o_r = (4 * g + (c >> 2)) * TILEB + (c & 3) * 8;
    const f32x4 z4 = (f32x4){0.f, 0.f, 0.f, 0.f};
    bf16x8 A1[NHELP], A2[NHELP], A4[NHELP]; f32x4 P[NHELP];
#pragma unroll
    for (int k = 0; k < NHELP; ++k) { const LAS unsigned char* tl = set0 + k * SL_BYTES + SL_T;
        const v2u bl = *(const LAS v2u*)(tl + o_w), al = trd(tl + o_r); A1[k] = mk8(al.x, al.y, 0u, 0u); P[k] = MFMA16(A1[k], mk8(bl.x, bl.y, 0u, 0u), z4); }
#pragma unroll
    for (int k = 0; k < NHELP; ++k) *(LAS v2u*)(scr + k * (16 * TILEB) + o_w) = (v2u){cvt2(P[k][0], P[k][1]), cvt2(P[k][2], P[k][3])};
#pragma unroll
    for (int k = 0; k < NHELP; ++k) { const v2u al = trd(scr + k * (16 * TILEB) + o_r); A2[k] = mk8(al.x, al.y, 0u, 0u); P[k] = MFMA16(A2[k], accB(P[k]), z4); }
#pragma unroll
    for (int k = 0; k < NHELP; ++k) *(LAS v2u*)(scr + k * (16 * TILEB) + o_w) = (v2u){cvt2(P[k][0], P[k][1]), cvt2(P[k][2], P[k][3])};
#pragma unroll
    for (int k = 0; k < NHELP; ++k) { const v2u al = trd(scr + k * (16 * TILEB) + o_r); A4[k] = mk8(al.x, al.y, 0u, 0u); P[k] = MFMA16(A4[k], accB(P[k]), z4); }
#pragma unroll
    for (int k = 0; k < NHELP; ++k) {
#pragma unroll
        for (int r = 0; r < 4; ++r) P[k][r] += (4 * g + r == c) ? 1.f : 0.f; }
#pragma unroll
    for (int k = 0; k < NHELP; ++k) P[k] = MFMA16(A4[k], accB(P[k]), P[k]);
#pragma unroll
    for (int k = 0; k < NHELP; ++k) P[k] = MFMA16(A2[k], accB(P[k]), P[k]);
#pragma unroll
    for (int k = 0; k < NHELP; ++k) P[k] = MFMA16(A1[k], accB(P[k]), P[k]);
#pragma unroll
    for (int k = 0; k < NHELP; ++k) *(LAS v2u*)(scr + k * (16 * TILEB) + o_w) = (v2u){cvt2(P[k][0], P[k][1]), cvt2(P[k][2], P[k][3])};
#pragma unroll
    for (int k = 0; k < NHELP; ++k) tt[k] = trd(scr + k * (16 * TILEB) + o_r);
}

__device__ __forceinline__ void p4_scan(Frame& F, const Args& AR) {
    const bf16* PROJ = (const bf16*)(F.ws + WS_PROJ); const bf16* DAG = (const bf16*)(F.ws + WS_DAG);
    float* BON = nullptr; bf16* MIX = (bf16*)(F.ws + WS_XN);
    LAS unsigned char* lds = F.lds + RING_OFF;
    LAS float* cst = (LAS float*)(lds + SC_CONST);
    const int tid = F.tid, lane = F.lane, wave = F.wave;
    for (int unit = blockIdx.x; unit < BATCH * NH; unit += F.G) {
        const int b = unit >> 3, h = unit & 7;
        const int tok0 = b * SEQ;
        if (tid < 384) { const int a = tid >> 6, c = tid & 63; const float* src = a == 0 ? AR.in[I_MU] + RC_R : a == 1 ? AR.in[I_MU] + RC_K : a == 2 ? AR.in[I_MU] + RC_V : a == 3 ? AR.in[I_KK] : a == 4 ? AR.in[I_KA] : AR.in[I_RK];
            cst[a * 64 + c] = src[h * 64 + c]; }
        __syncthreads();
        const int st_k = (tid >> 7) & 1, st_t = (tid >> 3) & 15, st_p = tid & 7;
        GAS v4u* ystore = (GAS v4u*)((GAS bf16*)MIX + (size_t)(tok0 + st_k * CS + st_t) * D + AW + h * 64 + 8 * st_p);
        const GAS v4u* gload = (const GAS v4u*)((const GAS bf16*)DAG + (size_t)(tok0 + st_k * CS + st_t) * NLORA + 1024 + h * 64 + 8 * st_p);
        const LAS unsigned char* yl_rd = lds + SC_YL + st_k * (CS * 256) + st_t * 256 + st_p * 16;
        v4u gnA = (v4u){0u, 0u, 0u, 0u}, gnB = gnA;
        float lng[8], lnb[8];
#pragma unroll
        for (int i = 0; i < 8; ++i) { lng[i] = AR.in[I_LNG][h * 64 + 8 * st_p + i]; lnb[i] = AR.in[I_LNB][h * 64 + 8 * st_p + i]; }
#define RWKV_OUT(it_, KO, gnext) do { if ((it_) >= 2 && NHELP * ((it_) - 2) + st_k + (KO) < NCHUNK) { \
            const v4u gw4 = gnext; \
            const v4u yw = *(const LAS v4u*)(yl_rd + (KO) * (CS * 256) + ((it_) & 1) * YL_BYTES), bw = *(const LAS v4u*)(yl_rd + (KO) * (CS * 256) + ((it_) & 1) * YL_BYTES + 128); \
            float y[8] = {bflo(yw.x), bfhi(yw.x), bflo(yw.y), bfhi(yw.y), bflo(yw.z), bfhi(yw.z), bflo(yw.w), bfhi(yw.w)}; \
            float sm = ((y[0] + y[1]) + (y[2] + y[3])) + ((y[4] + y[5]) + (y[6] + y[7])); \
            sm = red8(sm); \
            const float mean = sm * (1.f / 64.f); float sv = 0.f; \
            _Pragma("unroll") for (int i = 0; i < 8; ++i) { y[i] -= mean; sv += y[i] * y[i]; } \
            sv = red8(sv); \
            const float rs = 1.f / sqrtf(sv * (1.f / 64.f) + LNX_EPS); \
            const float bf_[8] = {bflo(bw.x), bfhi(bw.x), bflo(bw.y), bfhi(bw.y), bflo(bw.z), bfhi(bw.z), bflo(bw.w), bfhi(bw.w)}; \
            const float gf[8] = {bflo(gw4.x), bfhi(gw4.x), bflo(gw4.y), bfhi(gw4.y), bflo(gw4.z), bfhi(gw4.z), bflo(gw4.w), bfhi(gw4.w)}; \
            float ro[8]; \
            _Pragma("unroll") for (int i = 0; i < 8; ++i) ro[i] = (y[i] * rs * lng[i] + lnb[i] + bf_[i]) * gf[i]; \
            ystore[(size_t)(NHELP * ((it_) - 2) + (KO)) * CS * D / 8] = (v4u){pk2(ro[0], ro[1]), pk2(ro[2], ro[3]), pk2(ro[4], ro[5]), pk2(ro[6], ro[7])}; } \
            if ((it_) >= 1 && NHELP * ((it_) - 1) + st_k + (KO) < NCHUNK) gnext = gload[(size_t)(NHELP * ((it_) - 1) + (KO)) * CS * NLORA / 8]; } while (0)
        volatile LAS unsigned* cnt = (volatile LAS unsigned*)(F.lds + LDSCTL_OFF + 128);
        if (tid < 8) cnt[tid] = 0u;
        __syncthreads();
#define LDS_WAIT_GE(idx, target) do { while (cnt[idx] < (unsigned)(target)) __builtin_amdgcn_s_sleep(1); asm volatile("" ::: "memory"); } while (0)
#define LDS_SIGNAL(idx) do { asm volatile("s_waitcnt lgkmcnt(0)" ::: "memory"); if (lane == 0) __hip_atomic_fetch_add((LAS unsigned*)(cnt + (idx)), 1u, __ATOMIC_RELAXED, __HIP_MEMORY_SCOPE_WORKGROUP); } while (0)
        if (wave >= NSTATE) {
            const int hw = wave - NSTATE, kg = lane >> 4, tokl = tok0 + (lane & 15);
            HReg R;
            helper_load(R, PROJ, DAG, tokl + hw * CS, h, kg);
            for (int it = 0; it < NIT; ++it) {
                const int ch = NHELP * it + hw, s_ = it & 1;
                if (it >= 2) LDS_WAIT_GE(2 + s_, NSTATE * (it >> 1));
                helper_chunk(lds + (s_ * NHELP + hw) * SL_BYTES, cst, R, ch + NHELP < NCHUNK, PROJ, DAG, BON, tokl + ch * CS, h, lane);
                LDS_SIGNAL(0 + s_);
            }
        } else {
            f32x4 X[4];
#pragma unroll
            for (int jb = 0; jb < 4; ++jb) X[jb] = (f32x4){0.f, 0.f, 0.f, 0.f};
            for (int j = 0; j <= NIT; ++j) {
                if (j >= 1) { LDS_WAIT_GE(4 + ((j - 1) & 1), NSTATE * (((j - 1) >> 1) + 1));
                    RWKV_OUT(j + 1, 0, gnA); RWKV_OUT(j + 1, 2, gnB);
                    LDS_SIGNAL(6 + ((j - 1) & 1)); }
                else { RWKV_OUT(j + 1, 0, gnA); RWKV_OUT(j + 1, 2, gnB); }
                if (j < NIT) {
                    const int s_ = j & 1;
                    LDS_WAIT_GE(0 + s_, NHELP * ((j >> 1) + 1));
                    if (j >= 2) LDS_WAIT_GE(6 + s_, NSTATE * (j >> 1));
                    const LAS unsigned char* set0 = lds + (s_ * NHELP) * SL_BYTES;
                    LAS unsigned char* ylb = lds + SC_YL + s_ * YL_BYTES;
                    v2u tt[NHELP];
                    SOps Oa, Ob;
                    state_load(Oa, set0, lane, wave);
                    state_T(tt, set0, lds + SC_TS + wave * (NHELP * 16 * TILEB), lane);
#pragma unroll
                    for (int k = 0; k < NHELP; k += 2) {
                        state_load(Ob, set0 + (k + 1) * SL_BYTES, lane, wave);
                        state_compute(Oa, tt[k], X, ylb + k * (CS * 256), lane, wave);
                        if (k + 2 < NHELP) state_load(Oa, set0 + (k + 2) * SL_BYTES, lane, wave);
                        state_compute(Ob, tt[k + 1], X, ylb + (k + 1) * (CS * 256), lane, wave);
                    }
                    LDS_SIGNAL(2 + s_); LDS_SIGNAL(4 + s_);
                }
            }
        }
#undef LDS_WAIT_GE
#undef LDS_SIGNAL
        __syncthreads();
    }
}

__device__ __forceinline__ s16x4 vtr(const LAS unsigned char* p) { typedef short v4i16_t __attribute__((ext_vector_type(4)));
    return __builtin_bit_cast(s16x4, __builtin_amdgcn_ds_read_tr16_b64_v4i16((LAS v4i16_t*)p)); }
constexpr int ATT_UNITS = 3 * BATCH * NH * 16;
__device__ __forceinline__ void p4_attn(Frame& F, const Args& AR) {
    const bf16* PROJ = (const bf16*)(F.ws + WS_PROJ);
    bf16* PO = (bf16*)((unsigned char*)F.out + DO_PO); float* ML = (float*)(F.ws + WS_ML);
    const int tid = F.tid, lane = F.lane, wave = F.wave, half = wave >> 2, wq = wave & 3, th = tid & 255;
    const int r32 = lane & 31, hi = lane >> 5;
    LAS unsigned char* Kl = F.lds + RING_OFF + half * 65536; LAS unsigned char* Vl = Kl + 32768;
    gu32* qctr = F.ctl + CW_ATTQ;
    v4u kst[8], vst[8];
#define ATT_DECODE(up_) const int unit = 2 * (up_) + half; \
        const int pat = unit / (BATCH * NH * 16), rem = unit % (BATCH * NH * 16), bh = rem >> 4, i16 = rem & 15, b = bh >> 3, h = bh & 7; \
        const int dil = pat == 0 ? 1 : (pat == 1 ? 4 : 16); \
        const int res = pat == 0 ? 0 : (pat == 1 ? (i16 >> 2) : i16); \
        const int n = pat == 0 ? i16 : (pat == 1 ? (i16 & 3) : 0); \
        const size_t rowb = (size_t)b * SEQ;
#define ATT_ISSUE(up_) do { ATT_DECODE(up_) const int c = th & 7; \
        _Pragma("unroll") for (int i = 0; i < 8; ++i) { const int key = (th >> 3) + 32 * i; const int sub = 128 * (n - 1) + key; \
            kst[i] = (v4u){0u, 0u, 0u, 0u}; vst[i] = kst[i]; \
            if (sub >= 0) { const GAS bf16* src = (const GAS bf16*)PROJ + (rowb + res + dil * sub) * IN_COLS + h * 64 + 8 * c; kst[i] = *(const GAS v4u*)(src + PC_K); vst[i] = *(const GAS v4u*)(src + PC_V); } } } while (0)
    if (tid == 0) F.MISC[16] = __hip_atomic_fetch_add(qctr, 1u, RLX_AGENT);
    __syncthreads();
    int up = (int)F.MISC[16];
    __syncthreads();
    if (up < ATT_UNITS / 2) ATT_ISSUE(up);
    while (up < ATT_UNITS / 2) {
        if (tid == 0) F.MISC[16] = __hip_atomic_fetch_add(qctr, 1u, RLX_AGENT);
        ATT_DECODE(up)
        const int ql = 32 * wq + r32; const size_t qrow = rowb + res + dil * (128 * n + ql);
        bf16x8 qf[4];
#pragma unroll
        for (int d0 = 0; d0 < 4; ++d0) qf[d0] = *(const GAS bf16x8*)((const GAS bf16*)PROJ + qrow * IN_COLS + PC_Q + h * 64 + 16 * d0 + 8 * hi);
        {
            const int c = th & 7;
#pragma unroll
            for (int i = 0; i < 8; ++i) {
                const int key = (th >> 3) + 32 * i;
                *(LAS v4u*)(Kl + key * 128 + ((c ^ ((key >> 1) & 7)) * 16)) = kst[i];
                *(LAS v4u*)(Vl + (c >> 2) * 16384 + key * 64 + (c & 3) * 16) = vst[i];
            }
        }
        __syncthreads();
        const int upn = (int)F.MISC[16];
        if (upn < ATT_UNITS / 2) { ATT_ISSUE(upn); }
        const float slope2 = __builtin_amdgcn_exp2f(-(float)(h + 1)) * (float)dil * LOG2E;
        const int thr = r32 - 4 * hi;
        f32x16 sc[5];
        float mx = -INFINITY;
#pragma unroll
        for (int kt = 0; kt < 5; ++kt) {
            const bool skip = (n == 0) && (wq + kt < 4);
            f32x16 acc;
            if (!skip) {
                const int key = 32 * (wq + kt) + r32;
                const float bk = -slope2 * (float)(128 - 32 * kt + thr);
#pragma unroll
                for (int r = 0; r < 16; ++r) acc[r] = slope2 * (float)((r & 3) + 8 * (r >> 2)) + bk;
#pragma unroll
                for (int d0 = 0; d0 < 4; ++d0) {
                    const bf16x8 kf = *(const LAS bf16x8*)(Kl + key * 128 + (((2 * d0 + hi) ^ ((key >> 1) & 7)) * 16));
                    acc = __builtin_amdgcn_mfma_f32_32x32x16_bf16(kf, qf[d0], acc, 0, 0, 0);
                }
                if (kt == 0) {
#pragma unroll
                    for (int r = 0; r < 16; ++r) acc[r] = ((r & 3) + 8 * (r >> 2)) >= thr ? acc[r] : -INFINITY;
                }
                if (kt == 4) {
#pragma unroll
                    for (int r = 0; r < 16; ++r) acc[r] = ((r & 3) + 8 * (r >> 2)) <= thr ? acc[r] : -INFINITY;
                }
#pragma unroll
                for (int r = 0; r < 16; ++r) mx = fmaxf(mx, acc[r]);
            } else {
#pragma unroll
                for (int r = 0; r < 16; ++r) acc[r] = -INFINITY;
            }
            sc[kt] = acc;
            __builtin_amdgcn_sched_barrier(0);
        }
        mx = fmaxf(mx, __shfl_xor(mx, 32));
        float l = 0.f;
#pragma unroll
        for (int kt = 0; kt < 5; ++kt)
#pragma unroll
            for (int r = 0; r < 16; ++r) { const float p = __builtin_amdgcn_exp2f(sc[kt][r] - mx); sc[kt][r] = p; l += p; }
        l += __shfl_xor(l, 32);
        f32x16 o[2]; o[0] = f32x16{}; o[1] = f32x16{};
        const int voff = ((lane >> 4) & 1) * 32 + (lane & 3) * 8 + (4 * hi + ((lane & 15) >> 2)) * 64;
#pragma unroll
        for (int kt = 0; kt < 5; ++kt) {
            const bool skip = (n == 0) && (wq + kt < 4);
            if (!skip) {
#pragma unroll
            for (int s2 = 0; s2 < 2; ++s2) {
                v4u pw;
                pw.x = pg8::cvt_pk_bf16(sc[kt][8 * s2 + 0], sc[kt][8 * s2 + 1]); pw.y = pg8::cvt_pk_bf16(sc[kt][8 * s2 + 2], sc[kt][8 * s2 + 3]);
                pw.z = pg8::cvt_pk_bf16(sc[kt][8 * s2 + 4], sc[kt][8 * s2 + 5]); pw.w = pg8::cvt_pk_bf16(sc[kt][8 * s2 + 6], sc[kt][8 * s2 + 7]);
                const bf16x8 pf = __builtin_bit_cast(bf16x8, pw);
                const int kb = 32 * (wq + kt) + 16 * s2;
#pragma unroll
                for (int dt = 0; dt < 2; ++dt) {
                    const LAS unsigned char* vp = Vl + dt * 16384 + kb * 64 + voff;
                    const s16x4 lo = vtr(vp), hi4 = vtr(vp + 8 * 64);
                    const bf16x8 vf = (bf16x8){lo[0], lo[1], lo[2], lo[3], hi4[0], hi4[1], hi4[2], hi4[3]};
                    o[dt] = __builtin_amdgcn_mfma_f32_32x32x16_bf16(vf, pf, o[dt], 0, 0, 0);
                }
            }
            }
        }
        const float rl = 1.f / l;
        bf16* po = PO + ((size_t)pat * M + qrow) * AW + h * 64;
#pragma unroll
        for (int dt = 0; dt < 2; ++dt)
#pragma unroll
            for (int g = 0; g < 4; ++g) {
                const v2u w = (v2u){pk2(o[dt][4 * g] * rl, o[dt][4 * g + 1] * rl), pk2(o[dt][4 * g + 2] * rl, o[dt][4 * g + 3] * rl)};
                *(v2u*)(po + 32 * dt + 8 * g + 4 * hi) = w;
            }
        if (hi == 0) *(f32x2*)(ML + (((size_t)pat * M + qrow) * NH + h) * 2) = (f32x2){mx, l};
        __syncthreads();
        up = upn;
    }
#undef ATT_DECODE
#undef ATT_ISSUE
}

struct P5In { v4u po[3]; f32x2 ml[3]; };
__device__ __forceinline__ void p5_load(P5In& I, int m, int lane, const bf16* PO, const float* ML) {
    const int hd = lane >> 3;
#pragma unroll
    for (int p = 0; p < 3; ++p) { I.ml[p] = *(const GAS f32x2*)(ML + (((size_t)p * M + m) * NH + hd) * 2); I.po[p] = *(const GAS v4u*)(PO + ((size_t)p * M + m) * AW + 8 * lane); }
}
__device__ __forceinline__ void p5_token(const P5In& I, int m, int lane, bf16* MIX, const float (&aog)[8]) {
    const float mm = fmaxf(fmaxf(I.ml[0].x, I.ml[1].x), I.ml[2].x);
    float wp[3], wsum = 0.f;
#pragma unroll
    for (int p = 0; p < 3; ++p) { wp[p] = __builtin_amdgcn_exp2f(I.ml[p].x - mm) * I.ml[p].y; wsum += wp[p]; }
    const float rws = 1.f / wsum;
    float at[8] = {0.f, 0.f, 0.f, 0.f, 0.f, 0.f, 0.f, 0.f};
#pragma unroll
    for (int p = 0; p < 3; ++p) { const v4u w = I.po[p]; const float f = wp[p] * rws;
        at[0] += f * bflo(w.x); at[1] += f * bfhi(w.x); at[2] += f * bflo(w.y); at[3] += f * bfhi(w.y); at[4] += f * bflo(w.z); at[5] += f * bfhi(w.z); at[6] += f * bflo(w.w); at[7] += f * bfhi(w.w); }
    float ss = 0.f;
#pragma unroll
    for (int i = 0; i < 8; ++i) ss += at[i] * at[i];
    ss += __shfl_xor(ss, 1); ss += __shfl_xor(ss, 2); ss += __shfl_xor(ss, 4);
    const float rstd = 1.f / sqrtf(ss * (1.f / 64.f) + NORM_EPS);
    v4u oa; oa.x = pk2(at[0] * rstd * aog[0], at[1] * rstd * aog[1]); oa.y = pk2(at[2] * rstd * aog[2], at[3] * rstd * aog[3]);
    oa.z = pk2(at[4] * rstd * aog[4], at[5] * rstd * aog[5]); oa.w = pk2(at[6] * rstd * aog[6], at[7] * rstd * aog[7]);
    *(GAS v4u*)(MIX + (size_t)m * D + 8 * lane) = oa;
}
__device__ __forceinline__ void p5_post(Frame& F, const Args& AR, int m_lo, int m_hi, int wg, int nwg) {
    const int gw = wg * NWAVES + F.wave, NGW = nwg * NWAVES, lane = F.lane;
    const bf16* PO = (const bf16*)((unsigned char*)F.out + DO_PO); const float* ML = (const float*)(F.ws + WS_ML);
    bf16* MIX = (bf16*)(F.ws + WS_XN);
    float aog[8];
#pragma unroll
    for (int i = 0; i < 8; ++i) aog[i] = AR.in[I_AOG][8 * lane + i];
    static_assert(M % 4 == 0, "four tokens per step");
    for (int m = m_lo + 4 * gw; m < m_hi; m += 4 * NGW) {
        P5In A, B, C, E;
        p5_load(A, m, lane, PO, ML); p5_load(B, m + 1, lane, PO, ML); p5_load(C, m + 2, lane, PO, ML); p5_load(E, m + 3, lane, PO, ML);
        p5_token(A, m, lane, MIX, aog); p5_token(B, m + 1, lane, MIX, aog); p5_token(C, m + 2, lane, MIX, aog); p5_token(E, m + 3, lane, MIX, aog);
    }
}

__device__ __forceinline__ void p1_tail_weights(Frame& F, const Args& AR, int w0, int nw) {
    LAS float* scr = (LAS float*)(F.lds + RING_OFF + F.wave * TR_SCR);
    bf16* Wout_t = (bf16*)(F.ws + WS_WOUT); bf16* Wgu_t = (bf16*)(F.ws + WS_WGU); bf16* Wdn_t = (bf16*)(F.ws + WS_WDN);
    constexpr int I_OUT = (D / 64) * (D / 64), I_G = (D / 64) * (FF / 64), I_DN = (FF / 64) * (D / 64), NLATE = I_OUT + 2 * I_G + I_DN;
    for (int it = w0; it < NLATE; it += nw) {
        int r = it;
        if (r < I_OUT) { p0_transpose_item(AR.in[I_WOUT], D, D, Wout_t, 0, scr, r, F.lane); continue; } r -= I_OUT;
        if (r < I_G) { p0_transpose_item(AR.in[I_WG], D, FF, Wgu_t, 1, scr, r, F.lane, AR.in[I_N2G]); continue; } r -= I_G;
        if (r < I_G) { p0_transpose_item(AR.in[I_WU], D, FF, Wgu_t, 2, scr, r, F.lane, AR.in[I_N2G]); continue; } r -= I_G;
        p0_transpose_item(AR.in[I_WD], FF, D, Wdn_t, 0, scr, r, F.lane);
    }
}

__global__ void __launch_bounds__(NWAVES * 64, 2) hybrid_fwd(Args args) {
    extern __shared__ __attribute__((aligned(16))) unsigned char lds[];
    Frame F;
    F.lds = (LAS unsigned char*)lds;
    F.MISC = (volatile LAS unsigned*)(F.lds + MISC_OFF);
    F.tid = threadIdx.x; F.lane = F.tid & 63; F.wave = __builtin_amdgcn_readfirstlane(F.tid >> 6);
    F.G = gridDim.x; { const int bx = blockIdx.x; F.vcu = (F.G % 8 == 0) ? (bx % 8) * (F.G / 8) + bx / 8 : bx; }
    F.ws = args.ws; F.out = args.out;
    F.ctl = (gu32*)(args.ws + WS_CTL);
    for (int u = F.tid; u < (LDS_BYTES - LDSCTL_OFF) / 4; u += NWAVES * 64) ((LAS unsigned*)(F.lds + LDSCTL_OFF))[u] = 0u;
    __syncthreads();
    XcdBarrier bar; bar.bar = (unsigned*)(F.ctl + CW_BAR); bar.x = 0; bar.st = nullptr;
    if (N_LAUNCHES != PER_PHASE) bar = xcd_barrier_post((unsigned*)(F.ctl + CW_BAR), F.MISC + 8, (unsigned)F.G);
    const bool SPLIT = (N_LAUNCHES == 1) && (F.G % 16 == 0) && ((M / 256) % 2 == 0);
    const int sg = SPLIT ? ((int)blockIdx.x & 1) : 0, sgG = SPLIT ? F.G / 2 : F.G, sgc = SPLIT ? ((int)blockIdx.x >> 3) * 4 + (((int)blockIdx.x & 7) >> 1) : (int)blockIdx.x, sgM = SPLIT ? M / 2 : M, sgX = SPLIT ? 4 : 8;
    const size_t sgr = (size_t)sg * sgM;
    XcdBarrier sbar = bar;
    if (SPLIT) sbar = xcd_barrier_post((unsigned*)(F.ctl + CW_BAR_SUB + 4096 * sg), F.MISC + 10, (unsigned)sgG);
#define SUB_BAR() do { if (SPLIT) xcd_barrier(sbar); else GRID_BAR(); } while (0)
#define GRID_BAR() do { if (N_LAUNCHES != PER_PHASE) xcd_barrier(bar); } while (0)
    const int lo = args.ph_lo, hi = args.ph_hi;
#ifndef PHMASK
#define PHMASK 0x3ff
#endif
#define IN(k) (((PHMASK >> (k)) & 1) && lo <= (k) && (k) < hi)
#define BOTH(k) (IN(k) && IN((k) + 1))
#define PSTAMP(i) do { if (PROBE_SEL >= 0 && blockIdx.x == 0 && F.tid == 0) { const unsigned long long t_ = __builtin_amdgcn_s_memtime(); __hip_atomic_store(F.ctl + 9100 + (i), (unsigned)(t_ >> 4), RLX_AGENT); } } while (0)
#ifndef REPMASK
#define REPMASK 0
#endif
#define REP(k) for (int rep_ = 0; rep_ <= ((REPMASK >> (k)) & 1); ++rep_)
    bf16* XN = (bf16*)(args.ws + WS_XN); bf16* PROJ = (bf16*)(args.ws + WS_PROJ);

    PSTAMP(0);
    if (IN(0)) { p0_prologue(F, args); if (BOTH(0)) GRID_BAR(); }
    PSTAMP(1);
    if (IN(1)) {
        pg8::Gemm g{XN, (const bf16*)(args.ws + WS_WIN), M, IN_COLS, D}; pg8::StaticOrder S; S.init(M, IN_COLS, F.G, (int)blockIdx.x);
        pg8::EpiProj E{PROJ, IN_COLS, args.in[I_QNG], args.in[I_KNG]};
        const int nu = (M / 256) * (IN_COLS / 256), rem = nu % F.G;
        if (rem != 0 && (int)blockIdx.x >= rem) { p1_tail_weights(F, args, ((int)blockIdx.x - rem) * NWAVES + F.wave, (F.G - rem) * NWAVES); __syncthreads(); }
        pg8::gemm_phase<pg8::EpiProj, pg8::StaticOrder, true, true>(F.lds + RING_OFF, g, S, E);
        if (rem == 0) p1_tail_weights(F, args, (int)blockIdx.x * NWAVES + F.wave, F.G * NWAVES);
        if (BOTH(1)) GRID_BAR();
    }
    PSTAMP(2);
    PSTAMP(3);
    if (IN(3)) { p3_lora(F, args); if (BOTH(3)) GRID_BAR(); }
    PSTAMP(4);
    if (IN(4)) { p4_scan(F, args); PSTAMP(11); p4_attn(F, args); PSTAMP(12); if (BOTH(4)) GRID_BAR(); }
    PSTAMP(5);
    const int p5a = SPLIT ? P5A_ROWS : M;
    if (IN(5)) { p5_post(F, args, 0, p5a, F.vcu, F.G); if (BOTH(5)) GRID_BAR(); }
    PSTAMP(6);
    if (IN(6)) {
        if (SPLIT && sg == 1) {
            p5_post(F, args, p5a, M, sgc, sgG);
            asm volatile("s_waitcnt vmcnt(0)" ::: "memory"); __syncthreads();
            if (F.tid == 0) __hip_atomic_fetch_add(F.ctl + CW_P5B, 1u, __ATOMIC_RELEASE, __HIP_MEMORY_SCOPE_AGENT);
            SUB_BAR();
        }
        pg8::Gemm g{XN + sgr * D, (const bf16*)(args.ws + WS_WOUT), sgM, D, D}; pg8::StaticOrder S; S.init(sgM, D, sgG, sgc, sgX);
        pg8::EpiOut E{args.in[I_X] + sgr * D, (bf16*)(args.ws + WS_DAG) + sgr * D, (float*)(args.ws + WS_SS) + sgr * 4, D, (LAS float*)(F.lds + RING_OFF + 131072)};
        pg8::gemm_phase<pg8::EpiOut, pg8::StaticOrder, true, true>(F.lds + RING_OFF, g, S, E);
        if (IN(8)) SUB_BAR();
    }
    PSTAMP(8);
    if (IN(8)) {
        pg8::Gemm g{(const bf16*)(args.ws + WS_DAG) + sgr * D, (const bf16*)(args.ws + WS_WGU), sgM, NGU, D}; pg8::StaticOrder S; S.init(sgM, NGU, sgG, sgc, sgX);
        pg8::EpiSwiglu E{PROJ + sgr * FF, FF, (const float*)(args.ws + WS_SS) + sgr * 4};
        pg8::gemm_phase<pg8::EpiSwiglu, pg8::StaticOrder, true, true>(F.lds + RING_OFF, g, S, E);
        if (BOTH(8)) SUB_BAR();
    }
    PSTAMP(9);
    if (IN(9)) {
        if (SPLIT && sg == 0) {
            if (F.tid == 0) { unsigned sp_ = 0; while (__hip_atomic_load(F.ctl + CW_P5B, __ATOMIC_ACQUIRE, __HIP_MEMORY_SCOPE_AGENT) < (unsigned)sgG && ++sp_ < (1u << 24)) __builtin_amdgcn_s_sleep(8); }
            __syncthreads();
        }
        pg8::Gemm g{PROJ + sgr * FF, (const bf16*)(args.ws + WS_WDN), sgM, D, FF}; pg8::StaticOrder S; S.init(sgM, D, sgG, sgc, sgX);
        pg8::EpiFinal E{(const bf16*)(args.ws + WS_DAG) + sgr * D, F.out + sgr * D, D};
        pg8::gemm_phase<pg8::EpiFinal, pg8::StaticOrder, true, true>(F.lds + RING_OFF, g, S, E);
    }
    PSTAMP(10);
    if (PROBE_SEL >= 0 && blockIdx.x == 0 && F.tid == 0) {
        unsigned w = 0;
        auto ld = [&](int i) { return __hip_atomic_load(F.ctl + 9100 + i, RLX_AGENT); };
        const int sel = PROBE_SEL;
        if (sel <= 9) { const int nxt = sel == 6 ? 8 : (sel == 9 ? 10 : sel + 1); w = ld(nxt) - ld(sel); }
        else if (sel == 20) w = ld(11) - ld(4);
        else if (sel == 21) w = ld(12) - ld(11);
        else w = ld(sel);
        const unsigned long long t0 = __builtin_amdgcn_s_memtime();
        while (((__builtin_amdgcn_s_memtime() - t0) >> 4) < (unsigned long long)w) __builtin_amdgcn_s_sleep(8);
    }
#undef IN
#undef BOTH
}

extern "C" void kernel_launch(void* const* d_in, const int* in_sizes, int n_in, void* d_out, int out_size, void* d_ws, size_t ws_size, hipStream_t stream) {
    static int grid = 0;
    if (grid == 0) {
        if (n_in != 22 || in_sizes[0] != M * D || out_size != M * D || ws_size < WS_END) { fprintf(stderr, "kernel_launch: unexpected shapes (n_in %d, in0 %d, out %d, ws %zu); nothing launched\n", n_in, n_in > 0 ? in_sizes[0] : -1, out_size, ws_size); grid = -1; return; }
        int dev = 0, cus = 0, per_cu = 0;
        if (hipGetDevice(&dev) != hipSuccess || hipDeviceGetAttribute(&cus, hipDeviceAttributeMultiprocessorCount, dev) != hipSuccess) { grid = -1; return; }
        if (hipFuncSetAttribute((const void*)hybrid_fwd, hipFuncAttributeMaxDynamicSharedMemorySize, LDS_BYTES) != hipSuccess) { fprintf(stderr, "kernel_launch: hipFuncSetAttribute failed\n"); grid = -1; return; }
        if (hipOccupancyMaxActiveBlocksPerMultiprocessor(&per_cu, (const void*)hybrid_fwd, NWAVES * 64, LDS_BYTES) != hipSuccess || per_cu < 1)
            fprintf(stderr, "kernel_launch: note: occupancy query reports %d workgroups per CU\n", per_cu);
        (void)hipGetLastError();
        grid = cus;
    }
    if (grid < 0) return;
    if (hipMemsetAsync((char*)d_ws + WS_CTL, 0, CTL_ZERO_BYTES, stream) != hipSuccess) { fprintf(stderr, "kernel_launch: hipMemsetAsync failed\n"); return; }
    Args a{};
    for (int i = 0; i < 22; ++i) a.in[i] = (const float*)d_in[i];
    a.out = (float*)d_out; a.ws = (unsigned char*)d_ws;
    for (int li = 0; li < N_LAUNCHES; ++li) {
        a.ph_lo = (N_LAUNCHES == PER_PHASE) ? li : 0; a.ph_hi = (N_LAUNCHES == PER_PHASE) ? li + 1 : PER_PHASE; a.li = li;
        hipLaunchKernelGGL(hybrid_fwd, dim3(grid), dim3(NWAVES * 64), LDS_BYTES, stream, a);
        const hipError_t le = hipPeekAtLastError();
        if (le != hipSuccess) { fprintf(stderr, "kernel_launch: launch %d failed: %s\n", li, hipGetErrorName(le)); break; }
    }
}
```

```cpp
#include <hip/hip_runtime.h>
#include <cstdio>
#include <cstdint>

#ifndef P5A_16
#define P5A_16 12
#endif
#ifndef PROBE_SEL
#define PROBE_SEL -1
#endif
#ifndef MK_N_LAUNCHES
#define MK_N_LAUNCHES 1
#endif

namespace pg8 {
#define PG8_LAS __attribute__((address_space(3)))
typedef unsigned short bf16_t;
typedef short bf16x8 __attribute__((ext_vector_type(8)));
typedef float f32x4 __attribute__((ext_vector_type(4)));
typedef float f32x2 __attribute__((ext_vector_type(2)));
typedef unsigned u32x4 __attribute__((ext_vector_type(4)));
constexpr int BM = 256, BK = 64, HALF = 128, HTB = HALF * BK * 2, STAGE_BYTES = 8 * HTB, NXCD = 8, WGM = 8;

__host__ __device__ __forceinline__ int lds_byte(int r, int c) { const int st = (r >> 4) * 2 + (c >> 5), rr = r & 15, cc = c & 31, ob = rr * 64 + cc * 2; return st * 1024 + (ob ^ (((ob >> 9) & 1) << 5)); }
__host__ __device__ __forceinline__ void stage_rc(int b, int& R, int& C) { const int st = b / 1024, sb = b % 1024, swz = sb ^ (((sb >> 9) & 1) << 5); R = (st >> 1) * 16 + swz / 64; C = (st & 1) * 32 + (swz % 64) / 2; }
__host__ __device__ __forceinline__ int perm32(int rho) { const int n = rho >> 4, i = rho & 15; return 8 * (i >> 2) + 4 * n + (i & 3); }

struct Unit { int pm, pn, aux; };
typedef float f32x2_e __attribute__((ext_vector_type(2)));
struct Gemm { const bf16_t* A; const bf16_t* Bt; int M, N, K; };

struct StaticOrder {
    int nM, nN, nwg, G, c, nx;
    __host__ __device__ void init(int M, int N, int G_, int c_, int nx_ = NXCD) { nM = M / BM; nN = N / BM; nwg = nM * nN; G = G_; c = c_; nx = nx_; }
    __host__ __device__ bool next(int i, Unit& u) const {
        const long L = (long)i * G + c; if (L >= nwg) return false;
        int wgid = (int)L; { const int q = nwg / nx, r = nwg % nx, xcd = wgid % nx, off = wgid / nx; wgid = (xcd < r ? xcd * (q + 1) : r * (q + 1) + (xcd - r) * q) + off; }
        const int nig = WGM * nN, gid = wgid / nig, fm = gid * WGM, gsz = (nM - fm) < WGM ? (nM - fm) : WGM;
        u.pm = fm + ((wgid % nig) % gsz); u.pn = (wgid % nig) / gsz; return true;
    }
    __device__ __forceinline__ void a_ready(const Unit&) const {}
    __device__ __forceinline__ void done(const Unit&) const {}
};

__device__ __forceinline__ unsigned cvt_pk_bf16(float lo, float hi) { unsigned r; asm volatile("v_cvt_pk_bf16_f32 %0, %1, %2" : "=v"(r) : "v"(lo), "v"(hi)); return r; }
__device__ __forceinline__ float fsigmoid(float x) { return __builtin_amdgcn_rcpf(1.0f + __builtin_amdgcn_exp2f(-1.4426950408889634f * x)); }

struct EpiBf16 {
    static constexpr bool PERM = true, AFTER_DRAIN = false, PREF = false;
    bf16_t* O; int ldc;
    __device__ __forceinline__ void operator()(const f32x4 (&acc)[2][2][4][2], const Unit& u, int wr, int wc, int fr, int fq) const {
        const int row0 = u.pm * BM + wr * 64 + fr; const int col0 = u.pn * BM + wc * 32 + 8 * fq;
#pragma unroll
        for (int ai = 0; ai < 2; ++ai)
#pragma unroll
            for (int m = 0; m < 4; ++m) { bf16_t* rowp = O + (size_t)(row0 + ai * HALF + m * 16) * ldc + col0;
#pragma unroll
                for (int bj = 0; bj < 2; ++bj) { const f32x4 v0 = acc[ai][bj][m][0], v1 = acc[ai][bj][m][1];
                    u32x4 w; w.x = cvt_pk_bf16(v0[0], v0[1]); w.y = cvt_pk_bf16(v0[2], v0[3]); w.z = cvt_pk_bf16(v1[0], v1[1]); w.w = cvt_pk_bf16(v1[2], v1[3]);
                    *(u32x4*)(rowp + bj * HALF) = w; } }
    }
};
struct EpiProj {
    static constexpr bool PERM = true, AFTER_DRAIN = false, PREF = true;
    const float* ss1; PG8_LAS float* scr;
    bf16_t* O; int ldc; PG8_LAS const float* gl;
    __device__ __forceinline__ void issue_raw(const Unit& u, int wr, int fr, int fq, f32x4 (&raw)[2]) const {
#pragma unroll
        for (int j = 0; j < 2; ++j) { const int i = 2 * fq + j; raw[j][0] = ss1[u.pm * BM + wr * 64 + fr + (i >> 2) * HALF + (i & 3) * 16]; }
    }
    __device__ __forceinline__ void reduce_raw(const f32x4 (&raw)[2], const Unit& u, int wr, int wc, int fr, int fq) const {
        if (wc == 0) {
            f32x2_e v;
#pragma unroll
            for (int j = 0; j < 2; ++j) v[j] = 1.0f / sqrtf(raw[j][0] * (1.0f / 1024.0f) + 1e-6f);
            *(PG8_LAS f32x2_e*)(scr + u.aux * 256 + (wr * 16 + fr) * 8 + 2 * fq) = v;
        }
    }
    __device__ __forceinline__ void operator()(const f32x4 (&acc)[2][2][4][2], const Unit& u, int wr, int wc, int fr, int fq) const {
        const int row0 = u.pm * BM + wr * 64 + fr;
        float rs[2][4];
        { const PG8_LAS f32x4* p = (const PG8_LAS f32x4*)(scr + u.aux * 256 + (wr * 16 + fr) * 8); const f32x4 a = p[0], b = p[1];
          rs[0][0] = a[0]; rs[0][1] = a[1]; rs[0][2] = a[2]; rs[0][3] = a[3]; rs[1][0] = b[0]; rs[1][1] = b[1]; rs[1][2] = b[2]; rs[1][3] = b[3]; }
        if (u.pn >= 4) {
            const int col0 = u.pn * BM + wc * 32 + 8 * fq;
#pragma unroll
            for (int ai = 0; ai < 2; ++ai)
#pragma unroll
                for (int m = 0; m < 4; ++m) { bf16_t* rowp = O + (size_t)(row0 + ai * HALF + m * 16) * ldc + col0;
#pragma unroll
                    for (int bj = 0; bj < 2; ++bj) { const f32x4 v0 = acc[ai][bj][m][0] * rs[ai][m], v1 = acc[ai][bj][m][1] * rs[ai][m];
                        u32x4 w; w.x = cvt_pk_bf16(v0[0], v0[1]); w.y = cvt_pk_bf16(v0[2], v0[3]); w.z = cvt_pk_bf16(v1[0], v1[1]); w.w = cvt_pk_bf16(v1[2], v1[3]);
                        *(u32x4*)(rowp + bj * HALF) = w; } }
        } else {
            PG8_LAS const float* gsrc = gl + (u.pn < 2 ? 0 : 64) + 8 * fq;
            f32x4 g4[2][2];
#pragma unroll
            for (int bj = 0; bj < 2; ++bj)
#pragma unroll
                for (int n = 0; n < 2; ++n) g4[bj][n] = *(PG8_LAS const f32x4*)(gsrc + 32 * bj + 4 * n);
            const int col0 = u.pn * BM + wc * 64 + 8 * fq;
#pragma unroll
            for (int ai = 0; ai < 2; ++ai)
#pragma unroll
                for (int m = 0; m < 4; ++m) {
                    float ss = 0.f;
#pragma unroll
                    for (int bj = 0; bj < 2; ++bj)
#pragma unroll
                        for (int n = 0; n < 2; ++n) { const f32x4 v = acc[ai][bj][m][n]; ss += (v[0] * v[0] + v[1] * v[1]) + (v[2] * v[2] + v[3] * v[3]); }
                    ss += __shfl_xor(ss, 16); ss += __shfl_xor(ss, 32);
                    const float rstd = rs[ai][m] * __builtin_amdgcn_rsqf(ss * (rs[ai][m] * rs[ai][m]) * (1.0f / 64.0f) + 1e-6f);
                    bf16_t* rowp = O + (size_t)(row0 + ai * HALF + m * 16) * ldc + col0;
#pragma unroll
                    for (int bj = 0; bj < 2; ++bj) { const f32x4 v0 = acc[ai][bj][m][0] * g4[bj][0] * rstd, v1 = acc[ai][bj][m][1] * g4[bj][1] * rstd;
                        u32x4 w; w.x = cvt_pk_bf16(v0[0], v0[1]); w.y = cvt_pk_bf16(v0[2], v0[3]); w.z = cvt_pk_bf16(v1[0], v1[1]); w.w = cvt_pk_bf16(v1[2], v1[3]);
                        *(u32x4*)(rowp + 32 * bj) = w; }
                    __builtin_amdgcn_sched_barrier(0); }
        }
    }
};
struct EpiLora {
    static constexpr bool PERM = true, AFTER_DRAIN = false, PREF = false;
    bf16_t* O; int ldc; const float* w0; const float* a0;
    __device__ __forceinline__ void operator()(const f32x4 (&acc)[2][2][4][2], const Unit& u, int wr, int wc, int fr, int fq) const {
        const int row0 = u.pm * BM + wr * 64 + fr; const int col0 = u.pn * BM + wc * 32 + 8 * fq;
        const int kind = u.pn >> 1;
        const float sc = kind == 0 ? -0.6065306597126334f : (kind == 1 ? 1.0f : 0.0f), lin = kind == 2 ? 1.0f : 0.0f;
        const float* bp = kind == 0 ? w0 : a0;
        const float bs = kind == 2 ? 0.0f : 1.0f;
#pragma unroll
        for (int bj = 0; bj < 2; ++bj) {
            const int c = (col0 + bj * HALF) & 511;
            const f32x4 b0 = *(const f32x4*)(bp + c) * bs, b1 = *(const f32x4*)(bp + c + 4) * bs;
#pragma unroll
            for (int ai = 0; ai < 2; ++ai)
#pragma unroll
                for (int m = 0; m < 4; ++m) { bf16_t* rowp = O + (size_t)(row0 + ai * HALF + m * 16) * ldc + col0;
                    f32x4 v0 = acc[ai][bj][m][0] + b0, v1 = acc[ai][bj][m][1] + b1;
#pragma unroll
                    for (int e = 0; e < 4; ++e) { v0[e] = sc * fsigmoid(v0[e]) + lin * v0[e]; v1[e] = sc * fsigmoid(v1[e]) + lin * v1[e]; }
                    u32x4 w; w.x = cvt_pk_bf16(v0[0], v0[1]); w.y = cvt_pk_bf16(v0[2], v0[3]); w.z = cvt_pk_bf16(v1[0], v1[1]); w.w = cvt_pk_bf16(v1[2], v1[3]);
                    *(u32x4*)(rowp + bj * HALF) = w;
                    __builtin_amdgcn_sched_barrier(0); }
        }
    }
};
struct EpiSwiglu {
    static constexpr bool PERM = true, AFTER_DRAIN = false, PREF = true;
    bf16_t* H; int ldh; const float* rstd; PG8_LAS float* scr;
    __device__ __forceinline__ void issue_raw(const Unit& u, int wr, int fr, int fq, f32x4 (&raw)[2]) const {
#pragma unroll
        for (int j = 0; j < 2; ++j) { const int i = 2 * fq + j; raw[j] = *(const f32x4*)(rstd + (size_t)(u.pm * BM + wr * 64 + fr + (i >> 2) * HALF + (i & 3) * 16) * 4); }
    }
    __device__ __forceinline__ void reduce_raw(const f32x4 (&raw)[2], const Unit& u, int wr, int wc, int fr, int fq) const {
        if (wc == 0) {
            f32x2_e v;
#pragma unroll
            for (int j = 0; j < 2; ++j) v[j] = 1.0f / sqrtf(((raw[j][0] + raw[j][1]) + (raw[j][2] + raw[j][3])) * (1.0f / 1024.0f) + 1e-6f);
            *(PG8_LAS f32x2_e*)(scr + u.aux * 256 + (wr * 16 + fr) * 8 + 2 * fq) = v;
        }
    }
    __device__ __forceinline__ void operator()(const f32x4 (&acc)[2][2][4][2], const Unit& u, int wr, int wc, int fr, int fq) const {
        const int row0 = u.pm * BM + wr * 64 + fr; const int col0 = u.pn * HALF + wc * 32 + 8 * fq;
        float rs[8];
        { const PG8_LAS f32x4* p = (const PG8_LAS f32x4*)(scr + u.aux * 256 + (wr * 16 + fr) * 8); const f32x4 a = p[0], b = p[1]; rs[0] = a[0]; rs[1] = a[1]; rs[2] = a[2]; rs[3] = a[3]; rs[4] = b[0]; rs[5] = b[1]; rs[6] = b[2]; rs[7] = b[3]; }
#pragma unroll
        for (int ai = 0; ai < 2; ++ai)
#pragma unroll
            for (int m = 0; m < 4; ++m) { bf16_t* rowp = H + (size_t)(row0 + ai * HALF + m * 16) * ldh + col0;
                const float c1_ = -1.4426950408889634f * rs[ai * 4 + m], rs2_ = rs[ai * 4 + m] * rs[ai * 4 + m];
                float h[8];
#pragma unroll
                for (int n = 0; n < 2; ++n)
#pragma unroll
                    for (int e = 0; e < 4; ++e) { const float ag = acc[ai][0][m][n][e], au = acc[ai][1][m][n][e];
                        h[4 * n + e] = (ag * au) * __builtin_amdgcn_rcpf(1.0f + __builtin_amdgcn_exp2f(ag * c1_)) * rs2_; }
                u32x4 w; w.x = cvt_pk_bf16(h[0], h[1]); w.y = cvt_pk_bf16(h[2], h[3]); w.z = cvt_pk_bf16(h[4], h[5]); w.w = cvt_pk_bf16(h[6], h[7]);
                *(u32x4*)rowp = w;
                __builtin_amdgcn_sched_barrier(0); }
    }
};
struct EpiOut {
    static constexpr bool PERM = true, AFTER_DRAIN = false, PREF = false;
    const bf16_t* base; bf16_t* xb; float* SS; int ldc; PG8_LAS float* scr;
#define EPO_LOAD(dst, g) do { _Pragma("unroll") for (int mm = 0; mm < 2; ++mm) _Pragma("unroll") for (int bj = 0; bj < 2; ++bj) { \
        const size_t o_ = (size_t)(((g) >> 1) * HALF + (((g) & 1) * 2 + mm) * 16) * ldc + bj * HALF; dst[mm * 2 + bj] = __builtin_nontemporal_load((const u32x4*)(bp + o_)); } } while (0)
    __device__ __forceinline__ void operator()(const f32x4 (&acc)[2][2][4][2], const Unit& u, int wr, int wc, int fr, int fq) const {
        const int row0 = u.pm * BM + wr * 64 + fr, col0 = u.pn * BM + wc * 32 + 8 * fq;
        const bf16_t* bp = base + (size_t)row0 * ldc + col0; bf16_t* xp = xb + (size_t)row0 * ldc + col0;
        u32x4 xa[4], xc[4];
        EPO_LOAD(xa, 0); EPO_LOAD(xc, 1);
        __builtin_amdgcn_sched_barrier(0);
#pragma unroll
        for (int g = 0; g < 4; ++g) {
            const int ai = g >> 1;
            u32x4 wo[4]; float ssv[2];
#pragma unroll
            for (int mm = 0; mm < 2; ++mm) { const int m = (g & 1) * 2 + mm; float ss = 0.f;
#pragma unroll
                for (int bj = 0; bj < 2; ++bj) {
                    const u32x4 xw = ((g & 1) ? xc : xa)[mm * 2 + bj];
                    const f32x4 x0 = (f32x4){__builtin_bit_cast(float, xw.x << 16), __builtin_bit_cast(float, xw.x & 0xffff0000u), __builtin_bit_cast(float, xw.y << 16), __builtin_bit_cast(float, xw.y & 0xffff0000u)};
                    const f32x4 x1 = (f32x4){__builtin_bit_cast(float, xw.z << 16), __builtin_bit_cast(float, xw.z & 0xffff0000u), __builtin_bit_cast(float, xw.w << 16), __builtin_bit_cast(float, xw.w & 0xffff0000u)};
                    const f32x4 o0 = x0 + acc[ai][bj][m][0], o1 = x1 + acc[ai][bj][m][1];
                    u32x4 w; w.x = cvt_pk_bf16(o0[0], o0[1]); w.y = cvt_pk_bf16(o0[2], o0[3]); w.z = cvt_pk_bf16(o1[0], o1[1]); w.w = cvt_pk_bf16(o1[2], o1[3]);
                    wo[mm * 2 + bj] = w;
                    ss += ((o0[0] * o0[0] + o0[1] * o0[1]) + (o0[2] * o0[2] + o0[3] * o0[3])) + ((o1[0] * o1[0] + o1[1] * o1[1]) + (o1[2] * o1[2] + o1[3] * o1[3])); }
                ss += __shfl_xor(ss, 16); ss += __shfl_xor(ss, 32); ssv[mm] = ss; }
            __builtin_amdgcn_sched_barrier(0);
            if (g == 0) EPO_LOAD(xa, 2);
            if (g == 1) EPO_LOAD(xc, 3);
            __builtin_amdgcn_sched_barrier(0);
#pragma unroll
            for (int mm = 0; mm < 2; ++mm) { const int m = (g & 1) * 2 + mm;
#pragma unroll
                for (int bj = 0; bj < 2; ++bj) *(u32x4*)(xp + (size_t)(ai * HALF + m * 16) * ldc + bj * HALF) = wo[mm * 2 + bj];
                if (fq == 0) scr[((((wr * 2 + ai) * 4 + m) * 16) + fr) * 4 + wc] = ssv[mm]; }
            __builtin_amdgcn_sched_barrier(0);
        }
        asm volatile("s_waitcnt lgkmcnt(0)" ::: "memory"); __builtin_amdgcn_s_barrier(); asm volatile("" ::: "memory");
        const int tid = threadIdx.x;
        if (tid < 256) { const f32x4 s4 = *(const PG8_LAS f32x4*)(scr + tid * 4);
            const int row = u.pm * BM + ((tid >> 6) & 1) * HALF + (tid >> 7) * 64 + ((tid >> 4) & 3) * 16 + (tid & 15);
            SS[(size_t)row * 4 + u.pn] = (s4[0] + s4[1]) + (s4[2] + s4[3]); }
    }
#undef EPO_LOAD
};
struct EpiFinal {
    static constexpr bool PERM = true, AFTER_DRAIN = false, PREF = false;
    const bf16_t* xb; float* out; int ldc;
    __device__ __forceinline__ void operator()(const f32x4 (&acc)[2][2][4][2], const Unit& u, int wr, int wc, int fr, int fq) const {
        const int row0 = u.pm * BM + wr * 64 + fr, col0 = u.pn * BM + wc * 32 + 8 * fq;
#pragma unroll
        for (int ai = 0; ai < 2; ++ai)
#pragma unroll
            for (int m = 0; m < 4; ++m) { const size_t off = (size_t)(row0 + ai * HALF + m * 16) * ldc + col0;
#pragma unroll
                for (int bj = 0; bj < 2; ++bj) { const u32x4 w = *(const u32x4*)(xb + off + bj * HALF);
                    const f32x4 b0 = (f32x4){__builtin_bit_cast(float, w.x << 16), __builtin_bit_cast(float, w.x & 0xffff0000u), __builtin_bit_cast(float, w.y << 16), __builtin_bit_cast(float, w.y & 0xffff0000u)};
                    const f32x4 b1 = (f32x4){__builtin_bit_cast(float, w.z << 16), __builtin_bit_cast(float, w.z & 0xffff0000u), __builtin_bit_cast(float, w.w << 16), __builtin_bit_cast(float, w.w & 0xffff0000u)};
                    __builtin_nontemporal_store(b0 + acc[ai][bj][m][0], (f32x4*)(out + off + bj * HALF)); __builtin_nontemporal_store(b1 + acc[ai][bj][m][1], (f32x4*)(out + off + bj * HALF + 4)); }
                if (m & 1) asm volatile("" ::: "memory"); }
    }
};

template <class Epi, class Sched, bool ALIGN_EPI = false, bool SP2 = false>
__device__ __forceinline__ void gemm_phase(PG8_LAS unsigned char* lds, const Gemm g, const Sched& S, const Epi& E) {
    const int tid = threadIdx.x, wid = __builtin_amdgcn_readfirstlane(tid >> 6), lane = tid & 63, wr = wid >> 2, wc = wid & 3, fr = lane & 15, fq = lane >> 4;
    const int K = g.K, nt = K / BK;
    unsigned voffA[2], voffB[2];
#pragma unroll
    for (int i = 0; i < 2; ++i) { int R, C; stage_rc(tid * 16 + i * 8192, R, C); const int Rb = Epi::PERM ? ((R & ~31) + perm32(R & 31)) : R;
        voffA[i] = (unsigned)(R * K + C) * 2u; voffB[i] = (unsigned)(Rb * K + C) * 2u; }
    const size_t kstep = (size_t)(BK * 2);
    const size_t hstep = (size_t)HALF * K * 2;
    const size_t tstep = 2 * hstep;
    const unsigned ldsw = (unsigned)wid * 1024u;
    const int aoff = lds_byte(wr * 64 + fr, fq * 8), boff = lds_byte(wc * 32 + fr, fq * 8);
#define PG8_SA(b, h) (((b) * 2 + (h)) * HTB)
#define PG8_SB(b, h) ((4 + (b) * 2 + (h)) * HTB)
#define PG8_STAGE(bufoff, gbase, voff) do { _Pragma("unroll") for (int _i = 0; _i < 2; ++_i) \
        __builtin_amdgcn_global_load_lds((const unsigned*)((const char*)(gbase) + (voff)[_i]), (PG8_LAS unsigned*)(lds + (bufoff) + ldsw + _i * 8192), 16, 0, 0); } while (0)
#define PG8_LDA(dst, b, h) do { _Pragma("unroll") for (int m = 0; m < 4; ++m) _Pragma("unroll") for (int k = 0; k < 2; ++k) dst[m][k] = *(const PG8_LAS bf16x8*)(lds + PG8_SA(b, h) + aoff + m * 2048 + k * 1024); } while (0)
#define PG8_LDB(dst, b, h) do { _Pragma("unroll") for (int n = 0; n < 2; ++n) _Pragma("unroll") for (int k = 0; k < 2; ++k) dst[n][k] = *(const PG8_LAS bf16x8*)(lds + PG8_SB(b, h) + boff + n * 2048 + k * 1024); } while (0)
#define PG8_MMA(ai, bj, At, Bt) do { __builtin_amdgcn_s_setprio(1); _Pragma("unroll") for (int m = 0; m < 4; ++m) _Pragma("unroll") for (int n = 0; n < 2; ++n) _Pragma("unroll") for (int k = 0; k < 2; ++k) \
        acc[ai][bj][m][n] = __builtin_amdgcn_mfma_f32_16x16x32_bf16(Bt[n][k], At[m][k], acc[ai][bj][m][n], 0, 0, 0); __builtin_amdgcn_s_setprio(0); } while (0)
#define PG8_WAIT_V(n) asm volatile("s_waitcnt vmcnt(" #n ")" ::: "memory")
#define PG8_WAIT_L(n) asm volatile("s_waitcnt lgkmcnt(" #n ")" ::: "memory")
#define PG8_BAR __builtin_amdgcn_s_barrier()
#define PG8_SCHED __builtin_amdgcn_sched_barrier(0)
    Unit cur, nxt; int ui = 0;
    if (!S.next(0, cur)) return;
    f32x4 acc[2][2][4][2];
#pragma unroll
    for (int a = 0; a < 2; ++a)
#pragma unroll
        for (int b = 0; b < 2; ++b)
#pragma unroll
            for (int m = 0; m < 4; ++m)
#pragma unroll
                for (int n = 0; n < 2; ++n) acc[a][b][m][n] = (f32x4){0.f, 0.f, 0.f, 0.f};
    bf16x8 At[4][2], B0[2][2], B1[2][2];
    const char* cA = (const char*)g.A + (size_t)cur.pm * tstep; const char* cB = (const char*)g.Bt + (size_t)cur.pn * tstep;
    cur.aux = 0;
    if constexpr (Epi::PREF) { f32x4 raw0[2]; E.issue_raw(cur, wr, fr, fq, raw0); E.reduce_raw(raw0, cur, wr, wc, fr, fq); }
    S.a_ready(cur);
    if constexpr (SP2) {
        PG8_STAGE(PG8_SB(0, 0), cB, voffB); PG8_STAGE(PG8_SB(0, 1), cB + hstep, voffB); PG8_STAGE(PG8_SA(0, 0), cA, voffA); PG8_STAGE(PG8_SA(0, 1), cA + hstep, voffA);
        if (wr == 1) PG8_BAR;
        PG8_WAIT_V(2); PG8_BAR;
        PG8_STAGE(PG8_SB(1, 0), cB + kstep, voffB); PG8_STAGE(PG8_SA(1, 0), cA + kstep, voffA); PG8_STAGE(PG8_SB(1, 1), cB + hstep + kstep, voffB);
        PG8_WAIT_V(6); PG8_BAR;
    } else {
        PG8_STAGE(PG8_SB(0, 0), cB, voffB); PG8_STAGE(PG8_SA(0, 0), cA, voffA); PG8_STAGE(PG8_SB(0, 1), cB + hstep, voffB); PG8_STAGE(PG8_SA(0, 1), cA + hstep, voffA);
        if (wr == 1) PG8_BAR;
        PG8_WAIT_V(4); PG8_BAR;
        PG8_STAGE(PG8_SB(1, 0), cB + kstep, voffB); PG8_STAGE(PG8_SA(1, 0), cA + kstep, voffA); PG8_STAGE(PG8_SB(1, 1), cB + hstep + kstep, voffB);
        PG8_WAIT_V(6); PG8_BAR;
    }
    for (;;) {
        const bool has_next = S.next(ui + 1, nxt); nxt.aux = (ui + 1) & 1;
        const char* nA = has_next ? (const char*)g.A + (size_t)nxt.pm * tstep : cA; const char* nB = has_next ? (const char*)g.Bt + (size_t)nxt.pn * tstep : cB;
#pragma nounroll
        for (int t = 0; t < nt; t += 2) {
            const bool last = (t == nt - 2);
            const char* a1 = cA + (size_t)(t + 1) * kstep;
            const char* a2 = last ? nA : cA + (size_t)(t + 2) * kstep; const char* b2 = last ? nB : cB + (size_t)(t + 2) * kstep;
            const char* a3 = a2 + kstep; const char* b3 = b2 + kstep;
            if (last && has_next) S.a_ready(nxt);
            if constexpr (SP2) {
            PG8_LDB(B0, 0, 0); PG8_LDB(B1, 0, 1); PG8_SCHED; PG8_LDA(At, 0, 0); PG8_STAGE(PG8_SA(1, 1), a1 + hstep, voffA);
            PG8_WAIT_V(8); PG8_WAIT_L(0); PG8_BAR; PG8_MMA(0, 0, At, B0); PG8_MMA(0, 1, At, B1); PG8_BAR; PG8_SCHED;
            PG8_LDA(At, 0, 1); PG8_STAGE(PG8_SB(0, 0), b2, voffB); PG8_STAGE(PG8_SB(0, 1), b2 + hstep, voffB); PG8_STAGE(PG8_SA(0, 0), a2, voffA);
            PG8_WAIT_V(8); PG8_WAIT_L(0); PG8_BAR; PG8_MMA(1, 0, At, B0); PG8_MMA(1, 1, At, B1); PG8_BAR; PG8_SCHED;
            PG8_LDB(B0, 1, 0); PG8_LDB(B1, 1, 1); PG8_SCHED; PG8_LDA(At, 1, 0); PG8_STAGE(PG8_SA(0, 1), a2 + hstep, voffA);
            PG8_WAIT_V(8); PG8_WAIT_L(0); PG8_BAR; PG8_MMA(0, 0, At, B0); PG8_MMA(0, 1, At, B1); PG8_BAR; PG8_SCHED;
            PG8_LDA(At, 1, 1); PG8_STAGE(PG8_SB(1, 0), b3, voffB); PG8_STAGE(PG8_SB(1, 1), b3 + hstep, voffB); PG8_STAGE(PG8_SA(1, 0), a3, voffA);
            PG8_WAIT_V(8); PG8_WAIT_L(0); PG8_BAR; PG8_MMA(1, 0, At, B0); PG8_MMA(1, 1, At, B1); PG8_BAR; PG8_SCHED;
            } else {
            PG8_LDB(B0, 0, 0); PG8_SCHED; PG8_LDA(At, 0, 0); PG8_STAGE(PG8_SA(1, 1), a1 + hstep, voffA);
            PG8_WAIT_L(8); PG8_BAR; PG8_WAIT_L(0); PG8_MMA(0, 0, At, B0); PG8_BAR; PG8_SCHED;
            PG8_LDB(B1, 0, 1); PG8_STAGE(PG8_SB(0, 0), b2, voffB);
            PG8_BAR; PG8_WAIT_L(0); PG8_MMA(0, 1, At, B1); PG8_BAR;
            PG8_LDA(At, 0, 1); PG8_STAGE(PG8_SA(0, 0), a2, voffA);
            PG8_BAR; PG8_WAIT_L(0); PG8_MMA(1, 0, At, B0); PG8_BAR; PG8_SCHED;
            PG8_STAGE(PG8_SB(0, 1), b2 + hstep, voffB);
            PG8_WAIT_V(6); PG8_BAR; PG8_MMA(1, 1, At, B1); PG8_BAR;
            PG8_LDB(B0, 1, 0); PG8_SCHED; PG8_LDA(At, 1, 0); PG8_STAGE(PG8_SA(0, 1), a2 + hstep, voffA);
            PG8_WAIT_L(8); PG8_BAR; PG8_WAIT_L(0); PG8_MMA(0, 0, At, B0); PG8_BAR; PG8_SCHED;
            PG8_LDB(B1, 1, 1); PG8_STAGE(PG8_SB(1, 0), b3, voffB);
            PG8_BAR; PG8_WAIT_L(0); PG8_MMA(0, 1, At, B1); PG8_BAR;
            PG8_LDA(At, 1, 1); PG8_STAGE(PG8_SA(1, 0), a3, voffA);
            PG8_BAR; PG8_WAIT_L(0); PG8_MMA(1, 0, At, B0); PG8_BAR; PG8_SCHED;
            PG8_STAGE(PG8_SB(1, 1), b3 + hstep, voffB);
            PG8_WAIT_V(6); PG8_BAR; PG8_MMA(1, 1, At, B1); PG8_BAR;
            }
        }
        if constexpr (ALIGN_EPI) { if (wr == 0) PG8_BAR; }
        if constexpr (Epi::PREF) {
            f32x4 rawn[2];
            if (has_next) E.issue_raw(nxt, wr, fr, fq, rawn);
            E(acc, cur, wr, wc, fr, fq); S.done(cur);
            if (has_next) E.reduce_raw(rawn, nxt, wr, wc, fr, fq);
        } else if constexpr (!Epi::AFTER_DRAIN) { E(acc, cur, wr, wc, fr, fq); S.done(cur); }
        if (!has_next) break;
#pragma unroll
        for (int a = 0; a < 2; ++a)
#pragma unroll
            for (int b = 0; b < 2; ++b)
#pragma unroll
                for (int m = 0; m < 4; ++m)
#pragma unroll
                    for (int n = 0; n < 2; ++n) acc[a][b][m][n] = (f32x4){0.f, 0.f, 0.f, 0.f};
        cur = nxt; cA = nA; cB = nB; ++ui;
        if constexpr (ALIGN_EPI) { if (wr == 1) PG8_BAR; }
    }
    PG8_WAIT_V(0);
    if constexpr (!ALIGN_EPI) { if (wr == 0) PG8_BAR; }
    PG8_BAR;
#undef PG8_SA
#undef PG8_SB
#undef PG8_STAGE
#undef PG8_LDA
#undef PG8_LDB
#undef PG8_MMA
#undef PG8_WAIT_V
#undef PG8_WAIT_L
#undef PG8_BAR
#undef PG8_SCHED
}
}

constexpr int NWAVES = 8;
constexpr int N_LAUNCHES = MK_N_LAUNCHES;
constexpr int PER_PHASE = 10;
constexpr int BATCH = 16, SEQ = 2048, D = 1024, M = BATCH * SEQ;
constexpr int NH = 8, HD = 64, AW = 512, RW = 512;
constexpr int RWKV_COLS = 1792, IN_COLS = 3328, FF = 2816, NGU = 2 * FF, NLORA = 1536, KLORA = 256;
constexpr int PC_Q = 0, PC_K = 512, PC_V = 1024, PC_RW = 1536;
constexpr int RC_R = 0, RC_K = 512, RC_V = 1024, RC_L = 1536;
constexpr size_t DAG_G = (size_t)8 * 32768 * 128;
constexpr int WLF_K01 = 8 * 2 * 4 * 64 * 8, WLF_ELEMS = 4 * WLF_K01;
constexpr float NORM_EPS = 1e-6f, LNX_EPS = 64e-5f;
constexpr float LOG2E = 1.4426950408889634f;

constexpr size_t MiB = 1u << 20;
constexpr size_t WS_CTL = 0, CTL_ZERO_BYTES = 1 * MiB;
constexpr size_t WS_WIN = 2 * MiB;
constexpr size_t WS_WOUT = 9 * MiB;
constexpr size_t WS_WGU = 11 * MiB;
constexpr size_t WS_WDN = 22 * MiB;
constexpr size_t WS_WL = 28 * MiB;
constexpr size_t WS_BON = 29 * MiB;
constexpr size_t WS_SS1 = 30 * MiB + 512 * 1024;
constexpr size_t WS_SS = 30 * MiB;
constexpr size_t WS_XN = 32 * MiB;
constexpr size_t WS_PROJ = 96 * MiB;
constexpr size_t WS_A2 = 304 * MiB;
constexpr size_t WS_DAG = 320 * MiB;
constexpr size_t WS_ML = 416 * MiB;
constexpr size_t WS_XBF = 424 * MiB;
constexpr size_t WS_END = 488 * MiB;
constexpr size_t DO_PO = 0, DO_Y = 96 * MiB;
constexpr int CW_TMO = 0, CW_CODE = 1;
constexpr int CW_BAR = 4096;
constexpr int CW_ATTQ = 8192;
constexpr int CW_P5B = 8448;
constexpr int P5A_ROWS = (M / 16) * P5A_16;
constexpr int CW_BAR_SUB = 16384;

constexpr int LDS_BYTES = 163840;
constexpr int RING_OFF = 0, RING_BYTES = LDS_BYTES - 1024;
constexpr int LDSCTL_OFF = RING_BYTES, MISC_OFF = LDSCTL_OFF + 320;

#define GAS __attribute__((address_space(1)))
#define LAS __attribute__((address_space(3)))
typedef unsigned short bf16;
typedef unsigned v4u __attribute__((ext_vector_type(4)));
typedef unsigned v2u __attribute__((ext_vector_type(2)));
typedef float f32x4 __attribute__((ext_vector_type(4)));
typedef float f32x2 __attribute__((ext_vector_type(2)));
typedef float f32x16 __attribute__((ext_vector_type(16)));
typedef short bf16x8 __attribute__((ext_vector_type(8)));
typedef short s16x4 __attribute__((ext_vector_type(4)));
typedef GAS unsigned gu32;
#define RLX_AGENT __ATOMIC_RELAXED, __HIP_MEMORY_SCOPE_AGENT
#define LDS_WAIT() asm volatile("s_waitcnt lgkmcnt(0)" ::: "memory")
#define VM_WAIT() asm volatile("s_waitcnt vmcnt(0)" ::: "memory")
__device__ __forceinline__ unsigned f2bf(float f) { unsigned u = __builtin_bit_cast(unsigned, f); return (u + 0x7fffu + ((u >> 16) & 1u)) >> 16; }
typedef float f32x2_t __attribute__((ext_vector_type(2))); typedef __bf16 bf16x2_t __attribute__((ext_vector_type(2)));
__device__ __forceinline__ unsigned cvt2(float lo, float hi) { f32x2_t v = {lo, hi}; bf16x2_t b = __builtin_convertvector(v, bf16x2_t); return __builtin_bit_cast(unsigned, b); }
__device__ __forceinline__ unsigned pk2(float lo, float hi) { return cvt2(lo, hi); }
__device__ __forceinline__ float bflo(unsigned w) { return __builtin_bit_cast(float, w << 16); }
__device__ __forceinline__ float bfhi(unsigned w) { return __builtin_bit_cast(float, w & 0xffff0000u); }
__device__ __forceinline__ float fsig(float x) { return __builtin_amdgcn_rcpf(1.0f + __builtin_amdgcn_exp2f(-LOG2E * x)); }

#define XB_TMO      128
#define XB_XCNT(j)  (256  + 64 * (j))
#define XB_XSUB(j)  (1280 + 64 * (j))
#define XB_XGEN(j)  (2304 + 64 * (j))
#define XB_TOP      3328
#define XB_TOPGEN   3392
#define XCD_BAR_WORDS 3456
#define XB_SPIN_CAP (1u << 18)
__device__ __forceinline__ unsigned xb_ld(unsigned* p)              { return __hip_atomic_load(p, __ATOMIC_RELAXED, __HIP_MEMORY_SCOPE_AGENT); }
__device__ __forceinline__ unsigned xb_add(unsigned* p, unsigned v) { return __hip_atomic_fetch_add(p, v, __ATOMIC_RELAXED, __HIP_MEMORY_SCOPE_AGENT); }
__device__ __forceinline__ unsigned xb_xcc_id() { return (unsigned)__builtin_amdgcn_s_getreg((3 << 11) | 20) & 0xFu; }
#define XB_SPIN(cond, bar) do { unsigned _sp = 0; while (cond) { __builtin_amdgcn_s_sleep(1); \
    if ((++_sp & 255u) == 0u) { if (xb_ld(&(bar)[XB_TMO])) break; if (_sp > XB_SPIN_CAP) { atomicAdd(&(bar)[XB_TMO], 1u); break; } } } } while (0)
struct XcdBarrier { unsigned* bar; unsigned x; volatile LAS unsigned* st; unsigned total; };
__device__ __forceinline__ XcdBarrier xcd_barrier_post(unsigned* bar, volatile LAS unsigned* st, unsigned total) {
    XcdBarrier b; b.bar = bar; b.x = xb_xcc_id(); b.st = st; b.total = total;
    if (threadIdx.x == 0) (void)xb_add(&bar[XB_XCNT(b.x)], 1u);
    return b;
}
__device__ __forceinline__ void xcd_barrier_complete(unsigned* bar, unsigned x, unsigned G, unsigned& nloc, unsigned& nx) {
    unsigned sum, cnt, mine, sp = 0u;
    for (;;) {
        sum = 0u; cnt = 0u; mine = 0u;
#pragma unroll
        for (unsigned j = 0; j < 16; ++j) { const unsigned c = xb_ld(&bar[XB_XCNT(j)]); sum += c; cnt += (c > 0u) ? 1u : 0u; mine = (j == x) ? c : mine; }
        if (sum == G) break;
        __builtin_amdgcn_s_sleep(1);
        if ((++sp & 255u) == 0u) { if (xb_ld(&bar[XB_TMO])) break; if (sp > XB_SPIN_CAP) { atomicAdd(&bar[XB_TMO], 1u); break; } }
    }
    nloc = mine > 0u ? mine : 1u; nx = cnt > 0u ? cnt : 1u;
}
__device__ __forceinline__ void xcd_barrier(const XcdBarrier& b) {
    asm volatile("s_waitcnt vmcnt(0)" ::: "memory");
    __syncthreads();
    if (threadIdx.x == 0) {
        unsigned* bar = b.bar;
        __builtin_amdgcn_s_waitcnt(0);
        unsigned nloc = b.st[0], nx = b.st[1];
        if (nloc == 0u) { xcd_barrier_complete(bar, b.x, b.total, nloc, nx); b.st[0] = nloc; b.st[1] = nx; }
        const unsigned old = xb_add(&bar[XB_XSUB(b.x)], 1u);
        const unsigned gen = old / nloc;
        if (old + 1u == (gen + 1u) * nloc) {
            __builtin_amdgcn_fence(__ATOMIC_RELEASE, "agent");
            asm volatile("s_waitcnt vmcnt(0)" ::: "memory");
            const unsigned og = xb_add(&bar[XB_TOP], 1u);
            const unsigned tg = og / nx;
            if (og + 1u == (tg + 1u) * nx) xb_add(&bar[XB_TOPGEN], 1u);
            else XB_SPIN(xb_ld(&bar[XB_TOPGEN]) == tg, bar);
            __builtin_amdgcn_fence(__ATOMIC_ACQUIRE, "agent");
            asm volatile("s_waitcnt vmcnt(0)" ::: "memory");
        } else {
            XB_SPIN(xb_ld(&bar[XB_TOPGEN]) == gen, bar);
            __builtin_amdgcn_fence(__ATOMIC_ACQUIRE, "agent");
            asm volatile("s_waitcnt vmcnt(0)" ::: "memory");
        }
    }
    __syncthreads();
}
__device__ __forceinline__ void xcd_barrier_arrive(const XcdBarrier& b, volatile LAS unsigned* genw) {
    asm volatile("s_waitcnt vmcnt(0)" ::: "memory");
    __syncthreads();
    if (threadIdx.x == 0) {
        unsigned* bar = b.bar;
        __builtin_amdgcn_s_waitcnt(0);
        unsigned nloc = b.st[0], nx = b.st[1];
        if (nloc == 0u) { xcd_barrier_complete(bar, b.x, b.total, nloc, nx); b.st[0] = nloc; b.st[1] = nx; }
        const unsigned old = xb_add(&bar[XB_XSUB(b.x)], 1u);
        const unsigned gen = old / nloc;
        *genw = gen;
        if (old + 1u == (gen + 1u) * nloc) {
            __builtin_amdgcn_fence(__ATOMIC_RELEASE, "agent");
            asm volatile("s_waitcnt vmcnt(0)" ::: "memory");
            const unsigned og = xb_add(&bar[XB_TOP], 1u);
            const unsigned tg = og / nx;
            if (og + 1u == (tg + 1u) * nx) xb_add(&bar[XB_TOPGEN], 1u);
        }
    }
}
__device__ __forceinline__ void xcd_barrier_wait(const XcdBarrier& b, volatile LAS unsigned* genw) {
    if (threadIdx.x == 0) {
        unsigned* bar = b.bar;
        const unsigned gen = *genw;
        XB_SPIN(xb_ld(&bar[XB_TOPGEN]) == gen, bar);
        __builtin_amdgcn_fence(__ATOMIC_ACQUIRE, "agent");
        asm volatile("s_waitcnt vmcnt(0)" ::: "memory");
    }
    __syncthreads();
}

struct Frame {
    LAS unsigned char* lds;
    volatile LAS unsigned* MISC;
    gu32* ctl;
    int tid, lane, wave;
    int vcu, G;
    float* out; unsigned char* ws;
};
struct Args { const float* in[22]; float* out; unsigned char* ws; int ph_lo, ph_hi, li, pad; };
enum { I_X = 0, I_N1G, I_WIN, I_QNG, I_KNG, I_AOG, I_MU, I_W0, I_W2, I_A0, I_A2, I_G2, I_KK, I_KA, I_RK, I_LNG, I_LNB, I_WOUT, I_N2G, I_WG, I_WU, I_WD };

__device__ __forceinline__ float wave_sum(float v) {
#pragma unroll
    for (int o = 1; o < 64; o <<= 1) v += __shfl_xor(v, o);
    return v;
}
__device__ __forceinline__ float red16(float x) {
    x += __builtin_bit_cast(float, __builtin_amdgcn_update_dpp(0, __builtin_bit_cast(int, x), 0x128, 0xf, 0xf, false));
    x += __builtin_bit_cast(float, __builtin_amdgcn_update_dpp(0, __builtin_bit_cast(int, x), 0x124, 0xf, 0xf, false));
    x += __builtin_bit_cast(float, __builtin_amdgcn_update_dpp(0, __builtin_bit_cast(int, x), 0x122, 0xf, 0xf, false));
    x += __builtin_bit_cast(float, __builtin_amdgcn_update_dpp(0, __builtin_bit_cast(int, x), 0x121, 0xf, 0xf, false));
    return x;
}

constexpr int TR_SCR = 64 * 65 * 4 + 256;
__device__ __forceinline__ int tr_row(int rmode, int n) {
    return rmode == 0 ? n : rmode == 3 ? (n < 1024 ? ((n >> 8) * 256 + ((n >> 5) & 1) * 128 + ((n >> 6) & 3) * 32 + (n & 31)) : n) : ((n >> 7) * 256 + (n & 127) + (rmode == 2 ? 128 : 0));
}
__device__ __forceinline__ void p0_transpose_item(const float* W, int K, int N, bf16* WT, int rmode, LAS float* scr, int item, int lane, const float* ksc = nullptr) {
    const int nblk = N / 64, kb = item / nblk, nb = item % nblk, k0 = 64 * kb, n0 = 64 * nb;
    const int ks = lane >> 4, n4 = (lane & 15) * 4;
    f32x4 v[16];
#pragma unroll
    for (int i = 0; i < 16; ++i) v[i] = __builtin_nontemporal_load((const GAS f32x4*)((const GAS float*)W + (size_t)(k0 + 4 * i + ks) * N + n0 + n4));
#pragma unroll
    for (int i = 0; i < 16; ++i) { const int kk = 4 * i + ks; const float sc = ksc ? ksc[k0 + kk] : 1.0f;
        scr[kk * 65 + n4 + 0] = v[i].x * sc; scr[kk * 65 + n4 + 1] = v[i].y * sc; scr[kk * 65 + n4 + 2] = v[i].z * sc; scr[kk * 65 + n4 + 3] = v[i].w * sc; }
    LDS_WAIT(); asm volatile("" ::: "memory");
    GAS v4u* dst = (GAS v4u*)(WT + (size_t)tr_row(rmode, n0 + lane) * K + k0);
#pragma unroll
    for (int j = 0; j < 8; ++j) { const LAS float* c = scr + (8 * j) * 65 + lane;
        v4u o; o.x = pk2(c[0 * 65], c[1 * 65]); o.y = pk2(c[2 * 65], c[3 * 65]); o.z = pk2(c[4 * 65], c[5 * 65]); o.w = pk2(c[6 * 65], c[7 * 65]);
        dst[j] = o; }
    LDS_WAIT(); asm volatile("" ::: "memory");
}
template <int NR> __device__ __forceinline__ void rows_to_bf16_ss(int lane, const float* x0, size_t rstride, bf16* o0, size_t ostride, float* ss) {
    f32x4 v[NR][4];
#pragma unroll
    for (int r = 0; r < NR; ++r) { const GAS f32x4* xr = (const GAS f32x4*)(x0 + r * rstride) + lane;
#pragma unroll
        for (int j = 0; j < 4; ++j) v[r][j] = __builtin_nontemporal_load(xr + 64 * j); }
#pragma unroll
    for (int r = 0; r < NR; ++r) { float s = 0.f;
#pragma unroll
        for (int j = 0; j < 4; ++j) s += (v[r][j].x * v[r][j].x + v[r][j].y * v[r][j].y) + (v[r][j].z * v[r][j].z + v[r][j].w * v[r][j].w);
        s = wave_sum(s);
        if (lane == 0) ss[r] = s;
        GAS unsigned long long* o8 = (GAS unsigned long long*)(o0 + r * ostride) + lane;
#pragma unroll
        for (int j = 0; j < 4; ++j)
            o8[64 * j] = (unsigned long long)pk2(v[r][j].x, v[r][j].y) | ((unsigned long long)pk2(v[r][j].z, v[r][j].w) << 32); }
}

__device__ __forceinline__ void p0_prologue(Frame& F, const Args& AR) {
    LAS float* scr = (LAS float*)(F.lds + RING_OFF + F.wave * TR_SCR);
    const int gw = F.vcu * NWAVES + F.wave, NGW = F.G * NWAVES;
    bf16* Win_t = (bf16*)(F.ws + WS_WIN); bf16* Wout_t = (bf16*)(F.ws + WS_WOUT); bf16* Wgu_t = (bf16*)(F.ws + WS_WGU); bf16* Wdn_t = (bf16*)(F.ws + WS_WDN); bf16* Wl_t = (bf16*)(F.ws + WS_WL);
    constexpr int I_IN = (D / 64) * (IN_COLS / 64);
    for (int it = gw; it < I_IN; it += NGW) p0_transpose_item(AR.in[I_WIN], D, IN_COLS, Win_t, 3, scr, it, F.lane, AR.in[I_N1G]);
    for (int e = (F.vcu * NWAVES * 64 + F.tid); e < WLF_ELEMS; e += F.G * NWAVES * 64) {
        const int kind = e < WLF_K01 ? 0 : (e < 2 * WLF_K01 ? 1 : 2), r = e - (kind == 2 ? 2 * WLF_K01 : kind * WLF_K01);
        const int ee = r & 7, ln = (r >> 3) & 63, b = (r >> 9) & 3, s = kind == 2 ? (r >> 11) & 3 : (r >> 11) & 1, g = kind == 2 ? r >> 13 : r >> 12;
        const int k = 32 * s + 8 * (ln >> 4) + ee, c = 64 * g + 32 * (b >> 1) + 8 * ((ln & 15) >> 2) + 4 * (b & 1) + (ln & 3);
        const float* W = kind == 0 ? AR.in[I_W2] : (kind == 1 ? AR.in[I_A2] : AR.in[I_G2]);
        Wl_t[e] = (bf16)f2bf(W[k * 512 + c]);
    }
    bf16* XBF = (bf16*)(F.ws + WS_XBF); float* SS1 = (float*)(F.ws + WS_SS1);
    for (int m = gw * 4; m < M; m += NGW * 4) rows_to_bf16_ss<4>(F.lane, AR.in[I_X] + (size_t)m * D, D, XBF + (size_t)m * D, D, SS1 + m);
}

constexpr int LR_ROWB = 528;
#define MFMA16(a, b, c) __builtin_amdgcn_mfma_f32_16x16x32_bf16((a), (b), (c), 0, 0, 0)
template <int KIND> struct P3W { bf16x8 Af[KIND == 2 ? 4 : 2][4]; f32x4 bs[2][2]; };
template <int KIND> __device__ __forceinline__ void p3_wload(P3W<KIND>& W, const bf16* WLF, const float* bias, int wave, int lane) {
    constexpr int KS = KIND == 2 ? 4 : 2;
    const int q = lane >> 4;
    const GAS v4u* wf = (const GAS v4u*)(WLF + (KIND == 2 ? 2 * WLF_K01 : KIND * WLF_K01)) + (size_t)wave * KS * 4 * 64 + lane;
#pragma unroll
    for (int s = 0; s < KS; ++s)
#pragma unroll
        for (int b = 0; b < 4; ++b) W.Af[s][b] = __builtin_bit_cast(bf16x8, wf[(s * 4 + b) * 64]);
    if (KIND != 2) {
#pragma unroll
        for (int p = 0; p < 2; ++p) { const GAS f32x4* bp = (const GAS f32x4*)((const GAS float*)bias + 64 * wave + 32 * p + 8 * q); W.bs[p][0] = bp[0] * (-LOG2E); W.bs[p][1] = bp[1] * (-LOG2E); }
    }
}
template <int KIND> __device__ __forceinline__ void p3_kind(const LAS unsigned char* At, const P3W<KIND>& W, bf16* DAG, int m0, int wave, int lane) {
    constexpr int KS = KIND == 2 ? 4 : 2, KOFF = KIND == 0 ? 0 : (KIND == 1 ? 64 : 128);
    const int q = lane >> 4, t = lane & 15;
    const auto& Af = W.Af; const auto& bs = W.bs;
    const LAS unsigned char* ap = At + t * LR_ROWB + (KOFF + 8 * q) * 2;
    constexpr int DREC = KIND == 2 ? 64 : 128;
    GAS bf16* dp = (GAS bf16*)DAG + (KIND == 2 ? DAG_G : 0) + (((size_t)(m0 >> 4) * 8 + wave) * 16 + t) * DREC + (KIND == 1 ? 64 : 0) + 8 * q;
    const f32x4 z4 = {0.f, 0.f, 0.f, 0.f};
#pragma unroll 2
    for (int tb = 0; tb < 8; ++tb) {
        bf16x8 Bf[KS];
#pragma unroll
        for (int s = 0; s < KS; ++s) Bf[s] = *(const LAS bf16x8*)(ap + tb * 16 * LR_ROWB + 64 * s);
        f32x4 acc[4];
#pragma unroll
        for (int b = 0; b < 4; ++b) { acc[b] = MFMA16(Af[0][b], Bf[0], z4);
#pragma unroll
            for (int s = 1; s < KS; ++s) acc[b] = MFMA16(Af[s][b], Bf[s], acc[b]); }
#pragma unroll
        for (int p = 0; p < 2; ++p) {
            f32x4 v0 = acc[2 * p], v1 = acc[2 * p + 1];
            if (KIND != 2) {
#pragma unroll
                for (int e = 0; e < 4; ++e) { v0[e] = __builtin_amdgcn_rcpf(1.0f + __builtin_amdgcn_exp2f(__builtin_fmaf(v0[e], -LOG2E, bs[p][0][e])));
                                              v1[e] = __builtin_amdgcn_rcpf(1.0f + __builtin_amdgcn_exp2f(__builtin_fmaf(v1[e], -LOG2E, bs[p][1][e]))); }
            }
            v4u w; w.x = cvt2(v0[0], v0[1]); w.y = cvt2(v0[2], v0[3]); w.z = cvt2(v1[0], v1[1]); w.w = cvt2(v1[2], v1[3]);
            *(GAS v4u*)(dp + (size_t)tb * (8 * 16 * DREC) + 32 * p) = w;
        }
    }
}
__device__ __forceinline__ void p3_lora(Frame& F, const Args& AR) {
    const int lane = F.lane, wave = F.wave;
    const bf16* PROJ = (const bf16*)(F.ws + WS_PROJ); const bf16* WLF = (const bf16*)(F.ws + WS_WL); bf16* DAG = (bf16*)(F.ws + WS_DAG);
    LAS unsigned char* At = F.lds + RING_OFF;
    const f32x4 mu4 = *(const f32x4*)(AR.in[I_MU] + RC_L + 4 * lane);
    const float ksc = lane < 16 ? -2.f * LOG2E : -LOG2E;
    for (int u = F.vcu; u < M / 128; u += F.G) {
        const int m0 = u * 128, t0 = 16 * wave;
        P3W<0> W0; P3W<1> W1; P3W<2> W2;
        p3_wload<0>(W0, WLF, AR.in[I_W0], wave, lane); p3_wload<1>(W1, WLF, AR.in[I_A0], wave, lane);
        const GAS bf16* row = (const GAS bf16*)PROJ + (size_t)(m0 + t0) * IN_COLS + PC_RW + RC_L + 4 * lane;
        v2u w[17];
        w[0] = (v2u){0u, 0u};
        if (((m0 + t0) & (SEQ - 1)) != 0) w[0] = *(const GAS v2u*)(row - IN_COLS);
#pragma unroll
        for (int i = 0; i < 16; ++i) w[i + 1] = *(const GAS v2u*)(row + (size_t)i * IN_COLS);
#pragma unroll
        for (int i = 0; i < 16; ++i) {
            const v2u cu = w[i + 1], pv = w[i];
            const float c4[4] = {bflo(cu.x), bfhi(cu.x), bflo(cu.y), bfhi(cu.y)}, p4[4] = {bflo(pv.x), bfhi(pv.x), bflo(pv.y), bfhi(pv.y)};
            float xs[4];
#pragma unroll
            for (int e = 0; e < 4; ++e) { const float v = c4[e] + (p4[e] - c4[e]) * mu4[e];
                const float s = __builtin_amdgcn_rcpf(1.0f + __builtin_amdgcn_exp2f(ksc * v));
                xs[e] = lane < 16 ? 2.f * s - 1.f : (lane < 32 ? v : s); }
            *(LAS v2u*)(At + (t0 + i) * LR_ROWB + 8 * lane) = (v2u){pk2(xs[0], xs[1]), pk2(xs[2], xs[3])};
        }
        __syncthreads();
        p3_wload<2>(W2, WLF, nullptr, wave, lane);
        p3_kind<0>(At, W0, DAG, m0, wave, lane);
        p3_kind<1>(At, W1, DAG, m0, wave, lane);
        p3_kind<2>(At, W2, DAG, m0, wave, lane);
        __syncthreads();
    }
}

__device__ __forceinline__ float red8(float x) {
    x += __builtin_bit_cast(float, __builtin_amdgcn_update_dpp(0, __builtin_bit_cast(int, x), 0xB1, 0xf, 0xf, false));
    x += __builtin_bit_cast(float, __builtin_amdgcn_update_dpp(0, __builtin_bit_cast(int, x), 0x4E, 0xf, 0xf, false));
    x += __builtin_bit_cast(float, __builtin_amdgcn_update_dpp(0, __builtin_bit_cast(int, x), 0x141, 0xf, 0xf, false));
    return x;
}
__device__ __forceinline__ float redrows(float x) {
    { auto r = __builtin_amdgcn_permlane16_swap(__float_as_uint(x), __float_as_uint(x), false, false); x = __uint_as_float(r[0]) + __uint_as_float(r[1]); }
    { auto r = __builtin_amdgcn_permlane32_swap(__float_as_uint(x), __float_as_uint(x), false, false); x = __uint_as_float(r[0]) + __uint_as_float(r[1]); }
    return x;
}
constexpr int CS = 16, NCHUNK = SEQ / CS, NHELP = 4, NSTATE = 4, NIT = (NCHUNK + NHELP - 1) / NHELP;
constexpr int ROWB = 144, TILEB = 40;
constexpr int SL_A = 0, SL_R = 16 * ROWB, SL_B = 32 * ROWB, SL_K = 48 * ROWB, SL_V = 64 * ROWB, SL_T = 80 * ROWB, SL_LAK = SL_T + 16 * TILEB, SL_LRB = SL_LAK + 16 * TILEB, SL_LRK = SL_LRB + 16 * TILEB,
              SL_G = SL_LRK + 16 * TILEB, SL_BON = SL_G + 256, SL_INV = SL_BON + 64, SL_BYTES = SL_INV + 64;
static_assert(SL_BYTES % 16 == 0 && SL_T % 8 == 0, "slot alignment");
constexpr int SC_CONST = 2 * NHELP * SL_BYTES;
constexpr int SC_YL = SC_CONST + 6 * 64 * 4, YL_BYTES = NHELP * CS * 256;
constexpr int SC_TS = SC_YL + 2 * YL_BYTES;
static_assert(SC_TS + NSTATE * NHELP * 16 * TILEB <= RING_BYTES && NHELP * CS * 8 == 2 * NSTATE * 64 && NCHUNK % NHELP == 0 && NHELP % 2 == 0, "scan LDS");
struct HReg { v4u r[2], k[2], v[2], pr[2], pk[2], pv[2], e[2], a[2]; };
__device__ __forceinline__ void helper_load(HReg& R, const bf16* PROJ, const bf16* DAG, int tok, int h, int kg) {
    const GAS bf16* row = (const GAS bf16*)PROJ + (size_t)tok * IN_COLS + PC_RW + h * 64 + 16 * kg;
    const GAS bf16* rowp = row - IN_COLS;
    const GAS bf16* dr = (const GAS bf16*)DAG + (((size_t)(tok >> 4) * 8 + h) * 16 + (tok & 15)) * 128 + 16 * kg;
    asm volatile("" : "+v"(row)); asm volatile("" : "+v"(rowp)); asm volatile("" : "+v"(dr));
    const bool hp = (tok & (SEQ - 1)) != 0;
#pragma unroll
    for (int i = 0; i < 2; ++i) {
        R.r[i] = *(const GAS v4u*)(row + RC_R + 8 * i); R.k[i] = *(const GAS v4u*)(row + RC_K + 8 * i); R.v[i] = *(const GAS v4u*)(row + RC_V + 8 * i);
        if (hp) { R.pr[i] = *(const GAS v4u*)(rowp + RC_R + 8 * i); R.pk[i] = *(const GAS v4u*)(rowp + RC_K + 8 * i); R.pv[i] = *(const GAS v4u*)(rowp + RC_V + 8 * i); }
        else { R.pr[i] = (v4u){0u, 0u, 0u, 0u}; R.pk[i] = R.pr[i]; R.pv[i] = R.pr[i]; }
        R.e[i] = *(const GAS v4u*)(dr + 8 * i); R.a[i] = *(const GAS v4u*)(dr + 64 + 8 * i);
    }
}
__device__ __forceinline__ void unpack4(const unsigned w0, const unsigned w1, float (&x)[4]) { x[0] = bflo(w0); x[1] = bfhi(w0); x[2] = bflo(w1); x[3] = bfhi(w1); }
__device__ __forceinline__ float dpp_shr(float x, const int ctrl_sel) {
    int r;
    if (ctrl_sel == 1) r = __builtin_amdgcn_update_dpp(0, __builtin_bit_cast(int, x), 0x111, 0xf, 0xf, true);
    else if (ctrl_sel == 2) r = __builtin_amdgcn_update_dpp(0, __builtin_bit_cast(int, x), 0x112, 0xf, 0xf, true);
    else if (ctrl_sel == 4) r = __builtin_amdgcn_update_dpp(0, __builtin_bit_cast(int, x), 0x114, 0xf, 0xf, true);
    else r = __builtin_amdgcn_update_dpp(0, __builtin_bit_cast(int, x), 0x118, 0xf, 0xf, true);
    return __builtin_bit_cast(float, r);
}
__device__ __forceinline__ unsigned cvt2s(float lo, float hi) { asm volatile("" : "+v"(lo), "+v"(hi)); return cvt2(lo, hi); }
__device__ __forceinline__ bf16x8 mk8(unsigned a, unsigned b, unsigned c, unsigned d) { return __builtin_bit_cast(bf16x8, (v4u){a, b, c, d}); }
__device__ __forceinline__ bf16x8 accB(const f32x4 v) { return mk8(cvt2(v[0], v[1]), cvt2(v[2], v[3]), 0u, 0u); }
__device__ __forceinline__ v2u trd(const LAS unsigned char* p) { typedef short v4i16_t __attribute__((ext_vector_type(4)));
    return __builtin_bit_cast(v2u, __builtin_amdgcn_ds_read_tr16_b64_v4i16((LAS v4i16_t*)p)); }
#define PIN_PTR(p) asm volatile("" : "+v"(p))

#define HR_UNPACK(dst, arr, gp) do { if ((gp) & 1) unpack4(R.arr[(gp) >> 1].z, R.arr[(gp) >> 1].w, dst); else unpack4(R.arr[(gp) >> 1].x, R.arr[(gp) >> 1].y, dst); } while (0)
__device__ __forceinline__ void helper_chunk(LAS unsigned char* slot, const LAS float* cst, HReg& R, bool prefetch, const bf16* PROJ, const bf16* DAG, float* BON, int tok, int h, int lane) {
    const int t = lane & 15, kg = lane >> 4;
    LAS unsigned char* p_row = slot + t * ROWB + kg * 16;
    LAS unsigned char* p_v = slot + SL_V + t * ROWB + kg * 32;
    LAS unsigned char* p_tw = slot + t * TILEB + kg * 8;
    LAS unsigned char* p_g = slot + SL_G + kg * 16;
    const LAS float* p_c = cst + 16 * kg;
    PIN_PTR(p_row); PIN_PTR(p_v); PIN_PTR(p_tw); PIN_PTR(p_g); PIN_PTR(p_c);
    float E[16], G[16], GI[16], GP[16];
#pragma unroll
    for (int gp = 0; gp < 4; ++gp) { float e[4]; HR_UNPACK(e, e, gp);
#pragma unroll
        for (int i = 0; i < 4; ++i) E[4 * gp + i] = e[i]; }
#pragma unroll
    for (int q = 0; q < 16; ++q) E[q] += dpp_shr(E[q], 1);
#pragma unroll
    for (int q = 0; q < 16; ++q) E[q] += dpp_shr(E[q], 2);
#pragma unroll
    for (int q = 0; q < 16; ++q) E[q] += dpp_shr(E[q], 4);
#pragma unroll
    for (int q = 0; q < 16; ++q) E[q] += dpp_shr(E[q], 8);
#pragma unroll
    for (int q = 0; q < 16; ++q) { G[q] = __builtin_amdgcn_exp2f((-0.6065306597126334f * LOG2E) * E[q]); GI[q] = __builtin_amdgcn_exp2f((0.6065306597126334f * LOG2E) * E[q]); }
#pragma unroll
    for (int q = 0; q < 16; ++q) { const float gpv = dpp_shr(G[q], 1); GP[q] = (t == 0) ? 1.f : gpv; }
    if (t == 15) {
#pragma unroll
        for (int gp = 0; gp < 4; ++gp) *(LAS f32x4*)(p_g + gp * 64) = (f32x4){G[4 * gp], G[4 * gp + 1], G[4 * gp + 2], G[4 * gp + 3]};
    }
    float ss = 0.f, bon = 0.f;
#pragma unroll
    for (int gp = 0; gp < 4; ++gp) {
        float r[4], k[4], v[4], pr[4], pk[4], pv[4], a[4];
        HR_UNPACK(r, r, gp); HR_UNPACK(k, k, gp); HR_UNPACK(v, v, gp); HR_UNPACK(pr, pr, gp); HR_UNPACK(pk, pk, gp); HR_UNPACK(pv, pv, gp); HR_UNPACK(a, a, gp);
        const f32x4 mur = *(const LAS f32x4*)(p_c + 0 * 64 + 4 * gp), muk = *(const LAS f32x4*)(p_c + 1 * 64 + 4 * gp), muv = *(const LAS f32x4*)(p_c + 2 * 64 + 4 * gp);
        const f32x4 kkc = *(const LAS f32x4*)(p_c + 3 * 64 + 4 * gp), kac = *(const LAS f32x4*)(p_c + 4 * 64 + 4 * gp), rkc = *(const LAS f32x4*)(p_c + 5 * 64 + 4 * gp);
        float xv[4], At[4], Rt[4], Bt[4], Kt[4];
#pragma unroll
        for (int i = 0; i < 4; ++i) { const int q = 4 * gp + i;
            const float xr = r[i] + (pr[i] - r[i]) * mur[i], xk = k[i] + (pk[i] - k[i]) * muk[i]; xv[i] = v[i] + (pv[i] - v[i]) * muv[i];
            const float kkv = xk * kkc[i], kpv = xk * (1.f + (a[i] - 1.f) * kac[i]); ss += kkv * kkv; bon += xr * kpv * rkc[i];
            At[i] = -kkv * GP[q]; Rt[i] = xr * G[q]; Bt[i] = kkv * a[i] * GI[q]; Kt[i] = kpv * GI[q]; }
        *(LAS v2u*)(p_v + gp * 8) = (v2u){cvt2s(xv[0], xv[1]), cvt2s(xv[2], xv[3])};
        const int co = (gp >> 1) * 64 + (gp & 1) * 8;
        *(LAS v2u*)(p_row + SL_A + co) = (v2u){cvt2s(At[0], At[1]), cvt2s(At[2], At[3])}; *(LAS v2u*)(p_row + SL_R + co) = (v2u){cvt2s(Rt[0], Rt[1]), cvt2s(Rt[2], Rt[3])};
        *(LAS v2u*)(p_row + SL_B + co) = (v2u){cvt2s(Bt[0], Bt[1]), cvt2s(Bt[2], Bt[3])}; *(LAS v2u*)(p_row + SL_K + co) = (v2u){cvt2s(Kt[0], Kt[1]), cvt2s(Kt[2], Kt[3])};
    }
    ss = redrows(ss); bon = redrows(bon);
    const float inv = __builtin_amdgcn_rsqf(fmaxf(ss, 1e-24f));
    if (kg == 0) { *(LAS float*)(slot + SL_BON + t * 4) = bon; *(LAS float*)(slot + SL_INV + t * 4) = inv; }
    if (prefetch) helper_load(R, PROJ, DAG, tok + NHELP * CS, h, kg);
    const bf16x8 FA0 = *(const LAS bf16x8*)(p_row + SL_A), FA1 = *(const LAS bf16x8*)(p_row + SL_A + 64), FR0 = *(const LAS bf16x8*)(p_row + SL_R), FR1 = *(const LAS bf16x8*)(p_row + SL_R + 64);
    const bf16x8 FB0 = *(const LAS bf16x8*)(p_row + SL_B), FB1 = *(const LAS bf16x8*)(p_row + SL_B + 64), FK0 = *(const LAS bf16x8*)(p_row + SL_K), FK1 = *(const LAS bf16x8*)(p_row + SL_K + 64);
    const f32x4 z4 = (f32x4){0.f, 0.f, 0.f, 0.f};
    f32x4 Lab = MFMA16(FA0, FB0, z4); Lab = MFMA16(FA1, FB1, Lab);
    f32x4 Lak = MFMA16(FA0, FK0, z4); Lak = MFMA16(FA1, FK1, Lak);
    f32x4 Lrb = MFMA16(FR0, FB0, z4); Lrb = MFMA16(FR1, FB1, Lrb);
    f32x4 Lrk = MFMA16(FR0, FK0, z4); Lrk = MFMA16(FR1, FK1, Lrk);
    const int s = t;
#pragma unroll
    for (int r = 0; r < 4; ++r) { const int tt = 4 * kg + r;
        Lab[r] = tt > s ? Lab[r] : 0.f; Lak[r] = tt > s ? Lak[r] : 0.f; Lrb[r] = tt >= s ? Lrb[r] : 0.f; Lrk[r] = tt >= s ? Lrk[r] : 0.f; }
    { const f32x4 ir = *(const LAS f32x4*)(slot + SL_INV + 16 * kg);
      Lab = Lab * ir * inv; }
#define WR_TILE(off, X) (*(LAS v2u*)(p_tw + (off)) = (v2u){cvt2((X)[0], (X)[1]), cvt2((X)[2], (X)[3])})
    WR_TILE(SL_LAK, Lak); WR_TILE(SL_LRB, Lrb); WR_TILE(SL_LRK, Lrk); WR_TILE(SL_T, Lab);
#undef WR_TILE
}

struct SOps { bf16x8 a0, a1, r0, r1; v2u vt, lak, lrb, lrk, bb[4], kk2[4]; f32x4 gm[4], bn, iv; };
__device__ __forceinline__ void state_load(SOps& O, const LAS unsigned char* slot, int lane, int wv) {
    const int c = lane & 15, g = lane >> 4, q4 = 4 * g + (c >> 2), pp = c & 3;
    const LAS unsigned char* p128 = slot + c * ROWB + g * 16;
    const LAS unsigned char* p_bt = slot + q4 * ROWB + pp * 16;
    const LAS unsigned char* p_tr = slot + q4 * TILEB + pp * 8;
    const LAS unsigned char* p_v = slot + SL_V + q4 * ROWB + wv * 32 + pp * 8;
    const LAS unsigned char* pg = slot + SL_G + g * 16;
    PIN_PTR(p128); PIN_PTR(p_bt); PIN_PTR(p_tr); PIN_PTR(p_v); PIN_PTR(pg);
    O.a0 = *(const LAS bf16x8*)(p128 + SL_A); O.a1 = *(const LAS bf16x8*)(p128 + SL_A + 64); O.r0 = *(const LAS bf16x8*)(p128 + SL_R); O.r1 = *(const LAS bf16x8*)(p128 + SL_R + 64);
    O.vt = trd(p_v); O.lak = trd(p_tr + SL_LAK); O.lrb = trd(p_tr + SL_LRB); O.lrk = trd(p_tr + SL_LRK);
#pragma unroll
    for (int jb = 0; jb < 4; ++jb) { O.bb[jb] = trd(p_bt + SL_B + (jb >> 1) * 64 + (jb & 1) * 8); O.kk2[jb] = trd(p_bt + SL_K + (jb >> 1) * 64 + (jb & 1) * 8); O.gm[jb] = *(const LAS f32x4*)(pg + jb * 64); }
    O.bn = *(const LAS f32x4*)(slot + SL_BON + 16 * g); O.iv = *(const LAS f32x4*)(slot + SL_INV + 16 * g);
}
__device__ __forceinline__ void state_compute(const SOps& O, const v2u tt, f32x4 (&X)[4], LAS unsigned char* yl, int lane, int wv) {
    const int c = lane & 15, g = lane >> 4;
    const f32x4 z4 = (f32x4){0.f, 0.f, 0.f, 0.f};
    const bf16x8 xb0 = mk8(cvt2(X[0][0], X[0][1]), cvt2(X[0][2], X[0][3]), cvt2(X[1][0], X[1][1]), cvt2(X[1][2], X[1][3]));
    const bf16x8 xb1 = mk8(cvt2(X[2][0], X[2][1]), cvt2(X[2][2], X[2][3]), cvt2(X[3][0], X[3][1]), cvt2(X[3][2], X[3][3]));
    f32x4 Z = MFMA16(O.a0, xb0, z4); Z = MFMA16(O.a1, xb1, Z); Z = MFMA16(mk8(O.lak.x, O.lak.y, 0u, 0u), mk8(O.vt.x, O.vt.y, 0u, 0u), Z) * O.iv;
    const f32x4 U = MFMA16(mk8(tt.x, tt.y, 0u, 0u), accB(Z), z4) * O.iv;
    const bf16x8 uv = mk8(cvt2(U[0], U[1]), cvt2(U[2], U[3]), O.vt.x, O.vt.y);
    f32x4 Y = MFMA16(O.r0, xb0, z4); Y = MFMA16(O.r1, xb1, Y); Y = MFMA16(mk8(O.lrb.x, O.lrb.y, O.lrk.x, O.lrk.y), uv, Y);
#pragma unroll
    for (int jb = 0; jb < 4; ++jb) X[jb] = MFMA16(mk8(O.bb[jb].x, O.bb[jb].y, O.kk2[jb].x, O.kk2[jb].y), uv, X[jb]) * O.gm[jb];
    LAS unsigned char* py = yl + (4 * g) * 256 + (16 * wv + c) * 2;
    PIN_PTR(py);
    const float vv[4] = {bflo(O.vt.x), bfhi(O.vt.x), bflo(O.vt.y), bfhi(O.vt.y)};
#pragma unroll
    for (int r = 0; r < 4; ++r) { *(LAS unsigned short*)(py + r * 256) = (unsigned short)f2bf(Y[r]); *(LAS unsigned short*)(py + r * 256 + 128) = (unsigned short)f2bf(O.bn[r] * vv[r]); }
}
__device__ __forceinline__ void state_T(v2u (&tt)[NHELP], const LAS unsigned char* set0, LAS unsigned char* scr, int lane) {
    const int c = lane & 15, g = lane >> 4;
    const int o_w = c * TILEB + g * 8, o_r = (4 * g + (c >> 2)) * TILEB + (c & 3) * 8;
    const f32x4 z4 = (f32x4){0.f, 0.f, 0.f, 0.f};
    bf16x8 A1[NHELP], A2[NHELP], A4[NHELP]; f32x4 P[NHELP];
#pragma unroll
    for (int k = 0; k < NHELP; ++k) { const LAS unsigned char* tl = set0 + k * SL_BYTES + SL_T;
        const v2u bl = *(const LAS v2u*)(tl + o_w), al = trd(tl + o_r); A1[k] = mk8(al.x, al.y, 0u, 0u); P[k] = MFMA16(A1[k], mk8(bl.x, bl.y, 0u, 0u), z4); }
#pragma unroll
    for (int k = 0; k < NHELP; ++k) *(LAS v2u*)(scr + k * (16 * TILEB) + o_w) = (v2u){cvt2(P[k][0], P[k][1]), cvt2(P[k][2], P[k][3])};
#pragma unroll
    for (int k = 0; k < NHELP; ++k) { const v2u al = trd(scr + k * (16 * TILEB) + o_r); A2[k] = mk8(al.x, al.y, 0u, 0u); P[k] = MFMA16(A2[k], accB(P[k]), z4); }
#pragma unroll
    for (int k = 0; k < NHELP; ++k) *(LAS v2u*)(scr + k * (16 * TILEB) + o_w) = (v2u){cvt2(P[k][0], P[k][1]), cvt2(P[k][2], P[k][3])};
#pragma unroll
    for (int k = 0; k < NHELP; ++k) { const v2u al = trd(scr + k * (16 * TILEB) + o_r); A4[k] = mk8(al.x, al.y, 0u, 0u); P[k] = MFMA16(A4[k], accB(P[k]), z4); }
#pragma unroll
    for (int k = 0; k < NHELP; ++k) {
#pragma unroll
        for (int r = 0; r < 4; ++r) P[k][r] += (4 * g + r == c) ? 1.f : 0.f; }
#pragma unroll
    for (int k = 0; k < NHELP; ++k) P[k] = MFMA16(A4[k], accB(P[k]), P[k]);
#pragma unroll
    for (int k = 0; k < NHELP; ++k) P[k] = MFMA16(A2[k], accB(P[k]), P[k]);
#pragma unroll
    for (int k = 0; k < NHELP; ++k) P[k] = MFMA16(A1[k], accB(P[k]), P[k]);
#pragma unroll
    for (int k = 0; k < NHELP; ++k) *(LAS v2u*)(scr + k * (16 * TILEB) + o_w) = (v2u){cvt2(P[k][0], P[k][1]), cvt2(P[k][2], P[k][3])};
#pragma unroll
    for (int k = 0; k < NHELP; ++k) tt[k] = trd(scr + k * (16 * TILEB) + o_r);
}

__device__ __forceinline__ void p4_scan(Frame& F, const Args& AR) {
    const bf16* PROJ = (const bf16*)(F.ws + WS_PROJ); const bf16* DAG = (const bf16*)(F.ws + WS_DAG);
    float* BON = nullptr; bf16* MIX = (bf16*)(F.ws + WS_XN);
    LAS unsigned char* lds = F.lds + RING_OFF;
    LAS float* cst = (LAS float*)(lds + SC_CONST);
    const int tid = F.tid, lane = F.lane, wave = F.wave;
    for (int unit = blockIdx.x; unit < BATCH * NH; unit += F.G) {
        const int b = unit >> 3, h = unit & 7;
        const int tok0 = b * SEQ;
        if (tid < 384) { const int a = tid >> 6, c = tid & 63; const float* src = a == 0 ? AR.in[I_MU] + RC_R : a == 1 ? AR.in[I_MU] + RC_K : a == 2 ? AR.in[I_MU] + RC_V : a == 3 ? AR.in[I_KK] : a == 4 ? AR.in[I_KA] : AR.in[I_RK];
            cst[a * 64 + c] = src[h * 64 + c]; }
        __syncthreads();
        const int st_k = (tid >> 7) & 1, st_t = (tid >> 3) & 15, st_p = tid & 7;
        GAS v4u* ystore = (GAS v4u*)((GAS bf16*)MIX + (size_t)(tok0 + st_k * CS + st_t) * D + AW + h * 64 + 8 * st_p);
        const GAS v4u* gload = (const GAS v4u*)((const GAS bf16*)DAG + DAG_G + (((size_t)((tok0 >> 4) + st_k) * 8 + h) * 16 + st_t) * 64 + 8 * st_p);
        const LAS unsigned char* yl_rd = lds + SC_YL + st_k * (CS * 256) + st_t * 256 + st_p * 16;
        v4u gnA = (v4u){0u, 0u, 0u, 0u}, gnB = gnA;
        float lng[8], lnb[8];
#pragma unroll
        for (int i = 0; i < 8; ++i) { lng[i] = AR.in[I_LNG][h * 64 + 8 * st_p + i]; lnb[i] = AR.in[I_LNB][h * 64 + 8 * st_p + i]; }
#define RWKV_OUT(it_, KO, gnext) do { if ((it_) >= 2 && NHELP * ((it_) - 2) + st_k + (KO) < NCHUNK) { \
            const v4u gw4 = gnext; \
            const v4u yw = *(const LAS v4u*)(yl_rd + (KO) * (CS * 256) + ((it_) & 1) * YL_BYTES), bw = *(const LAS v4u*)(yl_rd + (KO) * (CS * 256) + ((it_) & 1) * YL_BYTES + 128); \
            float y[8] = {bflo(yw.x), bfhi(yw.x), bflo(yw.y), bfhi(yw.y), bflo(yw.z), bfhi(yw.z), bflo(yw.w), bfhi(yw.w)}; \
            float sm = ((y[0] + y[1]) + (y[2] + y[3])) + ((y[4] + y[5]) + (y[6] + y[7])); \
            sm = red8(sm); \
            const float mean = sm * (1.f / 64.f); float sv = 0.f; \
            _Pragma("unroll") for (int i = 0; i < 8; ++i) { y[i] -= mean; sv += y[i] * y[i]; } \
            sv = red8(sv); \
            const float rs = __builtin_amdgcn_rsqf(sv * (1.f / 64.f) + LNX_EPS);     \
            const float bf_[8] = {bflo(bw.x), bfhi(bw.x), bflo(bw.y), bfhi(bw.y), bflo(bw.z), bfhi(bw.z), bflo(bw.w), bfhi(bw.w)}; \
            const float gf[8] = {bflo(gw4.x), bfhi(gw4.x), bflo(gw4.y), bfhi(gw4.y), bflo(gw4.z), bfhi(gw4.z), bflo(gw4.w), bfhi(gw4.w)}; \
            float ro[8]; \
            _Pragma("unroll") for (int i = 0; i < 8; ++i) ro[i] = (y[i] * rs * lng[i] + lnb[i] + bf_[i]) * gf[i]; \
            ystore[(size_t)(NHELP * ((it_) - 2) + (KO)) * CS * D / 8] = (v4u){pk2(ro[0], ro[1]), pk2(ro[2], ro[3]), pk2(ro[4], ro[5]), pk2(ro[6], ro[7])}; } \
            if ((it_) >= 1 && NHELP * ((it_) - 1) + st_k + (KO) < NCHUNK) gnext = gload[(size_t)(NHELP * ((it_) - 1) + (KO)) * (8 * 16 * 64 / 8)]; } while (0)
        volatile LAS unsigned* cnt = (volatile LAS unsigned*)(F.lds + LDSCTL_OFF + 128);
        if (tid < 8) cnt[tid] = 0u;
        __syncthreads();
#define LDS_WAIT_GE(idx, target) do { while (cnt[idx] < (unsigned)(target)) __builtin_amdgcn_s_sleep(1); asm volatile("" ::: "memory"); } while (0)
#define LDS_SIGNAL(idx) do { asm volatile("s_waitcnt lgkmcnt(0)" ::: "memory"); if (lane == 0) __hip_atomic_fetch_add((LAS unsigned*)(cnt + (idx)), 1u, __ATOMIC_RELAXED, __HIP_MEMORY_SCOPE_WORKGROUP); } while (0)
        if (wave >= NSTATE) {
            const int hw = wave - NSTATE, kg = lane >> 4, tokl = tok0 + (lane & 15);
            HReg R;
            helper_load(R, PROJ, DAG, tokl + hw * CS, h, kg);
            for (int it = 0; it < NIT; ++it) {
                const int ch = NHELP * it + hw, s_ = it & 1;
                if (it >= 2) LDS_WAIT_GE(2 + s_, NSTATE * (it >> 1));
                helper_chunk(lds + (s_ * NHELP + hw) * SL_BYTES, cst, R, ch + NHELP < NCHUNK, PROJ, DAG, BON, tokl + ch * CS, h, lane);
                LDS_SIGNAL(0 + s_);
            }
        } else {
            f32x4 X[4];
#pragma unroll
            for (int jb = 0; jb < 4; ++jb) X[jb] = (f32x4){0.f, 0.f, 0.f, 0.f};
            for (int j = 0; j <= NIT; ++j) {
                if (j >= 1) { LDS_WAIT_GE(4 + ((j - 1) & 1), NSTATE * (((j - 1) >> 1) + 1));
                    RWKV_OUT(j + 1, 0, gnA); RWKV_OUT(j + 1, 2, gnB);
                    LDS_SIGNAL(6 + ((j - 1) & 1)); }
                else { RWKV_OUT(j + 1, 0, gnA); RWKV_OUT(j + 1, 2, gnB); }
                if (j < NIT) {
                    const int s_ = j & 1;
                    LDS_WAIT_GE(0 + s_, NHELP * ((j >> 1) + 1));
                    if (j >= 2) LDS_WAIT_GE(6 + s_, NSTATE * (j >> 1));
                    const LAS unsigned char* set0 = lds + (s_ * NHELP) * SL_BYTES;
                    LAS unsigned char* ylb = lds + SC_YL + s_ * YL_BYTES;
                    v2u tt[NHELP];
                    SOps Oa, Ob;
                    state_load(Oa, set0, lane, wave);
                    state_T(tt, set0, lds + SC_TS + wave * (NHELP * 16 * TILEB), lane);
#pragma unroll
                    for (int k = 0; k < NHELP; k += 2) {
                        state_load(Ob, set0 + (k + 1) * SL_BYTES, lane, wave);
                        state_compute(Oa, tt[k], X, ylb + k * (CS * 256), lane, wave);
                        if (k + 2 < NHELP) state_load(Oa, set0 + (k + 2) * SL_BYTES, lane, wave);
                        state_compute(Ob, tt[k + 1], X, ylb + (k + 1) * (CS * 256), lane, wave);
                    }
                    LDS_SIGNAL(2 + s_); LDS_SIGNAL(4 + s_);
                }
            }
        }
#undef LDS_WAIT_GE
#undef LDS_SIGNAL
        __syncthreads();
    }
}

__device__ __forceinline__ s16x4 vtr(const LAS unsigned char* p) { typedef short v4i16_t __attribute__((ext_vector_type(4)));
    return __builtin_bit_cast(s16x4, __builtin_amdgcn_ds_read_tr16_b64_v4i16((LAS v4i16_t*)p)); }
constexpr int ATT_UNITS = 3 * BATCH * NH * 16;
__device__ __forceinline__ void p4_attn(Frame& F, const Args& AR) {
    const bf16* PROJ = (const bf16*)(F.ws + WS_PROJ);
    bf16* PO = (bf16*)((unsigned char*)F.out + DO_PO); float* ML = (float*)(F.ws + WS_ML);
    const int tid = F.tid, lane = F.lane, wave = F.wave, half = wave >> 2, wq = wave & 3, th = tid & 255;
    const int r32 = lane & 31, hi = lane >> 5;
    LAS unsigned char* Kl = F.lds + RING_OFF + half * 65536; LAS unsigned char* Vl = Kl + 32768;
    float Bsh;
    { float gq = fabsf(AR.in[I_QNG][lane]), gk = fabsf(AR.in[I_KNG][lane]);
#pragma unroll
      for (int o = 1; o < 64; o <<= 1) { gq = fmaxf(gq, __shfl_xor(gq, o)); gk = fmaxf(gk, __shfl_xor(gk, o)); }
      Bsh = 8.f * LOG2E * gq * gk; }
    v4u kfb0;
    { const unsigned kpb = cvt2((float)r32, 0.f) & 0xffffu, one = 0x3F80u;
      kfb0 = hi ? (v4u){0u, 0u, 0u, 0u} : (v4u){kpb | (kpb << 16), kpb | (one << 16), one | (one << 16), 0u}; }
    gu32* qctr = F.ctl + CW_ATTQ;
    v4u kst[8], vst[8];
#define ATT_DECODE(up_) const int unit = 2 * (up_) + half; \
        const int pat = unit / (BATCH * NH * 16), rem = unit % (BATCH * NH * 16), bh = rem >> 4, i16 = rem & 15, b = bh >> 3, h = bh & 7; \
        const int dil = pat == 0 ? 1 : (pat == 1 ? 4 : 16); \
        const int res = pat == 0 ? 0 : (pat == 1 ? (i16 >> 2) : i16); \
        const int n = pat == 0 ? i16 : (pat == 1 ? (i16 & 3) : 0); \
        const size_t rowb = (size_t)b * SEQ;
#define ATT_ISSUE(up_) do { ATT_DECODE(up_) const int c = th & 7; \
        _Pragma("unroll") for (int i = 0; i < 8; ++i) { const int key = (th >> 3) + 32 * i; const int sub = 128 * (n - 1) + key; \
            kst[i] = (v4u){0u, 0u, 0u, 0u}; vst[i] = kst[i]; \
            if (sub >= 0) { const GAS bf16* src = (const GAS bf16*)PROJ + (rowb + res + dil * sub) * IN_COLS + h * 64 + 8 * c; kst[i] = *(const GAS v4u*)(src + PC_K); vst[i] = *(const GAS v4u*)(src + PC_V); } } } while (0)
    if (tid == 0) F.MISC[16] = __hip_atomic_fetch_add(qctr, 1u, RLX_AGENT);
    __syncthreads();
    int up = (int)F.MISC[16];
    __syncthreads();
    if (up < ATT_UNITS / 2) ATT_ISSUE(up);
    while (up < ATT_UNITS / 2) {
        if (tid == 0) F.MISC[16] = __hip_atomic_fetch_add(qctr, 1u, RLX_AGENT);
        ATT_DECODE(up)
        const int ql = 32 * wq + r32; const size_t qrow = rowb + res + dil * (128 * n + ql);
        bf16x8 qf[4];
#pragma unroll
        for (int d0 = 0; d0 < 4; ++d0) qf[d0] = *(const GAS bf16x8*)((const GAS bf16*)PROJ + qrow * IN_COLS + PC_Q + h * 64 + 16 * d0 + 8 * hi);
        {
            const int c = th & 7;
#pragma unroll
            for (int i = 0; i < 8; ++i) {
                const int key = (th >> 3) + 32 * i;
                if (n > 0 || i >= 4) {
                    *(LAS v4u*)(Kl + key * 128 + ((c ^ ((key >> 1) & 7)) * 16)) = kst[i];
                    *(LAS v4u*)(Vl + (c >> 2) * 16384 + key * 64 + (c & 3) * 16) = vst[i]; }
            }
        }
        __syncthreads();
        const int upn = (int)F.MISC[16];
        if (upn < ATT_UNITS / 2) { ATT_ISSUE(upn); }
        const float slope2 = __builtin_amdgcn_exp2f(-(float)(h + 1)) * (float)dil * LOG2E;
        const int thr = r32 - 4 * hi;
        bf16x8 qfb;
        { unsigned sp[3], tp[3], dp[3];
#define SPLIT3(x_, o_) do { float r_ = (x_); _Pragma("unroll") for (int j_ = 0; j_ < 3; ++j_) { const unsigned b_ = cvt2(r_, 0.f) & 0xffffu; o_[j_] = b_; r_ -= __builtin_bit_cast(float, b_ << 16); } } while (0)
          SPLIT3(slope2, sp); SPLIT3(-slope2 * (float)(128 + r32) - Bsh, tp); SPLIT3(32.f * slope2, dp);
#undef SPLIT3
          const v4u q4 = hi ? (v4u){dp[2], 0u, 0u, 0u} : (v4u){sp[0] | (sp[1] << 16), sp[2] | (tp[0] << 16), tp[1] | (tp[2] << 16), dp[0] | (dp[1] << 16)};
          qfb = __builtin_bit_cast(bf16x8, q4); }
        v4u pw[5][2];
        float l = 0.f;
        const float mx = Bsh;
        f32x16 o[2]; o[0] = f32x16{}; o[1] = f32x16{};
        const int voff = ((lane >> 4) & 1) * 32 + (lane & 3) * 8 + (4 * hi + ((lane & 15) >> 2)) * 64;
#define ATT_QK(kt) do { f32x16 acc; const int key = 32 * (wq + (kt)) + r32; \
            { constexpr unsigned KB_ = (kt) == 0 ? 0u : ((kt) == 1 ? 0x3F80u : ((kt) == 2 ? 0x4000u : ((kt) == 3 ? 0x4040u : 0x4080u)));     \
              const v4u k4 = (v4u){hi ? KB_ : kfb0.x, kfb0.y, kfb0.z, hi ? 0u : (KB_ | (KB_ << 16))}; \
              acc = __builtin_amdgcn_mfma_f32_32x32x16_bf16(__builtin_bit_cast(bf16x8, k4), qfb, f32x16{}, 0, 0, 0); } \
            _Pragma("unroll") for (int d0 = 0; d0 < 4; ++d0) { \
                const bf16x8 kf = *(const LAS bf16x8*)(Kl + key * 128 + (((2 * d0 + hi) ^ ((key >> 1) & 7)) * 16)); \
                acc = __builtin_amdgcn_mfma_f32_32x32x16_bf16(kf, qf[d0], acc, 0, 0, 0); } \
            _Pragma("unroll") for (int r = 0; r < 16; ++r) { \
                float p = __builtin_amdgcn_exp2f(acc[r]); \
                if ((kt) == 0) p = ((r & 3) + 8 * (r >> 2)) >= thr ? p : 0.f; \
                if ((kt) == 4) p = ((r & 3) + 8 * (r >> 2)) <= thr ? p : 0.f; \
                acc[r] = p; l += p; } \
            _Pragma("unroll") for (int s2 = 0; s2 < 2; ++s2) { \
                pw[kt][s2].x = cvt2(acc[8 * s2 + 0], acc[8 * s2 + 1]); pw[kt][s2].y = cvt2(acc[8 * s2 + 2], acc[8 * s2 + 3]); \
                pw[kt][s2].z = cvt2(acc[8 * s2 + 4], acc[8 * s2 + 5]); pw[kt][s2].w = cvt2(acc[8 * s2 + 6], acc[8 * s2 + 7]); } } while (0)
#define ATT_PV(kt) do { _Pragma("unroll") for (int s2 = 0; s2 < 2; ++s2) { \
                const bf16x8 pf = __builtin_bit_cast(bf16x8, pw[kt][s2]); \
                const int kb = 32 * (wq + (kt)) + 16 * s2; \
                _Pragma("unroll") for (int dt = 0; dt < 2; ++dt) { \
                    const LAS unsigned char* vp = Vl + dt * 16384 + kb * 64 + voff; \
                    const s16x4 lo = vtr(vp), hi4 = vtr(vp + 8 * 64); \
                    const bf16x8 vf = (bf16x8){lo[0], lo[1], lo[2], lo[3], hi4[0], hi4[1], hi4[2], hi4[3]}; \
                    o[dt] = __builtin_amdgcn_mfma_f32_32x32x16_bf16(vf, pf, o[dt], 0, 0, 0); } } } while (0)
        if (n != 0) {
            ATT_QK(0); ATT_QK(1); ATT_QK(2); ATT_QK(3); ATT_QK(4);
            ATT_PV(0); ATT_PV(1); ATT_PV(2); ATT_PV(3); ATT_PV(4);
        } else {
            if (wq + 0 >= 4) ATT_QK(0); if (wq + 1 >= 4) ATT_QK(1); if (wq + 2 >= 4) ATT_QK(2); if (wq + 3 >= 4) ATT_QK(3); ATT_QK(4);
            if (wq + 0 >= 4) ATT_PV(0); if (wq + 1 >= 4) ATT_PV(1); if (wq + 2 >= 4) ATT_PV(2); if (wq + 3 >= 4) ATT_PV(3); ATT_PV(4);
        }
#undef ATT_QK
#undef ATT_PV
        l += __shfl_xor(l, 32);
        bf16* po = PO + ((size_t)pat * M + qrow) * AW + h * 64;
#pragma unroll
        for (int kp = 0; kp < 4; ++kp) {
            const int dt = kp >> 1, g = 2 * (kp & 1);
            v2u a = (v2u){pk2(o[dt][4 * g], o[dt][4 * g + 1]), pk2(o[dt][4 * g + 2], o[dt][4 * g + 3])};
            v2u b = (v2u){pk2(o[dt][4 * g + 4], o[dt][4 * g + 5]), pk2(o[dt][4 * g + 6], o[dt][4 * g + 7])};
            { auto r = __builtin_amdgcn_permlane32_swap(a.x, b.x, false, false); a.x = r[0]; b.x = r[1]; }
            { auto r = __builtin_amdgcn_permlane32_swap(a.y, b.y, false, false); a.y = r[0]; b.y = r[1]; }
            *(v4u*)(po + 16 * kp + 8 * hi) = (v4u){a.x, a.y, b.x, b.y};
        }
        if (hi == 0) *(f32x2*)(ML + (((size_t)pat * M + qrow) * NH + h) * 2) = (f32x2){mx, l};
        __syncthreads();
        up = upn;
    }
#undef ATT_DECODE
#undef ATT_ISSUE
}

struct P5In { v4u po[3]; f32x2 ml[3]; };
__device__ __forceinline__ void p5_load(P5In& I, int m, int lane, const bf16* PO, const float* ML) {
    const int hd = lane >> 3;
#pragma unroll
    for (int p = 0; p < 3; ++p) { I.ml[p] = *(const GAS f32x2*)(ML + (((size_t)p * M + m) * NH + hd) * 2); I.po[p] = __builtin_nontemporal_load((const GAS v4u*)(PO + ((size_t)p * M + m) * AW + 8 * lane)); }
}
__device__ __forceinline__ void p5_token(const P5In& I, int m, int lane, bf16* MIX, const float (&aog)[8]) {
    const float mm = fmaxf(fmaxf(I.ml[0].x, I.ml[1].x), I.ml[2].x);
    float wp[3], wsum = 0.f;
#pragma unroll
    for (int p = 0; p < 3; ++p) { wp[p] = __builtin_amdgcn_exp2f(I.ml[p].x - mm); wsum += wp[p] * I.ml[p].y; }
    const float rws = __builtin_amdgcn_rcpf(wsum);
    float at[8] = {0.f, 0.f, 0.f, 0.f, 0.f, 0.f, 0.f, 0.f};
#pragma unroll
    for (int p = 0; p < 3; ++p) { const v4u w = I.po[p]; const float f = wp[p] * rws;
        at[0] += f * bflo(w.x); at[1] += f * bfhi(w.x); at[2] += f * bflo(w.y); at[3] += f * bfhi(w.y); at[4] += f * bflo(w.z); at[5] += f * bfhi(w.z); at[6] += f * bflo(w.w); at[7] += f * bfhi(w.w); }
    float ss = 0.f;
#pragma unroll
    for (int i = 0; i < 8; ++i) ss += at[i] * at[i];
    ss += __shfl_xor(ss, 1); ss += __shfl_xor(ss, 2); ss += __shfl_xor(ss, 4);
    const float rstd = __builtin_amdgcn_rsqf(ss * (1.f / 64.f) + NORM_EPS);
    v4u oa; oa.x = pk2(at[0] * rstd * aog[0], at[1] * rstd * aog[1]); oa.y = pk2(at[2] * rstd * aog[2], at[3] * rstd * aog[3]);
    oa.z = pk2(at[4] * rstd * aog[4], at[5] * rstd * aog[5]); oa.w = pk2(at[6] * rstd * aog[6], at[7] * rstd * aog[7]);
    *(GAS v4u*)(MIX + (size_t)m * D + 8 * lane) = oa;
}
template <int T>
__device__ __forceinline__ void p5_post(Frame& F, const Args& AR, int m_lo, int m_hi, int wg, int nwg) {
    const int gw = wg * NWAVES + F.wave, NGW = nwg * NWAVES, lane = F.lane;
    const bf16* PO = (const bf16*)((unsigned char*)F.out + DO_PO); const float* ML = (const float*)(F.ws + WS_ML);
    bf16* MIX = (bf16*)(F.ws + WS_XN);
    float aog[8];
#pragma unroll
    for (int i = 0; i < 8; ++i) aog[i] = AR.in[I_AOG][8 * lane + i];
    static_assert(M % 4 == 0, "four tokens per step");
    if constexpr (T == 4) {
        for (int m = m_lo + 4 * gw; m < m_hi; m += 4 * NGW) {
            P5In A, B, C, E;
            p5_load(A, m, lane, PO, ML); p5_load(B, m + 1, lane, PO, ML); p5_load(C, m + 2, lane, PO, ML); p5_load(E, m + 3, lane, PO, ML);
            p5_token(A, m, lane, MIX, aog); p5_token(B, m + 1, lane, MIX, aog); p5_token(C, m + 2, lane, MIX, aog); p5_token(E, m + 3, lane, MIX, aog);
        }
    } else {
        for (int m = m_lo + 6 * gw; m < m_hi; m += 6 * NGW) {
            const bool v1 = m + 2 < m_hi, v2 = m + 4 < m_hi;
            P5In A, B, C, E, G, H;
            p5_load(A, m, lane, PO, ML); p5_load(B, m + 1, lane, PO, ML);
            if (v1) { p5_load(C, m + 2, lane, PO, ML); p5_load(E, m + 3, lane, PO, ML); }
            if (v2) { p5_load(G, m + 4, lane, PO, ML); p5_load(H, m + 5, lane, PO, ML); }
            p5_token(A, m, lane, MIX, aog); p5_token(B, m + 1, lane, MIX, aog);
            if (v1) { p5_token(C, m + 2, lane, MIX, aog); p5_token(E, m + 3, lane, MIX, aog); }
            if (v2) { p5_token(G, m + 4, lane, MIX, aog); p5_token(H, m + 5, lane, MIX, aog); }
        }
    }
}

__device__ __forceinline__ void p1_tail_weights(Frame& F, const Args& AR, int w0, int nw) {
    LAS float* scr = (LAS float*)(F.lds + RING_OFF + F.wave * TR_SCR);
    bf16* Wout_t = (bf16*)(F.ws + WS_WOUT); bf16* Wgu_t = (bf16*)(F.ws + WS_WGU); bf16* Wdn_t = (bf16*)(F.ws + WS_WDN);
    constexpr int I_OUT = (D / 64) * (D / 64), I_G = (D / 64) * (FF / 64), I_DN = (FF / 64) * (D / 64), NLATE = I_OUT + 2 * I_G + I_DN;
    for (int it = w0; it < NLATE; it += nw) {
        int r = it;
        if (r < I_OUT) { p0_transpose_item(AR.in[I_WOUT], D, D, Wout_t, 0, scr, r, F.lane); continue; } r -= I_OUT;
        if (r < I_G) { p0_transpose_item(AR.in[I_WG], D, FF, Wgu_t, 1, scr, r, F.lane, AR.in[I_N2G]); continue; } r -= I_G;
        if (r < I_G) { p0_transpose_item(AR.in[I_WU], D, FF, Wgu_t, 2, scr, r, F.lane, AR.in[I_N2G]); continue; } r -= I_G;
        p0_transpose_item(AR.in[I_WD], FF, D, Wdn_t, 0, scr, r, F.lane);
    }
}

__global__ void __launch_bounds__(NWAVES * 64, 2) hybrid_fwd(Args args) {
    extern __shared__ __attribute__((aligned(16))) unsigned char lds[];
    Frame F;
    F.lds = (LAS unsigned char*)lds;
    F.MISC = (volatile LAS unsigned*)(F.lds + MISC_OFF);
    F.tid = threadIdx.x; F.lane = F.tid & 63; F.wave = __builtin_amdgcn_readfirstlane(F.tid >> 6);
    F.G = gridDim.x; { const int bx = blockIdx.x; F.vcu = (F.G % 8 == 0) ? (bx % 8) * (F.G / 8) + bx / 8 : bx; }
    F.ws = args.ws; F.out = args.out;
    F.ctl = (gu32*)(args.ws + WS_CTL);
    for (int u = F.tid; u < (LDS_BYTES - LDSCTL_OFF) / 4; u += NWAVES * 64) ((LAS unsigned*)(F.lds + LDSCTL_OFF))[u] = 0u;
    __syncthreads();
    XcdBarrier bar; bar.bar = (unsigned*)(F.ctl + CW_BAR); bar.x = 0; bar.st = nullptr;
    if (N_LAUNCHES != PER_PHASE) bar = xcd_barrier_post((unsigned*)(F.ctl + CW_BAR), F.MISC + 8, (unsigned)F.G);
    const bool SPLIT = (N_LAUNCHES == 1) && (F.G % 16 == 0) && ((M / 256) % 2 == 0);
    const int sg = SPLIT ? ((int)blockIdx.x & 1) : 0, sgG = SPLIT ? F.G / 2 : F.G, sgc = SPLIT ? ((int)blockIdx.x >> 3) * 4 + (((int)blockIdx.x & 7) >> 1) : (int)blockIdx.x, sgM = SPLIT ? M / 2 : M, sgX = SPLIT ? 4 : 8;
    const size_t sgr = (size_t)sg * sgM;
    XcdBarrier sbar = bar;
    if (SPLIT) sbar = xcd_barrier_post((unsigned*)(F.ctl + CW_BAR_SUB + 4096 * sg), F.MISC + 10, (unsigned)sgG);
#define SUB_BAR() do { if (SPLIT) xcd_barrier(sbar); else GRID_BAR(); } while (0)
#define GRID_BAR() do { if (N_LAUNCHES != PER_PHASE) xcd_barrier(bar); } while (0)
    const int lo = args.ph_lo, hi = args.ph_hi;
#ifndef PHMASK
#define PHMASK 0x3ff
#endif
#define IN(k) (((PHMASK >> (k)) & 1) && lo <= (k) && (k) < hi)
#define BOTH(k) (IN(k) && IN((k) + 1))
#define PSTAMP(i) do { if (PROBE_SEL >= 0 && blockIdx.x == 0 && F.tid == 0) { const unsigned long long t_ = __builtin_amdgcn_s_memtime(); __hip_atomic_store(F.ctl + 9100 + (i), (unsigned)(t_ >> 4), RLX_AGENT); } } while (0)
#ifndef REPMASK
#define REPMASK 0
#endif
#define REP(k) for (int rep_ = 0; rep_ <= ((REPMASK >> (k)) & 1); ++rep_)
    bf16* XN = (bf16*)(args.ws + WS_XN); bf16* PROJ = (bf16*)(args.ws + WS_PROJ);

    PSTAMP(0);
    if (IN(0)) { p0_prologue(F, args); if (BOTH(0)) GRID_BAR(); }
    PSTAMP(1);
    if (IN(1)) {
        pg8::Gemm g{(const bf16*)(args.ws + WS_XBF), (const bf16*)(args.ws + WS_WIN), M, IN_COLS, D}; pg8::StaticOrder S; S.init(M, IN_COLS, F.G, (int)blockIdx.x);
        LAS float* gl = (LAS float*)(F.lds + RING_OFF + 131072 + 4096);
        pg8::EpiProj E{(const float*)(args.ws + WS_SS1), gl + 128, PROJ, IN_COLS, gl};
        const int nu = (M / 256) * (IN_COLS / 256), rem = nu % F.G;
        if (rem != 0 && (int)blockIdx.x >= rem) { p1_tail_weights(F, args, ((int)blockIdx.x - rem) * NWAVES + F.wave, (F.G - rem) * NWAVES); __syncthreads(); }
        if (F.tid < 128) gl[F.tid] = F.tid < 64 ? args.in[I_QNG][F.tid] * (0.125f * LOG2E) : args.in[I_KNG][F.tid - 64];
        __syncthreads();
        pg8::gemm_phase<pg8::EpiProj, pg8::StaticOrder, true, true>(F.lds + RING_OFF, g, S, E);
        if (rem == 0) p1_tail_weights(F, args, (int)blockIdx.x * NWAVES + F.wave, F.G * NWAVES);
        if (BOTH(1)) GRID_BAR();
    }
    PSTAMP(2);
    PSTAMP(3);
    const bool P3_ARRIVE_ONLY = (N_LAUNCHES == 1) && BOTH(3) && ((int)blockIdx.x >= BATCH * NH);
    if (IN(3)) { p3_lora(F, args); if (BOTH(3)) { if (P3_ARRIVE_ONLY) xcd_barrier_arrive(bar, F.MISC + 15); else GRID_BAR(); } }
    PSTAMP(4);
    if (IN(4)) { p4_scan(F, args); PSTAMP(11); p4_attn(F, args); PSTAMP(12); if (P3_ARRIVE_ONLY) xcd_barrier_wait(bar, F.MISC + 15); if (BOTH(4)) GRID_BAR(); }
    PSTAMP(5);
    const int p5a = SPLIT ? P5A_ROWS : M;
    const bool P5_SPLITPHASE = SPLIT && (N_LAUNCHES == 1) && BOTH(5);
    if (IN(5)) { p5_post<6>(F, args, 0, p5a, F.vcu, F.G);
        if (BOTH(5)) { if (P5_SPLITPHASE && sg == 1) xcd_barrier_arrive(bar, F.MISC + 14); else GRID_BAR(); } }
    PSTAMP(6);
    if (IN(6)) {
        if (SPLIT && sg == 1) {
            p5_post<4>(F, args, p5a, M, sgc, sgG);
            asm volatile("s_waitcnt vmcnt(0)" ::: "memory"); __syncthreads();
            if (F.tid == 0) __hip_atomic_fetch_add(F.ctl + CW_P5B, 1u, __ATOMIC_RELEASE, __HIP_MEMORY_SCOPE_AGENT);
            SUB_BAR();
            if (P5_SPLITPHASE) xcd_barrier_wait(bar, F.MISC + 14);
        }
        pg8::Gemm g{XN + sgr * D, (const bf16*)(args.ws + WS_WOUT), sgM, D, D}; pg8::StaticOrder S; S.init(sgM, D, sgG, sgc, sgX);
        pg8::EpiOut E{(const bf16*)(args.ws + WS_XBF) + sgr * D, (bf16*)(args.ws + WS_DAG) + sgr * D, (float*)(args.ws + WS_SS) + sgr * 4, D, (LAS float*)(F.lds + RING_OFF + 131072)};
        pg8::gemm_phase<pg8::EpiOut, pg8::StaticOrder, true, true>(F.lds + RING_OFF, g, S, E);
        if (IN(8)) SUB_BAR();
    }
    PSTAMP(8);
    if (IN(8)) {
        pg8::Gemm g{(const bf16*)(args.ws + WS_DAG) + sgr * D, (const bf16*)(args.ws + WS_WGU), sgM, NGU, D}; pg8::StaticOrder S; S.init(sgM, NGU, sgG, sgc, sgX);
        pg8::EpiSwiglu E{PROJ + sgr * FF, FF, (const float*)(args.ws + WS_SS) + sgr * 4, (LAS float*)(F.lds + RING_OFF + 131072)};
        pg8::gemm_phase<pg8::EpiSwiglu, pg8::StaticOrder, true, true>(F.lds + RING_OFF, g, S, E);
        if (BOTH(8)) SUB_BAR();
    }
    PSTAMP(9);
    if (IN(9)) {
        if (SPLIT && sg == 0) {
            if (F.tid == 0) { unsigned sp_ = 0; while (__hip_atomic_load(F.ctl + CW_P5B, __ATOMIC_ACQUIRE, __HIP_MEMORY_SCOPE_AGENT) < (unsigned)sgG && ++sp_ < (1u << 24)) __builtin_amdgcn_s_sleep(8); }
            __syncthreads();
        }
        pg8::Gemm g{PROJ + sgr * FF, (const bf16*)(args.ws + WS_WDN), sgM, D, FF}; pg8::StaticOrder S; S.init(sgM, D, sgG, sgc, sgX);
        pg8::EpiFinal E{(const bf16*)(args.ws + WS_DAG) + sgr * D, F.out + sgr * D, D};
        pg8::gemm_phase<pg8::EpiFinal, pg8::StaticOrder, true, true>(F.lds + RING_OFF, g, S, E);
    }
    PSTAMP(10);
    if (PROBE_SEL >= 0 && blockIdx.x == 0 && F.tid == 0) {
        unsigned w = 0;
        auto ld = [&](int i) { return __hip_atomic_load(F.ctl + 9100 + i, RLX_AGENT); };
        const int sel = PROBE_SEL;
        if (sel <= 9) { const int nxt = sel == 6 ? 8 : (sel == 9 ? 10 : sel + 1); w = ld(nxt) - ld(sel); }
        else if (sel == 20) w = ld(11) - ld(4);
        else if (sel == 21) w = ld(12) - ld(11);
        else w = ld(sel);
        const unsigned long long t0 = __builtin_amdgcn_s_memtime();
        while (((__builtin_amdgcn_s_memtime() - t0) >> 4) < (unsigned long long)w) __builtin_amdgcn_s_sleep(8);
    }
#undef IN
#undef BOTH
}

extern "C" void kernel_launch(void* const* d_in, const int* in_sizes, int n_in, void* d_out, int out_size, void* d_ws, size_t ws_size, hipStream_t stream) {
    static int grid = 0;
    if (grid == 0) {
        if (n_in != 22 || in_sizes[0] != M * D || out_size != M * D || ws_size < WS_END) { fprintf(stderr, "kernel_launch: unexpected shapes (n_in %d, in0 %d, out %d, ws %zu); nothing launched\n", n_in, n_in > 0 ? in_sizes[0] : -1, out_size, ws_size); grid = -1; return; }
        int dev = 0, cus = 0, per_cu = 0;
        if (hipGetDevice(&dev) != hipSuccess || hipDeviceGetAttribute(&cus, hipDeviceAttributeMultiprocessorCount, dev) != hipSuccess) { grid = -1; return; }
        if (hipFuncSetAttribute((const void*)hybrid_fwd, hipFuncAttributeMaxDynamicSharedMemorySize, LDS_BYTES) != hipSuccess) { fprintf(stderr, "kernel_launch: hipFuncSetAttribute failed\n"); grid = -1; return; }
        if (hipOccupancyMaxActiveBlocksPerMultiprocessor(&per_cu, (const void*)hybrid_fwd, NWAVES * 64, LDS_BYTES) != hipSuccess || per_cu < 1)
            fprintf(stderr, "kernel_launch: note: occupancy query reports %d workgroups per CU\n", per_cu);
        (void)hipGetLastError();
        grid = cus;
    }
    if (grid < 0) return;
    if (hipMemsetAsync((char*)d_ws + WS_CTL, 0, CTL_ZERO_BYTES, stream) != hipSuccess) { fprintf(stderr, "kernel_launch: hipMemsetAsync failed\n"); return; }
    Args a{};
    for (int i = 0; i < 22; ++i) a.in[i] = (const float*)d_in[i];
    a.out = (float*)d_out; a.ws = (unsigned char*)d_ws;
    for (int li = 0; li < N_LAUNCHES; ++li) {
        a.ph_lo = (N_LAUNCHES == PER_PHASE) ? li : 0; a.ph_hi = (N_LAUNCHES == PER_PHASE) ? li + 1 : PER_PHASE; a.li = li;
        hipLaunchKernelGGL(hybrid_fwd, dim3(grid), dim3(NWAVES * 64), LDS_BYTES, stream, a);
        const hipError_t le = hipPeekAtLastError();
        if (le != hipSuccess) { fprintf(stderr, "kernel_launch: launch %d failed: %s\n", li, hipGetErrorName(le)); break; }
    }
}
```
